# Optimizing an MI355X kernel written in HIP

```python
import jax
import jax.numpy as jnp
from jax import lax
import numpy as np

D_MODEL = 1024
BATCH = 8
SEQ = 2048
DEPTH = 4

GRID_W = 64
CTX_LEN = 256
RMS_EPS = 1e-6
N_MOD = 6

NA_HEADS = 8
NA_HEAD_DIM = 64
NA_WIDTH = NA_HEADS * NA_HEAD_DIM
WIN_ROWS = 8
WIN_COLS = 16
NA_QCB = 16
NA_KCB = 32

HG_HEADS = 4
HG_DK = 128
HG_DV = 128
HG_KEY_WIDTH = HG_HEADS * HG_DK
HG_WIDTH = HG_HEADS * HG_DV
HG_CHUNK = 64

GQA_Q_HEADS = 8
GQA_KV_HEADS = 2
GQA_HEAD_DIM = 64
GQA_Q_WIDTH = GQA_Q_HEADS * GQA_HEAD_DIM
GQA_KV_WIDTH = GQA_KV_HEADS * GQA_HEAD_DIM
GQA_BLOCK = 128
ROPE_THETA = 10000.0

N_BRANCHES = 3
BRANCH_W = 512

N_GROUPS = 4
EXPERTS_PER_GROUP = 4
N_EXPERTS = N_GROUPS * EXPERTS_PER_GROUP
TOP_K = 2
EXPERT_HIDDEN = 512

IN_SPLITS = (NA_WIDTH, NA_WIDTH, NA_WIDTH,
             HG_KEY_WIDTH, HG_KEY_WIDTH, HG_KEY_WIDTH, HG_WIDTH, HG_WIDTH,
             GQA_Q_WIDTH, GQA_KV_WIDTH, GQA_KV_WIDTH,
             D_MODEL, D_MODEL, D_MODEL)
IN_COLS = 3 * NA_WIDTH + 3 * HG_KEY_WIDTH + 2 * HG_WIDTH + GQA_Q_WIDTH + 2 * GQA_KV_WIDTH + N_BRANCHES * D_MODEL

kernel_name = 'hybrid_na_hgrn2_gqa_hmoe_dit'


def rmsnorm(x, g):
    xf = x.astype(jnp.float32)
    y = xf * lax.rsqrt(jnp.mean(xf * xf, axis=-1, keepdims=True) + RMS_EPS)
    return (y * g.astype(jnp.float32)).astype(x.dtype)


def modulate(h, shift, scale):
    return h * (1 + scale) + shift


def split_heads(z, dh):
    return z.reshape(z.shape[:-1] + (z.shape[-1] // dh, dh))


def split_in(z):
    return jnp.split(z, np.cumsum(IN_SPLITS)[:-1].tolist(), axis=-1)


def axial_rope_tables(n_tokens, dtype):
    t = jnp.arange(n_tokens)
    pos = jnp.stack([t // GRID_W, t % GRID_W], axis=-1).astype(jnp.float32)
    n_freq = GQA_HEAD_DIM // 4
    inv_freq = jnp.power(ROPE_THETA, -jnp.arange(n_freq, dtype=jnp.float32) / n_freq)
    ang = pos[:, :, None] * inv_freq
    ang = jnp.concatenate([ang, ang], axis=-1)
    return jnp.cos(ang).astype(dtype), jnp.sin(ang).astype(dtype)


def apply_axial_rope(x, cos, sin):
    xa = x.reshape(x.shape[:-1] + (2, GQA_HEAD_DIM // 2))
    x1, x2 = jnp.split(xa, 2, axis=-1)
    rot = jnp.concatenate([-x2, x1], axis=-1)
    out = xa * cos[None, :, None] + rot * sin[None, :, None]
    return out.reshape(x.shape)


def grouped_attention(q, k, v):
    scale = q.shape[-1] ** -0.5
    s = jnp.einsum('bqgrd,bkgd->bgrqk', q, k).astype(jnp.float32) * scale
    p = jax.nn.softmax(s, axis=-1).astype(v.dtype)
    return jnp.einsum('bgrqk,bkgd->bqgrd', p, v)


def blocked_grouped_attention(q, k, v):
    B, L, G, R, hd = q.shape
    nb = L // GQA_BLOCK
    qb = q.reshape(B, nb, GQA_BLOCK, G, R, hd).transpose(1, 0, 2, 3, 4, 5)
    ob = lax.map(lambda qq: grouped_attention(qq, k, v), qb)
    return ob.transpose(1, 0, 2, 3, 4, 5).reshape(B, L, G, R, hd)


def neighbourhood_attention(q, k, v, k_ctx, v_ctx, rpb):
    B, L, H, hd = q.shape
    rows = L // GRID_W
    wr = min(WIN_ROWS, rows)
    ncb = GRID_W // NA_QCB
    n_loc = wr * NA_KCB
    scale = hd ** -0.5
    qg = q.reshape(B, rows, GRID_W, H, hd)
    kg = k.reshape(B, rows, GRID_W, H, hd)
    vg = v.reshape(B, rows, GRID_W, H, hd)
    qcol = np.arange(GRID_W).reshape(ncb, NA_QCB)
    kc0 = np.clip(np.arange(ncb) * NA_QCB - WIN_COLS // 2, 0, GRID_W - NA_KCB)
    kcol = kc0[:, None] + np.arange(NA_KCB)[None, :]
    c0 = np.clip(qcol - WIN_COLS // 2, 0, GRID_W - WIN_COLS)
    col_ok = (kcol[:, None, :] >= c0[:, :, None]) & (kcol[:, None, :] < c0[:, :, None] + WIN_COLS)
    dcol = kcol[:, None, :] - qcol[:, :, None] + WIN_COLS - 1
    mask = np.broadcast_to(col_ok[:, :, None, :], (ncb, NA_QCB, wr, NA_KCB)).reshape(ncb, NA_QCB, n_loc)
    rpb = rpb.astype(jnp.float32)

    def one_row(r):
        r0 = jnp.clip(r - wr // 2, 0, rows - wr)
        q_r = lax.dynamic_index_in_dim(qg, r, axis=1, keepdims=False)
        k_r = lax.dynamic_slice_in_dim(kg, r0, wr, axis=1)[:, :, kcol]
        v_r = lax.dynamic_slice_in_dim(vg, r0, wr, axis=1)[:, :, kcol]
        k_r = k_r.transpose(0, 2, 1, 3, 4, 5).reshape(B, ncb, n_loc, H, hd)
        v_r = v_r.transpose(0, 2, 1, 3, 4, 5).reshape(B, ncb, n_loc, H, hd)
        q_b = q_r.reshape(B, ncb, NA_QCB, H, hd)
        drow = r0 + jnp.arange(wr) - r + WIN_ROWS - 1
        bias = rpb[:, drow][:, :, dcol]
        bias = bias.transpose(0, 2, 3, 1, 4).reshape(H, ncb, NA_QCB, n_loc)
        s_loc = jnp.einsum('bjqhd,bjkhd->bhjqk', q_b, k_r).astype(jnp.float32) * scale + bias
        s_loc = jnp.where(mask, s_loc, -jnp.inf)
        s_ctx = jnp.einsum('bjqhd,bkhd->bhjqk', q_b, k_ctx).astype(jnp.float32) * scale
        p = jax.nn.softmax(jnp.concatenate([s_loc, s_ctx], axis=-1), axis=-1).astype(v.dtype)
        o = (jnp.einsum('bhjqk,bjkhd->bjqhd', p[..., :n_loc], v_r)
             + jnp.einsum('bhjqk,bkhd->bjqhd', p[..., n_loc:], v_ctx))
        return o.reshape(B, GRID_W, H, hd)

    o = lax.map(one_row, jnp.arange(rows))
    return o.transpose(1, 0, 2, 3, 4).reshape(B, L, H * hd)


def chunked_gated_scan(q, k, v, log_f, s0):
    B, L, H, _ = q.shape
    dv = v.shape[-1]
    n = L // HG_CHUNK

    def chunks(a):
        return a.reshape(B, n, HG_CHUNK, H, a.shape[-1]).transpose(1, 0, 3, 2, 4)

    tri = np.tril(np.ones((HG_CHUNK, HG_CHUNK), dtype=bool))[:, :, None]

    def step(S, inp):
        qc, kc, vc, gc = inp
        b = jnp.cumsum(gc, axis=2)
        decay = jnp.exp(jnp.where(tri, b[:, :, :, None, :] - b[:, :, None, :, :], -jnp.inf))
        a = jnp.einsum('bhtd,bhsd,bhtsd->bhts', qc, kc, decay)
        o = jnp.einsum('bhts,bhsv->bhtv', a, vc) + jnp.einsum('bhtd,bhdv->bhtv', qc * jnp.exp(b), S)
        b_last = b[:, :, -1:, :]
        S = jnp.exp(b_last)[:, :, 0, :, None] * S + jnp.einsum('bhsd,bhsv->bhdv', kc * jnp.exp(b_last - b), vc)
        return S, o

    s_fin, o = lax.scan(step, s0, (chunks(q), chunks(k), chunks(v), chunks(log_f)))
    return o.transpose(1, 0, 3, 2, 4).reshape(B, L, H, dv), s_fin


def hgrn2_scans(q_raw, ff_raw, fb_raw, i_raw, lb, s_fwd, s_bwd):
    q = split_heads(jax.nn.silu(q_raw.astype(jnp.float32)), HG_DK)
    v = split_heads(i_raw.astype(jnp.float32), HG_DV)

    def forget(f_raw, lower):
        f = lower + (1.0 - lower) * jax.nn.sigmoid(f_raw.astype(jnp.float32))
        return split_heads(1.0 - f, HG_DK), split_heads(jnp.log(f), HG_DK)

    k_f, g_f = forget(ff_raw, lb[0])
    k_b, g_b = forget(fb_raw, lb[1])
    rev = lambda a: jnp.flip(a, axis=1)
    o_f, s_fwd = chunked_gated_scan(q, k_f, v, g_f, s_fwd)
    o_b, s_bwd = chunked_gated_scan(rev(q), rev(k_b), rev(v), rev(g_b), s_bwd)
    return o_f + rev(o_b), s_fwd, s_bwd


def hgrn2_readout(o, g_raw, norm_g):
    y = rmsnorm(o, norm_g) * jax.nn.silu(split_heads(g_raw, HG_DV).astype(jnp.float32))
    return y.reshape(o.shape[:2] + (HG_WIDTH,)).astype(g_raw.dtype)


def group_queries(q):
    return q.reshape(q.shape[:2] + (GQA_KV_HEADS, GQA_Q_HEADS // GQA_KV_HEADS, GQA_HEAD_DIM))


def branch_merge(branches, gate_logits, w_branch, w_out):
    y = 0
    for i in range(N_BRANCHES):
        y = y + jax.nn.sigmoid(gate_logits[i]) * (branches[i] @ w_branch[i])
    return y @ w_out


def token_mixer(h_lat, h_ctx, w_in, rpb, lb, hg_norm_g, q_norm_g, k_norm_g, w_branch, w_out, cos, sin, with_ctx):
    B, L, _ = h_lat.shape
    n_ctx = h_ctx.shape[1]
    zl = split_in(h_lat @ w_in)
    zc = split_in(h_ctx @ w_in)
    na_q, na_k, na_v = [split_heads(z, NA_HEAD_DIM) for z in zl[0:3]]
    na_qc, na_kc, na_vc = [split_heads(z, NA_HEAD_DIM) for z in zc[0:3]]
    a_lat = neighbourhood_attention(na_q, na_k, na_v, na_kc, na_vc, rpb)
    s0 = jnp.zeros((B, HG_HEADS, HG_DK, HG_DV), jnp.float32)
    o_ctx, s_fwd, s_bwd = hgrn2_scans(zc[3], zc[4], zc[5], zc[6], lb, s0, s0)
    o_lat, _, _ = hgrn2_scans(zl[3], zl[4], zl[5], zl[6], lb, s_fwd, s_bwd)
    b_lat = hgrn2_readout(o_lat, zl[7], hg_norm_g)
    q_lat = apply_axial_rope(rmsnorm(split_heads(zl[8], GQA_HEAD_DIM), q_norm_g), cos, sin)
    k_lat = apply_axial_rope(rmsnorm(split_heads(zl[9], GQA_HEAD_DIM), k_norm_g), cos, sin)
    q_ctx = rmsnorm(split_heads(zc[8], GQA_HEAD_DIM), q_norm_g)
    k_ctx = rmsnorm(split_heads(zc[9], GQA_HEAD_DIM), k_norm_g)
    v_lat = split_heads(zl[10], GQA_HEAD_DIM)
    v_ctx = split_heads(zc[10], GQA_HEAD_DIM)
    k_all = jnp.concatenate([k_ctx, k_lat], axis=1)
    v_all = jnp.concatenate([v_ctx, v_lat], axis=1)
    c_lat = blocked_grouped_attention(group_queries(q_lat), k_all, v_all).reshape(B, L, GQA_Q_WIDTH)
    y_lat = branch_merge((a_lat, b_lat, c_lat), zl[11:14], w_branch, w_out)
    if not with_ctx:
        return y_lat, None
    a_ctx = grouped_attention(na_qc[:, :, :, None, :], na_kc, na_vc).reshape(B, n_ctx, NA_WIDTH)
    b_ctx = hgrn2_readout(o_ctx, zc[7], hg_norm_g)
    c_ctx_out = grouped_attention(group_queries(q_ctx), k_ctx, v_ctx).reshape(B, n_ctx, GQA_Q_WIDTH)
    y_ctx = branch_merge((a_ctx, b_ctx, c_ctx_out), zc[11:14], w_branch, w_out)
    return y_lat, y_ctx


def hierarchical_moe(h, w_gr, b_gr, w_er, b_er, w_gate, w_up, w_down):
    n = h.shape[0]
    g_logits = (h @ w_gr + b_gr).astype(jnp.float32)
    g_val, g_idx = lax.top_k(g_logits, 1)
    p_group = jnp.exp(g_val - jax.nn.logsumexp(g_logits, axis=-1, keepdims=True))
    e_logits = (h @ w_er + b_er).astype(jnp.float32).reshape(n, N_GROUPS, EXPERTS_PER_GROUP)
    e_in = jnp.take_along_axis(e_logits, g_idx[:, :, None], axis=1)[:, 0]
    e_val, e_idx = lax.top_k(e_in, TOP_K)
    w_sel = jax.nn.softmax(e_val, axis=-1) * p_group
    expert_id = g_idx * EXPERTS_PER_GROUP + e_idx
    combine = jnp.einsum('nk,nke->ne', w_sel, jax.nn.one_hot(expert_id, N_EXPERTS, dtype=jnp.float32)).astype(h.dtype)
    y = jnp.zeros_like(h)
    for e in range(N_EXPERTS):
        he = jax.nn.silu(h @ w_gate[e]) * (h @ w_up[e])
        y = y + combine[:, e:e + 1] * (he @ w_down[e])
    return y


def setup_inputs(seed: int = 0) -> dict:
    key = jax.random.key(seed)
    ks = iter(jax.random.split(key, 32))
    d = D_MODEL

    def nrm(shape, s):
        return jax.random.normal(next(ks), shape, jnp.float32) * s

    return {
        'x': nrm((BATCH, SEQ, d), 1.0),
        'c': nrm((BATCH, d), 1.0),
        'ctx': nrm((BATCH, CTX_LEN, d), 1.0),
        'c_ctx': nrm((d,), 1.0),
        'w_ada': nrm((DEPTH, d, N_MOD * d), 0.5 * d ** -0.5),
        'b_ada': nrm((DEPTH, N_MOD * d), 0.02),
        'g_mix': 1.0 + nrm((DEPTH, d), 0.1),
        'g_ffn': 1.0 + nrm((DEPTH, d), 0.1),
        'w_in': nrm((DEPTH, d, IN_COLS), d ** -0.5),
        'na_rpb': nrm((DEPTH, NA_HEADS, 2 * WIN_ROWS - 1, 2 * WIN_COLS - 1), 0.1),
        'hg_lb_logits': nrm((DEPTH, 2, HG_KEY_WIDTH), 1.0),
        'hg_norm_g': 1.0 + nrm((DEPTH, HG_DV), 0.1),
        'gqa_qnorm_g': 1.0 + nrm((DEPTH, GQA_HEAD_DIM), 0.1),
        'gqa_knorm_g': 1.0 + nrm((DEPTH, GQA_HEAD_DIM), 0.1),
        'w_branch': nrm((DEPTH, N_BRANCHES, BRANCH_W, d), BRANCH_W ** -0.5),
        'w_out': nrm((DEPTH, d, d), d ** -0.5),
        'w_group_router': nrm((DEPTH, d, N_GROUPS), d ** -0.5),
        'b_group_router': nrm((DEPTH, N_GROUPS), 0.01),
        'w_expert_router': nrm((DEPTH, d, N_EXPERTS), d ** -0.5),
        'b_expert_router': nrm((DEPTH, N_EXPERTS), 0.01),
        'w_exp_gate': nrm((DEPTH, N_EXPERTS, d, EXPERT_HIDDEN), d ** -0.5),
        'w_exp_up': nrm((DEPTH, N_EXPERTS, d, EXPERT_HIDDEN), d ** -0.5),
        'w_exp_down': nrm((DEPTH, N_EXPERTS, EXPERT_HIDDEN, d), EXPERT_HIDDEN ** -0.5),
        'g_final': 1.0 + nrm((d,), 0.1),
    }


def reference(x, c, ctx, c_ctx, w_ada, b_ada, g_mix, g_ffn, w_in, na_rpb, hg_lb_logits, hg_norm_g,
              gqa_qnorm_g, gqa_knorm_g, w_branch, w_out, w_group_router, b_group_router,
              w_expert_router, b_expert_router, w_exp_gate, w_exp_up, w_exp_down, g_final):
    B, L, d = x.shape
    cos, sin = axial_rope_tables(L, x.dtype)
    p_lb = jax.nn.softmax(hg_lb_logits.astype(jnp.float32), axis=0)
    lower_bounds = jnp.cumsum(p_lb, axis=0) - p_lb[0:1]
    silu_c = jax.nn.silu(c)
    silu_cc = jax.nn.silu(c_ctx)[None, :]
    for l in range(DEPTH):
        last = l == DEPTH - 1
        mod = jnp.split((silu_c @ w_ada[l] + b_ada[l])[:, None, :], N_MOD, axis=-1)
        mod_c = jnp.split((silu_cc @ w_ada[l] + b_ada[l])[:, None, :], N_MOD, axis=-1)
        h_lat = modulate(rmsnorm(x, g_mix[l]), mod[0], mod[1])
        h_ctx = modulate(rmsnorm(ctx, g_mix[l]), mod_c[0], mod_c[1])
        y_lat, y_ctx = token_mixer(h_lat, h_ctx, w_in[l], na_rpb[l], lower_bounds[l], hg_norm_g[l],
                                   gqa_qnorm_g[l], gqa_knorm_g[l], w_branch[l], w_out[l], cos, sin, not last)
        x = x + mod[2] * y_lat
        f_lat = modulate(rmsnorm(x, g_ffn[l]), mod[3], mod[4]).reshape(-1, d)
        if last:
            y = hierarchical_moe(f_lat, w_group_router[l], b_group_router[l], w_expert_router[l],
                                 b_expert_router[l], w_exp_gate[l], w_exp_up[l], w_exp_down[l])
            x = x + mod[5] * y.reshape(x.shape)
        else:
            ctx = ctx + mod_c[2] * y_ctx
            f_ctx = modulate(rmsnorm(ctx, g_ffn[l]), mod_c[3], mod_c[4]).reshape(-1, d)
            n_lat = f_lat.shape[0]
            y = hierarchical_moe(jnp.concatenate([f_lat, f_ctx], axis=0), w_group_router[l], b_group_router[l],
                                 w_expert_router[l], b_expert_router[l], w_exp_gate[l], w_exp_up[l], w_exp_down[l])
            x = x + mod[5] * y[:n_lat].reshape(x.shape)
            ctx = ctx + mod_c[5] * y[n_lat:].reshape(ctx.shape)
    return rmsnorm(x, g_final)
```

```cpp
#include <hip/hip_runtime.h>
#include <cstdio>
#include <cstdint>

#define LAS __attribute__((address_space(3)))
typedef unsigned short bf16_t;
typedef short bf16x8 __attribute__((ext_vector_type(8)));
typedef float f32x4 __attribute__((ext_vector_type(4)));
typedef unsigned u32x4 __attribute__((ext_vector_type(4)));

constexpr int D = 1024, NB = 8, SEQ = 2048, DEPTH = 4, CTXL = 256;
constexpr int NLAT = NB * SEQ, NCTX = NB * CTXL, NTOK = NLAT + NCTX;
constexpr int INC = 7936;
constexpr int C_NAQ = 0, C_NAK = 512, C_NAV = 1024, C_HQ = 1536, C_HFF = 2048, C_HFB = 2560, C_HI = 3072, C_HG = 3584,
              C_GQ = 4096, C_GK = 4608, C_GV = 4736, C_GATE = 4864;
constexpr int BRW = 1536;
constexpr int NEXP = 16, EH = 512;
constexpr int MPAD = 40960;
constexpr int NTHR = 512;
constexpr int LDS_BYTES = 147456;

constexpr size_t WS_BAR = 0;
constexpr size_t WS_CNT = 16384;
constexpr size_t WS_ZERO_BYTES = 65536;
constexpr size_t WS_MODS = 65536;
constexpr size_t WS_LB = WS_MODS + 884736;
constexpr size_t WS_ROPE = WS_LB + 16384;
constexpr size_t WS_SELE = WS_ROPE + 12288;
constexpr size_t WS_SELW = WS_SELE + 147456;
constexpr size_t WS_SELP = WS_SELW + 147456;
constexpr size_t WS_SROW = WS_SELP + 147456;
constexpr size_t WS_X = 2097152;
constexpr size_t WS_H = WS_X + (size_t)NTOK * D * 4;
constexpr size_t WS_Z = WS_H + (size_t)NTOK * D * 2;
constexpr size_t WS_BR = WS_Z + (size_t)NTOK * INC * 2;
constexpr size_t WS_Y = WS_BR + (size_t)NTOK * BRW * 2;
constexpr size_t WS_QN = WS_Y + (size_t)NTOK * D * 2;
constexpr size_t WS_KN = WS_QN + (size_t)NTOK * 512 * 2;
constexpr size_t WS_WIN = WS_KN + (size_t)NTOK * 128 * 2;
constexpr size_t WS_WBR = WS_WIN + (size_t)INC * D * 2;
constexpr size_t WS_WOUT = WS_WBR + (size_t)3 * D * 512 * 2;
constexpr size_t WS_WGU = WS_WOUT + (size_t)D * D * 2;
constexpr size_t WS_WDN = WS_WGU + (size_t)NEXP * 1024 * 1024 * 2;
constexpr size_t WS_END = WS_WDN + (size_t)NEXP * 1024 * 512 * 2;
constexpr size_t WS_FS = WS_Z;
constexpr size_t WS_HS = WS_FS + (size_t)MPAD * 1024 * 2;
constexpr size_t WS_YS = WS_HS + (size_t)MPAD * 512 * 2;
static_assert(WS_YS + (size_t)MPAD * 1024 * 2 <= WS_BR, "moe alias");
static_assert(WS_SROW + 147456 <= WS_X, "ctl");

#define XB_TMO      128
#define XB_XCNT(j)  (256  + 64 * (j))
#define XB_XSUB(j)  (1280 + 64 * (j))
#define XB_XGEN(j)  (2304 + 64 * (j))
#define XB_TOP      3328
#define XB_TOPGEN   3392
#define XCD_BAR_WORDS 3456
#define XB_SPIN_CAP (1u << 22)
__device__ __forceinline__ unsigned xb_ld(unsigned* p)              { return __hip_atomic_load(p, __ATOMIC_RELAXED, __HIP_MEMORY_SCOPE_AGENT); }
__device__ __forceinline__ unsigned xb_add(unsigned* p, unsigned v) { return __hip_atomic_fetch_add(p, v, __ATOMIC_RELAXED, __HIP_MEMORY_SCOPE_AGENT); }
__device__ __forceinline__ unsigned xb_xcc_id() { return (unsigned)__builtin_amdgcn_s_getreg((3 << 11) | 20) & 0xFu; }
#define XB_SPIN(cond, bar) do { unsigned _sp = 0; while (cond) { __builtin_amdgcn_s_sleep(1); \
    if ((++_sp & 255u) == 0u) { if (xb_ld(&(bar)[XB_TMO])) break; if (_sp > XB_SPIN_CAP) { atomicAdd(&(bar)[XB_TMO], 1u); break; } } } } while (0)
struct XcdBarrier { unsigned* bar; unsigned x; volatile LAS unsigned* st; };
__device__ __forceinline__ XcdBarrier xcd_barrier_post(unsigned* bar, volatile LAS unsigned* st) {
    XcdBarrier b; b.bar = bar; b.x = xb_xcc_id(); b.st = st;
    if (threadIdx.x == 0) (void)xb_add(&bar[XB_XCNT(b.x)], 1u);
    return b;
}
__device__ __forceinline__ void xcd_barrier_complete(unsigned* bar, unsigned x, unsigned& nloc, unsigned& nx) {
    const unsigned G = gridDim.x * gridDim.y * gridDim.z;
    unsigned sum, cnt, mine, sp = 0u;
    for (;;) {
        sum = 0u; cnt = 0u; mine = 0u;
#pragma unroll
        for (unsigned j = 0; j < 16; ++j) { const unsigned c = xb_ld(&bar[XB_XCNT(j)]); sum += c; cnt += (c > 0u) ? 1u : 0u; mine = (j == x) ? c : mine; }
        if (sum == G) break;
        __builtin_amdgcn_s_sleep(1);
        if ((++sp & 255u) == 0u) { if (xb_ld(&bar[XB_TMO])) break; if (sp > XB_SPIN_CAP) { atomicAdd(&bar[XB_TMO], 1u); break; } }
    }
    nloc = mine > 0u ? mine : 1u; nx = cnt > 0u ? cnt : 1u;
}
__device__ __forceinline__ void xcd_barrier(const XcdBarrier& b) {
    asm volatile("s_waitcnt vmcnt(0)" ::: "memory");
    __syncthreads();
    if (threadIdx.x == 0) {
        unsigned* bar = b.bar;
        __builtin_amdgcn_s_waitcnt(0);
        unsigned nloc = b.st[0], nx = b.st[1];
        if (nloc == 0u) { xcd_barrier_complete(bar, b.x, nloc, nx); b.st[0] = nloc; b.st[1] = nx; }
        const unsigned old = xb_add(&bar[XB_XSUB(b.x)], 1u);
        const unsigned gen = old / nloc;
        if (old + 1u == (gen + 1u) * nloc) {
            __builtin_amdgcn_fence(__ATOMIC_RELEASE, "agent");
            asm volatile("s_waitcnt vmcnt(0)" ::: "memory");
            const unsigned og = xb_add(&bar[XB_TOP], 1u);
            const unsigned tg = og / nx;
            if (og + 1u == (tg + 1u) * nx) xb_add(&bar[XB_TOPGEN], 1u);
            else XB_SPIN(xb_ld(&bar[XB_TOPGEN]) == tg, bar);
            __builtin_amdgcn_fence(__ATOMIC_ACQUIRE, "agent");
            xb_add(&bar[XB_XGEN(b.x)], 1u);
            asm volatile("s_waitcnt vmcnt(0)" ::: "memory");
        } else {
            XB_SPIN(xb_ld(&bar[XB_XGEN(b.x)]) == gen, bar);
            __builtin_amdgcn_fence(__ATOMIC_ACQUIRE, "agent");
            asm volatile("s_waitcnt vmcnt(0)" ::: "memory");
        }
    }
    __syncthreads();
}

__device__ __forceinline__ float bf_lo(unsigned u) { return __uint_as_float(u << 16); }
__device__ __forceinline__ float bf_hi(unsigned u) { return __uint_as_float(u & 0xffff0000u); }
__device__ __forceinline__ float bf2f(bf16_t b) { return __uint_as_float(((unsigned)b) << 16); }
__device__ __forceinline__ unsigned pk_bf16(float lo, float hi) { unsigned r; asm volatile("v_cvt_pk_bf16_f32 %0, %1, %2" : "=v"(r) : "v"(lo), "v"(hi)); return r; }
__device__ __forceinline__ float sigmoidf_(float x) { return 1.0f / (1.0f + __expf(-x)); }
__device__ __forceinline__ float siluf_(float x) { return x / (1.0f + __expf(-x)); }
__device__ __forceinline__ float wave_sum(float v) {
#pragma unroll
    for (int o = 32; o > 0; o >>= 1) v += __shfl_xor(v, o, 64);
    return v;
}

__device__ __forceinline__ int tid_() { int t = threadIdx.x; asm volatile("" : "+v"(t)); return t; }
__device__ __forceinline__ int bid_() { int t = blockIdx.x; asm volatile("" : "+s"(t)); return t; }
struct Params {
    const float* in[24];
    float* out;
    unsigned char* ws;
    int ph_lo, ph_hi;
};
enum { I_X = 0, I_C, I_CTX, I_CCTX, I_WADA, I_BADA, I_GMIX, I_GFFN, I_WIN, I_RPB, I_LBL, I_HGN, I_QNG, I_KNG, I_WBR, I_WOUT,
       I_WGR, I_BGR, I_WER, I_BER, I_WEG, I_WEU, I_WED, I_GFIN };

__device__ __forceinline__ void g128_kloop(f32x4 (&acc)[4][4], LAS unsigned char* lds, const bf16_t* A, int lda, const bf16_t* Bt, int ldb, int K) {
    const int tid = tid_(), wid = tid >> 6, lane = tid & 63, wr = wid >> 2, wc = wid & 3, fr = lane & 15, fq = lane >> 4;
    LAS unsigned char* SA = lds; LAS unsigned char* SB = lds + 8192;
    const int srow = tid >> 2, skc = (tid & 3) * 8;
    const bf16_t* ap = A + (size_t)srow * lda + skc;
    const bf16_t* bp0 = Bt + (size_t)srow * ldb + skc;
    const bf16_t* bp1 = Bt + (size_t)(srow + 128) * ldb + skc;
    for (int k0 = 0; k0 < K; k0 += 32) {
        const uint4 va = *(const uint4*)(ap + k0);
        const uint4 vb0 = *(const uint4*)(bp0 + k0);
        const uint4 vb1 = *(const uint4*)(bp1 + k0);
        __syncthreads();
        *(LAS u32x4*)(SA + tid * 16) = (u32x4){va.x, va.y, va.z, va.w};
        *(LAS u32x4*)(SB + tid * 16) = (u32x4){vb0.x, vb0.y, vb0.z, vb0.w};
        *(LAS u32x4*)(SB + 8192 + tid * 16) = (u32x4){vb1.x, vb1.y, vb1.z, vb1.w};
        __syncthreads();
        bf16x8 At[4], Bf[4];
#pragma unroll
        for (int m = 0; m < 4; ++m) At[m] = *(const LAS bf16x8*)(SA + ((wr * 64 + m * 16 + fr) * 32 + fq * 8) * 2);
#pragma unroll
        for (int n = 0; n < 4; ++n) Bf[n] = *(const LAS bf16x8*)(SB + ((wc * 64 + n * 16 + fr) * 32 + fq * 8) * 2);
#pragma unroll
        for (int m = 0; m < 4; ++m)
#pragma unroll
            for (int n = 0; n < 4; ++n) acc[m][n] = __builtin_amdgcn_mfma_f32_16x16x32_bf16(Bf[n], At[m], acc[m][n], 0, 0, 0);
    }
}
__device__ __forceinline__ void acc_zero(f32x4 (&acc)[4][4]) {
#pragma unroll
    for (int m = 0; m < 4; ++m)
#pragma unroll
        for (int n = 0; n < 4; ++n) acc[m][n] = (f32x4){0.f, 0.f, 0.f, 0.f};
}
template <class Epi>
__device__ __forceinline__ void g128_epilogue(const f32x4 (&acc)[4][4], int row0, int col0, const Epi& E) {
    const int tid = tid_(), wid = tid >> 6, lane = tid & 63, wr = wid >> 2, wc = wid & 3, fr = lane & 15, fq = lane >> 4;
#pragma unroll
    for (int m = 0; m < 4; ++m)
#pragma unroll
        for (int n = 0; n < 4; n += 2) E(row0 + wr * 64 + m * 16 + fr, col0 + wc * 64 + n * 16 + fq * 4, acc[m][n], acc[m][n + 1]);
}

__device__ __forceinline__ void ph_prologue(const Params& P, LAS unsigned char* lds) {
    const int tid = tid_(), bid = bid_(), G = gridDim.x;
    float* mods = (float*)(P.ws + WS_MODS);
    if (bid < 48) {
        LAS float* sc = (LAS float*)lds;
        for (int i = tid; i < 9 * 1024; i += NTHR) { const float v = (i < 8192) ? P.in[I_C][i] : P.in[I_CCTX][i - 8192]; sc[i] = siluf_(v); }
        __syncthreads();
        const int l = bid / 12, col = (bid % 12) * 512 + tid;
        const float* w = P.in[I_WADA] + (size_t)l * 1024 * 6144 + col;
        float a[9];
#pragma unroll
        for (int r = 0; r < 9; ++r) a[r] = 0.f;
        for (int k = 0; k < 1024; ++k) {
            const float wv = w[(size_t)k * 6144];
#pragma unroll
            for (int r = 0; r < 9; ++r) a[r] += sc[r * 1024 + k] * wv;
        }
        const float bb = P.in[I_BADA][l * 6144 + col];
#pragma unroll
        for (int r = 0; r < 9; ++r) mods[((size_t)l * 9 + r) * 6144 + col] = a[r] + bb;
    } else if (bid == 48) {
        float* lbv = (float*)(P.ws + WS_LB);
        for (int i = tid; i < 1024; i += NTHR) {
            float lg[DEPTH], mx = -1e30f;
#pragma unroll
            for (int l = 0; l < DEPTH; ++l) { lg[l] = P.in[I_LBL][l * 1024 + i]; mx = fmaxf(mx, lg[l]); }
            float s = 0.f;
#pragma unroll
            for (int l = 0; l < DEPTH; ++l) { lg[l] = expf(lg[l] - mx); s += lg[l]; }
            float cum = 0.f;
#pragma unroll
            for (int l = 0; l < DEPTH; ++l) { if (l > 0) cum += lg[l] / s; lbv[l * 1024 + i] = cum; }
        }
        float* rope = (float*)(P.ws + WS_ROPE);
        for (int i = tid; i < 96 * 16; i += NTHR) {
            const int pos = i >> 4, fi = i & 15;
            const float inv = powf(10000.0f, -(float)fi / 16.0f);
            const float p = (pos < 32) ? (float)pos : (float)(pos - 32);
            const float ang = p * inv;
            if (pos < 32) { rope[pos * 16 + fi] = cosf(ang); rope[512 + pos * 16 + fi] = sinf(ang); }
            else { rope[1024 + (pos - 32) * 16 + fi] = cosf(ang); rope[2048 + (pos - 32) * 16 + fi] = sinf(ang); }
        }
    }
    float4* xr = (float4*)(P.ws + WS_X);
    const float4* xs = (const float4*)P.in[I_X]; const float4* cs = (const float4*)P.in[I_CTX];
    const size_t nx4 = (size_t)NLAT * D / 4, nc4 = (size_t)NCTX * D / 4;
    for (size_t i = (size_t)bid * NTHR + tid; i < nx4 + nc4; i += (size_t)G * NTHR) xr[i] = (i < nx4) ? xs[i] : cs[i - nx4];
}

__device__ __forceinline__ void conv_tile(LAS float* t, const float* srcA, const float* srcB, int ld, bool inter, bf16_t* dst, int K, int n0, int k0) {
    const int tid = tid_();
    {
        const int nn = tid & 63, kk = tid >> 6, n = n0 + nn;
        const float* cp;
        if (!inter) cp = srcA + n; else { const int g = n >> 5, i = n & 31; cp = (i < 16) ? (srcA + 16 * g + i) : (srcB + 16 * g + i - 16); }
#pragma unroll
        for (int p = 0; p < 8; ++p) { const int k = kk + 8 * p; t[k * 65 + nn] = cp[(size_t)(k0 + k) * ld]; }
    }
    __syncthreads();
    {
        const int n = tid >> 3, k8 = (tid & 7) * 8;
        float v[8];
#pragma unroll
        for (int j = 0; j < 8; ++j) v[j] = t[(k8 + j) * 65 + n];
        uint4 o; o.x = pk_bf16(v[0], v[1]); o.y = pk_bf16(v[2], v[3]); o.z = pk_bf16(v[4], v[5]); o.w = pk_bf16(v[6], v[7]);
        *(uint4*)(dst + (size_t)(n0 + n) * K + k0 + k8) = o;
    }
    __syncthreads();
}
__device__ __forceinline__ void ph_wconv(const Params& P, LAS unsigned char* lds, int l) {
    LAS float* t = (LAS float*)lds;
    const int bid = bid_(), G = gridDim.x;
    constexpr int T_IN = 16 * 124, T_BR = 3 * 8 * 16, T_OUT = 16 * 16, T_GU = 16 * 16 * 16, T_DN = 16 * 8 * 16;
    constexpr int TOT = T_IN + T_BR + T_OUT + T_GU + T_DN;
    for (int u = bid; u < TOT; u += G) {
        int v = u;
        if (v < T_IN) { const int kt = v % 16, nt = v / 16;
            conv_tile(t, P.in[I_WIN] + (size_t)l * 1024 * INC, nullptr, INC, false, (bf16_t*)(P.ws + WS_WIN), 1024, nt * 64, kt * 64); continue; }
        v -= T_IN;
        if (v < T_BR) { const int i = v / 128, w = v % 128, kt = w % 8, nt = w / 8;
            conv_tile(t, P.in[I_WBR] + ((size_t)l * 3 + i) * 512 * 1024, nullptr, 1024, false, (bf16_t*)(P.ws + WS_WBR) + (size_t)i * 1024 * 512, 512, nt * 64, kt * 64); continue; }
        v -= T_BR;
        if (v < T_OUT) { const int kt = v % 16, nt = v / 16;
            conv_tile(t, P.in[I_WOUT] + (size_t)l * 1024 * 1024, nullptr, 1024, false, (bf16_t*)(P.ws + WS_WOUT), 1024, nt * 64, kt * 64); continue; }
        v -= T_OUT;
        if (v < T_GU) { const int e = v / 256, w = v % 256, kt = w % 16, nt = w / 16;
            const size_t eo = ((size_t)l * NEXP + e) * 1024 * 512;
            conv_tile(t, P.in[I_WEG] + eo, P.in[I_WEU] + eo, 512, true, (bf16_t*)(P.ws + WS_WGU) + (size_t)e * 1024 * 1024, 1024, nt * 64, kt * 64); continue; }
        v -= T_GU;
        { const int e = v / 128, w = v % 128, kt = w % 8, nt = w / 8;
            conv_tile(t, P.in[I_WED] + ((size_t)l * NEXP + e) * 512 * 1024, nullptr, 1024, false, (bf16_t*)(P.ws + WS_WDN) + (size_t)e * 1024 * 512, 512, nt * 64, kt * 64); }
    }
}

__device__ __forceinline__ void norm_row(const float4 (&x)[4], const float* g, const float* shift, const float* scale, int lane, float4 (&o)[4]) {
    float ss = 0.f;
#pragma unroll
    for (int i = 0; i < 4; ++i) ss += x[i].x * x[i].x + x[i].y * x[i].y + x[i].z * x[i].z + x[i].w * x[i].w;
    ss = wave_sum(ss);
    const float rstd = 1.0f / sqrtf(ss * (1.0f / 1024.0f) + 1e-6f);
#pragma unroll
    for (int i = 0; i < 4; ++i) {
        const int c = lane * 4 + 256 * i;
        const float4 gv = *(const float4*)(g + c), sh = *(const float4*)(shift + c), sc = *(const float4*)(scale + c);
        o[i].x = x[i].x * rstd * gv.x * (1.0f + sc.x) + sh.x;
        o[i].y = x[i].y * rstd * gv.y * (1.0f + sc.y) + sh.y;
        o[i].z = x[i].z * rstd * gv.z * (1.0f + sc.z) + sh.z;
        o[i].w = x[i].w * rstd * gv.w * (1.0f + sc.w) + sh.w;
    }
}
__device__ __forceinline__ int row_modrow(int r) { return r < NLAT ? (r >> 11) : 8; }

__device__ __forceinline__ void ph_norm1(const Params& P, int l) {
    const int tid = tid_(), lane = tid & 63, wid = tid >> 6;
    const float* xres = (const float*)(P.ws + WS_X);
    bf16_t* h = (bf16_t*)(P.ws + WS_H);
    const float* g = P.in[I_GMIX] + l * 1024;
    for (int r = bid_() * 8 + wid; r < NTOK; r += gridDim.x * 8) {
        const float* mod = (const float*)(P.ws + WS_MODS) + ((size_t)l * 9 + row_modrow(r)) * 6144;
        float4 x[4], o[4];
#pragma unroll
        for (int i = 0; i < 4; ++i) x[i] = *(const float4*)(xres + (size_t)r * D + lane * 4 + 256 * i);
        norm_row(x, g, mod, mod + 1024, lane, o);
#pragma unroll
        for (int i = 0; i < 4; ++i) { uint2 u; u.x = pk_bf16(o[i].x, o[i].y); u.y = pk_bf16(o[i].z, o[i].w); *(uint2*)(h + (size_t)r * D + lane * 4 + 256 * i) = u; }
    }
}

struct EpiStoreBf16 { bf16_t* O; int ldc;
    __device__ __forceinline__ void operator()(int row, int col, const f32x4& v0, const f32x4& v1) const {
        uint2 a, b; a.x = pk_bf16(v0[0], v0[1]); a.y = pk_bf16(v0[2], v0[3]); b.x = pk_bf16(v1[0], v1[1]); b.y = pk_bf16(v1[2], v1[3]);
        *(uint2*)(O + (size_t)row * ldc + col) = a; *(uint2*)(O + (size_t)row * ldc + col + 16) = b; } };
__device__ __forceinline__ void ph_g1(const Params& P, LAS unsigned char* lds) {
    const bf16_t* A = (const bf16_t*)(P.ws + WS_H); const bf16_t* Bt = (const bf16_t*)(P.ws + WS_WIN);
    EpiStoreBf16 E{(bf16_t*)(P.ws + WS_Z), INC};
    constexpr int NM = NTOK / 128, NN = INC / 256;
    for (int u = bid_(); u < NM * NN; u += gridDim.x) {
        const int pm = u % NM, pn = u / NM;
        f32x4 acc[4][4]; acc_zero(acc);
        g128_kloop(acc, lds, A + (size_t)pm * 128 * D, D, Bt + (size_t)pn * 256 * D, D, D);
        g128_epilogue(acc, pm * 128, pn * 256, E);
    }
}

__device__ __forceinline__ void ph_prep(const Params& P, int l) {
    const int tid = tid_(), lane = tid & 63, wid = tid >> 6;
    const bf16_t* z = (const bf16_t*)(P.ws + WS_Z);
    bf16_t* qn = (bf16_t*)(P.ws + WS_QN); bf16_t* kn = (bf16_t*)(P.ws + WS_KN);
    const float* rope = (const float*)(P.ws + WS_ROPE);
    const float gq = P.in[I_QNG][l * 64 + lane], gk = P.in[I_KNG][l * 64 + lane];
    for (int r = bid_() * 8 + wid; r < NTOK; r += gridDim.x * 8) {
        const bool lat = r < NLAT;
        float cs = 1.f, sn = 0.f;
        if (lat) { const int t = r & 2047, fi = lane & 15;
            if (lane < 32) { const int pr = t >> 6; cs = rope[pr * 16 + fi]; sn = rope[512 + pr * 16 + fi]; }
            else { const int pc = t & 63; cs = rope[1024 + pc * 16 + fi]; sn = rope[2048 + pc * 16 + fi]; } }
        const float sgn = (lane & 16) ? 1.f : -1.f;
#pragma unroll
        for (int hh = 0; hh < 10; ++hh) {
            const int col = (hh < 8) ? (C_GQ + hh * 64) : (C_GK + (hh - 8) * 64);
            const float x = bf2f(z[(size_t)r * INC + col + lane]);
            const float ss = wave_sum(x * x);
            const float xn = x * (1.0f / sqrtf(ss * (1.0f / 64.0f) + 1e-6f)) * (hh < 8 ? gq : gk);
            const float pa = __shfl_xor(xn, 16, 64);
            const float o = xn * cs + sgn * pa * sn;
            const bf16_t ob = (bf16_t)(pk_bf16(o, 0.f) & 0xffffu);
            if (hh < 8) qn[(size_t)r * 512 + hh * 64 + lane] = ob; else kn[(size_t)r * 128 + (hh - 8) * 64 + lane] = ob;
        }
    }
}

__device__ __forceinline__ void load_q64(float (&q)[64], const bf16_t* p) {
#pragma unroll
    for (int i = 0; i < 8; ++i) { const uint4 u = ((const uint4*)p)[i];
        q[8 * i + 0] = bf_lo(u.x); q[8 * i + 1] = bf_hi(u.x); q[8 * i + 2] = bf_lo(u.y); q[8 * i + 3] = bf_hi(u.y);
        q[8 * i + 4] = bf_lo(u.z); q[8 * i + 5] = bf_hi(u.z); q[8 * i + 6] = bf_lo(u.w); q[8 * i + 7] = bf_hi(u.w); }
}
__device__ __forceinline__ void attn_key(const float (&q)[64], const bf16_t* kp, const bf16_t* vp, float bias, float& m, float& lsum, float (&o)[64]) {
    float s = 0.f;
#pragma unroll
    for (int i = 0; i < 8; ++i) { const uint4 u = ((const uint4*)kp)[i];
        s += q[8 * i + 0] * bf_lo(u.x) + q[8 * i + 1] * bf_hi(u.x) + q[8 * i + 2] * bf_lo(u.y) + q[8 * i + 3] * bf_hi(u.y)
           + q[8 * i + 4] * bf_lo(u.z) + q[8 * i + 5] * bf_hi(u.z) + q[8 * i + 6] * bf_lo(u.w) + q[8 * i + 7] * bf_hi(u.w); }
    s = s * 0.125f + bias;
    const float mn = fmaxf(m, s), corr = __expf(m - mn), pp = __expf(s - mn);
    lsum = lsum * corr + pp; m = mn;
#pragma unroll
    for (int i = 0; i < 8; ++i) { const uint4 u = ((const uint4*)vp)[i];
        o[8 * i + 0] = o[8 * i + 0] * corr + pp * bf_lo(u.x); o[8 * i + 1] = o[8 * i + 1] * corr + pp * bf_hi(u.x);
        o[8 * i + 2] = o[8 * i + 2] * corr + pp * bf_lo(u.y); o[8 * i + 3] = o[8 * i + 3] * corr + pp * bf_hi(u.y);
        o[8 * i + 4] = o[8 * i + 4] * corr + pp * bf_lo(u.z); o[8 * i + 5] = o[8 * i + 5] * corr + pp * bf_hi(u.z);
        o[8 * i + 6] = o[8 * i + 6] * corr + pp * bf_lo(u.w); o[8 * i + 7] = o[8 * i + 7] * corr + pp * bf_hi(u.w); }
}
__device__ __forceinline__ void store_o64(const float (&o)[64], float inv, bf16_t* p) {
#pragma unroll
    for (int i = 0; i < 8; ++i) { uint4 u;
        u.x = pk_bf16(o[8 * i + 0] * inv, o[8 * i + 1] * inv); u.y = pk_bf16(o[8 * i + 2] * inv, o[8 * i + 3] * inv);
        u.z = pk_bf16(o[8 * i + 4] * inv, o[8 * i + 5] * inv); u.w = pk_bf16(o[8 * i + 6] * inv, o[8 * i + 7] * inv);
        ((uint4*)p)[i] = u; }
}
__device__ __forceinline__ void na_thread(const Params& P, int l, int r, int h) {
    const bf16_t* z = (const bf16_t*)(P.ws + WS_Z);
    bf16_t* br = (bf16_t*)(P.ws + WS_BR);
    float q[64], o[64]; float m = -INFINITY, ls = 0.f;
#pragma unroll
    for (int i = 0; i < 64; ++i) o[i] = 0.f;
    load_q64(q, z + (size_t)r * INC + C_NAQ + h * 64);
    int b;
    if (r < NLAT) {
        b = r >> 11; const int t = r & 2047, qr = t >> 6, qc = t & 63;
        const int r0 = min(max(qr - 4, 0), 24), c0 = min(max(qc - 8, 0), 48);
        const float* rpb = P.in[I_RPB] + ((size_t)l * 8 + h) * 15 * 31;
        for (int kr = r0; kr < r0 + 8; ++kr)
            for (int kc = c0; kc < c0 + 16; ++kc) {
                const size_t krow = (size_t)(b * 2048 + kr * 64 + kc) * INC;
                attn_key(q, z + krow + C_NAK + h * 64, z + krow + C_NAV + h * 64, rpb[(kr - qr + 7) * 31 + (kc - qc + 15)], m, ls, o);
            }
    } else b = (r - NLAT) >> 8;
    for (int j = 0; j < 256; ++j) {
        const size_t krow = (size_t)(NLAT + b * 256 + j) * INC;
        attn_key(q, z + krow + C_NAK + h * 64, z + krow + C_NAV + h * 64, 0.f, m, ls, o);
    }
    store_o64(o, 1.0f / ls, br + (size_t)r * BRW + h * 64);
}
__device__ __forceinline__ void gqa_thread(const Params& P, int r, int hq) {
    const bf16_t* z = (const bf16_t*)(P.ws + WS_Z);
    const bf16_t* qn = (const bf16_t*)(P.ws + WS_QN); const bf16_t* kn = (const bf16_t*)(P.ws + WS_KN);
    bf16_t* br = (bf16_t*)(P.ws + WS_BR);
    float q[64], o[64]; float m = -INFINITY, ls = 0.f;
#pragma unroll
    for (int i = 0; i < 64; ++i) o[i] = 0.f;
    load_q64(q, qn + (size_t)r * 512 + hq * 64);
    const int g = hq >> 2;
    const int b = (r < NLAT) ? (r >> 11) : ((r - NLAT) >> 8);
    for (int j = 0; j < 256; ++j) {
        const size_t kr = (size_t)(NLAT + b * 256 + j);
        attn_key(q, kn + kr * 128 + g * 64, z + kr * INC + C_GV + g * 64, 0.f, m, ls, o);
    }
    if (r < NLAT)
        for (int j = 0; j < 2048; ++j) {
            const size_t kr = (size_t)(b * 2048 + j);
            attn_key(q, kn + kr * 128 + g * 64, z + kr * INC + C_GV + g * 64, 0.f, m, ls, o);
        }
    store_o64(o, 1.0f / ls, br + (size_t)r * BRW + 1024 + hq * 64);
}
__device__ __forceinline__ void hgrn_unit(const Params& P, LAS unsigned char* lds, int l, int u) {
    const int tid = tid_(), v = tid >> 2, kq = tid & 3;
    const int b = u >> 3, h = (u >> 1) & 3, dir = u & 1;
    const bf16_t* z = (const bf16_t*)(P.ws + WS_Z);
    float* O = (float*)(P.ws + (dir ? WS_Y : WS_H));
    const float* lbv = (const float*)(P.ws + WS_LB) + ((size_t)l * 2 + dir) * 512 + h * 128;
    LAS float* fS = (LAS float*)lds; LAS float* qS = fS + 16 * 128; LAS float* vS = qS + 16 * 128;
    const int cf = (dir ? C_HFB : C_HFF) + h * 128, cq = C_HQ + h * 128, cv = C_HI + h * 128;
    float S[32];
#pragma unroll
    for (int j = 0; j < 32; ++j) S[j] = 0.f;
    for (int s0 = 0; s0 < 2304; s0 += 16) {
        __syncthreads();
        for (int e = tid; e < 16 * 128; e += NTHR) {
            const int tt = e >> 7, d = e & 127, s = s0 + tt;
            int row;
            if (s < 256) row = NLAT + b * 256 + (dir ? 255 - s : s); else { const int j = s - 256; row = b * 2048 + (dir ? 2047 - j : j); }
            const bf16_t* zr = z + (size_t)row * INC;
            const float lb = lbv[d];
            fS[e] = lb + (1.0f - lb) * sigmoidf_(bf2f(zr[cf + d]));
            qS[e] = siluf_(bf2f(zr[cq + d]));
            vS[e] = bf2f(zr[cv + d]);
        }
        __syncthreads();
        for (int tt = 0; tt < 16; ++tt) {
            const int s = s0 + tt;
            const float vv = vS[tt * 128 + v];
            float op = 0.f;
#pragma unroll
            for (int j = 0; j < 32; ++j) { const float f = fS[tt * 128 + kq * 32 + j];
                S[j] = f * S[j] + (1.0f - f) * vv; op += S[j] * qS[tt * 128 + kq * 32 + j]; }
            op += __shfl_xor(op, 1, 64); op += __shfl_xor(op, 2, 64);
            if (kq == 0) {
                int row;
                if (s < 256) row = NLAT + b * 256 + (dir ? 255 - s : s); else { const int j = s - 256; row = b * 2048 + (dir ? 2047 - j : j); }
                O[(size_t)row * 512 + h * 128 + v] = op;
            }
        }
    }
}
__device__ __forceinline__ void ph_mix(const Params& P, LAS unsigned char* lds, int l) {
    const int tid = tid_();
    for (int u = bid_(); u < 640; u += gridDim.x) {
        if (u < 64) hgrn_unit(P, lds, l, u);
        else if (u < 320) { const int idx = (u - 64) * NTHR + tid; gqa_thread(P, idx >> 3, idx & 7); }
        else if (u < 576) { const int idx = (u - 320) * NTHR + tid; na_thread(P, l, idx >> 3, idx & 7); }
        else if (u < 608) { const int idx = (u - 576) * NTHR + tid; gqa_thread(P, NLAT + (idx >> 3), idx & 7); }
        else { const int idx = (u - 608) * NTHR + tid; na_thread(P, l, NLAT + (idx >> 3), idx & 7); }
    }
}
__device__ __forceinline__ void ph_readout(const Params& P, int l) {
    const int tid = tid_(), lane = tid & 63, wid = tid >> 6;
    const float* OF = (const float*)(P.ws + WS_H); const float* OB = (const float*)(P.ws + WS_Y);
    const bf16_t* z = (const bf16_t*)(P.ws + WS_Z);
    bf16_t* br = (bf16_t*)(P.ws + WS_BR);
    const float g0 = P.in[I_HGN][l * 128 + lane * 2], g1 = P.in[I_HGN][l * 128 + lane * 2 + 1];
    for (int r = bid_() * 8 + wid; r < NTOK; r += gridDim.x * 8) {
#pragma unroll
        for (int h = 0; h < 4; ++h) {
            const int c = h * 128 + lane * 2;
            const float2 a = *(const float2*)(OF + (size_t)r * 512 + c), bb = *(const float2*)(OB + (size_t)r * 512 + c);
            const float o0 = a.x + bb.x, o1 = a.y + bb.y;
            const float ss = wave_sum(o0 * o0 + o1 * o1);
            const float rstd = 1.0f / sqrtf(ss * (1.0f / 128.0f) + 1e-6f);
            const unsigned gz = *(const unsigned*)(z + (size_t)r * INC + C_HG + c);
            *(unsigned*)(br + (size_t)r * BRW + 512 + c) = pk_bf16(o0 * rstd * g0 * siluf_(bf_lo(gz)), o1 * rstd * g1 * siluf_(bf_hi(gz)));
        }
    }
}
__device__ __forceinline__ void ph_merge(const Params& P, LAS unsigned char* lds) {
    const bf16_t* br = (const bf16_t*)(P.ws + WS_BR); const bf16_t* wb = (const bf16_t*)(P.ws + WS_WBR);
    const bf16_t* z = (const bf16_t*)(P.ws + WS_Z);
    EpiStoreBf16 E{(bf16_t*)(P.ws + WS_Y), D};
    const int tid = tid_(), wid = tid >> 6, lane = tid & 63, wr = wid >> 2, wc = wid & 3, fr = lane & 15, fq = lane >> 4;
    constexpr int NM = NTOK / 128, NN = D / 256;
    for (int u = bid_(); u < NM * NN; u += gridDim.x) {
        const int pm = u % NM, pn = u / NM;
        f32x4 tot[4][4]; acc_zero(tot);
#pragma unroll 1
        for (int i = 0; i < 3; ++i) {
            f32x4 acc[4][4]; acc_zero(acc);
            g128_kloop(acc, lds, br + (size_t)pm * 128 * BRW + i * 512, BRW, wb + ((size_t)i * 1024 + pn * 256) * 512, 512, 512);
#pragma unroll
            for (int m = 0; m < 4; ++m)
#pragma unroll
                for (int n = 0; n < 4; ++n) {
                    const int row = pm * 128 + wr * 64 + m * 16 + fr, col = pn * 256 + wc * 64 + n * 16 + fq * 4;
                    const uint2 gz = *(const uint2*)(z + (size_t)row * INC + C_GATE + i * 1024 + col);
                    tot[m][n][0] += sigmoidf_(bf_lo(gz.x)) * acc[m][n][0]; tot[m][n][1] += sigmoidf_(bf_hi(gz.x)) * acc[m][n][1];
                    tot[m][n][2] += sigmoidf_(bf_lo(gz.y)) * acc[m][n][2]; tot[m][n][3] += sigmoidf_(bf_hi(gz.y)) * acc[m][n][3];
                }
        }
        g128_epilogue(tot, pm * 128, pn * 256, E);
    }
}
struct EpiResid { float* X; const float* mods; int l;
    __device__ __forceinline__ void operator()(int row, int col, const f32x4& v0, const f32x4& v1) const {
        const float* gate = mods + ((size_t)l * 9 + row_modrow(row)) * 6144 + 2 * 1024;
        float4* p0 = (float4*)(X + (size_t)row * D + col); float4* p1 = (float4*)(X + (size_t)row * D + col + 16);
        const float4 g0 = *(const float4*)(gate + col), g1 = *(const float4*)(gate + col + 16);
        float4 a = *p0, b = *p1;
        a.x += g0.x * v0[0]; a.y += g0.y * v0[1]; a.z += g0.z * v0[2]; a.w += g0.w * v0[3];
        b.x += g1.x * v1[0]; b.y += g1.y * v1[1]; b.z += g1.z * v1[2]; b.w += g1.w * v1[3];
        *p0 = a; *p1 = b; } };
__device__ __forceinline__ void ph_wout(const Params& P, LAS unsigned char* lds, int l) {
    const bf16_t* A = (const bf16_t*)(P.ws + WS_Y); const bf16_t* Bt = (const bf16_t*)(P.ws + WS_WOUT);
    EpiResid E{(float*)(P.ws + WS_X), (const float*)(P.ws + WS_MODS), l};
    constexpr int NM = NTOK / 128, NN = D / 256;
    for (int u = bid_(); u < NM * NN; u += gridDim.x) {
        const int pm = u % NM, pn = u / NM;
        f32x4 acc[4][4]; acc_zero(acc);
        g128_kloop(acc, lds, A + (size_t)pm * 128 * D, D, Bt + (size_t)pn * 256 * D, D, D);
        g128_epilogue(acc, pm * 128, pn * 256, E);
    }
}
__device__ __forceinline__ void ph_norm2_route(const Params& P, LAS unsigned char* lds, int l) {
    const int tid = tid_(), lane = tid & 63, wid = tid >> 6;
    LAS float* Wt = (LAS float*)lds;
    for (int i = tid; i < 20 * 1024; i += NTHR) { const int j = i >> 10, c = i & 1023;
        Wt[i] = (j < 4) ? P.in[I_WGR][((size_t)l * 1024 + c) * 4 + j] : P.in[I_WER][((size_t)l * 1024 + c) * 16 + (j - 4)]; }
    __syncthreads();
    const float* xres = (const float*)(P.ws + WS_X);
    bf16_t* f = (bf16_t*)(P.ws + WS_H);
    const float* g = P.in[I_GFFN] + l * 1024;
    int* cnt = (int*)(P.ws + WS_CNT) + l * 16;
    int* sel_e = (int*)(P.ws + WS_SELE); float* sel_w = (float*)(P.ws + WS_SELW); int* sel_p = (int*)(P.ws + WS_SELP);
    for (int r = bid_() * 8 + wid; r < NTOK; r += gridDim.x * 8) {
        const float* mod = (const float*)(P.ws + WS_MODS) + ((size_t)l * 9 + row_modrow(r)) * 6144;
        float4 x[4], o[4];
#pragma unroll
        for (int i = 0; i < 4; ++i) x[i] = *(const float4*)(xres + (size_t)r * D + lane * 4 + 256 * i);
        norm_row(x, g, mod + 3 * 1024, mod + 4 * 1024, lane, o);
#pragma unroll
        for (int i = 0; i < 4; ++i) { uint2 u; u.x = pk_bf16(o[i].x, o[i].y); u.y = pk_bf16(o[i].z, o[i].w); *(uint2*)(f + (size_t)r * D + lane * 4 + 256 * i) = u; }
        float lg[20];
#pragma unroll
        for (int j = 0; j < 20; ++j) {
            float s = 0.f;
#pragma unroll
            for (int i = 0; i < 4; ++i) { const f32x4 w = *(const LAS f32x4*)(Wt + j * 1024 + lane * 4 + 256 * i); s += o[i].x * w[0] + o[i].y * w[1] + o[i].z * w[2] + o[i].w * w[3]; }
            lg[j] = wave_sum(s);
        }
        if (lane == 0) {
            float gl[4]; int gi = 0;
#pragma unroll
            for (int j = 0; j < 4; ++j) gl[j] = lg[j] + P.in[I_BGR][l * 4 + j];
            float gm = gl[0];
#pragma unroll
            for (int j = 1; j < 4; ++j) if (gl[j] > gm) { gm = gl[j]; gi = j; }
            float se = 0.f;
#pragma unroll
            for (int j = 0; j < 4; ++j) se += expf(gl[j] - gm);
            const float pg = 1.0f / se;
            float el[4];
#pragma unroll
            for (int j = 0; j < 4; ++j) {
                float v = 0.f;
#pragma unroll
                for (int q = 0; q < 4; ++q) v = (gi == q) ? lg[4 + q * 4 + j] : v;
                el[j] = v + P.in[I_BER][l * 16 + gi * 4 + j];
            }
            int i0 = 0; float v0 = el[0];
#pragma unroll
            for (int j = 1; j < 4; ++j) if (el[j] > v0) { v0 = el[j]; i0 = j; }
            int i1 = -1; float v1 = -INFINITY;
#pragma unroll
            for (int j = 0; j < 4; ++j) if (j != i0 && el[j] > v1) { v1 = el[j]; i1 = j; }
            const float w0 = 1.0f / (1.0f + expf(v1 - v0)), w1 = 1.0f - w0;
            const int e0 = gi * 4 + i0, e1 = gi * 4 + i1;
            sel_e[r * 2] = e0; sel_e[r * 2 + 1] = e1;
            sel_w[r * 2] = w0 * pg; sel_w[r * 2 + 1] = w1 * pg;
            sel_p[r * 2] = atomicAdd(&cnt[e0], 1); sel_p[r * 2 + 1] = atomicAdd(&cnt[e1], 1);
        }
    }
}
__device__ __forceinline__ void moe_offsets(const int* cnt, int (&off)[17]) {
    int a = 0;
#pragma unroll
    for (int e = 0; e < 16; ++e) { off[e] = a; a += (cnt[e] + 255) & ~255; }
    off[16] = a;
}
__device__ __forceinline__ void ph_scatter(const Params& P, int l) {
    const int tid = tid_(), lane = tid & 63, wid = tid >> 6;
    const int* cnt = (const int*)(P.ws + WS_CNT) + l * 16;
    int off[17]; moe_offsets(cnt, off);
    const bf16_t* f = (const bf16_t*)(P.ws + WS_H); bf16_t* Fs = (bf16_t*)(P.ws + WS_FS);
    const int* sel_e = (const int*)(P.ws + WS_SELE); const int* sel_p = (const int*)(P.ws + WS_SELP); int* srow = (int*)(P.ws + WS_SROW);
    for (int r = bid_() * 8 + wid; r < NTOK; r += gridDim.x * 8) {
        const uint4 a = *(const uint4*)(f + (size_t)r * D + lane * 8), b = *(const uint4*)(f + (size_t)r * D + 512 + lane * 8);
#pragma unroll
        for (int k = 0; k < 2; ++k) {
            const int e = sel_e[r * 2 + k];
            int o = 0;
#pragma unroll
            for (int q = 0; q < 16; ++q) o = (e == q) ? off[q] : o;
            const int d = o + sel_p[r * 2 + k];
            *(uint4*)(Fs + (size_t)d * D + lane * 8) = a; *(uint4*)(Fs + (size_t)d * D + 512 + lane * 8) = b;
            if (lane == 0) srow[r * 2 + k] = d;
        }
    }
}
struct EpiSwiglu { bf16_t* H;
    __device__ __forceinline__ void operator()(int row, int col, const f32x4& v0, const f32x4& v1) const {
        const int hc = ((col & ~31) >> 1) + (col & 15);
        uint2 a; a.x = pk_bf16(siluf_(v0[0]) * v1[0], siluf_(v0[1]) * v1[1]); a.y = pk_bf16(siluf_(v0[2]) * v1[2], siluf_(v0[3]) * v1[3]);
        *(uint2*)(H + (size_t)row * EH + hc) = a; } };
__device__ __forceinline__ void ph_moe1(const Params& P, LAS unsigned char* lds, int l) {
    const int* cnt = (const int*)(P.ws + WS_CNT) + l * 16;
    int off[17]; moe_offsets(cnt, off);
    const bf16_t* Fs = (const bf16_t*)(P.ws + WS_FS); const bf16_t* W = (const bf16_t*)(P.ws + WS_WGU);
    EpiSwiglu E{(bf16_t*)(P.ws + WS_HS)};
    const int NM = off[16] / 128;
    for (int u = bid_(); u < NM * 4; u += gridDim.x) {
        const int pm = u % NM, pn = u / NM, row0 = pm * 128;
        int e = 0;
#pragma unroll
        for (int q = 1; q < 16; ++q) e += (row0 >= off[q]) ? 1 : 0;
        f32x4 acc[4][4]; acc_zero(acc);
        g128_kloop(acc, lds, Fs + (size_t)row0 * D, D, W + ((size_t)e * 1024 + pn * 256) * 1024, 1024, 1024);
        g128_epilogue(acc, row0, pn * 256, E);
    }
}
__device__ __forceinline__ void ph_moe2(const Params& P, LAS unsigned char* lds, int l) {
    const int* cnt = (const int*)(P.ws + WS_CNT) + l * 16;
    int off[17]; moe_offsets(cnt, off);
    const bf16_t* Hs = (const bf16_t*)(P.ws + WS_HS); const bf16_t* W = (const bf16_t*)(P.ws + WS_WDN);
    EpiStoreBf16 E{(bf16_t*)(P.ws + WS_YS), D};
    const int NM = off[16] / 128;
    for (int u = bid_(); u < NM * 4; u += gridDim.x) {
        const int pm = u % NM, pn = u / NM, row0 = pm * 128;
        int e = 0;
#pragma unroll
        for (int q = 1; q < 16; ++q) e += (row0 >= off[q]) ? 1 : 0;
        f32x4 acc[4][4]; acc_zero(acc);
        g128_kloop(acc, lds, Hs + (size_t)row0 * EH, EH, W + ((size_t)e * 1024 + pn * 256) * 512, 512, 512);
        g128_epilogue(acc, row0, pn * 256, E);
    }
}
__device__ __forceinline__ void ph_combine(const Params& P, int l) {
    const int tid = tid_(), lane = tid & 63, wid = tid >> 6;
    float* xres = (float*)(P.ws + WS_X);
    const bf16_t* Ys = (const bf16_t*)(P.ws + WS_YS);
    const float* sel_w = (const float*)(P.ws + WS_SELW); const int* srow = (const int*)(P.ws + WS_SROW);
    for (int r = bid_() * 8 + wid; r < NTOK; r += gridDim.x * 8) {
        const float* gate = (const float*)(P.ws + WS_MODS) + ((size_t)l * 9 + row_modrow(r)) * 6144 + 5 * 1024;
        const float w0 = sel_w[r * 2], w1 = sel_w[r * 2 + 1];
        const bf16_t* y0 = Ys + (size_t)srow[r * 2] * D; const bf16_t* y1 = Ys + (size_t)srow[r * 2 + 1] * D;
        float4 x[4];
        float ss = 0.f;
#pragma unroll
        for (int i = 0; i < 4; ++i) {
            const int c = lane * 4 + 256 * i;
            x[i] = *(const float4*)(xres + (size_t)r * D + c);
            const uint2 a = *(const uint2*)(y0 + c), b = *(const uint2*)(y1 + c);
            const float4 gv = *(const float4*)(gate + c);
            x[i].x += gv.x * (w0 * bf_lo(a.x) + w1 * bf_lo(b.x)); x[i].y += gv.y * (w0 * bf_hi(a.x) + w1 * bf_hi(b.x));
            x[i].z += gv.z * (w0 * bf_lo(a.y) + w1 * bf_lo(b.y)); x[i].w += gv.w * (w0 * bf_hi(a.y) + w1 * bf_hi(b.y));
            *(float4*)(xres + (size_t)r * D + c) = x[i];
            ss += x[i].x * x[i].x + x[i].y * x[i].y + x[i].z * x[i].z + x[i].w * x[i].w;
        }
        if (l == DEPTH - 1 && r < NLAT) {
            ss = wave_sum(ss);
            const float rstd = 1.0f / sqrtf(ss * (1.0f / 1024.0f) + 1e-6f);
#pragma unroll
            for (int i = 0; i < 4; ++i) {
                const int c = lane * 4 + 256 * i;
                const float4 gv = *(const float4*)(P.in[I_GFIN] + c);
                float4 o; o.x = x[i].x * rstd * gv.x; o.y = x[i].y * rstd * gv.y; o.z = x[i].z * rstd * gv.z; o.w = x[i].w * rstd * gv.w;
                *(float4*)(P.out + (size_t)r * D + c) = o;
            }
        }
    }
}

constexpr int NPH_LAYER = 12, NPH = 1 + DEPTH * NPH_LAYER;
#define CAS __attribute__((address_space(4)))
__device__ __forceinline__ const Params& kparams() { const CAS Params* k = (const CAS Params*)__builtin_amdgcn_kernarg_segment_ptr(); asm volatile("" : "+s"(k)); return *(const Params*)k; }
__global__ void __launch_bounds__(NTHR, 2) fwd(Params P_) {
    extern __shared__ __attribute__((aligned(16))) unsigned char lds_raw[];
    LAS unsigned char* lds = (LAS unsigned char*)lds_raw;
    volatile LAS unsigned* xbw = (volatile LAS unsigned*)(lds + LDS_BYTES - 16);
    if (threadIdx.x == 0) { xbw[0] = 0u; xbw[1] = 0u; xbw[2] = 0u; xbw[3] = 0u; }
    __syncthreads();
    const int lo = P_.ph_lo, hi = P_.ph_hi;
    XcdBarrier bar; bar.bar = (unsigned*)(P_.ws + WS_BAR); bar.x = 0; bar.st = xbw;
    if (hi - lo > 1) bar = xcd_barrier_post((unsigned*)(P_.ws + WS_BAR), xbw);
#ifndef PHMASK
#define PHMASK 0xFFFF
#endif
#define EN(j) ((PHMASK >> (j)) & 1)
#define IN(k) (lo <= (k) && (k) < hi)
#define SEAM(k) do { if (IN(k) && IN((k) + 1)) xcd_barrier(bar); } while (0)
    if (EN(12) && IN(0)) { ph_prologue(kparams(), lds); }
    SEAM(0);
    for (int l = 0; l < DEPTH; ++l) {
        const int p0 = 1 + l * NPH_LAYER;
        if (EN(0) && IN(p0 + 0)) { ph_wconv(kparams(), lds, l); ph_norm1(kparams(), l); }
        SEAM(p0 + 0);
        if (EN(1) && IN(p0 + 1)) ph_g1(kparams(), lds);
        SEAM(p0 + 1);
        if (EN(2) && IN(p0 + 2)) ph_prep(kparams(), l);
        SEAM(p0 + 2);
        if (EN(3) && IN(p0 + 3)) ph_mix(kparams(), lds, l);
        SEAM(p0 + 3);
        if (EN(4) && IN(p0 + 4)) ph_readout(kparams(), l);
        SEAM(p0 + 4);
        if (EN(5) && IN(p0 + 5)) ph_merge(kparams(), lds);
        SEAM(p0 + 5);
        if (EN(6) && IN(p0 + 6)) ph_wout(kparams(), lds, l);
        SEAM(p0 + 6);
        if (EN(7) && IN(p0 + 7)) ph_norm2_route(kparams(), lds, l);
        SEAM(p0 + 7);
        if (EN(8) && IN(p0 + 8)) ph_scatter(kparams(), l);
        SEAM(p0 + 8);
        if (EN(9) && IN(p0 + 9)) ph_moe1(kparams(), lds, l);
        SEAM(p0 + 9);
        if (EN(10) && IN(p0 + 10)) ph_moe2(kparams(), lds, l);
        SEAM(p0 + 10);
        if (EN(11) && IN(p0 + 11)) ph_combine(kparams(), l);
        SEAM(p0 + 11);
    }
#undef IN
#undef SEAM
}

#ifndef MK_PER_PHASE
#define MK_PER_PHASE 1
#endif
extern "C" void kernel_launch(void* const* d_in, const int* in_sizes, int n_in, void* d_out, int out_size, void* d_ws, size_t ws_size, hipStream_t stream) {
    static int grid = 0;
    if (grid == 0) {
        if (n_in != 24 || out_size != NLAT * D || ws_size < WS_END) { fprintf(stderr, "kernel_launch: unexpected shapes (n_in %d out %d ws %zu need %zu)\n", n_in, out_size, ws_size, (size_t)WS_END); grid = -1; return; }
        int dev = 0, cus = 0, per_cu = 0;
        if (hipGetDevice(&dev) != hipSuccess || hipDeviceGetAttribute(&cus, hipDeviceAttributeMultiprocessorCount, dev) != hipSuccess) { grid = -1; return; }
        if (hipFuncSetAttribute((const void*)fwd, hipFuncAttributeMaxDynamicSharedMemorySize, LDS_BYTES) != hipSuccess) { fprintf(stderr, "kernel_launch: hipFuncSetAttribute failed\n"); grid = -1; return; }
        if (hipOccupancyMaxActiveBlocksPerMultiprocessor(&per_cu, (const void*)fwd, NTHR, LDS_BYTES) != hipSuccess || per_cu < 1) { fprintf(stderr, "kernel_launch: occupancy query says %d\n", per_cu); }
        (void)hipGetLastError();
        grid = cus;
    }
    if (grid < 0) return;
    (void)hipMemsetAsync(d_ws, 0, WS_ZERO_BYTES, stream);
    Params p{};
    for (int i = 0; i < 24; ++i) p.in[i] = (const float*)d_in[i];
    p.out = (float*)d_out; p.ws = (unsigned char*)d_ws;
#if MK_PER_PHASE
    for (int ph = 0; ph < NPH; ++ph) { p.ph_lo = ph; p.ph_hi = ph + 1; hipLaunchKernelGGL(fwd, dim3(grid), dim3(NTHR), LDS_BYTES, stream, p); }
#else
    p.ph_lo = 0; p.ph_hi = NPH; hipLaunchKernelGGL(fwd, dim3(grid), dim3(NTHR), LDS_BYTES, stream, p);
#endif
}
```

```cpp
#include <hip/hip_runtime.h>
#include <cstdio>
#include <cstdint>

#define LAS __attribute__((address_space(3)))
typedef unsigned short bf16_t;
typedef short bf16x8 __attribute__((ext_vector_type(8)));
typedef float f32x4 __attribute__((ext_vector_type(4)));
typedef unsigned u32x4 __attribute__((ext_vector_type(4)));

constexpr int D = 1024, NB = 8, SEQ = 2048, DEPTH = 4, CTXL = 256;
constexpr int NLAT = NB * SEQ, NCTX = NB * CTXL, NTOK = NLAT + NCTX;
constexpr int INC = 7936;
constexpr int C_NAQ = 0, C_NAK = 512, C_NAV = 1024, C_HQ = 1536, C_HFF = 2048, C_HFB = 2560, C_HI = 3072, C_HG = 3584,
              C_GQ = 4096, C_GK = 4608, C_GV = 4736, C_GATE = 4864;
constexpr int BRW = 1536;
constexpr int NEXP = 16, EH = 512;
constexpr int MPAD = 40960;
constexpr int NTHR = 512;
constexpr int LDS_BYTES = 147456;

constexpr size_t WS_BAR = 0;
constexpr size_t WS_CNT = 16384;
constexpr size_t WS_ZERO_BYTES = 65536;
constexpr size_t WS_MODS = 65536;
constexpr size_t WS_LB = WS_MODS + 884736;
constexpr size_t WS_ROPE = WS_LB + 16384;
constexpr size_t WS_SELE = WS_ROPE + 12288;
constexpr size_t WS_SELW = WS_SELE + 147456;
constexpr size_t WS_SELP = WS_SELW + 147456;
constexpr size_t WS_SROW = WS_SELP + 147456;
constexpr size_t WS_X = 2097152;
constexpr size_t WS_H = WS_X + (size_t)NTOK * D * 4;
constexpr size_t WS_Z = WS_H + (size_t)NTOK * D * 2;
constexpr size_t WS_BR = WS_Z + (size_t)NTOK * INC * 2;
constexpr size_t WS_Y = WS_BR + (size_t)NTOK * BRW * 2;
constexpr size_t WS_QN = WS_Y + (size_t)NTOK * D * 2;
constexpr size_t WS_KN = WS_QN + (size_t)NTOK * 512 * 2;
constexpr size_t WS_WIN = WS_KN + (size_t)NTOK * 128 * 2;
constexpr size_t WS_WBR = WS_WIN + (size_t)INC * D * 2;
constexpr size_t WS_WOUT = WS_WBR + (size_t)3 * D * 512 * 2;
constexpr size_t WS_WGU = WS_WOUT + (size_t)D * D * 2;
constexpr size_t WS_WDN = WS_WGU + (size_t)NEXP * 1024 * 1024 * 2;
constexpr size_t WS_END = WS_WDN + (size_t)NEXP * 1024 * 512 * 2;
constexpr size_t WS_FS = WS_Z;
constexpr size_t WS_HS = WS_FS + (size_t)MPAD * 1024 * 2;
constexpr size_t WS_YS = WS_HS + (size_t)MPAD * 512 * 2;
static_assert(WS_YS + (size_t)MPAD * 1024 * 2 <= WS_BR, "moe alias");
static_assert(WS_SROW + 147456 <= WS_X, "ctl");

#define XB_TMO      128
#define XB_XCNT(j)  (256  + 64 * (j))
#define XB_XSUB(j)  (1280 + 64 * (j))
#define XB_XGEN(j)  (2304 + 64 * (j))
#define XB_TOP      3328
#define XB_TOPGEN   3392
#define XCD_BAR_WORDS 3456
#define XB_SPIN_CAP (1u << 22)
__device__ __forceinline__ unsigned xb_ld(unsigned* p)              { return __hip_atomic_load(p, __ATOMIC_RELAXED, __HIP_MEMORY_SCOPE_AGENT); }
__device__ __forceinline__ unsigned xb_add(unsigned* p, unsigned v) { return __hip_atomic_fetch_add(p, v, __ATOMIC_RELAXED, __HIP_MEMORY_SCOPE_AGENT); }
__device__ __forceinline__ unsigned xb_xcc_id() { return (unsigned)__builtin_amdgcn_s_getreg((3 << 11) | 20) & 0xFu; }
#define XB_SPIN(cond, bar) do { unsigned _sp = 0; while (cond) { __builtin_amdgcn_s_sleep(1); \
    if ((++_sp & 255u) == 0u) { if (xb_ld(&(bar)[XB_TMO])) break; if (_sp > XB_SPIN_CAP) { atomicAdd(&(bar)[XB_TMO], 1u); break; } } } } while (0)
struct XcdBarrier { unsigned* bar; unsigned x; volatile LAS unsigned* st; };
__device__ __forceinline__ XcdBarrier xcd_barrier_post(unsigned* bar, volatile LAS unsigned* st) {
    XcdBarrier b; b.bar = bar; b.x = xb_xcc_id(); b.st = st;
    if (threadIdx.x == 0) (void)xb_add(&bar[XB_XCNT(b.x)], 1u);
    return b;
}
__device__ __forceinline__ void xcd_barrier_complete(unsigned* bar, unsigned x, unsigned& nloc, unsigned& nx) {
    const unsigned G = gridDim.x * gridDim.y * gridDim.z;
    unsigned sum, cnt, mine, sp = 0u;
    for (;;) {
        sum = 0u; cnt = 0u; mine = 0u;
#pragma unroll
        for (unsigned j = 0; j < 16; ++j) { const unsigned c = xb_ld(&bar[XB_XCNT(j)]); sum += c; cnt += (c > 0u) ? 1u : 0u; mine = (j == x) ? c : mine; }
        if (sum == G) break;
        __builtin_amdgcn_s_sleep(1);
        if ((++sp & 255u) == 0u) { if (xb_ld(&bar[XB_TMO])) break; if (sp > XB_SPIN_CAP) { atomicAdd(&bar[XB_TMO], 1u); break; } }
    }
    nloc = mine > 0u ? mine : 1u; nx = cnt > 0u ? cnt : 1u;
}
__device__ __forceinline__ void xcd_barrier(const XcdBarrier& b) {
    asm volatile("s_waitcnt vmcnt(0)" ::: "memory");
    __syncthreads();
    if (threadIdx.x == 0) {
        unsigned* bar = b.bar;
        __builtin_amdgcn_s_waitcnt(0);
        unsigned nloc = b.st[0], nx = b.st[1];
        if (nloc == 0u) { xcd_barrier_complete(bar, b.x, nloc, nx); b.st[0] = nloc; b.st[1] = nx; }
        const unsigned old = xb_add(&bar[XB_XSUB(b.x)], 1u);
        const unsigned gen = old / nloc;
        if (old + 1u == (gen + 1u) * nloc) {
            __builtin_amdgcn_fence(__ATOMIC_RELEASE, "agent");
            asm volatile("s_waitcnt vmcnt(0)" ::: "memory");
            const unsigned og = xb_add(&bar[XB_TOP], 1u);
            const unsigned tg = og / nx;
            if (og + 1u == (tg + 1u) * nx) xb_add(&bar[XB_TOPGEN], 1u);
            else XB_SPIN(xb_ld(&bar[XB_TOPGEN]) == tg, bar);
            __builtin_amdgcn_fence(__ATOMIC_ACQUIRE, "agent");
            xb_add(&bar[XB_XGEN(b.x)], 1u);
            asm volatile("s_waitcnt vmcnt(0)" ::: "memory");
        } else {
            XB_SPIN(xb_ld(&bar[XB_XGEN(b.x)]) == gen, bar);
            __builtin_amdgcn_fence(__ATOMIC_ACQUIRE, "agent");
            asm volatile("s_waitcnt vmcnt(0)" ::: "memory");
        }
    }
    __syncthreads();
}

__device__ __forceinline__ float bf_lo(unsigned u) { return __uint_as_float(u << 16); }
__device__ __forceinline__ float bf_hi(unsigned u) { return __uint_as_float(u & 0xffff0000u); }
__device__ __forceinline__ float bf2f(bf16_t b) { return __uint_as_float(((unsigned)b) << 16); }
__device__ __forceinline__ unsigned pk_bf16(float lo, float hi) { unsigned r; asm volatile("v_cvt_pk_bf16_f32 %0, %1, %2" : "=v"(r) : "v"(lo), "v"(hi)); return r; }
__device__ __forceinline__ float sigmoidf_(float x) { return 1.0f / (1.0f + __expf(-x)); }
__device__ __forceinline__ float siluf_(float x) { return x / (1.0f + __expf(-x)); }
__device__ __forceinline__ float wave_sum(float v) {
#pragma unroll
    for (int o = 32; o > 0; o >>= 1) v += __shfl_xor(v, o, 64);
    return v;
}

__device__ __forceinline__ int tid_() { int t = threadIdx.x; asm volatile("" : "+v"(t)); return t; }
__device__ __forceinline__ int bid_() { int t = blockIdx.x; asm volatile("" : "+s"(t)); return t; }
struct Params {
    const float* in[24];
    float* out;
    unsigned char* ws;
    int ph_lo, ph_hi;
};
enum { I_X = 0, I_C, I_CTX, I_CCTX, I_WADA, I_BADA, I_GMIX, I_GFFN, I_WIN, I_RPB, I_LBL, I_HGN, I_QNG, I_KNG, I_WBR, I_WOUT,
       I_WGR, I_BGR, I_WER, I_BER, I_WEG, I_WEU, I_WED, I_GFIN };

__device__ __forceinline__ void g128_kloop(f32x4 (&acc)[4][4], LAS unsigned char* lds, const bf16_t* A, int lda, const bf16_t* Bt, int ldb, int K) {
    const int tid = tid_(), wid = tid >> 6, lane = tid & 63, wr = wid >> 2, wc = wid & 3, fr = lane & 15, fq = lane >> 4;
    LAS unsigned char* SA = lds; LAS unsigned char* SB = lds + 8192;
    const int srow = tid >> 2, skc = (tid & 3) * 8;
    const bf16_t* ap = A + (size_t)srow * lda + skc;
    const bf16_t* bp0 = Bt + (size_t)srow * ldb + skc;
    const bf16_t* bp1 = Bt + (size_t)(srow + 128) * ldb + skc;
    for (int k0 = 0; k0 < K; k0 += 32) {
        const uint4 va = *(const uint4*)(ap + k0);
        const uint4 vb0 = *(const uint4*)(bp0 + k0);
        const uint4 vb1 = *(const uint4*)(bp1 + k0);
        __syncthreads();
        *(LAS u32x4*)(SA + tid * 16) = (u32x4){va.x, va.y, va.z, va.w};
        *(LAS u32x4*)(SB + tid * 16) = (u32x4){vb0.x, vb0.y, vb0.z, vb0.w};
        *(LAS u32x4*)(SB + 8192 + tid * 16) = (u32x4){vb1.x, vb1.y, vb1.z, vb1.w};
        __syncthreads();
        bf16x8 At[4], Bf[4];
#pragma unroll
        for (int m = 0; m < 4; ++m) At[m] = *(const LAS bf16x8*)(SA + ((wr * 64 + m * 16 + fr) * 32 + fq * 8) * 2);
#pragma unroll
        for (int n = 0; n < 4; ++n) Bf[n] = *(const LAS bf16x8*)(SB + ((wc * 64 + n * 16 + fr) * 32 + fq * 8) * 2);
#pragma unroll
        for (int m = 0; m < 4; ++m)
#pragma unroll
            for (int n = 0; n < 4; ++n) acc[m][n] = __builtin_amdgcn_mfma_f32_16x16x32_bf16(Bf[n], At[m], acc[m][n], 0, 0, 0);
    }
}
__device__ __forceinline__ void acc_zero(f32x4 (&acc)[4][4]) {
#pragma unroll
    for (int m = 0; m < 4; ++m)
#pragma unroll
        for (int n = 0; n < 4; ++n) acc[m][n] = (f32x4){0.f, 0.f, 0.f, 0.f};
}
template <class Epi>
__device__ __forceinline__ void g128_epilogue(const f32x4 (&acc)[4][4], int row0, int col0, const Epi& E) {
    const int tid = tid_(), wid = tid >> 6, lane = tid & 63, wr = wid >> 2, wc = wid & 3, fr = lane & 15, fq = lane >> 4;
#pragma unroll
    for (int m = 0; m < 4; ++m)
#pragma unroll
        for (int n = 0; n < 4; n += 2) E(row0 + wr * 64 + m * 16 + fr, col0 + wc * 64 + n * 16 + fq * 4, acc[m][n], acc[m][n + 1]);
}

__device__ __forceinline__ void ph_prologue(const Params& P, LAS unsigned char* lds) {
    const int tid = tid_(), bid = bid_(), G = gridDim.x;
    float* mods = (float*)(P.ws + WS_MODS);
    if (bid < 48) {
        LAS float* sc = (LAS float*)lds;
        for (int i = tid; i < 9 * 1024; i += NTHR) { const float v = (i < 8192) ? P.in[I_C][i] : P.in[I_CCTX][i - 8192]; sc[i] = siluf_(v); }
        __syncthreads();
        const int l = bid / 12, col = (bid % 12) * 512 + tid;
        const float* w = P.in[I_WADA] + (size_t)l * 1024 * 6144 + col;
        float a[9];
#pragma unroll
        for (int r = 0; r < 9; ++r) a[r] = 0.f;
        for (int k = 0; k < 1024; ++k) {
            const float wv = w[(size_t)k * 6144];
#pragma unroll
            for (int r = 0; r < 9; ++r) a[r] += sc[r * 1024 + k] * wv;
        }
        const float bb = P.in[I_BADA][l * 6144 + col];
#pragma unroll
        for (int r = 0; r < 9; ++r) mods[((size_t)l * 9 + r) * 6144 + col] = a[r] + bb;
    } else if (bid == 48) {
        float* lbv = (float*)(P.ws + WS_LB);
        for (int i = tid; i < 1024; i += NTHR) {
            float lg[DEPTH], mx = -1e30f;
#pragma unroll
            for (int l = 0; l < DEPTH; ++l) { lg[l] = P.in[I_LBL][l * 1024 + i]; mx = fmaxf(mx, lg[l]); }
            float s = 0.f;
#pragma unroll
            for (int l = 0; l < DEPTH; ++l) { lg[l] = expf(lg[l] - mx); s += lg[l]; }
            float cum = 0.f;
#pragma unroll
            for (int l = 0; l < DEPTH; ++l) { if (l > 0) cum += lg[l] / s; lbv[l * 1024 + i] = cum; }
        }
        float* rope = (float*)(P.ws + WS_ROPE);
        for (int i = tid; i < 96 * 16; i += NTHR) {
            const int pos = i >> 4, fi = i & 15;
            const float inv = powf(10000.0f, -(float)fi / 16.0f);
            const float p = (pos < 32) ? (float)pos : (float)(pos - 32);
            const float ang = p * inv;
            if (pos < 32) { rope[pos * 16 + fi] = cosf(ang); rope[512 + pos * 16 + fi] = sinf(ang); }
            else { rope[1024 + (pos - 32) * 16 + fi] = cosf(ang); rope[2048 + (pos - 32) * 16 + fi] = sinf(ang); }
        }
    }
    float4* xr = (float4*)(P.ws + WS_X);
    const float4* xs = (const float4*)P.in[I_X]; const float4* cs = (const float4*)P.in[I_CTX];
    const size_t nx4 = (size_t)NLAT * D / 4, nc4 = (size_t)NCTX * D / 4;
    for (size_t i = (size_t)bid * NTHR + tid; i < nx4 + nc4; i += (size_t)G * NTHR) xr[i] = (i < nx4) ? xs[i] : cs[i - nx4];
}

__device__ __forceinline__ void conv_tile(LAS float* t, const float* srcA, const float* srcB, int ld, bool inter, bf16_t* dst, int K, int n0, int k0) {
    const int tid = tid_();
    {
        const int nn = tid & 63, kk = tid >> 6, n = n0 + nn;
        const float* cp;
        if (!inter) cp = srcA + n; else { const int g = n >> 5, i = n & 31; cp = (i < 16) ? (srcA + 16 * g + i) : (srcB + 16 * g + i - 16); }
#pragma unroll
        for (int p = 0; p < 8; ++p) { const int k = kk + 8 * p; t[k * 65 + nn] = cp[(size_t)(k0 + k) * ld]; }
    }
    __syncthreads();
    {
        const int n = tid >> 3, k8 = (tid & 7) * 8;
        float v[8];
#pragma unroll
        for (int j = 0; j < 8; ++j) v[j] = t[(k8 + j) * 65 + n];
        uint4 o; o.x = pk_bf16(v[0], v[1]); o.y = pk_bf16(v[2], v[3]); o.z = pk_bf16(v[4], v[5]); o.w = pk_bf16(v[6], v[7]);
        *(uint4*)(dst + (size_t)(n0 + n) * K + k0 + k8) = o;
    }
    __syncthreads();
}
__device__ __forceinline__ void ph_wconv(const Params& P, LAS unsigned char* lds, int l) {
    LAS float* t = (LAS float*)lds;
    const int bid = bid_(), G = gridDim.x;
    constexpr int T_IN = 16 * 124, T_BR = 3 * 8 * 16, T_OUT = 16 * 16, T_GU = 16 * 16 * 16, T_DN = 16 * 8 * 16;
    constexpr int TOT = T_IN + T_BR + T_OUT + T_GU + T_DN;
    for (int u = bid; u < TOT; u += G) {
        int v = u;
        if (v < T_IN) { const int kt = v % 16, nt = v / 16;
            conv_tile(t, P.in[I_WIN] + (size_t)l * 1024 * INC, nullptr, INC, false, (bf16_t*)(P.ws + WS_WIN), 1024, nt * 64, kt * 64); continue; }
        v -= T_IN;
        if (v < T_BR) { const int i = v / 128, w = v % 128, kt = w % 8, nt = w / 8;
            conv_tile(t, P.in[I_WBR] + ((size_t)l * 3 + i) * 512 * 1024, nullptr, 1024, false, (bf16_t*)(P.ws + WS_WBR) + (size_t)i * 1024 * 512, 512, nt * 64, kt * 64); continue; }
        v -= T_BR;
        if (v < T_OUT) { const int kt = v % 16, nt = v / 16;
            conv_tile(t, P.in[I_WOUT] + (size_t)l * 1024 * 1024, nullptr, 1024, false, (bf16_t*)(P.ws + WS_WOUT), 1024, nt * 64, kt * 64); continue; }
        v -= T_OUT;
        if (v < T_GU) { const int e = v / 256, w = v % 256, kt = w % 16, nt = w / 16;
            const size_t eo = ((size_t)l * NEXP + e) * 1024 * 512;
            conv_tile(t, P.in[I_WEG] + eo, P.in[I_WEU] + eo, 512, true, (bf16_t*)(P.ws + WS_WGU) + (size_t)e * 1024 * 1024, 1024, nt * 64, kt * 64); continue; }
        v -= T_GU;
        { const int e = v / 128, w = v % 128, kt = w % 8, nt = w / 8;
            conv_tile(t, P.in[I_WED] + ((size_t)l * NEXP + e) * 512 * 1024, nullptr, 1024, false, (bf16_t*)(P.ws + WS_WDN) + (size_t)e * 1024 * 512, 512, nt * 64, kt * 64); }
    }
}

__device__ __forceinline__ void norm_row(const float4 (&x)[4], const float* g, const float* shift, const float* scale, int lane, float4 (&o)[4]) {
    float ss = 0.f;
#pragma unroll
    for (int i = 0; i < 4; ++i) ss += x[i].x * x[i].x + x[i].y * x[i].y + x[i].z * x[i].z + x[i].w * x[i].w;
    ss = wave_sum(ss);
    const float rstd = 1.0f / sqrtf(ss * (1.0f / 1024.0f) + 1e-6f);
#pragma unroll
    for (int i = 0; i < 4; ++i) {
        const int c = lane * 4 + 256 * i;
        const float4 gv = *(const float4*)(g + c), sh = *(const float4*)(shift + c), sc = *(const float4*)(scale + c);
        o[i].x = x[i].x * rstd * gv.x * (1.0f + sc.x) + sh.x;
        o[i].y = x[i].y * rstd * gv.y * (1.0f + sc.y) + sh.y;
        o[i].z = x[i].z * rstd * gv.z * (1.0f + sc.z) + sh.z;
        o[i].w = x[i].w * rstd * gv.w * (1.0f + sc.w) + sh.w;
    }
}
__device__ __forceinline__ int row_modrow(int r) { return r < NLAT ? (r >> 11) : 8; }

__device__ __forceinline__ void ph_norm1(const Params& P, int l) {
    const int tid = tid_(), lane = tid & 63, wid = tid >> 6;
    const float* xres = (const float*)(P.ws + WS_X);
    bf16_t* h = (bf16_t*)(P.ws + WS_H);
    const float* g = P.in[I_GMIX] + l * 1024;
    for (int r = bid_() * 8 + wid; r < NTOK; r += gridDim.x * 8) {
        const float* mod = (const float*)(P.ws + WS_MODS) + ((size_t)l * 9 + row_modrow(r)) * 6144;
        float4 x[4], o[4];
#pragma unroll
        for (int i = 0; i < 4; ++i) x[i] = *(const float4*)(xres + (size_t)r * D + lane * 4 + 256 * i);
        norm_row(x, g, mod, mod + 1024, lane, o);
#pragma unroll
        for (int i = 0; i < 4; ++i) { uint2 u; u.x = pk_bf16(o[i].x, o[i].y); u.y = pk_bf16(o[i].z, o[i].w); *(uint2*)(h + (size_t)r * D + lane * 4 + 256 * i) = u; }
    }
}

struct EpiStoreBf16 { bf16_t* O; int ldc;
    __device__ __forceinline__ void operator()(int row, int col, const f32x4& v0, const f32x4& v1) const {
        uint2 a, b; a.x = pk_bf16(v0[0], v0[1]); a.y = pk_bf16(v0[2], v0[3]); b.x = pk_bf16(v1[0], v1[1]); b.y = pk_bf16(v1[2], v1[3]);
        *(uint2*)(O + (size_t)row * ldc + col) = a; *(uint2*)(O + (size_t)row * ldc + col + 16) = b; } };
__device__ __forceinline__ void ph_g1(const Params& P, LAS unsigned char* lds) {
    const bf16_t* A = (const bf16_t*)(P.ws + WS_H); const bf16_t* Bt = (const bf16_t*)(P.ws + WS_WIN);
    EpiStoreBf16 E{(bf16_t*)(P.ws + WS_Z), INC};
    constexpr int NM = NTOK / 128, NN = INC / 256;
    for (int u = bid_(); u < NM * NN; u += gridDim.x) {
        const int pm = u % NM, pn = u / NM;
        f32x4 acc[4][4]; acc_zero(acc);
        g128_kloop(acc, lds, A + (size_t)pm * 128 * D, D, Bt + (size_t)pn * 256 * D, D, D);
        g128_epilogue(acc, pm * 128, pn * 256, E);
    }
}

__device__ __forceinline__ void ph_prep(const Params& P, int l) {
    const int tid = tid_(), lane = tid & 63, wid = tid >> 6;
    const bf16_t* z = (const bf16_t*)(P.ws + WS_Z);
    bf16_t* qn = (bf16_t*)(P.ws + WS_QN); bf16_t* kn = (bf16_t*)(P.ws + WS_KN);
    const float* rope = (const float*)(P.ws + WS_ROPE);
    const float gq = P.in[I_QNG][l * 64 + lane], gk = P.in[I_KNG][l * 64 + lane];
    for (int r = bid_() * 8 + wid; r < NTOK; r += gridDim.x * 8) {
        const bool lat = r < NLAT;
        float cs = 1.f, sn = 0.f;
        if (lat) { const int t = r & 2047, fi = lane & 15;
            if (lane < 32) { const int pr = t >> 6; cs = rope[pr * 16 + fi]; sn = rope[512 + pr * 16 + fi]; }
            else { const int pc = t & 63; cs = rope[1024 + pc * 16 + fi]; sn = rope[2048 + pc * 16 + fi]; } }
        const float sgn = (lane & 16) ? 1.f : -1.f;
#pragma unroll
        for (int hh = 0; hh < 10; ++hh) {
            const int col = (hh < 8) ? (C_GQ + hh * 64) : (C_GK + (hh - 8) * 64);
            const float x = bf2f(z[(size_t)r * INC + col + lane]);
            const float ss = wave_sum(x * x);
            const float xn = x * (1.0f / sqrtf(ss * (1.0f / 64.0f) + 1e-6f)) * (hh < 8 ? gq : gk);
            const float pa = __shfl_xor(xn, 16, 64);
            const float o = xn * cs + sgn * pa * sn;
            const bf16_t ob = (bf16_t)(pk_bf16(o, 0.f) & 0xffffu);
            if (hh < 8) qn[(size_t)r * 512 + hh * 64 + lane] = ob; else kn[(size_t)r * 128 + (hh - 8) * 64 + lane] = ob;
        }
    }
}

__device__ __forceinline__ void load_q64(float (&q)[64], const bf16_t* p) {
#pragma unroll
    for (int i = 0; i < 8; ++i) { const uint4 u = ((const uint4*)p)[i];
        q[8 * i + 0] = bf_lo(u.x); q[8 * i + 1] = bf_hi(u.x); q[8 * i + 2] = bf_lo(u.y); q[8 * i + 3] = bf_hi(u.y);
        q[8 * i + 4] = bf_lo(u.z); q[8 * i + 5] = bf_hi(u.z); q[8 * i + 6] = bf_lo(u.w); q[8 * i + 7] = bf_hi(u.w); }
}
__device__ __forceinline__ void attn_key(const float (&q)[64], const bf16_t* kp, const bf16_t* vp, float bias, float& m, float& lsum, float (&o)[64]) {
    float s = 0.f;
#pragma unroll
    for (int i = 0; i < 8; ++i) { const uint4 u = ((const uint4*)kp)[i];
        s += q[8 * i + 0] * bf_lo(u.x) + q[8 * i + 1] * bf_hi(u.x) + q[8 * i + 2] * bf_lo(u.y) + q[8 * i + 3] * bf_hi(u.y)
           + q[8 * i + 4] * bf_lo(u.z) + q[8 * i + 5] * bf_hi(u.z) + q[8 * i + 6] * bf_lo(u.w) + q[8 * i + 7] * bf_hi(u.w); }
    s = s * 0.125f + bias;
    const float mn = fmaxf(m, s), corr = __expf(m - mn), pp = __expf(s - mn);
    lsum = lsum * corr + pp; m = mn;
#pragma unroll
    for (int i = 0; i < 8; ++i) { const uint4 u = ((const uint4*)vp)[i];
        o[8 * i + 0] = o[8 * i + 0] * corr + pp * bf_lo(u.x); o[8 * i + 1] = o[8 * i + 1] * corr + pp * bf_hi(u.x);
        o[8 * i + 2] = o[8 * i + 2] * corr + pp * bf_lo(u.y); o[8 * i + 3] = o[8 * i + 3] * corr + pp * bf_hi(u.y);
        o[8 * i + 4] = o[8 * i + 4] * corr + pp * bf_lo(u.z); o[8 * i + 5] = o[8 * i + 5] * corr + pp * bf_hi(u.z);
        o[8 * i + 6] = o[8 * i + 6] * corr + pp * bf_lo(u.w); o[8 * i + 7] = o[8 * i + 7] * corr + pp * bf_hi(u.w); }
}
__device__ __forceinline__ void store_o64(const float (&o)[64], float inv, bf16_t* p) {
#pragma unroll
    for (int i = 0; i < 8; ++i) { uint4 u;
        u.x = pk_bf16(o[8 * i + 0] * inv, o[8 * i + 1] * inv); u.y = pk_bf16(o[8 * i + 2] * inv, o[8 * i + 3] * inv);
        u.z = pk_bf16(o[8 * i + 4] * inv, o[8 * i + 5] * inv); u.w = pk_bf16(o[8 * i + 6] * inv, o[8 * i + 7] * inv);
        ((uint4*)p)[i] = u; }
}
__device__ __forceinline__ void na_thread(const Params& P, int l, int r, int h) {
    const bf16_t* z = (const bf16_t*)(P.ws + WS_Z);
    bf16_t* br = (bf16_t*)(P.ws + WS_BR);
    float q[64], o[64]; float m = -INFINITY, ls = 0.f;
#pragma unroll
    for (int i = 0; i < 64; ++i) o[i] = 0.f;
    load_q64(q, z + (size_t)r * INC + C_NAQ + h * 64);
    int b;
    if (r < NLAT) {
        b = r >> 11; const int t = r & 2047, qr = t >> 6, qc = t & 63;
        const int r0 = min(max(qr - 4, 0), 24), c0 = min(max(qc - 8, 0), 48);
        const float* rpb = P.in[I_RPB] + ((size_t)l * 8 + h) * 15 * 31;
        for (int kr = r0; kr < r0 + 8; ++kr)
            for (int kc = c0; kc < c0 + 16; ++kc) {
                const size_t krow = (size_t)(b * 2048 + kr * 64 + kc) * INC;
                attn_key(q, z + krow + C_NAK + h * 64, z + krow + C_NAV + h * 64, rpb[(kr - qr + 7) * 31 + (kc - qc + 15)], m, ls, o);
            }
    } else b = (r - NLAT) >> 8;
    for (int j = 0; j < 256; ++j) {
        const size_t krow = (size_t)(NLAT + b * 256 + j) * INC;
        attn_key(q, z + krow + C_NAK + h * 64, z + krow + C_NAV + h * 64, 0.f, m, ls, o);
    }
    store_o64(o, 1.0f / ls, br + (size_t)r * BRW + h * 64);
}
__device__ __forceinline__ void gqa_thread(const Params& P, int r, int hq) {
    const bf16_t* z = (const bf16_t*)(P.ws + WS_Z);
    const bf16_t* qn = (const bf16_t*)(P.ws + WS_QN); const bf16_t* kn = (const bf16_t*)(P.ws + WS_KN);
    bf16_t* br = (bf16_t*)(P.ws + WS_BR);
    float q[64], o[64]; float m = -INFINITY, ls = 0.f;
#pragma unroll
    for (int i = 0; i < 64; ++i) o[i] = 0.f;
    load_q64(q, qn + (size_t)r * 512 + hq * 64);
    const int g = hq >> 2;
    const int b = (r < NLAT) ? (r >> 11) : ((r - NLAT) >> 8);
    for (int j = 0; j < 256; ++j) {
        const size_t kr = (size_t)(NLAT + b * 256 + j);
        attn_key(q, kn + kr * 128 + g * 64, z + kr * INC + C_GV + g * 64, 0.f, m, ls, o);
    }
    if (r < NLAT)
        for (int j = 0; j < 2048; ++j) {
            const size_t kr = (size_t)(b * 2048 + j);
            attn_key(q, kn + kr * 128 + g * 64, z + kr * INC + C_GV + g * 64, 0.f, m, ls, o);
        }
    store_o64(o, 1.0f / ls, br + (size_t)r * BRW + 1024 + hq * 64);
}
__device__ __forceinline__ void hgrn_unit(const Params& P, LAS unsigned char* lds, int l, int u) {
    const int tid = tid_(), v = tid >> 2, kq = tid & 3;
    const int b = u >> 3, h = (u >> 1) & 3, dir = u & 1;
    const bf16_t* z = (const bf16_t*)(P.ws + WS_Z);
    float* O = (float*)(P.ws + (dir ? WS_Y : WS_H));
    const float* lbv = (const float*)(P.ws + WS_LB) + ((size_t)l * 2 + dir) * 512 + h * 128;
    LAS float* fS = (LAS float*)lds; LAS float* qS = fS + 16 * 128; LAS float* vS = qS + 16 * 128;
    const int cf = (dir ? C_HFB : C_HFF) + h * 128, cq = C_HQ + h * 128, cv = C_HI + h * 128;
    float S[32];
#pragma unroll
    for (int j = 0; j < 32; ++j) S[j] = 0.f;
    for (int s0 = 0; s0 < 2304; s0 += 16) {
        __syncthreads();
        for (int e = tid; e < 16 * 128; e += NTHR) {
            const int tt = e >> 7, d = e & 127, s = s0 + tt;
            int row;
            if (s < 256) row = NLAT + b * 256 + (dir ? 255 - s : s); else { const int j = s - 256; row = b * 2048 + (dir ? 2047 - j : j); }
            const bf16_t* zr = z + (size_t)row * INC;
            const float lb = lbv[d];
            fS[e] = lb + (1.0f - lb) * sigmoidf_(bf2f(zr[cf + d]));
            qS[e] = siluf_(bf2f(zr[cq + d]));
            vS[e] = bf2f(zr[cv + d]);
        }
        __syncthreads();
        for (int tt = 0; tt < 16; ++tt) {
            const int s = s0 + tt;
            const float vv = vS[tt * 128 + v];
            float op = 0.f;
#pragma unroll
            for (int j = 0; j < 32; ++j) { const float f = fS[tt * 128 + kq * 32 + j];
                S[j] = f * S[j] + (1.0f - f) * vv; op += S[j] * qS[tt * 128 + kq * 32 + j]; }
            op += __shfl_xor(op, 1, 64); op += __shfl_xor(op, 2, 64);
            if (kq == 0) {
                int row;
                if (s < 256) row = NLAT + b * 256 + (dir ? 255 - s : s); else { const int j = s - 256; row = b * 2048 + (dir ? 2047 - j : j); }
                O[(size_t)row * 512 + h * 128 + v] = op;
            }
        }
    }
}
__device__ __forceinline__ void ph_mix(const Params& P, LAS unsigned char* lds, int l) {
    const int tid = tid_();
    for (int u = bid_(); u < 640; u += gridDim.x) {
        if (u < 64) hgrn_unit(P, lds, l, u);
        else if (u < 320) { const int idx = (u - 64) * NTHR + tid; gqa_thread(P, idx >> 3, idx & 7); }
        else if (u < 576) { const int idx = (u - 320) * NTHR + tid; na_thread(P, l, idx >> 3, idx & 7); }
        else if (u < 608) { const int idx = (u - 576) * NTHR + tid; gqa_thread(P, NLAT + (idx >> 3), idx & 7); }
        else { const int idx = (u - 608) * NTHR + tid; na_thread(P, l, NLAT + (idx >> 3), idx & 7); }
    }
}
__device__ __forceinline__ void ph_readout(const Params& P, int l) {
    const int tid = tid_(), lane = tid & 63, wid = tid >> 6;
    const float* OF = (const float*)(P.ws + WS_H); const float* OB = (const float*)(P.ws + WS_Y);
    const bf16_t* z = (const bf16_t*)(P.ws + WS_Z);
    bf16_t* br = (bf16_t*)(P.ws + WS_BR);
    const float g0 = P.in[I_HGN][l * 128 + lane * 2], g1 = P.in[I_HGN][l * 128 + lane * 2 + 1];
    for (int r = bid_() * 8 + wid; r < NTOK; r += gridDim.x * 8) {
#pragma unroll
        for (int h = 0; h < 4; ++h) {
            const int c = h * 128 + lane * 2;
            const float2 a = *(const float2*)(OF + (size_t)r * 512 + c), bb = *(const float2*)(OB + (size_t)r * 512 + c);
            const float o0 = a.x + bb.x, o1 = a.y + bb.y;
            const float ss = wave_sum(o0 * o0 + o1 * o1);
            const float rstd = 1.0f / sqrtf(ss * (1.0f / 128.0f) + 1e-6f);
            const unsigned gz = *(const unsigned*)(z + (size_t)r * INC + C_HG + c);
            *(unsigned*)(br + (size_t)r * BRW + 512 + c) = pk_bf16(o0 * rstd * g0 * siluf_(bf_lo(gz)), o1 * rstd * g1 * siluf_(bf_hi(gz)));
        }
    }
}
__device__ __forceinline__ void ph_merge(const Params& P, LAS unsigned char* lds) {
    const bf16_t* br = (const bf16_t*)(P.ws + WS_BR); const bf16_t* wb = (const bf16_t*)(P.ws + WS_WBR);
    const bf16_t* z = (const bf16_t*)(P.ws + WS_Z);
    EpiStoreBf16 E{(bf16_t*)(P.ws + WS_Y), D};
    const int tid = tid_(), wid = tid >> 6, lane = tid & 63, wr = wid >> 2, wc = wid & 3, fr = lane & 15, fq = lane >> 4;
    constexpr int NM = NTOK / 128, NN = D / 256;
    for (int u = bid_(); u < NM * NN; u += gridDim.x) {
        const int pm = u % NM, pn = u / NM;
        f32x4 tot[4][4]; acc_zero(tot);
#pragma unroll 1
        for (int i = 0; i < 3; ++i) {
            f32x4 acc[4][4]; acc_zero(acc);
            g128_kloop(acc, lds, br + (size_t)pm * 128 * BRW + i * 512, BRW, wb + ((size_t)i * 1024 + pn * 256) * 512, 512, 512);
#pragma unroll
            for (int m = 0; m < 4; ++m)
#pragma unroll
                for (int n = 0; n < 4; ++n) {
                    const int row = pm * 128 + wr * 64 + m * 16 + fr, col = pn * 256 + wc * 64 + n * 16 + fq * 4;
                    const uint2 gz = *(const uint2*)(z + (size_t)row * INC + C_GATE + i * 1024 + col);
                    tot[m][n][0] += sigmoidf_(bf_lo(gz.x)) * acc[m][n][0]; tot[m][n][1] += sigmoidf_(bf_hi(gz.x)) * acc[m][n][1];
                    tot[m][n][2] += sigmoidf_(bf_lo(gz.y)) * acc[m][n][2]; tot[m][n][3] += sigmoidf_(bf_hi(gz.y)) * acc[m][n][3];
                }
        }
        g128_epilogue(tot, pm * 128, pn * 256, E);
    }
}
struct EpiResid { float* X; const float* mods; int l;
    __device__ __forceinline__ void operator()(int row, int col, const f32x4& v0, const f32x4& v1) const {
        const float* gate = mods + ((size_t)l * 9 + row_modrow(row)) * 6144 + 2 * 1024;
        float4* p0 = (float4*)(X + (size_t)row * D + col); float4* p1 = (float4*)(X + (size_t)row * D + col + 16);
        const float4 g0 = *(const float4*)(gate + col), g1 = *(const float4*)(gate + col + 16);
        float4 a = *p0, b = *p1;
        a.x += g0.x * v0[0]; a.y += g0.y * v0[1]; a.z += g0.z * v0[2]; a.w += g0.w * v0[3];
        b.x += g1.x * v1[0]; b.y += g1.y * v1[1]; b.z += g1.z * v1[2]; b.w += g1.w * v1[3];
        *p0 = a; *p1 = b; } };
__device__ __forceinline__ void ph_wout(const Params& P, LAS unsigned char* lds, int l) {
    const bf16_t* A = (const bf16_t*)(P.ws + WS_Y); const bf16_t* Bt = (const bf16_t*)(P.ws + WS_WOUT);
    EpiResid E{(float*)(P.ws + WS_X), (const float*)(P.ws + WS_MODS), l};
    constexpr int NM = NTOK / 128, NN = D / 256;
    for (int u = bid_(); u < NM * NN; u += gridDim.x) {
        const int pm = u % NM, pn = u / NM;
        f32x4 acc[4][4]; acc_zero(acc);
        g128_kloop(acc, lds, A + (size_t)pm * 128 * D, D, Bt + (size_t)pn * 256 * D, D, D);
        g128_epilogue(acc, pm * 128, pn * 256, E);
    }
}
__device__ __forceinline__ void ph_norm2_route(const Params& P, LAS unsigned char* lds, int l) {
    const int tid = tid_(), lane = tid & 63, wid = tid >> 6;
    LAS float* Wt = (LAS float*)lds;
    for (int i = tid; i < 20 * 1024; i += NTHR) { const int j = i >> 10, c = i & 1023;
        Wt[i] = (j < 4) ? P.in[I_WGR][((size_t)l * 1024 + c) * 4 + j] : P.in[I_WER][((size_t)l * 1024 + c) * 16 + (j - 4)]; }
    __syncthreads();
    const float* xres = (const float*)(P.ws + WS_X);
    bf16_t* f = (bf16_t*)(P.ws + WS_H);
    const float* g = P.in[I_GFFN] + l * 1024;
    int* cnt = (int*)(P.ws + WS_CNT) + l * 16;
    int* sel_e = (int*)(P.ws + WS_SELE); float* sel_w = (float*)(P.ws + WS_SELW); int* sel_p = (int*)(P.ws + WS_SELP);
    for (int r = bid_() * 8 + wid; r < NTOK; r += gridDim.x * 8) {
        const float* mod = (const float*)(P.ws + WS_MODS) + ((size_t)l * 9 + row_modrow(r)) * 6144;
        float4 x[4], o[4];
#pragma unroll
        for (int i = 0; i < 4; ++i) x[i] = *(const float4*)(xres + (size_t)r * D + lane * 4 + 256 * i);
        norm_row(x, g, mod + 3 * 1024, mod + 4 * 1024, lane, o);
#pragma unroll
        for (int i = 0; i < 4; ++i) { uint2 u; u.x = pk_bf16(o[i].x, o[i].y); u.y = pk_bf16(o[i].z, o[i].w); *(uint2*)(f + (size_t)r * D + lane * 4 + 256 * i) = u; }
        float lg[20];
#pragma unroll
        for (int j = 0; j < 20; ++j) {
            float s = 0.f;
#pragma unroll
            for (int i = 0; i < 4; ++i) { const f32x4 w = *(const LAS f32x4*)(Wt + j * 1024 + lane * 4 + 256 * i); s += o[i].x * w[0] + o[i].y * w[1] + o[i].z * w[2] + o[i].w * w[3]; }
            lg[j] = wave_sum(s);
        }
        if (lane == 0) {
            float gl[4]; int gi = 0;
#pragma unroll
            for (int j = 0; j < 4; ++j) gl[j] = lg[j] + P.in[I_BGR][l * 4 + j];
            float gm = gl[0];
#pragma unroll
            for (int j = 1; j < 4; ++j) if (gl[j] > gm) { gm = gl[j]; gi = j; }
            float se = 0.f;
#pragma unroll
            for (int j = 0; j < 4; ++j) se += expf(gl[j] - gm);
            const float pg = 1.0f / se;
            float el[4];
#pragma unroll
            for (int j = 0; j < 4; ++j) {
                float v = 0.f;
#pragma unroll
                for (int q = 0; q < 4; ++q) v = (gi == q) ? lg[4 + q * 4 + j] : v;
                el[j] = v + P.in[I_BER][l * 16 + gi * 4 + j];
            }
            int i0 = 0; float v0 = el[0];
#pragma unroll
            for (int j = 1; j < 4; ++j) if (el[j] > v0) { v0 = el[j]; i0 = j; }
            int i1 = -1; float v1 = -INFINITY;
#pragma unroll
            for (int j = 0; j < 4; ++j) if (j != i0 && el[j] > v1) { v1 = el[j]; i1 = j; }
            const float w0 = 1.0f / (1.0f + expf(v1 - v0)), w1 = 1.0f - w0;
            const int e0 = gi * 4 + i0, e1 = gi * 4 + i1;
            sel_e[r * 2] = e0; sel_e[r * 2 + 1] = e1;
            sel_w[r * 2] = w0 * pg; sel_w[r * 2 + 1] = w1 * pg;
            sel_p[r * 2] = atomicAdd(&cnt[e0], 1); sel_p[r * 2 + 1] = atomicAdd(&cnt[e1], 1);
        }
    }
}
__device__ __forceinline__ void moe_offsets(const int* cnt, int (&off)[17]) {
    int a = 0;
#pragma unroll
    for (int e = 0; e < 16; ++e) { off[e] = a; a += (cnt[e] + 255) & ~255; }
    off[16] = a;
}
__device__ __forceinline__ void ph_scatter(const Params& P, int l) {
    const int tid = tid_(), lane = tid & 63, wid = tid >> 6;
    const int* cnt = (const int*)(P.ws + WS_CNT) + l * 16;
    int off[17]; moe_offsets(cnt, off);
    const bf16_t* f = (const bf16_t*)(P.ws + WS_H); bf16_t* Fs = (bf16_t*)(P.ws + WS_FS);
    const int* sel_e = (const int*)(P.ws + WS_SELE); const int* sel_p = (const int*)(P.ws + WS_SELP); int* srow = (int*)(P.ws + WS_SROW);
    for (int r = bid_() * 8 + wid; r < NTOK; r += gridDim.x * 8) {
        const uint4 a = *(const uint4*)(f + (size_t)r * D + lane * 8), b = *(const uint4*)(f + (size_t)r * D + 512 + lane * 8);
#pragma unroll
        for (int k = 0; k < 2; ++k) {
            const int e = sel_e[r * 2 + k];
            int o = 0;
#pragma unroll
            for (int q = 0; q < 16; ++q) o = (e == q) ? off[q] : o;
            const int d = o + sel_p[r * 2 + k];
            *(uint4*)(Fs + (size_t)d * D + lane * 8) = a; *(uint4*)(Fs + (size_t)d * D + 512 + lane * 8) = b;
            if (lane == 0) srow[r * 2 + k] = d;
        }
    }
}
struct EpiSwiglu { bf16_t* H;
    __device__ __forceinline__ void operator()(int row, int col, const f32x4& v0, const f32x4& v1) const {
        const int hc = ((col & ~31) >> 1) + (col & 15);
        uint2 a; a.x = pk_bf16(siluf_(v0[0]) * v1[0], siluf_(v0[1]) * v1[1]); a.y = pk_bf16(siluf_(v0[2]) * v1[2], siluf_(v0[3]) * v1[3]);
        *(uint2*)(H + (size_t)row * EH + hc) = a; } };
__device__ __forceinline__ void ph_moe1(const Params& P, LAS unsigned char* lds, int l) {
    const int* cnt = (const int*)(P.ws + WS_CNT) + l * 16;
    int off[17]; moe_offsets(cnt, off);
    const bf16_t* Fs = (const bf16_t*)(P.ws + WS_FS); const bf16_t* W = (const bf16_t*)(P.ws + WS_WGU);
    EpiSwiglu E{(bf16_t*)(P.ws + WS_HS)};
    const int NM = off[16] / 128;
    for (int u = bid_(); u < NM * 4; u += gridDim.x) {
        const int pm = u % NM, pn = u / NM, row0 = pm * 128;
        int e = 0;
#pragma unroll
        for (int q = 1; q < 16; ++q) e += (row0 >= off[q]) ? 1 : 0;
        f32x4 acc[4][4]; acc_zero(acc);
        g128_kloop(acc, lds, Fs + (size_t)row0 * D, D, W + ((size_t)e * 1024 + pn * 256) * 1024, 1024, 1024);
        g128_epilogue(acc, row0, pn * 256, E);
    }
}
__device__ __forceinline__ void ph_moe2(const Params& P, LAS unsigned char* lds, int l) {
    const int* cnt = (const int*)(P.ws + WS_CNT) + l * 16;
    int off[17]; moe_offsets(cnt, off);
    const bf16_t* Hs = (const bf16_t*)(P.ws + WS_HS); const bf16_t* W = (const bf16_t*)(P.ws + WS_WDN);
    EpiStoreBf16 E{(bf16_t*)(P.ws + WS_YS), D};
    const int NM = off[16] / 128;
    for (int u = bid_(); u < NM * 4; u += gridDim.x) {
        const int pm = u % NM, pn = u / NM, row0 = pm * 128;
        int e = 0;
#pragma unroll
        for (int q = 1; q < 16; ++q) e += (row0 >= off[q]) ? 1 : 0;
        f32x4 acc[4][4]; acc_zero(acc);
        g128_kloop(acc, lds, Hs + (size_t)row0 * EH, EH, W + ((size_t)e * 1024 + pn * 256) * 512, 512, 512);
        g128_epilogue(acc, row0, pn * 256, E);
    }
}
__device__ __forceinline__ void ph_combine(const Params& P, int l) {
    const int tid = tid_(), lane = tid & 63, wid = tid >> 6;
    float* xres = (float*)(P.ws + WS_X);
    const bf16_t* Ys = (const bf16_t*)(P.ws + WS_YS);
    const float* sel_w = (const float*)(P.ws + WS_SELW); const int* srow = (const int*)(P.ws + WS_SROW);
    for (int r = bid_() * 8 + wid; r < NTOK; r += gridDim.x * 8) {
        const float* gate = (const float*)(P.ws + WS_MODS) + ((size_t)l * 9 + row_modrow(r)) * 6144 + 5 * 1024;
        const float w0 = sel_w[r * 2], w1 = sel_w[r * 2 + 1];
        const bf16_t* y0 = Ys + (size_t)srow[r * 2] * D; const bf16_t* y1 = Ys + (size_t)srow[r * 2 + 1] * D;
        float4 x[4];
        float ss = 0.f;
#pragma unroll
        for (int i = 0; i < 4; ++i) {
            const int c = lane * 4 + 256 * i;
            x[i] = *(const float4*)(xres + (size_t)r * D + c);
            const uint2 a = *(const uint2*)(y0 + c), b = *(const uint2*)(y1 + c);
            const float4 gv = *(const float4*)(gate + c);
            x[i].x += gv.x * (w0 * bf_lo(a.x) + w1 * bf_lo(b.x)); x[i].y += gv.y * (w0 * bf_hi(a.x) + w1 * bf_hi(b.x));
            x[i].z += gv.z * (w0 * bf_lo(a.y) + w1 * bf_lo(b.y)); x[i].w += gv.w * (w0 * bf_hi(a.y) + w1 * bf_hi(b.y));
            *(float4*)(xres + (size_t)r * D + c) = x[i];
            ss += x[i].x * x[i].x + x[i].y * x[i].y + x[i].z * x[i].z + x[i].w * x[i].w;
        }
        if (l == DEPTH - 1 && r < NLAT) {
            ss = wave_sum(ss);
            const float rstd = 1.0f / sqrtf(ss * (1.0f / 1024.0f) + 1e-6f);
#pragma unroll
            for (int i = 0; i < 4; ++i) {
                const int c = lane * 4 + 256 * i;
                const float4 gv = *(const float4*)(P.in[I_GFIN] + c);
                float4 o; o.x = x[i].x * rstd * gv.x; o.y = x[i].y * rstd * gv.y; o.z = x[i].z * rstd * gv.z; o.w = x[i].w * rstd * gv.w;
                *(float4*)(P.out + (size_t)r * D + c) = o;
            }
        }
    }
}

constexpr int NPH_LAYER = 12, NPH = 1 + DEPTH * NPH_LAYER;
#define CAS __attribute__((address_space(4)))
__device__ __forceinline__ const Params& kparams() { const CAS Params* k = (const CAS Params*)__builtin_amdgcn_kernarg_segment_ptr(); asm volatile("" : "+s"(k)); return *(const Params*)k; }
__global__ void __launch_bounds__(NTHR, 2) fwd(Params P_) {
    extern __shared__ __attribute__((aligned(16))) unsigned char lds_raw[];
    LAS unsigned char* lds = (LAS unsigned char*)lds_raw;
    volatile LAS unsigned* xbw = (volatile LAS unsigned*)(lds + LDS_BYTES - 16);
    if (threadIdx.x == 0) { xbw[0] = 0u; xbw[1] = 0u; xbw[2] = 0u; xbw[3] = 0u; }
    __syncthreads();
    const int lo = P_.ph_lo, hi = P_.ph_hi;
    XcdBarrier bar; bar.bar = (unsigned*)(P_.ws + WS_BAR); bar.x = 0; bar.st = xbw;
    if (hi - lo > 1) bar = xcd_barrier_post((unsigned*)(P_.ws + WS_BAR), xbw);
#ifndef PHMASK
#define PHMASK 0xFFFF
#endif
#define EN(j) ((PHMASK >> (j)) & 1)
#define IN(k) (lo <= (k) && (k) < hi)
#define SEAM(k) do { if (IN(k) && IN((k) + 1)) xcd_barrier(bar); } while (0)
    if (EN(12) && IN(0)) { ph_prologue(kparams(), lds); }
    SEAM(0);
    for (int l = 0; l < DEPTH; ++l) {
        const int p0 = 1 + l * NPH_LAYER;
        if (EN(0) && IN(p0 + 0)) { ph_wconv(kparams(), lds, l); ph_norm1(kparams(), l); }
        SEAM(p0 + 0);
        if (EN(1) && IN(p0 + 1)) ph_g1(kparams(), lds);
        SEAM(p0 + 1);
        if (EN(2) && IN(p0 + 2)) ph_prep(kparams(), l);
        SEAM(p0 + 2);
        if (EN(3) && IN(p0 + 3)) ph_mix(kparams(), lds, l);
        SEAM(p0 + 3);
        if (EN(4) && IN(p0 + 4)) ph_readout(kparams(), l);
        SEAM(p0 + 4);
        if (EN(5) && IN(p0 + 5)) ph_merge(kparams(), lds);
        SEAM(p0 + 5);
        if (EN(6) && IN(p0 + 6)) ph_wout(kparams(), lds, l);
        SEAM(p0 + 6);
        if (EN(7) && IN(p0 + 7)) ph_norm2_route(kparams(), lds, l);
        SEAM(p0 + 7);
        if (EN(8) && IN(p0 + 8)) ph_scatter(kparams(), l);
        SEAM(p0 + 8);
        if (EN(9) && IN(p0 + 9)) ph_moe1(kparams(), lds, l);
        SEAM(p0 + 9);
        if (EN(10) && IN(p0 + 10)) ph_moe2(kparams(), lds, l);
        SEAM(p0 + 10);
        if (EN(11) && IN(p0 + 11)) ph_combine(kparams(), l);
        SEAM(p0 + 11);
    }
#undef IN
#undef SEAM
}

#ifndef MK_PER_PHASE
#define MK_PER_PHASE 0
#endif
extern "C" void kernel_launch(void* const* d_in, const int* in_sizes, int n_in, void* d_out, int out_size, void* d_ws, size_t ws_size, hipStream_t stream) {
    static int grid = 0;
    if (grid == 0) {
        if (n_in != 24 || out_size != NLAT * D || ws_size < WS_END) { fprintf(stderr, "kernel_launch: unexpected shapes (n_in %d out %d ws %zu need %zu)\n", n_in, out_size, ws_size, (size_t)WS_END); grid = -1; return; }
        int dev = 0, cus = 0, per_cu = 0;
        if (hipGetDevice(&dev) != hipSuccess || hipDeviceGetAttribute(&cus, hipDeviceAttributeMultiprocessorCount, dev) != hipSuccess) { grid = -1; return; }
        if (hipFuncSetAttribute((const void*)fwd, hipFuncAttributeMaxDynamicSharedMemorySize, LDS_BYTES) != hipSuccess) { fprintf(stderr, "kernel_launch: hipFuncSetAttribute failed\n"); grid = -1; return; }
        if (hipOccupancyMaxActiveBlocksPerMultiprocessor(&per_cu, (const void*)fwd, NTHR, LDS_BYTES) != hipSuccess || per_cu < 1) { fprintf(stderr, "kernel_launch: occupancy query says %d\n", per_cu); }
        (void)hipGetLastError();
        grid = cus;
    }
    if (grid < 0) return;
    (void)hipMemsetAsync(d_ws, 0, WS_ZERO_BYTES, stream);
    Params p{};
    for (int i = 0; i < 24; ++i) p.in[i] = (const float*)d_in[i];
    p.out = (float*)d_out; p.ws = (unsigned char*)d_ws;
#if MK_PER_PHASE
    for (int ph = 0; ph < NPH; ++ph) { p.ph_lo = ph; p.ph_hi = ph + 1; hipLaunchKernelGGL(fwd, dim3(grid), dim3(NTHR), LDS_BYTES, stream, p); }
#else
    p.ph_lo = 0; p.ph_hi = NPH; hipLaunchKernelGGL(fwd, dim3(grid), dim3(NTHR), LDS_BYTES, stream, p);
#endif
}
```

```cpp
#include <hip/hip_runtime.h>
#include <cstdio>
#include <cstdint>

#define LAS __attribute__((address_space(3)))
typedef unsigned short bf16_t;
typedef short bf16x8 __attribute__((ext_vector_type(8)));
typedef float f32x4 __attribute__((ext_vector_type(4)));
typedef unsigned u32x4 __attribute__((ext_vector_type(4)));

constexpr int D = 1024, NB = 8, SEQ = 2048, DEPTH = 4, CTXL = 256;
constexpr int NLAT = NB * SEQ, NCTX = NB * CTXL, NTOK = NLAT + NCTX;
constexpr int INC = 7936;
constexpr int C_NAQ = 0, C_NAK = 512, C_NAV = 1024, C_HQ = 1536, C_HFF = 2048, C_HFB = 2560, C_HI = 3072, C_HG = 3584,
              C_GQ = 4096, C_GK = 4608, C_GV = 4736, C_GATE = 4864;
constexpr int BRW = 1536;
constexpr int NEXP = 16, EH = 512;
constexpr int MPAD = 40960;
constexpr int NTHR = 512;
constexpr int LDS_BYTES = 147456;

constexpr size_t WS_BAR = 0;
constexpr size_t WS_CNT = 16384;
constexpr size_t WS_ZERO_BYTES = 65536;
constexpr size_t WS_MODS = 65536;
constexpr size_t WS_LB = WS_MODS + 884736;
constexpr size_t WS_ROPE = WS_LB + 16384;
constexpr size_t WS_SELE = WS_ROPE + 12288;
constexpr size_t WS_SELW = WS_SELE + 147456;
constexpr size_t WS_SELP = WS_SELW + 147456;
constexpr size_t WS_SROW = WS_SELP + 147456;
constexpr size_t WS_X = 2097152;
constexpr size_t WS_H = WS_X + (size_t)NTOK * D * 4;
constexpr size_t WS_Z = WS_H + (size_t)NTOK * D * 2;
constexpr size_t WS_BR = WS_Z + (size_t)NTOK * INC * 2;
constexpr size_t WS_Y = WS_BR + (size_t)NTOK * BRW * 2;
constexpr size_t WS_QN = WS_Y + (size_t)NTOK * D * 2;
constexpr size_t WS_KN = WS_QN + (size_t)NTOK * 512 * 2;
constexpr size_t WS_VN = WS_KN + (size_t)NTOK * 128 * 2;
constexpr size_t WS_NAVT = WS_VN + (size_t)NTOK * 128 * 2;
constexpr size_t WS_WIN = WS_NAVT + (size_t)NTOK * 512 * 2;
constexpr size_t WS_WBR = WS_WIN + (size_t)INC * D * 2;
constexpr size_t WS_WOUT = WS_WBR + (size_t)3 * D * 512 * 2;
constexpr size_t WS_WGU = WS_WOUT + (size_t)D * D * 2;
constexpr size_t WS_WDN = WS_WGU + (size_t)NEXP * 1024 * 1024 * 2;
constexpr size_t WS_END = WS_WDN + (size_t)NEXP * 1024 * 512 * 2;
constexpr size_t WS_FS = WS_Z;
constexpr size_t WS_HS = WS_FS + (size_t)MPAD * 1024 * 2;
constexpr size_t WS_YS = WS_HS + (size_t)MPAD * 512 * 2;
static_assert(WS_YS + (size_t)MPAD * 1024 * 2 <= WS_BR, "moe alias");
static_assert(WS_SROW + 147456 <= WS_X, "ctl");

#define XB_TMO      128
#define XB_XCNT(j)  (256  + 64 * (j))
#define XB_XSUB(j)  (1280 + 64 * (j))
#define XB_XGEN(j)  (2304 + 64 * (j))
#define XB_TOP      3328
#define XB_TOPGEN   3392
#define XCD_BAR_WORDS 3456
#define XB_SPIN_CAP (1u << 22)
__device__ __forceinline__ unsigned xb_ld(unsigned* p)              { return __hip_atomic_load(p, __ATOMIC_RELAXED, __HIP_MEMORY_SCOPE_AGENT); }
__device__ __forceinline__ unsigned xb_add(unsigned* p, unsigned v) { return __hip_atomic_fetch_add(p, v, __ATOMIC_RELAXED, __HIP_MEMORY_SCOPE_AGENT); }
__device__ __forceinline__ unsigned xb_xcc_id() { return (unsigned)__builtin_amdgcn_s_getreg((3 << 11) | 20) & 0xFu; }
#define XB_SPIN(cond, bar) do { unsigned _sp = 0; while (cond) { __builtin_amdgcn_s_sleep(1); \
    if ((++_sp & 255u) == 0u) { if (xb_ld(&(bar)[XB_TMO])) break; if (_sp > XB_SPIN_CAP) { atomicAdd(&(bar)[XB_TMO], 1u); break; } } } } while (0)
struct XcdBarrier { unsigned* bar; unsigned x; volatile LAS unsigned* st; };
__device__ __forceinline__ XcdBarrier xcd_barrier_post(unsigned* bar, volatile LAS unsigned* st) {
    XcdBarrier b; b.bar = bar; b.x = xb_xcc_id(); b.st = st;
    if (threadIdx.x == 0) (void)xb_add(&bar[XB_XCNT(b.x)], 1u);
    return b;
}
__device__ __forceinline__ void xcd_barrier_complete(unsigned* bar, unsigned x, unsigned& nloc, unsigned& nx) {
    const unsigned G = gridDim.x * gridDim.y * gridDim.z;
    unsigned sum, cnt, mine, sp = 0u;
    for (;;) {
        sum = 0u; cnt = 0u; mine = 0u;
#pragma unroll
        for (unsigned j = 0; j < 16; ++j) { const unsigned c = xb_ld(&bar[XB_XCNT(j)]); sum += c; cnt += (c > 0u) ? 1u : 0u; mine = (j == x) ? c : mine; }
        if (sum == G) break;
        __builtin_amdgcn_s_sleep(1);
        if ((++sp & 255u) == 0u) { if (xb_ld(&bar[XB_TMO])) break; if (sp > XB_SPIN_CAP) { atomicAdd(&bar[XB_TMO], 1u); break; } }
    }
    nloc = mine > 0u ? mine : 1u; nx = cnt > 0u ? cnt : 1u;
}
__device__ __forceinline__ void xcd_barrier(const XcdBarrier& b) {
    asm volatile("s_waitcnt vmcnt(0)" ::: "memory");
    __syncthreads();
    if (threadIdx.x == 0) {
        unsigned* bar = b.bar;
        __builtin_amdgcn_s_waitcnt(0);
        unsigned nloc = b.st[0], nx = b.st[1];
        if (nloc == 0u) { xcd_barrier_complete(bar, b.x, nloc, nx); b.st[0] = nloc; b.st[1] = nx; }
        const unsigned old = xb_add(&bar[XB_XSUB(b.x)], 1u);
        const unsigned gen = old / nloc;
        if (old + 1u == (gen + 1u) * nloc) {
            __builtin_amdgcn_fence(__ATOMIC_RELEASE, "agent");
            asm volatile("s_waitcnt vmcnt(0)" ::: "memory");
            const unsigned og = xb_add(&bar[XB_TOP], 1u);
            const unsigned tg = og / nx;
            if (og + 1u == (tg + 1u) * nx) xb_add(&bar[XB_TOPGEN], 1u);
            else XB_SPIN(xb_ld(&bar[XB_TOPGEN]) == tg, bar);
            __builtin_amdgcn_fence(__ATOMIC_ACQUIRE, "agent");
            xb_add(&bar[XB_XGEN(b.x)], 1u);
            asm volatile("s_waitcnt vmcnt(0)" ::: "memory");
        } else {
            XB_SPIN(xb_ld(&bar[XB_XGEN(b.x)]) == gen, bar);
            __builtin_amdgcn_fence(__ATOMIC_ACQUIRE, "agent");
            asm volatile("s_waitcnt vmcnt(0)" ::: "memory");
        }
    }
    __syncthreads();
}

__device__ __forceinline__ float bf_lo(unsigned u) { return __uint_as_float(u << 16); }
__device__ __forceinline__ float bf_hi(unsigned u) { return __uint_as_float(u & 0xffff0000u); }
__device__ __forceinline__ float bf2f(bf16_t b) { return __uint_as_float(((unsigned)b) << 16); }
__device__ __forceinline__ unsigned pk_bf16(float lo, float hi) { unsigned r; asm volatile("v_cvt_pk_bf16_f32 %0, %1, %2" : "=v"(r) : "v"(lo), "v"(hi)); return r; }
__device__ __forceinline__ bf16x8 pack8(const float (&v)[8]) { u32x4 u = {pk_bf16(v[0], v[1]), pk_bf16(v[2], v[3]), pk_bf16(v[4], v[5]), pk_bf16(v[6], v[7])}; return __builtin_bit_cast(bf16x8, u); }
__device__ __forceinline__ float sigmoidf_(float x) { return 1.0f / (1.0f + __expf(-x)); }
__device__ __forceinline__ float siluf_(float x) { return x / (1.0f + __expf(-x)); }
__device__ __forceinline__ float wave_sum(float v) {
#pragma unroll
    for (int o = 32; o > 0; o >>= 1) v += __shfl_xor(v, o, 64);
    return v;
}

__device__ __forceinline__ int tid_() { int t = threadIdx.x; asm volatile("" : "+v"(t)); return t; }
__device__ __forceinline__ int bid_() { int t = blockIdx.x; asm volatile("" : "+s"(t)); return t; }
struct Params {
    const float* in[24];
    float* out;
    unsigned char* ws;
    int ph_lo, ph_hi;
};
enum { I_X = 0, I_C, I_CTX, I_CCTX, I_WADA, I_BADA, I_GMIX, I_GFFN, I_WIN, I_RPB, I_LBL, I_HGN, I_QNG, I_KNG, I_WBR, I_WOUT,
       I_WGR, I_BGR, I_WER, I_BER, I_WEG, I_WEU, I_WED, I_GFIN };

__device__ __forceinline__ void g128_kloop(f32x4 (&acc)[4][4], LAS unsigned char* lds, const bf16_t* A, int lda, const bf16_t* Bt, int ldb, int K) {
    const int tid = tid_(), wid = tid >> 6, lane = tid & 63, wr = wid >> 2, wc = wid & 3, fr = lane & 15, fq = lane >> 4;
    LAS unsigned char* SA = lds; LAS unsigned char* SB = lds + 8192;
    const int srow = tid >> 2, skc = (tid & 3) * 8;
    const bf16_t* ap = A + (size_t)srow * lda + skc;
    const bf16_t* bp0 = Bt + (size_t)srow * ldb + skc;
    const bf16_t* bp1 = Bt + (size_t)(srow + 128) * ldb + skc;
    for (int k0 = 0; k0 < K; k0 += 32) {
        const uint4 va = *(const uint4*)(ap + k0);
        const uint4 vb0 = *(const uint4*)(bp0 + k0);
        const uint4 vb1 = *(const uint4*)(bp1 + k0);
        __syncthreads();
        *(LAS u32x4*)(SA + tid * 16) = (u32x4){va.x, va.y, va.z, va.w};
        *(LAS u32x4*)(SB + tid * 16) = (u32x4){vb0.x, vb0.y, vb0.z, vb0.w};
        *(LAS u32x4*)(SB + 8192 + tid * 16) = (u32x4){vb1.x, vb1.y, vb1.z, vb1.w};
        __syncthreads();
        bf16x8 At[4], Bf[4];
#pragma unroll
        for (int m = 0; m < 4; ++m) At[m] = *(const LAS bf16x8*)(SA + ((wr * 64 + m * 16 + fr) * 32 + fq * 8) * 2);
#pragma unroll
        for (int n = 0; n < 4; ++n) Bf[n] = *(const LAS bf16x8*)(SB + ((wc * 64 + n * 16 + fr) * 32 + fq * 8) * 2);
#pragma unroll
        for (int m = 0; m < 4; ++m)
#pragma unroll
            for (int n = 0; n < 4; ++n) acc[m][n] = __builtin_amdgcn_mfma_f32_16x16x32_bf16(Bf[n], At[m], acc[m][n], 0, 0, 0);
    }
}
__device__ __forceinline__ void acc_zero(f32x4 (&acc)[4][4]) {
#pragma unroll
    for (int m = 0; m < 4; ++m)
#pragma unroll
        for (int n = 0; n < 4; ++n) acc[m][n] = (f32x4){0.f, 0.f, 0.f, 0.f};
}
template <class Epi>
__device__ __forceinline__ void g128_epilogue(const f32x4 (&acc)[4][4], int row0, int col0, const Epi& E) {
    const int tid = tid_(), wid = tid >> 6, lane = tid & 63, wr = wid >> 2, wc = wid & 3, fr = lane & 15, fq = lane >> 4;
#pragma unroll
    for (int m = 0; m < 4; ++m)
#pragma unroll
        for (int n = 0; n < 4; n += 2) E(row0 + wr * 64 + m * 16 + fr, col0 + wc * 64 + n * 16 + fq * 4, acc[m][n], acc[m][n + 1]);
}


namespace pg8 {
constexpr int BM = 256, BK = 64, HALF = 128, HTB = HALF * BK * 2, STAGE_BYTES = 8 * HTB;
__device__ __forceinline__ int lds_byte(int r, int c) { const int st = (r >> 4) * 2 + (c >> 5), rr = r & 15, cc = c & 31, ob = rr * 64 + cc * 2; return st * 1024 + (ob ^ (((ob >> 9) & 1) << 5)); }
__device__ __forceinline__ void stage_rc(int b, int& R, int& C) { const int st = b / 1024, sb = b % 1024, swz = sb ^ (((sb >> 9) & 1) << 5); R = (st >> 1) * 16 + swz / 64; C = (st & 1) * 32 + (swz % 64) / 2; }
struct Unit { int row0, col0, aux; const char* A; const char* B; };
struct Gemm { int K, lda, ldb; };
template <class Epi, class Sched>
__device__ __forceinline__ void gemm_phase(LAS unsigned char* lds, const Gemm g, const Sched& S, const Epi& E) {
    const int tid = tid_(), wid = __builtin_amdgcn_readfirstlane(tid >> 6), lane = tid & 63, wr = wid >> 2, wc = wid & 3, fr = lane & 15, fq = lane >> 4;
    const int K = g.K, nt = K / BK;
    unsigned voffA[2], voffB[2];
#pragma unroll
    for (int i = 0; i < 2; ++i) { int R, C; stage_rc(tid * 16 + i * 8192, R, C);
        voffA[i] = (unsigned)(R * g.lda + C) * 2u; voffB[i] = (unsigned)(R * g.ldb + C) * 2u; }
    const size_t kstep = (size_t)(BK * 2);
    const size_t hstepA = (size_t)HALF * g.lda * 2, hstepB = (size_t)HALF * g.ldb * 2;
    const unsigned ldsw = (unsigned)wid * 1024u;
    const int aoff = lds_byte(wr * 64 + fr, fq * 8), boff = lds_byte(wc * 32 + fr, fq * 8);
#define PG8_SA(b, h) (((b) * 2 + (h)) * HTB)
#define PG8_SB(b, h) ((4 + (b) * 2 + (h)) * HTB)
#define PG8_STAGE(bufoff, gbase, voff) do { _Pragma("unroll") for (int _i = 0; _i < 2; ++_i) \
        __builtin_amdgcn_global_load_lds((const unsigned*)((const char*)(gbase) + (voff)[_i]), (LAS unsigned*)(lds + (bufoff) + ldsw + _i * 8192), 16, 0, 0); } while (0)
#define PG8_LDA(dst, b, h) do { _Pragma("unroll") for (int m = 0; m < 4; ++m) _Pragma("unroll") for (int k = 0; k < 2; ++k) dst[m][k] = *(const LAS bf16x8*)(lds + PG8_SA(b, h) + aoff + m * 2048 + k * 1024); } while (0)
#define PG8_LDB(dst, b, h) do { _Pragma("unroll") for (int n = 0; n < 2; ++n) _Pragma("unroll") for (int k = 0; k < 2; ++k) dst[n][k] = *(const LAS bf16x8*)(lds + PG8_SB(b, h) + boff + n * 2048 + k * 1024); } while (0)
#define PG8_MMA(ai, bj, At, Bt) do { __builtin_amdgcn_s_setprio(1); _Pragma("unroll") for (int m = 0; m < 4; ++m) _Pragma("unroll") for (int n = 0; n < 2; ++n) _Pragma("unroll") for (int k = 0; k < 2; ++k) \
        acc[ai][bj][m][n] = __builtin_amdgcn_mfma_f32_16x16x32_bf16(Bt[n][k], At[m][k], acc[ai][bj][m][n], 0, 0, 0); __builtin_amdgcn_s_setprio(0); } while (0)
#define PG8_WAIT_V(n) asm volatile("s_waitcnt vmcnt(" #n ")" ::: "memory")
#define PG8_WAIT_L(n) asm volatile("s_waitcnt lgkmcnt(" #n ")" ::: "memory")
#define PG8_BAR __builtin_amdgcn_s_barrier()
#define PG8_SCHED __builtin_amdgcn_sched_barrier(0)
    Unit cur, nxt; int ui = 0;
    if (!S.next(0, cur)) return;
    f32x4 acc[2][2][4][2];
#pragma unroll
    for (int a = 0; a < 2; ++a)
#pragma unroll
        for (int b = 0; b < 2; ++b)
#pragma unroll
            for (int m = 0; m < 4; ++m)
#pragma unroll
                for (int n = 0; n < 2; ++n) acc[a][b][m][n] = (f32x4){0.f, 0.f, 0.f, 0.f};
    bf16x8 At[4][2], B0[2][2], B1[2][2];
    const char* cA = cur.A; const char* cB = cur.B;
    PG8_STAGE(PG8_SB(0, 0), cB, voffB); PG8_STAGE(PG8_SA(0, 0), cA, voffA); PG8_STAGE(PG8_SB(0, 1), cB + hstepB, voffB); PG8_STAGE(PG8_SA(0, 1), cA + hstepA, voffA);
    if (wr == 1) PG8_BAR;
    PG8_WAIT_V(4); PG8_BAR;
    PG8_STAGE(PG8_SB(1, 0), cB + kstep, voffB); PG8_STAGE(PG8_SA(1, 0), cA + kstep, voffA); PG8_STAGE(PG8_SB(1, 1), cB + hstepB + kstep, voffB);
    PG8_WAIT_V(6); PG8_BAR;
    for (;;) {
        const bool has_next = S.next(ui + 1, nxt);
        const char* nA = has_next ? nxt.A : cA; const char* nB = has_next ? nxt.B : cB;
        for (int t = 0; t < nt; t += 2) {
            const bool last = (t == nt - 2);
            const char* a1 = cA + (size_t)(t + 1) * kstep;
            const char* a2 = last ? nA : cA + (size_t)(t + 2) * kstep; const char* b2 = last ? nB : cB + (size_t)(t + 2) * kstep;
            const char* a3 = a2 + kstep; const char* b3 = b2 + kstep;
            PG8_LDB(B0, 0, 0); PG8_SCHED; PG8_LDA(At, 0, 0); PG8_STAGE(PG8_SA(1, 1), a1 + hstepA, voffA);
            PG8_WAIT_L(8); PG8_BAR; PG8_WAIT_L(0); PG8_MMA(0, 0, At, B0); PG8_BAR; PG8_SCHED;
            PG8_LDB(B1, 0, 1); PG8_STAGE(PG8_SB(0, 0), b2, voffB);
            PG8_BAR; PG8_WAIT_L(0); PG8_MMA(0, 1, At, B1); PG8_BAR;
            PG8_LDA(At, 0, 1); PG8_STAGE(PG8_SA(0, 0), a2, voffA);
            PG8_BAR; PG8_WAIT_L(0); PG8_MMA(1, 0, At, B0); PG8_BAR; PG8_SCHED;
            PG8_STAGE(PG8_SB(0, 1), b2 + hstepB, voffB);
            PG8_WAIT_V(6); PG8_BAR; PG8_MMA(1, 1, At, B1); PG8_BAR;
            PG8_LDB(B0, 1, 0); PG8_SCHED; PG8_LDA(At, 1, 0); PG8_STAGE(PG8_SA(0, 1), a2 + hstepA, voffA);
            PG8_WAIT_L(8); PG8_BAR; PG8_WAIT_L(0); PG8_MMA(0, 0, At, B0); PG8_BAR; PG8_SCHED;
            PG8_LDB(B1, 1, 1); PG8_STAGE(PG8_SB(1, 0), b3, voffB);
            PG8_BAR; PG8_WAIT_L(0); PG8_MMA(0, 1, At, B1); PG8_BAR;
            PG8_LDA(At, 1, 1); PG8_STAGE(PG8_SA(1, 0), a3, voffA);
            PG8_BAR; PG8_WAIT_L(0); PG8_MMA(1, 0, At, B0); PG8_BAR; PG8_SCHED;
            PG8_STAGE(PG8_SB(1, 1), b3 + hstepB, voffB);
            PG8_WAIT_V(6); PG8_BAR; PG8_MMA(1, 1, At, B1); PG8_BAR;
        }
        E(acc, cur, wr, wc, fr, fq);
        if (!has_next) break;
#pragma unroll
        for (int a = 0; a < 2; ++a)
#pragma unroll
            for (int b = 0; b < 2; ++b)
#pragma unroll
                for (int m = 0; m < 4; ++m)
#pragma unroll
                    for (int n = 0; n < 2; ++n) acc[a][b][m][n] = (f32x4){0.f, 0.f, 0.f, 0.f};
        cur = nxt; cA = nA; cB = nB; ++ui;
    }
    PG8_WAIT_V(0);
    if (wr == 0) PG8_BAR;
    PG8_BAR;
#undef PG8_SA
#undef PG8_SB
#undef PG8_STAGE
#undef PG8_LDA
#undef PG8_LDB
#undef PG8_MMA
#undef PG8_WAIT_V
#undef PG8_WAIT_L
#undef PG8_BAR
#undef PG8_SCHED
}
template <class F> struct EpiPair { F f;
    __device__ __forceinline__ void operator()(const f32x4 (&acc)[2][2][4][2], const Unit& u, int wr, int wc, int fr, int fq) const {
#pragma unroll
        for (int ai = 0; ai < 2; ++ai)
#pragma unroll
            for (int m = 0; m < 4; ++m)
#pragma unroll
                for (int bj = 0; bj < 2; ++bj) f(u, u.row0 + ai * HALF + wr * 64 + m * 16 + fr, u.col0 + bj * HALF + wc * 32 + 4 * fq, acc[ai][bj][m][0], acc[ai][bj][m][1]);
    } };
struct SchedDense { int nM, nN, G, c; const char* A; const char* B; size_t tA, tB;
    __device__ __forceinline__ bool next(int i, Unit& u) const {
        const int nwg = nM * nN; const long L = (long)i * G + c; if (L >= nwg) return false;
        int wgid = (int)L; { const int q = nwg / 8, r = nwg % 8, xcd = wgid % 8, off = wgid / 8; wgid = (xcd < r ? xcd * (q + 1) : r * (q + 1) + (xcd - r) * q) + off; }
        const int nig = 8 * nN, gid = wgid / nig, fm = gid * 8, gsz = (nM - fm) < 8 ? (nM - fm) : 8;
        const int pm = fm + ((wgid % nig) % gsz), pn = (wgid % nig) / gsz;
        u.row0 = pm * 256; u.col0 = pn * 256; u.aux = 0; u.A = A + (size_t)pm * tA; u.B = B + (size_t)pn * tB; return true; } };
}


namespace gqa {
using f32x16 = __attribute__((ext_vector_type(16))) float;
using s16x4 = __attribute__((ext_vector_type(4))) short;
constexpr int QP = 512, KVP = 128, OP = BRW;
constexpr int NW = 8, QBLK = 32, KVBLK = 64;
__device__ __forceinline__ int crow(int r, int hi) { return (r & 3) + 8 * (r >> 2) + 4 * hi; }
#define SBAR() __builtin_amdgcn_sched_barrier(0)
constexpr int NSLOT = 3, SLOTB = 8192;
constexpr int LDS_K = 0, LDS_V = NSLOT * SLOTB, LDS_WS = 2 * NSLOT * SLOTB, LDS_OST = LDS_WS + NW * 64 * 4, LDS_BYTES_ = LDS_OST + NW * 4096;
__device__ __forceinline__ void glds16(const void* gsrc, unsigned lds_dst) { unsigned keep;
  asm volatile("s_mov_b32 %0, m0\n\ts_mov_b32 m0, %2\n\ts_nop 0\n\tglobal_load_lds_dwordx4 %1, off\n\ts_mov_b32 m0, %0" : "=&s"(keep) : "v"(gsrc), "s"(lds_dst) : "memory"); }
__device__ __forceinline__ float max3f(float a, float b, float c) { float r; asm("v_max3_f32 %0, %1, %2, %3" : "=v"(r) : "v"(a), "v"(b), "v"(c)); return r; }
__device__ __forceinline__ float max2f(float a, float b) { float r; asm("v_max_f32_e32 %0, %1, %2" : "=v"(r) : "v"(a), "v"(b)); return r; }
__device__ __forceinline__ float fadd_s(float a, float b) { float r; asm("v_add_f32_e32 %0, %1, %2" : "=v"(r) : "v"(a), "v"(b)); return r; }
__device__ __forceinline__ float fsub_s(float a, float b) { float r; asm("v_sub_f32_e32 %0, %1, %2" : "=v"(r) : "v"(a), "v"(b)); return r; }
typedef float f32x2_t __attribute__((ext_vector_type(2))); typedef __bf16 bf16x2_t __attribute__((ext_vector_type(2)));
__device__ __forceinline__ unsigned cvtpk_s(float lo, float hi) { f32x2_t v = {lo, hi}; bf16x2_t b = __builtin_convertvector(v, bf16x2_t); return __builtin_bit_cast(unsigned, b); }
#define WAIT_BAR(N) asm volatile("s_waitcnt vmcnt(" #N ") lgkmcnt(0)\n\ts_barrier" ::: "memory")
__device__ __forceinline__ void qkt(f32x16& p0, f32x16& p1, const char* Kslot, const bf16x8* qr, const f32x16& negm, int r32, int hi) {
  const char* kb = Kslot + hi * 1024 + r32 * 16;
  #pragma unroll
  for (int d0 = 0; d0 < 4; ++d0) {
    const bf16x8 b0 = *reinterpret_cast<const bf16x8*>(kb + d0 * 2048);
    const bf16x8 b1 = *reinterpret_cast<const bf16x8*>(kb + d0 * 2048 + 512);
    if (d0 == 0) { p0 = __builtin_amdgcn_mfma_f32_32x32x16_bf16(b0, qr[0], negm, 0, 0, 0); p1 = __builtin_amdgcn_mfma_f32_32x32x16_bf16(b1, qr[0], negm, 0, 0, 0); }
    else { p0 = __builtin_amdgcn_mfma_f32_32x32x16_bf16(b0, qr[d0], p0, 0, 0, 0); p1 = __builtin_amdgcn_mfma_f32_32x32x16_bf16(b1, qr[d0], p1, 0, 0, 0); } }
}
typedef __attribute__((address_space(3))) const char* lds_cptr;
typedef short v4i16_t __attribute__((ext_vector_type(4)));
__device__ __forceinline__ void kload8(bf16x8* kf, lds_cptr kp) {
  kf[0] = *(const LAS bf16x8*)(kp);        kf[1] = *(const LAS bf16x8*)(kp + 512);
  kf[2] = *(const LAS bf16x8*)(kp + 2048); kf[3] = *(const LAS bf16x8*)(kp + 2560);
  kf[4] = *(const LAS bf16x8*)(kp + 4096); kf[5] = *(const LAS bf16x8*)(kp + 4608);
  kf[6] = *(const LAS bf16x8*)(kp + 6144); kf[7] = *(const LAS bf16x8*)(kp + 6656);
}
__device__ __forceinline__ void kload2(bf16x8* kf, lds_cptr kp, int j) { kf[2 * j] = *(const LAS bf16x8*)(kp + j * 2048); kf[2 * j + 1] = *(const LAS bf16x8*)(kp + j * 2048 + 512); }
__device__ __forceinline__ s16x4 vtr(lds_cptr p) { return __builtin_bit_cast(s16x4, __builtin_amdgcn_ds_read_tr16_b64_v4i16((LAS v4i16_t*)p)); }
__device__ __forceinline__ float rowmax(const f32x16& p0, const f32x16& p1) {
  float a = max3f(p0[0], p0[1], p1[0]), b = max3f(p0[2], p0[3], p1[1]); a = max3f(a, p1[2], p1[3]);
  #pragma unroll
  for (int r = 4; r < 16; r += 4) { a = max3f(a, p0[r], p0[r + 1]); b = max3f(b, p0[r + 2], p0[r + 3]); a = max3f(a, p1[r], p1[r + 1]); b = max3f(b, p1[r + 2], p1[r + 3]); }
  const float m = max2f(a, b);
  auto rr = __builtin_amdgcn_permlane32_swap(__float_as_uint(m), __float_as_uint(m), false, false);
  return max2f(__uint_as_float(rr[0]), __uint_as_float(rr[1]));
}
__device__ __forceinline__ void pv(f32x16* o, int vb, bf16x8 pa0, bf16x8 pa1, bf16x8 pa2, bf16x8 pa3) {
  #pragma unroll
  for (int d0 = 0; d0 < 2; ++d0) { s16x4 lo[4], hi[4];
    #pragma unroll
    for (int ks = 0; ks < 4; ++ks) {
      asm volatile("ds_read_b64_tr_b16 %0,%1 offset:%c2" : "=&v"(lo[ks]) : "v"(vb), "i"(d0 * 4096 + ks * 1024) : "memory");
      asm volatile("ds_read_b64_tr_b16 %0,%1 offset:%c2" : "=&v"(hi[ks]) : "v"(vb), "i"(d0 * 4096 + ks * 1024 + 512) : "memory"); }
    asm volatile("s_waitcnt lgkmcnt(0)" ::: "memory"); SBAR();
    #define PK(k) (bf16x8){lo[k][0], lo[k][1], lo[k][2], lo[k][3], hi[k][0], hi[k][1], hi[k][2], hi[k][3]}
    o[d0] = __builtin_amdgcn_mfma_f32_32x32x16_bf16(pa0, PK(0), o[d0], 0, 0, 0);
    o[d0] = __builtin_amdgcn_mfma_f32_32x32x16_bf16(pa1, PK(1), o[d0], 0, 0, 0);
    o[d0] = __builtin_amdgcn_mfma_f32_32x32x16_bf16(pa2, PK(2), o[d0], 0, 0, 0);
    o[d0] = __builtin_amdgcn_mfma_f32_32x32x16_bf16(pa3, PK(3), o[d0], 0, 0, 0);
    #undef PK
  }
}
template <int THRL> __device__ __forceinline__ void attn_unit(const bf16_t* Qu, const bf16_t* __restrict__ Kh, const bf16_t* __restrict__ Vh, bf16_t* Ou, const int NT, char* shm) {
  const int tid = tid_(), lane = tid & 63, r32 = lane & 31, hi = lane >> 5; const int wid = __builtin_amdgcn_readfirstlane(tid >> 6);
  const bf16_t* Qw = Qu + (long)wid * QBLK * QP;
  const unsigned lds0 = (unsigned)(uintptr_t)shm;
  float* wsf = (float*)(shm + LDS_WS) + wid * 64;
  const bf16_t* ksrc = Kh + (long)lane * KVP + wid * 8;
  const bf16_t* vsrc = Vh + (long)(16 * (wid & 3) + (lane >> 2)) * KVP + (wid >> 2) * 32 + (lane & 3) * 8;
  const unsigned kdst = lds0 + LDS_K + wid * 1024, vdst = lds0 + LDS_V + wid * 1024;
  #define DMA_K(t, slot) glds16(ksrc + (long)(t) * KVBLK * KVP, (unsigned)__builtin_amdgcn_readfirstlane(kdst + (slot)))
  #define DMA_V(t, slot) glds16(vsrc + (long)(t) * KVBLK * KVP, (unsigned)__builtin_amdgcn_readfirstlane(vdst + (slot)))
  const int vb0 = (int)(lds0 + LDS_V) + ((lane >> 4) & 1) * 32 + (lane & 3) * 8 + (4 * hi + ((lane & 15) >> 2)) * 64;
  const char* Kbase = shm + LDS_K; bf16x8 kf[8];
  const lds_cptr shm3 = (lds_cptr)shm; const lds_cptr kp0 = shm3 + LDS_K + hi * 1024 + r32 * 16; const lds_cptr vp0 = shm3 + LDS_V + ((lane >> 4) & 1) * 32 + (lane & 3) * 8 + (4 * hi + ((lane & 15) >> 2)) * 64;
  DMA_K(0, 0); DMA_V(0, 0); DMA_K(1, SLOTB);
  bf16x8 qr[4];
  #pragma unroll
  for (int d0 = 0; d0 < 4; ++d0) qr[d0] = *reinterpret_cast<const bf16x8*>(&Qw[(long)r32 * QP + d0 * 16 + hi * 8]);
  float mhat = 0.f, l_reg = 0.f; f32x16 o[2]; o[0] = f32x16{}; o[1] = f32x16{}; f32x16 negm = f32x16{}; asm volatile("" : "+v"(negm));
  bool resc = false;
  #define START(P0, P1) do { const float rm = rowmax(P0, P1); resc = false; \
    { const float dl = rm; mhat = fadd_s(mhat, dl); \
      _Pragma("unroll") for (int r = 0; r < 16; ++r) { P0[r] = fsub_s(P0[r], dl); P1[r] = fsub_s(P1[r], dl); } \
      _Pragma("unroll") for (int r = 0; r < 16; ++r) negm[r] = -mhat; asm volatile("" : "+v"(negm)); } \
    _Pragma("unroll") for (int r = 0; r < 16; ++r) P0[r] = __builtin_amdgcn_exp2f(P0[r]); } while (0)
  #define RESC() do { if (resc) { asm volatile("s_waitcnt lgkmcnt(0)" ::: "memory"); \
      _Pragma("unroll") for (int d_ = 0; d_ < 2; ++d_) _Pragma("unroll") for (int r = 0; r < 16; ++r) o[d_][r] *= wsf[crow(r, hi)]; } } while (0)
  f32x16 pA0, pA1, pB0, pB1;
  int sl_prev = 0, sl_cur = 0, sl_next = SLOTB;
  #define ROT() do { sl_prev = sl_cur; sl_cur = sl_next; sl_next = (sl_next == (NSLOT - 1) * SLOTB) ? 0 : sl_next + SLOTB; } while (0)
  DMA_K(2, 2 * SLOTB);
  WAIT_BAR(3);
  qkt(pA0, pA1, Kbase, qr, negm, r32, hi); asm volatile("s_nop 15\n\ts_nop 7" : "+v"(pA0), "+v"(pA1));
  START(pA0, pA1);
  _Pragma("unroll") for (int r = 0; r < 16; ++r) pA1[r] = __builtin_amdgcn_exp2f(pA1[r]);
  WAIT_BAR(0);
  DMA_K(3, 0); DMA_V(1, SLOTB);
  ROT();
  kload8(kf, kp0 + sl_cur);
  WAIT_BAR(2);
  s16x4 vlo[8], vhi[8]; u32x4 pw0, pw1, pw2, pw3;
  #define PKW(P, B) cvtpk_s(P[B], P[B + 1])
  #define PAF(k) __builtin_bit_cast(bf16x8, pw##k)
  #define VFR(i) (bf16x8){vlo[i][0], vlo[i][1], vlo[i][2], vlo[i][3], vhi[i][0], vhi[i][1], vhi[i][2], vhi[i][3]}
  #define PIN(x) asm volatile("" : "+v"(x))
  #define MX3(a, b, c) __builtin_fmaxf(__builtin_fmaxf((a), (b)), (c))
  #define GAPA(MF, A0, A1, A2, A3, W0, W1, PW) do { MF; sacc += A0; sacc += A1; sacc += A2; sacc += A3; PIN(sacc); W0; W1; PIN(PW); SBAR(); } while (0)
  #define EX(v) __builtin_amdgcn_exp2f(v)
  #define GAPB(MF, X, B) do { MF; X[B] = EX(X[B]); X[B + 1] = EX(X[B + 1]); X[B + 2] = EX(X[B + 2]); X[B + 3] = EX(X[B + 3]); PIN(X); SBAR(); } while (0)
  #define VRD(i) do { vlo[i] = vtr(vp_ + (((i) >> 2) * 4096 + ((i) & 3) * 1024)); vhi[i] = vtr(vp_ + (((i) >> 2) * 4096 + ((i) & 3) * 1024 + 512)); } while (0)
  #define KRD(G, j) do { if (G) { kload2(kf, kp0 + sl_next, j); SBAR(); } } while (0)
  #define STEP(C0, C1, P0, P1, t, GK, GV, GL) do { SBAR(); \
    const lds_cptr vp_ = vp0 + sl_prev; \
    VRD(0); SBAR(); float sacc = (P0[0] + P0[1]); \
    GAPA(C0 = __builtin_amdgcn_mfma_f32_32x32x16_bf16(kf[0], qr[0], negm, 0, 0, 0), P0[2], P0[3], P0[4], P0[5],     pw0[0] = PKW(P0, 0), pw0[1] = PKW(P0, 2), pw0); \
    VRD(4); SBAR(); GAPA(C1 = __builtin_amdgcn_mfma_f32_32x32x16_bf16(kf[1], qr[0], negm, 0, 0, 0), P0[6], P0[7], P0[8], P0[9],     pw0[2] = PKW(P0, 4), pw0[3] = PKW(P0, 6), pw0); \
    VRD(1); SBAR(); GAPA(C0 = __builtin_amdgcn_mfma_f32_32x32x16_bf16(kf[2], qr[1], C0, 0, 0, 0),   P0[10], P0[11], P0[12], P0[13], pw1[0] = PKW(P0, 8), pw1[1] = PKW(P0, 10), pw1); \
    VRD(5); SBAR(); GAPA(C1 = __builtin_amdgcn_mfma_f32_32x32x16_bf16(kf[3], qr[1], C1, 0, 0, 0),   P0[14], P0[15], P1[0], P1[1],   pw1[2] = PKW(P0, 12), pw1[3] = PKW(P0, 14), pw1); \
    VRD(2); SBAR(); GAPA(C0 = __builtin_amdgcn_mfma_f32_32x32x16_bf16(kf[4], qr[2], C0, 0, 0, 0),   P1[2], P1[3], P1[4], P1[5],     pw2[0] = PKW(P1, 0), pw2[1] = PKW(P1, 2), pw2); \
    VRD(6); SBAR(); GAPA(C1 = __builtin_amdgcn_mfma_f32_32x32x16_bf16(kf[5], qr[2], C1, 0, 0, 0),   P1[6], P1[7], P1[8], P1[9],     pw2[2] = PKW(P1, 4), pw2[3] = PKW(P1, 6), pw2); \
    VRD(3); SBAR(); GAPA(C0 = __builtin_amdgcn_mfma_f32_32x32x16_bf16(kf[6], qr[3], C0, 0, 0, 0),   P1[10], P1[11], P1[12], P1[13], pw3[0] = PKW(P1, 8), pw3[1] = PKW(P1, 10), pw3); \
    VRD(7); SBAR(); GAPA(C1 = __builtin_amdgcn_mfma_f32_32x32x16_bf16(kf[7], qr[3], C1, 0, 0, 0),   P1[14], P1[15], 0.f, 0.f,       pw3[2] = PKW(P1, 12), pw3[3] = PKW(P1, 14), pw3); \
    l_reg += sacc; \
    if (GK) { DMA_K((t) + 3, sl_cur); } if (GV) { DMA_V((t) + 1, sl_next); } \
    { float a = MX3(C0[0], C0[1], C1[0]), b = MX3(C0[2], C0[3], C1[1]); a = MX3(a, C1[2], C1[3]); \
      _Pragma("unroll") for (int r = 4; r < 16; r += 4) { a = MX3(a, C0[r], C0[r + 1]); b = MX3(b, C0[r + 2], C0[r + 3]); a = MX3(a, C1[r], C1[r + 1]); b = MX3(b, C1[r + 2], C1[r + 3]); } \
      float rm = __builtin_fmaxf(a, b); { auto rr = __builtin_amdgcn_permlane32_swap(__float_as_uint(rm), __float_as_uint(rm), false, false); rm = __builtin_fmaxf(__uint_as_float(rr[0]), __uint_as_float(rr[1])); } \
      resc = false; \
      if (__builtin_expect(__any(rm > (float)THRL), 0)) { const float dl = __builtin_fmaxf(rm, 0.f); mhat += dl; \
        _Pragma("unroll") for (int r = 0; r < 16; ++r) { C0[r] -= dl; C1[r] -= dl; } \
        _Pragma("unroll") for (int r = 0; r < 16; ++r) negm[r] = -mhat; asm volatile("" : "+v"(negm)); \
        const float f = __builtin_amdgcn_exp2f(-dl); l_reg *= f; if (hi == 0) wsf[r32] = f; resc = true; } } \
    SBAR(); \
    GAPB(o[0] = __builtin_amdgcn_mfma_f32_32x32x16_bf16(PAF(0), VFR(0), o[0], 0, 0, 0), C0, 0); \
    GAPB(o[1] = __builtin_amdgcn_mfma_f32_32x32x16_bf16(PAF(0), VFR(4), o[1], 0, 0, 0), C0, 4); \
    KRD(GL, 0); GAPB(o[0] = __builtin_amdgcn_mfma_f32_32x32x16_bf16(PAF(1), VFR(1), o[0], 0, 0, 0), C0, 8); \
    KRD(GL, 1); GAPB(o[1] = __builtin_amdgcn_mfma_f32_32x32x16_bf16(PAF(1), VFR(5), o[1], 0, 0, 0), C0, 12); \
    KRD(GL, 2); GAPB(o[0] = __builtin_amdgcn_mfma_f32_32x32x16_bf16(PAF(2), VFR(2), o[0], 0, 0, 0), C1, 0); \
    KRD(GL, 3); GAPB(o[1] = __builtin_amdgcn_mfma_f32_32x32x16_bf16(PAF(2), VFR(6), o[1], 0, 0, 0), C1, 4); \
    GAPB(o[0] = __builtin_amdgcn_mfma_f32_32x32x16_bf16(PAF(3), VFR(3), o[0], 0, 0, 0), C1, 8); \
    GAPB(o[1] = __builtin_amdgcn_mfma_f32_32x32x16_bf16(PAF(3), VFR(7), o[1], 0, 0, 0), C1, 12); \
    } while (0)
  int t = 1;
  for (; t + 5 < NT; t += 2) {
    STEP(pB0, pB1, pA0, pA1, t, true, true, true);     WAIT_BAR(2); RESC(); ROT();
    STEP(pA0, pA1, pB0, pB1, t + 1, true, true, true); WAIT_BAR(2); RESC(); ROT();
  }
  #define ENDW(tt) do { if ((tt) + 3 < NT) { WAIT_BAR(2); } else if ((tt) + 2 < NT) { WAIT_BAR(1); } else { WAIT_BAR(0); } } while (0)
  for (; t + 1 < NT; t += 2) {
    STEP(pB0, pB1, pA0, pA1, t, (t + 3 < NT), (t + 1 < NT), (t + 1 < NT));         ENDW(t);     RESC(); ROT();
    STEP(pA0, pA1, pB0, pB1, t + 1, (t + 4 < NT), (t + 2 < NT), (t + 2 < NT));     ENDW(t + 1); RESC(); ROT();
  }
  STEP(pB0, pB1, pA0, pA1, NT - 1, false, false, false); RESC();
  { float sacc = pB0[0] + pB0[1]; _Pragma("unroll") for (int r = 2; r < 16; ++r) sacc += pB0[r]; _Pragma("unroll") for (int r = 0; r < 16; ++r) sacc += pB1[r]; l_reg += sacc;
    pw0 = (u32x4){PKW(pB0, 0), PKW(pB0, 2), PKW(pB0, 4), PKW(pB0, 6)}; pw1 = (u32x4){PKW(pB0, 8), PKW(pB0, 10), PKW(pB0, 12), PKW(pB0, 14)}; pw2 = (u32x4){PKW(pB1, 0), PKW(pB1, 2), PKW(pB1, 4), PKW(pB1, 6)}; pw3 = (u32x4){PKW(pB1, 8), PKW(pB1, 10), PKW(pB1, 12), PKW(pB1, 14)};
    SBAR(); pv(o, vb0 + sl_cur, PAF(0), PAF(1), PAF(2), PAF(3)); }
  #undef PKW
  #undef PAF
  #undef VFR
  #undef PIN
  #undef MX3
  #undef GAPA
  #undef GAPB
  #undef EX
  #undef VRD
  #undef KRD
  #undef STEP
  #undef ENDW
  { auto rr = __builtin_amdgcn_permlane32_swap(__float_as_uint(l_reg), __float_as_uint(l_reg), false, false); l_reg = __uint_as_float(rr[0]) + __uint_as_float(rr[1]); }
  if (hi == 0) wsf[32 + r32] = l_reg; asm volatile("s_waitcnt lgkmcnt(0)" ::: "memory");
  float rli[16];
  #pragma unroll
  for (int r = 0; r < 16; ++r) rli[r] = __builtin_amdgcn_rcpf(wsf[32 + crow(r, hi)]);
  bf16_t* Ow = Ou + (long)wid * QBLK * OP;
  { bf16_t* stg = (bf16_t*)(shm + LDS_OST) + wid * 2048;
    #pragma unroll
    for (int r = 0; r < 16; ++r) { const int orow = crow(r, hi);
      #pragma unroll
      for (int d0 = 0; d0 < 2; ++d0) stg[orow * 64 + d0 * 32 + r32] = (bf16_t)(cvtpk_s(o[d0][r] * rli[r], 0.f) & 0xffffu); }
    asm volatile("s_waitcnt lgkmcnt(0)" ::: "memory");
    #pragma unroll
    for (int i = 0; i < 4; ++i) { const int row = i * 8 + (lane >> 3), ch = lane & 7; const u32x4 v = *(const u32x4*)(stg + row * 64 + ch * 8); *(u32x4*)(Ow + (long)row * OP + ch * 8) = v; } }
  asm volatile("s_waitcnt lgkmcnt(0)\n\ts_barrier" ::: "memory");
  #undef DMA_K
  #undef DMA_V
  #undef START
  #undef RESC
  #undef ROT
}
#undef SBAR
#undef WAIT_BAR
}

__device__ __forceinline__ void ph_prologue(const Params& P, LAS unsigned char* lds) {
    const int tid = tid_(), bid = bid_(), G = gridDim.x;
    float* mods = (float*)(P.ws + WS_MODS);
    if (bid < 48) {
        LAS float* sc = (LAS float*)lds;
        for (int i = tid; i < 9 * 1024; i += NTHR) { const float v = (i < 8192) ? P.in[I_C][i] : P.in[I_CCTX][i - 8192]; sc[i] = siluf_(v); }
        __syncthreads();
        const int l = bid / 12, col = (bid % 12) * 512 + tid;
        const float* w = P.in[I_WADA] + (size_t)l * 1024 * 6144 + col;
        float a[9];
#pragma unroll
        for (int r = 0; r < 9; ++r) a[r] = 0.f;
        for (int k = 0; k < 1024; ++k) {
            const float wv = w[(size_t)k * 6144];
#pragma unroll
            for (int r = 0; r < 9; ++r) a[r] += sc[r * 1024 + k] * wv;
        }
        const float bb = P.in[I_BADA][l * 6144 + col];
#pragma unroll
        for (int r = 0; r < 9; ++r) mods[((size_t)l * 9 + r) * 6144 + col] = a[r] + bb;
    } else if (bid == 48) {
        float* lbv = (float*)(P.ws + WS_LB);
        for (int i = tid; i < 1024; i += NTHR) {
            float lg[DEPTH], mx = -1e30f;
#pragma unroll
            for (int l = 0; l < DEPTH; ++l) { lg[l] = P.in[I_LBL][l * 1024 + i]; mx = fmaxf(mx, lg[l]); }
            float s = 0.f;
#pragma unroll
            for (int l = 0; l < DEPTH; ++l) { lg[l] = expf(lg[l] - mx); s += lg[l]; }
            float cum = 0.f;
#pragma unroll
            for (int l = 0; l < DEPTH; ++l) { if (l > 0) cum += lg[l] / s; lbv[l * 1024 + i] = cum; }
        }
        float* rope = (float*)(P.ws + WS_ROPE);
        for (int i = tid; i < 96 * 16; i += NTHR) {
            const int pos = i >> 4, fi = i & 15;
            const float inv = powf(10000.0f, -(float)fi / 16.0f);
            const float p = (pos < 32) ? (float)pos : (float)(pos - 32);
            const float ang = p * inv;
            if (pos < 32) { rope[pos * 16 + fi] = cosf(ang); rope[512 + pos * 16 + fi] = sinf(ang); }
            else { rope[1024 + (pos - 32) * 16 + fi] = cosf(ang); rope[2048 + (pos - 32) * 16 + fi] = sinf(ang); }
        }
    }
    float4* xr = (float4*)(P.ws + WS_X);
    const float4* xs = (const float4*)P.in[I_X]; const float4* cs = (const float4*)P.in[I_CTX];
    const size_t nx4 = (size_t)NLAT * D / 4, nc4 = (size_t)NCTX * D / 4;
    for (size_t i = (size_t)bid * NTHR + tid; i < nx4 + nc4; i += (size_t)G * NTHR) xr[i] = (i < nx4) ? xs[i] : cs[i - nx4];
}

__device__ __forceinline__ void conv_tile(LAS float* t, const float* srcA, const float* srcB, int ld, bool inter, bf16_t* dst, int K, int n0, int k0) {
    const int tid = tid_();
    {
        const int nn = tid & 63, kk = tid >> 6, n = n0 + nn;
        const float* cp;
        if (!inter) cp = srcA + n; else { const int g = n >> 5, i = n & 31; cp = (i < 16) ? (srcA + 16 * g + i) : (srcB + 16 * g + i - 16); }
#pragma unroll
        for (int p = 0; p < 8; ++p) { const int k = kk + 8 * p; t[k * 65 + nn] = cp[(size_t)(k0 + k) * ld]; }
    }
    __syncthreads();
    {
        const int n = tid >> 3, k8 = (tid & 7) * 8;
        float v[8];
#pragma unroll
        for (int j = 0; j < 8; ++j) v[j] = t[(k8 + j) * 65 + n];
        uint4 o; o.x = pk_bf16(v[0], v[1]); o.y = pk_bf16(v[2], v[3]); o.z = pk_bf16(v[4], v[5]); o.w = pk_bf16(v[6], v[7]);
        *(uint4*)(dst + (size_t)(n0 + n) * K + k0 + k8) = o;
    }
    __syncthreads();
}
__device__ __forceinline__ void ph_wconv(const Params& P, LAS unsigned char* lds, int l) {
    LAS float* t = (LAS float*)lds;
    const int bid = bid_(), G = gridDim.x;
    constexpr int T_IN = 16 * 124, T_BR = 3 * 8 * 16, T_OUT = 16 * 16, T_GU = 16 * 16 * 16, T_DN = 16 * 8 * 16;
    constexpr int TOT = T_IN + T_BR + T_OUT + T_GU + T_DN;
    for (int u = bid; u < TOT; u += G) {
        int v = u;
        if (v < T_IN) { const int kt = v % 16, nt = v / 16;
            conv_tile(t, P.in[I_WIN] + (size_t)l * 1024 * INC, nullptr, INC, false, (bf16_t*)(P.ws + WS_WIN), 1024, nt * 64, kt * 64); continue; }
        v -= T_IN;
        if (v < T_BR) { const int i = v / 128, w = v % 128, kt = w % 8, nt = w / 8;
            conv_tile(t, P.in[I_WBR] + ((size_t)l * 3 + i) * 512 * 1024, nullptr, 1024, false, (bf16_t*)(P.ws + WS_WBR) + (size_t)i * 1024 * 512, 512, nt * 64, kt * 64); continue; }
        v -= T_BR;
        if (v < T_OUT) { const int kt = v % 16, nt = v / 16;
            conv_tile(t, P.in[I_WOUT] + (size_t)l * 1024 * 1024, nullptr, 1024, false, (bf16_t*)(P.ws + WS_WOUT), 1024, nt * 64, kt * 64); continue; }
        v -= T_OUT;
        if (v < T_GU) { const int e = v / 256, w = v % 256, kt = w % 16, nt = w / 16;
            const size_t eo = ((size_t)l * NEXP + e) * 1024 * 512;
            conv_tile(t, P.in[I_WEG] + eo, P.in[I_WEU] + eo, 512, true, (bf16_t*)(P.ws + WS_WGU) + (size_t)e * 1024 * 1024, 1024, nt * 64, kt * 64); continue; }
        v -= T_GU;
        { const int e = v / 128, w = v % 128, kt = w % 8, nt = w / 8;
            conv_tile(t, P.in[I_WED] + ((size_t)l * NEXP + e) * 512 * 1024, nullptr, 1024, false, (bf16_t*)(P.ws + WS_WDN) + (size_t)e * 1024 * 512, 512, nt * 64, kt * 64); }
    }
}

__device__ __forceinline__ void norm_row(const float4 (&x)[4], const float* g, const float* shift, const float* scale, int lane, float4 (&o)[4]) {
    float ss = 0.f;
#pragma unroll
    for (int i = 0; i < 4; ++i) ss += x[i].x * x[i].x + x[i].y * x[i].y + x[i].z * x[i].z + x[i].w * x[i].w;
    ss = wave_sum(ss);
    const float rstd = 1.0f / sqrtf(ss * (1.0f / 1024.0f) + 1e-6f);
#pragma unroll
    for (int i = 0; i < 4; ++i) {
        const int c = lane * 4 + 256 * i;
        const float4 gv = *(const float4*)(g + c), sh = *(const float4*)(shift + c), sc = *(const float4*)(scale + c);
        o[i].x = x[i].x * rstd * gv.x * (1.0f + sc.x) + sh.x;
        o[i].y = x[i].y * rstd * gv.y * (1.0f + sc.y) + sh.y;
        o[i].z = x[i].z * rstd * gv.z * (1.0f + sc.z) + sh.z;
        o[i].w = x[i].w * rstd * gv.w * (1.0f + sc.w) + sh.w;
    }
}
__device__ __forceinline__ int row_modrow(int r) { return r < NLAT ? (r >> 11) : 8; }

__device__ __forceinline__ void ph_norm1(const Params& P, int l) {
    const int tid = tid_(), lane = tid & 63, wid = tid >> 6;
    const float* xres = (const float*)(P.ws + WS_X);
    bf16_t* h = (bf16_t*)(P.ws + WS_H);
    const float* g = P.in[I_GMIX] + l * 1024;
    for (int r = bid_() * 8 + wid; r < NTOK; r += gridDim.x * 8) {
        const float* mod = (const float*)(P.ws + WS_MODS) + ((size_t)l * 9 + row_modrow(r)) * 6144;
        float4 x[4], o[4];
#pragma unroll
        for (int i = 0; i < 4; ++i) x[i] = *(const float4*)(xres + (size_t)r * D + lane * 4 + 256 * i);
        norm_row(x, g, mod, mod + 1024, lane, o);
#pragma unroll
        for (int i = 0; i < 4; ++i) { uint2 u; u.x = pk_bf16(o[i].x, o[i].y); u.y = pk_bf16(o[i].z, o[i].w); *(uint2*)(h + (size_t)r * D + lane * 4 + 256 * i) = u; }
    }
}

struct EpiStoreBf16 { bf16_t* O; int ldc;
    __device__ __forceinline__ void operator()(int row, int col, const f32x4& v0, const f32x4& v1) const {
        uint2 a, b; a.x = pk_bf16(v0[0], v0[1]); a.y = pk_bf16(v0[2], v0[3]); b.x = pk_bf16(v1[0], v1[1]); b.y = pk_bf16(v1[2], v1[3]);
        *(uint2*)(O + (size_t)row * ldc + col) = a; *(uint2*)(O + (size_t)row * ldc + col + 16) = b; } };
struct FStoreBf16 { bf16_t* O; int ldc;
    __device__ __forceinline__ void operator()(const pg8::Unit&, int row, int col, const f32x4& v0, const f32x4& v1) const {
        uint2 a, b; a.x = pk_bf16(v0[0], v0[1]); a.y = pk_bf16(v0[2], v0[3]); b.x = pk_bf16(v1[0], v1[1]); b.y = pk_bf16(v1[2], v1[3]);
        *(uint2*)(O + (size_t)row * ldc + col) = a; *(uint2*)(O + (size_t)row * ldc + col + 16) = b; } };
__device__ __forceinline__ void ph_g1(const Params& P, LAS unsigned char* lds) {
    pg8::SchedDense S{NTOK / 256, INC / 256, (int)gridDim.x, bid_(), (const char*)(P.ws + WS_H), (const char*)(P.ws + WS_WIN), (size_t)256 * D * 2, (size_t)256 * D * 2};
    pg8::EpiPair<FStoreBf16> E{{(bf16_t*)(P.ws + WS_Z), INC}};
    pg8::gemm_phase(lds, pg8::Gemm{D, D, D}, S, E);
}

__device__ __forceinline__ int kvrow(int r) { return r < NLAT ? ((r >> 11) * 2304 + 256 + (r & 2047)) : (((r - NLAT) >> 8) * 2304 + ((r - NLAT) & 255)); }
__device__ __forceinline__ void ph_prep(const Params& P, int l) {
    const int tid = tid_(), lane = tid & 63, wid = tid >> 6;
    const bf16_t* z = (const bf16_t*)(P.ws + WS_Z);
    bf16_t* qn = (bf16_t*)(P.ws + WS_QN); bf16_t* kn = (bf16_t*)(P.ws + WS_KN); bf16_t* vn = (bf16_t*)(P.ws + WS_VN);
    const float* rope = (const float*)(P.ws + WS_ROPE);
    const float gq = P.in[I_QNG][l * 64 + lane] * (0.125f * 1.4426950408889634f), gk = P.in[I_KNG][l * 64 + lane];
    for (int r = bid_() * 8 + wid; r < NTOK; r += gridDim.x * 8) {
        const bool lat = r < NLAT;
        const size_t kr = (size_t)kvrow(r);
        float cs = 1.f, sn = 0.f;
        if (lat) { const int t = r & 2047, fi = lane & 15;
            if (lane < 32) { const int pr = t >> 6; cs = rope[pr * 16 + fi]; sn = rope[512 + pr * 16 + fi]; }
            else { const int pc = t & 63; cs = rope[1024 + pc * 16 + fi]; sn = rope[2048 + pc * 16 + fi]; } }
        const float sgn = (lane & 16) ? 1.f : -1.f;
#pragma unroll
        for (int hh = 0; hh < 10; ++hh) {
            const int col = (hh < 8) ? (C_GQ + hh * 64) : (C_GK + (hh - 8) * 64);
            const float x = bf2f(z[(size_t)r * INC + col + lane]);
            const float ss = wave_sum(x * x);
            const float xn = x * (1.0f / sqrtf(ss * (1.0f / 64.0f) + 1e-6f)) * (hh < 8 ? gq : gk);
            const float pa = __shfl_xor(xn, 16, 64);
            const float o = xn * cs + sgn * pa * sn;
            const bf16_t ob = (bf16_t)(pk_bf16(o, 0.f) & 0xffffu);
            if (hh < 8) qn[(size_t)r * 512 + hh * 64 + lane] = ob; else kn[kr * 128 + (hh - 8) * 64 + lane] = ob;
        }
        *(unsigned*)(vn + kr * 128 + lane * 2) = *(const unsigned*)(z + (size_t)r * INC + C_GV + lane * 2);
    }
}

__device__ __forceinline__ void ph_navt(const Params& P, LAS unsigned char* lds) {
    const int tid = tid_();
    const bf16_t* z = (const bf16_t*)(P.ws + WS_Z); bf16_t* vt = (bf16_t*)(P.ws + WS_NAVT);
    constexpr int PT = 1040;
    for (int u = bid_(); u < NB * 36; u += gridDim.x) {
        const int b = u / 36, tl = u % 36;
        const int row0 = (tl < 4) ? (NLAT + b * 256 + tl * 64) : (b * 2048 + (tl - 4) * 64);
        __syncthreads();
#pragma unroll
        for (int i = 0; i < 8; ++i) { const int ch = tid + i * NTHR, rr = ch >> 6, cc = ch & 63;
            const uint4 v = *(const uint4*)(z + (size_t)(row0 + rr) * INC + C_NAV + cc * 8);
            *(LAS u32x4*)(lds + rr * PT + cc * 16) = (u32x4){v.x, v.y, v.z, v.w}; }
        __syncthreads();
#pragma unroll
        for (int i = 0; i < 8; ++i) { const int c = tid, tg = i;
            unsigned short e[8];
#pragma unroll
            for (int k = 0; k < 8; ++k) e[k] = *(const LAS unsigned short*)(lds + (tg * 8 + k) * PT + c * 2);
            uint4 o; o.x = e[0] | ((unsigned)e[1] << 16); o.y = e[2] | ((unsigned)e[3] << 16); o.z = e[4] | ((unsigned)e[5] << 16); o.w = e[6] | ((unsigned)e[7] << 16);
            *(uint4*)(vt + ((size_t)(b * 8 + (c >> 6)) * 64 + (c & 63)) * 2304 + tl * 64 + tg * 8) = o; }
    }
    __syncthreads();
}

#ifdef DIAG
__device__ __forceinline__ void load_q64(float (&q)[64], const bf16_t* p) {
#pragma unroll
    for (int i = 0; i < 8; ++i) { const uint4 u = ((const uint4*)p)[i];
        q[8 * i + 0] = bf_lo(u.x); q[8 * i + 1] = bf_hi(u.x); q[8 * i + 2] = bf_lo(u.y); q[8 * i + 3] = bf_hi(u.y);
        q[8 * i + 4] = bf_lo(u.z); q[8 * i + 5] = bf_hi(u.z); q[8 * i + 6] = bf_lo(u.w); q[8 * i + 7] = bf_hi(u.w); }
}
__device__ __forceinline__ void attn_key(const float (&q)[64], const bf16_t* kp, const bf16_t* vp, float bias, float& m, float& lsum, float (&o)[64]) {
    float s = 0.f;
#pragma unroll
    for (int i = 0; i < 8; ++i) { const uint4 u = ((const uint4*)kp)[i];
        s += q[8 * i + 0] * bf_lo(u.x) + q[8 * i + 1] * bf_hi(u.x) + q[8 * i + 2] * bf_lo(u.y) + q[8 * i + 3] * bf_hi(u.y)
           + q[8 * i + 4] * bf_lo(u.z) + q[8 * i + 5] * bf_hi(u.z) + q[8 * i + 6] * bf_lo(u.w) + q[8 * i + 7] * bf_hi(u.w); }
    s = s * 0.125f + bias;
    const float mn = fmaxf(m, s), corr = __expf(m - mn), pp = __expf(s - mn);
    lsum = lsum * corr + pp; m = mn;
#pragma unroll
    for (int i = 0; i < 8; ++i) { const uint4 u = ((const uint4*)vp)[i];
        o[8 * i + 0] = o[8 * i + 0] * corr + pp * bf_lo(u.x); o[8 * i + 1] = o[8 * i + 1] * corr + pp * bf_hi(u.x);
        o[8 * i + 2] = o[8 * i + 2] * corr + pp * bf_lo(u.y); o[8 * i + 3] = o[8 * i + 3] * corr + pp * bf_hi(u.y);
        o[8 * i + 4] = o[8 * i + 4] * corr + pp * bf_lo(u.z); o[8 * i + 5] = o[8 * i + 5] * corr + pp * bf_hi(u.z);
        o[8 * i + 6] = o[8 * i + 6] * corr + pp * bf_lo(u.w); o[8 * i + 7] = o[8 * i + 7] * corr + pp * bf_hi(u.w); }
}
__device__ __forceinline__ void store_o64(const float (&o)[64], float inv, bf16_t* p) {
#pragma unroll
    for (int i = 0; i < 8; ++i) { uint4 u;
        u.x = pk_bf16(o[8 * i + 0] * inv, o[8 * i + 1] * inv); u.y = pk_bf16(o[8 * i + 2] * inv, o[8 * i + 3] * inv);
        u.z = pk_bf16(o[8 * i + 4] * inv, o[8 * i + 5] * inv); u.w = pk_bf16(o[8 * i + 6] * inv, o[8 * i + 7] * inv);
        ((uint4*)p)[i] = u; }
}
__device__ __forceinline__ void na_thread(const Params& P, int l, int r, int h, bf16_t* br, int OPN) {
    const bf16_t* z = (const bf16_t*)(P.ws + WS_Z);
    float q[64], o[64]; float m = -INFINITY, ls = 0.f;
#pragma unroll
    for (int i = 0; i < 64; ++i) o[i] = 0.f;
    load_q64(q, z + (size_t)r * INC + C_NAQ + h * 64);
    int b;
    if (r < NLAT) {
        b = r >> 11; const int t = r & 2047, qr = t >> 6, qc = t & 63;
        const int r0 = min(max(qr - 4, 0), 24), c0 = min(max(qc - 8, 0), 48);
        const float* rpb = P.in[I_RPB] + ((size_t)l * 8 + h) * 15 * 31;
        for (int kr = r0; kr < r0 + 8; ++kr)
            for (int kc = c0; kc < c0 + 16; ++kc) {
                const size_t krow = (size_t)(b * 2048 + kr * 64 + kc) * INC;
                attn_key(q, z + krow + C_NAK + h * 64, z + krow + C_NAV + h * 64, rpb[(kr - qr + 7) * 31 + (kc - qc + 15)], m, ls, o);
            }
    } else b = (r - NLAT) >> 8;
    for (int j = 0; j < 256; ++j) {
        const size_t krow = (size_t)(NLAT + b * 256 + j) * INC;
        attn_key(q, z + krow + C_NAK + h * 64, z + krow + C_NAV + h * 64, 0.f, m, ls, o);
    }
    store_o64(o, 1.0f / ls, br + (size_t)r * OPN + h * 64);
}
#endif
namespace na {
constexpr int KP = 144, VP = 528;
constexpr int L_K = 0, L_V = 256 * KP, L_B = L_V + 64 * VP, L_END = L_B + 480 * 4;
constexpr float C2 = 0.125f * 1.4426950408889634f, LOG2E = 1.4426950408889634f;
struct Acc { float m, l; f32x4 o[4]; };
template <class VF> __device__ __forceinline__ void absorb(Acc& A, f32x4 (&sa)[4], f32x4 (&sb)[4], const VF& vf) {
    float mx = -INFINITY;
#pragma unroll
    for (int g = 0; g < 4; ++g)
#pragma unroll
        for (int j = 0; j < 4; ++j) mx = fmaxf(mx, fmaxf(sa[g][j], sb[g][j]));
    mx = fmaxf(mx, __shfl_xor(mx, 16, 64)); mx = fmaxf(mx, __shfl_xor(mx, 32, 64));
    const float mn = fmaxf(A.m, mx), corr = __builtin_amdgcn_exp2f(A.m - mn);
    A.m = mn;
    float ps = 0.f;
    bf16x8 pf[4];
#pragma unroll
    for (int g = 0; g < 4; ++g) { float p[8];
#pragma unroll
        for (int j = 0; j < 4; ++j) { p[j] = __builtin_amdgcn_exp2f(sa[g][j] - mn); p[4 + j] = __builtin_amdgcn_exp2f(sb[g][j] - mn); ps += p[j] + p[4 + j]; }
        pf[g] = pack8(p); }
    A.l = A.l * corr + ps;
#pragma unroll
    for (int db = 0; db < 4; ++db) A.o[db] *= corr;
#pragma unroll
    for (int g = 0; g < 4; ++g)
#pragma unroll
        for (int db = 0; db < 4; ++db) A.o[db] = __builtin_amdgcn_mfma_f32_16x16x32_bf16(vf(g, db), pf[g], A.o[db], 0, 0, 0);
}
}
__device__ __forceinline__ void na_unit(const Params& P, LAS unsigned char* lds, int l, int u, bf16_t* br, int OPN) {
    const int tid = tid_(), lane = tid & 63, wid = __builtin_amdgcn_readfirstlane(tid >> 6), c16 = lane & 15, kq = lane >> 4;
    const bool latu = u < 256;
    const int bh = latu ? (u >> 2) : (u - 256), b = bh >> 3, h = bh & 7, q4 = u & 3;
    const bf16_t* z = (const bf16_t*)(P.ws + WS_Z); const bf16_t* vt = (const bf16_t*)(P.ws + WS_NAVT) + (size_t)bh * 64 * 2304;
    LAS unsigned char* KL = lds + na::L_K; LAS unsigned char* VL = lds + na::L_V; LAS float* BL = (LAS float*)(lds + na::L_B);
    __syncthreads();
#pragma unroll
    for (int i = 0; i < 4; ++i) { const int ch = tid + i * NTHR, rr = ch >> 3, cc = ch & 7;
        const uint4 v = *(const uint4*)(z + (size_t)(NLAT + b * 256 + rr) * INC + C_NAK + h * 64 + cc * 8);
        *(LAS u32x4*)(KL + rr * na::KP + cc * 16) = (u32x4){v.x, v.y, v.z, v.w}; }
#pragma unroll
    for (int i = 0; i < 4; ++i) { const int ch = tid + i * NTHR, rr = ch >> 5, cc = ch & 31;
        const uint4 v = *(const uint4*)(vt + (size_t)rr * 2304 + cc * 8);
        *(LAS u32x4*)(VL + rr * na::VP + cc * 16) = (u32x4){v.x, v.y, v.z, v.w}; }
    if (tid < 465) BL[tid] = P.in[I_RPB][((size_t)l * 8 + h) * 465 + tid] * na::LOG2E;
    __syncthreads();
    const int sA = 8 * (c16 >> 2) + (c16 & 3);
    const int ntask = latu ? 4 : 2;
    for (int it = 0; it < ntask; ++it) {
        const int tk = it * 8 + wid;
        int qrow, r = 0, jb = 0;
        if (latu) { r = q4 * 8 + (tk >> 2); jb = tk & 3; qrow = b * 2048 + r * 64 + jb * 16 + c16; }
        else qrow = NLAT + b * 256 + tk * 16 + c16;
        bf16x8 qf[2];
#pragma unroll
        for (int ks = 0; ks < 2; ++ks) qf[ks] = *(const bf16x8*)(z + (size_t)qrow * INC + C_NAQ + h * 64 + 32 * ks + 8 * kq);
        bf16_t* op = br + (size_t)qrow * OPN + h * 64 + 4 * kq; asm volatile("" : "+v"(op));
        na::Acc A; A.m = -INFINITY; A.l = 0.f;
#pragma unroll
        for (int db = 0; db < 4; ++db) A.o[db] = (f32x4){0.f, 0.f, 0.f, 0.f};
        if (latu) {
            const int r0 = min(max(r - 4, 0), 24), kc0 = min(max(jb * 16 - 8, 0), 32), qc = jb * 16 + c16, c0 = min(max(qc - 8, 0), 48);
            int dcol[8]; bool ok[8];
#pragma unroll
            for (int j = 0; j < 8; ++j) { const int kc = kc0 + 8 * kq + j; ok[j] = (kc >= c0) && (kc < c0 + 16); dcol[j] = ok[j] ? (kc - qc + 15) : 0; }
#pragma unroll 1
            for (int ch = 0; ch < 2; ++ch) {
                f32x4 sa[4], sb[4];
                const size_t tokbase = (size_t)b * 2048 + (size_t)(r0 + ch * 4) * 64 + kc0;
#pragma unroll
                for (int g = 0; g < 4; ++g) {
                    const bf16_t* kp = z + (tokbase + (size_t)g * 64 + sA) * INC + C_NAK + h * 64 + 8 * kq;
                    const bf16x8 kA0 = *(const bf16x8*)kp, kA1 = *(const bf16x8*)(kp + 32), kB0 = *(const bf16x8*)(kp + 4 * INC), kB1 = *(const bf16x8*)(kp + 4 * INC + 32);
                    f32x4 a = {0.f, 0.f, 0.f, 0.f}, bq = {0.f, 0.f, 0.f, 0.f};
                    a = __builtin_amdgcn_mfma_f32_16x16x32_bf16(kA0, qf[0], a, 0, 0, 0); a = __builtin_amdgcn_mfma_f32_16x16x32_bf16(kA1, qf[1], a, 0, 0, 0);
                    bq = __builtin_amdgcn_mfma_f32_16x16x32_bf16(kB0, qf[0], bq, 0, 0, 0); bq = __builtin_amdgcn_mfma_f32_16x16x32_bf16(kB1, qf[1], bq, 0, 0, 0);
                    const int brow = (r0 + ch * 4 + g - r + 7) * 31;
#pragma unroll
                    for (int j = 0; j < 4; ++j) {
                        sa[g][j] = ok[j] ? (a[j] * na::C2 + BL[brow + dcol[j]]) : -INFINITY;
                        sb[g][j] = ok[4 + j] ? (bq[j] * na::C2 + BL[brow + dcol[4 + j]]) : -INFINITY; }
                }
                const bf16_t* vp = vt + (size_t)c16 * 2304 + 256 + (r0 + ch * 4) * 64 + kc0 + 8 * kq;
                na::absorb(A, sa, sb, [&](int g, int db) { return *(const bf16x8*)(vp + (size_t)db * 16 * 2304 + g * 64); });
            }
        }
#pragma unroll 1
        for (int ch = 0; ch < 2; ++ch) {
            f32x4 sa[4], sb[4];
#pragma unroll
            for (int g = 0; g < 4; ++g) {
                const LAS unsigned char* kp = KL + (ch * 128 + g * 32 + sA) * na::KP + kq * 16;
                const bf16x8 kA0 = *(const LAS bf16x8*)kp, kA1 = *(const LAS bf16x8*)(kp + 64), kB0 = *(const LAS bf16x8*)(kp + 4 * na::KP), kB1 = *(const LAS bf16x8*)(kp + 4 * na::KP + 64);
                f32x4 a = {0.f, 0.f, 0.f, 0.f}, bq = {0.f, 0.f, 0.f, 0.f};
                a = __builtin_amdgcn_mfma_f32_16x16x32_bf16(kA0, qf[0], a, 0, 0, 0); a = __builtin_amdgcn_mfma_f32_16x16x32_bf16(kA1, qf[1], a, 0, 0, 0);
                bq = __builtin_amdgcn_mfma_f32_16x16x32_bf16(kB0, qf[0], bq, 0, 0, 0); bq = __builtin_amdgcn_mfma_f32_16x16x32_bf16(kB1, qf[1], bq, 0, 0, 0);
                sa[g] = a * na::C2; sb[g] = bq * na::C2;
            }
            const LAS unsigned char* vp = VL + c16 * na::VP + (ch * 128 + 8 * kq) * 2;
            na::absorb(A, sa, sb, [&](int g, int db) { return *(const LAS bf16x8*)(vp + db * 16 * na::VP + g * 64); });
        }
        float ls = A.l; ls += __shfl_xor(ls, 16, 64); ls += __shfl_xor(ls, 32, 64);
        const float inv = 1.0f / ls;
#pragma unroll
        for (int db = 0; db < 4; ++db) { uint2 o; o.x = pk_bf16(A.o[db][0] * inv, A.o[db][1] * inv); o.y = pk_bf16(A.o[db][2] * inv, A.o[db][3] * inv);
            *(uint2*)(op + 16 * db) = o; }
    }
}
__device__ __forceinline__ int hg_row(int b, int dir, int s) { return s < 256 ? (NLAT + b * 256 + (dir ? 255 - s : s)) : (b * 2048 + (dir ? 2047 - (s - 256) : (s - 256))); }
__device__ __forceinline__ void hgrn_unit(const Params& P, LAS unsigned char* lds, int l, int u) {
    const int tid = tid_(), lane = tid & 63, wid = __builtin_amdgcn_readfirstlane(tid >> 6), c16 = lane & 15, kq = lane >> 4;
    const int b = u >> 3, h = (u >> 1) & 3, dir = u & 1;
    const bf16_t* z = (const bf16_t*)(P.ws + WS_Z);
    float* O = (float*)(P.ws + (dir ? WS_Y : WS_H));
    const float* lbv = (const float*)(P.ws + WS_LB) + ((size_t)l * 2 + dir) * 512 + h * 128;
    constexpr int PQ = 272, PK = 80;
    LAS unsigned char* QH = lds; LAS unsigned char* KT = lds + 8704; LAS unsigned char* KH = lds + 17408; LAS unsigned char* VT = KH + 10240;
    LAS float* DL = (LAS float*)(VT + 10240); LAS float* WT = DL + 128;
    const int tt = tid >> 4, d8 = (tid & 15) * 8;
    float lb8[8];
#pragma unroll
    for (int j = 0; j < 8; ++j) lb8[j] = lbv[d8 + j];
    const int cf = (dir ? C_HFB : C_HFF) + h * 128 + d8, cq = C_HQ + h * 128 + d8, cv = C_HI + h * 128 + d8;
    f32x4 SA[4], SB[4];
#pragma unroll
    for (int G = 0; G < 4; ++G) { SA[G] = (f32x4){0.f, 0.f, 0.f, 0.f}; SB[G] = (f32x4){0.f, 0.f, 0.f, 0.f}; }
    uint4 rf, rq, rv;
    { const bf16_t* zr = z + (size_t)hg_row(b, dir, tt) * INC; rf = *(const uint4*)(zr + cf); rq = *(const uint4*)(zr + cq); rv = *(const uint4*)(zr + cv); }
    const int sA = 8 * (c16 >> 2) + (c16 & 3);
    for (int st = 0; st < 72; ++st) {
        const uint4 xf = rf, xq = rq, xv = rv;
        if (st + 1 < 72) { const bf16_t* zr = z + (size_t)hg_row(b, dir, (st + 1) * 32 + tt) * INC; rf = *(const uint4*)(zr + cf); rq = *(const uint4*)(zr + cq); rv = *(const uint4*)(zr + cv); }
        float fx[8], qx[8], g[8], kk[8];
        fx[0] = bf_lo(xf.x); fx[1] = bf_hi(xf.x); fx[2] = bf_lo(xf.y); fx[3] = bf_hi(xf.y); fx[4] = bf_lo(xf.z); fx[5] = bf_hi(xf.z); fx[6] = bf_lo(xf.w); fx[7] = bf_hi(xf.w);
        qx[0] = bf_lo(xq.x); qx[1] = bf_hi(xq.x); qx[2] = bf_lo(xq.y); qx[3] = bf_hi(xq.y); qx[4] = bf_lo(xq.z); qx[5] = bf_hi(xq.z); qx[6] = bf_lo(xq.w); qx[7] = bf_hi(xq.w);
        float bc[8];
#pragma unroll
        for (int j = 0; j < 8; ++j) {
            const float f = lb8[j] + (1.0f - lb8[j]) * sigmoidf_(fx[j]);
            g[j] = __logf(f); kk[j] = 1.0f - f; qx[j] = siluf_(qx[j]);
            float v = g[j];
            const float t1 = __shfl_up(v, 16, 64); if (lane >= 16) v += t1;
            const float t2 = __shfl_up(v, 32, 64); if (lane >= 32) v += t2;
            bc[j] = v;
        }
        if (lane >= 48) {
#pragma unroll
            for (int j = 0; j < 8; ++j) WT[wid * 128 + d8 + j] = bc[j];
        }
        __syncthreads();
        float pre[8], tot[8];
#pragma unroll
        for (int j = 0; j < 8; ++j) { pre[j] = 0.f; tot[j] = 0.f; }
#pragma unroll
        for (int w = 0; w < 8; ++w) {
            const f32x4 a0 = *(const LAS f32x4*)(WT + w * 128 + d8), a1 = *(const LAS f32x4*)(WT + w * 128 + d8 + 4);
            const float m = (w < wid) ? 1.f : 0.f;
#pragma unroll
            for (int j = 0; j < 4; ++j) { tot[j] += a0[j]; tot[4 + j] += a1[j]; pre[j] += m * a0[j]; pre[4 + j] += m * a1[j]; }
        }
        float qh[8], kt[8], kh[8];
#pragma unroll
        for (int j = 0; j < 8; ++j) { const float bb = bc[j] + pre[j];
            qh[j] = qx[j] * __expf(bb); kt[j] = kk[j] * __expf(-bb); kh[j] = kk[j] * __expf(tot[j] - bb); }
        *(LAS bf16x8*)(QH + tt * PQ + d8 * 2) = pack8(qh);
        *(LAS bf16x8*)(KT + tt * PQ + d8 * 2) = pack8(kt);
        { const unsigned vw[4] = {xv.x, xv.y, xv.z, xv.w};
#pragma unroll
          for (int j = 0; j < 8; ++j) {
            *(LAS bf16_t*)(KH + (d8 + j) * PK + tt * 2) = (bf16_t)(pk_bf16(kh[j], 0.f) & 0xffffu);
            *(LAS bf16_t*)(VT + (d8 + j) * PK + tt * 2) = (bf16_t)((j & 1) ? (vw[j >> 1] >> 16) : (vw[j >> 1] & 0xffffu)); } }
        if (tt == 0) {
#pragma unroll
            for (int j = 0; j < 8; ++j) DL[d8 + j] = __expf(tot[j]);
        }
        __syncthreads();
        const bf16x8 vfr = *(const LAS bf16x8*)(VT + (16 * wid + c16) * PK + kq * 16);
        bf16x8 Sb[4];
#pragma unroll
        for (int G = 0; G < 4; ++G) { const float sv[8] = {SA[G][0], SA[G][1], SA[G][2], SA[G][3], SB[G][0], SB[G][1], SB[G][2], SB[G][3]}; Sb[G] = pack8(sv); }
#pragma unroll
        for (int T = 0; T < 2; ++T) {
            f32x4 aA = {0.f, 0.f, 0.f, 0.f}, aB = {0.f, 0.f, 0.f, 0.f};
            bf16x8 qf[4];
#pragma unroll
            for (int ks = 0; ks < 4; ++ks) {
                const bf16x8 kA = *(const LAS bf16x8*)(KT + sA * PQ + (32 * ks + 8 * kq) * 2);
                const bf16x8 kB = *(const LAS bf16x8*)(KT + (sA + 4) * PQ + (32 * ks + 8 * kq) * 2);
                qf[ks] = *(const LAS bf16x8*)(QH + (16 * T + c16) * PQ + (32 * ks + 8 * kq) * 2);
                aA = __builtin_amdgcn_mfma_f32_16x16x32_bf16(kA, qf[ks], aA, 0, 0, 0);
                aB = __builtin_amdgcn_mfma_f32_16x16x32_bf16(kB, qf[ks], aB, 0, 0, 0);
            }
            const int t = 16 * T + c16;
            float pv_[8];
#pragma unroll
            for (int jj = 0; jj < 4; ++jj) { pv_[jj] = (8 * kq + jj <= t) ? aA[jj] : 0.f; pv_[4 + jj] = (8 * kq + 4 + jj <= t) ? aB[jj] : 0.f; }
            f32x4 o = {0.f, 0.f, 0.f, 0.f};
            o = __builtin_amdgcn_mfma_f32_16x16x32_bf16(pack8(pv_), vfr, o, 0, 0, 0);
#pragma unroll
            for (int ks = 0; ks < 4; ++ks) o = __builtin_amdgcn_mfma_f32_16x16x32_bf16(qf[ks], Sb[ks], o, 0, 0, 0);
#pragma unroll
            for (int jj = 0; jj < 4; ++jj) O[(size_t)hg_row(b, dir, st * 32 + 16 * T + 4 * kq + jj) * 512 + h * 128 + 16 * wid + c16] = o[jj];
        }
#pragma unroll
        for (int G = 0; G < 4; ++G) {
            const f32x4 d0 = *(const LAS f32x4*)(DL + 32 * G + 8 * kq), d1 = *(const LAS f32x4*)(DL + 32 * G + 8 * kq + 4);
            const bf16x8 hA = *(const LAS bf16x8*)(KH + (32 * G + sA) * PK + kq * 16);
            const bf16x8 hB = *(const LAS bf16x8*)(KH + (32 * G + sA + 4) * PK + kq * 16);
            SA[G] = __builtin_amdgcn_mfma_f32_16x16x32_bf16(hA, vfr, SA[G] * d0, 0, 0, 0);
            SB[G] = __builtin_amdgcn_mfma_f32_16x16x32_bf16(hB, vfr, SB[G] * d1, 0, 0, 0);
        }
    }
    __syncthreads();
}
__device__ __forceinline__ void gqa_unit(const Params& P, char* shm, int U) {
    const bf16_t* qn = (const bf16_t*)(P.ws + WS_QN); const bf16_t* kn = (const bf16_t*)(P.ws + WS_KN); const bf16_t* vn = (const bf16_t*)(P.ws + WS_VN);
    bf16_t* br = (bf16_t*)(P.ws + WS_BR);
    int b, hq, row0, NT;
    if (U < 512) { const int bg = U >> 5; b = bg >> 1; hq = (bg & 1) * 4 + ((U & 31) >> 3); row0 = b * 2048 + (U & 7) * 256; NT = 36; }
    else { const int v = U - 512; b = v >> 3; hq = v & 7; row0 = NLAT + b * 256; NT = 4; }
    const int g = hq >> 2;
    gqa::attn_unit<8>(qn + (size_t)row0 * 512 + hq * 64, kn + (size_t)b * 2304 * 128 + g * 64, vn + (size_t)b * 2304 * 128 + g * 64,
                      br + (size_t)row0 * BRW + 1024 + hq * 64, NT, shm);
}
__device__ __forceinline__ void ph_mix(const Params& P, LAS unsigned char* lds, char* shm, int l) {
    const int tid = tid_();
    const int G = gridDim.x, c = bid_(), vcu = (G % 8 == 0) ? (c % 8) * (G / 8) + c / 8 : c;
    for (int U = vcu; U < 512; U += G) gqa_unit(P, shm, U);
    for (int U = 512 + vcu; U < 576; U += G) gqa_unit(P, shm, U);
    __syncthreads();
    if (c < 64) hgrn_unit(P, lds, l, c);
#ifdef DIAG
    for (int u = c; u < ((DIAG == 3 || DIAG == 5) ? 0 : 288); u += G) {
        bf16_t* nb = (DIAG == 4) ? (bf16_t*)(P.ws + WS_END) : (bf16_t*)(P.ws + WS_BR); const int np = (DIAG == 4) ? 512 : BRW;
        if (u < 256) { const int idx = u * NTHR + tid; na_thread(P, l, idx >> 3, idx & 7, nb, np); }
        else { const int idx = (u - 256) * NTHR + tid; na_thread(P, l, NLAT + (idx >> 3), idx & 7, nb, np); }
    }
#if DIAG == 2
    __syncthreads();
    for (int u = vcu; u < 320; u += G) na_unit(P, lds, l, u, (bf16_t*)(P.ws + WS_BR), BRW);
#elif DIAG == 4
    for (int u = vcu; u < 320; u += G) na_unit(P, lds, l, u, (bf16_t*)(P.ws + WS_BR), BRW);
#elif DIAG == 5
#elif DIAG == 3
    for (int u = vcu; u < 320; u += G) na_unit(P, lds, l, u, (bf16_t*)(P.ws + WS_END), 512);
#else
    for (int u = vcu; u < 320; u += G) na_unit(P, lds, l, u, (bf16_t*)(P.ws + WS_END), 512);
    for (int u = vcu; u < 320; u += G) na_unit(P, lds, l, u, (bf16_t*)(P.ws + WS_END) + (size_t)NTOK * 512, 512);
#endif
#else
    for (int u = vcu; u < 320; u += G) na_unit(P, lds, l, u, (bf16_t*)(P.ws + WS_BR), BRW);
#endif
    __syncthreads();
}
#ifdef DIAG
__device__ __forceinline__ void ph_diag_cmp(const Params& P) {
    const bf16_t* br = (const bf16_t*)(P.ws + WS_BR); const bf16_t* d1 = (const bf16_t*)(P.ws + WS_END); const bf16_t* d2 = d1 + (size_t)NTOK * 512;
    const bf16_t* z = (const bf16_t*)(P.ws + WS_Z); const bf16_t* vt = (const bf16_t*)(P.ws + WS_NAVT);
    unsigned* dg = (unsigned*)(P.ws + 20480);
    unsigned c1 = 0, c2 = 0, c3 = 0;
    for (size_t i = (size_t)bid_() * NTHR + tid_(); i < (size_t)NTOK * 512; i += (size_t)gridDim.x * NTHR) {
        const size_t r = i >> 9; const int c = (int)(i & 511);
        const float a = bf2f(br[r * BRW + c]), x = bf2f(d1[i]);
        if (!(fabsf(x - a) <= 0.004f + 0.02f * fabsf(a))) ++c1;
        if (DIAG != 4 && d1[i] != d2[i]) ++c3;
        const int rr = (int)r; const int bb = rr < NLAT ? (rr >> 11) : ((rr - NLAT) >> 8); const int tok = rr < NLAT ? (256 + (rr & 2047)) : ((rr - NLAT) & 255);
        if (vt[((size_t)(bb * 8 + (c >> 6)) * 64 + (c & 63)) * 2304 + tok] != z[r * INC + C_NAV + c]) ++c2;
    }
    if (c1) atomicAdd(dg + 1, c1);
    if (c2) atomicAdd(dg + 2, c2);
    if (c3) atomicAdd(dg + 3, c3);
}
__device__ __forceinline__ void ph_diag_out(const Params& P) {
    const volatile unsigned* dg = (const volatile unsigned*)(P.ws + 20480);
    const unsigned c1 = dg[1], c2 = dg[2], c3 = dg[3];
    if ((c1 | c2 | c3) == 0) return;
    unsigned k = 0; { unsigned v = c1; while (v) { ++k; v >>= 1; } }
    if (c2) k += 30; if (c3) k += 60;
    const float cst = sqrtf(10.0f * (float)k + 9.0f);
    for (size_t i = (size_t)bid_() * NTHR + tid_(); i < (size_t)NLAT * D; i += (size_t)gridDim.x * NTHR) P.out[i] = cst;
}
#endif

__device__ __forceinline__ void ph_readout(const Params& P, int l) {
    const int tid = tid_(), lane = tid & 63, wid = tid >> 6;
    const float* OF = (const float*)(P.ws + WS_H); const float* OB = (const float*)(P.ws + WS_Y);
    const bf16_t* z = (const bf16_t*)(P.ws + WS_Z);
    bf16_t* br = (bf16_t*)(P.ws + WS_BR);
    const float g0 = P.in[I_HGN][l * 128 + lane * 2], g1 = P.in[I_HGN][l * 128 + lane * 2 + 1];
    for (int r = bid_() * 8 + wid; r < NTOK; r += gridDim.x * 8) {
#pragma unroll
        for (int h = 0; h < 4; ++h) {
            const int c = h * 128 + lane * 2;
            const float2 a = *(const float2*)(OF + (size_t)r * 512 + c), bb = *(const float2*)(OB + (size_t)r * 512 + c);
            const float o0 = a.x + bb.x, o1 = a.y + bb.y;
            const float ss = wave_sum(o0 * o0 + o1 * o1);
            const float rstd = 1.0f / sqrtf(ss * (1.0f / 128.0f) + 1e-6f);
            const unsigned gz = *(const unsigned*)(z + (size_t)r * INC + C_HG + c);
            *(unsigned*)(br + (size_t)r * BRW + 512 + c) = pk_bf16(o0 * rstd * g0 * siluf_(bf_lo(gz)), o1 * rstd * g1 * siluf_(bf_hi(gz)));
        }
    }
}
struct SchedMerge { int G, c; const char* br; const char* wb;
    __device__ __forceinline__ bool next(int i, pg8::Unit& u) const {
        const int tile = (i / 3) * G + c, bi = i % 3; if (tile >= (NTOK / 256) * 4) return false;
        const int pm = tile >> 2, pn = tile & 3;
        u.row0 = pm * 256; u.col0 = pn * 256; u.aux = bi;
        u.A = br + ((size_t)pm * 256 * BRW + bi * 512) * 2; u.B = wb + ((size_t)bi * 1024 + pn * 256) * 512 * 2; return true; } };
struct FMerge { bf16_t* Y; const bf16_t* z;
    __device__ __forceinline__ void operator()(const pg8::Unit& u, int row, int col, const f32x4& v0, const f32x4& v1) const {
        const bf16_t* gp = z + (size_t)row * INC + C_GATE + u.aux * 1024 + col;
        const uint2 g0 = *(const uint2*)gp, g1 = *(const uint2*)(gp + 16);
        uint2* y0 = (uint2*)(Y + (size_t)row * D + col); uint2* y1 = (uint2*)(Y + (size_t)row * D + col + 16);
        float a[4] = {0.f, 0.f, 0.f, 0.f}, b[4] = {0.f, 0.f, 0.f, 0.f};
        if (u.aux != 0) { const uint2 p0 = *y0, p1 = *y1;
            a[0] = bf_lo(p0.x); a[1] = bf_hi(p0.x); a[2] = bf_lo(p0.y); a[3] = bf_hi(p0.y);
            b[0] = bf_lo(p1.x); b[1] = bf_hi(p1.x); b[2] = bf_lo(p1.y); b[3] = bf_hi(p1.y); }
        a[0] += sigmoidf_(bf_lo(g0.x)) * v0[0]; a[1] += sigmoidf_(bf_hi(g0.x)) * v0[1]; a[2] += sigmoidf_(bf_lo(g0.y)) * v0[2]; a[3] += sigmoidf_(bf_hi(g0.y)) * v0[3];
        b[0] += sigmoidf_(bf_lo(g1.x)) * v1[0]; b[1] += sigmoidf_(bf_hi(g1.x)) * v1[1]; b[2] += sigmoidf_(bf_lo(g1.y)) * v1[2]; b[3] += sigmoidf_(bf_hi(g1.y)) * v1[3];
        uint2 o0, o1; o0.x = pk_bf16(a[0], a[1]); o0.y = pk_bf16(a[2], a[3]); o1.x = pk_bf16(b[0], b[1]); o1.y = pk_bf16(b[2], b[3]);
        *y0 = o0; *y1 = o1; } };
__device__ __forceinline__ void ph_merge(const Params& P, LAS unsigned char* lds) {
    SchedMerge S{(int)gridDim.x, bid_(), (const char*)(P.ws + WS_BR), (const char*)(P.ws + WS_WBR)};
    pg8::EpiPair<FMerge> E{{(bf16_t*)(P.ws + WS_Y), (const bf16_t*)(P.ws + WS_Z)}};
    pg8::gemm_phase(lds, pg8::Gemm{512, BRW, 512}, S, E);
}
struct FResid { float* X; const float* mods; int l;
    __device__ __forceinline__ void operator()(const pg8::Unit&, int row, int col, const f32x4& v0, const f32x4& v1) const {
        const float* gate = mods + ((size_t)l * 9 + row_modrow(row)) * 6144 + 2 * 1024;
        float4* p0 = (float4*)(X + (size_t)row * D + col); float4* p1 = (float4*)(X + (size_t)row * D + col + 16);
        const float4 g0 = *(const float4*)(gate + col), g1 = *(const float4*)(gate + col + 16);
        float4 a = *p0, b = *p1;
        a.x += g0.x * v0[0]; a.y += g0.y * v0[1]; a.z += g0.z * v0[2]; a.w += g0.w * v0[3];
        b.x += g1.x * v1[0]; b.y += g1.y * v1[1]; b.z += g1.z * v1[2]; b.w += g1.w * v1[3];
        *p0 = a; *p1 = b; } };
__device__ __forceinline__ void ph_wout(const Params& P, LAS unsigned char* lds, int l) {
    pg8::SchedDense S{NTOK / 256, D / 256, (int)gridDim.x, bid_(), (const char*)(P.ws + WS_Y), (const char*)(P.ws + WS_WOUT), (size_t)256 * D * 2, (size_t)256 * D * 2};
    pg8::EpiPair<FResid> E{{(float*)(P.ws + WS_X), (const float*)(P.ws + WS_MODS), l}};
    pg8::gemm_phase(lds, pg8::Gemm{D, D, D}, S, E);
}
__device__ __forceinline__ void ph_norm2_route(const Params& P, LAS unsigned char* lds, int l) {
    const int tid = tid_(), lane = tid & 63, wid = tid >> 6;
    LAS float* Wt = (LAS float*)lds;
    for (int i = tid; i < 20 * 1024; i += NTHR) { const int j = i >> 10, c = i & 1023;
        Wt[i] = (j < 4) ? P.in[I_WGR][((size_t)l * 1024 + c) * 4 + j] : P.in[I_WER][((size_t)l * 1024 + c) * 16 + (j - 4)]; }
    __syncthreads();
    const float* xres = (const float*)(P.ws + WS_X);
    bf16_t* f = (bf16_t*)(P.ws + WS_H);
    const float* g = P.in[I_GFFN] + l * 1024;
    int* cnt = (int*)(P.ws + WS_CNT) + l * 16;
    int* sel_e = (int*)(P.ws + WS_SELE); float* sel_w = (float*)(P.ws + WS_SELW); int* sel_p = (int*)(P.ws + WS_SELP);
    for (int r = bid_() * 8 + wid; r < NTOK; r += gridDim.x * 8) {
        const float* mod = (const float*)(P.ws + WS_MODS) + ((size_t)l * 9 + row_modrow(r)) * 6144;
        float4 x[4], o[4];
#pragma unroll
        for (int i = 0; i < 4; ++i) x[i] = *(const float4*)(xres + (size_t)r * D + lane * 4 + 256 * i);
        norm_row(x, g, mod + 3 * 1024, mod + 4 * 1024, lane, o);
#pragma unroll
        for (int i = 0; i < 4; ++i) { uint2 u; u.x = pk_bf16(o[i].x, o[i].y); u.y = pk_bf16(o[i].z, o[i].w); *(uint2*)(f + (size_t)r * D + lane * 4 + 256 * i) = u; }
        float lg[20];
#pragma unroll
        for (int j = 0; j < 20; ++j) {
            float s = 0.f;
#pragma unroll
            for (int i = 0; i < 4; ++i) { const f32x4 w = *(const LAS f32x4*)(Wt + j * 1024 + lane * 4 + 256 * i); s += o[i].x * w[0] + o[i].y * w[1] + o[i].z * w[2] + o[i].w * w[3]; }
            lg[j] = wave_sum(s);
        }
        if (lane == 0) {
            float gl[4]; int gi = 0;
#pragma unroll
            for (int j = 0; j < 4; ++j) gl[j] = lg[j] + P.in[I_BGR][l * 4 + j];
            float gm = gl[0];
#pragma unroll
            for (int j = 1; j < 4; ++j) if (gl[j] > gm) { gm = gl[j]; gi = j; }
            float se = 0.f;
#pragma unroll
            for (int j = 0; j < 4; ++j) se += expf(gl[j] - gm);
            const float pg = 1.0f / se;
            float el[4];
#pragma unroll
            for (int j = 0; j < 4; ++j) {
                float v = 0.f;
#pragma unroll
                for (int q = 0; q < 4; ++q) v = (gi == q) ? lg[4 + q * 4 + j] : v;
                el[j] = v + P.in[I_BER][l * 16 + gi * 4 + j];
            }
            int i0 = 0; float v0 = el[0];
#pragma unroll
            for (int j = 1; j < 4; ++j) if (el[j] > v0) { v0 = el[j]; i0 = j; }
            int i1 = -1; float v1 = -INFINITY;
#pragma unroll
            for (int j = 0; j < 4; ++j) if (j != i0 && el[j] > v1) { v1 = el[j]; i1 = j; }
            const float w0 = 1.0f / (1.0f + expf(v1 - v0)), w1 = 1.0f - w0;
            const int e0 = gi * 4 + i0, e1 = gi * 4 + i1;
            sel_e[r * 2] = e0; sel_e[r * 2 + 1] = e1;
            sel_w[r * 2] = w0 * pg; sel_w[r * 2 + 1] = w1 * pg;
            sel_p[r * 2] = atomicAdd(&cnt[e0], 1); sel_p[r * 2 + 1] = atomicAdd(&cnt[e1], 1);
        }
    }
}
__device__ __forceinline__ void moe_offsets(const int* cnt, int (&off)[17]) {
    int a = 0;
#pragma unroll
    for (int e = 0; e < 16; ++e) { off[e] = a; a += (cnt[e] + 255) & ~255; }
    off[16] = a;
}
__device__ __forceinline__ void ph_scatter(const Params& P, int l) {
    const int tid = tid_(), lane = tid & 63, wid = tid >> 6;
    const int* cnt = (const int*)(P.ws + WS_CNT) + l * 16;
    int off[17]; moe_offsets(cnt, off);
    const bf16_t* f = (const bf16_t*)(P.ws + WS_H); bf16_t* Fs = (bf16_t*)(P.ws + WS_FS);
    const int* sel_e = (const int*)(P.ws + WS_SELE); const int* sel_p = (const int*)(P.ws + WS_SELP); int* srow = (int*)(P.ws + WS_SROW);
    for (int r = bid_() * 8 + wid; r < NTOK; r += gridDim.x * 8) {
        const uint4 a = *(const uint4*)(f + (size_t)r * D + lane * 8), b = *(const uint4*)(f + (size_t)r * D + 512 + lane * 8);
#pragma unroll
        for (int k = 0; k < 2; ++k) {
            const int e = sel_e[r * 2 + k];
            int o = 0;
#pragma unroll
            for (int q = 0; q < 16; ++q) o = (e == q) ? off[q] : o;
            const int d = o + sel_p[r * 2 + k];
            *(uint4*)(Fs + (size_t)d * D + lane * 8) = a; *(uint4*)(Fs + (size_t)d * D + 512 + lane * 8) = b;
            if (lane == 0) srow[r * 2 + k] = d;
        }
    }
}
struct SchedMoe { int NM, G, c; int tfirst[16]; const char* A; const char* W; size_t tA, eW, tW;
    __device__ __forceinline__ bool next(int i, pg8::Unit& u) const {
        const int L = i * G + c; if (L >= NM * 4) return false;
        const int pm = L >> 2, pn = L & 3;
        int e = 0;
#pragma unroll
        for (int q = 1; q < 16; ++q) e += (pm >= tfirst[q]) ? 1 : 0;
        u.row0 = pm * 256; u.col0 = pn * 256; u.aux = e; u.A = A + (size_t)pm * tA; u.B = W + (size_t)e * eW + (size_t)pn * tW; return true; } };
struct FSwiglu { bf16_t* H;
    __device__ __forceinline__ void operator()(const pg8::Unit&, int row, int col, const f32x4& v0, const f32x4& v1) const {
        const int hc = ((col & ~31) >> 1) + (col & 15);
        uint2 a; a.x = pk_bf16(siluf_(v0[0]) * v1[0], siluf_(v0[1]) * v1[1]); a.y = pk_bf16(siluf_(v0[2]) * v1[2], siluf_(v0[3]) * v1[3]);
        *(uint2*)(H + (size_t)row * EH + hc) = a; } };
__device__ __forceinline__ void moe_sched(const Params& P, int l, SchedMoe& S) {
    const int* cnt = (const int*)(P.ws + WS_CNT) + l * 16;
    int a = 0;
#pragma unroll
    for (int e = 0; e < 16; ++e) { S.tfirst[e] = a; a += (cnt[e] + 255) >> 8; }
    S.NM = a; S.G = (int)gridDim.x; S.c = bid_();
}
__device__ __forceinline__ void ph_moe1(const Params& P, LAS unsigned char* lds, int l) {
    SchedMoe S; moe_sched(P, l, S);
    S.A = (const char*)(P.ws + WS_FS); S.W = (const char*)(P.ws + WS_WGU); S.tA = (size_t)256 * D * 2; S.eW = (size_t)1024 * 1024 * 2; S.tW = (size_t)256 * 1024 * 2;
    pg8::EpiPair<FSwiglu> E{{(bf16_t*)(P.ws + WS_HS)}};
    pg8::gemm_phase(lds, pg8::Gemm{1024, 1024, 1024}, S, E);
}
__device__ __forceinline__ void ph_moe2(const Params& P, LAS unsigned char* lds, int l) {
    SchedMoe S; moe_sched(P, l, S);
    S.A = (const char*)(P.ws + WS_HS); S.W = (const char*)(P.ws + WS_WDN); S.tA = (size_t)256 * EH * 2; S.eW = (size_t)1024 * 512 * 2; S.tW = (size_t)256 * 512 * 2;
    pg8::EpiPair<FStoreBf16> E{{(bf16_t*)(P.ws + WS_YS), D}};
    pg8::gemm_phase(lds, pg8::Gemm{512, 512, 512}, S, E);
}
__device__ __forceinline__ void ph_combine(const Params& P, int l) {
    const int tid = tid_(), lane = tid & 63, wid = tid >> 6;
    float* xres = (float*)(P.ws + WS_X);
    const bf16_t* Ys = (const bf16_t*)(P.ws + WS_YS);
    const float* sel_w = (const float*)(P.ws + WS_SELW); const int* srow = (const int*)(P.ws + WS_SROW);
    for (int r = bid_() * 8 + wid; r < NTOK; r += gridDim.x * 8) {
        const float* gate = (const float*)(P.ws + WS_MODS) + ((size_t)l * 9 + row_modrow(r)) * 6144 + 5 * 1024;
        const float w0 = sel_w[r * 2], w1 = sel_w[r * 2 + 1];
        const bf16_t* y0 = Ys + (size_t)srow[r * 2] * D; const bf16_t* y1 = Ys + (size_t)srow[r * 2 + 1] * D;
        float4 x[4];
        float ss = 0.f;
#pragma unroll
        for (int i = 0; i < 4; ++i) {
            const int c = lane * 4 + 256 * i;
            x[i] = *(const float4*)(xres + (size_t)r * D + c);
            const uint2 a = *(const uint2*)(y0 + c), b = *(const uint2*)(y1 + c);
            const float4 gv = *(const float4*)(gate + c);
            x[i].x += gv.x * (w0 * bf_lo(a.x) + w1 * bf_lo(b.x)); x[i].y += gv.y * (w0 * bf_hi(a.x) + w1 * bf_hi(b.x));
            x[i].z += gv.z * (w0 * bf_lo(a.y) + w1 * bf_lo(b.y)); x[i].w += gv.w * (w0 * bf_hi(a.y) + w1 * bf_hi(b.y));
            *(float4*)(xres + (size_t)r * D + c) = x[i];
            ss += x[i].x * x[i].x + x[i].y * x[i].y + x[i].z * x[i].z + x[i].w * x[i].w;
        }
        if (l == DEPTH - 1 && r < NLAT) {
            ss = wave_sum(ss);
            const float rstd = 1.0f / sqrtf(ss * (1.0f / 1024.0f) + 1e-6f);
#pragma unroll
            for (int i = 0; i < 4; ++i) {
                const int c = lane * 4 + 256 * i;
                const float4 gv = *(const float4*)(P.in[I_GFIN] + c);
                float4 o; o.x = x[i].x * rstd * gv.x; o.y = x[i].y * rstd * gv.y; o.z = x[i].z * rstd * gv.z; o.w = x[i].w * rstd * gv.w;
                *(float4*)(P.out + (size_t)r * D + c) = o;
            }
        }
    }
}

constexpr int NPH_LAYER = 12, NPH = 1 + DEPTH * NPH_LAYER;
#define CAS __attribute__((address_space(4)))
__device__ __forceinline__ const Params& kparams() { const CAS Params* k = (const CAS Params*)__builtin_amdgcn_kernarg_segment_ptr(); asm volatile("" : "+s"(k)); return *(const Params*)k; }
__global__ void __launch_bounds__(NTHR, 2) fwd(Params P_) {
    extern __shared__ __attribute__((aligned(16))) unsigned char lds_raw[];
    LAS unsigned char* lds = (LAS unsigned char*)lds_raw;
    volatile LAS unsigned* xbw = (volatile LAS unsigned*)(lds + LDS_BYTES - 16);
    if (threadIdx.x == 0) { xbw[0] = 0u; xbw[1] = 0u; xbw[2] = 0u; xbw[3] = 0u; }
    __syncthreads();
    const int lo = P_.ph_lo, hi = P_.ph_hi;
    XcdBarrier bar; bar.bar = (unsigned*)(P_.ws + WS_BAR); bar.x = 0; bar.st = xbw;
    if (hi - lo > 1) bar = xcd_barrier_post((unsigned*)(P_.ws + WS_BAR), xbw);
#ifndef PHMASK
#define PHMASK 0xFFFF
#endif
#define EN(j) ((PHMASK >> (j)) & 1)
#define IN(k) (lo <= (k) && (k) < hi)
#define SEAM(k) do { if (IN(k) && IN((k) + 1)) xcd_barrier(bar); } while (0)
    if (EN(12) && IN(0)) { ph_prologue(kparams(), lds); }
    SEAM(0);
    for (int l = 0; l < DEPTH; ++l) {
        const int p0 = 1 + l * NPH_LAYER;
        if (EN(0) && IN(p0 + 0)) { ph_wconv(kparams(), lds, l); ph_norm1(kparams(), l); }
        SEAM(p0 + 0);
        if (EN(1) && IN(p0 + 1)) ph_g1(kparams(), lds);
        SEAM(p0 + 1);
        if (EN(2) && IN(p0 + 2)) { ph_prep(kparams(), l); ph_navt(kparams(), lds); }
        SEAM(p0 + 2);
        if (EN(3) && IN(p0 + 3)) ph_mix(kparams(), lds, (char*)lds_raw, l);
        SEAM(p0 + 3);
        if (EN(4) && IN(p0 + 4)) {
#if defined(DIAG) && DIAG == 5
            { const Params& Pq = kparams(); const int G_ = gridDim.x, c_ = bid_(), vcu_ = (c_ % 8) * (G_ / 8) + c_ / 8; for (int u = vcu_; u < 320; u += G_) na_unit(Pq, lds, l, u, (bf16_t*)(Pq.ws + WS_BR), BRW); __syncthreads(); }
#endif
            ph_readout(kparams(), l);
#if defined(DIAG) && (DIAG == 1 || DIAG == 4)
            ph_diag_cmp(kparams());
#endif
#if defined(DIAG) && DIAG == 3
            { const Params& Pq = kparams(); const uint4* d1 = (const uint4*)(Pq.ws + WS_END); bf16_t* brq = (bf16_t*)(Pq.ws + WS_BR);
              for (size_t i = (size_t)bid_() * NTHR + tid_(); i < (size_t)NTOK * 64; i += (size_t)gridDim.x * NTHR) { const size_t r = i >> 6; const int c8 = (int)(i & 63) * 8; *(uint4*)(brq + r * BRW + c8) = d1[i]; } }
#endif
        }
        SEAM(p0 + 4);
        if (EN(5) && IN(p0 + 5)) ph_merge(kparams(), lds);
        SEAM(p0 + 5);
        if (EN(6) && IN(p0 + 6)) ph_wout(kparams(), lds, l);
        SEAM(p0 + 6);
        if (EN(7) && IN(p0 + 7)) ph_norm2_route(kparams(), lds, l);
        SEAM(p0 + 7);
        if (EN(8) && IN(p0 + 8)) ph_scatter(kparams(), l);
        SEAM(p0 + 8);
        if (EN(9) && IN(p0 + 9)) ph_moe1(kparams(), lds, l);
        SEAM(p0 + 9);
        if (EN(10) && IN(p0 + 10)) ph_moe2(kparams(), lds, l);
        SEAM(p0 + 10);
        if (EN(11) && IN(p0 + 11)) ph_combine(kparams(), l);
        SEAM(p0 + 11);
    }
#if defined(DIAG) && (DIAG == 1 || DIAG == 4)
    xcd_barrier(bar); ph_diag_out(kparams());
#endif
#undef IN
#undef SEAM
}

#ifndef MK_PER_PHASE
#define MK_PER_PHASE 0
#endif
extern "C" void kernel_launch(void* const* d_in, const int* in_sizes, int n_in, void* d_out, int out_size, void* d_ws, size_t ws_size, hipStream_t stream) {
    static int grid = 0;
    if (grid == 0) {
        if (n_in != 24 || out_size != NLAT * D || ws_size < WS_END + (size_t)NTOK * 2048) { fprintf(stderr, "kernel_launch: unexpected shapes (n_in %d out %d ws %zu need %zu)\n", n_in, out_size, ws_size, (size_t)WS_END); grid = -1; return; }
        int dev = 0, cus = 0, per_cu = 0;
        if (hipGetDevice(&dev) != hipSuccess || hipDeviceGetAttribute(&cus, hipDeviceAttributeMultiprocessorCount, dev) != hipSuccess) { grid = -1; return; }
        if (hipFuncSetAttribute((const void*)fwd, hipFuncAttributeMaxDynamicSharedMemorySize, LDS_BYTES) != hipSuccess) { fprintf(stderr, "kernel_launch: hipFuncSetAttribute failed\n"); grid = -1; return; }
        if (hipOccupancyMaxActiveBlocksPerMultiprocessor(&per_cu, (const void*)fwd, NTHR, LDS_BYTES) != hipSuccess || per_cu < 1) { fprintf(stderr, "kernel_launch: occupancy query says %d\n", per_cu); }
        (void)hipGetLastError();
        grid = cus;
    }
    if (grid < 0) return;
    (void)hipMemsetAsync(d_ws, 0, WS_ZERO_BYTES, stream);
    Params p{};
    for (int i = 0; i < 24; ++i) p.in[i] = (const float*)d_in[i];
    p.out = (float*)d_out; p.ws = (unsigned char*)d_ws;
#if MK_PER_PHASE
    for (int ph = 0; ph < NPH; ++ph) { p.ph_lo = ph; p.ph_hi = ph + 1; hipLaunchKernelGGL(fwd, dim3(grid), dim3(NTHR), LDS_BYTES, stream, p); }
#else
    p.ph_lo = 0; p.ph_hi = NPH; hipLaunchKernelGGL(fwd, dim3(grid), dim3(NTHR), LDS_BYTES, stream, p);
#endif
}
```

```cpp
#include <hip/hip_runtime.h>
#include <cstdio>
#include <cstdint>

#define LAS __attribute__((address_space(3)))
typedef unsigned short bf16_t;
typedef short bf16x8 __attribute__((ext_vector_type(8)));
typedef float f32x4 __attribute__((ext_vector_type(4)));
typedef unsigned u32x4 __attribute__((ext_vector_type(4)));

constexpr int D = 1024, NB = 8, SEQ = 2048, DEPTH = 4, CTXL = 256;
constexpr int NLAT = NB * SEQ, NCTX = NB * CTXL, NTOK = NLAT + NCTX;
constexpr int INC = 7936;
constexpr int C_NAQ = 0, C_NAK = 512, C_NAV = 1024, C_HQ = 1536, C_HFF = 2048, C_HFB = 2560, C_HI = 3072, C_HG = 3584,
              C_GQ = 4096, C_GK = 4608, C_GV = 4736, C_GATE = 4864;
constexpr int BRW = 1536;
constexpr int NEXP = 16, EH = 512;
constexpr int MPAD = 40960;
constexpr int NTHR = 512;
constexpr int LDS_BYTES = 147456;

constexpr size_t WS_BAR = 0;
constexpr size_t WS_CNT = 16384;
constexpr size_t WS_ZERO_BYTES = 65536;
constexpr size_t WS_MODS = 65536;
constexpr size_t WS_LB = WS_MODS + 884736;
constexpr size_t WS_ROPE = WS_LB + 16384;
constexpr size_t WS_SELE = WS_ROPE + 12288;
constexpr size_t WS_SELW = WS_SELE + 147456;
constexpr size_t WS_SELP = WS_SELW + 147456;
constexpr size_t WS_SROW = WS_SELP + 147456;
constexpr size_t WS_X = 2097152;
constexpr size_t WS_H = WS_X + (size_t)NTOK * D * 4;
constexpr size_t WS_Z = WS_H + (size_t)NTOK * D * 2;
constexpr size_t WS_BR = WS_Z + (size_t)NTOK * INC * 2;
constexpr size_t WS_Y = WS_BR + (size_t)NTOK * BRW * 2;
constexpr size_t WS_QN = WS_Y + (size_t)NTOK * D * 2;
constexpr size_t WS_KN = WS_QN + (size_t)NTOK * 512 * 2;
constexpr size_t WS_VN = WS_KN + (size_t)NTOK * 128 * 2;
constexpr size_t WS_NAVT = WS_VN + (size_t)NTOK * 128 * 2;
constexpr size_t WS_WIN = WS_NAVT + (size_t)NTOK * 512 * 2;
constexpr size_t WS_WBR = WS_WIN + (size_t)INC * D * 2;
constexpr size_t WS_WOUT = WS_WBR + (size_t)3 * D * 512 * 2;
constexpr size_t WS_WGU = WS_WOUT + (size_t)D * D * 2;
constexpr size_t WS_WDN = WS_WGU + (size_t)NEXP * 1024 * 1024 * 2;
constexpr size_t WS_END = WS_WDN + (size_t)NEXP * 1024 * 512 * 2;
constexpr size_t WS_FS = WS_Z;
constexpr size_t WS_HS = WS_FS + (size_t)MPAD * 1024 * 2;
constexpr size_t WS_YS = WS_HS + (size_t)MPAD * 512 * 2;
static_assert(WS_YS + (size_t)MPAD * 1024 * 2 <= WS_BR, "moe alias");
static_assert(WS_SROW + 147456 <= WS_X, "ctl");

#define XB_TMO      128
#define XB_XCNT(j)  (256  + 64 * (j))
#define XB_XSUB(j)  (1280 + 64 * (j))
#define XB_XGEN(j)  (2304 + 64 * (j))
#define XB_TOP      3328
#define XB_TOPGEN   3392
#define XCD_BAR_WORDS 3456
#define XB_SPIN_CAP (1u << 22)
__device__ __forceinline__ unsigned xb_ld(unsigned* p)              { return __hip_atomic_load(p, __ATOMIC_RELAXED, __HIP_MEMORY_SCOPE_AGENT); }
__device__ __forceinline__ unsigned xb_add(unsigned* p, unsigned v) { return __hip_atomic_fetch_add(p, v, __ATOMIC_RELAXED, __HIP_MEMORY_SCOPE_AGENT); }
__device__ __forceinline__ unsigned xb_xcc_id() { return (unsigned)__builtin_amdgcn_s_getreg((3 << 11) | 20) & 0xFu; }
#define XB_SPIN(cond, bar) do { unsigned _sp = 0; while (cond) { __builtin_amdgcn_s_sleep(1); \
    if ((++_sp & 255u) == 0u) { if (xb_ld(&(bar)[XB_TMO])) break; if (_sp > XB_SPIN_CAP) { atomicAdd(&(bar)[XB_TMO], 1u); break; } } } } while (0)
struct XcdBarrier { unsigned* bar; unsigned x; volatile LAS unsigned* st; };
__device__ __forceinline__ XcdBarrier xcd_barrier_post(unsigned* bar, volatile LAS unsigned* st) {
    XcdBarrier b; b.bar = bar; b.x = xb_xcc_id(); b.st = st;
    if (threadIdx.x == 0) (void)xb_add(&bar[XB_XCNT(b.x)], 1u);
    return b;
}
__device__ __forceinline__ void xcd_barrier_complete(unsigned* bar, unsigned x, unsigned& nloc, unsigned& nx) {
    const unsigned G = gridDim.x * gridDim.y * gridDim.z;
    unsigned sum, cnt, mine, sp = 0u;
    for (;;) {
        sum = 0u; cnt = 0u; mine = 0u;
#pragma unroll
        for (unsigned j = 0; j < 16; ++j) { const unsigned c = xb_ld(&bar[XB_XCNT(j)]); sum += c; cnt += (c > 0u) ? 1u : 0u; mine = (j == x) ? c : mine; }
        if (sum == G) break;
        __builtin_amdgcn_s_sleep(1);
        if ((++sp & 255u) == 0u) { if (xb_ld(&bar[XB_TMO])) break; if (sp > XB_SPIN_CAP) { atomicAdd(&bar[XB_TMO], 1u); break; } }
    }
    nloc = mine > 0u ? mine : 1u; nx = cnt > 0u ? cnt : 1u;
}
__device__ __forceinline__ void xcd_barrier(const XcdBarrier& b) {
    asm volatile("s_waitcnt vmcnt(0)" ::: "memory");
    __syncthreads();
    if (threadIdx.x == 0) {
        unsigned* bar = b.bar;
        __builtin_amdgcn_s_waitcnt(0);
        unsigned nloc = b.st[0], nx = b.st[1];
        if (nloc == 0u) { xcd_barrier_complete(bar, b.x, nloc, nx); b.st[0] = nloc; b.st[1] = nx; }
        const unsigned old = xb_add(&bar[XB_XSUB(b.x)], 1u);
        const unsigned gen = old / nloc;
        if (old + 1u == (gen + 1u) * nloc) {
            __builtin_amdgcn_fence(__ATOMIC_RELEASE, "agent");
            asm volatile("s_waitcnt vmcnt(0)" ::: "memory");
            const unsigned og = xb_add(&bar[XB_TOP], 1u);
            const unsigned tg = og / nx;
            if (og + 1u == (tg + 1u) * nx) xb_add(&bar[XB_TOPGEN], 1u);
            else XB_SPIN(xb_ld(&bar[XB_TOPGEN]) == tg, bar);
            __builtin_amdgcn_fence(__ATOMIC_ACQUIRE, "agent");
            xb_add(&bar[XB_XGEN(b.x)], 1u);
            asm volatile("s_waitcnt vmcnt(0)" ::: "memory");
        } else {
            XB_SPIN(xb_ld(&bar[XB_XGEN(b.x)]) == gen, bar);
            __builtin_amdgcn_fence(__ATOMIC_ACQUIRE, "agent");
            asm volatile("s_waitcnt vmcnt(0)" ::: "memory");
        }
    }
    __syncthreads();
}

__device__ __forceinline__ float bf_lo(unsigned u) { return __uint_as_float(u << 16); }
__device__ __forceinline__ float bf_hi(unsigned u) { return __uint_as_float(u & 0xffff0000u); }
__device__ __forceinline__ float bf2f(bf16_t b) { return __uint_as_float(((unsigned)b) << 16); }
__device__ __forceinline__ unsigned pk_bf16(float lo, float hi) { unsigned r; asm volatile("v_cvt_pk_bf16_f32 %0, %1, %2" : "=v"(r) : "v"(lo), "v"(hi)); return r; }
__device__ __forceinline__ bf16x8 pack8(const float (&v)[8]) { u32x4 u = {pk_bf16(v[0], v[1]), pk_bf16(v[2], v[3]), pk_bf16(v[4], v[5]), pk_bf16(v[6], v[7])}; return __builtin_bit_cast(bf16x8, u); }
__device__ __forceinline__ float sigmoidf_(float x) { return __builtin_amdgcn_rcpf(1.0f + __expf(-x)); }
__device__ __forceinline__ float siluf_(float x) { return x * __builtin_amdgcn_rcpf(1.0f + __expf(-x)); }
__device__ __forceinline__ float dpp_f(float v, const int ctrl_sel) {
    const int x = __float_as_int(v);
    int r;
    if (ctrl_sel == 0) r = __builtin_amdgcn_update_dpp(0, x, 0xB1, 0xF, 0xF, true);
    else if (ctrl_sel == 1) r = __builtin_amdgcn_update_dpp(0, x, 0x4E, 0xF, 0xF, true);
    else if (ctrl_sel == 2) r = __builtin_amdgcn_update_dpp(0, x, 0x141, 0xF, 0xF, true);
    else r = __builtin_amdgcn_update_dpp(0, x, 0x140, 0xF, 0xF, true);
    return __int_as_float(r);
}
__device__ __forceinline__ float wave_sum(float v) {
    v += dpp_f(v, 0); v += dpp_f(v, 1); v += dpp_f(v, 2); v += dpp_f(v, 3);
    { auto rr = __builtin_amdgcn_permlane16_swap(__float_as_uint(v), __float_as_uint(v), false, false); v = __uint_as_float(rr[0]) + __uint_as_float(rr[1]); }
    { auto rr = __builtin_amdgcn_permlane32_swap(__float_as_uint(v), __float_as_uint(v), false, false); v = __uint_as_float(rr[0]) + __uint_as_float(rr[1]); }
    return v;
}

__device__ __forceinline__ int tid_() { int t = threadIdx.x; asm volatile("" : "+v"(t)); return t; }
__device__ __forceinline__ int bid_() { int t = blockIdx.x; asm volatile("" : "+s"(t)); return t; }
#ifndef REPEAT_MASK
#define REPEAT_MASK 0
#endif
#define NREP(j) (((REPEAT_MASK >> (j)) & 1) ? 2 : 1)
struct Params {
    const float* in[24];
    float* out;
    unsigned char* ws;
    int ph_lo, ph_hi;
};
enum { I_X = 0, I_C, I_CTX, I_CCTX, I_WADA, I_BADA, I_GMIX, I_GFFN, I_WIN, I_RPB, I_LBL, I_HGN, I_QNG, I_KNG, I_WBR, I_WOUT,
       I_WGR, I_BGR, I_WER, I_BER, I_WEG, I_WEU, I_WED, I_GFIN };

__device__ __forceinline__ void g128_kloop(f32x4 (&acc)[4][4], LAS unsigned char* lds, const bf16_t* A, int lda, const bf16_t* Bt, int ldb, int K) {
    const int tid = tid_(), wid = tid >> 6, lane = tid & 63, wr = wid >> 2, wc = wid & 3, fr = lane & 15, fq = lane >> 4;
    LAS unsigned char* SA = lds; LAS unsigned char* SB = lds + 8192;
    const int srow = tid >> 2, skc = (tid & 3) * 8;
    const bf16_t* ap = A + (size_t)srow * lda + skc;
    const bf16_t* bp0 = Bt + (size_t)srow * ldb + skc;
    const bf16_t* bp1 = Bt + (size_t)(srow + 128) * ldb + skc;
    for (int k0 = 0; k0 < K; k0 += 32) {
        const uint4 va = *(const uint4*)(ap + k0);
        const uint4 vb0 = *(const uint4*)(bp0 + k0);
        const uint4 vb1 = *(const uint4*)(bp1 + k0);
        __syncthreads();
        *(LAS u32x4*)(SA + tid * 16) = (u32x4){va.x, va.y, va.z, va.w};
        *(LAS u32x4*)(SB + tid * 16) = (u32x4){vb0.x, vb0.y, vb0.z, vb0.w};
        *(LAS u32x4*)(SB + 8192 + tid * 16) = (u32x4){vb1.x, vb1.y, vb1.z, vb1.w};
        __syncthreads();
        bf16x8 At[4], Bf[4];
#pragma unroll
        for (int m = 0; m < 4; ++m) At[m] = *(const LAS bf16x8*)(SA + ((wr * 64 + m * 16 + fr) * 32 + fq * 8) * 2);
#pragma unroll
        for (int n = 0; n < 4; ++n) Bf[n] = *(const LAS bf16x8*)(SB + ((wc * 64 + n * 16 + fr) * 32 + fq * 8) * 2);
#pragma unroll
        for (int m = 0; m < 4; ++m)
#pragma unroll
            for (int n = 0; n < 4; ++n) acc[m][n] = __builtin_amdgcn_mfma_f32_16x16x32_bf16(Bf[n], At[m], acc[m][n], 0, 0, 0);
    }
}
__device__ __forceinline__ void acc_zero(f32x4 (&acc)[4][4]) {
#pragma unroll
    for (int m = 0; m < 4; ++m)
#pragma unroll
        for (int n = 0; n < 4; ++n) acc[m][n] = (f32x4){0.f, 0.f, 0.f, 0.f};
}
template <class Epi>
__device__ __forceinline__ void g128_epilogue(const f32x4 (&acc)[4][4], int row0, int col0, const Epi& E) {
    const int tid = tid_(), wid = tid >> 6, lane = tid & 63, wr = wid >> 2, wc = wid & 3, fr = lane & 15, fq = lane >> 4;
#pragma unroll
    for (int m = 0; m < 4; ++m)
#pragma unroll
        for (int n = 0; n < 4; n += 2) E(row0 + wr * 64 + m * 16 + fr, col0 + wc * 64 + n * 16 + fq * 4, acc[m][n], acc[m][n + 1]);
}


namespace pg8 {
constexpr int BM = 256, BK = 64, HALF = 128, HTB = HALF * BK * 2, STAGE_BYTES = 8 * HTB;
__device__ __forceinline__ int lds_byte(int r, int c) { const int st = (r >> 4) * 2 + (c >> 5), rr = r & 15, cc = c & 31, ob = rr * 64 + cc * 2; return st * 1024 + (ob ^ (((ob >> 9) & 1) << 5)); }
__device__ __forceinline__ void stage_rc(int b, int& R, int& C) { const int st = b / 1024, sb = b % 1024, swz = sb ^ (((sb >> 9) & 1) << 5); R = (st >> 1) * 16 + swz / 64; C = (st & 1) * 32 + (swz % 64) / 2; }
struct Unit { int row0, col0, aux; const char* A; const char* B; };
struct Gemm { int K, lda, ldb; };
template <class Epi, class Sched>
__device__ __forceinline__ void gemm_phase(LAS unsigned char* lds, const Gemm g, const Sched& S, const Epi& E) {
    const int tid = tid_(), wid = __builtin_amdgcn_readfirstlane(tid >> 6), lane = tid & 63, wr = wid >> 2, wc = wid & 3, fr = lane & 15, fq = lane >> 4;
    const int K = g.K, nt = K / BK;
    unsigned voffA[2], voffB[2];
#pragma unroll
    for (int i = 0; i < 2; ++i) { int R, C; stage_rc(tid * 16 + i * 8192, R, C);
        voffA[i] = (unsigned)(R * g.lda + C) * 2u; voffB[i] = (unsigned)(R * g.ldb + C) * 2u; }
    const size_t kstep = (size_t)(BK * 2);
    const size_t hstepA = (size_t)HALF * g.lda * 2, hstepB = (size_t)HALF * g.ldb * 2;
    const unsigned ldsw = (unsigned)wid * 1024u;
    const int aoff = lds_byte(wr * 64 + fr, fq * 8), boff = lds_byte(wc * 32 + fr, fq * 8);
#define PG8_SA(b, h) (((b) * 2 + (h)) * HTB)
#define PG8_SB(b, h) ((4 + (b) * 2 + (h)) * HTB)
#define PG8_STAGE(bufoff, gbase, voff) do { _Pragma("unroll") for (int _i = 0; _i < 2; ++_i) \
        __builtin_amdgcn_global_load_lds((const unsigned*)((const char*)(gbase) + (voff)[_i]), (LAS unsigned*)(lds + (bufoff) + ldsw + _i * 8192), 16, 0, 0); } while (0)
#define PG8_LDA(dst, b, h) do { _Pragma("unroll") for (int m = 0; m < 4; ++m) _Pragma("unroll") for (int k = 0; k < 2; ++k) dst[m][k] = *(const LAS bf16x8*)(lds + PG8_SA(b, h) + aoff + m * 2048 + k * 1024); } while (0)
#define PG8_LDB(dst, b, h) do { _Pragma("unroll") for (int n = 0; n < 2; ++n) _Pragma("unroll") for (int k = 0; k < 2; ++k) dst[n][k] = *(const LAS bf16x8*)(lds + PG8_SB(b, h) + boff + n * 2048 + k * 1024); } while (0)
#define PG8_MMA(ai, bj, At, Bt) do { __builtin_amdgcn_s_setprio(1); _Pragma("unroll") for (int m = 0; m < 4; ++m) _Pragma("unroll") for (int n = 0; n < 2; ++n) _Pragma("unroll") for (int k = 0; k < 2; ++k) \
        acc[ai][bj][m][n] = __builtin_amdgcn_mfma_f32_16x16x32_bf16(Bt[n][k], At[m][k], acc[ai][bj][m][n], 0, 0, 0); __builtin_amdgcn_s_setprio(0); } while (0)
#define PG8_WAIT_V(n) asm volatile("s_waitcnt vmcnt(" #n ")" ::: "memory")
#define PG8_WAIT_L(n) asm volatile("s_waitcnt lgkmcnt(" #n ")" ::: "memory")
#define PG8_BAR __builtin_amdgcn_s_barrier()
#define PG8_SCHED __builtin_amdgcn_sched_barrier(0)
    Unit cur, nxt; int ui = 0;
    if (!S.next(0, cur)) return;
    f32x4 acc[2][2][4][2];
#pragma unroll
    for (int a = 0; a < 2; ++a)
#pragma unroll
        for (int b = 0; b < 2; ++b)
#pragma unroll
            for (int m = 0; m < 4; ++m)
#pragma unroll
                for (int n = 0; n < 2; ++n) acc[a][b][m][n] = (f32x4){0.f, 0.f, 0.f, 0.f};
    bf16x8 At[4][2], B0[2][2], B1[2][2];
    const char* cA = cur.A; const char* cB = cur.B;
    PG8_STAGE(PG8_SB(0, 0), cB, voffB); PG8_STAGE(PG8_SA(0, 0), cA, voffA); PG8_STAGE(PG8_SB(0, 1), cB + hstepB, voffB); PG8_STAGE(PG8_SA(0, 1), cA + hstepA, voffA);
    if (wr == 1) PG8_BAR;
    PG8_WAIT_V(4); PG8_BAR;
    PG8_STAGE(PG8_SB(1, 0), cB + kstep, voffB); PG8_STAGE(PG8_SA(1, 0), cA + kstep, voffA); PG8_STAGE(PG8_SB(1, 1), cB + hstepB + kstep, voffB);
    PG8_WAIT_V(6); PG8_BAR;
    for (;;) {
        const bool has_next = S.next(ui + 1, nxt);
        const char* nA = has_next ? nxt.A : cA; const char* nB = has_next ? nxt.B : cB;
        for (int t = 0; t < nt; t += 2) {
            const bool last = (t == nt - 2);
            const char* a1 = cA + (size_t)(t + 1) * kstep;
            const char* a2 = last ? nA : cA + (size_t)(t + 2) * kstep; const char* b2 = last ? nB : cB + (size_t)(t + 2) * kstep;
            const char* a3 = a2 + kstep; const char* b3 = b2 + kstep;
            PG8_LDB(B0, 0, 0); PG8_SCHED; PG8_LDA(At, 0, 0); PG8_STAGE(PG8_SA(1, 1), a1 + hstepA, voffA);
            PG8_WAIT_L(8); PG8_BAR; PG8_WAIT_L(0); PG8_MMA(0, 0, At, B0); PG8_BAR; PG8_SCHED;
            PG8_LDB(B1, 0, 1); PG8_STAGE(PG8_SB(0, 0), b2, voffB);
            PG8_BAR; PG8_WAIT_L(0); PG8_MMA(0, 1, At, B1); PG8_BAR;
            PG8_LDA(At, 0, 1); PG8_STAGE(PG8_SA(0, 0), a2, voffA);
            PG8_BAR; PG8_WAIT_L(0); PG8_MMA(1, 0, At, B0); PG8_BAR; PG8_SCHED;
            PG8_STAGE(PG8_SB(0, 1), b2 + hstepB, voffB);
            PG8_WAIT_V(6); PG8_BAR; PG8_MMA(1, 1, At, B1); PG8_BAR;
            PG8_LDB(B0, 1, 0); PG8_SCHED; PG8_LDA(At, 1, 0); PG8_STAGE(PG8_SA(0, 1), a2 + hstepA, voffA);
            PG8_WAIT_L(8); PG8_BAR; PG8_WAIT_L(0); PG8_MMA(0, 0, At, B0); PG8_BAR; PG8_SCHED;
            PG8_LDB(B1, 1, 1); PG8_STAGE(PG8_SB(1, 0), b3, voffB);
            PG8_BAR; PG8_WAIT_L(0); PG8_MMA(0, 1, At, B1); PG8_BAR;
            PG8_LDA(At, 1, 1); PG8_STAGE(PG8_SA(1, 0), a3, voffA);
            PG8_BAR; PG8_WAIT_L(0); PG8_MMA(1, 0, At, B0); PG8_BAR; PG8_SCHED;
            PG8_STAGE(PG8_SB(1, 1), b3 + hstepB, voffB);
            PG8_WAIT_V(6); PG8_BAR; PG8_MMA(1, 1, At, B1); PG8_BAR;
        }
        E(acc, cur, wr, wc, fr, fq);
        if (!has_next) break;
#pragma unroll
        for (int a = 0; a < 2; ++a)
#pragma unroll
            for (int b = 0; b < 2; ++b)
#pragma unroll
                for (int m = 0; m < 4; ++m)
#pragma unroll
                    for (int n = 0; n < 2; ++n) acc[a][b][m][n] = (f32x4){0.f, 0.f, 0.f, 0.f};
        cur = nxt; cA = nA; cB = nB; ++ui;
    }
    PG8_WAIT_V(0);
    if (wr == 0) PG8_BAR;
    PG8_BAR;
#undef PG8_SA
#undef PG8_SB
#undef PG8_STAGE
#undef PG8_LDA
#undef PG8_LDB
#undef PG8_MMA
#undef PG8_WAIT_V
#undef PG8_WAIT_L
#undef PG8_BAR
#undef PG8_SCHED
}
template <class F> struct EpiPair { F f;
    __device__ __forceinline__ void operator()(const f32x4 (&acc)[2][2][4][2], const Unit& u, int wr, int wc, int fr, int fq) const {
#pragma unroll
        for (int ai = 0; ai < 2; ++ai)
#pragma unroll
            for (int m = 0; m < 4; ++m)
#pragma unroll
                for (int bj = 0; bj < 2; ++bj) f(u, u.row0 + ai * HALF + wr * 64 + m * 16 + fr, u.col0 + bj * HALF + wc * 32 + 4 * fq, acc[ai][bj][m][0], acc[ai][bj][m][1]);
    } };
struct SchedDense { int nM, nN, G, c; const char* A; const char* B; size_t tA, tB;
    __device__ __forceinline__ bool next(int i, Unit& u) const {
        const int nwg = nM * nN; const long L = (long)i * G + c; if (L >= nwg) return false;
        int wgid = (int)L; { const int q = nwg / 8, r = nwg % 8, xcd = wgid % 8, off = wgid / 8; wgid = (xcd < r ? xcd * (q + 1) : r * (q + 1) + (xcd - r) * q) + off; }
        const int nig = 8 * nN, gid = wgid / nig, fm = gid * 8, gsz = (nM - fm) < 8 ? (nM - fm) : 8;
        const int pm = fm + ((wgid % nig) % gsz), pn = (wgid % nig) / gsz;
        u.row0 = pm * 256; u.col0 = pn * 256; u.aux = 0; u.A = A + (size_t)pm * tA; u.B = B + (size_t)pn * tB; return true; } };
}


namespace gqa {
using f32x16 = __attribute__((ext_vector_type(16))) float;
using s16x4 = __attribute__((ext_vector_type(4))) short;
constexpr int QP = 512, KVP = 128, OP = BRW;
constexpr int NW = 8, QBLK = 32, KVBLK = 64;
__device__ __forceinline__ int crow(int r, int hi) { return (r & 3) + 8 * (r >> 2) + 4 * hi; }
#define SBAR() __builtin_amdgcn_sched_barrier(0)
constexpr int NSLOT = 3, SLOTB = 8192;
constexpr int LDS_K = 0, LDS_V = NSLOT * SLOTB, LDS_WS = 2 * NSLOT * SLOTB, LDS_OST = LDS_WS + NW * 64 * 4, LDS_BYTES_ = LDS_OST + NW * 4096;
__device__ __forceinline__ void glds16(const void* gsrc, unsigned lds_dst) { unsigned keep;
  asm volatile("s_mov_b32 %0, m0\n\ts_mov_b32 m0, %2\n\ts_nop 0\n\tglobal_load_lds_dwordx4 %1, off\n\ts_mov_b32 m0, %0" : "=&s"(keep) : "v"(gsrc), "s"(lds_dst) : "memory"); }
__device__ __forceinline__ float max3f(float a, float b, float c) { float r; asm("v_max3_f32 %0, %1, %2, %3" : "=v"(r) : "v"(a), "v"(b), "v"(c)); return r; }
__device__ __forceinline__ float max2f(float a, float b) { float r; asm("v_max_f32_e32 %0, %1, %2" : "=v"(r) : "v"(a), "v"(b)); return r; }
__device__ __forceinline__ float fadd_s(float a, float b) { float r; asm("v_add_f32_e32 %0, %1, %2" : "=v"(r) : "v"(a), "v"(b)); return r; }
__device__ __forceinline__ float fsub_s(float a, float b) { float r; asm("v_sub_f32_e32 %0, %1, %2" : "=v"(r) : "v"(a), "v"(b)); return r; }
typedef float f32x2_t __attribute__((ext_vector_type(2))); typedef __bf16 bf16x2_t __attribute__((ext_vector_type(2)));
__device__ __forceinline__ unsigned cvtpk_s(float lo, float hi) { f32x2_t v = {lo, hi}; bf16x2_t b = __builtin_convertvector(v, bf16x2_t); return __builtin_bit_cast(unsigned, b); }
#define WAIT_BAR(N) asm volatile("s_waitcnt vmcnt(" #N ") lgkmcnt(0)\n\ts_barrier" ::: "memory")
__device__ __forceinline__ void qkt(f32x16& p0, f32x16& p1, const char* Kslot, const bf16x8* qr, const f32x16& negm, int r32, int hi) {
  const char* kb = Kslot + hi * 1024 + r32 * 16;
  #pragma unroll
  for (int d0 = 0; d0 < 4; ++d0) {
    const bf16x8 b0 = *reinterpret_cast<const bf16x8*>(kb + d0 * 2048);
    const bf16x8 b1 = *reinterpret_cast<const bf16x8*>(kb + d0 * 2048 + 512);
    if (d0 == 0) { p0 = __builtin_amdgcn_mfma_f32_32x32x16_bf16(b0, qr[0], negm, 0, 0, 0); p1 = __builtin_amdgcn_mfma_f32_32x32x16_bf16(b1, qr[0], negm, 0, 0, 0); }
    else { p0 = __builtin_amdgcn_mfma_f32_32x32x16_bf16(b0, qr[d0], p0, 0, 0, 0); p1 = __builtin_amdgcn_mfma_f32_32x32x16_bf16(b1, qr[d0], p1, 0, 0, 0); } }
}
typedef __attribute__((address_space(3))) const char* lds_cptr;
typedef short v4i16_t __attribute__((ext_vector_type(4)));
__device__ __forceinline__ void kload8(bf16x8* kf, lds_cptr kp) {
  kf[0] = *(const LAS bf16x8*)(kp);        kf[1] = *(const LAS bf16x8*)(kp + 512);
  kf[2] = *(const LAS bf16x8*)(kp + 2048); kf[3] = *(const LAS bf16x8*)(kp + 2560);
  kf[4] = *(const LAS bf16x8*)(kp + 4096); kf[5] = *(const LAS bf16x8*)(kp + 4608);
  kf[6] = *(const LAS bf16x8*)(kp + 6144); kf[7] = *(const LAS bf16x8*)(kp + 6656);
}
__device__ __forceinline__ void kload2(bf16x8* kf, lds_cptr kp, int j) { kf[2 * j] = *(const LAS bf16x8*)(kp + j * 2048); kf[2 * j + 1] = *(const LAS bf16x8*)(kp + j * 2048 + 512); }
__device__ __forceinline__ s16x4 vtr(lds_cptr p) { return __builtin_bit_cast(s16x4, __builtin_amdgcn_ds_read_tr16_b64_v4i16((LAS v4i16_t*)p)); }
__device__ __forceinline__ float rowmax(const f32x16& p0, const f32x16& p1) {
  float a = max3f(p0[0], p0[1], p1[0]), b = max3f(p0[2], p0[3], p1[1]); a = max3f(a, p1[2], p1[3]);
  #pragma unroll
  for (int r = 4; r < 16; r += 4) { a = max3f(a, p0[r], p0[r + 1]); b = max3f(b, p0[r + 2], p0[r + 3]); a = max3f(a, p1[r], p1[r + 1]); b = max3f(b, p1[r + 2], p1[r + 3]); }
  const float m = max2f(a, b);
  auto rr = __builtin_amdgcn_permlane32_swap(__float_as_uint(m), __float_as_uint(m), false, false);
  return max2f(__uint_as_float(rr[0]), __uint_as_float(rr[1]));
}
__device__ __forceinline__ void pv(f32x16* o, int vb, bf16x8 pa0, bf16x8 pa1, bf16x8 pa2, bf16x8 pa3) {
  #pragma unroll
  for (int d0 = 0; d0 < 2; ++d0) { s16x4 lo[4], hi[4];
    #pragma unroll
    for (int ks = 0; ks < 4; ++ks) {
      asm volatile("ds_read_b64_tr_b16 %0,%1 offset:%c2" : "=&v"(lo[ks]) : "v"(vb), "i"(d0 * 4096 + ks * 1024) : "memory");
      asm volatile("ds_read_b64_tr_b16 %0,%1 offset:%c2" : "=&v"(hi[ks]) : "v"(vb), "i"(d0 * 4096 + ks * 1024 + 512) : "memory"); }
    asm volatile("s_waitcnt lgkmcnt(0)" ::: "memory"); SBAR();
    #define PK(k) (bf16x8){lo[k][0], lo[k][1], lo[k][2], lo[k][3], hi[k][0], hi[k][1], hi[k][2], hi[k][3]}
    o[d0] = __builtin_amdgcn_mfma_f32_32x32x16_bf16(pa0, PK(0), o[d0], 0, 0, 0);
    o[d0] = __builtin_amdgcn_mfma_f32_32x32x16_bf16(pa1, PK(1), o[d0], 0, 0, 0);
    o[d0] = __builtin_amdgcn_mfma_f32_32x32x16_bf16(pa2, PK(2), o[d0], 0, 0, 0);
    o[d0] = __builtin_amdgcn_mfma_f32_32x32x16_bf16(pa3, PK(3), o[d0], 0, 0, 0);
    #undef PK
  }
}
template <int THRL> __device__ __forceinline__ void attn_unit(const bf16_t* Qu, const bf16_t* __restrict__ Kh, const bf16_t* __restrict__ Vh, bf16_t* Ou, const int NT, char* shm) {
  const int tid = tid_(), lane = tid & 63, r32 = lane & 31, hi = lane >> 5; const int wid = __builtin_amdgcn_readfirstlane(tid >> 6);
  const bf16_t* Qw = Qu + (long)wid * QBLK * QP;
  const unsigned lds0 = (unsigned)(uintptr_t)shm;
  float* wsf = (float*)(shm + LDS_WS) + wid * 64;
  const bf16_t* ksrc = Kh + (long)lane * KVP + wid * 8;
  const bf16_t* vsrc = Vh + (long)(16 * (wid & 3) + (lane >> 2)) * KVP + (wid >> 2) * 32 + (lane & 3) * 8;
  const unsigned kdst = lds0 + LDS_K + wid * 1024, vdst = lds0 + LDS_V + wid * 1024;
  #define DMA_K(t, slot) glds16(ksrc + (long)(t) * KVBLK * KVP, (unsigned)__builtin_amdgcn_readfirstlane(kdst + (slot)))
  #define DMA_V(t, slot) glds16(vsrc + (long)(t) * KVBLK * KVP, (unsigned)__builtin_amdgcn_readfirstlane(vdst + (slot)))
  const int vb0 = (int)(lds0 + LDS_V) + ((lane >> 4) & 1) * 32 + (lane & 3) * 8 + (4 * hi + ((lane & 15) >> 2)) * 64;
  const char* Kbase = shm + LDS_K; bf16x8 kf[8];
  const lds_cptr shm3 = (lds_cptr)shm; const lds_cptr kp0 = shm3 + LDS_K + hi * 1024 + r32 * 16; const lds_cptr vp0 = shm3 + LDS_V + ((lane >> 4) & 1) * 32 + (lane & 3) * 8 + (4 * hi + ((lane & 15) >> 2)) * 64;
  DMA_K(0, 0); DMA_V(0, 0); DMA_K(1, SLOTB);
  bf16x8 qr[4];
  #pragma unroll
  for (int d0 = 0; d0 < 4; ++d0) qr[d0] = *reinterpret_cast<const bf16x8*>(&Qw[(long)r32 * QP + d0 * 16 + hi * 8]);
  float mhat = 0.f, l_reg = 0.f; f32x16 o[2]; o[0] = f32x16{}; o[1] = f32x16{}; f32x16 negm = f32x16{}; asm volatile("" : "+v"(negm));
  bool resc = false;
  #define START(P0, P1) do { const float rm = rowmax(P0, P1); resc = false; \
    { const float dl = rm; mhat = fadd_s(mhat, dl); \
      _Pragma("unroll") for (int r = 0; r < 16; ++r) { P0[r] = fsub_s(P0[r], dl); P1[r] = fsub_s(P1[r], dl); } \
      _Pragma("unroll") for (int r = 0; r < 16; ++r) negm[r] = -mhat; asm volatile("" : "+v"(negm)); } \
    _Pragma("unroll") for (int r = 0; r < 16; ++r) P0[r] = __builtin_amdgcn_exp2f(P0[r]); } while (0)
  #define RESC() do { if (resc) { asm volatile("s_waitcnt lgkmcnt(0)" ::: "memory"); \
      _Pragma("unroll") for (int d_ = 0; d_ < 2; ++d_) _Pragma("unroll") for (int r = 0; r < 16; ++r) o[d_][r] *= wsf[crow(r, hi)]; } } while (0)
  f32x16 pA0, pA1, pB0, pB1;
  int sl_prev = 0, sl_cur = 0, sl_next = SLOTB;
  #define ROT() do { sl_prev = sl_cur; sl_cur = sl_next; sl_next = (sl_next == (NSLOT - 1) * SLOTB) ? 0 : sl_next + SLOTB; } while (0)
  DMA_K(2, 2 * SLOTB);
  WAIT_BAR(3);
  qkt(pA0, pA1, Kbase, qr, negm, r32, hi); asm volatile("s_nop 15\n\ts_nop 7" : "+v"(pA0), "+v"(pA1));
  START(pA0, pA1);
  _Pragma("unroll") for (int r = 0; r < 16; ++r) pA1[r] = __builtin_amdgcn_exp2f(pA1[r]);
  WAIT_BAR(0);
  DMA_K(3, 0); DMA_V(1, SLOTB);
  ROT();
  kload8(kf, kp0 + sl_cur);
  WAIT_BAR(2);
  s16x4 vlo[8], vhi[8]; u32x4 pw0, pw1, pw2, pw3;
  #define PKW(P, B) cvtpk_s(P[B], P[B + 1])
  #define PAF(k) __builtin_bit_cast(bf16x8, pw##k)
  #define VFR(i) (bf16x8){vlo[i][0], vlo[i][1], vlo[i][2], vlo[i][3], vhi[i][0], vhi[i][1], vhi[i][2], vhi[i][3]}
  #define PIN(x) asm volatile("" : "+v"(x))
  #define MX3(a, b, c) __builtin_fmaxf(__builtin_fmaxf((a), (b)), (c))
  #define GAPA(MF, A0, A1, A2, A3, W0, W1, PW) do { MF; sacc += A0; sacc += A1; sacc += A2; sacc += A3; PIN(sacc); W0; W1; PIN(PW); SBAR(); } while (0)
  #define EX(v) __builtin_amdgcn_exp2f(v)
  #define GAPB(MF, X, B) do { MF; X[B] = EX(X[B]); X[B + 1] = EX(X[B + 1]); X[B + 2] = EX(X[B + 2]); X[B + 3] = EX(X[B + 3]); PIN(X); SBAR(); } while (0)
  #define VRD(i) do { vlo[i] = vtr(vp_ + (((i) >> 2) * 4096 + ((i) & 3) * 1024)); vhi[i] = vtr(vp_ + (((i) >> 2) * 4096 + ((i) & 3) * 1024 + 512)); } while (0)
  #define KRD(G, j) do { if (G) { kload2(kf, kp0 + sl_next, j); SBAR(); } } while (0)
  #define STEP(C0, C1, P0, P1, t, GK, GV, GL) do { SBAR(); \
    const lds_cptr vp_ = vp0 + sl_prev; \
    VRD(0); SBAR(); float sacc = (P0[0] + P0[1]); \
    GAPA(C0 = __builtin_amdgcn_mfma_f32_32x32x16_bf16(kf[0], qr[0], negm, 0, 0, 0), P0[2], P0[3], P0[4], P0[5],     pw0[0] = PKW(P0, 0), pw0[1] = PKW(P0, 2), pw0); \
    VRD(4); SBAR(); GAPA(C1 = __builtin_amdgcn_mfma_f32_32x32x16_bf16(kf[1], qr[0], negm, 0, 0, 0), P0[6], P0[7], P0[8], P0[9],     pw0[2] = PKW(P0, 4), pw0[3] = PKW(P0, 6), pw0); \
    VRD(1); SBAR(); GAPA(C0 = __builtin_amdgcn_mfma_f32_32x32x16_bf16(kf[2], qr[1], C0, 0, 0, 0),   P0[10], P0[11], P0[12], P0[13], pw1[0] = PKW(P0, 8), pw1[1] = PKW(P0, 10), pw1); \
    VRD(5); SBAR(); GAPA(C1 = __builtin_amdgcn_mfma_f32_32x32x16_bf16(kf[3], qr[1], C1, 0, 0, 0),   P0[14], P0[15], P1[0], P1[1],   pw1[2] = PKW(P0, 12), pw1[3] = PKW(P0, 14), pw1); \
    VRD(2); SBAR(); GAPA(C0 = __builtin_amdgcn_mfma_f32_32x32x16_bf16(kf[4], qr[2], C0, 0, 0, 0),   P1[2], P1[3], P1[4], P1[5],     pw2[0] = PKW(P1, 0), pw2[1] = PKW(P1, 2), pw2); \
    VRD(6); SBAR(); GAPA(C1 = __builtin_amdgcn_mfma_f32_32x32x16_bf16(kf[5], qr[2], C1, 0, 0, 0),   P1[6], P1[7], P1[8], P1[9],     pw2[2] = PKW(P1, 4), pw2[3] = PKW(P1, 6), pw2); \
    VRD(3); SBAR(); GAPA(C0 = __builtin_amdgcn_mfma_f32_32x32x16_bf16(kf[6], qr[3], C0, 0, 0, 0),   P1[10], P1[11], P1[12], P1[13], pw3[0] = PKW(P1, 8), pw3[1] = PKW(P1, 10), pw3); \
    VRD(7); SBAR(); GAPA(C1 = __builtin_amdgcn_mfma_f32_32x32x16_bf16(kf[7], qr[3], C1, 0, 0, 0),   P1[14], P1[15], 0.f, 0.f,       pw3[2] = PKW(P1, 12), pw3[3] = PKW(P1, 14), pw3); \
    l_reg += sacc; \
    if (GK) { DMA_K((t) + 3, sl_cur); } if (GV) { DMA_V((t) + 1, sl_next); } \
    { float a = MX3(C0[0], C0[1], C1[0]), b = MX3(C0[2], C0[3], C1[1]); a = MX3(a, C1[2], C1[3]); \
      _Pragma("unroll") for (int r = 4; r < 16; r += 4) { a = MX3(a, C0[r], C0[r + 1]); b = MX3(b, C0[r + 2], C0[r + 3]); a = MX3(a, C1[r], C1[r + 1]); b = MX3(b, C1[r + 2], C1[r + 3]); } \
      float rm = __builtin_fmaxf(a, b); { auto rr = __builtin_amdgcn_permlane32_swap(__float_as_uint(rm), __float_as_uint(rm), false, false); rm = __builtin_fmaxf(__uint_as_float(rr[0]), __uint_as_float(rr[1])); } \
      resc = false; \
      if (__builtin_expect(__any(rm > (float)THRL), 0)) { const float dl = __builtin_fmaxf(rm, 0.f); mhat += dl; \
        _Pragma("unroll") for (int r = 0; r < 16; ++r) { C0[r] -= dl; C1[r] -= dl; } \
        _Pragma("unroll") for (int r = 0; r < 16; ++r) negm[r] = -mhat; asm volatile("" : "+v"(negm)); \
        const float f = __builtin_amdgcn_exp2f(-dl); l_reg *= f; if (hi == 0) wsf[r32] = f; resc = true; } } \
    SBAR(); \
    GAPB(o[0] = __builtin_amdgcn_mfma_f32_32x32x16_bf16(PAF(0), VFR(0), o[0], 0, 0, 0), C0, 0); \
    GAPB(o[1] = __builtin_amdgcn_mfma_f32_32x32x16_bf16(PAF(0), VFR(4), o[1], 0, 0, 0), C0, 4); \
    KRD(GL, 0); GAPB(o[0] = __builtin_amdgcn_mfma_f32_32x32x16_bf16(PAF(1), VFR(1), o[0], 0, 0, 0), C0, 8); \
    KRD(GL, 1); GAPB(o[1] = __builtin_amdgcn_mfma_f32_32x32x16_bf16(PAF(1), VFR(5), o[1], 0, 0, 0), C0, 12); \
    KRD(GL, 2); GAPB(o[0] = __builtin_amdgcn_mfma_f32_32x32x16_bf16(PAF(2), VFR(2), o[0], 0, 0, 0), C1, 0); \
    KRD(GL, 3); GAPB(o[1] = __builtin_amdgcn_mfma_f32_32x32x16_bf16(PAF(2), VFR(6), o[1], 0, 0, 0), C1, 4); \
    GAPB(o[0] = __builtin_amdgcn_mfma_f32_32x32x16_bf16(PAF(3), VFR(3), o[0], 0, 0, 0), C1, 8); \
    GAPB(o[1] = __builtin_amdgcn_mfma_f32_32x32x16_bf16(PAF(3), VFR(7), o[1], 0, 0, 0), C1, 12); \
    } while (0)
  int t = 1;
  for (; t + 5 < NT; t += 2) {
    STEP(pB0, pB1, pA0, pA1, t, true, true, true);     WAIT_BAR(2); RESC(); ROT();
    STEP(pA0, pA1, pB0, pB1, t + 1, true, true, true); WAIT_BAR(2); RESC(); ROT();
  }
  #define ENDW(tt) do { if ((tt) + 3 < NT) { WAIT_BAR(2); } else if ((tt) + 2 < NT) { WAIT_BAR(1); } else { WAIT_BAR(0); } } while (0)
  for (; t + 1 < NT; t += 2) {
    STEP(pB0, pB1, pA0, pA1, t, (t + 3 < NT), (t + 1 < NT), (t + 1 < NT));         ENDW(t);     RESC(); ROT();
    STEP(pA0, pA1, pB0, pB1, t + 1, (t + 4 < NT), (t + 2 < NT), (t + 2 < NT));     ENDW(t + 1); RESC(); ROT();
  }
  STEP(pB0, pB1, pA0, pA1, NT - 1, false, false, false); RESC();
  { float sacc = pB0[0] + pB0[1]; _Pragma("unroll") for (int r = 2; r < 16; ++r) sacc += pB0[r]; _Pragma("unroll") for (int r = 0; r < 16; ++r) sacc += pB1[r]; l_reg += sacc;
    pw0 = (u32x4){PKW(pB0, 0), PKW(pB0, 2), PKW(pB0, 4), PKW(pB0, 6)}; pw1 = (u32x4){PKW(pB0, 8), PKW(pB0, 10), PKW(pB0, 12), PKW(pB0, 14)}; pw2 = (u32x4){PKW(pB1, 0), PKW(pB1, 2), PKW(pB1, 4), PKW(pB1, 6)}; pw3 = (u32x4){PKW(pB1, 8), PKW(pB1, 10), PKW(pB1, 12), PKW(pB1, 14)};
    SBAR(); pv(o, vb0 + sl_cur, PAF(0), PAF(1), PAF(2), PAF(3)); }
  #undef PKW
  #undef PAF
  #undef VFR
  #undef PIN
  #undef MX3
  #undef GAPA
  #undef GAPB
  #undef EX
  #undef VRD
  #undef KRD
  #undef STEP
  #undef ENDW
  { auto rr = __builtin_amdgcn_permlane32_swap(__float_as_uint(l_reg), __float_as_uint(l_reg), false, false); l_reg = __uint_as_float(rr[0]) + __uint_as_float(rr[1]); }
  if (hi == 0) wsf[32 + r32] = l_reg; asm volatile("s_waitcnt lgkmcnt(0)" ::: "memory");
  float rli[16];
  #pragma unroll
  for (int r = 0; r < 16; ++r) rli[r] = __builtin_amdgcn_rcpf(wsf[32 + crow(r, hi)]);
  bf16_t* Ow = Ou + (long)wid * QBLK * OP;
  { bf16_t* stg = (bf16_t*)(shm + LDS_OST) + wid * 2048;
    #pragma unroll
    for (int r = 0; r < 16; ++r) { const int orow = crow(r, hi);
      #pragma unroll
      for (int d0 = 0; d0 < 2; ++d0) stg[orow * 64 + d0 * 32 + r32] = (bf16_t)(cvtpk_s(o[d0][r] * rli[r], 0.f) & 0xffffu); }
    asm volatile("s_waitcnt lgkmcnt(0)" ::: "memory");
    #pragma unroll
    for (int i = 0; i < 4; ++i) { const int row = i * 8 + (lane >> 3), ch = lane & 7; const u32x4 v = *(const u32x4*)(stg + row * 64 + ch * 8); *(u32x4*)(Ow + (long)row * OP + ch * 8) = v; } }
  asm volatile("s_waitcnt lgkmcnt(0)\n\ts_barrier" ::: "memory");
  #undef DMA_K
  #undef DMA_V
  #undef START
  #undef RESC
  #undef ROT
}
#undef SBAR
#undef WAIT_BAR
}

__device__ __forceinline__ void ph_prologue(const Params& P, LAS unsigned char* lds) {
    const int tid = tid_(), bid = bid_(), G = gridDim.x;
    float* mods = (float*)(P.ws + WS_MODS);
    if (bid < 48) {
        LAS float* sc = (LAS float*)lds;
        for (int i = tid; i < 9 * 1024; i += NTHR) { const float v = (i < 8192) ? P.in[I_C][i] : P.in[I_CCTX][i - 8192]; sc[i] = siluf_(v); }
        __syncthreads();
        const int l = bid / 12, col = (bid % 12) * 512 + tid;
        const float* w = P.in[I_WADA] + (size_t)l * 1024 * 6144 + col;
        float a[9];
#pragma unroll
        for (int r = 0; r < 9; ++r) a[r] = 0.f;
        for (int k = 0; k < 1024; ++k) {
            const float wv = w[(size_t)k * 6144];
#pragma unroll
            for (int r = 0; r < 9; ++r) a[r] += sc[r * 1024 + k] * wv;
        }
        const float bb = P.in[I_BADA][l * 6144 + col];
#pragma unroll
        for (int r = 0; r < 9; ++r) mods[((size_t)l * 9 + r) * 6144 + col] = a[r] + bb;
    } else if (bid == 48) {
        float* lbv = (float*)(P.ws + WS_LB);
        for (int i = tid; i < 1024; i += NTHR) {
            float lg[DEPTH], mx = -1e30f;
#pragma unroll
            for (int l = 0; l < DEPTH; ++l) { lg[l] = P.in[I_LBL][l * 1024 + i]; mx = fmaxf(mx, lg[l]); }
            float s = 0.f;
#pragma unroll
            for (int l = 0; l < DEPTH; ++l) { lg[l] = expf(lg[l] - mx); s += lg[l]; }
            float cum = 0.f;
#pragma unroll
            for (int l = 0; l < DEPTH; ++l) { if (l > 0) cum += lg[l] / s; lbv[l * 1024 + i] = cum; }
        }
        float* rope = (float*)(P.ws + WS_ROPE);
        for (int i = tid; i < 96 * 16; i += NTHR) {
            const int pos = i >> 4, fi = i & 15;
            const float inv = powf(10000.0f, -(float)fi / 16.0f);
            const float p = (pos < 32) ? (float)pos : (float)(pos - 32);
            const float ang = p * inv;
            if (pos < 32) { rope[pos * 16 + fi] = cosf(ang); rope[512 + pos * 16 + fi] = sinf(ang); }
            else { rope[1024 + (pos - 32) * 16 + fi] = cosf(ang); rope[2048 + (pos - 32) * 16 + fi] = sinf(ang); }
        }
    }
    float4* xr = (float4*)(P.ws + WS_X);
    const float4* xs = (const float4*)P.in[I_X]; const float4* cs = (const float4*)P.in[I_CTX];
    const size_t nx4 = (size_t)NLAT * D / 4, nc4 = (size_t)NCTX * D / 4;
    for (size_t i = (size_t)bid * NTHR + tid; i < nx4 + nc4; i += (size_t)G * NTHR) xr[i] = (i < nx4) ? xs[i] : cs[i - nx4];
}

__device__ __forceinline__ void conv_tile(LAS float* t, const float* srcA, const float* srcB, int ld, bool inter, bf16_t* dst, int K, int n0, int k0) {
    const int tid = tid_();
    {
        const int nn = tid & 63, kk = tid >> 6, n = n0 + nn;
        const float* cp;
        if (!inter) cp = srcA + n; else { const int g = n >> 5, i = n & 31; cp = (i < 16) ? (srcA + 16 * g + i) : (srcB + 16 * g + i - 16); }
#pragma unroll
        for (int p = 0; p < 8; ++p) { const int k = kk + 8 * p; t[k * 65 + nn] = cp[(size_t)(k0 + k) * ld]; }
    }
    __syncthreads();
    {
        const int n = tid >> 3, k8 = (tid & 7) * 8;
        float v[8];
#pragma unroll
        for (int j = 0; j < 8; ++j) v[j] = t[(k8 + j) * 65 + n];
        uint4 o; o.x = pk_bf16(v[0], v[1]); o.y = pk_bf16(v[2], v[3]); o.z = pk_bf16(v[4], v[5]); o.w = pk_bf16(v[6], v[7]);
        *(uint4*)(dst + (size_t)(n0 + n) * K + k0 + k8) = o;
    }
    __syncthreads();
}
__device__ __forceinline__ void ph_wconv(const Params& P, LAS unsigned char* lds, int l) {
    LAS float* t = (LAS float*)lds;
    const int bid = bid_(), G = gridDim.x;
    constexpr int T_IN = 16 * 124, T_BR = 3 * 8 * 16, T_OUT = 16 * 16, T_GU = 16 * 16 * 16, T_DN = 16 * 8 * 16;
    constexpr int TOT = T_IN + T_BR + T_OUT + T_GU + T_DN;
    for (int u = bid; u < TOT; u += G) {
        int v = u;
        if (v < T_IN) { const int kt = v % 16, nt = v / 16;
            conv_tile(t, P.in[I_WIN] + (size_t)l * 1024 * INC, nullptr, INC, false, (bf16_t*)(P.ws + WS_WIN), 1024, nt * 64, kt * 64); continue; }
        v -= T_IN;
        if (v < T_BR) { const int i = v / 128, w = v % 128, kt = w % 8, nt = w / 8;
            conv_tile(t, P.in[I_WBR] + ((size_t)l * 3 + i) * 512 * 1024, nullptr, 1024, false, (bf16_t*)(P.ws + WS_WBR) + (size_t)i * 1024 * 512, 512, nt * 64, kt * 64); continue; }
        v -= T_BR;
        if (v < T_OUT) { const int kt = v % 16, nt = v / 16;
            conv_tile(t, P.in[I_WOUT] + (size_t)l * 1024 * 1024, nullptr, 1024, false, (bf16_t*)(P.ws + WS_WOUT), 1024, nt * 64, kt * 64); continue; }
        v -= T_OUT;
        if (v < T_GU) { const int e = v / 256, w = v % 256, kt = w % 16, nt = w / 16;
            const size_t eo = ((size_t)l * NEXP + e) * 1024 * 512;
            conv_tile(t, P.in[I_WEG] + eo, P.in[I_WEU] + eo, 512, true, (bf16_t*)(P.ws + WS_WGU) + (size_t)e * 1024 * 1024, 1024, nt * 64, kt * 64); continue; }
        v -= T_GU;
        { const int e = v / 128, w = v % 128, kt = w % 8, nt = w / 8;
            conv_tile(t, P.in[I_WED] + ((size_t)l * NEXP + e) * 512 * 1024, nullptr, 1024, false, (bf16_t*)(P.ws + WS_WDN) + (size_t)e * 1024 * 512, 512, nt * 64, kt * 64); }
    }
}

__device__ __forceinline__ void norm_row(const float4 (&x)[4], const float* g, const float* shift, const float* scale, int lane, float4 (&o)[4]) {
    float ss = 0.f;
#pragma unroll
    for (int i = 0; i < 4; ++i) ss += x[i].x * x[i].x + x[i].y * x[i].y + x[i].z * x[i].z + x[i].w * x[i].w;
    ss = wave_sum(ss);
    const float rstd = __builtin_amdgcn_rsqf(ss * (1.0f / 1024.0f) + 1e-6f);
#pragma unroll
    for (int i = 0; i < 4; ++i) {
        const int c = lane * 4 + 256 * i;
        const float4 gv = *(const float4*)(g + c), sh = *(const float4*)(shift + c), sc = *(const float4*)(scale + c);
        o[i].x = x[i].x * rstd * gv.x * (1.0f + sc.x) + sh.x;
        o[i].y = x[i].y * rstd * gv.y * (1.0f + sc.y) + sh.y;
        o[i].z = x[i].z * rstd * gv.z * (1.0f + sc.z) + sh.z;
        o[i].w = x[i].w * rstd * gv.w * (1.0f + sc.w) + sh.w;
    }
}
__device__ __forceinline__ int row_modrow(int r) { return r < NLAT ? (r >> 11) : 8; }

__device__ __forceinline__ void ph_norm1(const Params& P, int l) {
    const int tid = tid_(), lane = tid & 63, wid = tid >> 6;
    const float* xres = (const float*)(P.ws + WS_X);
    bf16_t* h = (bf16_t*)(P.ws + WS_H);
    const float* g = P.in[I_GMIX] + l * 1024;
    for (int r = bid_() * 8 + wid; r < NTOK; r += gridDim.x * 8) {
        const float* mod = (const float*)(P.ws + WS_MODS) + ((size_t)l * 9 + row_modrow(r)) * 6144;
        float4 x[4], o[4];
#pragma unroll
        for (int i = 0; i < 4; ++i) x[i] = *(const float4*)(xres + (size_t)r * D + lane * 4 + 256 * i);
        norm_row(x, g, mod, mod + 1024, lane, o);
#pragma unroll
        for (int i = 0; i < 4; ++i) { uint2 u; u.x = pk_bf16(o[i].x, o[i].y); u.y = pk_bf16(o[i].z, o[i].w); *(uint2*)(h + (size_t)r * D + lane * 4 + 256 * i) = u; }
    }
}

struct EpiStoreBf16 { bf16_t* O; int ldc;
    __device__ __forceinline__ void operator()(int row, int col, const f32x4& v0, const f32x4& v1) const {
        uint2 a, b; a.x = pk_bf16(v0[0], v0[1]); a.y = pk_bf16(v0[2], v0[3]); b.x = pk_bf16(v1[0], v1[1]); b.y = pk_bf16(v1[2], v1[3]);
        *(uint2*)(O + (size_t)row * ldc + col) = a; *(uint2*)(O + (size_t)row * ldc + col + 16) = b; } };
struct FStoreBf16 { bf16_t* O; int ldc;
    __device__ __forceinline__ void operator()(const pg8::Unit&, int row, int col, const f32x4& v0, const f32x4& v1) const {
        uint2 a, b; a.x = pk_bf16(v0[0], v0[1]); a.y = pk_bf16(v0[2], v0[3]); b.x = pk_bf16(v1[0], v1[1]); b.y = pk_bf16(v1[2], v1[3]);
        *(uint2*)(O + (size_t)row * ldc + col) = a; *(uint2*)(O + (size_t)row * ldc + col + 16) = b; } };
__device__ __forceinline__ void ph_g1(const Params& P, LAS unsigned char* lds) {
    pg8::SchedDense S{NTOK / 256, INC / 256, (int)gridDim.x, bid_(), (const char*)(P.ws + WS_H), (const char*)(P.ws + WS_WIN), (size_t)256 * D * 2, (size_t)256 * D * 2};
    pg8::EpiPair<FStoreBf16> E{{(bf16_t*)(P.ws + WS_Z), INC}};
    pg8::gemm_phase(lds, pg8::Gemm{D, D, D}, S, E);
}

__device__ __forceinline__ int kvrow(int r) { return r < NLAT ? ((r >> 11) * 2304 + 256 + (r & 2047)) : (((r - NLAT) >> 8) * 2304 + ((r - NLAT) & 255)); }
__device__ __forceinline__ void ph_prep(const Params& P, int l) {
    const int tid = tid_(), lane = tid & 63, wid = tid >> 6;
    const bf16_t* z = (const bf16_t*)(P.ws + WS_Z);
    bf16_t* qn = (bf16_t*)(P.ws + WS_QN); bf16_t* kn = (bf16_t*)(P.ws + WS_KN); bf16_t* vn = (bf16_t*)(P.ws + WS_VN);
    const float* rope = (const float*)(P.ws + WS_ROPE);
    const float gq = P.in[I_QNG][l * 64 + lane] * (0.125f * 1.4426950408889634f), gk = P.in[I_KNG][l * 64 + lane];
    for (int r = bid_() * 8 + wid; r < NTOK; r += gridDim.x * 8) {
        const bool lat = r < NLAT;
        const size_t kr = (size_t)kvrow(r);
        float cs = 1.f, sn = 0.f;
        if (lat) { const int t = r & 2047, fi = lane & 15;
            if (lane < 32) { const int pr = t >> 6; cs = rope[pr * 16 + fi]; sn = rope[512 + pr * 16 + fi]; }
            else { const int pc = t & 63; cs = rope[1024 + pc * 16 + fi]; sn = rope[2048 + pc * 16 + fi]; } }
        const float sgn = (lane & 16) ? 1.f : -1.f;
#pragma unroll
        for (int hh = 0; hh < 10; ++hh) {
            const int col = (hh < 8) ? (C_GQ + hh * 64) : (C_GK + (hh - 8) * 64);
            const float x = bf2f(z[(size_t)r * INC + col + lane]);
            const float ss = wave_sum(x * x);
            const float xn = x * __builtin_amdgcn_rsqf(ss * (1.0f / 64.0f) + 1e-6f) * (hh < 8 ? gq : gk);
            const float pa = __shfl_xor(xn, 16, 64);
            const float o = xn * cs + sgn * pa * sn;
            const bf16_t ob = (bf16_t)(pk_bf16(o, 0.f) & 0xffffu);
            if (hh < 8) qn[(size_t)r * 512 + hh * 64 + lane] = ob; else kn[kr * 128 + (hh - 8) * 64 + lane] = ob;
        }
        *(unsigned*)(vn + kr * 128 + lane * 2) = *(const unsigned*)(z + (size_t)r * INC + C_GV + lane * 2);
    }
}

__device__ __forceinline__ void ph_navt(const Params& P, LAS unsigned char* lds) {
    const int tid = tid_();
    const bf16_t* z = (const bf16_t*)(P.ws + WS_Z); bf16_t* vt = (bf16_t*)(P.ws + WS_NAVT);
    constexpr int PT = 1040;
    for (int u = bid_(); u < NB * 36; u += gridDim.x) {
        const int b = u / 36, tl = u % 36;
        const int row0 = (tl < 4) ? (NLAT + b * 256 + tl * 64) : (b * 2048 + (tl - 4) * 64);
        __syncthreads();
#pragma unroll
        for (int i = 0; i < 8; ++i) { const int ch = tid + i * NTHR, rr = ch >> 6, cc = ch & 63;
            const uint4 v = *(const uint4*)(z + (size_t)(row0 + rr) * INC + C_NAV + cc * 8);
            *(LAS u32x4*)(lds + rr * PT + cc * 16) = (u32x4){v.x, v.y, v.z, v.w}; }
        __syncthreads();
#pragma unroll
        for (int i = 0; i < 8; ++i) { const int c = tid, tg = i;
            unsigned short e[8];
#pragma unroll
            for (int k = 0; k < 8; ++k) e[k] = *(const LAS unsigned short*)(lds + (tg * 8 + k) * PT + c * 2);
            uint4 o; o.x = e[0] | ((unsigned)e[1] << 16); o.y = e[2] | ((unsigned)e[3] << 16); o.z = e[4] | ((unsigned)e[5] << 16); o.w = e[6] | ((unsigned)e[7] << 16);
            *(uint4*)(vt + ((size_t)(b * 8 + (c >> 6)) * 64 + (c & 63)) * 2304 + tl * 64 + tg * 8) = o; }
    }
    __syncthreads();
}

#ifdef DIAG
__device__ __forceinline__ void load_q64(float (&q)[64], const bf16_t* p) {
#pragma unroll
    for (int i = 0; i < 8; ++i) { const uint4 u = ((const uint4*)p)[i];
        q[8 * i + 0] = bf_lo(u.x); q[8 * i + 1] = bf_hi(u.x); q[8 * i + 2] = bf_lo(u.y); q[8 * i + 3] = bf_hi(u.y);
        q[8 * i + 4] = bf_lo(u.z); q[8 * i + 5] = bf_hi(u.z); q[8 * i + 6] = bf_lo(u.w); q[8 * i + 7] = bf_hi(u.w); }
}
__device__ __forceinline__ void attn_key(const float (&q)[64], const bf16_t* kp, const bf16_t* vp, float bias, float& m, float& lsum, float (&o)[64]) {
    float s = 0.f;
#pragma unroll
    for (int i = 0; i < 8; ++i) { const uint4 u = ((const uint4*)kp)[i];
        s += q[8 * i + 0] * bf_lo(u.x) + q[8 * i + 1] * bf_hi(u.x) + q[8 * i + 2] * bf_lo(u.y) + q[8 * i + 3] * bf_hi(u.y)
           + q[8 * i + 4] * bf_lo(u.z) + q[8 * i + 5] * bf_hi(u.z) + q[8 * i + 6] * bf_lo(u.w) + q[8 * i + 7] * bf_hi(u.w); }
    s = s * 0.125f + bias;
    const float mn = fmaxf(m, s), corr = __expf(m - mn), pp = __expf(s - mn);
    lsum = lsum * corr + pp; m = mn;
#pragma unroll
    for (int i = 0; i < 8; ++i) { const uint4 u = ((const uint4*)vp)[i];
        o[8 * i + 0] = o[8 * i + 0] * corr + pp * bf_lo(u.x); o[8 * i + 1] = o[8 * i + 1] * corr + pp * bf_hi(u.x);
        o[8 * i + 2] = o[8 * i + 2] * corr + pp * bf_lo(u.y); o[8 * i + 3] = o[8 * i + 3] * corr + pp * bf_hi(u.y);
        o[8 * i + 4] = o[8 * i + 4] * corr + pp * bf_lo(u.z); o[8 * i + 5] = o[8 * i + 5] * corr + pp * bf_hi(u.z);
        o[8 * i + 6] = o[8 * i + 6] * corr + pp * bf_lo(u.w); o[8 * i + 7] = o[8 * i + 7] * corr + pp * bf_hi(u.w); }
}
__device__ __forceinline__ void store_o64(const float (&o)[64], float inv, bf16_t* p) {
#pragma unroll
    for (int i = 0; i < 8; ++i) { uint4 u;
        u.x = pk_bf16(o[8 * i + 0] * inv, o[8 * i + 1] * inv); u.y = pk_bf16(o[8 * i + 2] * inv, o[8 * i + 3] * inv);
        u.z = pk_bf16(o[8 * i + 4] * inv, o[8 * i + 5] * inv); u.w = pk_bf16(o[8 * i + 6] * inv, o[8 * i + 7] * inv);
        ((uint4*)p)[i] = u; }
}
__device__ __forceinline__ void na_thread(const Params& P, int l, int r, int h, bf16_t* br, int OPN) {
    const bf16_t* z = (const bf16_t*)(P.ws + WS_Z);
    float q[64], o[64]; float m = -INFINITY, ls = 0.f;
#pragma unroll
    for (int i = 0; i < 64; ++i) o[i] = 0.f;
    load_q64(q, z + (size_t)r * INC + C_NAQ + h * 64);
    int b;
    if (r < NLAT) {
        b = r >> 11; const int t = r & 2047, qr = t >> 6, qc = t & 63;
        const int r0 = min(max(qr - 4, 0), 24), c0 = min(max(qc - 8, 0), 48);
        const float* rpb = P.in[I_RPB] + ((size_t)l * 8 + h) * 15 * 31;
        for (int kr = r0; kr < r0 + 8; ++kr)
            for (int kc = c0; kc < c0 + 16; ++kc) {
                const size_t krow = (size_t)(b * 2048 + kr * 64 + kc) * INC;
                attn_key(q, z + krow + C_NAK + h * 64, z + krow + C_NAV + h * 64, rpb[(kr - qr + 7) * 31 + (kc - qc + 15)], m, ls, o);
            }
    } else b = (r - NLAT) >> 8;
    for (int j = 0; j < 256; ++j) {
        const size_t krow = (size_t)(NLAT + b * 256 + j) * INC;
        attn_key(q, z + krow + C_NAK + h * 64, z + krow + C_NAV + h * 64, 0.f, m, ls, o);
    }
    store_o64(o, 1.0f / ls, br + (size_t)r * OPN + h * 64);
}
#endif
namespace na {
constexpr int KP = 144, VP = 528;
constexpr int L_K = 0, L_V = 256 * KP, L_B = L_V + 64 * VP, L_END = L_B + 480 * 4;
constexpr float C2 = 0.125f * 1.4426950408889634f, LOG2E = 1.4426950408889634f;
struct Acc { float m, l; f32x4 o[4]; };
template <class VF> __device__ __forceinline__ void absorb(Acc& A, f32x4 (&sa)[4], f32x4 (&sb)[4], const VF& vf) {
    float mx = -INFINITY;
#pragma unroll
    for (int g = 0; g < 4; ++g)
#pragma unroll
        for (int j = 0; j < 4; ++j) mx = fmaxf(mx, fmaxf(sa[g][j], sb[g][j]));
    mx = fmaxf(mx, __shfl_xor(mx, 16, 64)); mx = fmaxf(mx, __shfl_xor(mx, 32, 64));
    const float mn = fmaxf(A.m, mx), corr = __builtin_amdgcn_exp2f(A.m - mn);
    A.m = mn;
    float ps = 0.f;
    bf16x8 pf[4];
#pragma unroll
    for (int g = 0; g < 4; ++g) { float p[8];
#pragma unroll
        for (int j = 0; j < 4; ++j) { p[j] = __builtin_amdgcn_exp2f(sa[g][j] - mn); p[4 + j] = __builtin_amdgcn_exp2f(sb[g][j] - mn); ps += p[j] + p[4 + j]; }
        pf[g] = pack8(p); }
    A.l = A.l * corr + ps;
#pragma unroll
    for (int db = 0; db < 4; ++db) A.o[db] *= corr;
#pragma unroll
    for (int g = 0; g < 4; ++g)
#pragma unroll
        for (int db = 0; db < 4; ++db) A.o[db] = __builtin_amdgcn_mfma_f32_16x16x32_bf16(vf(g, db), pf[g], A.o[db], 0, 0, 0);
}
}
__device__ __forceinline__ void na_unit(const Params& P, LAS unsigned char* lds, int l, int u, bf16_t* br, int OPN) {
    const int tid = tid_(), lane = tid & 63, wid = __builtin_amdgcn_readfirstlane(tid >> 6), c16 = lane & 15, kq = lane >> 4;
    const bool latu = u < 256;
    const int bh = latu ? (u >> 2) : (u - 256), b = bh >> 3, h = bh & 7, q4 = u & 3;
    const bf16_t* z = (const bf16_t*)(P.ws + WS_Z); const bf16_t* vt = (const bf16_t*)(P.ws + WS_NAVT) + (size_t)bh * 64 * 2304;
    LAS unsigned char* KL = lds + na::L_K; LAS unsigned char* VL = lds + na::L_V; LAS float* BL = (LAS float*)(lds + na::L_B);
    __syncthreads();
#pragma unroll
    for (int i = 0; i < 4; ++i) { const int ch = tid + i * NTHR, rr = ch >> 3, cc = ch & 7;
        const uint4 v = *(const uint4*)(z + (size_t)(NLAT + b * 256 + rr) * INC + C_NAK + h * 64 + cc * 8);
        *(LAS u32x4*)(KL + rr * na::KP + cc * 16) = (u32x4){v.x, v.y, v.z, v.w}; }
#pragma unroll
    for (int i = 0; i < 4; ++i) { const int ch = tid + i * NTHR, rr = ch >> 5, cc = ch & 31;
        const uint4 v = *(const uint4*)(vt + (size_t)rr * 2304 + cc * 8);
        *(LAS u32x4*)(VL + rr * na::VP + cc * 16) = (u32x4){v.x, v.y, v.z, v.w}; }
    if (tid < 465) BL[tid] = P.in[I_RPB][((size_t)l * 8 + h) * 465 + tid] * na::LOG2E;
    __syncthreads();
    const int sA = 8 * (c16 >> 2) + (c16 & 3);
    const int ntask = latu ? 4 : 2;
    for (int it = 0; it < ntask; ++it) {
        const int tk = it * 8 + wid;
        int qrow, r = 0, jb = 0;
        if (latu) { r = q4 * 8 + (tk >> 2); jb = tk & 3; qrow = b * 2048 + r * 64 + jb * 16 + c16; }
        else qrow = NLAT + b * 256 + tk * 16 + c16;
        bf16x8 qf[2];
#pragma unroll
        for (int ks = 0; ks < 2; ++ks) qf[ks] = *(const bf16x8*)(z + (size_t)qrow * INC + C_NAQ + h * 64 + 32 * ks + 8 * kq);
        bf16_t* op = br + (size_t)qrow * OPN + h * 64 + 4 * kq; asm volatile("" : "+v"(op));
        na::Acc A; A.m = -INFINITY; A.l = 0.f;
#pragma unroll
        for (int db = 0; db < 4; ++db) A.o[db] = (f32x4){0.f, 0.f, 0.f, 0.f};
        if (latu) {
            const int r0 = min(max(r - 4, 0), 24), kc0 = min(max(jb * 16 - 8, 0), 32), qc = jb * 16 + c16, c0 = min(max(qc - 8, 0), 48);
            int dcol[8]; bool ok[8];
#pragma unroll
            for (int j = 0; j < 8; ++j) { const int kc = kc0 + 8 * kq + j; ok[j] = (kc >= c0) && (kc < c0 + 16); dcol[j] = ok[j] ? (kc - qc + 15) : 0; }
#pragma unroll 1
            for (int ch = 0; ch < 2; ++ch) {
                f32x4 sa[4], sb[4];
                const size_t tokbase = (size_t)b * 2048 + (size_t)(r0 + ch * 4) * 64 + kc0;
#pragma unroll
                for (int g = 0; g < 4; ++g) {
                    const bf16_t* kp = z + (tokbase + (size_t)g * 64 + sA) * INC + C_NAK + h * 64 + 8 * kq;
                    const bf16x8 kA0 = *(const bf16x8*)kp, kA1 = *(const bf16x8*)(kp + 32), kB0 = *(const bf16x8*)(kp + 4 * INC), kB1 = *(const bf16x8*)(kp + 4 * INC + 32);
                    f32x4 a = {0.f, 0.f, 0.f, 0.f}, bq = {0.f, 0.f, 0.f, 0.f};
                    a = __builtin_amdgcn_mfma_f32_16x16x32_bf16(kA0, qf[0], a, 0, 0, 0); a = __builtin_amdgcn_mfma_f32_16x16x32_bf16(kA1, qf[1], a, 0, 0, 0);
                    bq = __builtin_amdgcn_mfma_f32_16x16x32_bf16(kB0, qf[0], bq, 0, 0, 0); bq = __builtin_amdgcn_mfma_f32_16x16x32_bf16(kB1, qf[1], bq, 0, 0, 0);
                    const int brow = (r0 + ch * 4 + g - r + 7) * 31;
#pragma unroll
                    for (int j = 0; j < 4; ++j) {
                        sa[g][j] = ok[j] ? (a[j] * na::C2 + BL[brow + dcol[j]]) : -INFINITY;
                        sb[g][j] = ok[4 + j] ? (bq[j] * na::C2 + BL[brow + dcol[4 + j]]) : -INFINITY; }
                }
                const bf16_t* vp = vt + (size_t)c16 * 2304 + 256 + (r0 + ch * 4) * 64 + kc0 + 8 * kq;
                na::absorb(A, sa, sb, [&](int g, int db) { return *(const bf16x8*)(vp + (size_t)db * 16 * 2304 + g * 64); });
            }
        }
#pragma unroll 1
        for (int ch = 0; ch < 2; ++ch) {
            f32x4 sa[4], sb[4];
#pragma unroll
            for (int g = 0; g < 4; ++g) {
                const LAS unsigned char* kp = KL + (ch * 128 + g * 32 + sA) * na::KP + kq * 16;
                const bf16x8 kA0 = *(const LAS bf16x8*)kp, kA1 = *(const LAS bf16x8*)(kp + 64), kB0 = *(const LAS bf16x8*)(kp + 4 * na::KP), kB1 = *(const LAS bf16x8*)(kp + 4 * na::KP + 64);
                f32x4 a = {0.f, 0.f, 0.f, 0.f}, bq = {0.f, 0.f, 0.f, 0.f};
                a = __builtin_amdgcn_mfma_f32_16x16x32_bf16(kA0, qf[0], a, 0, 0, 0); a = __builtin_amdgcn_mfma_f32_16x16x32_bf16(kA1, qf[1], a, 0, 0, 0);
                bq = __builtin_amdgcn_mfma_f32_16x16x32_bf16(kB0, qf[0], bq, 0, 0, 0); bq = __builtin_amdgcn_mfma_f32_16x16x32_bf16(kB1, qf[1], bq, 0, 0, 0);
                sa[g] = a * na::C2; sb[g] = bq * na::C2;
            }
            const LAS unsigned char* vp = VL + c16 * na::VP + (ch * 128 + 8 * kq) * 2;
            na::absorb(A, sa, sb, [&](int g, int db) { return *(const LAS bf16x8*)(vp + db * 16 * na::VP + g * 64); });
        }
        float ls = A.l; ls += __shfl_xor(ls, 16, 64); ls += __shfl_xor(ls, 32, 64);
        const float inv = __builtin_amdgcn_rcpf(ls);
#pragma unroll
        for (int db = 0; db < 4; ++db) { uint2 o; o.x = pk_bf16(A.o[db][0] * inv, A.o[db][1] * inv); o.y = pk_bf16(A.o[db][2] * inv, A.o[db][3] * inv);
            *(uint2*)(op + 16 * db) = o; }
    }
}
__device__ __forceinline__ int hg_row(int b, int dir, int s) { return s < 256 ? (NLAT + b * 256 + (dir ? 255 - s : s)) : (b * 2048 + (dir ? 2047 - (s - 256) : (s - 256))); }
__device__ __forceinline__ bf16x8 tr2(const LAS unsigned char* p0, const LAS unsigned char* p1) {
    typedef short v4i16_t __attribute__((ext_vector_type(4)));
    const v4i16_t a = __builtin_amdgcn_ds_read_tr16_b64_v4i16((LAS v4i16_t*)p0), c = __builtin_amdgcn_ds_read_tr16_b64_v4i16((LAS v4i16_t*)p1);
    return (bf16x8){a[0], a[1], a[2], a[3], c[0], c[1], c[2], c[3]};
}
__device__ __forceinline__ void hgrn_unit(const Params& P, LAS unsigned char* lds, int l, int u) {
    const int tid = tid_(), lane = tid & 63, wid = __builtin_amdgcn_readfirstlane(tid >> 6), c16 = lane & 15, kq = lane >> 4;
    const int b = u >> 3, h = (u >> 1) & 3, dir = u & 1;
    const bf16_t* z = (const bf16_t*)(P.ws + WS_Z);
    float* O = (float*)(P.ws + (dir ? WS_Y : WS_H));
    const float* lbv = (const float*)(P.ws + WS_LB) + ((size_t)l * 2 + dir) * 512 + h * 128;
    constexpr int PQ = 272;
    LAS unsigned char* QH = lds; LAS unsigned char* KT = lds + 8704; LAS unsigned char* KH = lds + 17408; LAS unsigned char* VV = lds + 26112;
    LAS float* DL = (LAS float*)(lds + 34816); LAS float* WT = DL + 128;
    const int ch = 2 * lane;
    const float lb0 = lbv[ch], lb1 = lbv[ch + 1];
    const int cf = (dir ? C_HFB : C_HFF) + h * 128 + ch, cq = C_HQ + h * 128 + ch, cv = C_HI + h * 128 + ch;
    f32x4 SA[4], SB[4];
#pragma unroll
    for (int G = 0; G < 4; ++G) { SA[G] = (f32x4){0.f, 0.f, 0.f, 0.f}; SB[G] = (f32x4){0.f, 0.f, 0.f, 0.f}; }
    unsigned rf[4], rq[4], rv[4];
#pragma unroll
    for (int k = 0; k < 4; ++k) { const bf16_t* zr = z + (size_t)hg_row(b, dir, 4 * wid + k) * INC; rf[k] = *(const unsigned*)(zr + cf); rq[k] = *(const unsigned*)(zr + cq); rv[k] = *(const unsigned*)(zr + cv); }
    const int sA = 8 * (c16 >> 2) + (c16 & 3);
    const int tq = c16 >> 2, tp = c16 & 3;
    for (int st = 0; st < 72; ++st) {
        unsigned xf[4], xq[4], xv[4];
#pragma unroll
        for (int k = 0; k < 4; ++k) { xf[k] = rf[k]; xq[k] = rq[k]; xv[k] = rv[k]; }
        if (st + 1 < 72) {
#pragma unroll
            for (int k = 0; k < 4; ++k) { const bf16_t* zr = z + (size_t)hg_row(b, dir, (st + 1) * 32 + 4 * wid + k) * INC; rf[k] = *(const unsigned*)(zr + cf); rq[k] = *(const unsigned*)(zr + cq); rv[k] = *(const unsigned*)(zr + cv); }
        }
        float g0[4], g1[4], k0[4], k1[4], q0[4], q1[4];
        float c0 = 0.f, c1 = 0.f;
#pragma unroll
        for (int k = 0; k < 4; ++k) {
            const float f0 = lb0 + (1.0f - lb0) * sigmoidf_(bf_lo(xf[k])), f1 = lb1 + (1.0f - lb1) * sigmoidf_(bf_hi(xf[k]));
            c0 += __logf(f0); c1 += __logf(f1); g0[k] = c0; g1[k] = c1;
            k0[k] = 1.0f - f0; k1[k] = 1.0f - f1; q0[k] = siluf_(bf_lo(xq[k])); q1[k] = siluf_(bf_hi(xq[k]));
        }
        WT[wid * 128 + ch] = c0; WT[wid * 128 + ch + 1] = c1;
        __syncthreads();
        float pre0 = 0.f, pre1 = 0.f, tot0 = 0.f, tot1 = 0.f;
#pragma unroll
        for (int w = 0; w < 8; ++w) { const float a0 = WT[w * 128 + ch], a1 = WT[w * 128 + ch + 1]; const float m = (w < wid) ? 1.f : 0.f; tot0 += a0; tot1 += a1; pre0 += m * a0; pre1 += m * a1; }
#pragma unroll
        for (int k = 0; k < 4; ++k) {
            const float b0 = g0[k] + pre0, b1 = g1[k] + pre1;
            const int ro = (4 * wid + k) * PQ + ch * 2;
            *(LAS unsigned*)(QH + ro) = pk_bf16(q0[k] * __expf(b0), q1[k] * __expf(b1));
            *(LAS unsigned*)(KT + ro) = pk_bf16(k0[k] * __expf(-b0), k1[k] * __expf(-b1));
            *(LAS unsigned*)(KH + ro) = pk_bf16(k0[k] * __expf(tot0 - b0), k1[k] * __expf(tot1 - b1));
            *(LAS unsigned*)(VV + ro) = xv[k];
        }
        if (wid == 0) { DL[ch] = __expf(tot0); DL[ch + 1] = __expf(tot1); }
        __syncthreads();
        const bf16x8 vfr = tr2(VV + (8 * kq + tq) * PQ + (16 * wid + 4 * tp) * 2, VV + (8 * kq + 4 + tq) * PQ + (16 * wid + 4 * tp) * 2);
        bf16x8 Sb[4];
#pragma unroll
        for (int G = 0; G < 4; ++G) { const float sv[8] = {SA[G][0], SA[G][1], SA[G][2], SA[G][3], SB[G][0], SB[G][1], SB[G][2], SB[G][3]}; Sb[G] = pack8(sv); }
#pragma unroll
        for (int T = 0; T < 2; ++T) {
            f32x4 aA = {0.f, 0.f, 0.f, 0.f}, aB = {0.f, 0.f, 0.f, 0.f};
            bf16x8 qf[4];
#pragma unroll
            for (int ks = 0; ks < 4; ++ks) {
                const bf16x8 kA = *(const LAS bf16x8*)(KT + sA * PQ + (32 * ks + 8 * kq) * 2);
                const bf16x8 kB = *(const LAS bf16x8*)(KT + (sA + 4) * PQ + (32 * ks + 8 * kq) * 2);
                qf[ks] = *(const LAS bf16x8*)(QH + (16 * T + c16) * PQ + (32 * ks + 8 * kq) * 2);
                aA = __builtin_amdgcn_mfma_f32_16x16x32_bf16(kA, qf[ks], aA, 0, 0, 0);
                aB = __builtin_amdgcn_mfma_f32_16x16x32_bf16(kB, qf[ks], aB, 0, 0, 0);
            }
            const int t = 16 * T + c16;
            float pv_[8];
#pragma unroll
            for (int jj = 0; jj < 4; ++jj) { pv_[jj] = (8 * kq + jj <= t) ? aA[jj] : 0.f; pv_[4 + jj] = (8 * kq + 4 + jj <= t) ? aB[jj] : 0.f; }
            f32x4 o = {0.f, 0.f, 0.f, 0.f};
            o = __builtin_amdgcn_mfma_f32_16x16x32_bf16(pack8(pv_), vfr, o, 0, 0, 0);
#pragma unroll
            for (int ks = 0; ks < 4; ++ks) o = __builtin_amdgcn_mfma_f32_16x16x32_bf16(qf[ks], Sb[ks], o, 0, 0, 0);
#pragma unroll
            for (int jj = 0; jj < 4; ++jj) O[(size_t)hg_row(b, dir, st * 32 + 16 * T + 4 * kq + jj) * 512 + h * 128 + 16 * wid + c16] = o[jj];
        }
#pragma unroll
        for (int G = 0; G < 4; ++G) {
            const f32x4 d0 = *(const LAS f32x4*)(DL + 32 * G + 8 * kq), d1 = *(const LAS f32x4*)(DL + 32 * G + 8 * kq + 4);
            const LAS unsigned char* ka = KH + (8 * kq + tq) * PQ + (32 * G + 8 * tp) * 2;
            const bf16x8 hA = tr2(ka, ka + 4 * PQ), hB = tr2(ka + 8, ka + 4 * PQ + 8);
            SA[G] = __builtin_amdgcn_mfma_f32_16x16x32_bf16(hA, vfr, SA[G] * d0, 0, 0, 0);
            SB[G] = __builtin_amdgcn_mfma_f32_16x16x32_bf16(hB, vfr, SB[G] * d1, 0, 0, 0);
        }
    }
    __syncthreads();
}
__device__ __forceinline__ void gqa_unit(const Params& P, char* shm, int U) {
    const bf16_t* qn = (const bf16_t*)(P.ws + WS_QN); const bf16_t* kn = (const bf16_t*)(P.ws + WS_KN); const bf16_t* vn = (const bf16_t*)(P.ws + WS_VN);
    bf16_t* br = (bf16_t*)(P.ws + WS_BR);
    int b, hq, row0, NT;
    if (U < 512) { const int bg = U >> 5; b = bg >> 1; hq = (bg & 1) * 4 + ((U & 31) >> 3); row0 = b * 2048 + (U & 7) * 256; NT = 36; }
    else { const int v = U - 512; b = v >> 3; hq = v & 7; row0 = NLAT + b * 256; NT = 4; }
    const int g = hq >> 2;
    gqa::attn_unit<8>(qn + (size_t)row0 * 512 + hq * 64, kn + (size_t)b * 2304 * 128 + g * 64, vn + (size_t)b * 2304 * 128 + g * 64,
                      br + (size_t)row0 * BRW + 1024 + hq * 64, NT, shm);
}
__device__ __forceinline__ void ph_mix(const Params& P, LAS unsigned char* lds, char* shm, int l) {
    const int tid = tid_();
    unsigned* qctr = (unsigned*)(P.ws + WS_CNT + 512) + l;
    volatile LAS unsigned* qslot = (volatile LAS unsigned*)(lds + LDS_BYTES - 32);
    for (;;) {
        if (tid == 0) *qslot = __hip_atomic_fetch_add(qctr, 1u, __ATOMIC_RELAXED, __HIP_MEMORY_SCOPE_AGENT);
        __syncthreads();
        const int u = (int)*qslot;
        __syncthreads();
        if (u >= 960) break;
        if (u < 64) hgrn_unit(P, lds, l, u);
        else if (u < 576) gqa_unit(P, shm, u - 64);
        else if (u < 832) na_unit(P, lds, l, u - 576, (bf16_t*)(P.ws + WS_BR), BRW);
        else if (u < 896) gqa_unit(P, shm, 512 + (u - 832));
        else na_unit(P, lds, l, 256 + (u - 896), (bf16_t*)(P.ws + WS_BR), BRW);
        __syncthreads();
    }
}
#ifdef DIAG
__device__ __forceinline__ void ph_diag_cmp(const Params& P) {
    const bf16_t* br = (const bf16_t*)(P.ws + WS_BR); const bf16_t* d1 = (const bf16_t*)(P.ws + WS_END); const bf16_t* d2 = d1 + (size_t)NTOK * 512;
    const bf16_t* z = (const bf16_t*)(P.ws + WS_Z); const bf16_t* vt = (const bf16_t*)(P.ws + WS_NAVT);
    unsigned* dg = (unsigned*)(P.ws + 20480);
    unsigned c1 = 0, c2 = 0, c3 = 0;
    for (size_t i = (size_t)bid_() * NTHR + tid_(); i < (size_t)NTOK * 512; i += (size_t)gridDim.x * NTHR) {
        const size_t r = i >> 9; const int c = (int)(i & 511);
        const float a = bf2f(br[r * BRW + c]), x = bf2f(d1[i]);
        if (!(fabsf(x - a) <= 0.004f + 0.02f * fabsf(a))) ++c1;
        if (DIAG != 4 && d1[i] != d2[i]) ++c3;
        const int rr = (int)r; const int bb = rr < NLAT ? (rr >> 11) : ((rr - NLAT) >> 8); const int tok = rr < NLAT ? (256 + (rr & 2047)) : ((rr - NLAT) & 255);
        if (vt[((size_t)(bb * 8 + (c >> 6)) * 64 + (c & 63)) * 2304 + tok] != z[r * INC + C_NAV + c]) ++c2;
    }
    if (c1) atomicAdd(dg + 1, c1);
    if (c2) atomicAdd(dg + 2, c2);
    if (c3) atomicAdd(dg + 3, c3);
}
__device__ __forceinline__ void ph_diag_out(const Params& P) {
    const volatile unsigned* dg = (const volatile unsigned*)(P.ws + 20480);
    const unsigned c1 = dg[1], c2 = dg[2], c3 = dg[3];
    if ((c1 | c2 | c3) == 0) return;
    unsigned k = 0; { unsigned v = c1; while (v) { ++k; v >>= 1; } }
    if (c2) k += 30; if (c3) k += 60;
    const float cst = sqrtf(10.0f * (float)k + 9.0f);
    for (size_t i = (size_t)bid_() * NTHR + tid_(); i < (size_t)NLAT * D; i += (size_t)gridDim.x * NTHR) P.out[i] = cst;
}
#endif

__device__ __forceinline__ void ph_readout(const Params& P, int l) {
    const int tid = tid_(), lane = tid & 63, wid = tid >> 6;
    const float* OF = (const float*)(P.ws + WS_H); const float* OB = (const float*)(P.ws + WS_Y);
    const bf16_t* z = (const bf16_t*)(P.ws + WS_Z);
    bf16_t* br = (bf16_t*)(P.ws + WS_BR);
    const float g0 = P.in[I_HGN][l * 128 + lane * 2], g1 = P.in[I_HGN][l * 128 + lane * 2 + 1];
    for (int r = bid_() * 8 + wid; r < NTOK; r += gridDim.x * 8) {
#pragma unroll
        for (int h = 0; h < 4; ++h) {
            const int c = h * 128 + lane * 2;
            const float2 a = *(const float2*)(OF + (size_t)r * 512 + c), bb = *(const float2*)(OB + (size_t)r * 512 + c);
            const float o0 = a.x + bb.x, o1 = a.y + bb.y;
            const float ss = wave_sum(o0 * o0 + o1 * o1);
            const float rstd = __builtin_amdgcn_rsqf(ss * (1.0f / 128.0f) + 1e-6f);
            const unsigned gz = *(const unsigned*)(z + (size_t)r * INC + C_HG + c);
            *(unsigned*)(br + (size_t)r * BRW + 512 + c) = pk_bf16(o0 * rstd * g0 * siluf_(bf_lo(gz)), o1 * rstd * g1 * siluf_(bf_hi(gz)));
        }
    }
}
struct SchedMerge { int G, c; const char* br; const char* wb;
    __device__ __forceinline__ bool next(int i, pg8::Unit& u) const {
        const int tile = (i / 3) * G + c, bi = i % 3; if (tile >= (NTOK / 256) * 4) return false;
        const int pm = tile >> 2, pn = tile & 3;
        u.row0 = pm * 256; u.col0 = pn * 256; u.aux = bi;
        u.A = br + ((size_t)pm * 256 * BRW + bi * 512) * 2; u.B = wb + ((size_t)bi * 1024 + pn * 256) * 512 * 2; return true; } };
struct FMerge { bf16_t* Y; const bf16_t* z;
    __device__ __forceinline__ void operator()(const pg8::Unit& u, int row, int col, const f32x4& v0, const f32x4& v1) const {
        const bf16_t* gp = z + (size_t)row * INC + C_GATE + u.aux * 1024 + col;
        const uint2 g0 = *(const uint2*)gp, g1 = *(const uint2*)(gp + 16);
        uint2* y0 = (uint2*)(Y + (size_t)row * D + col); uint2* y1 = (uint2*)(Y + (size_t)row * D + col + 16);
        float a[4] = {0.f, 0.f, 0.f, 0.f}, b[4] = {0.f, 0.f, 0.f, 0.f};
        if (u.aux != 0) { const uint2 p0 = *y0, p1 = *y1;
            a[0] = bf_lo(p0.x); a[1] = bf_hi(p0.x); a[2] = bf_lo(p0.y); a[3] = bf_hi(p0.y);
            b[0] = bf_lo(p1.x); b[1] = bf_hi(p1.x); b[2] = bf_lo(p1.y); b[3] = bf_hi(p1.y); }
        a[0] += sigmoidf_(bf_lo(g0.x)) * v0[0]; a[1] += sigmoidf_(bf_hi(g0.x)) * v0[1]; a[2] += sigmoidf_(bf_lo(g0.y)) * v0[2]; a[3] += sigmoidf_(bf_hi(g0.y)) * v0[3];
        b[0] += sigmoidf_(bf_lo(g1.x)) * v1[0]; b[1] += sigmoidf_(bf_hi(g1.x)) * v1[1]; b[2] += sigmoidf_(bf_lo(g1.y)) * v1[2]; b[3] += sigmoidf_(bf_hi(g1.y)) * v1[3];
        uint2 o0, o1; o0.x = pk_bf16(a[0], a[1]); o0.y = pk_bf16(a[2], a[3]); o1.x = pk_bf16(b[0], b[1]); o1.y = pk_bf16(b[2], b[3]);
        *y0 = o0; *y1 = o1; } };
__device__ __forceinline__ void ph_merge(const Params& P, LAS unsigned char* lds) {
    SchedMerge S{(int)gridDim.x, bid_(), (const char*)(P.ws + WS_BR), (const char*)(P.ws + WS_WBR)};
    pg8::EpiPair<FMerge> E{{(bf16_t*)(P.ws + WS_Y), (const bf16_t*)(P.ws + WS_Z)}};
    pg8::gemm_phase(lds, pg8::Gemm{512, BRW, 512}, S, E);
}
struct FResid { float* X; const float* mods; int l;
    __device__ __forceinline__ void operator()(const pg8::Unit&, int row, int col, const f32x4& v0, const f32x4& v1) const {
        const float* gate = mods + ((size_t)l * 9 + row_modrow(row)) * 6144 + 2 * 1024;
        float4* p0 = (float4*)(X + (size_t)row * D + col); float4* p1 = (float4*)(X + (size_t)row * D + col + 16);
        const float4 g0 = *(const float4*)(gate + col), g1 = *(const float4*)(gate + col + 16);
        float4 a = *p0, b = *p1;
        a.x += g0.x * v0[0]; a.y += g0.y * v0[1]; a.z += g0.z * v0[2]; a.w += g0.w * v0[3];
        b.x += g1.x * v1[0]; b.y += g1.y * v1[1]; b.z += g1.z * v1[2]; b.w += g1.w * v1[3];
        *p0 = a; *p1 = b; } };
__device__ __forceinline__ void ph_wout(const Params& P, LAS unsigned char* lds, int l, bool dry = false) {
    pg8::SchedDense S{NTOK / 256, D / 256, (int)gridDim.x, bid_(), (const char*)(P.ws + WS_Y), (const char*)(P.ws + WS_WOUT), (size_t)256 * D * 2, (size_t)256 * D * 2};
    pg8::EpiPair<FResid> E{{(float*)(P.ws + (dry ? WS_END : WS_X)), (const float*)(P.ws + WS_MODS), l}};
    pg8::gemm_phase(lds, pg8::Gemm{D, D, D}, S, E);
}
__device__ __forceinline__ void ph_norm2_route(const Params& P, LAS unsigned char* lds, int l, bool dry = false) {
    const int tid = tid_(), lane = tid & 63, wid = tid >> 6;
    LAS float* Wt = (LAS float*)lds;
    LAS int* lcnt = (LAS int*)(lds + 81920); LAS int* lbase = lcnt + 16; LAS int* rinfo = lbase + 16;
    LAS float* rw = (LAS float*)(rinfo + 128 * 4);
    for (int i = tid; i < 20 * 1024; i += NTHR) { const int j = i >> 10, c = i & 1023;
        Wt[i] = (j < 4) ? P.in[I_WGR][((size_t)l * 1024 + c) * 4 + j] : P.in[I_WER][((size_t)l * 1024 + c) * 16 + (j - 4)]; }
    if (tid < 16) lcnt[tid] = 0;
    __syncthreads();
    const float* xres = (const float*)(P.ws + WS_X);
    bf16_t* f = (bf16_t*)(P.ws + (dry ? WS_END : WS_H));
    const float* g = P.in[I_GFFN] + l * 1024;
    int* cnt = (int*)(P.ws + (dry ? 32768 : WS_CNT)) + l * 16;
    int* sel_e = (int*)(P.ws + (dry ? WS_END + 40000000 : WS_SELE)); float* sel_w = (float*)(P.ws + (dry ? WS_END + 41000000 : WS_SELW)); int* sel_p = (int*)(P.ws + (dry ? WS_END + 42000000 : WS_SELP));
    const int r0 = bid_() * 8, rstep = gridDim.x * 8;
    int it = 0;
    for (int r = r0 + wid; r < NTOK; r += rstep, ++it) {
        const float* mod = (const float*)(P.ws + WS_MODS) + ((size_t)l * 9 + row_modrow(r)) * 6144;
        float4 x[4], o[4];
#pragma unroll
        for (int i = 0; i < 4; ++i) x[i] = *(const float4*)(xres + (size_t)r * D + lane * 4 + 256 * i);
        norm_row(x, g, mod + 3 * 1024, mod + 4 * 1024, lane, o);
#pragma unroll
        for (int i = 0; i < 4; ++i) { uint2 u; u.x = pk_bf16(o[i].x, o[i].y); u.y = pk_bf16(o[i].z, o[i].w); *(uint2*)(f + (size_t)r * D + lane * 4 + 256 * i) = u; }
        float lg[20];
#pragma unroll
        for (int j = 0; j < 20; ++j) {
            float s = 0.f;
#pragma unroll
            for (int i = 0; i < 4; ++i) { const f32x4 w = *(const LAS f32x4*)(Wt + j * 1024 + lane * 4 + 256 * i); s += o[i].x * w[0] + o[i].y * w[1] + o[i].z * w[2] + o[i].w * w[3]; }
            lg[j] = wave_sum(s);
        }
        if (lane == 0) {
            float gl[4]; int gi = 0;
#pragma unroll
            for (int j = 0; j < 4; ++j) gl[j] = lg[j] + P.in[I_BGR][l * 4 + j];
            float gm = gl[0];
#pragma unroll
            for (int j = 1; j < 4; ++j) if (gl[j] > gm) { gm = gl[j]; gi = j; }
            float se = 0.f;
#pragma unroll
            for (int j = 0; j < 4; ++j) se += __expf(gl[j] - gm);
            const float pg = __builtin_amdgcn_rcpf(se);
            float el[4];
#pragma unroll
            for (int j = 0; j < 4; ++j) {
                float v = 0.f;
#pragma unroll
                for (int q = 0; q < 4; ++q) v = (gi == q) ? lg[4 + q * 4 + j] : v;
                el[j] = v + P.in[I_BER][l * 16 + gi * 4 + j];
            }
            int i0 = 0; float v0 = el[0];
#pragma unroll
            for (int j = 1; j < 4; ++j) if (el[j] > v0) { v0 = el[j]; i0 = j; }
            int i1 = -1; float v1 = -INFINITY;
#pragma unroll
            for (int j = 0; j < 4; ++j) if (j != i0 && el[j] > v1) { v1 = el[j]; i1 = j; }
            const float w0 = __builtin_amdgcn_rcpf(1.0f + __expf(v1 - v0)), w1 = 1.0f - w0;
            const int e0 = gi * 4 + i0, e1 = gi * 4 + i1;
            const int slot = it * 8 + wid;
            rinfo[slot * 4 + 0] = e0 | (e1 << 8);
            rinfo[slot * 4 + 1] = __hip_atomic_fetch_add(&lcnt[e0], 1, __ATOMIC_RELAXED, __HIP_MEMORY_SCOPE_WORKGROUP);
            rinfo[slot * 4 + 2] = __hip_atomic_fetch_add(&lcnt[e1], 1, __ATOMIC_RELAXED, __HIP_MEMORY_SCOPE_WORKGROUP);
            rw[slot * 2] = w0 * pg; rw[slot * 2 + 1] = w1 * pg;
        }
    }
    __syncthreads();
    if (tid < 16) lbase[tid] = atomicAdd(&cnt[tid], lcnt[tid]);
    __syncthreads();
    for (int slot = tid; slot < 128; slot += NTHR) {
        const int r = r0 + (slot & 7) + (slot >> 3) * rstep;
        if (r < NTOK) { const int ee = rinfo[slot * 4], e0 = ee & 255, e1 = ee >> 8;
            sel_e[r * 2] = e0; sel_e[r * 2 + 1] = e1;
            sel_w[r * 2] = rw[slot * 2]; sel_w[r * 2 + 1] = rw[slot * 2 + 1];
            sel_p[r * 2] = lbase[e0] + rinfo[slot * 4 + 1]; sel_p[r * 2 + 1] = lbase[e1] + rinfo[slot * 4 + 2]; }
    }
    __syncthreads();
}
__device__ __forceinline__ void moe_offsets(const int* cnt, int (&off)[17]) {
    int a = 0;
#pragma unroll
    for (int e = 0; e < 16; ++e) { off[e] = a; a += (cnt[e] + 255) & ~255; }
    off[16] = a;
}
__device__ __forceinline__ void ph_scatter(const Params& P, int l) {
    const int tid = tid_(), lane = tid & 63, wid = tid >> 6;
    const int* cnt = (const int*)(P.ws + WS_CNT) + l * 16;
    int off[17]; moe_offsets(cnt, off);
    const bf16_t* f = (const bf16_t*)(P.ws + WS_H); bf16_t* Fs = (bf16_t*)(P.ws + WS_FS);
    const int* sel_e = (const int*)(P.ws + WS_SELE); const int* sel_p = (const int*)(P.ws + WS_SELP); int* srow = (int*)(P.ws + WS_SROW);
    for (int r = bid_() * 8 + wid; r < NTOK; r += gridDim.x * 8) {
        const uint4 a = *(const uint4*)(f + (size_t)r * D + lane * 8), b = *(const uint4*)(f + (size_t)r * D + 512 + lane * 8);
#pragma unroll
        for (int k = 0; k < 2; ++k) {
            const int e = sel_e[r * 2 + k];
            int o = 0;
#pragma unroll
            for (int q = 0; q < 16; ++q) o = (e == q) ? off[q] : o;
            const int d = o + sel_p[r * 2 + k];
            *(uint4*)(Fs + (size_t)d * D + lane * 8) = a; *(uint4*)(Fs + (size_t)d * D + 512 + lane * 8) = b;
            if (lane == 0) srow[r * 2 + k] = d;
        }
    }
}
struct SchedMoe { int NM, G, c; int tfirst[16]; const char* A; const char* W; size_t tA, eW, tW;
    __device__ __forceinline__ bool next(int i, pg8::Unit& u) const {
        const int L = i * G + c; if (L >= NM * 4) return false;
        const int pm = L >> 2, pn = L & 3;
        int e = 0;
#pragma unroll
        for (int q = 1; q < 16; ++q) e += (pm >= tfirst[q]) ? 1 : 0;
        u.row0 = pm * 256; u.col0 = pn * 256; u.aux = e; u.A = A + (size_t)pm * tA; u.B = W + (size_t)e * eW + (size_t)pn * tW; return true; } };
struct FSwiglu { bf16_t* H;
    __device__ __forceinline__ void operator()(const pg8::Unit&, int row, int col, const f32x4& v0, const f32x4& v1) const {
        const int hc = ((col & ~31) >> 1) + (col & 15);
        uint2 a; a.x = pk_bf16(siluf_(v0[0]) * v1[0], siluf_(v0[1]) * v1[1]); a.y = pk_bf16(siluf_(v0[2]) * v1[2], siluf_(v0[3]) * v1[3]);
        *(uint2*)(H + (size_t)row * EH + hc) = a; } };
__device__ __forceinline__ void moe_sched(const Params& P, int l, SchedMoe& S) {
    const int* cnt = (const int*)(P.ws + WS_CNT) + l * 16;
    int a = 0;
#pragma unroll
    for (int e = 0; e < 16; ++e) { S.tfirst[e] = a; a += (cnt[e] + 255) >> 8; }
    S.NM = a; S.G = (int)gridDim.x; S.c = bid_();
}
__device__ __forceinline__ void ph_moe1(const Params& P, LAS unsigned char* lds, int l) {
    SchedMoe S; moe_sched(P, l, S);
    S.A = (const char*)(P.ws + WS_FS); S.W = (const char*)(P.ws + WS_WGU); S.tA = (size_t)256 * D * 2; S.eW = (size_t)1024 * 1024 * 2; S.tW = (size_t)256 * 1024 * 2;
    pg8::EpiPair<FSwiglu> E{{(bf16_t*)(P.ws + WS_HS)}};
    pg8::gemm_phase(lds, pg8::Gemm{1024, 1024, 1024}, S, E);
}
__device__ __forceinline__ void ph_moe2(const Params& P, LAS unsigned char* lds, int l) {
    SchedMoe S; moe_sched(P, l, S);
    S.A = (const char*)(P.ws + WS_HS); S.W = (const char*)(P.ws + WS_WDN); S.tA = (size_t)256 * EH * 2; S.eW = (size_t)1024 * 512 * 2; S.tW = (size_t)256 * 512 * 2;
    pg8::EpiPair<FStoreBf16> E{{(bf16_t*)(P.ws + WS_YS), D}};
    pg8::gemm_phase(lds, pg8::Gemm{512, 512, 512}, S, E);
}
__device__ __forceinline__ void ph_combine(const Params& P, int l, bool dry = false) {
    const int tid = tid_(), lane = tid & 63, wid = tid >> 6;
    float* xres = (float*)(P.ws + WS_X);
    const bf16_t* Ys = (const bf16_t*)(P.ws + WS_YS);
    const float* sel_w = (const float*)(P.ws + WS_SELW); const int* srow = (const int*)(P.ws + WS_SROW);
    for (int r = bid_() * 8 + wid; r < NTOK; r += gridDim.x * 8) {
        const float* gate = (const float*)(P.ws + WS_MODS) + ((size_t)l * 9 + row_modrow(r)) * 6144 + 5 * 1024;
        const float w0 = sel_w[r * 2], w1 = sel_w[r * 2 + 1];
        const bf16_t* y0 = Ys + (size_t)srow[r * 2] * D; const bf16_t* y1 = Ys + (size_t)srow[r * 2 + 1] * D;
        float4 x[4];
        float ss = 0.f;
#pragma unroll
        for (int i = 0; i < 4; ++i) {
            const int c = lane * 4 + 256 * i;
            x[i] = *(const float4*)(xres + (size_t)r * D + c);
            const uint2 a = *(const uint2*)(y0 + c), b = *(const uint2*)(y1 + c);
            const float4 gv = *(const float4*)(gate + c);
            x[i].x += gv.x * (w0 * bf_lo(a.x) + w1 * bf_lo(b.x)); x[i].y += gv.y * (w0 * bf_hi(a.x) + w1 * bf_hi(b.x));
            x[i].z += gv.z * (w0 * bf_lo(a.y) + w1 * bf_lo(b.y)); x[i].w += gv.w * (w0 * bf_hi(a.y) + w1 * bf_hi(b.y));
            *(float4*)((dry ? (float*)(P.ws + WS_END) : xres) + (size_t)r * D + c) = x[i];
            ss += x[i].x * x[i].x + x[i].y * x[i].y + x[i].z * x[i].z + x[i].w * x[i].w;
        }
        if (l == DEPTH - 1 && r < NLAT) {
            ss = wave_sum(ss);
            const float rstd = __builtin_amdgcn_rsqf(ss * (1.0f / 1024.0f) + 1e-6f);
#pragma unroll
            for (int i = 0; i < 4; ++i) {
                const int c = lane * 4 + 256 * i;
                const float4 gv = *(const float4*)(P.in[I_GFIN] + c);
                float4 o; o.x = x[i].x * rstd * gv.x; o.y = x[i].y * rstd * gv.y; o.z = x[i].z * rstd * gv.z; o.w = x[i].w * rstd * gv.w;
                *(float4*)((dry ? (float*)(P.ws + WS_END) : P.out) + (size_t)r * D + c) = o;
            }
        }
    }
}

constexpr int NPH_LAYER = 12, NPH = 1 + DEPTH * NPH_LAYER;
#define CAS __attribute__((address_space(4)))
__device__ __forceinline__ const Params& kparams() { const CAS Params* k = (const CAS Params*)__builtin_amdgcn_kernarg_segment_ptr(); asm volatile("" : "+s"(k)); return *(const Params*)k; }
__global__ void __launch_bounds__(NTHR, 2) fwd(Params P_) {
    extern __shared__ __attribute__((aligned(16))) unsigned char lds_raw[];
    LAS unsigned char* lds = (LAS unsigned char*)lds_raw;
    volatile LAS unsigned* xbw = (volatile LAS unsigned*)(lds + LDS_BYTES - 16);
    if (threadIdx.x == 0) { xbw[0] = 0u; xbw[1] = 0u; xbw[2] = 0u; xbw[3] = 0u; }
    __syncthreads();
    const int lo = P_.ph_lo, hi = P_.ph_hi;
    XcdBarrier bar; bar.bar = (unsigned*)(P_.ws + WS_BAR); bar.x = 0; bar.st = xbw;
    if (hi - lo > 1) bar = xcd_barrier_post((unsigned*)(P_.ws + WS_BAR), xbw);
#ifndef PHMASK
#define PHMASK 0xFFFF
#endif
#define EN(j) ((PHMASK >> (j)) & 1)
#define IN(k) (lo <= (k) && (k) < hi)
#define SEAM(k) do { if (IN(k) && IN((k) + 1)) xcd_barrier(bar); } while (0)
    if (EN(12) && IN(0)) for (int rep = 0; rep < NREP(12); ++rep) { ph_prologue(kparams(), lds); }
    SEAM(0);
    for (int l = 0; l < DEPTH; ++l) {
        const int p0 = 1 + l * NPH_LAYER;
        if (EN(0) && IN(p0 + 0)) for (int rep = 0; rep < NREP(0); ++rep) { ph_wconv(kparams(), lds, l); ph_norm1(kparams(), l); }
        SEAM(p0 + 0);
        if (EN(1) && IN(p0 + 1)) for (int rep = 0; rep < NREP(1); ++rep) ph_g1(kparams(), lds);
        SEAM(p0 + 1);
        if (EN(2) && IN(p0 + 2)) for (int rep = 0; rep < NREP(2); ++rep) { ph_prep(kparams(), l); ph_navt(kparams(), lds); }
        SEAM(p0 + 2);
        if (EN(3) && IN(p0 + 3)) for (int rep = 0; rep < NREP(3); ++rep) ph_mix(kparams(), lds, (char*)lds_raw, l);
        SEAM(p0 + 3);
        if (EN(4) && IN(p0 + 4)) for (int rep = 0; rep < NREP(4); ++rep) {
#if defined(DIAG) && DIAG == 5
            { const Params& Pq = kparams(); const int G_ = gridDim.x, c_ = bid_(), vcu_ = (c_ % 8) * (G_ / 8) + c_ / 8; for (int u = vcu_; u < 320; u += G_) na_unit(Pq, lds, l, u, (bf16_t*)(Pq.ws + WS_BR), BRW); __syncthreads(); }
#endif
            ph_readout(kparams(), l);
#if defined(DIAG) && (DIAG == 1 || DIAG == 4)
            ph_diag_cmp(kparams());
#endif
#if defined(DIAG) && DIAG == 3
            { const Params& Pq = kparams(); const uint4* d1 = (const uint4*)(Pq.ws + WS_END); bf16_t* brq = (bf16_t*)(Pq.ws + WS_BR);
              for (size_t i = (size_t)bid_() * NTHR + tid_(); i < (size_t)NTOK * 64; i += (size_t)gridDim.x * NTHR) { const size_t r = i >> 6; const int c8 = (int)(i & 63) * 8; *(uint4*)(brq + r * BRW + c8) = d1[i]; } }
#endif
        }
        SEAM(p0 + 4);
        if (EN(5) && IN(p0 + 5)) for (int rep = 0; rep < NREP(5); ++rep) ph_merge(kparams(), lds);
        SEAM(p0 + 5);
        if (EN(6) && IN(p0 + 6)) for (int rep = 0; rep < NREP(6); ++rep) ph_wout(kparams(), lds, l, rep > 0);
        SEAM(p0 + 6);
        if (EN(7) && IN(p0 + 7)) for (int rep = 0; rep < NREP(7); ++rep) ph_norm2_route(kparams(), lds, l, rep > 0);
        SEAM(p0 + 7);
        if (EN(8) && IN(p0 + 8)) for (int rep = 0; rep < NREP(8); ++rep) ph_scatter(kparams(), l);
        SEAM(p0 + 8);
        if (EN(9) && IN(p0 + 9)) for (int rep = 0; rep < NREP(9); ++rep) ph_moe1(kparams(), lds, l);
        SEAM(p0 + 9);
        if (EN(10) && IN(p0 + 10)) for (int rep = 0; rep < NREP(10); ++rep) ph_moe2(kparams(), lds, l);
        SEAM(p0 + 10);
        if (EN(11) && IN(p0 + 11)) for (int rep = 0; rep < NREP(11); ++rep) ph_combine(kparams(), l, rep > 0);
        SEAM(p0 + 11);
    }
#if defined(DIAG) && (DIAG == 1 || DIAG == 4)
    xcd_barrier(bar); ph_diag_out(kparams());
#endif
#undef IN
#undef SEAM
}

#ifndef MK_PER_PHASE
#define MK_PER_PHASE 0
#endif
extern "C" void kernel_launch(void* const* d_in, const int* in_sizes, int n_in, void* d_out, int out_size, void* d_ws, size_t ws_size, hipStream_t stream) {
    static int grid = 0;
    if (grid == 0) {
        if (n_in != 24 || out_size != NLAT * D || ws_size < WS_END + (size_t)NTOK * 4096 + 4096) { fprintf(stderr, "kernel_launch: unexpected shapes (n_in %d out %d ws %zu need %zu)\n", n_in, out_size, ws_size, (size_t)WS_END); grid = -1; return; }
        int dev = 0, cus = 0, per_cu = 0;
        if (hipGetDevice(&dev) != hipSuccess || hipDeviceGetAttribute(&cus, hipDeviceAttributeMultiprocessorCount, dev) != hipSuccess) { grid = -1; return; }
        if (hipFuncSetAttribute((const void*)fwd, hipFuncAttributeMaxDynamicSharedMemorySize, LDS_BYTES) != hipSuccess) { fprintf(stderr, "kernel_launch: hipFuncSetAttribute failed\n"); grid = -1; return; }
        if (hipOccupancyMaxActiveBlocksPerMultiprocessor(&per_cu, (const void*)fwd, NTHR, LDS_BYTES) != hipSuccess || per_cu < 1) { fprintf(stderr, "kernel_launch: occupancy query says %d\n", per_cu); }
        (void)hipGetLastError();
        grid = cus;
    }
    if (grid < 0) return;
    (void)hipMemsetAsync(d_ws, 0, WS_ZERO_BYTES, stream);
    Params p{};
    for (int i = 0; i < 24; ++i) p.in[i] = (const float*)d_in[i];
    p.out = (float*)d_out; p.ws = (unsigned char*)d_ws;
#if MK_PER_PHASE
    for (int ph = 0; ph < NPH; ++ph) { p.ph_lo = ph; p.ph_hi = ph + 1; hipLaunchKernelGGL(fwd, dim3(grid), dim3(NTHR), LDS_BYTES, stream, p); }
#else
    p.ph_lo = 0; p.ph_hi = NPH; hipLaunchKernelGGL(fwd, dim3(grid), dim3(NTHR), LDS_BYTES, stream, p);
#endif
}
```

```cpp
#include <hip/hip_runtime.h>
#include <cstdio>
#include <cstdint>

#define LAS __attribute__((address_space(3)))
typedef unsigned short bf16_t;
typedef short bf16x8 __attribute__((ext_vector_type(8)));
typedef float f32x4 __attribute__((ext_vector_type(4)));
typedef unsigned u32x4 __attribute__((ext_vector_type(4)));

constexpr int D = 1024, NB = 8, SEQ = 2048, DEPTH = 4, CTXL = 256;
constexpr int NLAT = NB * SEQ, NCTX = NB * CTXL, NTOK = NLAT + NCTX;
constexpr int INC = 7936;
constexpr int ZP = 4864;
constexpr int C_NAQ = 0, C_NAK = 512, C_NAV = 1024, C_HQ = 1536, C_HFF = 2048, C_HFB = 2560, C_HI = 3072, C_HG = 3584,
              C_GQ = 4096, C_GK = 4608, C_GV = 4736, C_GATE = 4864;
constexpr int BRW = 1536;
constexpr int NEXP = 16, EH = 512;
constexpr int MPAD = 40960;
constexpr int NTHR = 512;
constexpr int LDS_BYTES = 147456;

constexpr size_t WS_BAR = 0;
constexpr size_t WS_CNT = 16384;
constexpr size_t WS_ZERO_BYTES = 65536;
constexpr size_t WS_MODS = 65536;
constexpr size_t WS_LB = WS_MODS + 884736;
constexpr size_t WS_ROPE = WS_LB + 16384;
constexpr size_t WS_SELE = WS_ROPE + 12288;
constexpr size_t WS_SELW = WS_SELE + 147456;
constexpr size_t WS_SELP = WS_SELW + 147456;
constexpr size_t WS_SROW = WS_SELP + 147456;
constexpr size_t WS_X = 2097152;
constexpr size_t WS_H = WS_X + (size_t)NTOK * D * 4;
constexpr size_t WS_Z = WS_H + (size_t)NTOK * D * 2;
constexpr size_t WS_GT = WS_Z + (size_t)NTOK * ZP * 2;
constexpr size_t WS_BR = WS_GT + (size_t)NTOK * 3072 * 2;
constexpr size_t WS_Y = WS_BR + (size_t)NTOK * BRW * 2;
constexpr size_t WS_QN = WS_Y + (size_t)NTOK * D * 2;
constexpr size_t WS_KN = WS_QN + (size_t)NTOK * 512 * 2;
constexpr size_t WS_VN = WS_KN + (size_t)NTOK * 128 * 2;
constexpr size_t WS_NAVT = WS_VN + (size_t)NTOK * 128 * 2;
constexpr size_t WS_WIN = WS_NAVT + (size_t)NTOK * 512 * 2;
constexpr size_t WS_WBR = WS_WIN + (size_t)INC * D * 2;
constexpr size_t WS_WOUT = WS_WBR + (size_t)3 * D * 512 * 2;
constexpr size_t WS_WGU = WS_WOUT + (size_t)D * D * 2;
constexpr size_t WS_WDN = WS_WGU + (size_t)NEXP * 1024 * 1024 * 2;
constexpr size_t WS_END = WS_WDN + (size_t)NEXP * 1024 * 512 * 2;
constexpr size_t WS_FS = WS_Z;
constexpr size_t WS_HS = WS_FS + (size_t)MPAD * 1024 * 2;
constexpr size_t WS_YS = WS_HS + (size_t)MPAD * 512 * 2;
static_assert(WS_YS + (size_t)MPAD * 1024 * 2 <= WS_BR, "moe alias");
static_assert(WS_SROW + 147456 <= WS_X, "ctl");

#define XB_TMO      128
#define XB_XCNT(j)  (256  + 64 * (j))
#define XB_XSUB(j)  (1280 + 64 * (j))
#define XB_XGEN(j)  (2304 + 64 * (j))
#define XB_TOP      3328
#define XB_TOPGEN   3392
#define XCD_BAR_WORDS 3456
#define XB_SPIN_CAP (1u << 22)
__device__ __forceinline__ unsigned xb_ld(unsigned* p)              { return __hip_atomic_load(p, __ATOMIC_RELAXED, __HIP_MEMORY_SCOPE_AGENT); }
__device__ __forceinline__ unsigned xb_add(unsigned* p, unsigned v) { return __hip_atomic_fetch_add(p, v, __ATOMIC_RELAXED, __HIP_MEMORY_SCOPE_AGENT); }
__device__ __forceinline__ unsigned xb_xcc_id() { return (unsigned)__builtin_amdgcn_s_getreg((3 << 11) | 20) & 0xFu; }
#define XB_SPIN(cond, bar) do { unsigned _sp = 0; while (cond) { __builtin_amdgcn_s_sleep(1); \
    if ((++_sp & 255u) == 0u) { if (xb_ld(&(bar)[XB_TMO])) break; if (_sp > XB_SPIN_CAP) { atomicAdd(&(bar)[XB_TMO], 1u); break; } } } } while (0)
struct XcdBarrier { unsigned* bar; unsigned x; volatile LAS unsigned* st; };
__device__ __forceinline__ XcdBarrier xcd_barrier_post(unsigned* bar, volatile LAS unsigned* st) {
    XcdBarrier b; b.bar = bar; b.x = xb_xcc_id(); b.st = st;
    if (threadIdx.x == 0) (void)xb_add(&bar[XB_XCNT(b.x)], 1u);
    return b;
}
__device__ __forceinline__ void xcd_barrier_complete(unsigned* bar, unsigned x, unsigned& nloc, unsigned& nx) {
    const unsigned G = gridDim.x * gridDim.y * gridDim.z;
    unsigned sum, cnt, mine, sp = 0u;
    for (;;) {
        sum = 0u; cnt = 0u; mine = 0u;
#pragma unroll
        for (unsigned j = 0; j < 16; ++j) { const unsigned c = xb_ld(&bar[XB_XCNT(j)]); sum += c; cnt += (c > 0u) ? 1u : 0u; mine = (j == x) ? c : mine; }
        if (sum == G) break;
        __builtin_amdgcn_s_sleep(1);
        if ((++sp & 255u) == 0u) { if (xb_ld(&bar[XB_TMO])) break; if (sp > XB_SPIN_CAP) { atomicAdd(&bar[XB_TMO], 1u); break; } }
    }
    nloc = mine > 0u ? mine : 1u; nx = cnt > 0u ? cnt : 1u;
}
__device__ __forceinline__ void xcd_barrier(const XcdBarrier& b) {
    asm volatile("s_waitcnt vmcnt(0)" ::: "memory");
    __syncthreads();
    if (threadIdx.x == 0) {
        unsigned* bar = b.bar;
        __builtin_amdgcn_s_waitcnt(0);
        unsigned nloc = b.st[0], nx = b.st[1];
        if (nloc == 0u) { xcd_barrier_complete(bar, b.x, nloc, nx); b.st[0] = nloc; b.st[1] = nx; }
        const unsigned old = xb_add(&bar[XB_XSUB(b.x)], 1u);
        const unsigned gen = old / nloc;
        if (old + 1u == (gen + 1u) * nloc) {
            __builtin_amdgcn_fence(__ATOMIC_RELEASE, "agent");
            asm volatile("s_waitcnt vmcnt(0)" ::: "memory");
            const unsigned og = xb_add(&bar[XB_TOP], 1u);
            const unsigned tg = og / nx;
            if (og + 1u == (tg + 1u) * nx) xb_add(&bar[XB_TOPGEN], 1u);
            else XB_SPIN(xb_ld(&bar[XB_TOPGEN]) == tg, bar);
            __builtin_amdgcn_fence(__ATOMIC_ACQUIRE, "agent");
            xb_add(&bar[XB_XGEN(b.x)], 1u);
            asm volatile("s_waitcnt vmcnt(0)" ::: "memory");
        } else {
            XB_SPIN(xb_ld(&bar[XB_XGEN(b.x)]) == gen, bar);
            __builtin_amdgcn_fence(__ATOMIC_ACQUIRE, "agent");
            asm volatile("s_waitcnt vmcnt(0)" ::: "memory");
        }
    }
    __syncthreads();
}

__device__ __forceinline__ float bf_lo(unsigned u) { return __uint_as_float(u << 16); }
__device__ __forceinline__ float bf_hi(unsigned u) { return __uint_as_float(u & 0xffff0000u); }
__device__ __forceinline__ float bf2f(bf16_t b) { return __uint_as_float(((unsigned)b) << 16); }
typedef float pkf32x2_t __attribute__((ext_vector_type(2))); typedef __bf16 pkbf16x2_t __attribute__((ext_vector_type(2)));
__device__ __forceinline__ unsigned pk_bf16(float lo, float hi) { pkf32x2_t v = {lo, hi}; pkbf16x2_t b = __builtin_convertvector(v, pkbf16x2_t); return __builtin_bit_cast(unsigned, b); }
__device__ __forceinline__ bf16x8 pack8(const float (&v)[8]) { u32x4 u = {pk_bf16(v[0], v[1]), pk_bf16(v[2], v[3]), pk_bf16(v[4], v[5]), pk_bf16(v[6], v[7])}; return __builtin_bit_cast(bf16x8, u); }
__device__ __forceinline__ float sigmoidf_(float x) { return __builtin_amdgcn_rcpf(1.0f + __expf(-x)); }
__device__ __forceinline__ float siluf_(float x) { return x * __builtin_amdgcn_rcpf(1.0f + __expf(-x)); }
__device__ __forceinline__ float dpp_f(float v, const int ctrl_sel) {
    const int x = __float_as_int(v);
    int r;
    if (ctrl_sel == 0) r = __builtin_amdgcn_update_dpp(0, x, 0xB1, 0xF, 0xF, true);
    else if (ctrl_sel == 1) r = __builtin_amdgcn_update_dpp(0, x, 0x4E, 0xF, 0xF, true);
    else if (ctrl_sel == 2) r = __builtin_amdgcn_update_dpp(0, x, 0x141, 0xF, 0xF, true);
    else r = __builtin_amdgcn_update_dpp(0, x, 0x140, 0xF, 0xF, true);
    return __int_as_float(r);
}
__device__ __forceinline__ float wave_sum(float v) {
    v += dpp_f(v, 0); v += dpp_f(v, 1); v += dpp_f(v, 2); v += dpp_f(v, 3);
    { auto rr = __builtin_amdgcn_permlane16_swap(__float_as_uint(v), __float_as_uint(v), false, false); v = __uint_as_float(rr[0]) + __uint_as_float(rr[1]); }
    { auto rr = __builtin_amdgcn_permlane32_swap(__float_as_uint(v), __float_as_uint(v), false, false); v = __uint_as_float(rr[0]) + __uint_as_float(rr[1]); }
    return v;
}

__device__ __forceinline__ int tid_() { int t = threadIdx.x; asm volatile("" : "+v"(t)); return t; }
__device__ __forceinline__ int bid_() { int t = blockIdx.x; asm volatile("" : "+s"(t)); return t; }
#ifndef REPEAT_MASK
#define REPEAT_MASK 0
#endif
#define NREP(j) (((REPEAT_MASK >> (j)) & 1) ? 2 : 1)
struct Params {
    const float* in[24];
    float* out;
    unsigned char* ws;
    int ph_lo, ph_hi;
};
enum { I_X = 0, I_C, I_CTX, I_CCTX, I_WADA, I_BADA, I_GMIX, I_GFFN, I_WIN, I_RPB, I_LBL, I_HGN, I_QNG, I_KNG, I_WBR, I_WOUT,
       I_WGR, I_BGR, I_WER, I_BER, I_WEG, I_WEU, I_WED, I_GFIN };

__device__ __forceinline__ void g128_kloop(f32x4 (&acc)[4][4], LAS unsigned char* lds, const bf16_t* A, int lda, const bf16_t* Bt, int ldb, int K) {
    const int tid = tid_(), wid = tid >> 6, lane = tid & 63, wr = wid >> 2, wc = wid & 3, fr = lane & 15, fq = lane >> 4;
    LAS unsigned char* SA = lds; LAS unsigned char* SB = lds + 8192;
    const int srow = tid >> 2, skc = (tid & 3) * 8;
    const bf16_t* ap = A + (size_t)srow * lda + skc;
    const bf16_t* bp0 = Bt + (size_t)srow * ldb + skc;
    const bf16_t* bp1 = Bt + (size_t)(srow + 128) * ldb + skc;
    for (int k0 = 0; k0 < K; k0 += 32) {
        const uint4 va = *(const uint4*)(ap + k0);
        const uint4 vb0 = *(const uint4*)(bp0 + k0);
        const uint4 vb1 = *(const uint4*)(bp1 + k0);
        __syncthreads();
        *(LAS u32x4*)(SA + tid * 16) = (u32x4){va.x, va.y, va.z, va.w};
        *(LAS u32x4*)(SB + tid * 16) = (u32x4){vb0.x, vb0.y, vb0.z, vb0.w};
        *(LAS u32x4*)(SB + 8192 + tid * 16) = (u32x4){vb1.x, vb1.y, vb1.z, vb1.w};
        __syncthreads();
        bf16x8 At[4], Bf[4];
#pragma unroll
        for (int m = 0; m < 4; ++m) At[m] = *(const LAS bf16x8*)(SA + ((wr * 64 + m * 16 + fr) * 32 + fq * 8) * 2);
#pragma unroll
        for (int n = 0; n < 4; ++n) Bf[n] = *(const LAS bf16x8*)(SB + ((wc * 64 + n * 16 + fr) * 32 + fq * 8) * 2);
#pragma unroll
        for (int m = 0; m < 4; ++m)
#pragma unroll
            for (int n = 0; n < 4; ++n) acc[m][n] = __builtin_amdgcn_mfma_f32_16x16x32_bf16(Bf[n], At[m], acc[m][n], 0, 0, 0);
    }
}
__device__ __forceinline__ void acc_zero(f32x4 (&acc)[4][4]) {
#pragma unroll
    for (int m = 0; m < 4; ++m)
#pragma unroll
        for (int n = 0; n < 4; ++n) acc[m][n] = (f32x4){0.f, 0.f, 0.f, 0.f};
}
template <class Epi>
__device__ __forceinline__ void g128_epilogue(const f32x4 (&acc)[4][4], int row0, int col0, const Epi& E) {
    const int tid = tid_(), wid = tid >> 6, lane = tid & 63, wr = wid >> 2, wc = wid & 3, fr = lane & 15, fq = lane >> 4;
#pragma unroll
    for (int m = 0; m < 4; ++m)
#pragma unroll
        for (int n = 0; n < 4; n += 2) E(row0 + wr * 64 + m * 16 + fr, col0 + wc * 64 + n * 16 + fq * 4, acc[m][n], acc[m][n + 1]);
}


namespace pg8 {
constexpr int BM = 256, BK = 64, HALF = 128, HTB = HALF * BK * 2, STAGE_BYTES = 8 * HTB;
__device__ __forceinline__ int lds_byte(int r, int c) { const int st = (r >> 4) * 2 + (c >> 5), rr = r & 15, cc = c & 31, ob = rr * 64 + cc * 2; return st * 1024 + (ob ^ (((ob >> 9) & 1) << 5)); }
__device__ __forceinline__ void stage_rc(int b, int& R, int& C) { const int st = b / 1024, sb = b % 1024, swz = sb ^ (((sb >> 9) & 1) << 5); R = (st >> 1) * 16 + swz / 64; C = (st & 1) * 32 + (swz % 64) / 2; }
struct Unit { int row0, col0, aux; const char* A; const char* B; };
struct Gemm { int K, lda, ldb; };
template <class Epi, class Sched>
__device__ __forceinline__ void gemm_phase(LAS unsigned char* lds, const Gemm g, const Sched& S, const Epi& E) {
    const int tid = tid_(), wid = __builtin_amdgcn_readfirstlane(tid >> 6), lane = tid & 63, wr = wid >> 2, wc = wid & 3, fr = lane & 15, fq = lane >> 4;
    const int K = g.K, nt = K / BK;
    unsigned voffA[2], voffB[2];
#pragma unroll
    for (int i = 0; i < 2; ++i) { int R, C; stage_rc(tid * 16 + i * 8192, R, C);
        voffA[i] = (unsigned)(R * g.lda + C) * 2u; voffB[i] = (unsigned)(R * g.ldb + C) * 2u; }
    const size_t kstep = (size_t)(BK * 2);
    const size_t hstepA = (size_t)HALF * g.lda * 2, hstepB = (size_t)HALF * g.ldb * 2;
    const unsigned ldsw = (unsigned)wid * 1024u;
    const int aoff = lds_byte(wr * 64 + fr, fq * 8), boff = lds_byte(wc * 32 + fr, fq * 8);
#define PG8_SA(b, h) (((b) * 2 + (h)) * HTB)
#define PG8_SB(b, h) ((4 + (b) * 2 + (h)) * HTB)
#define PG8_STAGE(bufoff, gbase, voff) do { _Pragma("unroll") for (int _i = 0; _i < 2; ++_i) \
        __builtin_amdgcn_global_load_lds((const unsigned*)((const char*)(gbase) + (voff)[_i]), (LAS unsigned*)(lds + (bufoff) + ldsw + _i * 8192), 16, 0, 0); } while (0)
#define PG8_LDA(dst, b, h) do { _Pragma("unroll") for (int m = 0; m < 4; ++m) _Pragma("unroll") for (int k = 0; k < 2; ++k) dst[m][k] = *(const LAS bf16x8*)(lds + PG8_SA(b, h) + aoff + m * 2048 + k * 1024); } while (0)
#define PG8_LDB(dst, b, h) do { _Pragma("unroll") for (int n = 0; n < 2; ++n) _Pragma("unroll") for (int k = 0; k < 2; ++k) dst[n][k] = *(const LAS bf16x8*)(lds + PG8_SB(b, h) + boff + n * 2048 + k * 1024); } while (0)
#define PG8_MMA(ai, bj, At, Bt) do { __builtin_amdgcn_s_setprio(1); _Pragma("unroll") for (int m = 0; m < 4; ++m) _Pragma("unroll") for (int n = 0; n < 2; ++n) _Pragma("unroll") for (int k = 0; k < 2; ++k) \
        acc[ai][bj][m][n] = __builtin_amdgcn_mfma_f32_16x16x32_bf16(Bt[n][k], At[m][k], acc[ai][bj][m][n], 0, 0, 0); __builtin_amdgcn_s_setprio(0); } while (0)
#define PG8_WAIT_V(n) asm volatile("s_waitcnt vmcnt(" #n ")" ::: "memory")
#define PG8_WAIT_L(n) asm volatile("s_waitcnt lgkmcnt(" #n ")" ::: "memory")
#define PG8_BAR __builtin_amdgcn_s_barrier()
#define PG8_SCHED __builtin_amdgcn_sched_barrier(0)
    Unit cur, nxt; int ui = 0;
    if (!S.next(0, cur)) return;
    f32x4 acc[2][2][4][2];
#pragma unroll
    for (int a = 0; a < 2; ++a)
#pragma unroll
        for (int b = 0; b < 2; ++b)
#pragma unroll
            for (int m = 0; m < 4; ++m)
#pragma unroll
                for (int n = 0; n < 2; ++n) acc[a][b][m][n] = (f32x4){0.f, 0.f, 0.f, 0.f};
    bf16x8 At[4][2], B0[2][2], B1[2][2];
    const char* cA = cur.A; const char* cB = cur.B;
    PG8_STAGE(PG8_SB(0, 0), cB, voffB); PG8_STAGE(PG8_SA(0, 0), cA, voffA); PG8_STAGE(PG8_SB(0, 1), cB + hstepB, voffB); PG8_STAGE(PG8_SA(0, 1), cA + hstepA, voffA);
    if (wr == 1) PG8_BAR;
    PG8_WAIT_V(4); PG8_BAR;
    PG8_STAGE(PG8_SB(1, 0), cB + kstep, voffB); PG8_STAGE(PG8_SA(1, 0), cA + kstep, voffA); PG8_STAGE(PG8_SB(1, 1), cB + hstepB + kstep, voffB);
    PG8_WAIT_V(6); PG8_BAR;
    for (;;) {
        const bool has_next = S.next(ui + 1, nxt);
        const char* nA = has_next ? nxt.A : cA; const char* nB = has_next ? nxt.B : cB;
        for (int t = 0; t < nt; t += 2) {
            const bool last = (t == nt - 2);
            const char* a1 = cA + (size_t)(t + 1) * kstep;
            const char* a2 = last ? nA : cA + (size_t)(t + 2) * kstep; const char* b2 = last ? nB : cB + (size_t)(t + 2) * kstep;
            const char* a3 = a2 + kstep; const char* b3 = b2 + kstep;
            PG8_LDB(B0, 0, 0); PG8_SCHED; PG8_LDA(At, 0, 0); PG8_STAGE(PG8_SA(1, 1), a1 + hstepA, voffA);
            PG8_WAIT_L(8); PG8_BAR; PG8_WAIT_L(0); PG8_MMA(0, 0, At, B0); PG8_BAR; PG8_SCHED;
            PG8_LDB(B1, 0, 1); PG8_STAGE(PG8_SB(0, 0), b2, voffB);
            PG8_BAR; PG8_WAIT_L(0); PG8_MMA(0, 1, At, B1); PG8_BAR;
            PG8_LDA(At, 0, 1); PG8_STAGE(PG8_SA(0, 0), a2, voffA);
            PG8_BAR; PG8_WAIT_L(0); PG8_MMA(1, 0, At, B0); PG8_BAR; PG8_SCHED;
            PG8_STAGE(PG8_SB(0, 1), b2 + hstepB, voffB);
            PG8_WAIT_V(6); PG8_BAR; PG8_MMA(1, 1, At, B1); PG8_BAR;
            PG8_LDB(B0, 1, 0); PG8_SCHED; PG8_LDA(At, 1, 0); PG8_STAGE(PG8_SA(0, 1), a2 + hstepA, voffA);
            PG8_WAIT_L(8); PG8_BAR; PG8_WAIT_L(0); PG8_MMA(0, 0, At, B0); PG8_BAR; PG8_SCHED;
            PG8_LDB(B1, 1, 1); PG8_STAGE(PG8_SB(1, 0), b3, voffB);
            PG8_BAR; PG8_WAIT_L(0); PG8_MMA(0, 1, At, B1); PG8_BAR;
            PG8_LDA(At, 1, 1); PG8_STAGE(PG8_SA(1, 0), a3, voffA);
            PG8_BAR; PG8_WAIT_L(0); PG8_MMA(1, 0, At, B0); PG8_BAR; PG8_SCHED;
            PG8_STAGE(PG8_SB(1, 1), b3 + hstepB, voffB);
            PG8_WAIT_V(6); PG8_BAR; PG8_MMA(1, 1, At, B1); PG8_BAR;
        }
        E(acc, cur, wr, wc, fr, fq);
        if (!has_next) break;
#pragma unroll
        for (int a = 0; a < 2; ++a)
#pragma unroll
            for (int b = 0; b < 2; ++b)
#pragma unroll
                for (int m = 0; m < 4; ++m)
#pragma unroll
                    for (int n = 0; n < 2; ++n) acc[a][b][m][n] = (f32x4){0.f, 0.f, 0.f, 0.f};
        cur = nxt; cA = nA; cB = nB; ++ui;
    }
    PG8_WAIT_V(0);
    if (wr == 0) PG8_BAR;
    PG8_BAR;
#undef PG8_SA
#undef PG8_SB
#undef PG8_STAGE
#undef PG8_LDA
#undef PG8_LDB
#undef PG8_MMA
#undef PG8_WAIT_V
#undef PG8_WAIT_L
#undef PG8_BAR
#undef PG8_SCHED
}
template <class F> struct EpiPair { F f;
    __device__ __forceinline__ void operator()(const f32x4 (&acc)[2][2][4][2], const Unit& u, int wr, int wc, int fr, int fq) const {
#pragma unroll
        for (int ai = 0; ai < 2; ++ai)
#pragma unroll
            for (int m = 0; m < 4; ++m)
#pragma unroll
                for (int bj = 0; bj < 2; ++bj) f(u, u.row0 + ai * HALF + wr * 64 + m * 16 + fr, u.col0 + bj * HALF + wc * 32 + 4 * fq, acc[ai][bj][m][0], acc[ai][bj][m][1]);
    } };
struct SchedDense { int nM, nN, G, c; const char* A; const char* B; size_t tA, tB;
    __device__ __forceinline__ bool next(int i, Unit& u) const {
        const int nwg = nM * nN; const long L = (long)i * G + c; if (L >= nwg) return false;
        int wgid = (int)L; { const int q = nwg / 8, r = nwg % 8, xcd = wgid % 8, off = wgid / 8; wgid = (xcd < r ? xcd * (q + 1) : r * (q + 1) + (xcd - r) * q) + off; }
        const int nig = 8 * nN, gid = wgid / nig, fm = gid * 8, gsz = (nM - fm) < 8 ? (nM - fm) : 8;
        const int pm = fm + ((wgid % nig) % gsz), pn = (wgid % nig) / gsz;
        u.row0 = pm * 256; u.col0 = pn * 256; u.aux = 0; u.A = A + (size_t)pm * tA; u.B = B + (size_t)pn * tB; return true; } };
}


namespace gqa {
using f32x16 = __attribute__((ext_vector_type(16))) float;
using s16x4 = __attribute__((ext_vector_type(4))) short;
constexpr int QP = 512, KVP = 128, OP = BRW;
constexpr int NW = 8, QBLK = 32, KVBLK = 64;
__device__ __forceinline__ int crow(int r, int hi) { return (r & 3) + 8 * (r >> 2) + 4 * hi; }
#define SBAR() __builtin_amdgcn_sched_barrier(0)
constexpr int NSLOT = 3, SLOTB = 8192;
constexpr int LDS_K = 0, LDS_V = NSLOT * SLOTB, LDS_WS = 2 * NSLOT * SLOTB, LDS_OST = LDS_WS + NW * 64 * 4, LDS_BYTES_ = LDS_OST + NW * 4096;
__device__ __forceinline__ void glds16(const void* gsrc, unsigned lds_dst) { unsigned keep;
  asm volatile("s_mov_b32 %0, m0\n\ts_mov_b32 m0, %2\n\ts_nop 0\n\tglobal_load_lds_dwordx4 %1, off\n\ts_mov_b32 m0, %0" : "=&s"(keep) : "v"(gsrc), "s"(lds_dst) : "memory"); }
__device__ __forceinline__ float max3f(float a, float b, float c) { float r; asm("v_max3_f32 %0, %1, %2, %3" : "=v"(r) : "v"(a), "v"(b), "v"(c)); return r; }
__device__ __forceinline__ float max2f(float a, float b) { float r; asm("v_max_f32_e32 %0, %1, %2" : "=v"(r) : "v"(a), "v"(b)); return r; }
__device__ __forceinline__ float fadd_s(float a, float b) { float r; asm("v_add_f32_e32 %0, %1, %2" : "=v"(r) : "v"(a), "v"(b)); return r; }
__device__ __forceinline__ float fsub_s(float a, float b) { float r; asm("v_sub_f32_e32 %0, %1, %2" : "=v"(r) : "v"(a), "v"(b)); return r; }
typedef float f32x2_t __attribute__((ext_vector_type(2))); typedef __bf16 bf16x2_t __attribute__((ext_vector_type(2)));
__device__ __forceinline__ unsigned cvtpk_s(float lo, float hi) { f32x2_t v = {lo, hi}; bf16x2_t b = __builtin_convertvector(v, bf16x2_t); return __builtin_bit_cast(unsigned, b); }
#define WAIT_BAR(N) asm volatile("s_waitcnt vmcnt(" #N ") lgkmcnt(0)\n\ts_barrier" ::: "memory")
__device__ __forceinline__ void qkt(f32x16& p0, f32x16& p1, const char* Kslot, const bf16x8* qr, const f32x16& negm, int r32, int hi) {
  const char* kb = Kslot + hi * 1024 + r32 * 16;
  #pragma unroll
  for (int d0 = 0; d0 < 4; ++d0) {
    const bf16x8 b0 = *reinterpret_cast<const bf16x8*>(kb + d0 * 2048);
    const bf16x8 b1 = *reinterpret_cast<const bf16x8*>(kb + d0 * 2048 + 512);
    if (d0 == 0) { p0 = __builtin_amdgcn_mfma_f32_32x32x16_bf16(b0, qr[0], negm, 0, 0, 0); p1 = __builtin_amdgcn_mfma_f32_32x32x16_bf16(b1, qr[0], negm, 0, 0, 0); }
    else { p0 = __builtin_amdgcn_mfma_f32_32x32x16_bf16(b0, qr[d0], p0, 0, 0, 0); p1 = __builtin_amdgcn_mfma_f32_32x32x16_bf16(b1, qr[d0], p1, 0, 0, 0); } }
}
typedef __attribute__((address_space(3))) const char* lds_cptr;
typedef short v4i16_t __attribute__((ext_vector_type(4)));
__device__ __forceinline__ void kload8(bf16x8* kf, lds_cptr kp) {
  kf[0] = *(const LAS bf16x8*)(kp);        kf[1] = *(const LAS bf16x8*)(kp + 512);
  kf[2] = *(const LAS bf16x8*)(kp + 2048); kf[3] = *(const LAS bf16x8*)(kp + 2560);
  kf[4] = *(const LAS bf16x8*)(kp + 4096); kf[5] = *(const LAS bf16x8*)(kp + 4608);
  kf[6] = *(const LAS bf16x8*)(kp + 6144); kf[7] = *(const LAS bf16x8*)(kp + 6656);
}
__device__ __forceinline__ void kload2(bf16x8* kf, lds_cptr kp, int j) { kf[2 * j] = *(const LAS bf16x8*)(kp + j * 2048); kf[2 * j + 1] = *(const LAS bf16x8*)(kp + j * 2048 + 512); }
__device__ __forceinline__ s16x4 vtr(lds_cptr p) { return __builtin_bit_cast(s16x4, __builtin_amdgcn_ds_read_tr16_b64_v4i16((LAS v4i16_t*)p)); }
__device__ __forceinline__ float rowmax(const f32x16& p0, const f32x16& p1) {
  float a = max3f(p0[0], p0[1], p1[0]), b = max3f(p0[2], p0[3], p1[1]); a = max3f(a, p1[2], p1[3]);
  #pragma unroll
  for (int r = 4; r < 16; r += 4) { a = max3f(a, p0[r], p0[r + 1]); b = max3f(b, p0[r + 2], p0[r + 3]); a = max3f(a, p1[r], p1[r + 1]); b = max3f(b, p1[r + 2], p1[r + 3]); }
  const float m = max2f(a, b);
  auto rr = __builtin_amdgcn_permlane32_swap(__float_as_uint(m), __float_as_uint(m), false, false);
  return max2f(__uint_as_float(rr[0]), __uint_as_float(rr[1]));
}
__device__ __forceinline__ void pv(f32x16* o, int vb, bf16x8 pa0, bf16x8 pa1, bf16x8 pa2, bf16x8 pa3) {
  #pragma unroll
  for (int d0 = 0; d0 < 2; ++d0) { s16x4 lo[4], hi[4];
    #pragma unroll
    for (int ks = 0; ks < 4; ++ks) {
      asm volatile("ds_read_b64_tr_b16 %0,%1 offset:%c2" : "=&v"(lo[ks]) : "v"(vb), "i"(d0 * 4096 + ks * 1024) : "memory");
      asm volatile("ds_read_b64_tr_b16 %0,%1 offset:%c2" : "=&v"(hi[ks]) : "v"(vb), "i"(d0 * 4096 + ks * 1024 + 512) : "memory"); }
    asm volatile("s_waitcnt lgkmcnt(0)" ::: "memory"); SBAR();
    #define PK(k) (bf16x8){lo[k][0], lo[k][1], lo[k][2], lo[k][3], hi[k][0], hi[k][1], hi[k][2], hi[k][3]}
    o[d0] = __builtin_amdgcn_mfma_f32_32x32x16_bf16(pa0, PK(0), o[d0], 0, 0, 0);
    o[d0] = __builtin_amdgcn_mfma_f32_32x32x16_bf16(pa1, PK(1), o[d0], 0, 0, 0);
    o[d0] = __builtin_amdgcn_mfma_f32_32x32x16_bf16(pa2, PK(2), o[d0], 0, 0, 0);
    o[d0] = __builtin_amdgcn_mfma_f32_32x32x16_bf16(pa3, PK(3), o[d0], 0, 0, 0);
    #undef PK
  }
}
template <int THRL> __device__ __forceinline__ void attn_unit(const bf16_t* Qu, const bf16_t* __restrict__ Kh, const bf16_t* __restrict__ Vh, bf16_t* Ou, const int NT, char* shm) {
  const int tid = tid_(), lane = tid & 63, r32 = lane & 31, hi = lane >> 5; const int wid = __builtin_amdgcn_readfirstlane(tid >> 6);
  const bf16_t* Qw = Qu + (long)wid * QBLK * QP;
  const unsigned lds0 = (unsigned)(uintptr_t)shm;
  float* wsf = (float*)(shm + LDS_WS) + wid * 64;
  const bf16_t* ksrc = Kh + (long)lane * KVP + wid * 8;
  const bf16_t* vsrc = Vh + (long)(16 * (wid & 3) + (lane >> 2)) * KVP + (wid >> 2) * 32 + (lane & 3) * 8;
  const unsigned kdst = lds0 + LDS_K + wid * 1024, vdst = lds0 + LDS_V + wid * 1024;
  #define DMA_K(t, slot) glds16(ksrc + (long)(t) * KVBLK * KVP, (unsigned)__builtin_amdgcn_readfirstlane(kdst + (slot)))
  #define DMA_V(t, slot) glds16(vsrc + (long)(t) * KVBLK * KVP, (unsigned)__builtin_amdgcn_readfirstlane(vdst + (slot)))
  const int vb0 = (int)(lds0 + LDS_V) + ((lane >> 4) & 1) * 32 + (lane & 3) * 8 + (4 * hi + ((lane & 15) >> 2)) * 64;
  const char* Kbase = shm + LDS_K; bf16x8 kf[8];
  const lds_cptr shm3 = (lds_cptr)shm; const lds_cptr kp0 = shm3 + LDS_K + hi * 1024 + r32 * 16; const lds_cptr vp0 = shm3 + LDS_V + ((lane >> 4) & 1) * 32 + (lane & 3) * 8 + (4 * hi + ((lane & 15) >> 2)) * 64;
  DMA_K(0, 0); DMA_V(0, 0); DMA_K(1, SLOTB);
  bf16x8 qr[4];
  #pragma unroll
  for (int d0 = 0; d0 < 4; ++d0) qr[d0] = *reinterpret_cast<const bf16x8*>(&Qw[(long)r32 * QP + d0 * 16 + hi * 8]);
  float mhat = 0.f, l_reg = 0.f; f32x16 o[2]; o[0] = f32x16{}; o[1] = f32x16{}; f32x16 negm = f32x16{}; asm volatile("" : "+v"(negm));
  bool resc = false;
  #define START(P0, P1) do { const float rm = rowmax(P0, P1); resc = false; \
    { const float dl = rm; mhat = fadd_s(mhat, dl); \
      _Pragma("unroll") for (int r = 0; r < 16; ++r) { P0[r] = fsub_s(P0[r], dl); P1[r] = fsub_s(P1[r], dl); } \
      _Pragma("unroll") for (int r = 0; r < 16; ++r) negm[r] = -mhat; asm volatile("" : "+v"(negm)); } \
    _Pragma("unroll") for (int r = 0; r < 16; ++r) P0[r] = __builtin_amdgcn_exp2f(P0[r]); } while (0)
  #define RESC() do { if (resc) { asm volatile("s_waitcnt lgkmcnt(0)" ::: "memory"); \
      _Pragma("unroll") for (int d_ = 0; d_ < 2; ++d_) _Pragma("unroll") for (int r = 0; r < 16; ++r) o[d_][r] *= wsf[crow(r, hi)]; } } while (0)
  f32x16 pA0, pA1, pB0, pB1;
  int sl_prev = 0, sl_cur = 0, sl_next = SLOTB;
  #define ROT() do { sl_prev = sl_cur; sl_cur = sl_next; sl_next = (sl_next == (NSLOT - 1) * SLOTB) ? 0 : sl_next + SLOTB; } while (0)
  DMA_K(2, 2 * SLOTB);
  WAIT_BAR(3);
  qkt(pA0, pA1, Kbase, qr, negm, r32, hi); asm volatile("s_nop 15\n\ts_nop 7" : "+v"(pA0), "+v"(pA1));
  START(pA0, pA1);
  _Pragma("unroll") for (int r = 0; r < 16; ++r) pA1[r] = __builtin_amdgcn_exp2f(pA1[r]);
  WAIT_BAR(0);
  DMA_K(3, 0); DMA_V(1, SLOTB);
  ROT();
  kload8(kf, kp0 + sl_cur);
  WAIT_BAR(2);
  s16x4 vlo[8], vhi[8]; u32x4 pw0, pw1, pw2, pw3;
  #define PKW(P, B) cvtpk_s(P[B], P[B + 1])
  #define PAF(k) __builtin_bit_cast(bf16x8, pw##k)
  #define VFR(i) (bf16x8){vlo[i][0], vlo[i][1], vlo[i][2], vlo[i][3], vhi[i][0], vhi[i][1], vhi[i][2], vhi[i][3]}
  #define PIN(x) asm volatile("" : "+v"(x))
  #define MX3(a, b, c) __builtin_fmaxf(__builtin_fmaxf((a), (b)), (c))
  #define GAPA(MF, A0, A1, A2, A3, W0, W1, PW) do { MF; sacc += A0; sacc += A1; sacc += A2; sacc += A3; PIN(sacc); W0; W1; PIN(PW); SBAR(); } while (0)
  #define EX(v) __builtin_amdgcn_exp2f(v)
  #define GAPB(MF, X, B) do { MF; X[B] = EX(X[B]); X[B + 1] = EX(X[B + 1]); X[B + 2] = EX(X[B + 2]); X[B + 3] = EX(X[B + 3]); PIN(X); SBAR(); } while (0)
  #define VRD(i) do { vlo[i] = vtr(vp_ + (((i) >> 2) * 4096 + ((i) & 3) * 1024)); vhi[i] = vtr(vp_ + (((i) >> 2) * 4096 + ((i) & 3) * 1024 + 512)); } while (0)
  #define KRD(G, j) do { if (G) { kload2(kf, kp0 + sl_next, j); SBAR(); } } while (0)
  #define STEP(C0, C1, P0, P1, t, GK, GV, GL) do { SBAR(); \
    const lds_cptr vp_ = vp0 + sl_prev; \
    VRD(0); SBAR(); float sacc = (P0[0] + P0[1]); \
    GAPA(C0 = __builtin_amdgcn_mfma_f32_32x32x16_bf16(kf[0], qr[0], negm, 0, 0, 0), P0[2], P0[3], P0[4], P0[5],     pw0[0] = PKW(P0, 0), pw0[1] = PKW(P0, 2), pw0); \
    VRD(4); SBAR(); GAPA(C1 = __builtin_amdgcn_mfma_f32_32x32x16_bf16(kf[1], qr[0], negm, 0, 0, 0), P0[6], P0[7], P0[8], P0[9],     pw0[2] = PKW(P0, 4), pw0[3] = PKW(P0, 6), pw0); \
    VRD(1); SBAR(); GAPA(C0 = __builtin_amdgcn_mfma_f32_32x32x16_bf16(kf[2], qr[1], C0, 0, 0, 0),   P0[10], P0[11], P0[12], P0[13], pw1[0] = PKW(P0, 8), pw1[1] = PKW(P0, 10), pw1); \
    VRD(5); SBAR(); GAPA(C1 = __builtin_amdgcn_mfma_f32_32x32x16_bf16(kf[3], qr[1], C1, 0, 0, 0),   P0[14], P0[15], P1[0], P1[1],   pw1[2] = PKW(P0, 12), pw1[3] = PKW(P0, 14), pw1); \
    VRD(2); SBAR(); GAPA(C0 = __builtin_amdgcn_mfma_f32_32x32x16_bf16(kf[4], qr[2], C0, 0, 0, 0),   P1[2], P1[3], P1[4], P1[5],     pw2[0] = PKW(P1, 0), pw2[1] = PKW(P1, 2), pw2); \
    VRD(6); SBAR(); GAPA(C1 = __builtin_amdgcn_mfma_f32_32x32x16_bf16(kf[5], qr[2], C1, 0, 0, 0),   P1[6], P1[7], P1[8], P1[9],     pw2[2] = PKW(P1, 4), pw2[3] = PKW(P1, 6), pw2); \
    VRD(3); SBAR(); GAPA(C0 = __builtin_amdgcn_mfma_f32_32x32x16_bf16(kf[6], qr[3], C0, 0, 0, 0),   P1[10], P1[11], P1[12], P1[13], pw3[0] = PKW(P1, 8), pw3[1] = PKW(P1, 10), pw3); \
    VRD(7); SBAR(); GAPA(C1 = __builtin_amdgcn_mfma_f32_32x32x16_bf16(kf[7], qr[3], C1, 0, 0, 0),   P1[14], P1[15], 0.f, 0.f,       pw3[2] = PKW(P1, 12), pw3[3] = PKW(P1, 14), pw3); \
    l_reg += sacc; \
    if (GK) { DMA_K((t) + 3, sl_cur); } if (GV) { DMA_V((t) + 1, sl_next); } \
    { float a = MX3(C0[0], C0[1], C1[0]), b = MX3(C0[2], C0[3], C1[1]); a = MX3(a, C1[2], C1[3]); \
      _Pragma("unroll") for (int r = 4; r < 16; r += 4) { a = MX3(a, C0[r], C0[r + 1]); b = MX3(b, C0[r + 2], C0[r + 3]); a = MX3(a, C1[r], C1[r + 1]); b = MX3(b, C1[r + 2], C1[r + 3]); } \
      float rm = __builtin_fmaxf(a, b); { auto rr = __builtin_amdgcn_permlane32_swap(__float_as_uint(rm), __float_as_uint(rm), false, false); rm = __builtin_fmaxf(__uint_as_float(rr[0]), __uint_as_float(rr[1])); } \
      resc = false; \
      if (__builtin_expect(__any(rm > (float)THRL), 0)) { const float dl = __builtin_fmaxf(rm, 0.f); mhat += dl; \
        _Pragma("unroll") for (int r = 0; r < 16; ++r) { C0[r] -= dl; C1[r] -= dl; } \
        _Pragma("unroll") for (int r = 0; r < 16; ++r) negm[r] = -mhat; asm volatile("" : "+v"(negm)); \
        const float f = __builtin_amdgcn_exp2f(-dl); l_reg *= f; if (hi == 0) wsf[r32] = f; resc = true; } } \
    SBAR(); \
    GAPB(o[0] = __builtin_amdgcn_mfma_f32_32x32x16_bf16(PAF(0), VFR(0), o[0], 0, 0, 0), C0, 0); \
    GAPB(o[1] = __builtin_amdgcn_mfma_f32_32x32x16_bf16(PAF(0), VFR(4), o[1], 0, 0, 0), C0, 4); \
    KRD(GL, 0); GAPB(o[0] = __builtin_amdgcn_mfma_f32_32x32x16_bf16(PAF(1), VFR(1), o[0], 0, 0, 0), C0, 8); \
    KRD(GL, 1); GAPB(o[1] = __builtin_amdgcn_mfma_f32_32x32x16_bf16(PAF(1), VFR(5), o[1], 0, 0, 0), C0, 12); \
    KRD(GL, 2); GAPB(o[0] = __builtin_amdgcn_mfma_f32_32x32x16_bf16(PAF(2), VFR(2), o[0], 0, 0, 0), C1, 0); \
    KRD(GL, 3); GAPB(o[1] = __builtin_amdgcn_mfma_f32_32x32x16_bf16(PAF(2), VFR(6), o[1], 0, 0, 0), C1, 4); \
    GAPB(o[0] = __builtin_amdgcn_mfma_f32_32x32x16_bf16(PAF(3), VFR(3), o[0], 0, 0, 0), C1, 8); \
    GAPB(o[1] = __builtin_amdgcn_mfma_f32_32x32x16_bf16(PAF(3), VFR(7), o[1], 0, 0, 0), C1, 12); \
    } while (0)
  int t = 1;
  for (; t + 5 < NT; t += 2) {
    STEP(pB0, pB1, pA0, pA1, t, true, true, true);     WAIT_BAR(2); RESC(); ROT();
    STEP(pA0, pA1, pB0, pB1, t + 1, true, true, true); WAIT_BAR(2); RESC(); ROT();
  }
  #define ENDW(tt) do { if ((tt) + 3 < NT) { WAIT_BAR(2); } else if ((tt) + 2 < NT) { WAIT_BAR(1); } else { WAIT_BAR(0); } } while (0)
  for (; t + 1 < NT; t += 2) {
    STEP(pB0, pB1, pA0, pA1, t, (t + 3 < NT), (t + 1 < NT), (t + 1 < NT));         ENDW(t);     RESC(); ROT();
    STEP(pA0, pA1, pB0, pB1, t + 1, (t + 4 < NT), (t + 2 < NT), (t + 2 < NT));     ENDW(t + 1); RESC(); ROT();
  }
  STEP(pB0, pB1, pA0, pA1, NT - 1, false, false, false); RESC();
  { float sacc = pB0[0] + pB0[1]; _Pragma("unroll") for (int r = 2; r < 16; ++r) sacc += pB0[r]; _Pragma("unroll") for (int r = 0; r < 16; ++r) sacc += pB1[r]; l_reg += sacc;
    pw0 = (u32x4){PKW(pB0, 0), PKW(pB0, 2), PKW(pB0, 4), PKW(pB0, 6)}; pw1 = (u32x4){PKW(pB0, 8), PKW(pB0, 10), PKW(pB0, 12), PKW(pB0, 14)}; pw2 = (u32x4){PKW(pB1, 0), PKW(pB1, 2), PKW(pB1, 4), PKW(pB1, 6)}; pw3 = (u32x4){PKW(pB1, 8), PKW(pB1, 10), PKW(pB1, 12), PKW(pB1, 14)};
    SBAR(); pv(o, vb0 + sl_cur, PAF(0), PAF(1), PAF(2), PAF(3)); }
  #undef PKW
  #undef PAF
  #undef VFR
  #undef PIN
  #undef MX3
  #undef GAPA
  #undef GAPB
  #undef EX
  #undef VRD
  #undef KRD
  #undef STEP
  #undef ENDW
  { auto rr = __builtin_amdgcn_permlane32_swap(__float_as_uint(l_reg), __float_as_uint(l_reg), false, false); l_reg = __uint_as_float(rr[0]) + __uint_as_float(rr[1]); }
  if (hi == 0) wsf[32 + r32] = l_reg; asm volatile("s_waitcnt lgkmcnt(0)" ::: "memory");
  float rli[16];
  #pragma unroll
  for (int r = 0; r < 16; ++r) rli[r] = __builtin_amdgcn_rcpf(wsf[32 + crow(r, hi)]);
  bf16_t* Ow = Ou + (long)wid * QBLK * OP;
  { bf16_t* stg = (bf16_t*)(shm + LDS_OST) + wid * 2048;
    #pragma unroll
    for (int r = 0; r < 16; ++r) { const int orow = crow(r, hi);
      #pragma unroll
      for (int d0 = 0; d0 < 2; ++d0) stg[orow * 64 + d0 * 32 + r32] = (bf16_t)(cvtpk_s(o[d0][r] * rli[r], 0.f) & 0xffffu); }
    asm volatile("s_waitcnt lgkmcnt(0)" ::: "memory");
    #pragma unroll
    for (int i = 0; i < 4; ++i) { const int row = i * 8 + (lane >> 3), ch = lane & 7; const u32x4 v = *(const u32x4*)(stg + row * 64 + ch * 8); *(u32x4*)(Ow + (long)row * OP + ch * 8) = v; } }
  asm volatile("s_waitcnt lgkmcnt(0)\n\ts_barrier" ::: "memory");
  #undef DMA_K
  #undef DMA_V
  #undef START
  #undef RESC
  #undef ROT
}
#undef SBAR
#undef WAIT_BAR
}

__device__ __forceinline__ void ph_prologue(const Params& P, LAS unsigned char* lds) {
    const int tid = tid_(), bid = bid_(), G = gridDim.x;
    float* mods = (float*)(P.ws + WS_MODS);
    if (bid < 48) {
        LAS float* sc = (LAS float*)lds;
        for (int i = tid; i < 9 * 1024; i += NTHR) { const float v = (i < 8192) ? P.in[I_C][i] : P.in[I_CCTX][i - 8192]; sc[i] = siluf_(v); }
        __syncthreads();
        const int l = bid / 12, col = (bid % 12) * 512 + tid;
        const float* w = P.in[I_WADA] + (size_t)l * 1024 * 6144 + col;
        float a[9];
#pragma unroll
        for (int r = 0; r < 9; ++r) a[r] = 0.f;
        for (int k = 0; k < 1024; ++k) {
            const float wv = w[(size_t)k * 6144];
#pragma unroll
            for (int r = 0; r < 9; ++r) a[r] += sc[r * 1024 + k] * wv;
        }
        const float bb = P.in[I_BADA][l * 6144 + col];
#pragma unroll
        for (int r = 0; r < 9; ++r) mods[((size_t)l * 9 + r) * 6144 + col] = a[r] + bb;
    } else if (bid == 48) {
        float* lbv = (float*)(P.ws + WS_LB);
        for (int i = tid; i < 1024; i += NTHR) {
            float lg[DEPTH], mx = -1e30f;
#pragma unroll
            for (int l = 0; l < DEPTH; ++l) { lg[l] = P.in[I_LBL][l * 1024 + i]; mx = fmaxf(mx, lg[l]); }
            float s = 0.f;
#pragma unroll
            for (int l = 0; l < DEPTH; ++l) { lg[l] = expf(lg[l] - mx); s += lg[l]; }
            float cum = 0.f;
#pragma unroll
            for (int l = 0; l < DEPTH; ++l) { if (l > 0) cum += lg[l] / s; lbv[l * 1024 + i] = cum; }
        }
        float* rope = (float*)(P.ws + WS_ROPE);
        for (int i = tid; i < 96 * 16; i += NTHR) {
            const int pos = i >> 4, fi = i & 15;
            const float inv = powf(10000.0f, -(float)fi / 16.0f);
            const float p = (pos < 32) ? (float)pos : (float)(pos - 32);
            const float ang = p * inv;
            if (pos < 32) { rope[pos * 16 + fi] = cosf(ang); rope[512 + pos * 16 + fi] = sinf(ang); }
            else { rope[1024 + (pos - 32) * 16 + fi] = cosf(ang); rope[2048 + (pos - 32) * 16 + fi] = sinf(ang); }
        }
    }
    float4* xr = (float4*)(P.ws + WS_X);
    const float4* xs = (const float4*)P.in[I_X]; const float4* cs = (const float4*)P.in[I_CTX];
    const size_t nx4 = (size_t)NLAT * D / 4, nc4 = (size_t)NCTX * D / 4;
    for (size_t i = (size_t)bid * NTHR + tid; i < nx4 + nc4; i += (size_t)G * NTHR) xr[i] = (i < nx4) ? xs[i] : cs[i - nx4];
}

__device__ __forceinline__ void conv_tile(LAS float* t, const float* srcA, const float* srcB, int ld, bool inter, bf16_t* dst, int K, int n0, int k0) {
    const int tid = tid_();
    {
        const int nn = tid & 63, kk = tid >> 6, n = n0 + nn;
        const float* cp;
        if (!inter) cp = srcA + n; else { const int g = n >> 5, i = n & 31; cp = (i < 16) ? (srcA + 16 * g + i) : (srcB + 16 * g + i - 16); }
#pragma unroll
        for (int p = 0; p < 8; ++p) { const int k = kk + 8 * p; t[k * 65 + nn] = cp[(size_t)(k0 + k) * ld]; }
    }
    __syncthreads();
    {
        const int n = tid >> 3, k8 = (tid & 7) * 8;
        float v[8];
#pragma unroll
        for (int j = 0; j < 8; ++j) v[j] = t[(k8 + j) * 65 + n];
        uint4 o; o.x = pk_bf16(v[0], v[1]); o.y = pk_bf16(v[2], v[3]); o.z = pk_bf16(v[4], v[5]); o.w = pk_bf16(v[6], v[7]);
        *(uint4*)(dst + (size_t)(n0 + n) * K + k0 + k8) = o;
    }
    __syncthreads();
}
__device__ __forceinline__ void ph_wconv(const Params& P, LAS unsigned char* lds, int l) {
    LAS float* t = (LAS float*)lds;
    const int bid = bid_(), G = gridDim.x;
    constexpr int T_IN = 16 * 124, T_BR = 3 * 8 * 16, T_OUT = 16 * 16, T_GU = 16 * 16 * 16, T_DN = 16 * 8 * 16;
    constexpr int TOT = T_IN + T_BR + T_OUT + T_GU + T_DN;
    for (int u = bid; u < TOT; u += G) {
        int v = u;
        if (v < T_IN) { const int kt = v % 16, nt = v / 16;
            conv_tile(t, P.in[I_WIN] + (size_t)l * 1024 * INC, nullptr, INC, false, (bf16_t*)(P.ws + WS_WIN), 1024, nt * 64, kt * 64); continue; }
        v -= T_IN;
        if (v < T_BR) { const int i = v / 128, w = v % 128, kt = w % 8, nt = w / 8;
            conv_tile(t, P.in[I_WBR] + ((size_t)l * 3 + i) * 512 * 1024, nullptr, 1024, false, (bf16_t*)(P.ws + WS_WBR) + (size_t)i * 1024 * 512, 512, nt * 64, kt * 64); continue; }
        v -= T_BR;
        if (v < T_OUT) { const int kt = v % 16, nt = v / 16;
            conv_tile(t, P.in[I_WOUT] + (size_t)l * 1024 * 1024, nullptr, 1024, false, (bf16_t*)(P.ws + WS_WOUT), 1024, nt * 64, kt * 64); continue; }
        v -= T_OUT;
        if (v < T_GU) { const int e = v / 256, w = v % 256, kt = w % 16, nt = w / 16;
            const size_t eo = ((size_t)l * NEXP + e) * 1024 * 512;
            conv_tile(t, P.in[I_WEG] + eo, P.in[I_WEU] + eo, 512, true, (bf16_t*)(P.ws + WS_WGU) + (size_t)e * 1024 * 1024, 1024, nt * 64, kt * 64); continue; }
        v -= T_GU;
        { const int e = v / 128, w = v % 128, kt = w % 8, nt = w / 8;
            conv_tile(t, P.in[I_WED] + ((size_t)l * NEXP + e) * 512 * 1024, nullptr, 1024, false, (bf16_t*)(P.ws + WS_WDN) + (size_t)e * 1024 * 512, 512, nt * 64, kt * 64); }
    }
}

__device__ __forceinline__ void norm_row(const float4 (&x)[4], const float* g, const float* shift, const float* scale, int lane, float4 (&o)[4]) {
    float ss = 0.f;
#pragma unroll
    for (int i = 0; i < 4; ++i) ss += x[i].x * x[i].x + x[i].y * x[i].y + x[i].z * x[i].z + x[i].w * x[i].w;
    ss = wave_sum(ss);
    const float rstd = __builtin_amdgcn_rsqf(ss * (1.0f / 1024.0f) + 1e-6f);
#pragma unroll
    for (int i = 0; i < 4; ++i) {
        const int c = lane * 4 + 256 * i;
        const float4 gv = *(const float4*)(g + c), sh = *(const float4*)(shift + c), sc = *(const float4*)(scale + c);
        o[i].x = x[i].x * rstd * gv.x * (1.0f + sc.x) + sh.x;
        o[i].y = x[i].y * rstd * gv.y * (1.0f + sc.y) + sh.y;
        o[i].z = x[i].z * rstd * gv.z * (1.0f + sc.z) + sh.z;
        o[i].w = x[i].w * rstd * gv.w * (1.0f + sc.w) + sh.w;
    }
}
__device__ __forceinline__ int row_modrow(int r) { return r < NLAT ? (r >> 11) : 8; }

__device__ __forceinline__ void ph_norm1(const Params& P, int l) {
    const int tid = tid_(), lane = tid & 63, wid = tid >> 6;
    const float* xres = (const float*)(P.ws + WS_X);
    bf16_t* h = (bf16_t*)(P.ws + WS_H);
    const float* g = P.in[I_GMIX] + l * 1024;
    for (int r = bid_() * 8 + wid; r < NTOK; r += gridDim.x * 8) {
        const float* mod = (const float*)(P.ws + WS_MODS) + ((size_t)l * 9 + row_modrow(r)) * 6144;
        float4 x[4], o[4];
#pragma unroll
        for (int i = 0; i < 4; ++i) x[i] = *(const float4*)(xres + (size_t)r * D + lane * 4 + 256 * i);
        norm_row(x, g, mod, mod + 1024, lane, o);
#pragma unroll
        for (int i = 0; i < 4; ++i) { uint2 u; u.x = pk_bf16(o[i].x, o[i].y); u.y = pk_bf16(o[i].z, o[i].w); *(uint2*)(h + (size_t)r * D + lane * 4 + 256 * i) = u; }
    }
}

struct EpiStoreBf16 { bf16_t* O; int ldc;
    __device__ __forceinline__ void operator()(int row, int col, const f32x4& v0, const f32x4& v1) const {
        uint2 a, b; a.x = pk_bf16(v0[0], v0[1]); a.y = pk_bf16(v0[2], v0[3]); b.x = pk_bf16(v1[0], v1[1]); b.y = pk_bf16(v1[2], v1[3]);
        *(uint2*)(O + (size_t)row * ldc + col) = a; *(uint2*)(O + (size_t)row * ldc + col + 16) = b; } };
struct FStoreBf16 { bf16_t* O; int ldc;
    __device__ __forceinline__ void operator()(const pg8::Unit&, int row, int col, const f32x4& v0, const f32x4& v1) const {
        uint2 a, b; a.x = pk_bf16(v0[0], v0[1]); a.y = pk_bf16(v0[2], v0[3]); b.x = pk_bf16(v1[0], v1[1]); b.y = pk_bf16(v1[2], v1[3]);
        *(uint2*)(O + (size_t)row * ldc + col) = a; *(uint2*)(O + (size_t)row * ldc + col + 16) = b; } };
struct EpiG1 { bf16_t* Z; bf16_t* GT;
    __device__ __forceinline__ void operator()(const f32x4 (&acc)[2][2][4][2], const pg8::Unit& u, int wr, int wc, int fr, int fq) const {
        if (u.col0 < C_GATE) {
#pragma unroll
            for (int ai = 0; ai < 2; ++ai)
#pragma unroll
                for (int m = 0; m < 4; ++m)
#pragma unroll
                    for (int bj = 0; bj < 2; ++bj) { const int row = u.row0 + ai * 128 + wr * 64 + m * 16 + fr, col = u.col0 + bj * 128 + wc * 32 + 4 * fq;
                        const f32x4 v0 = acc[ai][bj][m][0], v1 = acc[ai][bj][m][1];
                        uint2 a, b; a.x = pk_bf16(v0[0], v0[1]); a.y = pk_bf16(v0[2], v0[3]); b.x = pk_bf16(v1[0], v1[1]); b.y = pk_bf16(v1[2], v1[3]);
                        *(uint2*)(Z + (size_t)row * ZP + col) = a; *(uint2*)(Z + (size_t)row * ZP + col + 16) = b; }
        } else {
            const int tidx = (wr * 4 + wc) * 64 + fq * 16 + fr;
            bf16_t* base = GT + ((size_t)(u.row0 >> 8) * 12 + ((u.col0 - C_GATE) >> 8)) * 65536 + tidx * 8;
#pragma unroll
            for (int ai = 0; ai < 2; ++ai)
#pragma unroll
                for (int bj = 0; bj < 2; ++bj)
#pragma unroll
                    for (int m = 0; m < 4; ++m) { const f32x4 v0 = acc[ai][bj][m][0], v1 = acc[ai][bj][m][1];
                        uint4 o; o.x = pk_bf16(sigmoidf_(v0[0]), sigmoidf_(v0[1])); o.y = pk_bf16(sigmoidf_(v0[2]), sigmoidf_(v0[3]));
                        o.z = pk_bf16(sigmoidf_(v1[0]), sigmoidf_(v1[1])); o.w = pk_bf16(sigmoidf_(v1[2]), sigmoidf_(v1[3]));
                        *(uint4*)(base + ((ai * 2 + bj) * 4 + m) * 4096) = o; }
        }
    } };
__device__ __forceinline__ void ph_g1(const Params& P, LAS unsigned char* lds) {
    pg8::SchedDense S{NTOK / 256, INC / 256, (int)gridDim.x, bid_(), (const char*)(P.ws + WS_H), (const char*)(P.ws + WS_WIN), (size_t)256 * D * 2, (size_t)256 * D * 2};
    EpiG1 E{(bf16_t*)(P.ws + WS_Z), (bf16_t*)(P.ws + WS_GT)};
    pg8::gemm_phase(lds, pg8::Gemm{D, D, D}, S, E);
}

__device__ __forceinline__ int kvrow(int r) { return r < NLAT ? ((r >> 11) * 2304 + 256 + (r & 2047)) : (((r - NLAT) >> 8) * 2304 + ((r - NLAT) & 255)); }
__device__ __forceinline__ void ph_prep(const Params& P, int l) {
    const int tid = tid_(), lane = tid & 63, wid = tid >> 6;
    const bf16_t* z = (const bf16_t*)(P.ws + WS_Z);
    bf16_t* qn = (bf16_t*)(P.ws + WS_QN); bf16_t* kn = (bf16_t*)(P.ws + WS_KN); bf16_t* vn = (bf16_t*)(P.ws + WS_VN);
    const float* rope = (const float*)(P.ws + WS_ROPE);
    const float gq = P.in[I_QNG][l * 64 + lane] * (0.125f * 1.4426950408889634f), gk = P.in[I_KNG][l * 64 + lane];
    for (int r = bid_() * 8 + wid; r < NTOK; r += gridDim.x * 8) {
        const bool lat = r < NLAT;
        const size_t kr = (size_t)kvrow(r);
        float cs = 1.f, sn = 0.f;
        if (lat) { const int t = r & 2047, fi = lane & 15;
            if (lane < 32) { const int pr = t >> 6; cs = rope[pr * 16 + fi]; sn = rope[512 + pr * 16 + fi]; }
            else { const int pc = t & 63; cs = rope[1024 + pc * 16 + fi]; sn = rope[2048 + pc * 16 + fi]; } }
        const float sgn = (lane & 16) ? 1.f : -1.f;
#pragma unroll
        for (int hh = 0; hh < 10; ++hh) {
            const int col = (hh < 8) ? (C_GQ + hh * 64) : (C_GK + (hh - 8) * 64);
            const float x = bf2f(z[(size_t)r * ZP + col + lane]);
            const float ss = wave_sum(x * x);
            const float xn = x * __builtin_amdgcn_rsqf(ss * (1.0f / 64.0f) + 1e-6f) * (hh < 8 ? gq : gk);
            const float pa = __shfl_xor(xn, 16, 64);
            const float o = xn * cs + sgn * pa * sn;
            const bf16_t ob = (bf16_t)(pk_bf16(o, 0.f) & 0xffffu);
            if (hh < 8) qn[(size_t)r * 512 + hh * 64 + lane] = ob; else kn[kr * 128 + (hh - 8) * 64 + lane] = ob;
        }
        *(unsigned*)(vn + kr * 128 + lane * 2) = *(const unsigned*)(z + (size_t)r * ZP + C_GV + lane * 2);
    }
}

__device__ __forceinline__ void ph_navt(const Params& P, LAS unsigned char* lds) {
    const int tid = tid_();
    const bf16_t* z = (const bf16_t*)(P.ws + WS_Z); bf16_t* vt = (bf16_t*)(P.ws + WS_NAVT);
    constexpr int PT = 1040;
    for (int u = bid_(); u < NB * 36; u += gridDim.x) {
        const int b = u / 36, tl = u % 36;
        const int row0 = (tl < 4) ? (NLAT + b * 256 + tl * 64) : (b * 2048 + (tl - 4) * 64);
        __syncthreads();
#pragma unroll
        for (int i = 0; i < 8; ++i) { const int ch = tid + i * NTHR, rr = ch >> 6, cc = ch & 63;
            const uint4 v = *(const uint4*)(z + (size_t)(row0 + rr) * ZP + C_NAV + cc * 8);
            *(LAS u32x4*)(lds + rr * PT + cc * 16) = (u32x4){v.x, v.y, v.z, v.w}; }
        __syncthreads();
#pragma unroll
        for (int i = 0; i < 8; ++i) { const int c = tid, tg = i;
            unsigned short e[8];
#pragma unroll
            for (int k = 0; k < 8; ++k) e[k] = *(const LAS unsigned short*)(lds + (tg * 8 + k) * PT + c * 2);
            uint4 o; o.x = e[0] | ((unsigned)e[1] << 16); o.y = e[2] | ((unsigned)e[3] << 16); o.z = e[4] | ((unsigned)e[5] << 16); o.w = e[6] | ((unsigned)e[7] << 16);
            *(uint4*)(vt + ((size_t)(b * 8 + (c >> 6)) * 64 + (c & 63)) * 2304 + tl * 64 + tg * 8) = o; }
    }
    __syncthreads();
}

#ifdef DIAG
__device__ __forceinline__ void load_q64(float (&q)[64], const bf16_t* p) {
#pragma unroll
    for (int i = 0; i < 8; ++i) { const uint4 u = ((const uint4*)p)[i];
        q[8 * i + 0] = bf_lo(u.x); q[8 * i + 1] = bf_hi(u.x); q[8 * i + 2] = bf_lo(u.y); q[8 * i + 3] = bf_hi(u.y);
        q[8 * i + 4] = bf_lo(u.z); q[8 * i + 5] = bf_hi(u.z); q[8 * i + 6] = bf_lo(u.w); q[8 * i + 7] = bf_hi(u.w); }
}
__device__ __forceinline__ void attn_key(const float (&q)[64], const bf16_t* kp, const bf16_t* vp, float bias, float& m, float& lsum, float (&o)[64]) {
    float s = 0.f;
#pragma unroll
    for (int i = 0; i < 8; ++i) { const uint4 u = ((const uint4*)kp)[i];
        s += q[8 * i + 0] * bf_lo(u.x) + q[8 * i + 1] * bf_hi(u.x) + q[8 * i + 2] * bf_lo(u.y) + q[8 * i + 3] * bf_hi(u.y)
           + q[8 * i + 4] * bf_lo(u.z) + q[8 * i + 5] * bf_hi(u.z) + q[8 * i + 6] * bf_lo(u.w) + q[8 * i + 7] * bf_hi(u.w); }
    s = s * 0.125f + bias;
    const float mn = fmaxf(m, s), corr = __expf(m - mn), pp = __expf(s - mn);
    lsum = lsum * corr + pp; m = mn;
#pragma unroll
    for (int i = 0; i < 8; ++i) { const uint4 u = ((const uint4*)vp)[i];
        o[8 * i + 0] = o[8 * i + 0] * corr + pp * bf_lo(u.x); o[8 * i + 1] = o[8 * i + 1] * corr + pp * bf_hi(u.x);
        o[8 * i + 2] = o[8 * i + 2] * corr + pp * bf_lo(u.y); o[8 * i + 3] = o[8 * i + 3] * corr + pp * bf_hi(u.y);
        o[8 * i + 4] = o[8 * i + 4] * corr + pp * bf_lo(u.z); o[8 * i + 5] = o[8 * i + 5] * corr + pp * bf_hi(u.z);
        o[8 * i + 6] = o[8 * i + 6] * corr + pp * bf_lo(u.w); o[8 * i + 7] = o[8 * i + 7] * corr + pp * bf_hi(u.w); }
}
__device__ __forceinline__ void store_o64(const float (&o)[64], float inv, bf16_t* p) {
#pragma unroll
    for (int i = 0; i < 8; ++i) { uint4 u;
        u.x = pk_bf16(o[8 * i + 0] * inv, o[8 * i + 1] * inv); u.y = pk_bf16(o[8 * i + 2] * inv, o[8 * i + 3] * inv);
        u.z = pk_bf16(o[8 * i + 4] * inv, o[8 * i + 5] * inv); u.w = pk_bf16(o[8 * i + 6] * inv, o[8 * i + 7] * inv);
        ((uint4*)p)[i] = u; }
}
__device__ __forceinline__ void na_thread(const Params& P, int l, int r, int h, bf16_t* br, int OPN) {
    const bf16_t* z = (const bf16_t*)(P.ws + WS_Z);
    float q[64], o[64]; float m = -INFINITY, ls = 0.f;
#pragma unroll
    for (int i = 0; i < 64; ++i) o[i] = 0.f;
    load_q64(q, z + (size_t)r * ZP + C_NAQ + h * 64);
    int b;
    if (r < NLAT) {
        b = r >> 11; const int t = r & 2047, qr = t >> 6, qc = t & 63;
        const int r0 = min(max(qr - 4, 0), 24), c0 = min(max(qc - 8, 0), 48);
        const float* rpb = P.in[I_RPB] + ((size_t)l * 8 + h) * 15 * 31;
        for (int kr = r0; kr < r0 + 8; ++kr)
            for (int kc = c0; kc < c0 + 16; ++kc) {
                const size_t krow = (size_t)(b * 2048 + kr * 64 + kc) * ZP;
                attn_key(q, z + krow + C_NAK + h * 64, z + krow + C_NAV + h * 64, rpb[(kr - qr + 7) * 31 + (kc - qc + 15)], m, ls, o);
            }
    } else b = (r - NLAT) >> 8;
    for (int j = 0; j < 256; ++j) {
        const size_t krow = (size_t)(NLAT + b * 256 + j) * ZP;
        attn_key(q, z + krow + C_NAK + h * 64, z + krow + C_NAV + h * 64, 0.f, m, ls, o);
    }
    store_o64(o, 1.0f / ls, br + (size_t)r * OPN + h * 64);
}
#endif
namespace na {
constexpr int KP = 144, VP = 528;
constexpr int L_K = 0, L_V = 256 * KP, L_B = L_V + 64 * VP, L_END = L_B + 480 * 4;
constexpr float C2 = 0.125f * 1.4426950408889634f, LOG2E = 1.4426950408889634f;
struct Acc { float m, l; f32x4 o[4]; };
template <class VF> __device__ __forceinline__ void absorb(Acc& A, f32x4 (&sa)[4], f32x4 (&sb)[4], const VF& vf) {
    float mx = -INFINITY;
#pragma unroll
    for (int g = 0; g < 4; ++g)
#pragma unroll
        for (int j = 0; j < 4; ++j) mx = fmaxf(mx, fmaxf(sa[g][j], sb[g][j]));
    mx = fmaxf(mx, __shfl_xor(mx, 16, 64)); mx = fmaxf(mx, __shfl_xor(mx, 32, 64));
    const float mn = fmaxf(A.m, mx), corr = __builtin_amdgcn_exp2f(A.m - mn);
    A.m = mn;
    float ps = 0.f;
    bf16x8 pf[4];
#pragma unroll
    for (int g = 0; g < 4; ++g) { float p[8];
#pragma unroll
        for (int j = 0; j < 4; ++j) { p[j] = __builtin_amdgcn_exp2f(sa[g][j] - mn); p[4 + j] = __builtin_amdgcn_exp2f(sb[g][j] - mn); ps += p[j] + p[4 + j]; }
        pf[g] = pack8(p); }
    A.l = A.l * corr + ps;
#pragma unroll
    for (int db = 0; db < 4; ++db) A.o[db] *= corr;
#pragma unroll
    for (int g = 0; g < 4; ++g)
#pragma unroll
        for (int db = 0; db < 4; ++db) A.o[db] = __builtin_amdgcn_mfma_f32_16x16x32_bf16(vf(g, db), pf[g], A.o[db], 0, 0, 0);
}
}
__device__ __forceinline__ void na_unit(const Params& P, LAS unsigned char* lds, int l, int u, bf16_t* br, int OPN) {
    const int tid = tid_(), lane = tid & 63, wid = __builtin_amdgcn_readfirstlane(tid >> 6), c16 = lane & 15, kq = lane >> 4;
    const bool latu = u < 256;
    const int bh = latu ? (u >> 2) : (u - 256), b = bh >> 3, h = bh & 7, q4 = u & 3;
    const bf16_t* z = (const bf16_t*)(P.ws + WS_Z); const bf16_t* vt = (const bf16_t*)(P.ws + WS_NAVT) + (size_t)bh * 64 * 2304;
    LAS unsigned char* KL = lds + na::L_K; LAS unsigned char* VL = lds + na::L_V; LAS float* BL = (LAS float*)(lds + na::L_B);
    __syncthreads();
#pragma unroll
    for (int i = 0; i < 4; ++i) { const int ch = tid + i * NTHR, rr = ch >> 3, cc = ch & 7;
        const uint4 v = *(const uint4*)(z + (size_t)(NLAT + b * 256 + rr) * ZP + C_NAK + h * 64 + cc * 8);
        *(LAS u32x4*)(KL + rr * na::KP + cc * 16) = (u32x4){v.x, v.y, v.z, v.w}; }
#pragma unroll
    for (int i = 0; i < 4; ++i) { const int ch = tid + i * NTHR, rr = ch >> 5, cc = ch & 31;
        const uint4 v = *(const uint4*)(vt + (size_t)rr * 2304 + cc * 8);
        *(LAS u32x4*)(VL + rr * na::VP + cc * 16) = (u32x4){v.x, v.y, v.z, v.w}; }
    if (tid < 465) BL[tid] = P.in[I_RPB][((size_t)l * 8 + h) * 465 + tid] * na::LOG2E;
    __syncthreads();
    const int sA = 8 * (c16 >> 2) + (c16 & 3);
    const int ntask = latu ? 4 : 2;
    for (int it = 0; it < ntask; ++it) {
        const int tk = it * 8 + wid;
        int qrow, r = 0, jb = 0;
        if (latu) { r = q4 * 8 + (tk >> 2); jb = tk & 3; qrow = b * 2048 + r * 64 + jb * 16 + c16; }
        else qrow = NLAT + b * 256 + tk * 16 + c16;
        bf16x8 qf[2];
#pragma unroll
        for (int ks = 0; ks < 2; ++ks) qf[ks] = *(const bf16x8*)(z + (size_t)qrow * ZP + C_NAQ + h * 64 + 32 * ks + 8 * kq);
        bf16_t* op = br + (size_t)qrow * OPN + h * 64 + 4 * kq; asm volatile("" : "+v"(op));
        na::Acc A; A.m = -INFINITY; A.l = 0.f;
#pragma unroll
        for (int db = 0; db < 4; ++db) A.o[db] = (f32x4){0.f, 0.f, 0.f, 0.f};
        if (latu) {
            const int r0 = min(max(r - 4, 0), 24), kc0 = min(max(jb * 16 - 8, 0), 32), qc = jb * 16 + c16, c0 = min(max(qc - 8, 0), 48);
            int dcol[8]; bool ok[8];
#pragma unroll
            for (int j = 0; j < 8; ++j) { const int kc = kc0 + 8 * kq + j; ok[j] = (kc >= c0) && (kc < c0 + 16); dcol[j] = ok[j] ? (kc - qc + 15) : 0; }
#pragma unroll 1
            for (int ch = 0; ch < 2; ++ch) {
                f32x4 sa[4], sb[4];
                const size_t tokbase = (size_t)b * 2048 + (size_t)(r0 + ch * 4) * 64 + kc0;
#pragma unroll
                for (int g = 0; g < 4; ++g) {
                    const bf16_t* kp = z + (tokbase + (size_t)g * 64 + sA) * ZP + C_NAK + h * 64 + 8 * kq;
                    const bf16x8 kA0 = *(const bf16x8*)kp, kA1 = *(const bf16x8*)(kp + 32), kB0 = *(const bf16x8*)(kp + 4 * ZP), kB1 = *(const bf16x8*)(kp + 4 * ZP + 32);
                    f32x4 a = {0.f, 0.f, 0.f, 0.f}, bq = {0.f, 0.f, 0.f, 0.f};
                    a = __builtin_amdgcn_mfma_f32_16x16x32_bf16(kA0, qf[0], a, 0, 0, 0); a = __builtin_amdgcn_mfma_f32_16x16x32_bf16(kA1, qf[1], a, 0, 0, 0);
                    bq = __builtin_amdgcn_mfma_f32_16x16x32_bf16(kB0, qf[0], bq, 0, 0, 0); bq = __builtin_amdgcn_mfma_f32_16x16x32_bf16(kB1, qf[1], bq, 0, 0, 0);
                    const int brow = (r0 + ch * 4 + g - r + 7) * 31;
#pragma unroll
                    for (int j = 0; j < 4; ++j) {
                        sa[g][j] = ok[j] ? (a[j] * na::C2 + BL[brow + dcol[j]]) : -INFINITY;
                        sb[g][j] = ok[4 + j] ? (bq[j] * na::C2 + BL[brow + dcol[4 + j]]) : -INFINITY; }
                }
                const bf16_t* vp = vt + (size_t)c16 * 2304 + 256 + (r0 + ch * 4) * 64 + kc0 + 8 * kq;
                na::absorb(A, sa, sb, [&](int g, int db) { return *(const bf16x8*)(vp + (size_t)db * 16 * 2304 + g * 64); });
            }
        }
#pragma unroll 1
        for (int ch = 0; ch < 2; ++ch) {
            f32x4 sa[4], sb[4];
#pragma unroll
            for (int g = 0; g < 4; ++g) {
                const LAS unsigned char* kp = KL + (ch * 128 + g * 32 + sA) * na::KP + kq * 16;
                const bf16x8 kA0 = *(const LAS bf16x8*)kp, kA1 = *(const LAS bf16x8*)(kp + 64), kB0 = *(const LAS bf16x8*)(kp + 4 * na::KP), kB1 = *(const LAS bf16x8*)(kp + 4 * na::KP + 64);
                f32x4 a = {0.f, 0.f, 0.f, 0.f}, bq = {0.f, 0.f, 0.f, 0.f};
                a = __builtin_amdgcn_mfma_f32_16x16x32_bf16(kA0, qf[0], a, 0, 0, 0); a = __builtin_amdgcn_mfma_f32_16x16x32_bf16(kA1, qf[1], a, 0, 0, 0);
                bq = __builtin_amdgcn_mfma_f32_16x16x32_bf16(kB0, qf[0], bq, 0, 0, 0); bq = __builtin_amdgcn_mfma_f32_16x16x32_bf16(kB1, qf[1], bq, 0, 0, 0);
                sa[g] = a * na::C2; sb[g] = bq * na::C2;
            }
            const LAS unsigned char* vp = VL + c16 * na::VP + (ch * 128 + 8 * kq) * 2;
            na::absorb(A, sa, sb, [&](int g, int db) { return *(const LAS bf16x8*)(vp + db * 16 * na::VP + g * 64); });
        }
        float ls = A.l; ls += __shfl_xor(ls, 16, 64); ls += __shfl_xor(ls, 32, 64);
        const float inv = __builtin_amdgcn_rcpf(ls);
#pragma unroll
        for (int db = 0; db < 4; ++db) { uint2 o; o.x = pk_bf16(A.o[db][0] * inv, A.o[db][1] * inv); o.y = pk_bf16(A.o[db][2] * inv, A.o[db][3] * inv);
            *(uint2*)(op + 16 * db) = o; }
    }
}
__device__ __forceinline__ int hg_row(int b, int dir, int s) { return s < 256 ? (NLAT + b * 256 + (dir ? 255 - s : s)) : (b * 2048 + (dir ? 2047 - (s - 256) : (s - 256))); }
__device__ __forceinline__ bf16x8 tr2(const LAS unsigned char* p0, const LAS unsigned char* p1) {
    typedef short v4i16_t __attribute__((ext_vector_type(4)));
    const v4i16_t a = __builtin_amdgcn_ds_read_tr16_b64_v4i16((LAS v4i16_t*)p0), c = __builtin_amdgcn_ds_read_tr16_b64_v4i16((LAS v4i16_t*)p1);
    return (bf16x8){a[0], a[1], a[2], a[3], c[0], c[1], c[2], c[3]};
}
__device__ __forceinline__ void hgrn_unit(const Params& P, LAS unsigned char* lds, int l, int u) {
    const int tid = tid_(), lane = tid & 63, wid = __builtin_amdgcn_readfirstlane(tid >> 6), c16 = lane & 15, kq = lane >> 4;
    const int b = u >> 3, h = (u >> 1) & 3, dir = u & 1;
    const bf16_t* z = (const bf16_t*)(P.ws + WS_Z);
    float* O = (float*)(P.ws + (dir ? WS_Y : WS_H));
    const float* lbv = (const float*)(P.ws + WS_LB) + ((size_t)l * 2 + dir) * 512 + h * 128;
    constexpr int PQ = 272;
    LAS unsigned char* QH = lds; LAS unsigned char* KT = lds + 8704; LAS unsigned char* KH = lds + 17408; LAS unsigned char* VV = lds + 26112;
    LAS float* DL = (LAS float*)(lds + 34816); LAS float* WT = DL + 128;
    const int ch = 2 * lane;
    const float lb0 = lbv[ch], lb1 = lbv[ch + 1];
    const int cf = (dir ? C_HFB : C_HFF) + h * 128 + ch, cq = C_HQ + h * 128 + ch, cv = C_HI + h * 128 + ch;
    f32x4 SA[4], SB[4];
#pragma unroll
    for (int G = 0; G < 4; ++G) { SA[G] = (f32x4){0.f, 0.f, 0.f, 0.f}; SB[G] = (f32x4){0.f, 0.f, 0.f, 0.f}; }
    unsigned rf[4], rq[4], rv[4];
#pragma unroll
    for (int k = 0; k < 4; ++k) { const bf16_t* zr = z + (size_t)hg_row(b, dir, 4 * wid + k) * ZP; rf[k] = *(const unsigned*)(zr + cf); rq[k] = *(const unsigned*)(zr + cq); rv[k] = *(const unsigned*)(zr + cv); }
    const int sA = 8 * (c16 >> 2) + (c16 & 3);
    const int tq = c16 >> 2, tp = c16 & 3;
    for (int st = 0; st < 72; ++st) {
        unsigned xf[4], xq[4], xv[4];
#pragma unroll
        for (int k = 0; k < 4; ++k) { xf[k] = rf[k]; xq[k] = rq[k]; xv[k] = rv[k]; }
        if (st + 1 < 72) {
#pragma unroll
            for (int k = 0; k < 4; ++k) { const bf16_t* zr = z + (size_t)hg_row(b, dir, (st + 1) * 32 + 4 * wid + k) * ZP; rf[k] = *(const unsigned*)(zr + cf); rq[k] = *(const unsigned*)(zr + cq); rv[k] = *(const unsigned*)(zr + cv); }
        }
        float g0[4], g1[4], k0[4], k1[4], q0[4], q1[4];
        float c0 = 0.f, c1 = 0.f;
#pragma unroll
        for (int k = 0; k < 4; ++k) {
            const float f0 = lb0 + (1.0f - lb0) * sigmoidf_(bf_lo(xf[k])), f1 = lb1 + (1.0f - lb1) * sigmoidf_(bf_hi(xf[k]));
            c0 += __logf(f0); c1 += __logf(f1); g0[k] = c0; g1[k] = c1;
            k0[k] = 1.0f - f0; k1[k] = 1.0f - f1; q0[k] = siluf_(bf_lo(xq[k])); q1[k] = siluf_(bf_hi(xq[k]));
        }
        WT[wid * 128 + ch] = c0; WT[wid * 128 + ch + 1] = c1;
        __syncthreads();
        float pre0 = 0.f, pre1 = 0.f, tot0 = 0.f, tot1 = 0.f;
#pragma unroll
        for (int w = 0; w < 8; ++w) { const float a0 = WT[w * 128 + ch], a1 = WT[w * 128 + ch + 1]; const float m = (w < wid) ? 1.f : 0.f; tot0 += a0; tot1 += a1; pre0 += m * a0; pre1 += m * a1; }
#pragma unroll
        for (int k = 0; k < 4; ++k) {
            const float b0 = g0[k] + pre0, b1 = g1[k] + pre1;
            const int ro = (4 * wid + k) * PQ + ch * 2;
            *(LAS unsigned*)(QH + ro) = pk_bf16(q0[k] * __expf(b0), q1[k] * __expf(b1));
            *(LAS unsigned*)(KT + ro) = pk_bf16(k0[k] * __expf(-b0), k1[k] * __expf(-b1));
            *(LAS unsigned*)(KH + ro) = pk_bf16(k0[k] * __expf(tot0 - b0), k1[k] * __expf(tot1 - b1));
            *(LAS unsigned*)(VV + ro) = xv[k];
        }
        if (wid == 0) { DL[ch] = __expf(tot0); DL[ch + 1] = __expf(tot1); }
        __syncthreads();
        const bf16x8 vfr = tr2(VV + (8 * kq + tq) * PQ + (16 * wid + 4 * tp) * 2, VV + (8 * kq + 4 + tq) * PQ + (16 * wid + 4 * tp) * 2);
        bf16x8 Sb[4];
#pragma unroll
        for (int G = 0; G < 4; ++G) { const float sv[8] = {SA[G][0], SA[G][1], SA[G][2], SA[G][3], SB[G][0], SB[G][1], SB[G][2], SB[G][3]}; Sb[G] = pack8(sv); }
#pragma unroll
        for (int T = 0; T < 2; ++T) {
            f32x4 aA = {0.f, 0.f, 0.f, 0.f}, aB = {0.f, 0.f, 0.f, 0.f};
            bf16x8 qf[4];
#pragma unroll
            for (int ks = 0; ks < 4; ++ks) {
                const bf16x8 kA = *(const LAS bf16x8*)(KT + sA * PQ + (32 * ks + 8 * kq) * 2);
                const bf16x8 kB = *(const LAS bf16x8*)(KT + (sA + 4) * PQ + (32 * ks + 8 * kq) * 2);
                qf[ks] = *(const LAS bf16x8*)(QH + (16 * T + c16) * PQ + (32 * ks + 8 * kq) * 2);
                aA = __builtin_amdgcn_mfma_f32_16x16x32_bf16(kA, qf[ks], aA, 0, 0, 0);
                aB = __builtin_amdgcn_mfma_f32_16x16x32_bf16(kB, qf[ks], aB, 0, 0, 0);
            }
            const int t = 16 * T + c16;
            float pv_[8];
#pragma unroll
            for (int jj = 0; jj < 4; ++jj) { pv_[jj] = (8 * kq + jj <= t) ? aA[jj] : 0.f; pv_[4 + jj] = (8 * kq + 4 + jj <= t) ? aB[jj] : 0.f; }
            f32x4 o = {0.f, 0.f, 0.f, 0.f};
            o = __builtin_amdgcn_mfma_f32_16x16x32_bf16(pack8(pv_), vfr, o, 0, 0, 0);
#pragma unroll
            for (int ks = 0; ks < 4; ++ks) o = __builtin_amdgcn_mfma_f32_16x16x32_bf16(qf[ks], Sb[ks], o, 0, 0, 0);
#pragma unroll
            for (int jj = 0; jj < 4; ++jj) O[(size_t)hg_row(b, dir, st * 32 + 16 * T + 4 * kq + jj) * 512 + h * 128 + 16 * wid + c16] = o[jj];
        }
#pragma unroll
        for (int G = 0; G < 4; ++G) {
            const f32x4 d0 = *(const LAS f32x4*)(DL + 32 * G + 8 * kq), d1 = *(const LAS f32x4*)(DL + 32 * G + 8 * kq + 4);
            const LAS unsigned char* ka = KH + (8 * kq + tq) * PQ + (32 * G + 8 * tp) * 2;
            const bf16x8 hA = tr2(ka, ka + 4 * PQ), hB = tr2(ka + 8, ka + 4 * PQ + 8);
            SA[G] = __builtin_amdgcn_mfma_f32_16x16x32_bf16(hA, vfr, SA[G] * d0, 0, 0, 0);
            SB[G] = __builtin_amdgcn_mfma_f32_16x16x32_bf16(hB, vfr, SB[G] * d1, 0, 0, 0);
        }
    }
    __syncthreads();
}
__device__ __forceinline__ void gqa_unit(const Params& P, char* shm, int U) {
    const bf16_t* qn = (const bf16_t*)(P.ws + WS_QN); const bf16_t* kn = (const bf16_t*)(P.ws + WS_KN); const bf16_t* vn = (const bf16_t*)(P.ws + WS_VN);
    bf16_t* br = (bf16_t*)(P.ws + WS_BR);
    int b, hq, row0, NT;
    if (U < 512) { const int bg = U >> 5; b = bg >> 1; hq = (bg & 1) * 4 + ((U & 31) >> 3); row0 = b * 2048 + (U & 7) * 256; NT = 36; }
    else { const int v = U - 512; b = v >> 3; hq = v & 7; row0 = NLAT + b * 256; NT = 4; }
    const int g = hq >> 2;
    gqa::attn_unit<8>(qn + (size_t)row0 * 512 + hq * 64, kn + (size_t)b * 2304 * 128 + g * 64, vn + (size_t)b * 2304 * 128 + g * 64,
                      br + (size_t)row0 * BRW + 1024 + hq * 64, NT, shm);
}
__device__ __forceinline__ void ph_mix(const Params& P, LAS unsigned char* lds, char* shm, int l) {
    const int tid = tid_();
    unsigned* qctr = (unsigned*)(P.ws + WS_CNT + 512) + l;
    volatile LAS unsigned* qslot = (volatile LAS unsigned*)(lds + LDS_BYTES - 32);
    for (;;) {
        if (tid == 0) *qslot = __hip_atomic_fetch_add(qctr, 1u, __ATOMIC_RELAXED, __HIP_MEMORY_SCOPE_AGENT);
        __syncthreads();
        const int u = (int)*qslot;
        __syncthreads();
        if (u >= 960) break;
        if (u < 64) hgrn_unit(P, lds, l, u);
        else if (u < 576) gqa_unit(P, shm, u - 64);
        else if (u < 832) na_unit(P, lds, l, u - 576, (bf16_t*)(P.ws + WS_BR), BRW);
        else if (u < 896) gqa_unit(P, shm, 512 + (u - 832));
        else na_unit(P, lds, l, 256 + (u - 896), (bf16_t*)(P.ws + WS_BR), BRW);
        __syncthreads();
    }
}
#ifdef DIAG
__device__ __forceinline__ void ph_diag_cmp(const Params& P) {
    const bf16_t* br = (const bf16_t*)(P.ws + WS_BR); const bf16_t* d1 = (const bf16_t*)(P.ws + WS_END); const bf16_t* d2 = d1 + (size_t)NTOK * 512;
    const bf16_t* z = (const bf16_t*)(P.ws + WS_Z); const bf16_t* vt = (const bf16_t*)(P.ws + WS_NAVT);
    unsigned* dg = (unsigned*)(P.ws + 20480);
    unsigned c1 = 0, c2 = 0, c3 = 0;
    for (size_t i = (size_t)bid_() * NTHR + tid_(); i < (size_t)NTOK * 512; i += (size_t)gridDim.x * NTHR) {
        const size_t r = i >> 9; const int c = (int)(i & 511);
        const float a = bf2f(br[r * BRW + c]), x = bf2f(d1[i]);
        if (!(fabsf(x - a) <= 0.004f + 0.02f * fabsf(a))) ++c1;
        if (DIAG != 4 && d1[i] != d2[i]) ++c3;
        const int rr = (int)r; const int bb = rr < NLAT ? (rr >> 11) : ((rr - NLAT) >> 8); const int tok = rr < NLAT ? (256 + (rr & 2047)) : ((rr - NLAT) & 255);
        if (vt[((size_t)(bb * 8 + (c >> 6)) * 64 + (c & 63)) * 2304 + tok] != z[r * ZP + C_NAV + c]) ++c2;
    }
    if (c1) atomicAdd(dg + 1, c1);
    if (c2) atomicAdd(dg + 2, c2);
    if (c3) atomicAdd(dg + 3, c3);
}
__device__ __forceinline__ void ph_diag_out(const Params& P) {
    const volatile unsigned* dg = (const volatile unsigned*)(P.ws + 20480);
    const unsigned c1 = dg[1], c2 = dg[2], c3 = dg[3];
    if ((c1 | c2 | c3) == 0) return;
    unsigned k = 0; { unsigned v = c1; while (v) { ++k; v >>= 1; } }
    if (c2) k += 30; if (c3) k += 60;
    const float cst = sqrtf(10.0f * (float)k + 9.0f);
    for (size_t i = (size_t)bid_() * NTHR + tid_(); i < (size_t)NLAT * D; i += (size_t)gridDim.x * NTHR) P.out[i] = cst;
}
#endif

__device__ __forceinline__ void ph_readout(const Params& P, int l) {
    const int tid = tid_(), lane = tid & 63, wid = tid >> 6;
    const float* OF = (const float*)(P.ws + WS_H); const float* OB = (const float*)(P.ws + WS_Y);
    const bf16_t* z = (const bf16_t*)(P.ws + WS_Z);
    bf16_t* br = (bf16_t*)(P.ws + WS_BR);
    const float g0 = P.in[I_HGN][l * 128 + lane * 2], g1 = P.in[I_HGN][l * 128 + lane * 2 + 1];
    for (int r = bid_() * 8 + wid; r < NTOK; r += gridDim.x * 8) {
#pragma unroll
        for (int h = 0; h < 4; ++h) {
            const int c = h * 128 + lane * 2;
            const float2 a = *(const float2*)(OF + (size_t)r * 512 + c), bb = *(const float2*)(OB + (size_t)r * 512 + c);
            const float o0 = a.x + bb.x, o1 = a.y + bb.y;
            const float ss = wave_sum(o0 * o0 + o1 * o1);
            const float rstd = __builtin_amdgcn_rsqf(ss * (1.0f / 128.0f) + 1e-6f);
            const unsigned gz = *(const unsigned*)(z + (size_t)r * ZP + C_HG + c);
            *(unsigned*)(br + (size_t)r * BRW + 512 + c) = pk_bf16(o0 * rstd * g0 * siluf_(bf_lo(gz)), o1 * rstd * g1 * siluf_(bf_hi(gz)));
        }
    }
}
struct SchedMerge { int G, c; const char* br; const char* wb;
    __device__ __forceinline__ bool next(int i, pg8::Unit& u) const {
        const int tile = (i / 3) * G + c, bi = i % 3; if (tile >= (NTOK / 256) * 4) return false;
        const int pm = tile >> 2, pn = tile & 3;
        u.row0 = pm * 256; u.col0 = pn * 256; u.aux = bi;
        u.A = br + ((size_t)pm * 256 * BRW + bi * 512) * 2; u.B = wb + ((size_t)bi * 1024 + pn * 256) * 512 * 2; return true; } };
struct EpiMerge { const bf16_t* GT; bf16_t* YP; bf16_t* Y;
    __device__ __forceinline__ void operator()(const f32x4 (&acc)[2][2][4][2], const pg8::Unit& u, int wr, int wc, int fr, int fq) const {
        const int tidx = (wr * 4 + wc) * 64 + fq * 16 + fr, bi = u.aux, pm = u.row0 >> 8, pn = u.col0 >> 8;
        const bf16_t* gb = GT + ((size_t)pm * 12 + bi * 4 + pn) * 65536 + tidx * 8;
        bf16_t* yb = YP + ((size_t)pm * 4 + pn) * 65536 + tidx * 8;
#pragma unroll
        for (int ai = 0; ai < 2; ++ai)
#pragma unroll
            for (int bj = 0; bj < 2; ++bj)
#pragma unroll
                for (int m = 0; m < 4; ++m) { const int k = ((ai * 2 + bj) * 4 + m) * 4096;
                    const uint4 g = *(const uint4*)(gb + k);
                    const f32x4 v0 = acc[ai][bj][m][0], v1 = acc[ai][bj][m][1];
                    float t[8] = {bf_lo(g.x) * v0[0], bf_hi(g.x) * v0[1], bf_lo(g.y) * v0[2], bf_hi(g.y) * v0[3], bf_lo(g.z) * v1[0], bf_hi(g.z) * v1[1], bf_lo(g.w) * v1[2], bf_hi(g.w) * v1[3]};
                    if (bi != 0) { const uint4 p = *(const uint4*)(yb + k);
                        t[0] += bf_lo(p.x); t[1] += bf_hi(p.x); t[2] += bf_lo(p.y); t[3] += bf_hi(p.y); t[4] += bf_lo(p.z); t[5] += bf_hi(p.z); t[6] += bf_lo(p.w); t[7] += bf_hi(p.w); }
                    if (bi != 2) { uint4 o; o.x = pk_bf16(t[0], t[1]); o.y = pk_bf16(t[2], t[3]); o.z = pk_bf16(t[4], t[5]); o.w = pk_bf16(t[6], t[7]); *(uint4*)(yb + k) = o; }
                    else { const int row = u.row0 + ai * 128 + wr * 64 + m * 16 + fr, col = u.col0 + bj * 128 + wc * 32 + 4 * fq;
                        uint2 a, b; a.x = pk_bf16(t[0], t[1]); a.y = pk_bf16(t[2], t[3]); b.x = pk_bf16(t[4], t[5]); b.y = pk_bf16(t[6], t[7]);
                        *(uint2*)(Y + (size_t)row * D + col) = a; *(uint2*)(Y + (size_t)row * D + col + 16) = b; }
                }
    } };
__device__ __forceinline__ void ph_merge(const Params& P, LAS unsigned char* lds) {
    SchedMerge S{(int)gridDim.x, bid_(), (const char*)(P.ws + WS_BR), (const char*)(P.ws + WS_WBR)};
    EpiMerge E{(const bf16_t*)(P.ws + WS_GT), (bf16_t*)(P.ws + WS_H), (bf16_t*)(P.ws + WS_Y)};
    pg8::gemm_phase(lds, pg8::Gemm{512, BRW, 512}, S, E);
}
struct FResid { float* X; const float* mods; int l;
    __device__ __forceinline__ void operator()(const pg8::Unit&, int row, int col, const f32x4& v0, const f32x4& v1) const {
        const float* gate = mods + ((size_t)l * 9 + row_modrow(row)) * 6144 + 2 * 1024;
        float4* p0 = (float4*)(X + (size_t)row * D + col); float4* p1 = (float4*)(X + (size_t)row * D + col + 16);
        const float4 g0 = *(const float4*)(gate + col), g1 = *(const float4*)(gate + col + 16);
        float4 a = *p0, b = *p1;
        a.x += g0.x * v0[0]; a.y += g0.y * v0[1]; a.z += g0.z * v0[2]; a.w += g0.w * v0[3];
        b.x += g1.x * v1[0]; b.y += g1.y * v1[1]; b.z += g1.z * v1[2]; b.w += g1.w * v1[3];
        *p0 = a; *p1 = b; } };
__device__ __forceinline__ void ph_wout(const Params& P, LAS unsigned char* lds, int l, bool dry = false) {
    pg8::SchedDense S{NTOK / 256, D / 256, (int)gridDim.x, bid_(), (const char*)(P.ws + WS_Y), (const char*)(P.ws + WS_WOUT), (size_t)256 * D * 2, (size_t)256 * D * 2};
    pg8::EpiPair<FResid> E{{(float*)(P.ws + (dry ? WS_END : WS_X)), (const float*)(P.ws + WS_MODS), l}};
    pg8::gemm_phase(lds, pg8::Gemm{D, D, D}, S, E);
}
__device__ __forceinline__ void ph_norm2_route(const Params& P, LAS unsigned char* lds, int l, bool dry = false) {
    const int tid = tid_(), lane = tid & 63, wid = tid >> 6;
    LAS float* Wt = (LAS float*)lds;
    LAS int* lcnt = (LAS int*)(lds + 81920); LAS int* lbase = lcnt + 16; LAS int* rinfo = lbase + 16;
    LAS float* rw = (LAS float*)(rinfo + 128 * 4);
    for (int i = tid; i < 20 * 1024; i += NTHR) { const int j = i >> 10, c = i & 1023;
        Wt[i] = (j < 4) ? P.in[I_WGR][((size_t)l * 1024 + c) * 4 + j] : P.in[I_WER][((size_t)l * 1024 + c) * 16 + (j - 4)]; }
    if (tid < 16) lcnt[tid] = 0;
    __syncthreads();
    const float* xres = (const float*)(P.ws + WS_X);
    bf16_t* f = (bf16_t*)(P.ws + (dry ? WS_END : WS_H));
    const float* g = P.in[I_GFFN] + l * 1024;
    int* cnt = (int*)(P.ws + (dry ? 32768 : WS_CNT)) + l * 16;
    int* sel_e = (int*)(P.ws + (dry ? WS_END + 40000000 : WS_SELE)); float* sel_w = (float*)(P.ws + (dry ? WS_END + 41000000 : WS_SELW)); int* sel_p = (int*)(P.ws + (dry ? WS_END + 42000000 : WS_SELP));
    const int r0 = bid_() * 8, rstep = gridDim.x * 8;
    int it = 0;
    for (int r = r0 + wid; r < NTOK; r += rstep, ++it) {
        const float* mod = (const float*)(P.ws + WS_MODS) + ((size_t)l * 9 + row_modrow(r)) * 6144;
        float4 x[4], o[4];
#pragma unroll
        for (int i = 0; i < 4; ++i) x[i] = *(const float4*)(xres + (size_t)r * D + lane * 4 + 256 * i);
        norm_row(x, g, mod + 3 * 1024, mod + 4 * 1024, lane, o);
#pragma unroll
        for (int i = 0; i < 4; ++i) { uint2 u; u.x = pk_bf16(o[i].x, o[i].y); u.y = pk_bf16(o[i].z, o[i].w); *(uint2*)(f + (size_t)r * D + lane * 4 + 256 * i) = u; }
        float lg[20];
#pragma unroll
        for (int j = 0; j < 20; ++j) {
            float s = 0.f;
#pragma unroll
            for (int i = 0; i < 4; ++i) { const f32x4 w = *(const LAS f32x4*)(Wt + j * 1024 + lane * 4 + 256 * i); s += o[i].x * w[0] + o[i].y * w[1] + o[i].z * w[2] + o[i].w * w[3]; }
            lg[j] = wave_sum(s);
        }
        if (lane == 0) {
            float gl[4]; int gi = 0;
#pragma unroll
            for (int j = 0; j < 4; ++j) gl[j] = lg[j] + P.in[I_BGR][l * 4 + j];
            float gm = gl[0];
#pragma unroll
            for (int j = 1; j < 4; ++j) if (gl[j] > gm) { gm = gl[j]; gi = j; }
            float se = 0.f;
#pragma unroll
            for (int j = 0; j < 4; ++j) se += __expf(gl[j] - gm);
            const float pg = __builtin_amdgcn_rcpf(se);
            float el[4];
#pragma unroll
            for (int j = 0; j < 4; ++j) {
                float v = 0.f;
#pragma unroll
                for (int q = 0; q < 4; ++q) v = (gi == q) ? lg[4 + q * 4 + j] : v;
                el[j] = v + P.in[I_BER][l * 16 + gi * 4 + j];
            }
            int i0 = 0; float v0 = el[0];
#pragma unroll
            for (int j = 1; j < 4; ++j) if (el[j] > v0) { v0 = el[j]; i0 = j; }
            int i1 = -1; float v1 = -INFINITY;
#pragma unroll
            for (int j = 0; j < 4; ++j) if (j != i0 && el[j] > v1) { v1 = el[j]; i1 = j; }
            const float w0 = __builtin_amdgcn_rcpf(1.0f + __expf(v1 - v0)), w1 = 1.0f - w0;
            const int e0 = gi * 4 + i0, e1 = gi * 4 + i1;
            const int slot = it * 8 + wid;
            rinfo[slot * 4 + 0] = e0 | (e1 << 8);
            rinfo[slot * 4 + 1] = __hip_atomic_fetch_add(&lcnt[e0], 1, __ATOMIC_RELAXED, __HIP_MEMORY_SCOPE_WORKGROUP);
            rinfo[slot * 4 + 2] = __hip_atomic_fetch_add(&lcnt[e1], 1, __ATOMIC_RELAXED, __HIP_MEMORY_SCOPE_WORKGROUP);
            rw[slot * 2] = w0 * pg; rw[slot * 2 + 1] = w1 * pg;
        }
    }
    __syncthreads();
    if (tid < 16) lbase[tid] = atomicAdd(&cnt[tid], lcnt[tid]);
    __syncthreads();
    for (int slot = tid; slot < 128; slot += NTHR) {
        const int r = r0 + (slot & 7) + (slot >> 3) * rstep;
        if (r < NTOK) { const int ee = rinfo[slot * 4], e0 = ee & 255, e1 = ee >> 8;
            sel_e[r * 2] = e0; sel_e[r * 2 + 1] = e1;
            sel_w[r * 2] = rw[slot * 2]; sel_w[r * 2 + 1] = rw[slot * 2 + 1];
            sel_p[r * 2] = lbase[e0] + rinfo[slot * 4 + 1]; sel_p[r * 2 + 1] = lbase[e1] + rinfo[slot * 4 + 2]; }
    }
    __syncthreads();
}
__device__ __forceinline__ void moe_offsets(const int* cnt, int (&off)[17]) {
    int a = 0;
#pragma unroll
    for (int e = 0; e < 16; ++e) { off[e] = a; a += (cnt[e] + 255) & ~255; }
    off[16] = a;
}
__device__ __forceinline__ void ph_scatter(const Params& P, int l) {
    const int tid = tid_(), lane = tid & 63, wid = tid >> 6;
    const int* cnt = (const int*)(P.ws + WS_CNT) + l * 16;
    int off[17]; moe_offsets(cnt, off);
    const bf16_t* f = (const bf16_t*)(P.ws + WS_H); bf16_t* Fs = (bf16_t*)(P.ws + WS_FS);
    const int* sel_e = (const int*)(P.ws + WS_SELE); const int* sel_p = (const int*)(P.ws + WS_SELP); int* srow = (int*)(P.ws + WS_SROW);
    for (int r = bid_() * 8 + wid; r < NTOK; r += gridDim.x * 8) {
        const uint4 a = *(const uint4*)(f + (size_t)r * D + lane * 8), b = *(const uint4*)(f + (size_t)r * D + 512 + lane * 8);
#pragma unroll
        for (int k = 0; k < 2; ++k) {
            const int e = sel_e[r * 2 + k];
            int o = 0;
#pragma unroll
            for (int q = 0; q < 16; ++q) o = (e == q) ? off[q] : o;
            const int d = o + sel_p[r * 2 + k];
            *(uint4*)(Fs + (size_t)d * D + lane * 8) = a; *(uint4*)(Fs + (size_t)d * D + 512 + lane * 8) = b;
            if (lane == 0) srow[r * 2 + k] = d;
        }
    }
}
struct SchedMoe { int NM, G, c; int tfirst[16]; const char* A; const char* W; size_t tA, eW, tW;
    __device__ __forceinline__ bool next(int i, pg8::Unit& u) const {
        const int L = i * G + c; if (L >= NM * 4) return false;
        const int pm = L >> 2, pn = L & 3;
        int e = 0;
#pragma unroll
        for (int q = 1; q < 16; ++q) e += (pm >= tfirst[q]) ? 1 : 0;
        u.row0 = pm * 256; u.col0 = pn * 256; u.aux = e; u.A = A + (size_t)pm * tA; u.B = W + (size_t)e * eW + (size_t)pn * tW; return true; } };
struct FSwiglu { bf16_t* H;
    __device__ __forceinline__ void operator()(const pg8::Unit&, int row, int col, const f32x4& v0, const f32x4& v1) const {
        const int hc = ((col & ~31) >> 1) + (col & 15);
        uint2 a; a.x = pk_bf16(siluf_(v0[0]) * v1[0], siluf_(v0[1]) * v1[1]); a.y = pk_bf16(siluf_(v0[2]) * v1[2], siluf_(v0[3]) * v1[3]);
        *(uint2*)(H + (size_t)row * EH + hc) = a; } };
__device__ __forceinline__ void moe_sched(const Params& P, int l, SchedMoe& S) {
    const int* cnt = (const int*)(P.ws + WS_CNT) + l * 16;
    int a = 0;
#pragma unroll
    for (int e = 0; e < 16; ++e) { S.tfirst[e] = a; a += (cnt[e] + 255) >> 8; }
    S.NM = a; S.G = (int)gridDim.x; S.c = bid_();
}
__device__ __forceinline__ void ph_moe1(const Params& P, LAS unsigned char* lds, int l) {
    SchedMoe S; moe_sched(P, l, S);
    S.A = (const char*)(P.ws + WS_FS); S.W = (const char*)(P.ws + WS_WGU); S.tA = (size_t)256 * D * 2; S.eW = (size_t)1024 * 1024 * 2; S.tW = (size_t)256 * 1024 * 2;
    pg8::EpiPair<FSwiglu> E{{(bf16_t*)(P.ws + WS_HS)}};
    pg8::gemm_phase(lds, pg8::Gemm{1024, 1024, 1024}, S, E);
}
__device__ __forceinline__ void ph_moe2(const Params& P, LAS unsigned char* lds, int l) {
    SchedMoe S; moe_sched(P, l, S);
    S.A = (const char*)(P.ws + WS_HS); S.W = (const char*)(P.ws + WS_WDN); S.tA = (size_t)256 * EH * 2; S.eW = (size_t)1024 * 512 * 2; S.tW = (size_t)256 * 512 * 2;
    pg8::EpiPair<FStoreBf16> E{{(bf16_t*)(P.ws + WS_YS), D}};
    pg8::gemm_phase(lds, pg8::Gemm{512, 512, 512}, S, E);
}
__device__ __forceinline__ void ph_combine(const Params& P, int l, bool dry = false) {
    const int tid = tid_(), lane = tid & 63, wid = tid >> 6;
    float* xres = (float*)(P.ws + WS_X);
    const bf16_t* Ys = (const bf16_t*)(P.ws + WS_YS);
    const float* sel_w = (const float*)(P.ws + WS_SELW); const int* srow = (const int*)(P.ws + WS_SROW);
    for (int r = bid_() * 8 + wid; r < NTOK; r += gridDim.x * 8) {
        const float* gate = (const float*)(P.ws + WS_MODS) + ((size_t)l * 9 + row_modrow(r)) * 6144 + 5 * 1024;
        const float w0 = sel_w[r * 2], w1 = sel_w[r * 2 + 1];
        const bf16_t* y0 = Ys + (size_t)srow[r * 2] * D; const bf16_t* y1 = Ys + (size_t)srow[r * 2 + 1] * D;
        float4 x[4];
        float ss = 0.f;
#pragma unroll
        for (int i = 0; i < 4; ++i) {
            const int c = lane * 4 + 256 * i;
            x[i] = *(const float4*)(xres + (size_t)r * D + c);
            const uint2 a = *(const uint2*)(y0 + c), b = *(const uint2*)(y1 + c);
            const float4 gv = *(const float4*)(gate + c);
            x[i].x += gv.x * (w0 * bf_lo(a.x) + w1 * bf_lo(b.x)); x[i].y += gv.y * (w0 * bf_hi(a.x) + w1 * bf_hi(b.x));
            x[i].z += gv.z * (w0 * bf_lo(a.y) + w1 * bf_lo(b.y)); x[i].w += gv.w * (w0 * bf_hi(a.y) + w1 * bf_hi(b.y));
            *(float4*)((dry ? (float*)(P.ws + WS_END) : xres) + (size_t)r * D + c) = x[i];
            ss += x[i].x * x[i].x + x[i].y * x[i].y + x[i].z * x[i].z + x[i].w * x[i].w;
        }
        if (l == DEPTH - 1 && r < NLAT) {
            ss = wave_sum(ss);
            const float rstd = __builtin_amdgcn_rsqf(ss * (1.0f / 1024.0f) + 1e-6f);
#pragma unroll
            for (int i = 0; i < 4; ++i) {
                const int c = lane * 4 + 256 * i;
                const float4 gv = *(const float4*)(P.in[I_GFIN] + c);
                float4 o; o.x = x[i].x * rstd * gv.x; o.y = x[i].y * rstd * gv.y; o.z = x[i].z * rstd * gv.z; o.w = x[i].w * rstd * gv.w;
                *(float4*)((dry ? (float*)(P.ws + WS_END) : P.out) + (size_t)r * D + c) = o;
            }
        }
    }
}

constexpr int NPH_LAYER = 12, NPH = 1 + DEPTH * NPH_LAYER;
#define CAS __attribute__((address_space(4)))
__device__ __forceinline__ const Params& kparams() { const CAS Params* k = (const CAS Params*)__builtin_amdgcn_kernarg_segment_ptr(); asm volatile("" : "+s"(k)); return *(const Params*)k; }
__global__ void __launch_bounds__(NTHR, 2) fwd(Params P_) {
    extern __shared__ __attribute__((aligned(16))) unsigned char lds_raw[];
    LAS unsigned char* lds = (LAS unsigned char*)lds_raw;
    volatile LAS unsigned* xbw = (volatile LAS unsigned*)(lds + LDS_BYTES - 16);
    if (threadIdx.x == 0) { xbw[0] = 0u; xbw[1] = 0u; xbw[2] = 0u; xbw[3] = 0u; }
    __syncthreads();
    const int lo = P_.ph_lo, hi = P_.ph_hi;
    XcdBarrier bar; bar.bar = (unsigned*)(P_.ws + WS_BAR); bar.x = 0; bar.st = xbw;
    if (hi - lo > 1) bar = xcd_barrier_post((unsigned*)(P_.ws + WS_BAR), xbw);
#ifndef PHMASK
#define PHMASK 0xFFFF
#endif
#define EN(j) ((PHMASK >> (j)) & 1)
#define IN(k) (lo <= (k) && (k) < hi)
#define SEAM(k) do { if (IN(k) && IN((k) + 1)) xcd_barrier(bar); } while (0)
    if (EN(12) && IN(0)) for (int rep = 0; rep < NREP(12); ++rep) { ph_prologue(kparams(), lds); }
    SEAM(0);
    for (int l = 0; l < DEPTH; ++l) {
        const int p0 = 1 + l * NPH_LAYER;
        if (EN(0) && IN(p0 + 0)) for (int rep = 0; rep < NREP(0); ++rep) { ph_wconv(kparams(), lds, l); ph_norm1(kparams(), l); }
        SEAM(p0 + 0);
        if (EN(1) && IN(p0 + 1)) for (int rep = 0; rep < NREP(1); ++rep) ph_g1(kparams(), lds);
        SEAM(p0 + 1);
        if (EN(2) && IN(p0 + 2)) for (int rep = 0; rep < NREP(2); ++rep) { ph_prep(kparams(), l); ph_navt(kparams(), lds); }
        SEAM(p0 + 2);
        if (EN(3) && IN(p0 + 3)) for (int rep = 0; rep < NREP(3); ++rep) ph_mix(kparams(), lds, (char*)lds_raw, l);
        SEAM(p0 + 3);
        if (EN(4) && IN(p0 + 4)) for (int rep = 0; rep < NREP(4); ++rep) {
#if defined(DIAG) && DIAG == 5
            { const Params& Pq = kparams(); const int G_ = gridDim.x, c_ = bid_(), vcu_ = (c_ % 8) * (G_ / 8) + c_ / 8; for (int u = vcu_; u < 320; u += G_) na_unit(Pq, lds, l, u, (bf16_t*)(Pq.ws + WS_BR), BRW); __syncthreads(); }
#endif
            ph_readout(kparams(), l);
#if defined(DIAG) && (DIAG == 1 || DIAG == 4)
            ph_diag_cmp(kparams());
#endif
#if defined(DIAG) && DIAG == 3
            { const Params& Pq = kparams(); const uint4* d1 = (const uint4*)(Pq.ws + WS_END); bf16_t* brq = (bf16_t*)(Pq.ws + WS_BR);
              for (size_t i = (size_t)bid_() * NTHR + tid_(); i < (size_t)NTOK * 64; i += (size_t)gridDim.x * NTHR) { const size_t r = i >> 6; const int c8 = (int)(i & 63) * 8; *(uint4*)(brq + r * BRW + c8) = d1[i]; } }
#endif
        }
        SEAM(p0 + 4);
        if (EN(5) && IN(p0 + 5)) for (int rep = 0; rep < NREP(5); ++rep) ph_merge(kparams(), lds);
        SEAM(p0 + 5);
        if (EN(6) && IN(p0 + 6)) for (int rep = 0; rep < NREP(6); ++rep) ph_wout(kparams(), lds, l, rep > 0);
        SEAM(p0 + 6);
        if (EN(7) && IN(p0 + 7)) for (int rep = 0; rep < NREP(7); ++rep) ph_norm2_route(kparams(), lds, l, rep > 0);
        SEAM(p0 + 7);
        if (EN(8) && IN(p0 + 8)) for (int rep = 0; rep < NREP(8); ++rep) ph_scatter(kparams(), l);
        SEAM(p0 + 8);
        if (EN(9) && IN(p0 + 9)) for (int rep = 0; rep < NREP(9); ++rep) ph_moe1(kparams(), lds, l);
        SEAM(p0 + 9);
        if (EN(10) && IN(p0 + 10)) for (int rep = 0; rep < NREP(10); ++rep) ph_moe2(kparams(), lds, l);
        SEAM(p0 + 10);
        if (EN(11) && IN(p0 + 11)) for (int rep = 0; rep < NREP(11); ++rep) ph_combine(kparams(), l, rep > 0);
        SEAM(p0 + 11);
    }
#if defined(DIAG) && (DIAG == 1 || DIAG == 4)
    xcd_barrier(bar); ph_diag_out(kparams());
#endif
#undef IN
#undef SEAM
}

#ifndef MK_PER_PHASE
#define MK_PER_PHASE 0
#endif
extern "C" void kernel_launch(void* const* d_in, const int* in_sizes, int n_in, void* d_out, int out_size, void* d_ws, size_t ws_size, hipStream_t stream) {
    static int grid = 0;
    if (grid == 0) {
        if (n_in != 24 || out_size != NLAT * D || ws_size < WS_END + (size_t)NTOK * 4096 + 4096) { fprintf(stderr, "kernel_launch: unexpected shapes (n_in %d out %d ws %zu need %zu)\n", n_in, out_size, ws_size, (size_t)WS_END); grid = -1; return; }
        int dev = 0, cus = 0, per_cu = 0;
        if (hipGetDevice(&dev) != hipSuccess || hipDeviceGetAttribute(&cus, hipDeviceAttributeMultiprocessorCount, dev) != hipSuccess) { grid = -1; return; }
        if (hipFuncSetAttribute((const void*)fwd, hipFuncAttributeMaxDynamicSharedMemorySize, LDS_BYTES) != hipSuccess) { fprintf(stderr, "kernel_launch: hipFuncSetAttribute failed\n"); grid = -1; return; }
        if (hipOccupancyMaxActiveBlocksPerMultiprocessor(&per_cu, (const void*)fwd, NTHR, LDS_BYTES) != hipSuccess || per_cu < 1) { fprintf(stderr, "kernel_launch: occupancy query says %d\n", per_cu); }
        (void)hipGetLastError();
        grid = cus;
    }
    if (grid < 0) return;
    (void)hipMemsetAsync(d_ws, 0, WS_ZERO_BYTES, stream);
    Params p{};
    for (int i = 0; i < 24; ++i) p.in[i] = (const float*)d_in[i];
    p.out = (float*)d_out; p.ws = (unsigned char*)d_ws;
#if MK_PER_PHASE
    for (int ph = 0; ph < NPH; ++ph) { p.ph_lo = ph; p.ph_hi = ph + 1; hipLaunchKernelGGL(fwd, dim3(grid), dim3(NTHR), LDS_BYTES, stream, p); }
#else
    p.ph_lo = 0; p.ph_hi = NPH; hipLaunchKernelGGL(fwd, dim3(grid), dim3(NTHR), LDS_BYTES, stream, p);
#endif
}
```

```cpp
#include <hip/hip_runtime.h>
#include <cstdio>
#include <cstdint>

#define LAS __attribute__((address_space(3)))
typedef unsigned short bf16_t;
typedef short bf16x8 __attribute__((ext_vector_type(8)));
typedef float f32x4 __attribute__((ext_vector_type(4)));
typedef unsigned u32x4 __attribute__((ext_vector_type(4)));

constexpr int D = 1024, NB = 8, SEQ = 2048, DEPTH = 4, CTXL = 256;
constexpr int NLAT = NB * SEQ, NCTX = NB * CTXL, NTOK = NLAT + NCTX;
constexpr int INC = 7936;
constexpr int ZP = 4864;
constexpr int C_NAQ = 0, C_NAK = 512, C_NAV = 1024, C_HQ = 1536, C_HFF = 2048, C_HFB = 2560, C_HI = 3072, C_HG = 3584,
              C_GQ = 4096, C_GK = 4608, C_GV = 4736, C_GATE = 4864;
constexpr int BRW = 1536;
constexpr int NEXP = 16, EH = 512;
constexpr int MPAD = 40960;
constexpr int NTHR = 512;
constexpr int LDS_BYTES = 147456;

constexpr size_t WS_BAR = 0;
constexpr size_t WS_CNT = 16384;
constexpr size_t WS_ZERO_BYTES = 65536;
constexpr size_t WS_MODS = 65536;
constexpr size_t WS_LB = WS_MODS + 884736;
constexpr size_t WS_ROPE = WS_LB + 16384;
constexpr size_t WS_SELE = WS_ROPE + 12288;
constexpr size_t WS_SELW = WS_SELE + 147456;
constexpr size_t WS_SELP = WS_SELW + 147456;
constexpr size_t WS_SROW = WS_SELP + 147456;
constexpr size_t WS_X = 2097152;
constexpr size_t WS_H = WS_X + (size_t)NTOK * D * 4;
constexpr size_t WS_Z = WS_H + (size_t)NTOK * D * 2;
constexpr size_t WS_GT = WS_Z + (size_t)NTOK * ZP * 2;
constexpr size_t WS_BR = WS_GT + (size_t)NTOK * 3072 * 2;
constexpr size_t WS_Y = WS_BR + (size_t)NTOK * BRW * 2;
constexpr size_t WS_QN = WS_Y + (size_t)NTOK * D * 2;
constexpr size_t WS_KN = WS_QN + (size_t)NTOK * 512 * 2;
constexpr size_t WS_VN = WS_KN + (size_t)NTOK * 128 * 2;
constexpr size_t WS_NAVT = WS_VN + (size_t)NTOK * 128 * 2;
constexpr size_t WS_WIN = WS_NAVT + (size_t)NTOK * 512 * 2;
constexpr size_t WS_WBR = WS_WIN + (size_t)INC * D * 2;
constexpr size_t WS_WOUT = WS_WBR + (size_t)3 * D * 512 * 2;
constexpr size_t WS_WGU = WS_WOUT + (size_t)D * D * 2;
constexpr size_t WS_WDN = WS_WGU + (size_t)NEXP * 1024 * 1024 * 2;
constexpr size_t WS_END = WS_WDN + (size_t)NEXP * 1024 * 512 * 2;
constexpr size_t WS_FS = WS_Z;
constexpr size_t WS_HS = WS_FS + (size_t)MPAD * 1024 * 2;
constexpr size_t WS_YS = WS_HS + (size_t)MPAD * 512 * 2;
static_assert(WS_YS + (size_t)MPAD * 1024 * 2 <= WS_BR, "moe alias");
static_assert(WS_SROW + 147456 <= WS_X, "ctl");

#define XB_TMO      128
#define XB_XCNT(j)  (256  + 64 * (j))
#define XB_XSUB(j)  (1280 + 64 * (j))
#define XB_XGEN(j)  (2304 + 64 * (j))
#define XB_TOP      3328
#define XB_TOPGEN   3392
#define XCD_BAR_WORDS 3456
#define XB_SPIN_CAP (1u << 22)
__device__ __forceinline__ unsigned xb_ld(unsigned* p)              { return __hip_atomic_load(p, __ATOMIC_RELAXED, __HIP_MEMORY_SCOPE_AGENT); }
__device__ __forceinline__ unsigned xb_add(unsigned* p, unsigned v) { return __hip_atomic_fetch_add(p, v, __ATOMIC_RELAXED, __HIP_MEMORY_SCOPE_AGENT); }
__device__ __forceinline__ unsigned xb_xcc_id() { return (unsigned)__builtin_amdgcn_s_getreg((3 << 11) | 20) & 0xFu; }
#define XB_SPIN(cond, bar) do { unsigned _sp = 0; while (cond) { __builtin_amdgcn_s_sleep(1); \
    if ((++_sp & 255u) == 0u) { if (xb_ld(&(bar)[XB_TMO])) break; if (_sp > XB_SPIN_CAP) { atomicAdd(&(bar)[XB_TMO], 1u); break; } } } } while (0)
struct XcdBarrier { unsigned* bar; unsigned x; volatile LAS unsigned* st; };
__device__ __forceinline__ XcdBarrier xcd_barrier_post(unsigned* bar, volatile LAS unsigned* st) {
    XcdBarrier b; b.bar = bar; b.x = xb_xcc_id(); b.st = st;
    if (threadIdx.x == 0) (void)xb_add(&bar[XB_XCNT(b.x)], 1u);
    return b;
}
__device__ __forceinline__ void xcd_barrier_complete(unsigned* bar, unsigned x, unsigned& nloc, unsigned& nx) {
    const unsigned G = gridDim.x * gridDim.y * gridDim.z;
    unsigned sum, cnt, mine, sp = 0u;
    for (;;) {
        sum = 0u; cnt = 0u; mine = 0u;
#pragma unroll
        for (unsigned j = 0; j < 16; ++j) { const unsigned c = xb_ld(&bar[XB_XCNT(j)]); sum += c; cnt += (c > 0u) ? 1u : 0u; mine = (j == x) ? c : mine; }
        if (sum == G) break;
        __builtin_amdgcn_s_sleep(1);
        if ((++sp & 255u) == 0u) { if (xb_ld(&bar[XB_TMO])) break; if (sp > XB_SPIN_CAP) { atomicAdd(&bar[XB_TMO], 1u); break; } }
    }
    nloc = mine > 0u ? mine : 1u; nx = cnt > 0u ? cnt : 1u;
}
__device__ __forceinline__ void xcd_barrier(const XcdBarrier& b) {
    asm volatile("s_waitcnt vmcnt(0)" ::: "memory");
    __syncthreads();
    if (threadIdx.x == 0) {
        unsigned* bar = b.bar;
        __builtin_amdgcn_s_waitcnt(0);
        unsigned nloc = b.st[0], nx = b.st[1];
        if (nloc == 0u) { xcd_barrier_complete(bar, b.x, nloc, nx); b.st[0] = nloc; b.st[1] = nx; }
        const unsigned old = xb_add(&bar[XB_XSUB(b.x)], 1u);
        const unsigned gen = old / nloc;
        if (old + 1u == (gen + 1u) * nloc) {
            __builtin_amdgcn_fence(__ATOMIC_RELEASE, "agent");
            asm volatile("s_waitcnt vmcnt(0)" ::: "memory");
            const unsigned og = xb_add(&bar[XB_TOP], 1u);
            const unsigned tg = og / nx;
            if (og + 1u == (tg + 1u) * nx) xb_add(&bar[XB_TOPGEN], 1u);
            else XB_SPIN(xb_ld(&bar[XB_TOPGEN]) == tg, bar);
            __builtin_amdgcn_fence(__ATOMIC_ACQUIRE, "agent");
            xb_add(&bar[XB_XGEN(b.x)], 1u);
            asm volatile("s_waitcnt vmcnt(0)" ::: "memory");
        } else {
            XB_SPIN(xb_ld(&bar[XB_XGEN(b.x)]) == gen, bar);
            __builtin_amdgcn_fence(__ATOMIC_ACQUIRE, "agent");
            asm volatile("s_waitcnt vmcnt(0)" ::: "memory");
        }
    }
    __syncthreads();
}

__device__ __forceinline__ float bf_lo(unsigned u) { return __uint_as_float(u << 16); }
__device__ __forceinline__ float bf_hi(unsigned u) { return __uint_as_float(u & 0xffff0000u); }
__device__ __forceinline__ float bf2f(bf16_t b) { return __uint_as_float(((unsigned)b) << 16); }
typedef float pkf32x2_t __attribute__((ext_vector_type(2))); typedef __bf16 pkbf16x2_t __attribute__((ext_vector_type(2)));
__device__ __forceinline__ unsigned pk_bf16(float lo, float hi) { pkf32x2_t v = {lo, hi}; pkbf16x2_t b = __builtin_convertvector(v, pkbf16x2_t); return __builtin_bit_cast(unsigned, b); }
__device__ __forceinline__ bf16x8 pack8(const float (&v)[8]) { u32x4 u = {pk_bf16(v[0], v[1]), pk_bf16(v[2], v[3]), pk_bf16(v[4], v[5]), pk_bf16(v[6], v[7])}; return __builtin_bit_cast(bf16x8, u); }
__device__ __forceinline__ float sigmoidf_(float x) { return __builtin_amdgcn_rcpf(1.0f + __expf(-x)); }
__device__ __forceinline__ float siluf_(float x) { return x * __builtin_amdgcn_rcpf(1.0f + __expf(-x)); }
__device__ __forceinline__ float dpp_f(float v, const int ctrl_sel) {
    const int x = __float_as_int(v);
    int r;
    if (ctrl_sel == 0) r = __builtin_amdgcn_update_dpp(0, x, 0xB1, 0xF, 0xF, true);
    else if (ctrl_sel == 1) r = __builtin_amdgcn_update_dpp(0, x, 0x4E, 0xF, 0xF, true);
    else if (ctrl_sel == 2) r = __builtin_amdgcn_update_dpp(0, x, 0x141, 0xF, 0xF, true);
    else r = __builtin_amdgcn_update_dpp(0, x, 0x140, 0xF, 0xF, true);
    return __int_as_float(r);
}
__device__ __forceinline__ float wave_sum(float v) {
    v += dpp_f(v, 0); v += dpp_f(v, 1); v += dpp_f(v, 2); v += dpp_f(v, 3);
    { auto rr = __builtin_amdgcn_permlane16_swap(__float_as_uint(v), __float_as_uint(v), false, false); v = __uint_as_float(rr[0]) + __uint_as_float(rr[1]); }
    { auto rr = __builtin_amdgcn_permlane32_swap(__float_as_uint(v), __float_as_uint(v), false, false); v = __uint_as_float(rr[0]) + __uint_as_float(rr[1]); }
    return v;
}

__device__ __forceinline__ int tid_() { int t = threadIdx.x; asm volatile("" : "+v"(t)); return t; }
__device__ __forceinline__ int bid_() { int t = blockIdx.x; asm volatile("" : "+s"(t)); return t; }
#ifndef REPEAT_MASK
#define REPEAT_MASK 0
#endif
#define NREP(j) (((REPEAT_MASK >> (j)) & 1) ? 2 : 1)
struct Params {
    const float* in[24];
    float* out;
    unsigned char* ws;
    int ph_lo, ph_hi;
};
enum { I_X = 0, I_C, I_CTX, I_CCTX, I_WADA, I_BADA, I_GMIX, I_GFFN, I_WIN, I_RPB, I_LBL, I_HGN, I_QNG, I_KNG, I_WBR, I_WOUT,
       I_WGR, I_BGR, I_WER, I_BER, I_WEG, I_WEU, I_WED, I_GFIN };

__device__ __forceinline__ void g128_kloop(f32x4 (&acc)[4][4], LAS unsigned char* lds, const bf16_t* A, int lda, const bf16_t* Bt, int ldb, int K) {
    const int tid = tid_(), wid = tid >> 6, lane = tid & 63, wr = wid >> 2, wc = wid & 3, fr = lane & 15, fq = lane >> 4;
    LAS unsigned char* SA = lds; LAS unsigned char* SB = lds + 8192;
    const int srow = tid >> 2, skc = (tid & 3) * 8;
    const bf16_t* ap = A + (size_t)srow * lda + skc;
    const bf16_t* bp0 = Bt + (size_t)srow * ldb + skc;
    const bf16_t* bp1 = Bt + (size_t)(srow + 128) * ldb + skc;
    for (int k0 = 0; k0 < K; k0 += 32) {
        const uint4 va = *(const uint4*)(ap + k0);
        const uint4 vb0 = *(const uint4*)(bp0 + k0);
        const uint4 vb1 = *(const uint4*)(bp1 + k0);
        __syncthreads();
        *(LAS u32x4*)(SA + tid * 16) = (u32x4){va.x, va.y, va.z, va.w};
        *(LAS u32x4*)(SB + tid * 16) = (u32x4){vb0.x, vb0.y, vb0.z, vb0.w};
        *(LAS u32x4*)(SB + 8192 + tid * 16) = (u32x4){vb1.x, vb1.y, vb1.z, vb1.w};
        __syncthreads();
        bf16x8 At[4], Bf[4];
#pragma unroll
        for (int m = 0; m < 4; ++m) At[m] = *(const LAS bf16x8*)(SA + ((wr * 64 + m * 16 + fr) * 32 + fq * 8) * 2);
#pragma unroll
        for (int n = 0; n < 4; ++n) Bf[n] = *(const LAS bf16x8*)(SB + ((wc * 64 + n * 16 + fr) * 32 + fq * 8) * 2);
#pragma unroll
        for (int m = 0; m < 4; ++m)
#pragma unroll
            for (int n = 0; n < 4; ++n) acc[m][n] = __builtin_amdgcn_mfma_f32_16x16x32_bf16(Bf[n], At[m], acc[m][n], 0, 0, 0);
    }
}
__device__ __forceinline__ void acc_zero(f32x4 (&acc)[4][4]) {
#pragma unroll
    for (int m = 0; m < 4; ++m)
#pragma unroll
        for (int n = 0; n < 4; ++n) acc[m][n] = (f32x4){0.f, 0.f, 0.f, 0.f};
}
template <class Epi>
__device__ __forceinline__ void g128_epilogue(const f32x4 (&acc)[4][4], int row0, int col0, const Epi& E) {
    const int tid = tid_(), wid = tid >> 6, lane = tid & 63, wr = wid >> 2, wc = wid & 3, fr = lane & 15, fq = lane >> 4;
#pragma unroll
    for (int m = 0; m < 4; ++m)
#pragma unroll
        for (int n = 0; n < 4; n += 2) E(row0 + wr * 64 + m * 16 + fr, col0 + wc * 64 + n * 16 + fq * 4, acc[m][n], acc[m][n + 1]);
}


namespace pg8 {
constexpr int BM = 256, BK = 64, HALF = 128, HTB = HALF * BK * 2, STAGE_BYTES = 8 * HTB;
__device__ __forceinline__ int lds_byte(int r, int c) { const int st = (r >> 4) * 2 + (c >> 5), rr = r & 15, cc = c & 31, ob = rr * 64 + cc * 2; return st * 1024 + (ob ^ (((ob >> 9) & 1) << 5)); }
__device__ __forceinline__ void stage_rc(int b, int& R, int& C) { const int st = b / 1024, sb = b % 1024, swz = sb ^ (((sb >> 9) & 1) << 5); R = (st >> 1) * 16 + swz / 64; C = (st & 1) * 32 + (swz % 64) / 2; }
struct Unit { int row0, col0, aux; const char* A; const char* B; };
struct Gemm { int K, lda, ldb; };
template <class Epi, class Sched>
__device__ __forceinline__ void gemm_phase(LAS unsigned char* lds, const Gemm g, const Sched& S, const Epi& E) {
    const int tid = tid_(), wid = __builtin_amdgcn_readfirstlane(tid >> 6), lane = tid & 63, wr = wid >> 2, wc = wid & 3, fr = lane & 15, fq = lane >> 4;
    const int K = g.K, nt = K / BK;
    unsigned voffA[2], voffB[2];
#pragma unroll
    for (int i = 0; i < 2; ++i) { int R, C; stage_rc(tid * 16 + i * 8192, R, C);
        voffA[i] = (unsigned)(R * g.lda + C) * 2u; voffB[i] = (unsigned)(R * g.ldb + C) * 2u; }
    const size_t kstep = (size_t)(BK * 2);
    const size_t hstepA = (size_t)HALF * g.lda * 2, hstepB = (size_t)HALF * g.ldb * 2;
    const unsigned ldsw = (unsigned)wid * 1024u;
    const int aoff = lds_byte(wr * 64 + fr, fq * 8), boff = lds_byte(wc * 32 + fr, fq * 8);
#define PG8_SA(b, h) (((b) * 2 + (h)) * HTB)
#define PG8_SB(b, h) ((4 + (b) * 2 + (h)) * HTB)
#define PG8_STAGE(bufoff, gbase, voff) do { _Pragma("unroll") for (int _i = 0; _i < 2; ++_i) \
        __builtin_amdgcn_global_load_lds((const unsigned*)((const char*)(gbase) + (voff)[_i]), (LAS unsigned*)(lds + (bufoff) + ldsw + _i * 8192), 16, 0, 0); } while (0)
#define PG8_LDA(dst, b, h) do { _Pragma("unroll") for (int m = 0; m < 4; ++m) _Pragma("unroll") for (int k = 0; k < 2; ++k) dst[m][k] = *(const LAS bf16x8*)(lds + PG8_SA(b, h) + aoff + m * 2048 + k * 1024); } while (0)
#define PG8_LDB(dst, b, h) do { _Pragma("unroll") for (int n = 0; n < 2; ++n) _Pragma("unroll") for (int k = 0; k < 2; ++k) dst[n][k] = *(const LAS bf16x8*)(lds + PG8_SB(b, h) + boff + n * 2048 + k * 1024); } while (0)
#define PG8_MMA(ai, bj, At, Bt) do { __builtin_amdgcn_s_setprio(1); _Pragma("unroll") for (int m = 0; m < 4; ++m) _Pragma("unroll") for (int n = 0; n < 2; ++n) _Pragma("unroll") for (int k = 0; k < 2; ++k) \
        acc[ai][bj][m][n] = __builtin_amdgcn_mfma_f32_16x16x32_bf16(Bt[n][k], At[m][k], acc[ai][bj][m][n], 0, 0, 0); __builtin_amdgcn_s_setprio(0); } while (0)
#define PG8_WAIT_V(n) asm volatile("s_waitcnt vmcnt(" #n ")" ::: "memory")
#define PG8_WAIT_L(n) asm volatile("s_waitcnt lgkmcnt(" #n ")" ::: "memory")
#define PG8_BAR __builtin_amdgcn_s_barrier()
#define PG8_SCHED __builtin_amdgcn_sched_barrier(0)
    Unit cur, nxt; int ui = 0;
    if (!S.next(0, cur)) return;
    f32x4 acc[2][2][4][2];
#pragma unroll
    for (int a = 0; a < 2; ++a)
#pragma unroll
        for (int b = 0; b < 2; ++b)
#pragma unroll
            for (int m = 0; m < 4; ++m)
#pragma unroll
                for (int n = 0; n < 2; ++n) acc[a][b][m][n] = (f32x4){0.f, 0.f, 0.f, 0.f};
    bf16x8 At[4][2], B0[2][2], B1[2][2];
    const char* cA = cur.A; const char* cB = cur.B;
    PG8_STAGE(PG8_SB(0, 0), cB, voffB); PG8_STAGE(PG8_SA(0, 0), cA, voffA); PG8_STAGE(PG8_SB(0, 1), cB + hstepB, voffB); PG8_STAGE(PG8_SA(0, 1), cA + hstepA, voffA);
    if (wr == 1) PG8_BAR;
    PG8_WAIT_V(4); PG8_BAR;
    PG8_STAGE(PG8_SB(1, 0), cB + kstep, voffB); PG8_STAGE(PG8_SA(1, 0), cA + kstep, voffA); PG8_STAGE(PG8_SB(1, 1), cB + hstepB + kstep, voffB);
    PG8_WAIT_V(6); PG8_BAR;
    for (;;) {
        const bool has_next = S.next(ui + 1, nxt);
        const char* nA = has_next ? nxt.A : cA; const char* nB = has_next ? nxt.B : cB;
        for (int t = 0; t < nt; t += 2) {
            const bool last = (t == nt - 2);
            const char* a1 = cA + (size_t)(t + 1) * kstep;
            const char* a2 = last ? nA : cA + (size_t)(t + 2) * kstep; const char* b2 = last ? nB : cB + (size_t)(t + 2) * kstep;
            const char* a3 = a2 + kstep; const char* b3 = b2 + kstep;
            PG8_LDB(B0, 0, 0); PG8_SCHED; PG8_LDA(At, 0, 0); PG8_STAGE(PG8_SA(1, 1), a1 + hstepA, voffA);
            PG8_WAIT_L(8); PG8_BAR; PG8_WAIT_L(0); PG8_MMA(0, 0, At, B0); PG8_BAR; PG8_SCHED;
            PG8_LDB(B1, 0, 1); PG8_STAGE(PG8_SB(0, 0), b2, voffB);
            PG8_BAR; PG8_WAIT_L(0); PG8_MMA(0, 1, At, B1); PG8_BAR;
            PG8_LDA(At, 0, 1); PG8_STAGE(PG8_SA(0, 0), a2, voffA);
            PG8_BAR; PG8_WAIT_L(0); PG8_MMA(1, 0, At, B0); PG8_BAR; PG8_SCHED;
            PG8_STAGE(PG8_SB(0, 1), b2 + hstepB, voffB);
            PG8_WAIT_V(6); PG8_BAR; PG8_MMA(1, 1, At, B1); PG8_BAR;
            PG8_LDB(B0, 1, 0); PG8_SCHED; PG8_LDA(At, 1, 0); PG8_STAGE(PG8_SA(0, 1), a2 + hstepA, voffA);
            PG8_WAIT_L(8); PG8_BAR; PG8_WAIT_L(0); PG8_MMA(0, 0, At, B0); PG8_BAR; PG8_SCHED;
            PG8_LDB(B1, 1, 1); PG8_STAGE(PG8_SB(1, 0), b3, voffB);
            PG8_BAR; PG8_WAIT_L(0); PG8_MMA(0, 1, At, B1); PG8_BAR;
            PG8_LDA(At, 1, 1); PG8_STAGE(PG8_SA(1, 0), a3, voffA);
            PG8_BAR; PG8_WAIT_L(0); PG8_MMA(1, 0, At, B0); PG8_BAR; PG8_SCHED;
            PG8_STAGE(PG8_SB(1, 1), b3 + hstepB, voffB);
            PG8_WAIT_V(6); PG8_BAR; PG8_MMA(1, 1, At, B1); PG8_BAR;
        }
        E(acc, cur, wr, wc, fr, fq);
        if (!has_next) break;
#pragma unroll
        for (int a = 0; a < 2; ++a)
#pragma unroll
            for (int b = 0; b < 2; ++b)
#pragma unroll
                for (int m = 0; m < 4; ++m)
#pragma unroll
                    for (int n = 0; n < 2; ++n) acc[a][b][m][n] = (f32x4){0.f, 0.f, 0.f, 0.f};
        cur = nxt; cA = nA; cB = nB; ++ui;
    }
    PG8_WAIT_V(0);
    if (wr == 0) PG8_BAR;
    PG8_BAR;
#undef PG8_SA
#undef PG8_SB
#undef PG8_STAGE
#undef PG8_LDA
#undef PG8_LDB
#undef PG8_MMA
#undef PG8_WAIT_V
#undef PG8_WAIT_L
#undef PG8_BAR
#undef PG8_SCHED
}
template <class F> struct EpiPair { F f;
    __device__ __forceinline__ void operator()(const f32x4 (&acc)[2][2][4][2], const Unit& u, int wr, int wc, int fr, int fq) const {
#pragma unroll
        for (int ai = 0; ai < 2; ++ai)
#pragma unroll
            for (int m = 0; m < 4; ++m)
#pragma unroll
                for (int bj = 0; bj < 2; ++bj) f(u, u.row0 + ai * HALF + wr * 64 + m * 16 + fr, u.col0 + bj * HALF + wc * 32 + 4 * fq, acc[ai][bj][m][0], acc[ai][bj][m][1]);
    } };
struct SchedDense { int nM, nN, G, c; const char* A; const char* B; size_t tA, tB;
    __device__ __forceinline__ bool next(int i, Unit& u) const {
        const int nwg = nM * nN; const long L = (long)i * G + c; if (L >= nwg) return false;
        int wgid = (int)L; { const int q = nwg / 8, r = nwg % 8, xcd = wgid % 8, off = wgid / 8; wgid = (xcd < r ? xcd * (q + 1) : r * (q + 1) + (xcd - r) * q) + off; }
        const int nig = 8 * nN, gid = wgid / nig, fm = gid * 8, gsz = (nM - fm) < 8 ? (nM - fm) : 8;
        const int pm = fm + ((wgid % nig) % gsz), pn = (wgid % nig) / gsz;
        u.row0 = pm * 256; u.col0 = pn * 256; u.aux = 0; u.A = A + (size_t)pm * tA; u.B = B + (size_t)pn * tB; return true; } };
}


namespace gqa {
using f32x16 = __attribute__((ext_vector_type(16))) float;
using s16x4 = __attribute__((ext_vector_type(4))) short;
constexpr int QP = 512, KVP = 128, OP = BRW;
constexpr int NW = 8, QBLK = 32, KVBLK = 64;
__device__ __forceinline__ int crow(int r, int hi) { return (r & 3) + 8 * (r >> 2) + 4 * hi; }
#define SBAR() __builtin_amdgcn_sched_barrier(0)
constexpr int NSLOT = 3, SLOTB = 8192;
constexpr int LDS_K = 0, LDS_V = NSLOT * SLOTB, LDS_WS = 2 * NSLOT * SLOTB, LDS_OST = LDS_WS + NW * 64 * 4, LDS_BYTES_ = LDS_OST + NW * 4096;
__device__ __forceinline__ void glds16(const void* gsrc, unsigned lds_dst) { unsigned keep;
  asm volatile("s_mov_b32 %0, m0\n\ts_mov_b32 m0, %2\n\ts_nop 0\n\tglobal_load_lds_dwordx4 %1, off\n\ts_mov_b32 m0, %0" : "=&s"(keep) : "v"(gsrc), "s"(lds_dst) : "memory"); }
__device__ __forceinline__ float max3f(float a, float b, float c) { float r; asm("v_max3_f32 %0, %1, %2, %3" : "=v"(r) : "v"(a), "v"(b), "v"(c)); return r; }
__device__ __forceinline__ float max2f(float a, float b) { float r; asm("v_max_f32_e32 %0, %1, %2" : "=v"(r) : "v"(a), "v"(b)); return r; }
__device__ __forceinline__ float fadd_s(float a, float b) { float r; asm("v_add_f32_e32 %0, %1, %2" : "=v"(r) : "v"(a), "v"(b)); return r; }
__device__ __forceinline__ float fsub_s(float a, float b) { float r; asm("v_sub_f32_e32 %0, %1, %2" : "=v"(r) : "v"(a), "v"(b)); return r; }
typedef float f32x2_t __attribute__((ext_vector_type(2))); typedef __bf16 bf16x2_t __attribute__((ext_vector_type(2)));
__device__ __forceinline__ unsigned cvtpk_s(float lo, float hi) { f32x2_t v = {lo, hi}; bf16x2_t b = __builtin_convertvector(v, bf16x2_t); return __builtin_bit_cast(unsigned, b); }
#define WAIT_BAR(N) asm volatile("s_waitcnt vmcnt(" #N ") lgkmcnt(0)\n\ts_barrier" ::: "memory")
__device__ __forceinline__ void qkt(f32x16& p0, f32x16& p1, const char* Kslot, const bf16x8* qr, const f32x16& negm, int r32, int hi) {
  const char* kb = Kslot + hi * 1024 + r32 * 16;
  #pragma unroll
  for (int d0 = 0; d0 < 4; ++d0) {
    const bf16x8 b0 = *reinterpret_cast<const bf16x8*>(kb + d0 * 2048);
    const bf16x8 b1 = *reinterpret_cast<const bf16x8*>(kb + d0 * 2048 + 512);
    if (d0 == 0) { p0 = __builtin_amdgcn_mfma_f32_32x32x16_bf16(b0, qr[0], negm, 0, 0, 0); p1 = __builtin_amdgcn_mfma_f32_32x32x16_bf16(b1, qr[0], negm, 0, 0, 0); }
    else { p0 = __builtin_amdgcn_mfma_f32_32x32x16_bf16(b0, qr[d0], p0, 0, 0, 0); p1 = __builtin_amdgcn_mfma_f32_32x32x16_bf16(b1, qr[d0], p1, 0, 0, 0); } }
}
typedef __attribute__((address_space(3))) const char* lds_cptr;
typedef short v4i16_t __attribute__((ext_vector_type(4)));
__device__ __forceinline__ void kload8(bf16x8* kf, lds_cptr kp) {
  kf[0] = *(const LAS bf16x8*)(kp);        kf[1] = *(const LAS bf16x8*)(kp + 512);
  kf[2] = *(const LAS bf16x8*)(kp + 2048); kf[3] = *(const LAS bf16x8*)(kp + 2560);
  kf[4] = *(const LAS bf16x8*)(kp + 4096); kf[5] = *(const LAS bf16x8*)(kp + 4608);
  kf[6] = *(const LAS bf16x8*)(kp + 6144); kf[7] = *(const LAS bf16x8*)(kp + 6656);
}
__device__ __forceinline__ void kload2(bf16x8* kf, lds_cptr kp, int j) { kf[2 * j] = *(const LAS bf16x8*)(kp + j * 2048); kf[2 * j + 1] = *(const LAS bf16x8*)(kp + j * 2048 + 512); }
__device__ __forceinline__ s16x4 vtr(lds_cptr p) { return __builtin_bit_cast(s16x4, __builtin_amdgcn_ds_read_tr16_b64_v4i16((LAS v4i16_t*)p)); }
__device__ __forceinline__ float rowmax(const f32x16& p0, const f32x16& p1) {
  float a = max3f(p0[0], p0[1], p1[0]), b = max3f(p0[2], p0[3], p1[1]); a = max3f(a, p1[2], p1[3]);
  #pragma unroll
  for (int r = 4; r < 16; r += 4) { a = max3f(a, p0[r], p0[r + 1]); b = max3f(b, p0[r + 2], p0[r + 3]); a = max3f(a, p1[r], p1[r + 1]); b = max3f(b, p1[r + 2], p1[r + 3]); }
  const float m = max2f(a, b);
  auto rr = __builtin_amdgcn_permlane32_swap(__float_as_uint(m), __float_as_uint(m), false, false);
  return max2f(__uint_as_float(rr[0]), __uint_as_float(rr[1]));
}
__device__ __forceinline__ void pv(f32x16* o, int vb, bf16x8 pa0, bf16x8 pa1, bf16x8 pa2, bf16x8 pa3) {
  #pragma unroll
  for (int d0 = 0; d0 < 2; ++d0) { s16x4 lo[4], hi[4];
    #pragma unroll
    for (int ks = 0; ks < 4; ++ks) {
      asm volatile("ds_read_b64_tr_b16 %0,%1 offset:%c2" : "=&v"(lo[ks]) : "v"(vb), "i"(d0 * 4096 + ks * 1024) : "memory");
      asm volatile("ds_read_b64_tr_b16 %0,%1 offset:%c2" : "=&v"(hi[ks]) : "v"(vb), "i"(d0 * 4096 + ks * 1024 + 512) : "memory"); }
    asm volatile("s_waitcnt lgkmcnt(0)" ::: "memory"); SBAR();
    #define PK(k) (bf16x8){lo[k][0], lo[k][1], lo[k][2], lo[k][3], hi[k][0], hi[k][1], hi[k][2], hi[k][3]}
    o[d0] = __builtin_amdgcn_mfma_f32_32x32x16_bf16(pa0, PK(0), o[d0], 0, 0, 0);
    o[d0] = __builtin_amdgcn_mfma_f32_32x32x16_bf16(pa1, PK(1), o[d0], 0, 0, 0);
    o[d0] = __builtin_amdgcn_mfma_f32_32x32x16_bf16(pa2, PK(2), o[d0], 0, 0, 0);
    o[d0] = __builtin_amdgcn_mfma_f32_32x32x16_bf16(pa3, PK(3), o[d0], 0, 0, 0);
    #undef PK
  }
}
template <int THRL> __device__ __forceinline__ void attn_unit(const bf16_t* Qu, const bf16_t* __restrict__ Kh, const bf16_t* __restrict__ Vh, bf16_t* Ou, const int NT, char* shm) {
  const int tid = tid_(), lane = tid & 63, r32 = lane & 31, hi = lane >> 5; const int wid = __builtin_amdgcn_readfirstlane(tid >> 6);
  const bf16_t* Qw = Qu + (long)wid * QBLK * QP;
  const unsigned lds0 = (unsigned)(uintptr_t)shm;
  float* wsf = (float*)(shm + LDS_WS) + wid * 64;
  const bf16_t* ksrc = Kh + (long)lane * KVP + wid * 8;
  const bf16_t* vsrc = Vh + (long)(16 * (wid & 3) + (lane >> 2)) * KVP + (wid >> 2) * 32 + (lane & 3) * 8;
  const unsigned kdst = lds0 + LDS_K + wid * 1024, vdst = lds0 + LDS_V + wid * 1024;
  #define DMA_K(t, slot) glds16(ksrc + (long)(t) * KVBLK * KVP, (unsigned)__builtin_amdgcn_readfirstlane(kdst + (slot)))
  #define DMA_V(t, slot) glds16(vsrc + (long)(t) * KVBLK * KVP, (unsigned)__builtin_amdgcn_readfirstlane(vdst + (slot)))
  const int vb0 = (int)(lds0 + LDS_V) + ((lane >> 4) & 1) * 32 + (lane & 3) * 8 + (4 * hi + ((lane & 15) >> 2)) * 64;
  const char* Kbase = shm + LDS_K; bf16x8 kf[8];
  const lds_cptr shm3 = (lds_cptr)shm; const lds_cptr kp0 = shm3 + LDS_K + hi * 1024 + r32 * 16; const lds_cptr vp0 = shm3 + LDS_V + ((lane >> 4) & 1) * 32 + (lane & 3) * 8 + (4 * hi + ((lane & 15) >> 2)) * 64;
  DMA_K(0, 0); DMA_V(0, 0); DMA_K(1, SLOTB);
  bf16x8 qr[4];
  #pragma unroll
  for (int d0 = 0; d0 < 4; ++d0) qr[d0] = *reinterpret_cast<const bf16x8*>(&Qw[(long)r32 * QP + d0 * 16 + hi * 8]);
  float mhat = 0.f, l_reg = 0.f; f32x16 o[2]; o[0] = f32x16{}; o[1] = f32x16{}; f32x16 negm = f32x16{}; asm volatile("" : "+v"(negm));
  bool resc = false;
  #define START(P0, P1) do { const float rm = rowmax(P0, P1); resc = false; \
    { const float dl = rm; mhat = fadd_s(mhat, dl); \
      _Pragma("unroll") for (int r = 0; r < 16; ++r) { P0[r] = fsub_s(P0[r], dl); P1[r] = fsub_s(P1[r], dl); } \
      _Pragma("unroll") for (int r = 0; r < 16; ++r) negm[r] = -mhat; asm volatile("" : "+v"(negm)); } \
    _Pragma("unroll") for (int r = 0; r < 16; ++r) P0[r] = __builtin_amdgcn_exp2f(P0[r]); } while (0)
  #define RESC() do { if (resc) { asm volatile("s_waitcnt lgkmcnt(0)" ::: "memory"); \
      _Pragma("unroll") for (int d_ = 0; d_ < 2; ++d_) _Pragma("unroll") for (int r = 0; r < 16; ++r) o[d_][r] *= wsf[crow(r, hi)]; } } while (0)
  f32x16 pA0, pA1, pB0, pB1;
  int sl_prev = 0, sl_cur = 0, sl_next = SLOTB;
  #define ROT() do { sl_prev = sl_cur; sl_cur = sl_next; sl_next = (sl_next == (NSLOT - 1) * SLOTB) ? 0 : sl_next + SLOTB; } while (0)
  DMA_K(2, 2 * SLOTB);
  WAIT_BAR(3);
  qkt(pA0, pA1, Kbase, qr, negm, r32, hi); asm volatile("s_nop 15\n\ts_nop 7" : "+v"(pA0), "+v"(pA1));
  START(pA0, pA1);
  _Pragma("unroll") for (int r = 0; r < 16; ++r) pA1[r] = __builtin_amdgcn_exp2f(pA1[r]);
  WAIT_BAR(0);
  DMA_K(3, 0); DMA_V(1, SLOTB);
  ROT();
  kload8(kf, kp0 + sl_cur);
  WAIT_BAR(2);
  s16x4 vlo[8], vhi[8]; u32x4 pw0, pw1, pw2, pw3;
  #define PKW(P, B) cvtpk_s(P[B], P[B + 1])
  #define PAF(k) __builtin_bit_cast(bf16x8, pw##k)
  #define VFR(i) (bf16x8){vlo[i][0], vlo[i][1], vlo[i][2], vlo[i][3], vhi[i][0], vhi[i][1], vhi[i][2], vhi[i][3]}
  #define PIN(x) asm volatile("" : "+v"(x))
  #define MX3(a, b, c) __builtin_fmaxf(__builtin_fmaxf((a), (b)), (c))
  #define GAPA(MF, A0, A1, A2, A3, W0, W1, PW) do { MF; sacc += A0; sacc += A1; sacc += A2; sacc += A3; PIN(sacc); W0; W1; PIN(PW); SBAR(); } while (0)
  #define EX(v) __builtin_amdgcn_exp2f(v)
  #define GAPB(MF, X, B) do { MF; X[B] = EX(X[B]); X[B + 1] = EX(X[B + 1]); X[B + 2] = EX(X[B + 2]); X[B + 3] = EX(X[B + 3]); PIN(X); SBAR(); } while (0)
  #define VRD(i) do { vlo[i] = vtr(vp_ + (((i) >> 2) * 4096 + ((i) & 3) * 1024)); vhi[i] = vtr(vp_ + (((i) >> 2) * 4096 + ((i) & 3) * 1024 + 512)); } while (0)
  #define KRD(G, j) do { if (G) { kload2(kf, kp0 + sl_next, j); SBAR(); } } while (0)
  #define STEP(C0, C1, P0, P1, t, GK, GV, GL) do { SBAR(); \
    const lds_cptr vp_ = vp0 + sl_prev; \
    VRD(0); SBAR(); float sacc = (P0[0] + P0[1]); \
    GAPA(C0 = __builtin_amdgcn_mfma_f32_32x32x16_bf16(kf[0], qr[0], negm, 0, 0, 0), P0[2], P0[3], P0[4], P0[5],     pw0[0] = PKW(P0, 0), pw0[1] = PKW(P0, 2), pw0); \
    VRD(4); SBAR(); GAPA(C1 = __builtin_amdgcn_mfma_f32_32x32x16_bf16(kf[1], qr[0], negm, 0, 0, 0), P0[6], P0[7], P0[8], P0[9],     pw0[2] = PKW(P0, 4), pw0[3] = PKW(P0, 6), pw0); \
    VRD(1); SBAR(); GAPA(C0 = __builtin_amdgcn_mfma_f32_32x32x16_bf16(kf[2], qr[1], C0, 0, 0, 0),   P0[10], P0[11], P0[12], P0[13], pw1[0] = PKW(P0, 8), pw1[1] = PKW(P0, 10), pw1); \
    VRD(5); SBAR(); GAPA(C1 = __builtin_amdgcn_mfma_f32_32x32x16_bf16(kf[3], qr[1], C1, 0, 0, 0),   P0[14], P0[15], P1[0], P1[1],   pw1[2] = PKW(P0, 12), pw1[3] = PKW(P0, 14), pw1); \
    VRD(2); SBAR(); GAPA(C0 = __builtin_amdgcn_mfma_f32_32x32x16_bf16(kf[4], qr[2], C0, 0, 0, 0),   P1[2], P1[3], P1[4], P1[5],     pw2[0] = PKW(P1, 0), pw2[1] = PKW(P1, 2), pw2); \
    VRD(6); SBAR(); GAPA(C1 = __builtin_amdgcn_mfma_f32_32x32x16_bf16(kf[5], qr[2], C1, 0, 0, 0),   P1[6], P1[7], P1[8], P1[9],     pw2[2] = PKW(P1, 4), pw2[3] = PKW(P1, 6), pw2); \
    VRD(3); SBAR(); GAPA(C0 = __builtin_amdgcn_mfma_f32_32x32x16_bf16(kf[6], qr[3], C0, 0, 0, 0),   P1[10], P1[11], P1[12], P1[13], pw3[0] = PKW(P1, 8), pw3[1] = PKW(P1, 10), pw3); \
    VRD(7); SBAR(); GAPA(C1 = __builtin_amdgcn_mfma_f32_32x32x16_bf16(kf[7], qr[3], C1, 0, 0, 0),   P1[14], P1[15], 0.f, 0.f,       pw3[2] = PKW(P1, 12), pw3[3] = PKW(P1, 14), pw3); \
    l_reg += sacc; \
    if (GK) { DMA_K((t) + 3, sl_cur); } if (GV) { DMA_V((t) + 1, sl_next); } \
    { float a = MX3(C0[0], C0[1], C1[0]), b = MX3(C0[2], C0[3], C1[1]); a = MX3(a, C1[2], C1[3]); \
      _Pragma("unroll") for (int r = 4; r < 16; r += 4) { a = MX3(a, C0[r], C0[r + 1]); b = MX3(b, C0[r + 2], C0[r + 3]); a = MX3(a, C1[r], C1[r + 1]); b = MX3(b, C1[r + 2], C1[r + 3]); } \
      float rm = __builtin_fmaxf(a, b); { auto rr = __builtin_amdgcn_permlane32_swap(__float_as_uint(rm), __float_as_uint(rm), false, false); rm = __builtin_fmaxf(__uint_as_float(rr[0]), __uint_as_float(rr[1])); } \
      resc = false; \
      if (__builtin_expect(__any(rm > (float)THRL), 0)) { const float dl = __builtin_fmaxf(rm, 0.f); mhat += dl; \
        _Pragma("unroll") for (int r = 0; r < 16; ++r) { C0[r] -= dl; C1[r] -= dl; } \
        _Pragma("unroll") for (int r = 0; r < 16; ++r) negm[r] = -mhat; asm volatile("" : "+v"(negm)); \
        const float f = __builtin_amdgcn_exp2f(-dl); l_reg *= f; if (hi == 0) wsf[r32] = f; resc = true; } } \
    SBAR(); \
    GAPB(o[0] = __builtin_amdgcn_mfma_f32_32x32x16_bf16(PAF(0), VFR(0), o[0], 0, 0, 0), C0, 0); \
    GAPB(o[1] = __builtin_amdgcn_mfma_f32_32x32x16_bf16(PAF(0), VFR(4), o[1], 0, 0, 0), C0, 4); \
    KRD(GL, 0); GAPB(o[0] = __builtin_amdgcn_mfma_f32_32x32x16_bf16(PAF(1), VFR(1), o[0], 0, 0, 0), C0, 8); \
    KRD(GL, 1); GAPB(o[1] = __builtin_amdgcn_mfma_f32_32x32x16_bf16(PAF(1), VFR(5), o[1], 0, 0, 0), C0, 12); \
    KRD(GL, 2); GAPB(o[0] = __builtin_amdgcn_mfma_f32_32x32x16_bf16(PAF(2), VFR(2), o[0], 0, 0, 0), C1, 0); \
    KRD(GL, 3); GAPB(o[1] = __builtin_amdgcn_mfma_f32_32x32x16_bf16(PAF(2), VFR(6), o[1], 0, 0, 0), C1, 4); \
    GAPB(o[0] = __builtin_amdgcn_mfma_f32_32x32x16_bf16(PAF(3), VFR(3), o[0], 0, 0, 0), C1, 8); \
    GAPB(o[1] = __builtin_amdgcn_mfma_f32_32x32x16_bf16(PAF(3), VFR(7), o[1], 0, 0, 0), C1, 12); \
    } while (0)
  int t = 1;
  for (; t + 5 < NT; t += 2) {
    STEP(pB0, pB1, pA0, pA1, t, true, true, true);     WAIT_BAR(2); RESC(); ROT();
    STEP(pA0, pA1, pB0, pB1, t + 1, true, true, true); WAIT_BAR(2); RESC(); ROT();
  }
  #define ENDW(tt) do { if ((tt) + 3 < NT) { WAIT_BAR(2); } else if ((tt) + 2 < NT) { WAIT_BAR(1); } else { WAIT_BAR(0); } } while (0)
  for (; t + 1 < NT; t += 2) {
    STEP(pB0, pB1, pA0, pA1, t, (t + 3 < NT), (t + 1 < NT), (t + 1 < NT));         ENDW(t);     RESC(); ROT();
    STEP(pA0, pA1, pB0, pB1, t + 1, (t + 4 < NT), (t + 2 < NT), (t + 2 < NT));     ENDW(t + 1); RESC(); ROT();
  }
  STEP(pB0, pB1, pA0, pA1, NT - 1, false, false, false); RESC();
  { float sacc = pB0[0] + pB0[1]; _Pragma("unroll") for (int r = 2; r < 16; ++r) sacc += pB0[r]; _Pragma("unroll") for (int r = 0; r < 16; ++r) sacc += pB1[r]; l_reg += sacc;
    pw0 = (u32x4){PKW(pB0, 0), PKW(pB0, 2), PKW(pB0, 4), PKW(pB0, 6)}; pw1 = (u32x4){PKW(pB0, 8), PKW(pB0, 10), PKW(pB0, 12), PKW(pB0, 14)}; pw2 = (u32x4){PKW(pB1, 0), PKW(pB1, 2), PKW(pB1, 4), PKW(pB1, 6)}; pw3 = (u32x4){PKW(pB1, 8), PKW(pB1, 10), PKW(pB1, 12), PKW(pB1, 14)};
    SBAR(); pv(o, vb0 + sl_cur, PAF(0), PAF(1), PAF(2), PAF(3)); }
  #undef PKW
  #undef PAF
  #undef VFR
  #undef PIN
  #undef MX3
  #undef GAPA
  #undef GAPB
  #undef EX
  #undef VRD
  #undef KRD
  #undef STEP
  #undef ENDW
  { auto rr = __builtin_amdgcn_permlane32_swap(__float_as_uint(l_reg), __float_as_uint(l_reg), false, false); l_reg = __uint_as_float(rr[0]) + __uint_as_float(rr[1]); }
  if (hi == 0) wsf[32 + r32] = l_reg; asm volatile("s_waitcnt lgkmcnt(0)" ::: "memory");
  float rli[16];
  #pragma unroll
  for (int r = 0; r < 16; ++r) rli[r] = __builtin_amdgcn_rcpf(wsf[32 + crow(r, hi)]);
  bf16_t* Ow = Ou + (long)wid * QBLK * OP;
  { bf16_t* stg = (bf16_t*)(shm + LDS_OST) + wid * 2048;
    #pragma unroll
    for (int r = 0; r < 16; ++r) { const int orow = crow(r, hi);
      #pragma unroll
      for (int d0 = 0; d0 < 2; ++d0) stg[orow * 64 + d0 * 32 + r32] = (bf16_t)(cvtpk_s(o[d0][r] * rli[r], 0.f) & 0xffffu); }
    asm volatile("s_waitcnt lgkmcnt(0)" ::: "memory");
    #pragma unroll
    for (int i = 0; i < 4; ++i) { const int row = i * 8 + (lane >> 3), ch = lane & 7; const u32x4 v = *(const u32x4*)(stg + row * 64 + ch * 8); *(u32x4*)(Ow + (long)row * OP + ch * 8) = v; } }
  asm volatile("s_waitcnt lgkmcnt(0)\n\ts_barrier" ::: "memory");
  #undef DMA_K
  #undef DMA_V
  #undef START
  #undef RESC
  #undef ROT
}
#undef SBAR
#undef WAIT_BAR
}

__device__ __forceinline__ void ph_prologue(const Params& P, LAS unsigned char* lds) {
    const int tid = tid_(), bid = bid_(), G = gridDim.x, lane = tid & 63, wid = tid >> 6;
    float* mods = (float*)(P.ws + WS_MODS);
    LAS float* sc = (LAS float*)lds;
    LAS float* red = sc + 9 * 1024;
    for (int i = tid; i < 9 * 1024; i += NTHR) { const float v = (i < 8192) ? P.in[I_C][i] : P.in[I_CCTX][i - 8192]; sc[i] = siluf_(v); }
    __syncthreads();
    {
        const int c = lane & 31, slot = wid * 2 + (lane >> 5);
        for (int u = bid; u < 4 * 192; u += G) {
            const int l = u / 192, cg = u % 192;
            const float* w = P.in[I_WADA] + (size_t)l * 1024 * 6144 + cg * 32 + c;
            float a[9];
#pragma unroll
            for (int r = 0; r < 9; ++r) a[r] = 0.f;
#pragma unroll 8
            for (int i = 0; i < 64; ++i) { const int k = slot + 16 * i; const float wv = w[(size_t)k * 6144];
#pragma unroll
                for (int r = 0; r < 9; ++r) a[r] += sc[r * 1024 + k] * wv; }
#pragma unroll
            for (int r = 0; r < 9; ++r) red[(slot * 9 + r) * 32 + c] = a[r];
            __syncthreads();
            if (tid < 288) { const int r = tid >> 5, cc = tid & 31; float s_ = 0.f;
#pragma unroll
                for (int q = 0; q < 16; ++q) s_ += red[(q * 9 + r) * 32 + cc];
                mods[((size_t)l * 9 + r) * 6144 + cg * 32 + cc] = s_ + P.in[I_BADA][l * 6144 + cg * 32 + cc]; }
            __syncthreads();
        }
    }
    if (bid == G - 1) {
        float* lbv = (float*)(P.ws + WS_LB);
        for (int i = tid; i < 1024; i += NTHR) {
            float lg[DEPTH], mx = -1e30f;
#pragma unroll
            for (int l = 0; l < DEPTH; ++l) { lg[l] = P.in[I_LBL][l * 1024 + i]; mx = fmaxf(mx, lg[l]); }
            float s = 0.f;
#pragma unroll
            for (int l = 0; l < DEPTH; ++l) { lg[l] = expf(lg[l] - mx); s += lg[l]; }
            float cum = 0.f;
#pragma unroll
            for (int l = 0; l < DEPTH; ++l) { if (l > 0) cum += lg[l] / s; lbv[l * 1024 + i] = cum; }
        }
        float* rope = (float*)(P.ws + WS_ROPE);
        for (int i = tid; i < 96 * 16; i += NTHR) {
            const int pos = i >> 4, fi = i & 15;
            const float inv = powf(10000.0f, -(float)fi / 16.0f);
            const float p = (pos < 32) ? (float)pos : (float)(pos - 32);
            const float ang = p * inv;
            if (pos < 32) { rope[pos * 16 + fi] = cosf(ang); rope[512 + pos * 16 + fi] = sinf(ang); }
            else { rope[1024 + (pos - 32) * 16 + fi] = cosf(ang); rope[2048 + (pos - 32) * 16 + fi] = sinf(ang); }
        }
    }
    float4* xr = (float4*)(P.ws + WS_X);
    const float4* xs = (const float4*)P.in[I_X]; const float4* cs = (const float4*)P.in[I_CTX];
    const size_t nx4 = (size_t)NLAT * D / 4, nc4 = (size_t)NCTX * D / 4;
    for (size_t i = (size_t)bid * NTHR + tid; i < nx4 + nc4; i += (size_t)G * NTHR) xr[i] = (i < nx4) ? xs[i] : cs[i - nx4];
}

struct ConvJob { const float* srcA; const float* srcB; int ld; bool inter; bool perm; bf16_t* dst; int K, n0, k0; };
__device__ __forceinline__ int perm32(int rho) { const int n = rho >> 4, i = rho & 15; return 8 * (i >> 2) + 4 * n + (i & 3); }
__device__ __forceinline__ bool conv_job(const Params& P, int l, int u, ConvJob& J) {
    constexpr int T_IN = 16 * 124, T_BR = 3 * 8 * 16, T_OUT = 16 * 16, T_GU = 16 * 16 * 16, T_DN = 16 * 8 * 16;
    constexpr int TOT = T_IN + T_BR + T_OUT + T_GU + T_DN;
    if (u >= TOT) return false;
    int v = u;
    J.srcB = nullptr; J.inter = false; J.perm = false;
    if (v < T_IN) { const int kt = v % 16, nt = v / 16; J.perm = true; J.srcA = P.in[I_WIN] + (size_t)l * 1024 * INC; J.ld = INC; J.dst = (bf16_t*)(P.ws + WS_WIN); J.K = 1024; J.n0 = nt * 64; J.k0 = kt * 64; return true; }
    v -= T_IN;
    if (v < T_BR) { const int i = v / 128, w = v % 128, kt = w % 8, nt = w / 8; J.perm = true; J.srcA = P.in[I_WBR] + ((size_t)l * 3 + i) * 512 * 1024; J.ld = 1024; J.dst = (bf16_t*)(P.ws + WS_WBR) + (size_t)i * 1024 * 512; J.K = 512; J.n0 = nt * 64; J.k0 = kt * 64; return true; }
    v -= T_BR;
    if (v < T_OUT) { const int kt = v % 16, nt = v / 16; J.srcA = P.in[I_WOUT] + (size_t)l * 1024 * 1024; J.ld = 1024; J.dst = (bf16_t*)(P.ws + WS_WOUT); J.K = 1024; J.n0 = nt * 64; J.k0 = kt * 64; return true; }
    v -= T_OUT;
    if (v < T_GU) { const int e = v / 256, w = v % 256, kt = w % 16, nt = w / 16; const size_t eo = ((size_t)l * NEXP + e) * 1024 * 512;
        J.srcA = P.in[I_WEG] + eo; J.srcB = P.in[I_WEU] + eo; J.inter = true; J.ld = 512; J.dst = (bf16_t*)(P.ws + WS_WGU) + (size_t)e * 1024 * 1024; J.K = 1024; J.n0 = nt * 64; J.k0 = kt * 64; return true; }
    v -= T_GU;
    { const int e = v / 128, w = v % 128, kt = w % 8, nt = w / 8; J.perm = true; J.srcA = P.in[I_WED] + ((size_t)l * NEXP + e) * 512 * 1024; J.ld = 1024; J.dst = (bf16_t*)(P.ws + WS_WDN) + (size_t)e * 1024 * 512; J.K = 512; J.n0 = nt * 64; J.k0 = kt * 64; return true; }
}
__device__ __forceinline__ void conv_load(const ConvJob& J, int tid, float (&v)[8]) {
    const int nn = tid & 63, kk = tid >> 6, n = J.n0 + nn;
    const float* cp;
    if (J.perm) cp = J.srcA + (n & ~31) + perm32(n & 31); else if (!J.inter) cp = J.srcA + n; else { const int g = n >> 5, i = n & 31; cp = (i < 16) ? (J.srcA + 16 * g + i) : (J.srcB + 16 * g + i - 16); }
#pragma unroll
    for (int p = 0; p < 8; ++p) v[p] = cp[(size_t)(J.k0 + kk + 8 * p) * J.ld];
}
__device__ __forceinline__ void ph_wconv(const Params& P, LAS unsigned char* lds, int l) {
    LAS float* t = (LAS float*)lds;
    const int tid = tid_(), G = gridDim.x;
    int u = bid_();
    ConvJob J; float v[8];
    bool have = conv_job(P, l, u, J);
    if (have) conv_load(J, tid, v);
    while (have) {
        ConvJob Jn; float vn[8];
        const bool hn = conv_job(P, l, u + G, Jn);
        if (hn) conv_load(Jn, tid, vn);
        { const int nn = tid & 63, kk = tid >> 6;
#pragma unroll
          for (int p = 0; p < 8; ++p) t[(kk + 8 * p) * 65 + nn] = v[p]; }
        __syncthreads();
        { const int n = tid >> 3, k8 = (tid & 7) * 8;
          float w[8];
#pragma unroll
          for (int j = 0; j < 8; ++j) w[j] = t[(k8 + j) * 65 + n];
          uint4 o; o.x = pk_bf16(w[0], w[1]); o.y = pk_bf16(w[2], w[3]); o.z = pk_bf16(w[4], w[5]); o.w = pk_bf16(w[6], w[7]);
          *(uint4*)(J.dst + (size_t)(J.n0 + n) * J.K + J.k0 + k8) = o; }
        __syncthreads();
        J = Jn; have = hn; u += G;
#pragma unroll
        for (int p = 0; p < 8; ++p) v[p] = vn[p];
    }
}

__device__ __forceinline__ void norm_row(const float4 (&x)[4], const float* g, const float* shift, const float* scale, int lane, float4 (&o)[4]) {
    float ss = 0.f;
#pragma unroll
    for (int i = 0; i < 4; ++i) ss += x[i].x * x[i].x + x[i].y * x[i].y + x[i].z * x[i].z + x[i].w * x[i].w;
    ss = wave_sum(ss);
    const float rstd = __builtin_amdgcn_rsqf(ss * (1.0f / 1024.0f) + 1e-6f);
#pragma unroll
    for (int i = 0; i < 4; ++i) {
        const int c = lane * 4 + 256 * i;
        const float4 gv = *(const float4*)(g + c), sh = *(const float4*)(shift + c), sc = *(const float4*)(scale + c);
        o[i].x = x[i].x * rstd * gv.x * (1.0f + sc.x) + sh.x;
        o[i].y = x[i].y * rstd * gv.y * (1.0f + sc.y) + sh.y;
        o[i].z = x[i].z * rstd * gv.z * (1.0f + sc.z) + sh.z;
        o[i].w = x[i].w * rstd * gv.w * (1.0f + sc.w) + sh.w;
    }
}
__device__ __forceinline__ int row_modrow(int r) { return r < NLAT ? (r >> 11) : 8; }

__device__ __forceinline__ void ph_norm1(const Params& P, int l) {
    const int tid = tid_(), lane = tid & 63, wid = tid >> 6;
    const float* xres = (const float*)(P.ws + WS_X);
    bf16_t* h = (bf16_t*)(P.ws + WS_H);
    const float* g = P.in[I_GMIX] + l * 1024;
    for (int r = bid_() * 8 + wid; r < NTOK; r += gridDim.x * 8) {
        const float* mod = (const float*)(P.ws + WS_MODS) + ((size_t)l * 9 + row_modrow(r)) * 6144;
        float4 x[4], o[4];
#pragma unroll
        for (int i = 0; i < 4; ++i) x[i] = *(const float4*)(xres + (size_t)r * D + lane * 4 + 256 * i);
        norm_row(x, g, mod, mod + 1024, lane, o);
#pragma unroll
        for (int i = 0; i < 4; ++i) { uint2 u; u.x = pk_bf16(o[i].x, o[i].y); u.y = pk_bf16(o[i].z, o[i].w); *(uint2*)(h + (size_t)r * D + lane * 4 + 256 * i) = u; }
    }
}

struct EpiStoreBf16 { bf16_t* O; int ldc;
    __device__ __forceinline__ void operator()(int row, int col, const f32x4& v0, const f32x4& v1) const {
        uint2 a, b; a.x = pk_bf16(v0[0], v0[1]); a.y = pk_bf16(v0[2], v0[3]); b.x = pk_bf16(v1[0], v1[1]); b.y = pk_bf16(v1[2], v1[3]);
        *(uint2*)(O + (size_t)row * ldc + col) = a; *(uint2*)(O + (size_t)row * ldc + col + 16) = b; } };
struct EpiStore16 { bf16_t* O; int ldc;
    __device__ __forceinline__ void operator()(const f32x4 (&acc)[2][2][4][2], const pg8::Unit& u, int wr, int wc, int fr, int fq) const {
#pragma unroll
        for (int ai = 0; ai < 2; ++ai)
#pragma unroll
            for (int m = 0; m < 4; ++m)
#pragma unroll
                for (int bj = 0; bj < 2; ++bj) { const int row = u.row0 + ai * 128 + wr * 64 + m * 16 + fr, col = u.col0 + bj * 128 + wc * 32 + 8 * fq;
                    const f32x4 v0 = acc[ai][bj][m][0], v1 = acc[ai][bj][m][1];
                    uint4 o; o.x = pk_bf16(v0[0], v0[1]); o.y = pk_bf16(v0[2], v0[3]); o.z = pk_bf16(v1[0], v1[1]); o.w = pk_bf16(v1[2], v1[3]);
                    *(uint4*)(O + (size_t)row * ldc + col) = o; }
    } };
struct FStoreBf16 { bf16_t* O; int ldc;
    __device__ __forceinline__ void operator()(const pg8::Unit&, int row, int col, const f32x4& v0, const f32x4& v1) const {
        uint2 a, b; a.x = pk_bf16(v0[0], v0[1]); a.y = pk_bf16(v0[2], v0[3]); b.x = pk_bf16(v1[0], v1[1]); b.y = pk_bf16(v1[2], v1[3]);
        *(uint2*)(O + (size_t)row * ldc + col) = a; *(uint2*)(O + (size_t)row * ldc + col + 16) = b; } };
struct EpiG1 { bf16_t* Z; bf16_t* GT;
    __device__ __forceinline__ void operator()(const f32x4 (&acc)[2][2][4][2], const pg8::Unit& u, int wr, int wc, int fr, int fq) const {
        if (u.col0 < C_GATE) {
#pragma unroll
            for (int ai = 0; ai < 2; ++ai)
#pragma unroll
                for (int m = 0; m < 4; ++m)
#pragma unroll
                    for (int bj = 0; bj < 2; ++bj) { const int row = u.row0 + ai * 128 + wr * 64 + m * 16 + fr, col = u.col0 + bj * 128 + wc * 32 + 8 * fq;
                        const f32x4 v0 = acc[ai][bj][m][0], v1 = acc[ai][bj][m][1];
                        uint4 o; o.x = pk_bf16(v0[0], v0[1]); o.y = pk_bf16(v0[2], v0[3]); o.z = pk_bf16(v1[0], v1[1]); o.w = pk_bf16(v1[2], v1[3]);
                        *(uint4*)(Z + (size_t)row * ZP + col) = o; }
        } else {
            const int tidx = (wr * 4 + wc) * 64 + fq * 16 + fr;
            bf16_t* base = GT + ((size_t)(u.row0 >> 8) * 12 + ((u.col0 - C_GATE) >> 8)) * 65536 + tidx * 8;
#pragma unroll
            for (int ai = 0; ai < 2; ++ai)
#pragma unroll
                for (int bj = 0; bj < 2; ++bj)
#pragma unroll
                    for (int m = 0; m < 4; ++m) { const f32x4 v0 = acc[ai][bj][m][0], v1 = acc[ai][bj][m][1];
                        uint4 o; o.x = pk_bf16(sigmoidf_(v0[0]), sigmoidf_(v0[1])); o.y = pk_bf16(sigmoidf_(v0[2]), sigmoidf_(v0[3]));
                        o.z = pk_bf16(sigmoidf_(v1[0]), sigmoidf_(v1[1])); o.w = pk_bf16(sigmoidf_(v1[2]), sigmoidf_(v1[3]));
                        *(uint4*)(base + ((ai * 2 + bj) * 4 + m) * 4096) = o; }
        }
    } };
__device__ __forceinline__ void ph_g1(const Params& P, LAS unsigned char* lds) {
    pg8::SchedDense S{NTOK / 256, INC / 256, (int)gridDim.x, bid_(), (const char*)(P.ws + WS_H), (const char*)(P.ws + WS_WIN), (size_t)256 * D * 2, (size_t)256 * D * 2};
    EpiG1 E{(bf16_t*)(P.ws + WS_Z), (bf16_t*)(P.ws + WS_GT)};
    pg8::gemm_phase(lds, pg8::Gemm{D, D, D}, S, E);
}

__device__ __forceinline__ int kvrow(int r) { return r < NLAT ? ((r >> 11) * 2304 + 256 + (r & 2047)) : (((r - NLAT) >> 8) * 2304 + ((r - NLAT) & 255)); }
__device__ __forceinline__ void ph_prep(const Params& P, int l) {
    const int tid = tid_(), lane = tid & 63, wid = tid >> 6;
    const bf16_t* z = (const bf16_t*)(P.ws + WS_Z);
    bf16_t* qn = (bf16_t*)(P.ws + WS_QN); bf16_t* kn = (bf16_t*)(P.ws + WS_KN); bf16_t* vn = (bf16_t*)(P.ws + WS_VN);
    const float* rope = (const float*)(P.ws + WS_ROPE);
    const float gq = P.in[I_QNG][l * 64 + lane] * (0.125f * 1.4426950408889634f), gk = P.in[I_KNG][l * 64 + lane];
    for (int r = bid_() * 8 + wid; r < NTOK; r += gridDim.x * 8) {
        const bool lat = r < NLAT;
        const size_t kr = (size_t)kvrow(r);
        float cs = 1.f, sn = 0.f;
        if (lat) { const int t = r & 2047, fi = lane & 15;
            if (lane < 32) { const int pr = t >> 6; cs = rope[pr * 16 + fi]; sn = rope[512 + pr * 16 + fi]; }
            else { const int pc = t & 63; cs = rope[1024 + pc * 16 + fi]; sn = rope[2048 + pc * 16 + fi]; } }
        const float sgn = (lane & 16) ? 1.f : -1.f;
#pragma unroll
        for (int hh = 0; hh < 10; ++hh) {
            const int col = (hh < 8) ? (C_GQ + hh * 64) : (C_GK + (hh - 8) * 64);
            const float x = bf2f(z[(size_t)r * ZP + col + lane]);
            const float ss = wave_sum(x * x);
            const float xn = x * __builtin_amdgcn_rsqf(ss * (1.0f / 64.0f) + 1e-6f) * (hh < 8 ? gq : gk);
            const float pa = __shfl_xor(xn, 16, 64);
            const float o = xn * cs + sgn * pa * sn;
            const bf16_t ob = (bf16_t)(pk_bf16(o, 0.f) & 0xffffu);
            if (hh < 8) qn[(size_t)r * 512 + hh * 64 + lane] = ob; else kn[kr * 128 + (hh - 8) * 64 + lane] = ob;
        }
        *(unsigned*)(vn + kr * 128 + lane * 2) = *(const unsigned*)(z + (size_t)r * ZP + C_GV + lane * 2);
    }
}

__device__ __forceinline__ void ph_navt(const Params& P, LAS unsigned char* lds) {
    const int tid = tid_();
    const bf16_t* z = (const bf16_t*)(P.ws + WS_Z); bf16_t* vt = (bf16_t*)(P.ws + WS_NAVT);
    constexpr int PT = 1040;
    for (int u = bid_(); u < NB * 36; u += gridDim.x) {
        const int b = u / 36, tl = u % 36;
        const int row0 = (tl < 4) ? (NLAT + b * 256 + tl * 64) : (b * 2048 + (tl - 4) * 64);
        __syncthreads();
#pragma unroll
        for (int i = 0; i < 8; ++i) { const int ch = tid + i * NTHR, rr = ch >> 6, cc = ch & 63;
            const uint4 v = *(const uint4*)(z + (size_t)(row0 + rr) * ZP + C_NAV + cc * 8);
            *(LAS u32x4*)(lds + rr * PT + cc * 16) = (u32x4){v.x, v.y, v.z, v.w}; }
        __syncthreads();
#pragma unroll
        for (int i = 0; i < 8; ++i) { const int c = tid, tg = i;
            unsigned short e[8];
#pragma unroll
            for (int k = 0; k < 8; ++k) e[k] = *(const LAS unsigned short*)(lds + (tg * 8 + k) * PT + c * 2);
            uint4 o; o.x = e[0] | ((unsigned)e[1] << 16); o.y = e[2] | ((unsigned)e[3] << 16); o.z = e[4] | ((unsigned)e[5] << 16); o.w = e[6] | ((unsigned)e[7] << 16);
            *(uint4*)(vt + ((size_t)(b * 8 + (c >> 6)) * 64 + (c & 63)) * 2304 + tl * 64 + tg * 8) = o; }
    }
    __syncthreads();
}

#ifdef DIAG
__device__ __forceinline__ void load_q64(float (&q)[64], const bf16_t* p) {
#pragma unroll
    for (int i = 0; i < 8; ++i) { const uint4 u = ((const uint4*)p)[i];
        q[8 * i + 0] = bf_lo(u.x); q[8 * i + 1] = bf_hi(u.x); q[8 * i + 2] = bf_lo(u.y); q[8 * i + 3] = bf_hi(u.y);
        q[8 * i + 4] = bf_lo(u.z); q[8 * i + 5] = bf_hi(u.z); q[8 * i + 6] = bf_lo(u.w); q[8 * i + 7] = bf_hi(u.w); }
}
__device__ __forceinline__ void attn_key(const float (&q)[64], const bf16_t* kp, const bf16_t* vp, float bias, float& m, float& lsum, float (&o)[64]) {
    float s = 0.f;
#pragma unroll
    for (int i = 0; i < 8; ++i) { const uint4 u = ((const uint4*)kp)[i];
        s += q[8 * i + 0] * bf_lo(u.x) + q[8 * i + 1] * bf_hi(u.x) + q[8 * i + 2] * bf_lo(u.y) + q[8 * i + 3] * bf_hi(u.y)
           + q[8 * i + 4] * bf_lo(u.z) + q[8 * i + 5] * bf_hi(u.z) + q[8 * i + 6] * bf_lo(u.w) + q[8 * i + 7] * bf_hi(u.w); }
    s = s * 0.125f + bias;
    const float mn = fmaxf(m, s), corr = __expf(m - mn), pp = __expf(s - mn);
    lsum = lsum * corr + pp; m = mn;
#pragma unroll
    for (int i = 0; i < 8; ++i) { const uint4 u = ((const uint4*)vp)[i];
        o[8 * i + 0] = o[8 * i + 0] * corr + pp * bf_lo(u.x); o[8 * i + 1] = o[8 * i + 1] * corr + pp * bf_hi(u.x);
        o[8 * i + 2] = o[8 * i + 2] * corr + pp * bf_lo(u.y); o[8 * i + 3] = o[8 * i + 3] * corr + pp * bf_hi(u.y);
        o[8 * i + 4] = o[8 * i + 4] * corr + pp * bf_lo(u.z); o[8 * i + 5] = o[8 * i + 5] * corr + pp * bf_hi(u.z);
        o[8 * i + 6] = o[8 * i + 6] * corr + pp * bf_lo(u.w); o[8 * i + 7] = o[8 * i + 7] * corr + pp * bf_hi(u.w); }
}
__device__ __forceinline__ void store_o64(const float (&o)[64], float inv, bf16_t* p) {
#pragma unroll
    for (int i = 0; i < 8; ++i) { uint4 u;
        u.x = pk_bf16(o[8 * i + 0] * inv, o[8 * i + 1] * inv); u.y = pk_bf16(o[8 * i + 2] * inv, o[8 * i + 3] * inv);
        u.z = pk_bf16(o[8 * i + 4] * inv, o[8 * i + 5] * inv); u.w = pk_bf16(o[8 * i + 6] * inv, o[8 * i + 7] * inv);
        ((uint4*)p)[i] = u; }
}
__device__ __forceinline__ void na_thread(const Params& P, int l, int r, int h, bf16_t* br, int OPN) {
    const bf16_t* z = (const bf16_t*)(P.ws + WS_Z);
    float q[64], o[64]; float m = -INFINITY, ls = 0.f;
#pragma unroll
    for (int i = 0; i < 64; ++i) o[i] = 0.f;
    load_q64(q, z + (size_t)r * ZP + C_NAQ + h * 64);
    int b;
    if (r < NLAT) {
        b = r >> 11; const int t = r & 2047, qr = t >> 6, qc = t & 63;
        const int r0 = min(max(qr - 4, 0), 24), c0 = min(max(qc - 8, 0), 48);
        const float* rpb = P.in[I_RPB] + ((size_t)l * 8 + h) * 15 * 31;
        for (int kr = r0; kr < r0 + 8; ++kr)
            for (int kc = c0; kc < c0 + 16; ++kc) {
                const size_t krow = (size_t)(b * 2048 + kr * 64 + kc) * ZP;
                attn_key(q, z + krow + C_NAK + h * 64, z + krow + C_NAV + h * 64, rpb[(kr - qr + 7) * 31 + (kc - qc + 15)], m, ls, o);
            }
    } else b = (r - NLAT) >> 8;
    for (int j = 0; j < 256; ++j) {
        const size_t krow = (size_t)(NLAT + b * 256 + j) * ZP;
        attn_key(q, z + krow + C_NAK + h * 64, z + krow + C_NAV + h * 64, 0.f, m, ls, o);
    }
    store_o64(o, 1.0f / ls, br + (size_t)r * OPN + h * 64);
}
#endif
namespace na {
constexpr int KP = 144, VP = 528;
constexpr int L_K = 0, L_V = 256 * KP, L_B = L_V + 64 * VP, L_END = L_B + 480 * 4;
constexpr float C2 = 0.125f * 1.4426950408889634f, LOG2E = 1.4426950408889634f;
struct Acc { float m, l; f32x4 o[4]; };
template <class VF> __device__ __forceinline__ void absorb(Acc& A, f32x4 (&sa)[4], f32x4 (&sb)[4], const VF& vf) {
    float mx = -INFINITY;
#pragma unroll
    for (int g = 0; g < 4; ++g)
#pragma unroll
        for (int j = 0; j < 4; ++j) mx = fmaxf(mx, fmaxf(sa[g][j], sb[g][j]));
    mx = fmaxf(mx, __shfl_xor(mx, 16, 64)); mx = fmaxf(mx, __shfl_xor(mx, 32, 64));
    const float mn = fmaxf(A.m, mx), corr = __builtin_amdgcn_exp2f(A.m - mn);
    A.m = mn;
    float ps = 0.f;
    bf16x8 pf[4];
#pragma unroll
    for (int g = 0; g < 4; ++g) { float p[8];
#pragma unroll
        for (int j = 0; j < 4; ++j) { p[j] = __builtin_amdgcn_exp2f(sa[g][j] - mn); p[4 + j] = __builtin_amdgcn_exp2f(sb[g][j] - mn); ps += p[j] + p[4 + j]; }
        pf[g] = pack8(p); }
    A.l = A.l * corr + ps;
#pragma unroll
    for (int db = 0; db < 4; ++db) A.o[db] *= corr;
    bf16x8 vfr[4][4];
#pragma unroll
    for (int g = 0; g < 4; ++g)
#pragma unroll
        for (int db = 0; db < 4; ++db) vfr[g][db] = vf(g, db);
#pragma unroll
    for (int g = 0; g < 4; ++g)
#pragma unroll
        for (int db = 0; db < 4; ++db) A.o[db] = __builtin_amdgcn_mfma_f32_16x16x32_bf16(vfr[g][db], pf[g], A.o[db], 0, 0, 0);
}
}
__device__ __forceinline__ void na_unit(const Params& P, LAS unsigned char* lds, int l, int u, bf16_t* br, int OPN) {
    const int tid = tid_(), lane = tid & 63, wid = __builtin_amdgcn_readfirstlane(tid >> 6), c16 = lane & 15, kq = lane >> 4;
    const bool latu = u < 256;
    const int bh = latu ? (u >> 2) : (u - 256), b = bh >> 3, h = bh & 7, q4 = u & 3;
    const bf16_t* z = (const bf16_t*)(P.ws + WS_Z); const bf16_t* vt = (const bf16_t*)(P.ws + WS_NAVT) + (size_t)bh * 64 * 2304;
    LAS unsigned char* KL = lds + na::L_K; LAS unsigned char* VL = lds + na::L_V; LAS float* BL = (LAS float*)(lds + na::L_B);
    __syncthreads();
#pragma unroll
    for (int i = 0; i < 4; ++i) { const int ch = tid + i * NTHR, rr = ch >> 3, cc = ch & 7;
        const uint4 v = *(const uint4*)(z + (size_t)(NLAT + b * 256 + rr) * ZP + C_NAK + h * 64 + cc * 8);
        *(LAS u32x4*)(KL + rr * na::KP + cc * 16) = (u32x4){v.x, v.y, v.z, v.w}; }
#pragma unroll
    for (int i = 0; i < 4; ++i) { const int ch = tid + i * NTHR, rr = ch >> 5, cc = ch & 31;
        const uint4 v = *(const uint4*)(vt + (size_t)rr * 2304 + cc * 8);
        *(LAS u32x4*)(VL + rr * na::VP + cc * 16) = (u32x4){v.x, v.y, v.z, v.w}; }
    if (tid < 465) BL[tid] = P.in[I_RPB][((size_t)l * 8 + h) * 465 + tid] * na::LOG2E;
    __syncthreads();
    const int sA = 8 * (c16 >> 2) + (c16 & 3);
    const int ntask = latu ? 4 : 2;
    for (int it = 0; it < ntask; ++it) {
        const int tk = it * 8 + wid;
        int qrow, r = 0, jb = 0;
        if (latu) { r = q4 * 8 + (tk >> 2); jb = tk & 3; qrow = b * 2048 + r * 64 + jb * 16 + c16; }
        else qrow = NLAT + b * 256 + tk * 16 + c16;
        bf16x8 qf[2];
#pragma unroll
        for (int ks = 0; ks < 2; ++ks) qf[ks] = *(const bf16x8*)(z + (size_t)qrow * ZP + C_NAQ + h * 64 + 32 * ks + 8 * kq);
        bf16_t* op = br + (size_t)qrow * OPN + h * 64 + 4 * kq; asm volatile("" : "+v"(op));
        na::Acc A; A.m = -INFINITY; A.l = 0.f;
#pragma unroll
        for (int db = 0; db < 4; ++db) A.o[db] = (f32x4){0.f, 0.f, 0.f, 0.f};
        if (latu) {
            const int r0 = min(max(r - 4, 0), 24), kc0 = min(max(jb * 16 - 8, 0), 32), qc = jb * 16 + c16, c0 = min(max(qc - 8, 0), 48);
            int dcol[8]; bool ok[8];
#pragma unroll
            for (int j = 0; j < 8; ++j) { const int kc = kc0 + 8 * kq + j; ok[j] = (kc >= c0) && (kc < c0 + 16); dcol[j] = ok[j] ? (kc - qc + 15) : 0; }
#pragma unroll 1
            for (int ch = 0; ch < 2; ++ch) {
                f32x4 sa[4], sb[4];
                const size_t tokbase = (size_t)b * 2048 + (size_t)(r0 + ch * 4) * 64 + kc0;
                bf16x8 kf[4][4];
#pragma unroll
                for (int g = 0; g < 4; ++g) {
                    const bf16_t* kp = z + (tokbase + (size_t)g * 64 + sA) * ZP + C_NAK + h * 64 + 8 * kq;
                    kf[g][0] = *(const bf16x8*)kp; kf[g][1] = *(const bf16x8*)(kp + 32); kf[g][2] = *(const bf16x8*)(kp + 4 * ZP); kf[g][3] = *(const bf16x8*)(kp + 4 * ZP + 32);
                }
                float bv[4][8];
#pragma unroll
                for (int g = 0; g < 4; ++g) { const int brow = (r0 + ch * 4 + g - r + 7) * 31;
#pragma unroll
                    for (int j = 0; j < 8; ++j) bv[g][j] = BL[brow + dcol[j]]; }
#pragma unroll
                for (int g = 0; g < 4; ++g) {
                    f32x4 a = {0.f, 0.f, 0.f, 0.f}, bq = {0.f, 0.f, 0.f, 0.f};
                    a = __builtin_amdgcn_mfma_f32_16x16x32_bf16(kf[g][0], qf[0], a, 0, 0, 0); a = __builtin_amdgcn_mfma_f32_16x16x32_bf16(kf[g][1], qf[1], a, 0, 0, 0);
                    bq = __builtin_amdgcn_mfma_f32_16x16x32_bf16(kf[g][2], qf[0], bq, 0, 0, 0); bq = __builtin_amdgcn_mfma_f32_16x16x32_bf16(kf[g][3], qf[1], bq, 0, 0, 0);
#pragma unroll
                    for (int j = 0; j < 4; ++j) {
                        const float va = a[j] * na::C2 + bv[g][j], vb = bq[j] * na::C2 + bv[g][4 + j];
                        sa[g][j] = ok[j] ? va : -INFINITY;
                        sb[g][j] = ok[4 + j] ? vb : -INFINITY; }
                }
                const bf16_t* vp = vt + (size_t)c16 * 2304 + 256 + (r0 + ch * 4) * 64 + kc0 + 8 * kq;
                na::absorb(A, sa, sb, [&](int g, int db) { return *(const bf16x8*)(vp + (size_t)db * 16 * 2304 + g * 64); });
            }
        }
#pragma unroll 1
        for (int ch = 0; ch < 2; ++ch) {
            f32x4 sa[4], sb[4];
            bf16x8 kf[4][4];
#pragma unroll
            for (int g = 0; g < 4; ++g) {
                const LAS unsigned char* kp = KL + (ch * 128 + g * 32 + sA) * na::KP + kq * 16;
                kf[g][0] = *(const LAS bf16x8*)kp; kf[g][1] = *(const LAS bf16x8*)(kp + 64); kf[g][2] = *(const LAS bf16x8*)(kp + 4 * na::KP); kf[g][3] = *(const LAS bf16x8*)(kp + 4 * na::KP + 64);
            }
#pragma unroll
            for (int g = 0; g < 4; ++g) {
                f32x4 a = {0.f, 0.f, 0.f, 0.f}, bq = {0.f, 0.f, 0.f, 0.f};
                a = __builtin_amdgcn_mfma_f32_16x16x32_bf16(kf[g][0], qf[0], a, 0, 0, 0); a = __builtin_amdgcn_mfma_f32_16x16x32_bf16(kf[g][1], qf[1], a, 0, 0, 0);
                bq = __builtin_amdgcn_mfma_f32_16x16x32_bf16(kf[g][2], qf[0], bq, 0, 0, 0); bq = __builtin_amdgcn_mfma_f32_16x16x32_bf16(kf[g][3], qf[1], bq, 0, 0, 0);
                sa[g] = a * na::C2; sb[g] = bq * na::C2;
            }
            const LAS unsigned char* vp = VL + c16 * na::VP + (ch * 128 + 8 * kq) * 2;
            na::absorb(A, sa, sb, [&](int g, int db) { return *(const LAS bf16x8*)(vp + db * 16 * na::VP + g * 64); });
        }
        float ls = A.l; ls += __shfl_xor(ls, 16, 64); ls += __shfl_xor(ls, 32, 64);
        const float inv = __builtin_amdgcn_rcpf(ls);
#pragma unroll
        for (int db = 0; db < 4; ++db) { uint2 o; o.x = pk_bf16(A.o[db][0] * inv, A.o[db][1] * inv); o.y = pk_bf16(A.o[db][2] * inv, A.o[db][3] * inv);
            *(uint2*)(op + 16 * db) = o; }
    }
}
__device__ __forceinline__ int hg_row(int b, int dir, int s) { return s < 256 ? (NLAT + b * 256 + (dir ? 255 - s : s)) : (b * 2048 + (dir ? 2047 - (s - 256) : (s - 256))); }
__device__ __forceinline__ bf16x8 tr2(const LAS unsigned char* p0, const LAS unsigned char* p1) {
    typedef short v4i16_t __attribute__((ext_vector_type(4)));
    const v4i16_t a = __builtin_amdgcn_ds_read_tr16_b64_v4i16((LAS v4i16_t*)p0), c = __builtin_amdgcn_ds_read_tr16_b64_v4i16((LAS v4i16_t*)p1);
    return (bf16x8){a[0], a[1], a[2], a[3], c[0], c[1], c[2], c[3]};
}
__device__ __forceinline__ void hgrn_unit(const Params& P, LAS unsigned char* lds, int l, int u) {
    const int tid = tid_(), lane = tid & 63, wid = __builtin_amdgcn_readfirstlane(tid >> 6), c16 = lane & 15, kq = lane >> 4;
    const int b = u >> 3, h = (u >> 1) & 3, dir = u & 1;
    const bf16_t* z = (const bf16_t*)(P.ws + WS_Z);
    float* O = (float*)(P.ws + (dir ? WS_Y : WS_H));
    const float* lbv = (const float*)(P.ws + WS_LB) + ((size_t)l * 2 + dir) * 512 + h * 128;
    constexpr int PQ = 272;
    LAS unsigned char* QH = lds; LAS unsigned char* KT = lds + 8704; LAS unsigned char* KH = lds + 17408; LAS unsigned char* VV = lds + 26112;
    LAS float* DL = (LAS float*)(lds + 34816); LAS float* WT = DL + 128;
    const int ch = 2 * lane;
    const float lb0 = lbv[ch], lb1 = lbv[ch + 1];
    const int cf = (dir ? C_HFB : C_HFF) + h * 128 + ch, cq = C_HQ + h * 128 + ch, cv = C_HI + h * 128 + ch;
    f32x4 SA[4], SB[4];
#pragma unroll
    for (int G = 0; G < 4; ++G) { SA[G] = (f32x4){0.f, 0.f, 0.f, 0.f}; SB[G] = (f32x4){0.f, 0.f, 0.f, 0.f}; }
    unsigned rf[4], rq[4], rv[4];
#pragma unroll
    for (int k = 0; k < 4; ++k) { const bf16_t* zr = z + (size_t)hg_row(b, dir, 4 * wid + k) * ZP; rf[k] = *(const unsigned*)(zr + cf); rq[k] = *(const unsigned*)(zr + cq); rv[k] = *(const unsigned*)(zr + cv); }
    const int sA = 8 * (c16 >> 2) + (c16 & 3);
    const int tq = c16 >> 2, tp = c16 & 3;
    for (int st = 0; st < 72; ++st) {
        unsigned xf[4], xq[4], xv[4];
#pragma unroll
        for (int k = 0; k < 4; ++k) { xf[k] = rf[k]; xq[k] = rq[k]; xv[k] = rv[k]; }
        if (st + 1 < 72) {
#pragma unroll
            for (int k = 0; k < 4; ++k) { const bf16_t* zr = z + (size_t)hg_row(b, dir, (st + 1) * 32 + 4 * wid + k) * ZP; rf[k] = *(const unsigned*)(zr + cf); rq[k] = *(const unsigned*)(zr + cq); rv[k] = *(const unsigned*)(zr + cv); }
        }
        float g0[4], g1[4], k0[4], k1[4], q0[4], q1[4];
        float c0 = 1.f, c1 = 1.f;
#pragma unroll
        for (int k = 0; k < 4; ++k) {
            const float f0 = lb0 + (1.0f - lb0) * sigmoidf_(bf_lo(xf[k])), f1 = lb1 + (1.0f - lb1) * sigmoidf_(bf_hi(xf[k]));
            c0 *= f0; c1 *= f1; g0[k] = c0; g1[k] = c1;
            k0[k] = 1.0f - f0; k1[k] = 1.0f - f1; q0[k] = siluf_(bf_lo(xq[k])); q1[k] = siluf_(bf_hi(xq[k]));
        }
        WT[wid * 128 + ch] = c0; WT[wid * 128 + ch + 1] = c1;
        __syncthreads();
        float pre0 = 1.f, pre1 = 1.f, tot0 = 1.f, tot1 = 1.f;
#pragma unroll
        for (int w = 0; w < 8; ++w) { const float a0 = WT[w * 128 + ch], a1 = WT[w * 128 + ch + 1]; tot0 *= a0; tot1 *= a1; if (w < wid) { pre0 *= a0; pre1 *= a1; } }
#pragma unroll
        for (int k = 0; k < 4; ++k) {
            const float e0 = g0[k] * pre0, e1 = g1[k] * pre1;
            const float r0 = __builtin_amdgcn_rcpf(e0), r1 = __builtin_amdgcn_rcpf(e1);
            const float kt0 = k0[k] * r0, kt1 = k1[k] * r1;
            const int ro = (4 * wid + k) * PQ + ch * 2;
            *(LAS unsigned*)(QH + ro) = pk_bf16(q0[k] * e0, q1[k] * e1);
            *(LAS unsigned*)(KT + ro) = pk_bf16(kt0, kt1);
            *(LAS unsigned*)(KH + ro) = pk_bf16(kt0 * tot0, kt1 * tot1);
            *(LAS unsigned*)(VV + ro) = xv[k];
        }
        if (wid == 0) { DL[ch] = tot0; DL[ch + 1] = tot1; }
        __syncthreads();
        const bf16x8 vfr = tr2(VV + (8 * kq + tq) * PQ + (16 * wid + 4 * tp) * 2, VV + (8 * kq + 4 + tq) * PQ + (16 * wid + 4 * tp) * 2);
        bf16x8 Sb[4];
#pragma unroll
        for (int G = 0; G < 4; ++G) { const float sv[8] = {SA[G][0], SA[G][1], SA[G][2], SA[G][3], SB[G][0], SB[G][1], SB[G][2], SB[G][3]}; Sb[G] = pack8(sv); }
#pragma unroll
        for (int T = 0; T < 2; ++T) {
            f32x4 aA = {0.f, 0.f, 0.f, 0.f}, aB = {0.f, 0.f, 0.f, 0.f};
            bf16x8 qf[4];
#pragma unroll
            for (int ks = 0; ks < 4; ++ks) {
                const bf16x8 kA = *(const LAS bf16x8*)(KT + sA * PQ + (32 * ks + 8 * kq) * 2);
                const bf16x8 kB = *(const LAS bf16x8*)(KT + (sA + 4) * PQ + (32 * ks + 8 * kq) * 2);
                qf[ks] = *(const LAS bf16x8*)(QH + (16 * T + c16) * PQ + (32 * ks + 8 * kq) * 2);
                aA = __builtin_amdgcn_mfma_f32_16x16x32_bf16(kA, qf[ks], aA, 0, 0, 0);
                aB = __builtin_amdgcn_mfma_f32_16x16x32_bf16(kB, qf[ks], aB, 0, 0, 0);
            }
            const int t = 16 * T + c16;
            float pv_[8];
#pragma unroll
            for (int jj = 0; jj < 4; ++jj) { pv_[jj] = (8 * kq + jj <= t) ? aA[jj] : 0.f; pv_[4 + jj] = (8 * kq + 4 + jj <= t) ? aB[jj] : 0.f; }
            f32x4 o = {0.f, 0.f, 0.f, 0.f};
            o = __builtin_amdgcn_mfma_f32_16x16x32_bf16(pack8(pv_), vfr, o, 0, 0, 0);
#pragma unroll
            for (int ks = 0; ks < 4; ++ks) o = __builtin_amdgcn_mfma_f32_16x16x32_bf16(qf[ks], Sb[ks], o, 0, 0, 0);
#pragma unroll
            for (int jj = 0; jj < 4; ++jj) O[(size_t)hg_row(b, dir, st * 32 + 16 * T + 4 * kq + jj) * 512 + h * 128 + 16 * wid + c16] = o[jj];
        }
#pragma unroll
        for (int G = 0; G < 4; ++G) {
            const f32x4 d0 = *(const LAS f32x4*)(DL + 32 * G + 8 * kq), d1 = *(const LAS f32x4*)(DL + 32 * G + 8 * kq + 4);
            const LAS unsigned char* ka = KH + (8 * kq + tq) * PQ + (32 * G + 8 * tp) * 2;
            const bf16x8 hA = tr2(ka, ka + 4 * PQ), hB = tr2(ka + 8, ka + 4 * PQ + 8);
            SA[G] = __builtin_amdgcn_mfma_f32_16x16x32_bf16(hA, vfr, SA[G] * d0, 0, 0, 0);
            SB[G] = __builtin_amdgcn_mfma_f32_16x16x32_bf16(hB, vfr, SB[G] * d1, 0, 0, 0);
        }
    }
    __syncthreads();
}
__device__ __forceinline__ void gqa_unit(const Params& P, char* shm, int U) {
    const bf16_t* qn = (const bf16_t*)(P.ws + WS_QN); const bf16_t* kn = (const bf16_t*)(P.ws + WS_KN); const bf16_t* vn = (const bf16_t*)(P.ws + WS_VN);
    bf16_t* br = (bf16_t*)(P.ws + WS_BR);
    int b, hq, row0, NT;
    if (U < 512) { const int bg = U >> 5; b = bg >> 1; hq = (bg & 1) * 4 + ((U & 31) >> 3); row0 = b * 2048 + (U & 7) * 256; NT = 36; }
    else { const int v = U - 512; b = v >> 3; hq = v & 7; row0 = NLAT + b * 256; NT = 4; }
    const int g = hq >> 2;
    gqa::attn_unit<8>(qn + (size_t)row0 * 512 + hq * 64, kn + (size_t)b * 2304 * 128 + g * 64, vn + (size_t)b * 2304 * 128 + g * 64,
                      br + (size_t)row0 * BRW + 1024 + hq * 64, NT, shm);
}
__device__ __forceinline__ void ph_mix(const Params& P, LAS unsigned char* lds, char* shm, int l, int pass = 0, int filter = 0) {
    const int tid = tid_();
    unsigned* qctr = (unsigned*)(P.ws + WS_CNT + 512) + l + 4 * pass;
    volatile LAS unsigned* qslot = (volatile LAS unsigned*)(lds + LDS_BYTES - 32);
    for (;;) {
        if (tid == 0) *qslot = __hip_atomic_fetch_add(qctr, 1u, __ATOMIC_RELAXED, __HIP_MEMORY_SCOPE_AGENT);
        __syncthreads();
        const int u = (int)*qslot;
        __syncthreads();
        if (u >= 960) break;
        const int kind = (u < 64) ? 2 : (u < 576 || (u >= 832 && u < 896)) ? 1 : 3;
        if (filter != 0 && filter != kind) continue;
        if (u < 64) hgrn_unit(P, lds, l, u);
        else if (u < 576) gqa_unit(P, shm, u - 64);
        else if (u < 832) na_unit(P, lds, l, u - 576, (bf16_t*)(P.ws + WS_BR), BRW);
        else if (u < 896) gqa_unit(P, shm, 512 + (u - 832));
        else na_unit(P, lds, l, 256 + (u - 896), (bf16_t*)(P.ws + WS_BR), BRW);
        __syncthreads();
    }
}
#ifdef DIAG
__device__ __forceinline__ void ph_diag_cmp(const Params& P) {
    const bf16_t* br = (const bf16_t*)(P.ws + WS_BR); const bf16_t* d1 = (const bf16_t*)(P.ws + WS_END); const bf16_t* d2 = d1 + (size_t)NTOK * 512;
    const bf16_t* z = (const bf16_t*)(P.ws + WS_Z); const bf16_t* vt = (const bf16_t*)(P.ws + WS_NAVT);
    unsigned* dg = (unsigned*)(P.ws + 20480);
    unsigned c1 = 0, c2 = 0, c3 = 0;
    for (size_t i = (size_t)bid_() * NTHR + tid_(); i < (size_t)NTOK * 512; i += (size_t)gridDim.x * NTHR) {
        const size_t r = i >> 9; const int c = (int)(i & 511);
        const float a = bf2f(br[r * BRW + c]), x = bf2f(d1[i]);
        if (!(fabsf(x - a) <= 0.004f + 0.02f * fabsf(a))) ++c1;
        if (DIAG != 4 && d1[i] != d2[i]) ++c3;
        const int rr = (int)r; const int bb = rr < NLAT ? (rr >> 11) : ((rr - NLAT) >> 8); const int tok = rr < NLAT ? (256 + (rr & 2047)) : ((rr - NLAT) & 255);
        if (vt[((size_t)(bb * 8 + (c >> 6)) * 64 + (c & 63)) * 2304 + tok] != z[r * ZP + C_NAV + c]) ++c2;
    }
    if (c1) atomicAdd(dg + 1, c1);
    if (c2) atomicAdd(dg + 2, c2);
    if (c3) atomicAdd(dg + 3, c3);
}
__device__ __forceinline__ void ph_diag_out(const Params& P) {
    const volatile unsigned* dg = (const volatile unsigned*)(P.ws + 20480);
    const unsigned c1 = dg[1], c2 = dg[2], c3 = dg[3];
    if ((c1 | c2 | c3) == 0) return;
    unsigned k = 0; { unsigned v = c1; while (v) { ++k; v >>= 1; } }
    if (c2) k += 30; if (c3) k += 60;
    const float cst = sqrtf(10.0f * (float)k + 9.0f);
    for (size_t i = (size_t)bid_() * NTHR + tid_(); i < (size_t)NLAT * D; i += (size_t)gridDim.x * NTHR) P.out[i] = cst;
}
#endif

__device__ __forceinline__ void ph_readout(const Params& P, int l) {
    const int tid = tid_(), lane = tid & 63, wid = tid >> 6;
    const float* OF = (const float*)(P.ws + WS_H); const float* OB = (const float*)(P.ws + WS_Y);
    const bf16_t* z = (const bf16_t*)(P.ws + WS_Z);
    bf16_t* br = (bf16_t*)(P.ws + WS_BR);
    const float g0 = P.in[I_HGN][l * 128 + lane * 2], g1 = P.in[I_HGN][l * 128 + lane * 2 + 1];
    for (int r = bid_() * 8 + wid; r < NTOK; r += gridDim.x * 8) {
#pragma unroll
        for (int h = 0; h < 4; ++h) {
            const int c = h * 128 + lane * 2;
            const float2 a = *(const float2*)(OF + (size_t)r * 512 + c), bb = *(const float2*)(OB + (size_t)r * 512 + c);
            const float o0 = a.x + bb.x, o1 = a.y + bb.y;
            const float ss = wave_sum(o0 * o0 + o1 * o1);
            const float rstd = __builtin_amdgcn_rsqf(ss * (1.0f / 128.0f) + 1e-6f);
            const unsigned gz = *(const unsigned*)(z + (size_t)r * ZP + C_HG + c);
            *(unsigned*)(br + (size_t)r * BRW + 512 + c) = pk_bf16(o0 * rstd * g0 * siluf_(bf_lo(gz)), o1 * rstd * g1 * siluf_(bf_hi(gz)));
        }
    }
}
struct SchedMerge { int G, c; const char* br; const char* wb;
    __device__ __forceinline__ bool next(int i, pg8::Unit& u) const {
        const int tile = (i / 3) * G + c, bi = i % 3; if (tile >= (NTOK / 256) * 4) return false;
        const int pm = tile >> 2, pn = tile & 3;
        u.row0 = pm * 256; u.col0 = pn * 256; u.aux = bi;
        u.A = br + ((size_t)pm * 256 * BRW + bi * 512) * 2; u.B = wb + ((size_t)bi * 1024 + pn * 256) * 512 * 2; return true; } };
struct EpiMerge { const bf16_t* GT; bf16_t* YP; bf16_t* Y;
    __device__ __forceinline__ void operator()(const f32x4 (&acc)[2][2][4][2], const pg8::Unit& u, int wr, int wc, int fr, int fq) const {
        const int tidx = (wr * 4 + wc) * 64 + fq * 16 + fr, bi = u.aux, pm = u.row0 >> 8, pn = u.col0 >> 8;
        const bf16_t* gb = GT + ((size_t)pm * 12 + bi * 4 + pn) * 65536 + tidx * 8;
        bf16_t* yb = YP + ((size_t)pm * 4 + pn) * 65536 + tidx * 8;
#pragma unroll
        for (int ai = 0; ai < 2; ++ai)
#pragma unroll
            for (int bj = 0; bj < 2; ++bj) {
                uint4 g[4], p[4];
#pragma unroll
                for (int m = 0; m < 4; ++m) g[m] = *(const uint4*)(gb + ((ai * 2 + bj) * 4 + m) * 4096);
                if (bi != 0) {
#pragma unroll
                    for (int m = 0; m < 4; ++m) p[m] = *(const uint4*)(yb + ((ai * 2 + bj) * 4 + m) * 4096);
                } else {
#pragma unroll
                    for (int m = 0; m < 4; ++m) p[m] = make_uint4(0u, 0u, 0u, 0u);
                }
#pragma unroll
                for (int m = 0; m < 4; ++m) { const int k = ((ai * 2 + bj) * 4 + m) * 4096;
                    const f32x4 v0 = acc[ai][bj][m][0], v1 = acc[ai][bj][m][1];
                    const float t[8] = {bf_lo(p[m].x) + bf_lo(g[m].x) * v0[0], bf_hi(p[m].x) + bf_hi(g[m].x) * v0[1], bf_lo(p[m].y) + bf_lo(g[m].y) * v0[2], bf_hi(p[m].y) + bf_hi(g[m].y) * v0[3],
                                        bf_lo(p[m].z) + bf_lo(g[m].z) * v1[0], bf_hi(p[m].z) + bf_hi(g[m].z) * v1[1], bf_lo(p[m].w) + bf_lo(g[m].w) * v1[2], bf_hi(p[m].w) + bf_hi(g[m].w) * v1[3]};
                    if (bi != 2) { uint4 o; o.x = pk_bf16(t[0], t[1]); o.y = pk_bf16(t[2], t[3]); o.z = pk_bf16(t[4], t[5]); o.w = pk_bf16(t[6], t[7]); *(uint4*)(yb + k) = o; }
                    else { const int row = u.row0 + ai * 128 + wr * 64 + m * 16 + fr, col = u.col0 + bj * 128 + wc * 32 + 8 * fq;
                        uint4 o; o.x = pk_bf16(t[0], t[1]); o.y = pk_bf16(t[2], t[3]); o.z = pk_bf16(t[4], t[5]); o.w = pk_bf16(t[6], t[7]);
                        *(uint4*)(Y + (size_t)row * D + col) = o; }
                }
            }
    } };
__device__ __forceinline__ void ph_merge(const Params& P, LAS unsigned char* lds) {
    SchedMerge S{(int)gridDim.x, bid_(), (const char*)(P.ws + WS_BR), (const char*)(P.ws + WS_WBR)};
    EpiMerge E{(const bf16_t*)(P.ws + WS_GT), (bf16_t*)(P.ws + WS_H), (bf16_t*)(P.ws + WS_Y)};
    pg8::gemm_phase(lds, pg8::Gemm{512, BRW, 512}, S, E);
}
struct EpiResid { float* X; const float* mods; int l;
    __device__ __forceinline__ void operator()(const f32x4 (&acc)[2][2][4][2], const pg8::Unit& u, int wr, int wc, int fr, int fq) const {
        const float* gate = mods + ((size_t)l * 9 + row_modrow(u.row0)) * 6144 + 2 * 1024 + u.col0 + wc * 32 + 4 * fq;
        f32x4 gv[2][2];
#pragma unroll
        for (int bj = 0; bj < 2; ++bj)
#pragma unroll
            for (int n = 0; n < 2; ++n) gv[bj][n] = *(const f32x4*)(gate + bj * 128 + n * 16);
#pragma unroll
        for (int ai = 0; ai < 2; ++ai)
#pragma unroll
            for (int mh = 0; mh < 2; ++mh) {
                f32x4 xv[2][2][2];
#pragma unroll
                for (int mm = 0; mm < 2; ++mm)
#pragma unroll
                    for (int bj = 0; bj < 2; ++bj)
#pragma unroll
                        for (int n = 0; n < 2; ++n) xv[mm][bj][n] = *(const f32x4*)(X + (size_t)(u.row0 + ai * 128 + wr * 64 + (mh * 2 + mm) * 16 + fr) * D + u.col0 + bj * 128 + wc * 32 + 4 * fq + n * 16);
#pragma unroll
                for (int mm = 0; mm < 2; ++mm)
#pragma unroll
                    for (int bj = 0; bj < 2; ++bj)
#pragma unroll
                        for (int n = 0; n < 2; ++n) *(f32x4*)(X + (size_t)(u.row0 + ai * 128 + wr * 64 + (mh * 2 + mm) * 16 + fr) * D + u.col0 + bj * 128 + wc * 32 + 4 * fq + n * 16) = xv[mm][bj][n] + gv[bj][n] * acc[ai][bj][mh * 2 + mm][n];
            }
    } };
__device__ __forceinline__ void ph_wout(const Params& P, LAS unsigned char* lds, int l, bool dry = false) {
    pg8::SchedDense S{NTOK / 256, D / 256, (int)gridDim.x, bid_(), (const char*)(P.ws + WS_Y), (const char*)(P.ws + WS_WOUT), (size_t)256 * D * 2, (size_t)256 * D * 2};
    EpiResid E{(float*)(P.ws + (dry ? WS_END : WS_X)), (const float*)(P.ws + WS_MODS), l};
    pg8::gemm_phase(lds, pg8::Gemm{D, D, D}, S, E);
}
__device__ __forceinline__ void ph_norm2_route(const Params& P, LAS unsigned char* lds, int l, bool dry = false) {
    const int tid = tid_(), lane = tid & 63, wid = tid >> 6;
    LAS float* Wt = (LAS float*)lds;
    LAS int* lcnt = (LAS int*)(lds + 81920); LAS int* lbase = lcnt + 16; LAS int* rinfo = lbase + 16;
    LAS float* rw = (LAS float*)(rinfo + 128 * 4);
    for (int i = tid; i < 20 * 1024; i += NTHR) { const int j = i >> 10, c = i & 1023;
        Wt[i] = (j < 4) ? P.in[I_WGR][((size_t)l * 1024 + c) * 4 + j] : P.in[I_WER][((size_t)l * 1024 + c) * 16 + (j - 4)]; }
    if (tid < 16) lcnt[tid] = 0;
    __syncthreads();
    const float* xres = (const float*)(P.ws + WS_X);
    bf16_t* f = (bf16_t*)(P.ws + (dry ? WS_END : WS_H));
    const float* g = P.in[I_GFFN] + l * 1024;
    int* cnt = (int*)(P.ws + (dry ? 32768 : WS_CNT)) + l * 16;
    int* sel_e = (int*)(P.ws + (dry ? WS_END + 40000000 : WS_SELE)); float* sel_w = (float*)(P.ws + (dry ? WS_END + 41000000 : WS_SELW)); int* sel_p = (int*)(P.ws + (dry ? WS_END + 42000000 : WS_SELP));
    const int r0 = bid_() * 8, rstep = gridDim.x * 8;
    int it = 0;
    for (int r = r0 + wid; r < NTOK; r += rstep, ++it) {
        const float* mod = (const float*)(P.ws + WS_MODS) + ((size_t)l * 9 + row_modrow(r)) * 6144;
        float4 x[4], o[4];
#pragma unroll
        for (int i = 0; i < 4; ++i) x[i] = *(const float4*)(xres + (size_t)r * D + lane * 4 + 256 * i);
        norm_row(x, g, mod + 3 * 1024, mod + 4 * 1024, lane, o);
#pragma unroll
        for (int i = 0; i < 4; ++i) { uint2 u; u.x = pk_bf16(o[i].x, o[i].y); u.y = pk_bf16(o[i].z, o[i].w); *(uint2*)(f + (size_t)r * D + lane * 4 + 256 * i) = u; }
        float lg[20];
#pragma unroll
        for (int j = 0; j < 20; ++j) {
            float s = 0.f;
#pragma unroll
            for (int i = 0; i < 4; ++i) { const f32x4 w = *(const LAS f32x4*)(Wt + j * 1024 + lane * 4 + 256 * i); s += o[i].x * w[0] + o[i].y * w[1] + o[i].z * w[2] + o[i].w * w[3]; }
            lg[j] = wave_sum(s);
        }
        if (lane == 0) {
            float gl[4]; int gi = 0;
#pragma unroll
            for (int j = 0; j < 4; ++j) gl[j] = lg[j] + P.in[I_BGR][l * 4 + j];
            float gm = gl[0];
#pragma unroll
            for (int j = 1; j < 4; ++j) if (gl[j] > gm) { gm = gl[j]; gi = j; }
            float se = 0.f;
#pragma unroll
            for (int j = 0; j < 4; ++j) se += __expf(gl[j] - gm);
            const float pg = __builtin_amdgcn_rcpf(se);
            float el[4];
#pragma unroll
            for (int j = 0; j < 4; ++j) {
                float v = 0.f;
#pragma unroll
                for (int q = 0; q < 4; ++q) v = (gi == q) ? lg[4 + q * 4 + j] : v;
                el[j] = v + P.in[I_BER][l * 16 + gi * 4 + j];
            }
            int i0 = 0; float v0 = el[0];
#pragma unroll
            for (int j = 1; j < 4; ++j) if (el[j] > v0) { v0 = el[j]; i0 = j; }
            int i1 = -1; float v1 = -INFINITY;
#pragma unroll
            for (int j = 0; j < 4; ++j) if (j != i0 && el[j] > v1) { v1 = el[j]; i1 = j; }
            const float w0 = __builtin_amdgcn_rcpf(1.0f + __expf(v1 - v0)), w1 = 1.0f - w0;
            const int e0 = gi * 4 + i0, e1 = gi * 4 + i1;
            const int slot = it * 8 + wid;
            rinfo[slot * 4 + 0] = e0 | (e1 << 8);
            rinfo[slot * 4 + 1] = __hip_atomic_fetch_add(&lcnt[e0], 1, __ATOMIC_RELAXED, __HIP_MEMORY_SCOPE_WORKGROUP);
            rinfo[slot * 4 + 2] = __hip_atomic_fetch_add(&lcnt[e1], 1, __ATOMIC_RELAXED, __HIP_MEMORY_SCOPE_WORKGROUP);
            rw[slot * 2] = w0 * pg; rw[slot * 2 + 1] = w1 * pg;
        }
    }
    __syncthreads();
    if (tid < 16) lbase[tid] = atomicAdd(&cnt[tid], lcnt[tid]);
    __syncthreads();
    for (int slot = tid; slot < 128; slot += NTHR) {
        const int r = r0 + (slot & 7) + (slot >> 3) * rstep;
        if (r < NTOK) { const int ee = rinfo[slot * 4], e0 = ee & 255, e1 = ee >> 8;
            sel_e[r * 2] = e0; sel_e[r * 2 + 1] = e1;
            sel_w[r * 2] = rw[slot * 2]; sel_w[r * 2 + 1] = rw[slot * 2 + 1];
            sel_p[r * 2] = lbase[e0] + rinfo[slot * 4 + 1]; sel_p[r * 2 + 1] = lbase[e1] + rinfo[slot * 4 + 2]; }
    }
    __syncthreads();
}
__device__ __forceinline__ void moe_offsets(const int* cnt, int (&off)[17]) {
    int a = 0;
#pragma unroll
    for (int e = 0; e < 16; ++e) { off[e] = a; a += (cnt[e] + 255) & ~255; }
    off[16] = a;
}
__device__ __forceinline__ void ph_scatter(const Params& P, int l) {
    const int tid = tid_(), lane = tid & 63, wid = tid >> 6;
    const int* cnt = (const int*)(P.ws + WS_CNT) + l * 16;
    int off[17]; moe_offsets(cnt, off);
    const bf16_t* f = (const bf16_t*)(P.ws + WS_H); bf16_t* Fs = (bf16_t*)(P.ws + WS_FS);
    const int* sel_e = (const int*)(P.ws + WS_SELE); const int* sel_p = (const int*)(P.ws + WS_SELP); int* srow = (int*)(P.ws + WS_SROW);
    for (int r = bid_() * 8 + wid; r < NTOK; r += gridDim.x * 8) {
        const uint4 a = *(const uint4*)(f + (size_t)r * D + lane * 8), b = *(const uint4*)(f + (size_t)r * D + 512 + lane * 8);
#pragma unroll
        for (int k = 0; k < 2; ++k) {
            const int e = sel_e[r * 2 + k];
            int o = 0;
#pragma unroll
            for (int q = 0; q < 16; ++q) o = (e == q) ? off[q] : o;
            const int d = o + sel_p[r * 2 + k];
            *(uint4*)(Fs + (size_t)d * D + lane * 8) = a; *(uint4*)(Fs + (size_t)d * D + 512 + lane * 8) = b;
            if (lane == 0) srow[r * 2 + k] = d;
        }
    }
}
struct SchedMoe { int NM, G, c; int tfirst[16]; const char* A; const char* W; size_t tA, eW, tW;
    __device__ __forceinline__ bool next(int i, pg8::Unit& u) const {
        const int L = i * G + c; if (L >= NM * 4) return false;
        const int pm = L >> 2, pn = L & 3;
        int e = 0;
#pragma unroll
        for (int q = 1; q < 16; ++q) e += (pm >= tfirst[q]) ? 1 : 0;
        u.row0 = pm * 256; u.col0 = pn * 256; u.aux = e; u.A = A + (size_t)pm * tA; u.B = W + (size_t)e * eW + (size_t)pn * tW; return true; } };
struct FSwiglu { bf16_t* H;
    __device__ __forceinline__ void operator()(const pg8::Unit&, int row, int col, const f32x4& v0, const f32x4& v1) const {
        const int hc = ((col & ~31) >> 1) + (col & 15);
        uint2 a; a.x = pk_bf16(siluf_(v0[0]) * v1[0], siluf_(v0[1]) * v1[1]); a.y = pk_bf16(siluf_(v0[2]) * v1[2], siluf_(v0[3]) * v1[3]);
        *(uint2*)(H + (size_t)row * EH + hc) = a; } };
__device__ __forceinline__ void moe_sched(const Params& P, int l, SchedMoe& S) {
    const int* cnt = (const int*)(P.ws + WS_CNT) + l * 16;
    int a = 0;
#pragma unroll
    for (int e = 0; e < 16; ++e) { S.tfirst[e] = a; a += (cnt[e] + 255) >> 8; }
    S.NM = a; S.G = (int)gridDim.x; S.c = bid_();
}
__device__ __forceinline__ void ph_moe1(const Params& P, LAS unsigned char* lds, int l) {
    SchedMoe S; moe_sched(P, l, S);
    S.A = (const char*)(P.ws + WS_FS); S.W = (const char*)(P.ws + WS_WGU); S.tA = (size_t)256 * D * 2; S.eW = (size_t)1024 * 1024 * 2; S.tW = (size_t)256 * 1024 * 2;
    pg8::EpiPair<FSwiglu> E{{(bf16_t*)(P.ws + WS_HS)}};
    pg8::gemm_phase(lds, pg8::Gemm{1024, 1024, 1024}, S, E);
}
__device__ __forceinline__ void ph_moe2(const Params& P, LAS unsigned char* lds, int l) {
    SchedMoe S; moe_sched(P, l, S);
    S.A = (const char*)(P.ws + WS_HS); S.W = (const char*)(P.ws + WS_WDN); S.tA = (size_t)256 * EH * 2; S.eW = (size_t)1024 * 512 * 2; S.tW = (size_t)256 * 512 * 2;
    EpiStore16 E{(bf16_t*)(P.ws + WS_YS), D};
    pg8::gemm_phase(lds, pg8::Gemm{512, 512, 512}, S, E);
}
__device__ __forceinline__ void ph_combine(const Params& P, int l, bool dry = false) {
    const int tid = tid_(), lane = tid & 63, wid = tid >> 6;
    float* xres = (float*)(P.ws + WS_X);
    const bf16_t* Ys = (const bf16_t*)(P.ws + WS_YS);
    const float* sel_w = (const float*)(P.ws + WS_SELW); const int* srow = (const int*)(P.ws + WS_SROW);
    bf16_t* h = (bf16_t*)(P.ws + (dry ? WS_END : WS_H));
    for (int r = bid_() * 8 + wid; r < NTOK; r += gridDim.x * 8) {
        const float* gate = (const float*)(P.ws + WS_MODS) + ((size_t)l * 9 + row_modrow(r)) * 6144 + 5 * 1024;
        const float w0 = sel_w[r * 2], w1 = sel_w[r * 2 + 1];
        const bf16_t* y0 = Ys + (size_t)srow[r * 2] * D; const bf16_t* y1 = Ys + (size_t)srow[r * 2 + 1] * D;
        float4 x[4];
#pragma unroll
        for (int i = 0; i < 4; ++i) {
            const int c = lane * 4 + 256 * i;
            x[i] = *(const float4*)(xres + (size_t)r * D + c);
            const uint2 a = *(const uint2*)(y0 + c), b = *(const uint2*)(y1 + c);
            const float4 gv = *(const float4*)(gate + c);
            x[i].x += gv.x * (w0 * bf_lo(a.x) + w1 * bf_lo(b.x)); x[i].y += gv.y * (w0 * bf_hi(a.x) + w1 * bf_hi(b.x));
            x[i].z += gv.z * (w0 * bf_lo(a.y) + w1 * bf_lo(b.y)); x[i].w += gv.w * (w0 * bf_hi(a.y) + w1 * bf_hi(b.y));
        }
        if (l < DEPTH - 1) {
#pragma unroll
            for (int i = 0; i < 4; ++i) *(float4*)((dry ? (float*)(P.ws + WS_END) + (size_t)NTOK * 512 : xres) + (size_t)r * D + lane * 4 + 256 * i) = x[i];
            const float* mod = (const float*)(P.ws + WS_MODS) + ((size_t)(l + 1) * 9 + row_modrow(r)) * 6144;
            float4 o[4];
            norm_row(x, P.in[I_GMIX] + (l + 1) * 1024, mod, mod + 1024, lane, o);
#pragma unroll
            for (int i = 0; i < 4; ++i) { uint2 u; u.x = pk_bf16(o[i].x, o[i].y); u.y = pk_bf16(o[i].z, o[i].w); *(uint2*)(h + (size_t)r * D + lane * 4 + 256 * i) = u; }
        } else if (r < NLAT) {
            float ss = 0.f;
#pragma unroll
            for (int i = 0; i < 4; ++i) ss += x[i].x * x[i].x + x[i].y * x[i].y + x[i].z * x[i].z + x[i].w * x[i].w;
            ss = wave_sum(ss);
            const float rstd = __builtin_amdgcn_rsqf(ss * (1.0f / 1024.0f) + 1e-6f);
#pragma unroll
            for (int i = 0; i < 4; ++i) {
                const int c = lane * 4 + 256 * i;
                const float4 gv = *(const float4*)(P.in[I_GFIN] + c);
                float4 o; o.x = x[i].x * rstd * gv.x; o.y = x[i].y * rstd * gv.y; o.z = x[i].z * rstd * gv.z; o.w = x[i].w * rstd * gv.w;
                *(float4*)((dry ? (float*)(P.ws + WS_END) : P.out) + (size_t)r * D + c) = o;
            }
        }
    }
}

constexpr int NPH_LAYER = 12, NPH = 1 + DEPTH * NPH_LAYER;
#define CAS __attribute__((address_space(4)))
__device__ __forceinline__ const Params& kparams() { const CAS Params* k = (const CAS Params*)__builtin_amdgcn_kernarg_segment_ptr(); asm volatile("" : "+s"(k)); return *(const Params*)k; }
__global__ void __launch_bounds__(NTHR, 2) fwd(Params P_) {
    extern __shared__ __attribute__((aligned(16))) unsigned char lds_raw[];
    LAS unsigned char* lds = (LAS unsigned char*)lds_raw;
    volatile LAS unsigned* xbw = (volatile LAS unsigned*)(lds + LDS_BYTES - 16);
    if (threadIdx.x == 0) { xbw[0] = 0u; xbw[1] = 0u; xbw[2] = 0u; xbw[3] = 0u; }
    __syncthreads();
    const int lo = P_.ph_lo, hi = P_.ph_hi;
    XcdBarrier bar; bar.bar = (unsigned*)(P_.ws + WS_BAR); bar.x = 0; bar.st = xbw;
    if (hi - lo > 1) bar = xcd_barrier_post((unsigned*)(P_.ws + WS_BAR), xbw);
#ifndef PHMASK
#define PHMASK 0xFFFF
#endif
#define EN(j) ((PHMASK >> (j)) & 1)
#define IN(k) (lo <= (k) && (k) < hi)
#define SEAM(k) do { if (IN(k) && IN((k) + 1)) xcd_barrier(bar); } while (0)
    if (EN(12) && IN(0)) for (int rep = 0; rep < NREP(12); ++rep) { ph_prologue(kparams(), lds); }
    SEAM(0);
    for (int l = 0; l < DEPTH; ++l) {
        const int p0 = 1 + l * NPH_LAYER;
        if (l == 0) { if (EN(0) && IN(p0 + 0)) for (int rep = 0; rep < NREP(0); ++rep) { ph_wconv(kparams(), lds, l); ph_norm1(kparams(), l); }
        SEAM(p0 + 0); }
        if (EN(1) && IN(p0 + 1)) for (int rep = 0; rep < NREP(1); ++rep) ph_g1(kparams(), lds);
        SEAM(p0 + 1);
        if (EN(2) && IN(p0 + 2)) for (int rep = 0; rep < NREP(2); ++rep) { ph_prep(kparams(), l); ph_navt(kparams(), lds); }
        SEAM(p0 + 2);
        if (EN(3) && IN(p0 + 3)) { ph_mix(kparams(), lds, (char*)lds_raw, l);
            if (REPEAT_MASK & 0x8) { xcd_barrier(bar); ph_mix(kparams(), lds, (char*)lds_raw, l, 1, 0); }
            if (REPEAT_MASK & 0x2000) { xcd_barrier(bar); ph_mix(kparams(), lds, (char*)lds_raw, l, 1, 1); }
            if (REPEAT_MASK & 0x4000) { xcd_barrier(bar); ph_mix(kparams(), lds, (char*)lds_raw, l, 1, 2); }
            if (REPEAT_MASK & 0x8000) { xcd_barrier(bar); ph_mix(kparams(), lds, (char*)lds_raw, l, 1, 3); } }
        SEAM(p0 + 3);
        if (EN(4) && IN(p0 + 4)) for (int rep = 0; rep < NREP(4); ++rep) {
#if defined(DIAG) && DIAG == 5
            { const Params& Pq = kparams(); const int G_ = gridDim.x, c_ = bid_(), vcu_ = (c_ % 8) * (G_ / 8) + c_ / 8; for (int u = vcu_; u < 320; u += G_) na_unit(Pq, lds, l, u, (bf16_t*)(Pq.ws + WS_BR), BRW); __syncthreads(); }
#endif
            ph_readout(kparams(), l);
#if defined(DIAG) && (DIAG == 1 || DIAG == 4)
            ph_diag_cmp(kparams());
#endif
#if defined(DIAG) && DIAG == 3
            { const Params& Pq = kparams(); const uint4* d1 = (const uint4*)(Pq.ws + WS_END); bf16_t* brq = (bf16_t*)(Pq.ws + WS_BR);
              for (size_t i = (size_t)bid_() * NTHR + tid_(); i < (size_t)NTOK * 64; i += (size_t)gridDim.x * NTHR) { const size_t r = i >> 6; const int c8 = (int)(i & 63) * 8; *(uint4*)(brq + r * BRW + c8) = d1[i]; } }
#endif
        }
        SEAM(p0 + 4);
        if (EN(5) && IN(p0 + 5)) for (int rep = 0; rep < NREP(5); ++rep) ph_merge(kparams(), lds);
        SEAM(p0 + 5);
        if (EN(6) && IN(p0 + 6)) for (int rep = 0; rep < NREP(6); ++rep) ph_wout(kparams(), lds, l, rep > 0);
        SEAM(p0 + 6);
        if (EN(7) && IN(p0 + 7)) for (int rep = 0; rep < NREP(7); ++rep) ph_norm2_route(kparams(), lds, l, rep > 0);
        SEAM(p0 + 7);
        if (EN(8) && IN(p0 + 8)) for (int rep = 0; rep < NREP(8); ++rep) ph_scatter(kparams(), l);
        SEAM(p0 + 8);
        if (EN(9) && IN(p0 + 9)) for (int rep = 0; rep < NREP(9); ++rep) ph_moe1(kparams(), lds, l);
        SEAM(p0 + 9);
        if (EN(10) && IN(p0 + 10)) for (int rep = 0; rep < NREP(10); ++rep) ph_moe2(kparams(), lds, l);
        SEAM(p0 + 10);
        if (EN(11) && IN(p0 + 11)) for (int rep = 0; rep < NREP(11); ++rep) { ph_combine(kparams(), l, rep > 0); if (l + 1 < DEPTH) ph_wconv(kparams(), lds, l + 1); }
        if (l + 1 < DEPTH) { if (IN(p0 + 11) && IN(p0 + 13)) xcd_barrier(bar); }
    }
#if defined(DIAG) && (DIAG == 1 || DIAG == 4)
    xcd_barrier(bar); ph_diag_out(kparams());
#endif
#undef IN
#undef SEAM
}

#ifndef MK_PER_PHASE
#define MK_PER_PHASE 0
#endif
extern "C" void kernel_launch(void* const* d_in, const int* in_sizes, int n_in, void* d_out, int out_size, void* d_ws, size_t ws_size, hipStream_t stream) {
    static int grid = 0;
    if (grid == 0) {
        if (n_in != 24 || out_size != NLAT * D || ws_size < WS_END + (size_t)NTOK * 4096 + 4096) { fprintf(stderr, "kernel_launch: unexpected shapes (n_in %d out %d ws %zu need %zu)\n", n_in, out_size, ws_size, (size_t)WS_END); grid = -1; return; }
        int dev = 0, cus = 0, per_cu = 0;
        if (hipGetDevice(&dev) != hipSuccess || hipDeviceGetAttribute(&cus, hipDeviceAttributeMultiprocessorCount, dev) != hipSuccess) { grid = -1; return; }
        if (hipFuncSetAttribute((const void*)fwd, hipFuncAttributeMaxDynamicSharedMemorySize, LDS_BYTES) != hipSuccess) { fprintf(stderr, "kernel_launch: hipFuncSetAttribute failed\n"); grid = -1; return; }
        if (hipOccupancyMaxActiveBlocksPerMultiprocessor(&per_cu, (const void*)fwd, NTHR, LDS_BYTES) != hipSuccess || per_cu < 1) { fprintf(stderr, "kernel_launch: occupancy query says %d\n", per_cu); }
        (void)hipGetLastError();
        grid = cus;
    }
    if (grid < 0) return;
    (void)hipMemsetAsync(d_ws, 0, WS_ZERO_BYTES, stream);
    Params p{};
    for (int i = 0; i < 24; ++i) p.in[i] = (const float*)d_in[i];
    p.out = (float*)d_out; p.ws = (unsigned char*)d_ws;
#if MK_PER_PHASE
    for (int ph = 0; ph < NPH; ++ph) { p.ph_lo = ph; p.ph_hi = ph + 1; hipLaunchKernelGGL(fwd, dim3(grid), dim3(NTHR), LDS_BYTES, stream, p); }
#else
    p.ph_lo = 0; p.ph_hi = NPH; hipLaunchKernelGGL(fwd, dim3(grid), dim3(NTHR), LDS_BYTES, stream, p);
#endif
}
```

```cpp
#include <hip/hip_runtime.h>
#include <cstdio>
#include <cstdint>

#define LAS __attribute__((address_space(3)))
typedef unsigned short bf16_t;
typedef short bf16x8 __attribute__((ext_vector_type(8)));
typedef float f32x4 __attribute__((ext_vector_type(4)));
typedef unsigned u32x4 __attribute__((ext_vector_type(4)));

constexpr int D = 1024, NB = 8, SEQ = 2048, DEPTH = 4, CTXL = 256;
constexpr int NLAT = NB * SEQ, NCTX = NB * CTXL, NTOK = NLAT + NCTX;
constexpr int INC = 7936;
constexpr int ZP = 4864;
constexpr int C_NAQ = 0, C_NAK = 512, C_NAV = 1024, C_HQ = 1536, C_HFF = 2048, C_HFB = 2560, C_HI = 3072, C_HG = 3584,
              C_GQ = 4096, C_GK = 4608, C_GV = 4736, C_GATE = 4864;
constexpr int BRW = 1536;
constexpr int NEXP = 16, EH = 512;
constexpr int MPAD = 40960;
constexpr int NTHR = 512;
constexpr int LDS_BYTES = 147456;

constexpr size_t WS_BAR = 0;
constexpr size_t WS_CNT = 16384;
constexpr size_t WS_ZERO_BYTES = 65536;
constexpr size_t WS_MODS = 65536;
constexpr size_t WS_LB = WS_MODS + 884736;
constexpr size_t WS_ROPE = WS_LB + 16384;
constexpr size_t WS_SELE = WS_ROPE + 12288;
constexpr size_t WS_SELW = WS_SELE + 147456;
constexpr size_t WS_SELP = WS_SELW + 147456;
constexpr size_t WS_SROW = WS_SELP + 147456;
constexpr size_t WS_X = 2097152;
constexpr size_t WS_H = WS_X + (size_t)NTOK * D * 4;
constexpr size_t WS_Z = WS_H + (size_t)NTOK * D * 2;
constexpr size_t WS_GT = WS_Z + (size_t)NTOK * ZP * 2;
constexpr size_t WS_BR = WS_GT + (size_t)NTOK * 3072 * 2;
constexpr size_t WS_Y = WS_BR + (size_t)NTOK * BRW * 2;
constexpr size_t WS_QN = WS_Y + (size_t)NTOK * D * 2;
constexpr size_t WS_KN = WS_QN + (size_t)NTOK * 512 * 2;
constexpr size_t WS_VN = WS_KN + (size_t)NTOK * 128 * 2;
constexpr size_t WS_NAVT = WS_VN + (size_t)NTOK * 128 * 2;
constexpr size_t WS_WIN = WS_NAVT + (size_t)NTOK * 512 * 2;
constexpr size_t WS_WBR = WS_WIN + (size_t)INC * D * 2;
constexpr size_t WS_WOUT = WS_WBR + (size_t)3 * D * 512 * 2;
constexpr size_t WS_WGU = WS_WOUT + (size_t)D * D * 2;
constexpr size_t WS_WDN = WS_WGU + (size_t)NEXP * 1024 * 1024 * 2;
constexpr size_t WS_PG = WS_WDN + (size_t)NEXP * 1024 * 512 * 2;
constexpr size_t WS_END = WS_PG + (size_t)96 * 65536 * 2;
constexpr size_t WS_FS = WS_Z;
constexpr size_t WS_HS = WS_FS + (size_t)MPAD * 1024 * 2;
constexpr size_t WS_YS = WS_HS + (size_t)MPAD * 512 * 2;
static_assert(WS_YS + (size_t)MPAD * 1024 * 2 <= WS_BR, "moe alias");
static_assert(WS_SROW + 147456 <= WS_X, "ctl");

#define XB_TMO      128
#define XB_XCNT(j)  (256  + 64 * (j))
#define XB_XSUB(j)  (1280 + 64 * (j))
#define XB_XGEN(j)  (2304 + 64 * (j))
#define XB_TOP      3328
#define XB_TOPGEN   3392
#define XCD_BAR_WORDS 3456
#define XB_SPIN_CAP (1u << 22)
__device__ __forceinline__ unsigned xb_ld(unsigned* p)              { return __hip_atomic_load(p, __ATOMIC_RELAXED, __HIP_MEMORY_SCOPE_AGENT); }
__device__ __forceinline__ unsigned xb_add(unsigned* p, unsigned v) { return __hip_atomic_fetch_add(p, v, __ATOMIC_RELAXED, __HIP_MEMORY_SCOPE_AGENT); }
__device__ __forceinline__ unsigned xb_xcc_id() { return (unsigned)__builtin_amdgcn_s_getreg((3 << 11) | 20) & 0xFu; }
#define XB_SPIN(cond, bar) do { unsigned _sp = 0; while (cond) { __builtin_amdgcn_s_sleep(1); \
    if ((++_sp & 255u) == 0u) { if (xb_ld(&(bar)[XB_TMO])) break; if (_sp > XB_SPIN_CAP) { atomicAdd(&(bar)[XB_TMO], 1u); break; } } } } while (0)
struct XcdBarrier { unsigned* bar; unsigned x; volatile LAS unsigned* st; };
__device__ __forceinline__ XcdBarrier xcd_barrier_post(unsigned* bar, volatile LAS unsigned* st) {
    XcdBarrier b; b.bar = bar; b.x = xb_xcc_id(); b.st = st;
    if (threadIdx.x == 0) (void)xb_add(&bar[XB_XCNT(b.x)], 1u);
    return b;
}
__device__ __forceinline__ void xcd_barrier_complete(unsigned* bar, unsigned x, unsigned& nloc, unsigned& nx) {
    const unsigned G = gridDim.x * gridDim.y * gridDim.z;
    unsigned sum, cnt, mine, sp = 0u;
    for (;;) {
        sum = 0u; cnt = 0u; mine = 0u;
#pragma unroll
        for (unsigned j = 0; j < 16; ++j) { const unsigned c = xb_ld(&bar[XB_XCNT(j)]); sum += c; cnt += (c > 0u) ? 1u : 0u; mine = (j == x) ? c : mine; }
        if (sum == G) break;
        __builtin_amdgcn_s_sleep(1);
        if ((++sp & 255u) == 0u) { if (xb_ld(&bar[XB_TMO])) break; if (sp > XB_SPIN_CAP) { atomicAdd(&bar[XB_TMO], 1u); break; } }
    }
    nloc = mine > 0u ? mine : 1u; nx = cnt > 0u ? cnt : 1u;
}
__device__ __forceinline__ void xcd_barrier(const XcdBarrier& b) {
    asm volatile("s_waitcnt vmcnt(0)" ::: "memory");
    __syncthreads();
    if (threadIdx.x == 0) {
        unsigned* bar = b.bar;
        __builtin_amdgcn_s_waitcnt(0);
        unsigned nloc = b.st[0], nx = b.st[1];
        if (nloc == 0u) { xcd_barrier_complete(bar, b.x, nloc, nx); b.st[0] = nloc; b.st[1] = nx; }
        const unsigned old = xb_add(&bar[XB_XSUB(b.x)], 1u);
        const unsigned gen = old / nloc;
        if (old + 1u == (gen + 1u) * nloc) {
            __builtin_amdgcn_fence(__ATOMIC_RELEASE, "agent");
            asm volatile("s_waitcnt vmcnt(0)" ::: "memory");
            const unsigned og = xb_add(&bar[XB_TOP], 1u);
            const unsigned tg = og / nx;
            if (og + 1u == (tg + 1u) * nx) xb_add(&bar[XB_TOPGEN], 1u);
            else XB_SPIN(xb_ld(&bar[XB_TOPGEN]) == tg, bar);
            __builtin_amdgcn_fence(__ATOMIC_ACQUIRE, "agent");
            xb_add(&bar[XB_XGEN(b.x)], 1u);
            asm volatile("s_waitcnt vmcnt(0)" ::: "memory");
        } else {
            XB_SPIN(xb_ld(&bar[XB_XGEN(b.x)]) == gen, bar);
            __builtin_amdgcn_fence(__ATOMIC_ACQUIRE, "agent");
            asm volatile("s_waitcnt vmcnt(0)" ::: "memory");
        }
    }
    __syncthreads();
}

__device__ __forceinline__ float bf_lo(unsigned u) { return __uint_as_float(u << 16); }
__device__ __forceinline__ float bf_hi(unsigned u) { return __uint_as_float(u & 0xffff0000u); }
__device__ __forceinline__ float bf2f(bf16_t b) { return __uint_as_float(((unsigned)b) << 16); }
typedef float pkf32x2_t __attribute__((ext_vector_type(2))); typedef __bf16 pkbf16x2_t __attribute__((ext_vector_type(2)));
__device__ __forceinline__ unsigned pk_bf16(float lo, float hi) { pkf32x2_t v = {lo, hi}; pkbf16x2_t b = __builtin_convertvector(v, pkbf16x2_t); return __builtin_bit_cast(unsigned, b); }
__device__ __forceinline__ bf16x8 pack8(const float (&v)[8]) { u32x4 u = {pk_bf16(v[0], v[1]), pk_bf16(v[2], v[3]), pk_bf16(v[4], v[5]), pk_bf16(v[6], v[7])}; return __builtin_bit_cast(bf16x8, u); }
__device__ __forceinline__ float sigmoidf_(float x) { return __builtin_amdgcn_rcpf(1.0f + __expf(-x)); }
__device__ __forceinline__ float siluf_(float x) { return x * __builtin_amdgcn_rcpf(1.0f + __expf(-x)); }
__device__ __forceinline__ float dpp_f(float v, const int ctrl_sel) {
    const int x = __float_as_int(v);
    int r;
    if (ctrl_sel == 0) r = __builtin_amdgcn_update_dpp(0, x, 0xB1, 0xF, 0xF, true);
    else if (ctrl_sel == 1) r = __builtin_amdgcn_update_dpp(0, x, 0x4E, 0xF, 0xF, true);
    else if (ctrl_sel == 2) r = __builtin_amdgcn_update_dpp(0, x, 0x141, 0xF, 0xF, true);
    else r = __builtin_amdgcn_update_dpp(0, x, 0x140, 0xF, 0xF, true);
    return __int_as_float(r);
}
__device__ __forceinline__ float wave_sum(float v) {
    v += dpp_f(v, 0); v += dpp_f(v, 1); v += dpp_f(v, 2); v += dpp_f(v, 3);
    { auto rr = __builtin_amdgcn_permlane16_swap(__float_as_uint(v), __float_as_uint(v), false, false); v = __uint_as_float(rr[0]) + __uint_as_float(rr[1]); }
    { auto rr = __builtin_amdgcn_permlane32_swap(__float_as_uint(v), __float_as_uint(v), false, false); v = __uint_as_float(rr[0]) + __uint_as_float(rr[1]); }
    return v;
}

__device__ __forceinline__ int tid_() { int t = threadIdx.x; asm volatile("" : "+v"(t)); return t; }
__device__ __forceinline__ int bid_() { int t = blockIdx.x; asm volatile("" : "+s"(t)); return t; }
#ifndef REPEAT_MASK
#define REPEAT_MASK 0
#endif
#define NREP(j) (((REPEAT_MASK >> (j)) & 1) ? 2 : 1)
struct Params {
    const float* in[24];
    float* out;
    unsigned char* ws;
    int ph_lo, ph_hi;
};
enum { I_X = 0, I_C, I_CTX, I_CCTX, I_WADA, I_BADA, I_GMIX, I_GFFN, I_WIN, I_RPB, I_LBL, I_HGN, I_QNG, I_KNG, I_WBR, I_WOUT,
       I_WGR, I_BGR, I_WER, I_BER, I_WEG, I_WEU, I_WED, I_GFIN };

__device__ __forceinline__ void g128_kloop(f32x4 (&acc)[4][4], LAS unsigned char* lds, const bf16_t* A, int lda, const bf16_t* Bt, int ldb, int K) {
    const int tid = tid_(), wid = tid >> 6, lane = tid & 63, wr = wid >> 2, wc = wid & 3, fr = lane & 15, fq = lane >> 4;
    LAS unsigned char* SA = lds; LAS unsigned char* SB = lds + 8192;
    const int srow = tid >> 2, skc = (tid & 3) * 8;
    const bf16_t* ap = A + (size_t)srow * lda + skc;
    const bf16_t* bp0 = Bt + (size_t)srow * ldb + skc;
    const bf16_t* bp1 = Bt + (size_t)(srow + 128) * ldb + skc;
    for (int k0 = 0; k0 < K; k0 += 32) {
        const uint4 va = *(const uint4*)(ap + k0);
        const uint4 vb0 = *(const uint4*)(bp0 + k0);
        const uint4 vb1 = *(const uint4*)(bp1 + k0);
        __syncthreads();
        *(LAS u32x4*)(SA + tid * 16) = (u32x4){va.x, va.y, va.z, va.w};
        *(LAS u32x4*)(SB + tid * 16) = (u32x4){vb0.x, vb0.y, vb0.z, vb0.w};
        *(LAS u32x4*)(SB + 8192 + tid * 16) = (u32x4){vb1.x, vb1.y, vb1.z, vb1.w};
        __syncthreads();
        bf16x8 At[4], Bf[4];
#pragma unroll
        for (int m = 0; m < 4; ++m) At[m] = *(const LAS bf16x8*)(SA + ((wr * 64 + m * 16 + fr) * 32 + fq * 8) * 2);
#pragma unroll
        for (int n = 0; n < 4; ++n) Bf[n] = *(const LAS bf16x8*)(SB + ((wc * 64 + n * 16 + fr) * 32 + fq * 8) * 2);
#pragma unroll
        for (int m = 0; m < 4; ++m)
#pragma unroll
            for (int n = 0; n < 4; ++n) acc[m][n] = __builtin_amdgcn_mfma_f32_16x16x32_bf16(Bf[n], At[m], acc[m][n], 0, 0, 0);
    }
}
__device__ __forceinline__ void acc_zero(f32x4 (&acc)[4][4]) {
#pragma unroll
    for (int m = 0; m < 4; ++m)
#pragma unroll
        for (int n = 0; n < 4; ++n) acc[m][n] = (f32x4){0.f, 0.f, 0.f, 0.f};
}
template <class Epi>
__device__ __forceinline__ void g128_epilogue(const f32x4 (&acc)[4][4], int row0, int col0, const Epi& E) {
    const int tid = tid_(), wid = tid >> 6, lane = tid & 63, wr = wid >> 2, wc = wid & 3, fr = lane & 15, fq = lane >> 4;
#pragma unroll
    for (int m = 0; m < 4; ++m)
#pragma unroll
        for (int n = 0; n < 4; n += 2) E(row0 + wr * 64 + m * 16 + fr, col0 + wc * 64 + n * 16 + fq * 4, acc[m][n], acc[m][n + 1]);
}


namespace pg8 {
constexpr int BM = 256, BK = 64, HALF = 128, HTB = HALF * BK * 2, STAGE_BYTES = 8 * HTB;
__device__ __forceinline__ int lds_byte(int r, int c) { const int st = (r >> 4) * 2 + (c >> 5), rr = r & 15, cc = c & 31, ob = rr * 64 + cc * 2; return st * 1024 + (ob ^ (((ob >> 9) & 1) << 5)); }
__device__ __forceinline__ void stage_rc(int b, int& R, int& C) { const int st = b / 1024, sb = b % 1024, swz = sb ^ (((sb >> 9) & 1) << 5); R = (st >> 1) * 16 + swz / 64; C = (st & 1) * 32 + (swz % 64) / 2; }
struct Unit { int row0, col0, aux; const char* A; const char* B; };
struct Gemm { int K, lda, ldb; };
template <class Epi, class Sched>
__device__ __forceinline__ void gemm_phase(LAS unsigned char* lds, const Gemm g, const Sched& S, const Epi& E) {
    const int tid = tid_(), wid = __builtin_amdgcn_readfirstlane(tid >> 6), lane = tid & 63, wr = wid >> 2, wc = wid & 3, fr = lane & 15, fq = lane >> 4;
    const int K = g.K, nt = K / BK;
    unsigned voffA[2], voffB[2];
#pragma unroll
    for (int i = 0; i < 2; ++i) { int R, C; stage_rc(tid * 16 + i * 8192, R, C);
        voffA[i] = (unsigned)(R * g.lda + C) * 2u; voffB[i] = (unsigned)(R * g.ldb + C) * 2u; }
    const size_t kstep = (size_t)(BK * 2);
    const size_t hstepA = (size_t)HALF * g.lda * 2, hstepB = (size_t)HALF * g.ldb * 2;
    const unsigned ldsw = (unsigned)wid * 1024u;
    const int aoff = lds_byte(wr * 64 + fr, fq * 8), boff = lds_byte(wc * 32 + fr, fq * 8);
#define PG8_SA(b, h) (((b) * 2 + (h)) * HTB)
#define PG8_SB(b, h) ((4 + (b) * 2 + (h)) * HTB)
#define PG8_STAGE(bufoff, gbase, voff) do { _Pragma("unroll") for (int _i = 0; _i < 2; ++_i) \
        __builtin_amdgcn_global_load_lds((const unsigned*)((const char*)(gbase) + (voff)[_i]), (LAS unsigned*)(lds + (bufoff) + ldsw + _i * 8192), 16, 0, 0); } while (0)
#define PG8_LDA(dst, b, h) do { _Pragma("unroll") for (int m = 0; m < 4; ++m) _Pragma("unroll") for (int k = 0; k < 2; ++k) dst[m][k] = *(const LAS bf16x8*)(lds + PG8_SA(b, h) + aoff + m * 2048 + k * 1024); } while (0)
#define PG8_LDB(dst, b, h) do { _Pragma("unroll") for (int n = 0; n < 2; ++n) _Pragma("unroll") for (int k = 0; k < 2; ++k) dst[n][k] = *(const LAS bf16x8*)(lds + PG8_SB(b, h) + boff + n * 2048 + k * 1024); } while (0)
#define PG8_MMA(ai, bj, At, Bt) do { __builtin_amdgcn_s_setprio(1); _Pragma("unroll") for (int m = 0; m < 4; ++m) _Pragma("unroll") for (int n = 0; n < 2; ++n) _Pragma("unroll") for (int k = 0; k < 2; ++k) \
        acc[ai][bj][m][n] = __builtin_amdgcn_mfma_f32_16x16x32_bf16(Bt[n][k], At[m][k], acc[ai][bj][m][n], 0, 0, 0); __builtin_amdgcn_s_setprio(0); } while (0)
#define PG8_WAIT_V(n) asm volatile("s_waitcnt vmcnt(" #n ")" ::: "memory")
#define PG8_WAIT_L(n) asm volatile("s_waitcnt lgkmcnt(" #n ")" ::: "memory")
#define PG8_BAR __builtin_amdgcn_s_barrier()
#define PG8_SCHED __builtin_amdgcn_sched_barrier(0)
    Unit cur, nxt; int ui = 0;
    if (!S.next(0, cur)) return;
    f32x4 acc[2][2][4][2];
#pragma unroll
    for (int a = 0; a < 2; ++a)
#pragma unroll
        for (int b = 0; b < 2; ++b)
#pragma unroll
            for (int m = 0; m < 4; ++m)
#pragma unroll
                for (int n = 0; n < 2; ++n) acc[a][b][m][n] = (f32x4){0.f, 0.f, 0.f, 0.f};
    bf16x8 At[4][2], B0[2][2], B1[2][2];
    const char* cA = cur.A; const char* cB = cur.B;
    PG8_STAGE(PG8_SB(0, 0), cB, voffB); PG8_STAGE(PG8_SA(0, 0), cA, voffA); PG8_STAGE(PG8_SB(0, 1), cB + hstepB, voffB); PG8_STAGE(PG8_SA(0, 1), cA + hstepA, voffA);
    if (wr == 1) PG8_BAR;
    PG8_WAIT_V(4); PG8_BAR;
    PG8_STAGE(PG8_SB(1, 0), cB + kstep, voffB); PG8_STAGE(PG8_SA(1, 0), cA + kstep, voffA); PG8_STAGE(PG8_SB(1, 1), cB + hstepB + kstep, voffB);
    PG8_WAIT_V(6); PG8_BAR;
    for (;;) {
        const bool has_next = S.next(ui + 1, nxt);
        const char* nA = has_next ? nxt.A : cA; const char* nB = has_next ? nxt.B : cB;
        for (int t = 0; t < nt; t += 2) {
            const bool last = (t == nt - 2);
            const char* a1 = cA + (size_t)(t + 1) * kstep;
            const char* a2 = last ? nA : cA + (size_t)(t + 2) * kstep; const char* b2 = last ? nB : cB + (size_t)(t + 2) * kstep;
            const char* a3 = a2 + kstep; const char* b3 = b2 + kstep;
            PG8_LDB(B0, 0, 0); PG8_SCHED; PG8_LDA(At, 0, 0); PG8_STAGE(PG8_SA(1, 1), a1 + hstepA, voffA);
            PG8_WAIT_L(8); PG8_BAR; PG8_WAIT_L(0); PG8_MMA(0, 0, At, B0); PG8_BAR; PG8_SCHED;
            PG8_LDB(B1, 0, 1); PG8_STAGE(PG8_SB(0, 0), b2, voffB);
            PG8_BAR; PG8_WAIT_L(0); PG8_MMA(0, 1, At, B1); PG8_BAR;
            PG8_LDA(At, 0, 1); PG8_STAGE(PG8_SA(0, 0), a2, voffA);
            PG8_BAR; PG8_WAIT_L(0); PG8_MMA(1, 0, At, B0); PG8_BAR; PG8_SCHED;
            PG8_STAGE(PG8_SB(0, 1), b2 + hstepB, voffB);
            PG8_WAIT_V(6); PG8_BAR; PG8_MMA(1, 1, At, B1); PG8_BAR;
            PG8_LDB(B0, 1, 0); PG8_SCHED; PG8_LDA(At, 1, 0); PG8_STAGE(PG8_SA(0, 1), a2 + hstepA, voffA);
            PG8_WAIT_L(8); PG8_BAR; PG8_WAIT_L(0); PG8_MMA(0, 0, At, B0); PG8_BAR; PG8_SCHED;
            PG8_LDB(B1, 1, 1); PG8_STAGE(PG8_SB(1, 0), b3, voffB);
            PG8_BAR; PG8_WAIT_L(0); PG8_MMA(0, 1, At, B1); PG8_BAR;
            PG8_LDA(At, 1, 1); PG8_STAGE(PG8_SA(1, 0), a3, voffA);
            PG8_BAR; PG8_WAIT_L(0); PG8_MMA(1, 0, At, B0); PG8_BAR; PG8_SCHED;
            PG8_STAGE(PG8_SB(1, 1), b3 + hstepB, voffB);
            PG8_WAIT_V(6); PG8_BAR; PG8_MMA(1, 1, At, B1); PG8_BAR;
        }
        E(acc, cur, wr, wc, fr, fq);
        if (!has_next) break;
#pragma unroll
        for (int a = 0; a < 2; ++a)
#pragma unroll
            for (int b = 0; b < 2; ++b)
#pragma unroll
                for (int m = 0; m < 4; ++m)
#pragma unroll
                    for (int n = 0; n < 2; ++n) acc[a][b][m][n] = (f32x4){0.f, 0.f, 0.f, 0.f};
        cur = nxt; cA = nA; cB = nB; ++ui;
    }
    PG8_WAIT_V(0);
    if (wr == 0) PG8_BAR;
    PG8_BAR;
#undef PG8_SA
#undef PG8_SB
#undef PG8_STAGE
#undef PG8_LDA
#undef PG8_LDB
#undef PG8_MMA
#undef PG8_WAIT_V
#undef PG8_WAIT_L
#undef PG8_BAR
#undef PG8_SCHED
}
template <class F> struct EpiPair { F f;
    __device__ __forceinline__ void operator()(const f32x4 (&acc)[2][2][4][2], const Unit& u, int wr, int wc, int fr, int fq) const {
#pragma unroll
        for (int ai = 0; ai < 2; ++ai)
#pragma unroll
            for (int m = 0; m < 4; ++m)
#pragma unroll
                for (int bj = 0; bj < 2; ++bj) f(u, u.row0 + ai * HALF + wr * 64 + m * 16 + fr, u.col0 + bj * HALF + wc * 32 + 4 * fq, acc[ai][bj][m][0], acc[ai][bj][m][1]);
    } };
struct SchedDense { int nM, nN, G, c; const char* A; const char* B; size_t tA, tB;
    __device__ __forceinline__ bool next(int i, Unit& u) const {
        const int nwg = nM * nN; const long L = (long)i * G + c; if (L >= nwg) return false;
        int wgid = (int)L; { const int q = nwg / 8, r = nwg % 8, xcd = wgid % 8, off = wgid / 8; wgid = (xcd < r ? xcd * (q + 1) : r * (q + 1) + (xcd - r) * q) + off; }
        const int nig = 8 * nN, gid = wgid / nig, fm = gid * 8, gsz = (nM - fm) < 8 ? (nM - fm) : 8;
        const int pm = fm + ((wgid % nig) % gsz), pn = (wgid % nig) / gsz;
        u.row0 = pm * 256; u.col0 = pn * 256; u.aux = 0; u.A = A + (size_t)pm * tA; u.B = B + (size_t)pn * tB; return true; } };
}


namespace gqa {
using f32x16 = __attribute__((ext_vector_type(16))) float;
using s16x4 = __attribute__((ext_vector_type(4))) short;
constexpr int QP = 512, KVP = 128, OP = BRW;
constexpr int NW = 8, QBLK = 32, KVBLK = 64;
__device__ __forceinline__ int crow(int r, int hi) { return (r & 3) + 8 * (r >> 2) + 4 * hi; }
#define SBAR() __builtin_amdgcn_sched_barrier(0)
constexpr int NSLOT = 3, SLOTB = 8192;
constexpr int LDS_K = 0, LDS_V = NSLOT * SLOTB, LDS_WS = 2 * NSLOT * SLOTB, LDS_OST = LDS_WS + NW * 64 * 4, LDS_BYTES_ = LDS_OST + NW * 4096;
__device__ __forceinline__ void glds16(const void* gsrc, unsigned lds_dst) { unsigned keep;
  asm volatile("s_mov_b32 %0, m0\n\ts_mov_b32 m0, %2\n\ts_nop 0\n\tglobal_load_lds_dwordx4 %1, off\n\ts_mov_b32 m0, %0" : "=&s"(keep) : "v"(gsrc), "s"(lds_dst) : "memory"); }
__device__ __forceinline__ float max3f(float a, float b, float c) { float r; asm("v_max3_f32 %0, %1, %2, %3" : "=v"(r) : "v"(a), "v"(b), "v"(c)); return r; }
__device__ __forceinline__ float max2f(float a, float b) { float r; asm("v_max_f32_e32 %0, %1, %2" : "=v"(r) : "v"(a), "v"(b)); return r; }
__device__ __forceinline__ float fadd_s(float a, float b) { float r; asm("v_add_f32_e32 %0, %1, %2" : "=v"(r) : "v"(a), "v"(b)); return r; }
__device__ __forceinline__ float fsub_s(float a, float b) { float r; asm("v_sub_f32_e32 %0, %1, %2" : "=v"(r) : "v"(a), "v"(b)); return r; }
typedef float f32x2_t __attribute__((ext_vector_type(2))); typedef __bf16 bf16x2_t __attribute__((ext_vector_type(2)));
__device__ __forceinline__ unsigned cvtpk_s(float lo, float hi) { f32x2_t v = {lo, hi}; bf16x2_t b = __builtin_convertvector(v, bf16x2_t); return __builtin_bit_cast(unsigned, b); }
#define WAIT_BAR(N) asm volatile("s_waitcnt vmcnt(" #N ") lgkmcnt(0)\n\ts_barrier" ::: "memory")
__device__ __forceinline__ void qkt(f32x16& p0, f32x16& p1, const char* Kslot, const bf16x8* qr, const f32x16& negm, int r32, int hi) {
  const char* kb = Kslot + hi * 1024 + r32 * 16;
  #pragma unroll
  for (int d0 = 0; d0 < 4; ++d0) {
    const bf16x8 b0 = *reinterpret_cast<const bf16x8*>(kb + d0 * 2048);
    const bf16x8 b1 = *reinterpret_cast<const bf16x8*>(kb + d0 * 2048 + 512);
    if (d0 == 0) { p0 = __builtin_amdgcn_mfma_f32_32x32x16_bf16(b0, qr[0], negm, 0, 0, 0); p1 = __builtin_amdgcn_mfma_f32_32x32x16_bf16(b1, qr[0], negm, 0, 0, 0); }
    else { p0 = __builtin_amdgcn_mfma_f32_32x32x16_bf16(b0, qr[d0], p0, 0, 0, 0); p1 = __builtin_amdgcn_mfma_f32_32x32x16_bf16(b1, qr[d0], p1, 0, 0, 0); } }
}
typedef __attribute__((address_space(3))) const char* lds_cptr;
typedef short v4i16_t __attribute__((ext_vector_type(4)));
__device__ __forceinline__ void kload8(bf16x8* kf, lds_cptr kp) {
  kf[0] = *(const LAS bf16x8*)(kp);        kf[1] = *(const LAS bf16x8*)(kp + 512);
  kf[2] = *(const LAS bf16x8*)(kp + 2048); kf[3] = *(const LAS bf16x8*)(kp + 2560);
  kf[4] = *(const LAS bf16x8*)(kp + 4096); kf[5] = *(const LAS bf16x8*)(kp + 4608);
  kf[6] = *(const LAS bf16x8*)(kp + 6144); kf[7] = *(const LAS bf16x8*)(kp + 6656);
}
__device__ __forceinline__ void kload2(bf16x8* kf, lds_cptr kp, int j) { kf[2 * j] = *(const LAS bf16x8*)(kp + j * 2048); kf[2 * j + 1] = *(const LAS bf16x8*)(kp + j * 2048 + 512); }
__device__ __forceinline__ s16x4 vtr(lds_cptr p) { return __builtin_bit_cast(s16x4, __builtin_amdgcn_ds_read_tr16_b64_v4i16((LAS v4i16_t*)p)); }
__device__ __forceinline__ float rowmax(const f32x16& p0, const f32x16& p1) {
  float a = max3f(p0[0], p0[1], p1[0]), b = max3f(p0[2], p0[3], p1[1]); a = max3f(a, p1[2], p1[3]);
  #pragma unroll
  for (int r = 4; r < 16; r += 4) { a = max3f(a, p0[r], p0[r + 1]); b = max3f(b, p0[r + 2], p0[r + 3]); a = max3f(a, p1[r], p1[r + 1]); b = max3f(b, p1[r + 2], p1[r + 3]); }
  const float m = max2f(a, b);
  auto rr = __builtin_amdgcn_permlane32_swap(__float_as_uint(m), __float_as_uint(m), false, false);
  return max2f(__uint_as_float(rr[0]), __uint_as_float(rr[1]));
}
__device__ __forceinline__ void pv(f32x16* o, int vb, bf16x8 pa0, bf16x8 pa1, bf16x8 pa2, bf16x8 pa3) {
  #pragma unroll
  for (int d0 = 0; d0 < 2; ++d0) { s16x4 lo[4], hi[4];
    #pragma unroll
    for (int ks = 0; ks < 4; ++ks) {
      asm volatile("ds_read_b64_tr_b16 %0,%1 offset:%c2" : "=&v"(lo[ks]) : "v"(vb), "i"(d0 * 4096 + ks * 1024) : "memory");
      asm volatile("ds_read_b64_tr_b16 %0,%1 offset:%c2" : "=&v"(hi[ks]) : "v"(vb), "i"(d0 * 4096 + ks * 1024 + 512) : "memory"); }
    asm volatile("s_waitcnt lgkmcnt(0)" ::: "memory"); SBAR();
    #define PK(k) (bf16x8){lo[k][0], lo[k][1], lo[k][2], lo[k][3], hi[k][0], hi[k][1], hi[k][2], hi[k][3]}
    o[d0] = __builtin_amdgcn_mfma_f32_32x32x16_bf16(pa0, PK(0), o[d0], 0, 0, 0);
    o[d0] = __builtin_amdgcn_mfma_f32_32x32x16_bf16(pa1, PK(1), o[d0], 0, 0, 0);
    o[d0] = __builtin_amdgcn_mfma_f32_32x32x16_bf16(pa2, PK(2), o[d0], 0, 0, 0);
    o[d0] = __builtin_amdgcn_mfma_f32_32x32x16_bf16(pa3, PK(3), o[d0], 0, 0, 0);
    #undef PK
  }
}
template <int THRL> __device__ __forceinline__ void attn_unit(const bf16_t* Qu, const bf16_t* __restrict__ Kh, const bf16_t* __restrict__ Vh, bf16_t* Ou, const int NT, char* shm) {
  const int tid = tid_(), lane = tid & 63, r32 = lane & 31, hi = lane >> 5; const int wid = __builtin_amdgcn_readfirstlane(tid >> 6);
  const bf16_t* Qw = Qu + (long)wid * QBLK * QP;
  const unsigned lds0 = (unsigned)(uintptr_t)shm;
  float* wsf = (float*)(shm + LDS_WS) + wid * 64;
  const bf16_t* ksrc = Kh + (long)lane * KVP + wid * 8;
  const bf16_t* vsrc = Vh + (long)(16 * (wid & 3) + (lane >> 2)) * KVP + (wid >> 2) * 32 + (lane & 3) * 8;
  const unsigned kdst = lds0 + LDS_K + wid * 1024, vdst = lds0 + LDS_V + wid * 1024;
  #define DMA_K(t, slot) glds16(ksrc + (long)(t) * KVBLK * KVP, (unsigned)__builtin_amdgcn_readfirstlane(kdst + (slot)))
  #define DMA_V(t, slot) glds16(vsrc + (long)(t) * KVBLK * KVP, (unsigned)__builtin_amdgcn_readfirstlane(vdst + (slot)))
  const int vb0 = (int)(lds0 + LDS_V) + ((lane >> 4) & 1) * 32 + (lane & 3) * 8 + (4 * hi + ((lane & 15) >> 2)) * 64;
  const char* Kbase = shm + LDS_K; bf16x8 kf[8];
  const lds_cptr shm3 = (lds_cptr)shm; const lds_cptr kp0 = shm3 + LDS_K + hi * 1024 + r32 * 16; const lds_cptr vp0 = shm3 + LDS_V + ((lane >> 4) & 1) * 32 + (lane & 3) * 8 + (4 * hi + ((lane & 15) >> 2)) * 64;
  DMA_K(0, 0); DMA_V(0, 0); DMA_K(1, SLOTB);
  bf16x8 qr[4];
  #pragma unroll
  for (int d0 = 0; d0 < 4; ++d0) qr[d0] = *reinterpret_cast<const bf16x8*>(&Qw[(long)r32 * QP + d0 * 16 + hi * 8]);
  float mhat = 0.f, l_reg = 0.f; f32x16 o[2]; o[0] = f32x16{}; o[1] = f32x16{}; f32x16 negm = f32x16{}; asm volatile("" : "+v"(negm));
  bool resc = false;
  #define START(P0, P1) do { const float rm = rowmax(P0, P1); resc = false; \
    { const float dl = rm; mhat = fadd_s(mhat, dl); \
      _Pragma("unroll") for (int r = 0; r < 16; ++r) { P0[r] = fsub_s(P0[r], dl); P1[r] = fsub_s(P1[r], dl); } \
      _Pragma("unroll") for (int r = 0; r < 16; ++r) negm[r] = -mhat; asm volatile("" : "+v"(negm)); } \
    _Pragma("unroll") for (int r = 0; r < 16; ++r) P0[r] = __builtin_amdgcn_exp2f(P0[r]); } while (0)
  #define RESC() do { if (resc) { asm volatile("s_waitcnt lgkmcnt(0)" ::: "memory"); \
      _Pragma("unroll") for (int d_ = 0; d_ < 2; ++d_) _Pragma("unroll") for (int r = 0; r < 16; ++r) o[d_][r] *= wsf[crow(r, hi)]; } } while (0)
  f32x16 pA0, pA1, pB0, pB1;
  int sl_prev = 0, sl_cur = 0, sl_next = SLOTB;
  #define ROT() do { sl_prev = sl_cur; sl_cur = sl_next; sl_next = (sl_next == (NSLOT - 1) * SLOTB) ? 0 : sl_next + SLOTB; } while (0)
  DMA_K(2, 2 * SLOTB);
  WAIT_BAR(3);
  qkt(pA0, pA1, Kbase, qr, negm, r32, hi); asm volatile("s_nop 15\n\ts_nop 7" : "+v"(pA0), "+v"(pA1));
  START(pA0, pA1);
  _Pragma("unroll") for (int r = 0; r < 16; ++r) pA1[r] = __builtin_amdgcn_exp2f(pA1[r]);
  WAIT_BAR(0);
  DMA_K(3, 0); DMA_V(1, SLOTB);
  ROT();
  kload8(kf, kp0 + sl_cur);
  WAIT_BAR(2);
  s16x4 vlo[8], vhi[8]; u32x4 pw0, pw1, pw2, pw3;
  #define PKW(P, B) cvtpk_s(P[B], P[B + 1])
  #define PAF(k) __builtin_bit_cast(bf16x8, pw##k)
  #define VFR(i) (bf16x8){vlo[i][0], vlo[i][1], vlo[i][2], vlo[i][3], vhi[i][0], vhi[i][1], vhi[i][2], vhi[i][3]}
  #define PIN(x) asm volatile("" : "+v"(x))
  #define MX3(a, b, c) __builtin_fmaxf(__builtin_fmaxf((a), (b)), (c))
  #define GAPA(MF, A0, A1, A2, A3, W0, W1, PW) do { MF; sacc += A0; sacc += A1; sacc += A2; sacc += A3; PIN(sacc); W0; W1; PIN(PW); SBAR(); } while (0)
  #define EX(v) __builtin_amdgcn_exp2f(v)
  #define GAPB(MF, X, B) do { MF; X[B] = EX(X[B]); X[B + 1] = EX(X[B + 1]); X[B + 2] = EX(X[B + 2]); X[B + 3] = EX(X[B + 3]); PIN(X); SBAR(); } while (0)
  #define VRD(i) do { vlo[i] = vtr(vp_ + (((i) >> 2) * 4096 + ((i) & 3) * 1024)); vhi[i] = vtr(vp_ + (((i) >> 2) * 4096 + ((i) & 3) * 1024 + 512)); } while (0)
  #define KRD(G, j) do { if (G) { kload2(kf, kp0 + sl_next, j); SBAR(); } } while (0)
  #define STEP(C0, C1, P0, P1, t, GK, GV, GL) do { SBAR(); \
    const lds_cptr vp_ = vp0 + sl_prev; \
    VRD(0); SBAR(); float sacc = (P0[0] + P0[1]); \
    GAPA(C0 = __builtin_amdgcn_mfma_f32_32x32x16_bf16(kf[0], qr[0], negm, 0, 0, 0), P0[2], P0[3], P0[4], P0[5],     pw0[0] = PKW(P0, 0), pw0[1] = PKW(P0, 2), pw0); \
    VRD(4); SBAR(); GAPA(C1 = __builtin_amdgcn_mfma_f32_32x32x16_bf16(kf[1], qr[0], negm, 0, 0, 0), P0[6], P0[7], P0[8], P0[9],     pw0[2] = PKW(P0, 4), pw0[3] = PKW(P0, 6), pw0); \
    VRD(1); SBAR(); GAPA(C0 = __builtin_amdgcn_mfma_f32_32x32x16_bf16(kf[2], qr[1], C0, 0, 0, 0),   P0[10], P0[11], P0[12], P0[13], pw1[0] = PKW(P0, 8), pw1[1] = PKW(P0, 10), pw1); \
    VRD(5); SBAR(); GAPA(C1 = __builtin_amdgcn_mfma_f32_32x32x16_bf16(kf[3], qr[1], C1, 0, 0, 0),   P0[14], P0[15], P1[0], P1[1],   pw1[2] = PKW(P0, 12), pw1[3] = PKW(P0, 14), pw1); \
    VRD(2); SBAR(); GAPA(C0 = __builtin_amdgcn_mfma_f32_32x32x16_bf16(kf[4], qr[2], C0, 0, 0, 0),   P1[2], P1[3], P1[4], P1[5],     pw2[0] = PKW(P1, 0), pw2[1] = PKW(P1, 2), pw2); \
    VRD(6); SBAR(); GAPA(C1 = __builtin_amdgcn_mfma_f32_32x32x16_bf16(kf[5], qr[2], C1, 0, 0, 0),   P1[6], P1[7], P1[8], P1[9],     pw2[2] = PKW(P1, 4), pw2[3] = PKW(P1, 6), pw2); \
    VRD(3); SBAR(); GAPA(C0 = __builtin_amdgcn_mfma_f32_32x32x16_bf16(kf[6], qr[3], C0, 0, 0, 0),   P1[10], P1[11], P1[12], P1[13], pw3[0] = PKW(P1, 8), pw3[1] = PKW(P1, 10), pw3); \
    VRD(7); SBAR(); GAPA(C1 = __builtin_amdgcn_mfma_f32_32x32x16_bf16(kf[7], qr[3], C1, 0, 0, 0),   P1[14], P1[15], 0.f, 0.f,       pw3[2] = PKW(P1, 12), pw3[3] = PKW(P1, 14), pw3); \
    l_reg += sacc; \
    if (GK) { DMA_K((t) + 3, sl_cur); } if (GV) { DMA_V((t) + 1, sl_next); } \
    { float a = MX3(C0[0], C0[1], C1[0]), b = MX3(C0[2], C0[3], C1[1]); a = MX3(a, C1[2], C1[3]); \
      _Pragma("unroll") for (int r = 4; r < 16; r += 4) { a = MX3(a, C0[r], C0[r + 1]); b = MX3(b, C0[r + 2], C0[r + 3]); a = MX3(a, C1[r], C1[r + 1]); b = MX3(b, C1[r + 2], C1[r + 3]); } \
      float rm = __builtin_fmaxf(a, b); { auto rr = __builtin_amdgcn_permlane32_swap(__float_as_uint(rm), __float_as_uint(rm), false, false); rm = __builtin_fmaxf(__uint_as_float(rr[0]), __uint_as_float(rr[1])); } \
      resc = false; \
      if (__builtin_expect(__any(rm > (float)THRL), 0)) { const float dl = __builtin_fmaxf(rm, 0.f); mhat += dl; \
        _Pragma("unroll") for (int r = 0; r < 16; ++r) { C0[r] -= dl; C1[r] -= dl; } \
        _Pragma("unroll") for (int r = 0; r < 16; ++r) negm[r] = -mhat; asm volatile("" : "+v"(negm)); \
        const float f = __builtin_amdgcn_exp2f(-dl); l_reg *= f; if (hi == 0) wsf[r32] = f; resc = true; } } \
    SBAR(); \
    GAPB(o[0] = __builtin_amdgcn_mfma_f32_32x32x16_bf16(PAF(0), VFR(0), o[0], 0, 0, 0), C0, 0); \
    GAPB(o[1] = __builtin_amdgcn_mfma_f32_32x32x16_bf16(PAF(0), VFR(4), o[1], 0, 0, 0), C0, 4); \
    KRD(GL, 0); GAPB(o[0] = __builtin_amdgcn_mfma_f32_32x32x16_bf16(PAF(1), VFR(1), o[0], 0, 0, 0), C0, 8); \
    KRD(GL, 1); GAPB(o[1] = __builtin_amdgcn_mfma_f32_32x32x16_bf16(PAF(1), VFR(5), o[1], 0, 0, 0), C0, 12); \
    KRD(GL, 2); GAPB(o[0] = __builtin_amdgcn_mfma_f32_32x32x16_bf16(PAF(2), VFR(2), o[0], 0, 0, 0), C1, 0); \
    KRD(GL, 3); GAPB(o[1] = __builtin_amdgcn_mfma_f32_32x32x16_bf16(PAF(2), VFR(6), o[1], 0, 0, 0), C1, 4); \
    GAPB(o[0] = __builtin_amdgcn_mfma_f32_32x32x16_bf16(PAF(3), VFR(3), o[0], 0, 0, 0), C1, 8); \
    GAPB(o[1] = __builtin_amdgcn_mfma_f32_32x32x16_bf16(PAF(3), VFR(7), o[1], 0, 0, 0), C1, 12); \
    } while (0)
  int t = 1;
  for (; t + 5 < NT; t += 2) {
    STEP(pB0, pB1, pA0, pA1, t, true, true, true);     WAIT_BAR(2); RESC(); ROT();
    STEP(pA0, pA1, pB0, pB1, t + 1, true, true, true); WAIT_BAR(2); RESC(); ROT();
  }
  #define ENDW(tt) do { if ((tt) + 3 < NT) { WAIT_BAR(2); } else if ((tt) + 2 < NT) { WAIT_BAR(1); } else { WAIT_BAR(0); } } while (0)
  for (; t + 1 < NT; t += 2) {
    STEP(pB0, pB1, pA0, pA1, t, (t + 3 < NT), (t + 1 < NT), (t + 1 < NT));         ENDW(t);     RESC(); ROT();
    STEP(pA0, pA1, pB0, pB1, t + 1, (t + 4 < NT), (t + 2 < NT), (t + 2 < NT));     ENDW(t + 1); RESC(); ROT();
  }
  STEP(pB0, pB1, pA0, pA1, NT - 1, false, false, false); RESC();
  { float sacc = pB0[0] + pB0[1]; _Pragma("unroll") for (int r = 2; r < 16; ++r) sacc += pB0[r]; _Pragma("unroll") for (int r = 0; r < 16; ++r) sacc += pB1[r]; l_reg += sacc;
    pw0 = (u32x4){PKW(pB0, 0), PKW(pB0, 2), PKW(pB0, 4), PKW(pB0, 6)}; pw1 = (u32x4){PKW(pB0, 8), PKW(pB0, 10), PKW(pB0, 12), PKW(pB0, 14)}; pw2 = (u32x4){PKW(pB1, 0), PKW(pB1, 2), PKW(pB1, 4), PKW(pB1, 6)}; pw3 = (u32x4){PKW(pB1, 8), PKW(pB1, 10), PKW(pB1, 12), PKW(pB1, 14)};
    SBAR(); pv(o, vb0 + sl_cur, PAF(0), PAF(1), PAF(2), PAF(3)); }
  #undef PKW
  #undef PAF
  #undef VFR
  #undef PIN
  #undef MX3
  #undef GAPA
  #undef GAPB
  #undef EX
  #undef VRD
  #undef KRD
  #undef STEP
  #undef ENDW
  { auto rr = __builtin_amdgcn_permlane32_swap(__float_as_uint(l_reg), __float_as_uint(l_reg), false, false); l_reg = __uint_as_float(rr[0]) + __uint_as_float(rr[1]); }
  if (hi == 0) wsf[32 + r32] = l_reg; asm volatile("s_waitcnt lgkmcnt(0)" ::: "memory");
  float rli[16];
  #pragma unroll
  for (int r = 0; r < 16; ++r) rli[r] = __builtin_amdgcn_rcpf(wsf[32 + crow(r, hi)]);
  bf16_t* Ow = Ou + (long)wid * QBLK * OP;
  { bf16_t* stg = (bf16_t*)(shm + LDS_OST) + wid * 2048;
    #pragma unroll
    for (int r = 0; r < 16; ++r) { const int orow = crow(r, hi);
      #pragma unroll
      for (int d0 = 0; d0 < 2; ++d0) stg[orow * 64 + d0 * 32 + r32] = (bf16_t)(cvtpk_s(o[d0][r] * rli[r], 0.f) & 0xffffu); }
    asm volatile("s_waitcnt lgkmcnt(0)" ::: "memory");
    #pragma unroll
    for (int i = 0; i < 4; ++i) { const int row = i * 8 + (lane >> 3), ch = lane & 7; const u32x4 v = *(const u32x4*)(stg + row * 64 + ch * 8); *(u32x4*)(Ow + (long)row * OP + ch * 8) = v; } }
  asm volatile("s_waitcnt lgkmcnt(0)\n\ts_barrier" ::: "memory");
  #undef DMA_K
  #undef DMA_V
  #undef START
  #undef RESC
  #undef ROT
}
#undef SBAR
#undef WAIT_BAR
}

__device__ __forceinline__ void ph_prologue(const Params& P, LAS unsigned char* lds) {
    const int tid = tid_(), bid = bid_(), G = gridDim.x, lane = tid & 63, wid = tid >> 6;
    float* mods = (float*)(P.ws + WS_MODS);
    LAS float* sc = (LAS float*)lds;
    LAS float* red = sc + 9 * 1024;
    for (int i = tid; i < 9 * 1024; i += NTHR) { const float v = (i < 8192) ? P.in[I_C][i] : P.in[I_CCTX][i - 8192]; sc[i] = siluf_(v); }
    __syncthreads();
    {
        const int c = lane & 31, slot = wid * 2 + (lane >> 5);
        for (int u = bid; u < 4 * 192; u += G) {
            const int l = u / 192, cg = u % 192;
            const float* w = P.in[I_WADA] + (size_t)l * 1024 * 6144 + cg * 32 + c;
            float a[9];
#pragma unroll
            for (int r = 0; r < 9; ++r) a[r] = 0.f;
#pragma unroll 8
            for (int i = 0; i < 64; ++i) { const int k = slot + 16 * i; const float wv = w[(size_t)k * 6144];
#pragma unroll
                for (int r = 0; r < 9; ++r) a[r] += sc[r * 1024 + k] * wv; }
#pragma unroll
            for (int r = 0; r < 9; ++r) red[(slot * 9 + r) * 32 + c] = a[r];
            __syncthreads();
            if (tid < 288) { const int r = tid >> 5, cc = tid & 31; float s_ = 0.f;
#pragma unroll
                for (int q = 0; q < 16; ++q) s_ += red[(q * 9 + r) * 32 + cc];
                mods[((size_t)l * 9 + r) * 6144 + cg * 32 + cc] = s_ + P.in[I_BADA][l * 6144 + cg * 32 + cc]; }
            __syncthreads();
        }
    }
    if (bid == G - 1) {
        float* lbv = (float*)(P.ws + WS_LB);
        for (int i = tid; i < 1024; i += NTHR) {
            float lg[DEPTH], mx = -1e30f;
#pragma unroll
            for (int l = 0; l < DEPTH; ++l) { lg[l] = P.in[I_LBL][l * 1024 + i]; mx = fmaxf(mx, lg[l]); }
            float s = 0.f;
#pragma unroll
            for (int l = 0; l < DEPTH; ++l) { lg[l] = expf(lg[l] - mx); s += lg[l]; }
            float cum = 0.f;
#pragma unroll
            for (int l = 0; l < DEPTH; ++l) { if (l > 0) cum += lg[l] / s; lbv[l * 1024 + i] = cum; }
        }
        float* rope = (float*)(P.ws + WS_ROPE);
        for (int i = tid; i < 96 * 16; i += NTHR) {
            const int pos = i >> 4, fi = i & 15;
            const float inv = powf(10000.0f, -(float)fi / 16.0f);
            const float p = (pos < 32) ? (float)pos : (float)(pos - 32);
            const float ang = p * inv;
            if (pos < 32) { rope[pos * 16 + fi] = cosf(ang); rope[512 + pos * 16 + fi] = sinf(ang); }
            else { rope[1024 + (pos - 32) * 16 + fi] = cosf(ang); rope[2048 + (pos - 32) * 16 + fi] = sinf(ang); }
        }
    }
    float4* xr = (float4*)(P.ws + WS_X);
    const float4* xs = (const float4*)P.in[I_X]; const float4* cs = (const float4*)P.in[I_CTX];
    const size_t nx4 = (size_t)NLAT * D / 4, nc4 = (size_t)NCTX * D / 4;
    for (size_t i = (size_t)bid * NTHR + tid; i < nx4 + nc4; i += (size_t)G * NTHR) xr[i] = (i < nx4) ? xs[i] : cs[i - nx4];
}

struct ConvJob { const float* srcA; const float* srcB; int ld; bool inter; bool perm; bf16_t* dst; int K, n0, k0; };
__device__ __forceinline__ int perm32(int rho) { const int n = rho >> 4, i = rho & 15; return 8 * (i >> 2) + 4 * n + (i & 3); }
__device__ __forceinline__ bool conv_job(const Params& P, int l, int u, ConvJob& J) {
    constexpr int T_IN = 16 * 124, T_BR = 3 * 8 * 16, T_OUT = 16 * 16, T_GU = 16 * 16 * 16, T_DN = 16 * 8 * 16;
    constexpr int TOT = T_IN + T_BR + T_OUT + T_GU + T_DN;
    if (u >= TOT) return false;
    int v = u;
    J.srcB = nullptr; J.inter = false; J.perm = false;
    if (v < T_IN) { const int kt = v % 16, nt = v / 16; J.perm = true; J.srcA = P.in[I_WIN] + (size_t)l * 1024 * INC; J.ld = INC; J.dst = (bf16_t*)(P.ws + WS_WIN); J.K = 1024; J.n0 = nt * 64; J.k0 = kt * 64; return true; }
    v -= T_IN;
    if (v < T_BR) { const int i = v / 128, w = v % 128, kt = w % 8, nt = w / 8; J.perm = true; J.srcA = P.in[I_WBR] + ((size_t)l * 3 + i) * 512 * 1024; J.ld = 1024; J.dst = (bf16_t*)(P.ws + WS_WBR) + (size_t)i * 1024 * 512; J.K = 512; J.n0 = nt * 64; J.k0 = kt * 64; return true; }
    v -= T_BR;
    if (v < T_OUT) { const int kt = v % 16, nt = v / 16; J.srcA = P.in[I_WOUT] + (size_t)l * 1024 * 1024; J.ld = 1024; J.dst = (bf16_t*)(P.ws + WS_WOUT); J.K = 1024; J.n0 = nt * 64; J.k0 = kt * 64; return true; }
    v -= T_OUT;
    if (v < T_GU) { const int e = v / 256, w = v % 256, kt = w % 16, nt = w / 16; const size_t eo = ((size_t)l * NEXP + e) * 1024 * 512;
        J.srcA = P.in[I_WEG] + eo; J.srcB = P.in[I_WEU] + eo; J.inter = true; J.ld = 512; J.dst = (bf16_t*)(P.ws + WS_WGU) + (size_t)e * 1024 * 1024; J.K = 1024; J.n0 = nt * 64; J.k0 = kt * 64; return true; }
    v -= T_GU;
    { const int e = v / 128, w = v % 128, kt = w % 8, nt = w / 8; J.perm = true; J.srcA = P.in[I_WED] + ((size_t)l * NEXP + e) * 512 * 1024; J.ld = 1024; J.dst = (bf16_t*)(P.ws + WS_WDN) + (size_t)e * 1024 * 512; J.K = 512; J.n0 = nt * 64; J.k0 = kt * 64; return true; }
}
__device__ __forceinline__ void conv_load(const ConvJob& J, int tid, float (&v)[8]) {
    const int nn = tid & 63, kk = tid >> 6, n = J.n0 + nn;
    const float* cp;
    if (J.perm) cp = J.srcA + (n & ~31) + perm32(n & 31); else if (!J.inter) cp = J.srcA + n; else { const int g = n >> 5, i = n & 31; cp = (i < 16) ? (J.srcA + 16 * g + i) : (J.srcB + 16 * g + i - 16); }
#pragma unroll
    for (int p = 0; p < 8; ++p) v[p] = cp[(size_t)(J.k0 + kk + 8 * p) * J.ld];
}
__device__ __forceinline__ void ph_wconv(const Params& P, LAS unsigned char* lds, int l) {
    LAS float* t = (LAS float*)lds;
    const int tid = tid_(), G = gridDim.x;
    int u = bid_();
    ConvJob J; float v[8];
    bool have = conv_job(P, l, u, J);
    if (have) conv_load(J, tid, v);
    while (have) {
        ConvJob Jn; float vn[8];
        const bool hn = conv_job(P, l, u + G, Jn);
        if (hn) conv_load(Jn, tid, vn);
        { const int nn = tid & 63, kk = tid >> 6;
#pragma unroll
          for (int p = 0; p < 8; ++p) t[(kk + 8 * p) * 65 + nn] = v[p]; }
        __syncthreads();
        { const int n = tid >> 3, k8 = (tid & 7) * 8;
          float w[8];
#pragma unroll
          for (int j = 0; j < 8; ++j) w[j] = t[(k8 + j) * 65 + n];
          uint4 o; o.x = pk_bf16(w[0], w[1]); o.y = pk_bf16(w[2], w[3]); o.z = pk_bf16(w[4], w[5]); o.w = pk_bf16(w[6], w[7]);
          *(uint4*)(J.dst + (size_t)(J.n0 + n) * J.K + J.k0 + k8) = o; }
        __syncthreads();
        J = Jn; have = hn; u += G;
#pragma unroll
        for (int p = 0; p < 8; ++p) v[p] = vn[p];
    }
}

__device__ __forceinline__ void norm_row(const float4 (&x)[4], const float* g, const float* shift, const float* scale, int lane, float4 (&o)[4]) {
    float ss = 0.f;
#pragma unroll
    for (int i = 0; i < 4; ++i) ss += x[i].x * x[i].x + x[i].y * x[i].y + x[i].z * x[i].z + x[i].w * x[i].w;
    ss = wave_sum(ss);
    const float rstd = __builtin_amdgcn_rsqf(ss * (1.0f / 1024.0f) + 1e-6f);
#pragma unroll
    for (int i = 0; i < 4; ++i) {
        const int c = lane * 4 + 256 * i;
        const float4 gv = *(const float4*)(g + c), sh = *(const float4*)(shift + c), sc = *(const float4*)(scale + c);
        o[i].x = x[i].x * rstd * gv.x * (1.0f + sc.x) + sh.x;
        o[i].y = x[i].y * rstd * gv.y * (1.0f + sc.y) + sh.y;
        o[i].z = x[i].z * rstd * gv.z * (1.0f + sc.z) + sh.z;
        o[i].w = x[i].w * rstd * gv.w * (1.0f + sc.w) + sh.w;
    }
}
__device__ __forceinline__ int row_modrow(int r) { return r < NLAT ? (r >> 11) : 8; }

__device__ __forceinline__ void ph_norm1(const Params& P, int l) {
    const int tid = tid_(), lane = tid & 63, wid = tid >> 6;
    const float* xres = (const float*)(P.ws + WS_X);
    bf16_t* h = (bf16_t*)(P.ws + WS_H);
    const float* g = P.in[I_GMIX] + l * 1024;
    for (int r = bid_() * 8 + wid; r < NTOK; r += gridDim.x * 8) {
        const float* mod = (const float*)(P.ws + WS_MODS) + ((size_t)l * 9 + row_modrow(r)) * 6144;
        float4 x[4], o[4];
#pragma unroll
        for (int i = 0; i < 4; ++i) x[i] = *(const float4*)(xres + (size_t)r * D + lane * 4 + 256 * i);
        norm_row(x, g, mod, mod + 1024, lane, o);
#pragma unroll
        for (int i = 0; i < 4; ++i) { uint2 u; u.x = pk_bf16(o[i].x, o[i].y); u.y = pk_bf16(o[i].z, o[i].w); *(uint2*)(h + (size_t)r * D + lane * 4 + 256 * i) = u; }
    }
}

struct EpiStoreBf16 { bf16_t* O; int ldc;
    __device__ __forceinline__ void operator()(int row, int col, const f32x4& v0, const f32x4& v1) const {
        uint2 a, b; a.x = pk_bf16(v0[0], v0[1]); a.y = pk_bf16(v0[2], v0[3]); b.x = pk_bf16(v1[0], v1[1]); b.y = pk_bf16(v1[2], v1[3]);
        *(uint2*)(O + (size_t)row * ldc + col) = a; *(uint2*)(O + (size_t)row * ldc + col + 16) = b; } };
struct EpiStore16 { bf16_t* O; int ldc;
    __device__ __forceinline__ void operator()(const f32x4 (&acc)[2][2][4][2], const pg8::Unit& u, int wr, int wc, int fr, int fq) const {
#pragma unroll
        for (int ai = 0; ai < 2; ++ai)
#pragma unroll
            for (int m = 0; m < 4; ++m)
#pragma unroll
                for (int bj = 0; bj < 2; ++bj) { const int row = u.row0 + ai * 128 + wr * 64 + m * 16 + fr, col = u.col0 + bj * 128 + wc * 32 + 8 * fq;
                    const f32x4 v0 = acc[ai][bj][m][0], v1 = acc[ai][bj][m][1];
                    uint4 o; o.x = pk_bf16(v0[0], v0[1]); o.y = pk_bf16(v0[2], v0[3]); o.z = pk_bf16(v1[0], v1[1]); o.w = pk_bf16(v1[2], v1[3]);
                    *(uint4*)(O + (size_t)row * ldc + col) = o; }
    } };
struct FStoreBf16 { bf16_t* O; int ldc;
    __device__ __forceinline__ void operator()(const pg8::Unit&, int row, int col, const f32x4& v0, const f32x4& v1) const {
        uint2 a, b; a.x = pk_bf16(v0[0], v0[1]); a.y = pk_bf16(v0[2], v0[3]); b.x = pk_bf16(v1[0], v1[1]); b.y = pk_bf16(v1[2], v1[3]);
        *(uint2*)(O + (size_t)row * ldc + col) = a; *(uint2*)(O + (size_t)row * ldc + col + 16) = b; } };
struct EpiG1 { bf16_t* Z; bf16_t* GT;
    __device__ __forceinline__ void operator()(const f32x4 (&acc)[2][2][4][2], const pg8::Unit& u, int wr, int wc, int fr, int fq) const {
        if (u.col0 < C_GATE) {
#pragma unroll
            for (int ai = 0; ai < 2; ++ai)
#pragma unroll
                for (int m = 0; m < 4; ++m)
#pragma unroll
                    for (int bj = 0; bj < 2; ++bj) { const int row = u.row0 + ai * 128 + wr * 64 + m * 16 + fr, col = u.col0 + bj * 128 + wc * 32 + 8 * fq;
                        const f32x4 v0 = acc[ai][bj][m][0], v1 = acc[ai][bj][m][1];
                        uint4 o; o.x = pk_bf16(v0[0], v0[1]); o.y = pk_bf16(v0[2], v0[3]); o.z = pk_bf16(v1[0], v1[1]); o.w = pk_bf16(v1[2], v1[3]);
                        *(uint4*)(Z + (size_t)row * ZP + col) = o; }
        } else {
            const int tidx = (wr * 4 + wc) * 64 + fq * 16 + fr;
            bf16_t* base = GT + ((size_t)(u.row0 >> 8) * 12 + ((u.col0 - C_GATE) >> 8)) * 65536 + tidx * 8;
#pragma unroll
            for (int ai = 0; ai < 2; ++ai)
#pragma unroll
                for (int bj = 0; bj < 2; ++bj)
#pragma unroll
                    for (int m = 0; m < 4; ++m) { const f32x4 v0 = acc[ai][bj][m][0], v1 = acc[ai][bj][m][1];
                        uint4 o; o.x = pk_bf16(sigmoidf_(v0[0]), sigmoidf_(v0[1])); o.y = pk_bf16(sigmoidf_(v0[2]), sigmoidf_(v0[3]));
                        o.z = pk_bf16(sigmoidf_(v1[0]), sigmoidf_(v1[1])); o.w = pk_bf16(sigmoidf_(v1[2]), sigmoidf_(v1[3]));
                        *(uint4*)(base + ((ai * 2 + bj) * 4 + m) * 4096) = o; }
        }
    } };
__device__ __forceinline__ void ph_g1(const Params& P, LAS unsigned char* lds) {
    pg8::SchedDense S{NTOK / 256, INC / 256, (int)gridDim.x, bid_(), (const char*)(P.ws + WS_H), (const char*)(P.ws + WS_WIN), (size_t)256 * D * 2, (size_t)256 * D * 2};
    EpiG1 E{(bf16_t*)(P.ws + WS_Z), (bf16_t*)(P.ws + WS_GT)};
    pg8::gemm_phase(lds, pg8::Gemm{D, D, D}, S, E);
}

__device__ __forceinline__ int kvrow(int r) { return r < NLAT ? ((r >> 11) * 2304 + 256 + (r & 2047)) : (((r - NLAT) >> 8) * 2304 + ((r - NLAT) & 255)); }
__device__ __forceinline__ void ph_prep(const Params& P, int l) {
    const int tid = tid_(), lane = tid & 63, wid = tid >> 6;
    const bf16_t* z = (const bf16_t*)(P.ws + WS_Z);
    bf16_t* qn = (bf16_t*)(P.ws + WS_QN); bf16_t* kn = (bf16_t*)(P.ws + WS_KN); bf16_t* vn = (bf16_t*)(P.ws + WS_VN);
    const float* rope = (const float*)(P.ws + WS_ROPE);
    const float gq = P.in[I_QNG][l * 64 + lane] * (0.125f * 1.4426950408889634f), gk = P.in[I_KNG][l * 64 + lane];
    for (int r = bid_() * 8 + wid; r < NTOK; r += gridDim.x * 8) {
        const bool lat = r < NLAT;
        const size_t kr = (size_t)kvrow(r);
        float cs = 1.f, sn = 0.f;
        if (lat) { const int t = r & 2047, fi = lane & 15;
            if (lane < 32) { const int pr = t >> 6; cs = rope[pr * 16 + fi]; sn = rope[512 + pr * 16 + fi]; }
            else { const int pc = t & 63; cs = rope[1024 + pc * 16 + fi]; sn = rope[2048 + pc * 16 + fi]; } }
        const float sgn = (lane & 16) ? 1.f : -1.f;
#pragma unroll
        for (int hh = 0; hh < 10; ++hh) {
            const int col = (hh < 8) ? (C_GQ + hh * 64) : (C_GK + (hh - 8) * 64);
            const float x = bf2f(z[(size_t)r * ZP + col + lane]);
            const float ss = wave_sum(x * x);
            const float xn = x * __builtin_amdgcn_rsqf(ss * (1.0f / 64.0f) + 1e-6f) * (hh < 8 ? gq : gk);
            const float pa = __shfl_xor(xn, 16, 64);
            const float o = xn * cs + sgn * pa * sn;
            const bf16_t ob = (bf16_t)(pk_bf16(o, 0.f) & 0xffffu);
            if (hh < 8) qn[(size_t)r * 512 + hh * 64 + lane] = ob; else kn[kr * 128 + (hh - 8) * 64 + lane] = ob;
        }
        *(unsigned*)(vn + kr * 128 + lane * 2) = *(const unsigned*)(z + (size_t)r * ZP + C_GV + lane * 2);
    }
}

__device__ __forceinline__ void ph_navt(const Params& P, LAS unsigned char* lds) {
    const int tid = tid_();
    const bf16_t* z = (const bf16_t*)(P.ws + WS_Z); bf16_t* vt = (bf16_t*)(P.ws + WS_NAVT);
    constexpr int PT = 1040;
    for (int u = bid_(); u < NB * 36; u += gridDim.x) {
        const int b = u / 36, tl = u % 36;
        const int row0 = (tl < 4) ? (NLAT + b * 256 + tl * 64) : (b * 2048 + (tl - 4) * 64);
        __syncthreads();
#pragma unroll
        for (int i = 0; i < 8; ++i) { const int ch = tid + i * NTHR, rr = ch >> 6, cc = ch & 63;
            const uint4 v = *(const uint4*)(z + (size_t)(row0 + rr) * ZP + C_NAV + cc * 8);
            *(LAS u32x4*)(lds + rr * PT + cc * 16) = (u32x4){v.x, v.y, v.z, v.w}; }
        __syncthreads();
#pragma unroll
        for (int i = 0; i < 8; ++i) { const int c = tid, tg = i;
            unsigned short e[8];
#pragma unroll
            for (int k = 0; k < 8; ++k) e[k] = *(const LAS unsigned short*)(lds + (tg * 8 + k) * PT + c * 2);
            uint4 o; o.x = e[0] | ((unsigned)e[1] << 16); o.y = e[2] | ((unsigned)e[3] << 16); o.z = e[4] | ((unsigned)e[5] << 16); o.w = e[6] | ((unsigned)e[7] << 16);
            *(uint4*)(vt + ((size_t)(b * 8 + (c >> 6)) * 64 + (c & 63)) * 2304 + tl * 64 + tg * 8) = o; }
    }
    __syncthreads();
}

#ifdef DIAG
__device__ __forceinline__ void load_q64(float (&q)[64], const bf16_t* p) {
#pragma unroll
    for (int i = 0; i < 8; ++i) { const uint4 u = ((const uint4*)p)[i];
        q[8 * i + 0] = bf_lo(u.x); q[8 * i + 1] = bf_hi(u.x); q[8 * i + 2] = bf_lo(u.y); q[8 * i + 3] = bf_hi(u.y);
        q[8 * i + 4] = bf_lo(u.z); q[8 * i + 5] = bf_hi(u.z); q[8 * i + 6] = bf_lo(u.w); q[8 * i + 7] = bf_hi(u.w); }
}
__device__ __forceinline__ void attn_key(const float (&q)[64], const bf16_t* kp, const bf16_t* vp, float bias, float& m, float& lsum, float (&o)[64]) {
    float s = 0.f;
#pragma unroll
    for (int i = 0; i < 8; ++i) { const uint4 u = ((const uint4*)kp)[i];
        s += q[8 * i + 0] * bf_lo(u.x) + q[8 * i + 1] * bf_hi(u.x) + q[8 * i + 2] * bf_lo(u.y) + q[8 * i + 3] * bf_hi(u.y)
           + q[8 * i + 4] * bf_lo(u.z) + q[8 * i + 5] * bf_hi(u.z) + q[8 * i + 6] * bf_lo(u.w) + q[8 * i + 7] * bf_hi(u.w); }
    s = s * 0.125f + bias;
    const float mn = fmaxf(m, s), corr = __expf(m - mn), pp = __expf(s - mn);
    lsum = lsum * corr + pp; m = mn;
#pragma unroll
    for (int i = 0; i < 8; ++i) { const uint4 u = ((const uint4*)vp)[i];
        o[8 * i + 0] = o[8 * i + 0] * corr + pp * bf_lo(u.x); o[8 * i + 1] = o[8 * i + 1] * corr + pp * bf_hi(u.x);
        o[8 * i + 2] = o[8 * i + 2] * corr + pp * bf_lo(u.y); o[8 * i + 3] = o[8 * i + 3] * corr + pp * bf_hi(u.y);
        o[8 * i + 4] = o[8 * i + 4] * corr + pp * bf_lo(u.z); o[8 * i + 5] = o[8 * i + 5] * corr + pp * bf_hi(u.z);
        o[8 * i + 6] = o[8 * i + 6] * corr + pp * bf_lo(u.w); o[8 * i + 7] = o[8 * i + 7] * corr + pp * bf_hi(u.w); }
}
__device__ __forceinline__ void store_o64(const float (&o)[64], float inv, bf16_t* p) {
#pragma unroll
    for (int i = 0; i < 8; ++i) { uint4 u;
        u.x = pk_bf16(o[8 * i + 0] * inv, o[8 * i + 1] * inv); u.y = pk_bf16(o[8 * i + 2] * inv, o[8 * i + 3] * inv);
        u.z = pk_bf16(o[8 * i + 4] * inv, o[8 * i + 5] * inv); u.w = pk_bf16(o[8 * i + 6] * inv, o[8 * i + 7] * inv);
        ((uint4*)p)[i] = u; }
}
__device__ __forceinline__ void na_thread(const Params& P, int l, int r, int h, bf16_t* br, int OPN) {
    const bf16_t* z = (const bf16_t*)(P.ws + WS_Z);
    float q[64], o[64]; float m = -INFINITY, ls = 0.f;
#pragma unroll
    for (int i = 0; i < 64; ++i) o[i] = 0.f;
    load_q64(q, z + (size_t)r * ZP + C_NAQ + h * 64);
    int b;
    if (r < NLAT) {
        b = r >> 11; const int t = r & 2047, qr = t >> 6, qc = t & 63;
        const int r0 = min(max(qr - 4, 0), 24), c0 = min(max(qc - 8, 0), 48);
        const float* rpb = P.in[I_RPB] + ((size_t)l * 8 + h) * 15 * 31;
        for (int kr = r0; kr < r0 + 8; ++kr)
            for (int kc = c0; kc < c0 + 16; ++kc) {
                const size_t krow = (size_t)(b * 2048 + kr * 64 + kc) * ZP;
                attn_key(q, z + krow + C_NAK + h * 64, z + krow + C_NAV + h * 64, rpb[(kr - qr + 7) * 31 + (kc - qc + 15)], m, ls, o);
            }
    } else b = (r - NLAT) >> 8;
    for (int j = 0; j < 256; ++j) {
        const size_t krow = (size_t)(NLAT + b * 256 + j) * ZP;
        attn_key(q, z + krow + C_NAK + h * 64, z + krow + C_NAV + h * 64, 0.f, m, ls, o);
    }
    store_o64(o, 1.0f / ls, br + (size_t)r * OPN + h * 64);
}
#endif
namespace na {
constexpr int KP = 144, VP = 528;
constexpr int L_K = 0, L_V = 256 * KP, L_B = L_V + 64 * VP, L_END = L_B + 480 * 4;
constexpr float C2 = 0.125f * 1.4426950408889634f, LOG2E = 1.4426950408889634f;
struct Acc { float m, l; f32x4 o[4]; };
template <class VF> __device__ __forceinline__ void absorb(Acc& A, f32x4 (&sa)[4], f32x4 (&sb)[4], const VF& vf) {
    float mx = -INFINITY;
#pragma unroll
    for (int g = 0; g < 4; ++g)
#pragma unroll
        for (int j = 0; j < 4; ++j) mx = fmaxf(mx, fmaxf(sa[g][j], sb[g][j]));
    mx = fmaxf(mx, __shfl_xor(mx, 16, 64)); mx = fmaxf(mx, __shfl_xor(mx, 32, 64));
    const float mn = fmaxf(A.m, mx), corr = __builtin_amdgcn_exp2f(A.m - mn);
    A.m = mn;
    float ps = 0.f;
    bf16x8 pf[4];
#pragma unroll
    for (int g = 0; g < 4; ++g) { float p[8];
#pragma unroll
        for (int j = 0; j < 4; ++j) { p[j] = __builtin_amdgcn_exp2f(sa[g][j] - mn); p[4 + j] = __builtin_amdgcn_exp2f(sb[g][j] - mn); ps += p[j] + p[4 + j]; }
        pf[g] = pack8(p); }
    A.l = A.l * corr + ps;
#pragma unroll
    for (int db = 0; db < 4; ++db) A.o[db] *= corr;
    bf16x8 vfr[4][4];
#pragma unroll
    for (int g = 0; g < 4; ++g)
#pragma unroll
        for (int db = 0; db < 4; ++db) vfr[g][db] = vf(g, db);
#pragma unroll
    for (int g = 0; g < 4; ++g)
#pragma unroll
        for (int db = 0; db < 4; ++db) A.o[db] = __builtin_amdgcn_mfma_f32_16x16x32_bf16(vfr[g][db], pf[g], A.o[db], 0, 0, 0);
}
}
__device__ __forceinline__ void na_unit(const Params& P, LAS unsigned char* lds, int l, int u, bf16_t* br, int OPN) {
    const int tid = tid_(), lane = tid & 63, wid = __builtin_amdgcn_readfirstlane(tid >> 6), c16 = lane & 15, kq = lane >> 4;
    const bool latu = u < 256;
    const int bh = latu ? (u >> 2) : (u - 256), b = bh >> 3, h = bh & 7, q4 = u & 3;
    const bf16_t* z = (const bf16_t*)(P.ws + WS_Z); const bf16_t* vt = (const bf16_t*)(P.ws + WS_NAVT) + (size_t)bh * 64 * 2304;
    LAS unsigned char* KL = lds + na::L_K; LAS unsigned char* VL = lds + na::L_V; LAS float* BL = (LAS float*)(lds + na::L_B);
    __syncthreads();
#pragma unroll
    for (int i = 0; i < 4; ++i) { const int ch = tid + i * NTHR, rr = ch >> 3, cc = ch & 7;
        const uint4 v = *(const uint4*)(z + (size_t)(NLAT + b * 256 + rr) * ZP + C_NAK + h * 64 + cc * 8);
        *(LAS u32x4*)(KL + rr * na::KP + cc * 16) = (u32x4){v.x, v.y, v.z, v.w}; }
#pragma unroll
    for (int i = 0; i < 4; ++i) { const int ch = tid + i * NTHR, rr = ch >> 5, cc = ch & 31;
        const uint4 v = *(const uint4*)(vt + (size_t)rr * 2304 + cc * 8);
        *(LAS u32x4*)(VL + rr * na::VP + cc * 16) = (u32x4){v.x, v.y, v.z, v.w}; }
    if (tid < 465) BL[tid] = P.in[I_RPB][((size_t)l * 8 + h) * 465 + tid] * na::LOG2E;
    __syncthreads();
    const int sA = 8 * (c16 >> 2) + (c16 & 3);
    const int ntask = latu ? 4 : 2;
    for (int it = 0; it < ntask; ++it) {
        const int tk = it * 8 + wid;
        int qrow, r = 0, jb = 0;
        if (latu) { r = q4 * 8 + (tk >> 2); jb = tk & 3; qrow = b * 2048 + r * 64 + jb * 16 + c16; }
        else qrow = NLAT + b * 256 + tk * 16 + c16;
        bf16x8 qf[2];
#pragma unroll
        for (int ks = 0; ks < 2; ++ks) qf[ks] = *(const bf16x8*)(z + (size_t)qrow * ZP + C_NAQ + h * 64 + 32 * ks + 8 * kq);
        bf16_t* op = br + (size_t)qrow * OPN + h * 64 + 4 * kq; asm volatile("" : "+v"(op));
        na::Acc A; A.m = -INFINITY; A.l = 0.f;
#pragma unroll
        for (int db = 0; db < 4; ++db) A.o[db] = (f32x4){0.f, 0.f, 0.f, 0.f};
        if (latu) {
            const int r0 = min(max(r - 4, 0), 24), kc0 = min(max(jb * 16 - 8, 0), 32), qc = jb * 16 + c16, c0 = min(max(qc - 8, 0), 48);
            int dcol[8]; bool ok[8];
#pragma unroll
            for (int j = 0; j < 8; ++j) { const int kc = kc0 + 8 * kq + j; ok[j] = (kc >= c0) && (kc < c0 + 16); dcol[j] = ok[j] ? (kc - qc + 15) : 0; }
#pragma unroll 1
            for (int ch = 0; ch < 2; ++ch) {
                f32x4 sa[4], sb[4];
                const size_t tokbase = (size_t)b * 2048 + (size_t)(r0 + ch * 4) * 64 + kc0;
                bf16x8 kf[4][4];
#pragma unroll
                for (int g = 0; g < 4; ++g) {
                    const bf16_t* kp = z + (tokbase + (size_t)g * 64 + sA) * ZP + C_NAK + h * 64 + 8 * kq;
                    kf[g][0] = *(const bf16x8*)kp; kf[g][1] = *(const bf16x8*)(kp + 32); kf[g][2] = *(const bf16x8*)(kp + 4 * ZP); kf[g][3] = *(const bf16x8*)(kp + 4 * ZP + 32);
                }
                float bv[4][8];
#pragma unroll
                for (int g = 0; g < 4; ++g) { const int brow = (r0 + ch * 4 + g - r + 7) * 31;
#pragma unroll
                    for (int j = 0; j < 8; ++j) bv[g][j] = BL[brow + dcol[j]]; }
#pragma unroll
                for (int g = 0; g < 4; ++g) {
                    f32x4 a = {0.f, 0.f, 0.f, 0.f}, bq = {0.f, 0.f, 0.f, 0.f};
                    a = __builtin_amdgcn_mfma_f32_16x16x32_bf16(kf[g][0], qf[0], a, 0, 0, 0); a = __builtin_amdgcn_mfma_f32_16x16x32_bf16(kf[g][1], qf[1], a, 0, 0, 0);
                    bq = __builtin_amdgcn_mfma_f32_16x16x32_bf16(kf[g][2], qf[0], bq, 0, 0, 0); bq = __builtin_amdgcn_mfma_f32_16x16x32_bf16(kf[g][3], qf[1], bq, 0, 0, 0);
#pragma unroll
                    for (int j = 0; j < 4; ++j) {
                        const float va = a[j] * na::C2 + bv[g][j], vb = bq[j] * na::C2 + bv[g][4 + j];
                        sa[g][j] = ok[j] ? va : -INFINITY;
                        sb[g][j] = ok[4 + j] ? vb : -INFINITY; }
                }
                const bf16_t* vp = vt + (size_t)c16 * 2304 + 256 + (r0 + ch * 4) * 64 + kc0 + 8 * kq;
                na::absorb(A, sa, sb, [&](int g, int db) { return *(const bf16x8*)(vp + (size_t)db * 16 * 2304 + g * 64); });
            }
        }
#pragma unroll 1
        for (int ch = 0; ch < 2; ++ch) {
            f32x4 sa[4], sb[4];
            bf16x8 kf[4][4];
#pragma unroll
            for (int g = 0; g < 4; ++g) {
                const LAS unsigned char* kp = KL + (ch * 128 + g * 32 + sA) * na::KP + kq * 16;
                kf[g][0] = *(const LAS bf16x8*)kp; kf[g][1] = *(const LAS bf16x8*)(kp + 64); kf[g][2] = *(const LAS bf16x8*)(kp + 4 * na::KP); kf[g][3] = *(const LAS bf16x8*)(kp + 4 * na::KP + 64);
            }
#pragma unroll
            for (int g = 0; g < 4; ++g) {
                f32x4 a = {0.f, 0.f, 0.f, 0.f}, bq = {0.f, 0.f, 0.f, 0.f};
                a = __builtin_amdgcn_mfma_f32_16x16x32_bf16(kf[g][0], qf[0], a, 0, 0, 0); a = __builtin_amdgcn_mfma_f32_16x16x32_bf16(kf[g][1], qf[1], a, 0, 0, 0);
                bq = __builtin_amdgcn_mfma_f32_16x16x32_bf16(kf[g][2], qf[0], bq, 0, 0, 0); bq = __builtin_amdgcn_mfma_f32_16x16x32_bf16(kf[g][3], qf[1], bq, 0, 0, 0);
                sa[g] = a * na::C2; sb[g] = bq * na::C2;
            }
            const LAS unsigned char* vp = VL + c16 * na::VP + (ch * 128 + 8 * kq) * 2;
            na::absorb(A, sa, sb, [&](int g, int db) { return *(const LAS bf16x8*)(vp + db * 16 * na::VP + g * 64); });
        }
        float ls = A.l; ls += __shfl_xor(ls, 16, 64); ls += __shfl_xor(ls, 32, 64);
        const float inv = __builtin_amdgcn_rcpf(ls);
#pragma unroll
        for (int db = 0; db < 4; ++db) { uint2 o; o.x = pk_bf16(A.o[db][0] * inv, A.o[db][1] * inv); o.y = pk_bf16(A.o[db][2] * inv, A.o[db][3] * inv);
            *(uint2*)(op + 16 * db) = o; }
    }
}
__device__ __forceinline__ int hg_row(int b, int dir, int s) { return s < 256 ? (NLAT + b * 256 + (dir ? 255 - s : s)) : (b * 2048 + (dir ? 2047 - (s - 256) : (s - 256))); }
__device__ __forceinline__ bf16x8 tr2(const LAS unsigned char* p0, const LAS unsigned char* p1) {
    typedef short v4i16_t __attribute__((ext_vector_type(4)));
    const v4i16_t a = __builtin_amdgcn_ds_read_tr16_b64_v4i16((LAS v4i16_t*)p0), c = __builtin_amdgcn_ds_read_tr16_b64_v4i16((LAS v4i16_t*)p1);
    return (bf16x8){a[0], a[1], a[2], a[3], c[0], c[1], c[2], c[3]};
}
__device__ __forceinline__ void hgrn_unit(const Params& P, LAS unsigned char* lds, int l, int u) {
    const int tid = tid_(), lane = tid & 63, wid = __builtin_amdgcn_readfirstlane(tid >> 6), c16 = lane & 15, kq = lane >> 4;
    const int b = u >> 3, h = (u >> 1) & 3, dir = u & 1;
    const bf16_t* z = (const bf16_t*)(P.ws + WS_Z);
    float* O = (float*)(P.ws + (dir ? WS_Y : WS_H));
    const float* lbv = (const float*)(P.ws + WS_LB) + ((size_t)l * 2 + dir) * 512 + h * 128;
    constexpr int PQ = 272;
    LAS unsigned char* QH = lds; LAS unsigned char* KT = lds + 8704; LAS unsigned char* KH = lds + 17408; LAS unsigned char* VV = lds + 26112;
    LAS float* DL = (LAS float*)(lds + 34816); LAS float* WT = DL + 128;
    const int ch = 2 * lane;
    const float lb0 = lbv[ch], lb1 = lbv[ch + 1];
    const int cf = (dir ? C_HFB : C_HFF) + h * 128 + ch, cq = C_HQ + h * 128 + ch, cv = C_HI + h * 128 + ch;
    f32x4 SA[4], SB[4];
#pragma unroll
    for (int G = 0; G < 4; ++G) { SA[G] = (f32x4){0.f, 0.f, 0.f, 0.f}; SB[G] = (f32x4){0.f, 0.f, 0.f, 0.f}; }
    unsigned rf[4], rq[4], rv[4];
#pragma unroll
    for (int k = 0; k < 4; ++k) { const bf16_t* zr = z + (size_t)hg_row(b, dir, 4 * wid + k) * ZP; rf[k] = *(const unsigned*)(zr + cf); rq[k] = *(const unsigned*)(zr + cq); rv[k] = *(const unsigned*)(zr + cv); }
    const int sA = 8 * (c16 >> 2) + (c16 & 3);
    const int tq = c16 >> 2, tp = c16 & 3;
    for (int st = 0; st < 72; ++st) {
        unsigned xf[4], xq[4], xv[4];
#pragma unroll
        for (int k = 0; k < 4; ++k) { xf[k] = rf[k]; xq[k] = rq[k]; xv[k] = rv[k]; }
        if (st + 1 < 72) {
#pragma unroll
            for (int k = 0; k < 4; ++k) { const bf16_t* zr = z + (size_t)hg_row(b, dir, (st + 1) * 32 + 4 * wid + k) * ZP; rf[k] = *(const unsigned*)(zr + cf); rq[k] = *(const unsigned*)(zr + cq); rv[k] = *(const unsigned*)(zr + cv); }
        }
        float g0[4], g1[4], k0[4], k1[4], q0[4], q1[4];
        float c0 = 1.f, c1 = 1.f;
#pragma unroll
        for (int k = 0; k < 4; ++k) {
            const float f0 = lb0 + (1.0f - lb0) * sigmoidf_(bf_lo(xf[k])), f1 = lb1 + (1.0f - lb1) * sigmoidf_(bf_hi(xf[k]));
            c0 *= f0; c1 *= f1; g0[k] = c0; g1[k] = c1;
            k0[k] = 1.0f - f0; k1[k] = 1.0f - f1; q0[k] = siluf_(bf_lo(xq[k])); q1[k] = siluf_(bf_hi(xq[k]));
        }
        WT[wid * 128 + ch] = c0; WT[wid * 128 + ch + 1] = c1;
        __syncthreads();
        float pre0 = 1.f, pre1 = 1.f, tot0 = 1.f, tot1 = 1.f;
#pragma unroll
        for (int w = 0; w < 8; ++w) { const float a0 = WT[w * 128 + ch], a1 = WT[w * 128 + ch + 1]; tot0 *= a0; tot1 *= a1; if (w < wid) { pre0 *= a0; pre1 *= a1; } }
#pragma unroll
        for (int k = 0; k < 4; ++k) {
            const float e0 = g0[k] * pre0, e1 = g1[k] * pre1;
            const float r0 = __builtin_amdgcn_rcpf(e0), r1 = __builtin_amdgcn_rcpf(e1);
            const float kt0 = k0[k] * r0, kt1 = k1[k] * r1;
            const int ro = (4 * wid + k) * PQ + ch * 2;
            *(LAS unsigned*)(QH + ro) = pk_bf16(q0[k] * e0, q1[k] * e1);
            *(LAS unsigned*)(KT + ro) = pk_bf16(kt0, kt1);
            *(LAS unsigned*)(KH + ro) = pk_bf16(kt0 * tot0, kt1 * tot1);
            *(LAS unsigned*)(VV + ro) = xv[k];
        }
        if (wid == 0) { DL[ch] = tot0; DL[ch + 1] = tot1; }
        __syncthreads();
        const bf16x8 vfr = tr2(VV + (8 * kq + tq) * PQ + (16 * wid + 4 * tp) * 2, VV + (8 * kq + 4 + tq) * PQ + (16 * wid + 4 * tp) * 2);
        bf16x8 Sb[4];
#pragma unroll
        for (int G = 0; G < 4; ++G) { const float sv[8] = {SA[G][0], SA[G][1], SA[G][2], SA[G][3], SB[G][0], SB[G][1], SB[G][2], SB[G][3]}; Sb[G] = pack8(sv); }
#pragma unroll
        for (int T = 0; T < 2; ++T) {
            f32x4 aA = {0.f, 0.f, 0.f, 0.f}, aB = {0.f, 0.f, 0.f, 0.f};
            bf16x8 qf[4];
#pragma unroll
            for (int ks = 0; ks < 4; ++ks) {
                const bf16x8 kA = *(const LAS bf16x8*)(KT + sA * PQ + (32 * ks + 8 * kq) * 2);
                const bf16x8 kB = *(const LAS bf16x8*)(KT + (sA + 4) * PQ + (32 * ks + 8 * kq) * 2);
                qf[ks] = *(const LAS bf16x8*)(QH + (16 * T + c16) * PQ + (32 * ks + 8 * kq) * 2);
                aA = __builtin_amdgcn_mfma_f32_16x16x32_bf16(kA, qf[ks], aA, 0, 0, 0);
                aB = __builtin_amdgcn_mfma_f32_16x16x32_bf16(kB, qf[ks], aB, 0, 0, 0);
            }
            const int t = 16 * T + c16;
            float pv_[8];
#pragma unroll
            for (int jj = 0; jj < 4; ++jj) { pv_[jj] = (8 * kq + jj <= t) ? aA[jj] : 0.f; pv_[4 + jj] = (8 * kq + 4 + jj <= t) ? aB[jj] : 0.f; }
            f32x4 o = {0.f, 0.f, 0.f, 0.f};
            o = __builtin_amdgcn_mfma_f32_16x16x32_bf16(pack8(pv_), vfr, o, 0, 0, 0);
#pragma unroll
            for (int ks = 0; ks < 4; ++ks) o = __builtin_amdgcn_mfma_f32_16x16x32_bf16(qf[ks], Sb[ks], o, 0, 0, 0);
#pragma unroll
            for (int jj = 0; jj < 4; ++jj) O[(size_t)hg_row(b, dir, st * 32 + 16 * T + 4 * kq + jj) * 512 + h * 128 + 16 * wid + c16] = o[jj];
        }
#pragma unroll
        for (int G = 0; G < 4; ++G) {
            const f32x4 d0 = *(const LAS f32x4*)(DL + 32 * G + 8 * kq), d1 = *(const LAS f32x4*)(DL + 32 * G + 8 * kq + 4);
            const LAS unsigned char* ka = KH + (8 * kq + tq) * PQ + (32 * G + 8 * tp) * 2;
            const bf16x8 hA = tr2(ka, ka + 4 * PQ), hB = tr2(ka + 8, ka + 4 * PQ + 8);
            SA[G] = __builtin_amdgcn_mfma_f32_16x16x32_bf16(hA, vfr, SA[G] * d0, 0, 0, 0);
            SB[G] = __builtin_amdgcn_mfma_f32_16x16x32_bf16(hB, vfr, SB[G] * d1, 0, 0, 0);
        }
    }
    __syncthreads();
}
__device__ __forceinline__ void gqa_unit(const Params& P, char* shm, int U) {
    const bf16_t* qn = (const bf16_t*)(P.ws + WS_QN); const bf16_t* kn = (const bf16_t*)(P.ws + WS_KN); const bf16_t* vn = (const bf16_t*)(P.ws + WS_VN);
    bf16_t* br = (bf16_t*)(P.ws + WS_BR);
    int b, hq, row0, NT;
    if (U < 512) { const int bg = U >> 5; b = bg >> 1; hq = (bg & 1) * 4 + ((U & 31) >> 3); row0 = b * 2048 + (U & 7) * 256; NT = 36; }
    else { const int v = U - 512; b = v >> 3; hq = v & 7; row0 = NLAT + b * 256; NT = 4; }
    const int g = hq >> 2;
    gqa::attn_unit<8>(qn + (size_t)row0 * 512 + hq * 64, kn + (size_t)b * 2304 * 128 + g * 64, vn + (size_t)b * 2304 * 128 + g * 64,
                      br + (size_t)row0 * BRW + 1024 + hq * 64, NT, shm);
}
__device__ __forceinline__ void ph_mix(const Params& P, LAS unsigned char* lds, char* shm, int l, int pass = 0, int filter = 0) {
    const int tid = tid_();
    unsigned* qctr = (unsigned*)(P.ws + WS_CNT + 512) + l + 4 * pass;
    volatile LAS unsigned* qslot = (volatile LAS unsigned*)(lds + LDS_BYTES - 32);
    for (;;) {
        if (tid == 0) *qslot = __hip_atomic_fetch_add(qctr, 1u, __ATOMIC_RELAXED, __HIP_MEMORY_SCOPE_AGENT);
        __syncthreads();
        const int u = (int)*qslot;
        __syncthreads();
        if (u >= 960) break;
        const int kind = (u < 64) ? 2 : (u < 576 || (u >= 832 && u < 896)) ? 1 : 3;
        if (filter != 0 && filter != kind) continue;
        if (u < 64) hgrn_unit(P, lds, l, u);
        else if (u < 576) gqa_unit(P, shm, u - 64);
        else if (u < 832) na_unit(P, lds, l, u - 576, (bf16_t*)(P.ws + WS_BR), BRW);
        else if (u < 896) gqa_unit(P, shm, 512 + (u - 832));
        else na_unit(P, lds, l, 256 + (u - 896), (bf16_t*)(P.ws + WS_BR), BRW);
        __syncthreads();
    }
}
#ifdef DIAG
__device__ __forceinline__ void ph_diag_cmp(const Params& P) {
    const bf16_t* br = (const bf16_t*)(P.ws + WS_BR); const bf16_t* d1 = (const bf16_t*)(P.ws + WS_END); const bf16_t* d2 = d1 + (size_t)NTOK * 512;
    const bf16_t* z = (const bf16_t*)(P.ws + WS_Z); const bf16_t* vt = (const bf16_t*)(P.ws + WS_NAVT);
    unsigned* dg = (unsigned*)(P.ws + 20480);
    unsigned c1 = 0, c2 = 0, c3 = 0;
    for (size_t i = (size_t)bid_() * NTHR + tid_(); i < (size_t)NTOK * 512; i += (size_t)gridDim.x * NTHR) {
        const size_t r = i >> 9; const int c = (int)(i & 511);
        const float a = bf2f(br[r * BRW + c]), x = bf2f(d1[i]);
        if (!(fabsf(x - a) <= 0.004f + 0.02f * fabsf(a))) ++c1;
        if (DIAG != 4 && d1[i] != d2[i]) ++c3;
        const int rr = (int)r; const int bb = rr < NLAT ? (rr >> 11) : ((rr - NLAT) >> 8); const int tok = rr < NLAT ? (256 + (rr & 2047)) : ((rr - NLAT) & 255);
        if (vt[((size_t)(bb * 8 + (c >> 6)) * 64 + (c & 63)) * 2304 + tok] != z[r * ZP + C_NAV + c]) ++c2;
    }
    if (c1) atomicAdd(dg + 1, c1);
    if (c2) atomicAdd(dg + 2, c2);
    if (c3) atomicAdd(dg + 3, c3);
}
__device__ __forceinline__ void ph_diag_out(const Params& P) {
    const volatile unsigned* dg = (const volatile unsigned*)(P.ws + 20480);
    const unsigned c1 = dg[1], c2 = dg[2], c3 = dg[3];
    if ((c1 | c2 | c3) == 0) return;
    unsigned k = 0; { unsigned v = c1; while (v) { ++k; v >>= 1; } }
    if (c2) k += 30; if (c3) k += 60;
    const float cst = sqrtf(10.0f * (float)k + 9.0f);
    for (size_t i = (size_t)bid_() * NTHR + tid_(); i < (size_t)NLAT * D; i += (size_t)gridDim.x * NTHR) P.out[i] = cst;
}
#endif

__device__ __forceinline__ void ph_readout(const Params& P, int l) {
    const int tid = tid_(), lane = tid & 63, wid = tid >> 6;
    const float* OF = (const float*)(P.ws + WS_H); const float* OB = (const float*)(P.ws + WS_Y);
    const bf16_t* z = (const bf16_t*)(P.ws + WS_Z);
    bf16_t* br = (bf16_t*)(P.ws + WS_BR);
    const float g0 = P.in[I_HGN][l * 128 + lane * 2], g1 = P.in[I_HGN][l * 128 + lane * 2 + 1];
    for (int r = bid_() * 8 + wid; r < NTOK; r += gridDim.x * 8) {
#pragma unroll
        for (int h = 0; h < 4; ++h) {
            const int c = h * 128 + lane * 2;
            const float2 a = *(const float2*)(OF + (size_t)r * 512 + c), bb = *(const float2*)(OB + (size_t)r * 512 + c);
            const float o0 = a.x + bb.x, o1 = a.y + bb.y;
            const float ss = wave_sum(o0 * o0 + o1 * o1);
            const float rstd = __builtin_amdgcn_rsqf(ss * (1.0f / 128.0f) + 1e-6f);
            const unsigned gz = *(const unsigned*)(z + (size_t)r * ZP + C_HG + c);
            *(unsigned*)(br + (size_t)r * BRW + 512 + c) = pk_bf16(o0 * rstd * g0 * siluf_(bf_lo(gz)), o1 * rstd * g1 * siluf_(bf_hi(gz)));
        }
    }
}
struct SchedMerge { int G, c; const char* br; const char* wb; bool last;
    __device__ __forceinline__ bool next(int i, pg8::Unit& u) const {
        const int nl = (c < 256) ? (256 - c + G - 1) / G : 0;
        int tile, bi, mode;
        if (i < 3 * nl) { tile = c + (i / 3) * G; bi = i % 3; mode = 0; }
        else { if (last) return false; const int sidx = c + (i - 3 * nl) * G; if (sidx >= 96) return false; tile = 256 + sidx / 3; bi = sidx % 3; mode = 1; }
        const int pm = tile >> 2, pn = tile & 3;
        u.row0 = pm * 256; u.col0 = pn * 256; u.aux = bi | (mode << 4);
        u.A = br + ((size_t)pm * 256 * BRW + bi * 512) * 2; u.B = wb + ((size_t)bi * 1024 + pn * 256) * 512 * 2; return true; } };
struct EpiMerge { const bf16_t* GT; bf16_t* YP; bf16_t* Y; bf16_t* PG;
    __device__ __forceinline__ void operator()(const f32x4 (&acc)[2][2][4][2], const pg8::Unit& u, int wr, int wc, int fr, int fq) const {
        const int tidx = (wr * 4 + wc) * 64 + fq * 16 + fr, bi = u.aux & 15, mode = u.aux >> 4, pm = u.row0 >> 8, pn = u.col0 >> 8;
        const bf16_t* gb = GT + ((size_t)pm * 12 + bi * 4 + pn) * 65536 + tidx * 8;
        if (mode == 1) {
            bf16_t* pb = PG + ((size_t)bi * 32 + (pm - 64) * 4 + pn) * 65536 + tidx * 8;
#pragma unroll
            for (int ai = 0; ai < 2; ++ai)
#pragma unroll
                for (int bj = 0; bj < 2; ++bj) {
                    uint4 g[4];
#pragma unroll
                    for (int m = 0; m < 4; ++m) g[m] = *(const uint4*)(gb + ((ai * 2 + bj) * 4 + m) * 4096);
#pragma unroll
                    for (int m = 0; m < 4; ++m) { const f32x4 v0 = acc[ai][bj][m][0], v1 = acc[ai][bj][m][1];
                        uint4 o; o.x = pk_bf16(bf_lo(g[m].x) * v0[0], bf_hi(g[m].x) * v0[1]); o.y = pk_bf16(bf_lo(g[m].y) * v0[2], bf_hi(g[m].y) * v0[3]);
                        o.z = pk_bf16(bf_lo(g[m].z) * v1[0], bf_hi(g[m].z) * v1[1]); o.w = pk_bf16(bf_lo(g[m].w) * v1[2], bf_hi(g[m].w) * v1[3]);
                        *(uint4*)(pb + ((ai * 2 + bj) * 4 + m) * 4096) = o; }
                }
            return;
        }
        bf16_t* yb = YP + ((size_t)pm * 4 + pn) * 65536 + tidx * 8;
#pragma unroll
        for (int ai = 0; ai < 2; ++ai)
#pragma unroll
            for (int bj = 0; bj < 2; ++bj) {
                uint4 g[4], p[4];
#pragma unroll
                for (int m = 0; m < 4; ++m) g[m] = *(const uint4*)(gb + ((ai * 2 + bj) * 4 + m) * 4096);
                if (bi != 0) {
#pragma unroll
                    for (int m = 0; m < 4; ++m) p[m] = *(const uint4*)(yb + ((ai * 2 + bj) * 4 + m) * 4096);
                } else {
#pragma unroll
                    for (int m = 0; m < 4; ++m) p[m] = make_uint4(0u, 0u, 0u, 0u);
                }
#pragma unroll
                for (int m = 0; m < 4; ++m) { const int k = ((ai * 2 + bj) * 4 + m) * 4096;
                    const f32x4 v0 = acc[ai][bj][m][0], v1 = acc[ai][bj][m][1];
                    const float t[8] = {bf_lo(p[m].x) + bf_lo(g[m].x) * v0[0], bf_hi(p[m].x) + bf_hi(g[m].x) * v0[1], bf_lo(p[m].y) + bf_lo(g[m].y) * v0[2], bf_hi(p[m].y) + bf_hi(g[m].y) * v0[3],
                                        bf_lo(p[m].z) + bf_lo(g[m].z) * v1[0], bf_hi(p[m].z) + bf_hi(g[m].z) * v1[1], bf_lo(p[m].w) + bf_lo(g[m].w) * v1[2], bf_hi(p[m].w) + bf_hi(g[m].w) * v1[3]};
                    if (bi != 2) { uint4 o; o.x = pk_bf16(t[0], t[1]); o.y = pk_bf16(t[2], t[3]); o.z = pk_bf16(t[4], t[5]); o.w = pk_bf16(t[6], t[7]); *(uint4*)(yb + k) = o; }
                    else { const int row = u.row0 + ai * 128 + wr * 64 + m * 16 + fr, col = u.col0 + bj * 128 + wc * 32 + 8 * fq;
                        uint4 o; o.x = pk_bf16(t[0], t[1]); o.y = pk_bf16(t[2], t[3]); o.z = pk_bf16(t[4], t[5]); o.w = pk_bf16(t[6], t[7]);
                        *(uint4*)(Y + (size_t)row * D + col) = o; }
                }
            }
    } };
__device__ __forceinline__ void ph_merge(const Params& P, LAS unsigned char* lds, int l) {
    SchedMerge S{(int)gridDim.x, bid_(), (const char*)(P.ws + WS_BR), (const char*)(P.ws + WS_WBR), l == DEPTH - 1};
    EpiMerge E{(const bf16_t*)(P.ws + WS_GT), (bf16_t*)(P.ws + WS_H), (bf16_t*)(P.ws + WS_Y), (bf16_t*)(P.ws + WS_PG)};
    pg8::gemm_phase(lds, pg8::Gemm{512, BRW, 512}, S, E);
}
struct EpiResid { float* X; const float* mods; int l;
    __device__ __forceinline__ void operator()(const f32x4 (&acc)[2][2][4][2], const pg8::Unit& u, int wr, int wc, int fr, int fq) const {
        const float* gate = mods + ((size_t)l * 9 + row_modrow(u.row0)) * 6144 + 2 * 1024 + u.col0 + wc * 32 + 4 * fq;
        f32x4 gv[2][2];
#pragma unroll
        for (int bj = 0; bj < 2; ++bj)
#pragma unroll
            for (int n = 0; n < 2; ++n) gv[bj][n] = *(const f32x4*)(gate + bj * 128 + n * 16);
#pragma unroll
        for (int ai = 0; ai < 2; ++ai)
#pragma unroll
            for (int mh = 0; mh < 2; ++mh) {
                f32x4 xv[2][2][2];
#pragma unroll
                for (int mm = 0; mm < 2; ++mm)
#pragma unroll
                    for (int bj = 0; bj < 2; ++bj)
#pragma unroll
                        for (int n = 0; n < 2; ++n) xv[mm][bj][n] = *(const f32x4*)(X + (size_t)(u.row0 + ai * 128 + wr * 64 + (mh * 2 + mm) * 16 + fr) * D + u.col0 + bj * 128 + wc * 32 + 4 * fq + n * 16);
#pragma unroll
                for (int mm = 0; mm < 2; ++mm)
#pragma unroll
                    for (int bj = 0; bj < 2; ++bj)
#pragma unroll
                        for (int n = 0; n < 2; ++n) *(f32x4*)(X + (size_t)(u.row0 + ai * 128 + wr * 64 + (mh * 2 + mm) * 16 + fr) * D + u.col0 + bj * 128 + wc * 32 + 4 * fq + n * 16) = xv[mm][bj][n] + gv[bj][n] * acc[ai][bj][mh * 2 + mm][n];
            }
    } };
struct SchedWout { int G, c; const char* A; const char* B; bool last;
    __device__ __forceinline__ bool next(int i, pg8::Unit& u) const {
        const int nc = (!last && c < 32) ? 1 : 0;
        int tile;
        if (i < nc) tile = 256 + c; else { tile = c + (i - nc) * G; if (tile >= 256) return false; }
        const int pm = tile >> 2, pn = tile & 3;
        u.row0 = pm * 256; u.col0 = pn * 256; u.aux = 0; u.A = A + (size_t)pm * 256 * D * 2; u.B = B + (size_t)pn * 256 * D * 2; return true; } };
__device__ __forceinline__ void ph_wout(const Params& P, LAS unsigned char* lds, int l, bool dry = false) {
    const bool last = (l == DEPTH - 1);
    const int c = bid_();
    if (!last && c < 32) {
        const int tid = tid_(), wid = tid >> 6, lane = tid & 63, wr = wid >> 2, wc = wid & 3, fr = lane & 15, fq = lane >> 4;
        const bf16_t* PG = (const bf16_t*)(P.ws + WS_PG); bf16_t* Y = (bf16_t*)(P.ws + WS_Y);
        const int pp = c >> 2;
        for (int pn = 0; pn < 4; ++pn)
#pragma unroll
            for (int kk = 0; kk < 16; ++kk) {
                const size_t off = ((size_t)pp * 4 + pn) * 65536 + kk * 4096 + tid * 8;
                const uint4 a = *(const uint4*)(PG + off), b = *(const uint4*)(PG + (size_t)32 * 65536 + off), d = *(const uint4*)(PG + (size_t)64 * 65536 + off);
                const int ai = kk >> 3, bj = (kk >> 2) & 1, m = kk & 3;
                const int row = (64 + pp) * 256 + ai * 128 + wr * 64 + m * 16 + fr, col = pn * 256 + bj * 128 + wc * 32 + 8 * fq;
                uint4 o;
                o.x = pk_bf16(bf_lo(a.x) + bf_lo(b.x) + bf_lo(d.x), bf_hi(a.x) + bf_hi(b.x) + bf_hi(d.x)); o.y = pk_bf16(bf_lo(a.y) + bf_lo(b.y) + bf_lo(d.y), bf_hi(a.y) + bf_hi(b.y) + bf_hi(d.y));
                o.z = pk_bf16(bf_lo(a.z) + bf_lo(b.z) + bf_lo(d.z), bf_hi(a.z) + bf_hi(b.z) + bf_hi(d.z)); o.w = pk_bf16(bf_lo(a.w) + bf_lo(b.w) + bf_lo(d.w), bf_hi(a.w) + bf_hi(b.w) + bf_hi(d.w));
                *(uint4*)(Y + (size_t)row * D + col) = o;
            }
        asm volatile("s_waitcnt vmcnt(0)" ::: "memory");
        __syncthreads();
    }
    SchedWout S{(int)gridDim.x, c, (const char*)(P.ws + WS_Y), (const char*)(P.ws + WS_WOUT), last};
    EpiResid E{(float*)(P.ws + (dry ? WS_END : WS_X)), (const float*)(P.ws + WS_MODS), l};
    pg8::gemm_phase(lds, pg8::Gemm{D, D, D}, S, E);
}
__device__ __forceinline__ void ph_norm2_route(const Params& P, LAS unsigned char* lds, int l, bool dry = false) {
    const int tid = tid_(), lane = tid & 63, wid = tid >> 6;
    LAS float* Wt = (LAS float*)lds;
    LAS int* lcnt = (LAS int*)(lds + 81920); LAS int* lbase = lcnt + 16; LAS int* rinfo = lbase + 16;
    LAS float* rw = (LAS float*)(rinfo + 128 * 4);
    for (int i = tid; i < 20 * 1024; i += NTHR) { const int j = i >> 10, c = i & 1023;
        Wt[i] = (j < 4) ? P.in[I_WGR][((size_t)l * 1024 + c) * 4 + j] : P.in[I_WER][((size_t)l * 1024 + c) * 16 + (j - 4)]; }
    if (tid < 16) lcnt[tid] = 0;
    __syncthreads();
    const float* xres = (const float*)(P.ws + WS_X);
    bf16_t* f = (bf16_t*)(P.ws + (dry ? WS_END : WS_H));
    const float* g = P.in[I_GFFN] + l * 1024;
    int* cnt = (int*)(P.ws + (dry ? 32768 : WS_CNT)) + l * 16;
    int* sel_e = (int*)(P.ws + (dry ? WS_END + 40000000 : WS_SELE)); float* sel_w = (float*)(P.ws + (dry ? WS_END + 41000000 : WS_SELW)); int* sel_p = (int*)(P.ws + (dry ? WS_END + 42000000 : WS_SELP));
    const int NR = (l == DEPTH - 1) ? NLAT : NTOK;
    const int r0 = bid_() * 8, rstep = gridDim.x * 8;
    int it = 0;
    for (int r = r0 + wid; r < NR; r += rstep, ++it) {
        const float* mod = (const float*)(P.ws + WS_MODS) + ((size_t)l * 9 + row_modrow(r)) * 6144;
        float4 x[4], o[4];
#pragma unroll
        for (int i = 0; i < 4; ++i) x[i] = *(const float4*)(xres + (size_t)r * D + lane * 4 + 256 * i);
        norm_row(x, g, mod + 3 * 1024, mod + 4 * 1024, lane, o);
#pragma unroll
        for (int i = 0; i < 4; ++i) { uint2 u; u.x = pk_bf16(o[i].x, o[i].y); u.y = pk_bf16(o[i].z, o[i].w); *(uint2*)(f + (size_t)r * D + lane * 4 + 256 * i) = u; }
        float lg[20];
#pragma unroll
        for (int j = 0; j < 20; ++j) {
            float s = 0.f;
#pragma unroll
            for (int i = 0; i < 4; ++i) { const f32x4 w = *(const LAS f32x4*)(Wt + j * 1024 + lane * 4 + 256 * i); s += o[i].x * w[0] + o[i].y * w[1] + o[i].z * w[2] + o[i].w * w[3]; }
            lg[j] = wave_sum(s);
        }
        if (lane == 0) {
            float gl[4]; int gi = 0;
#pragma unroll
            for (int j = 0; j < 4; ++j) gl[j] = lg[j] + P.in[I_BGR][l * 4 + j];
            float gm = gl[0];
#pragma unroll
            for (int j = 1; j < 4; ++j) if (gl[j] > gm) { gm = gl[j]; gi = j; }
            float se = 0.f;
#pragma unroll
            for (int j = 0; j < 4; ++j) se += __expf(gl[j] - gm);
            const float pg = __builtin_amdgcn_rcpf(se);
            float el[4];
#pragma unroll
            for (int j = 0; j < 4; ++j) {
                float v = 0.f;
#pragma unroll
                for (int q = 0; q < 4; ++q) v = (gi == q) ? lg[4 + q * 4 + j] : v;
                el[j] = v + P.in[I_BER][l * 16 + gi * 4 + j];
            }
            int i0 = 0; float v0 = el[0];
#pragma unroll
            for (int j = 1; j < 4; ++j) if (el[j] > v0) { v0 = el[j]; i0 = j; }
            int i1 = -1; float v1 = -INFINITY;
#pragma unroll
            for (int j = 0; j < 4; ++j) if (j != i0 && el[j] > v1) { v1 = el[j]; i1 = j; }
            const float w0 = __builtin_amdgcn_rcpf(1.0f + __expf(v1 - v0)), w1 = 1.0f - w0;
            const int e0 = gi * 4 + i0, e1 = gi * 4 + i1;
            const int slot = it * 8 + wid;
            rinfo[slot * 4 + 0] = e0 | (e1 << 8);
            rinfo[slot * 4 + 1] = __hip_atomic_fetch_add(&lcnt[e0], 1, __ATOMIC_RELAXED, __HIP_MEMORY_SCOPE_WORKGROUP);
            rinfo[slot * 4 + 2] = __hip_atomic_fetch_add(&lcnt[e1], 1, __ATOMIC_RELAXED, __HIP_MEMORY_SCOPE_WORKGROUP);
            rw[slot * 2] = w0 * pg; rw[slot * 2 + 1] = w1 * pg;
        }
    }
    __syncthreads();
    if (tid < 16) lbase[tid] = atomicAdd(&cnt[tid], lcnt[tid]);
    __syncthreads();
    for (int slot = tid; slot < 128; slot += NTHR) {
        const int r = r0 + (slot & 7) + (slot >> 3) * rstep;
        if (r < NR) { const int ee = rinfo[slot * 4], e0 = ee & 255, e1 = ee >> 8;
            sel_e[r * 2] = e0; sel_e[r * 2 + 1] = e1;
            sel_w[r * 2] = rw[slot * 2]; sel_w[r * 2 + 1] = rw[slot * 2 + 1];
            sel_p[r * 2] = lbase[e0] + rinfo[slot * 4 + 1]; sel_p[r * 2 + 1] = lbase[e1] + rinfo[slot * 4 + 2]; }
    }
    __syncthreads();
}
__device__ __forceinline__ void moe_offsets(const int* cnt, int (&off)[17]) {
    int a = 0;
#pragma unroll
    for (int e = 0; e < 16; ++e) { off[e] = a; a += (cnt[e] + 255) & ~255; }
    off[16] = a;
}
__device__ __forceinline__ void ph_scatter(const Params& P, int l) {
    const int tid = tid_(), lane = tid & 63, wid = tid >> 6;
    const int* cnt = (const int*)(P.ws + WS_CNT) + l * 16;
    int off[17]; moe_offsets(cnt, off);
    const bf16_t* f = (const bf16_t*)(P.ws + WS_H); bf16_t* Fs = (bf16_t*)(P.ws + WS_FS);
    const int* sel_e = (const int*)(P.ws + WS_SELE); const int* sel_p = (const int*)(P.ws + WS_SELP); int* srow = (int*)(P.ws + WS_SROW);
    for (int r = bid_() * 8 + wid; r < ((l == DEPTH - 1) ? NLAT : NTOK); r += gridDim.x * 8) {
        const uint4 a = *(const uint4*)(f + (size_t)r * D + lane * 8), b = *(const uint4*)(f + (size_t)r * D + 512 + lane * 8);
#pragma unroll
        for (int k = 0; k < 2; ++k) {
            const int e = sel_e[r * 2 + k];
            int o = 0;
#pragma unroll
            for (int q = 0; q < 16; ++q) o = (e == q) ? off[q] : o;
            const int d = o + sel_p[r * 2 + k];
            *(uint4*)(Fs + (size_t)d * D + lane * 8) = a; *(uint4*)(Fs + (size_t)d * D + 512 + lane * 8) = b;
            if (lane == 0) srow[r * 2 + k] = d;
        }
    }
}
struct SchedMoe { int NM, G, c; int tfirst[16]; const char* A; const char* W; size_t tA, eW, tW;
    __device__ __forceinline__ bool next(int i, pg8::Unit& u) const {
        const int L = i * G + c; if (L >= NM * 4) return false;
        const int pm = L >> 2, pn = L & 3;
        int e = 0;
#pragma unroll
        for (int q = 1; q < 16; ++q) e += (pm >= tfirst[q]) ? 1 : 0;
        u.row0 = pm * 256; u.col0 = pn * 256; u.aux = e; u.A = A + (size_t)pm * tA; u.B = W + (size_t)e * eW + (size_t)pn * tW; return true; } };
struct FSwiglu { bf16_t* H;
    __device__ __forceinline__ void operator()(const pg8::Unit&, int row, int col, const f32x4& v0, const f32x4& v1) const {
        const int hc = ((col & ~31) >> 1) + (col & 15);
        uint2 a; a.x = pk_bf16(siluf_(v0[0]) * v1[0], siluf_(v0[1]) * v1[1]); a.y = pk_bf16(siluf_(v0[2]) * v1[2], siluf_(v0[3]) * v1[3]);
        *(uint2*)(H + (size_t)row * EH + hc) = a; } };
__device__ __forceinline__ void moe_sched(const Params& P, int l, SchedMoe& S) {
    const int* cnt = (const int*)(P.ws + WS_CNT) + l * 16;
    int a = 0;
#pragma unroll
    for (int e = 0; e < 16; ++e) { S.tfirst[e] = a; a += (cnt[e] + 255) >> 8; }
    S.NM = a; S.G = (int)gridDim.x; S.c = bid_();
}
__device__ __forceinline__ void ph_moe1(const Params& P, LAS unsigned char* lds, int l) {
    SchedMoe S; moe_sched(P, l, S);
    S.A = (const char*)(P.ws + WS_FS); S.W = (const char*)(P.ws + WS_WGU); S.tA = (size_t)256 * D * 2; S.eW = (size_t)1024 * 1024 * 2; S.tW = (size_t)256 * 1024 * 2;
    pg8::EpiPair<FSwiglu> E{{(bf16_t*)(P.ws + WS_HS)}};
    pg8::gemm_phase(lds, pg8::Gemm{1024, 1024, 1024}, S, E);
}
__device__ __forceinline__ void ph_moe2(const Params& P, LAS unsigned char* lds, int l) {
    SchedMoe S; moe_sched(P, l, S);
    S.A = (const char*)(P.ws + WS_HS); S.W = (const char*)(P.ws + WS_WDN); S.tA = (size_t)256 * EH * 2; S.eW = (size_t)1024 * 512 * 2; S.tW = (size_t)256 * 512 * 2;
    EpiStore16 E{(bf16_t*)(P.ws + WS_YS), D};
    pg8::gemm_phase(lds, pg8::Gemm{512, 512, 512}, S, E);
}
__device__ __forceinline__ void ph_combine(const Params& P, int l, bool dry = false) {
    const int tid = tid_(), lane = tid & 63, wid = tid >> 6;
    float* xres = (float*)(P.ws + WS_X);
    const bf16_t* Ys = (const bf16_t*)(P.ws + WS_YS);
    const float* sel_w = (const float*)(P.ws + WS_SELW); const int* srow = (const int*)(P.ws + WS_SROW);
    bf16_t* h = (bf16_t*)(P.ws + (dry ? WS_END : WS_H));
    for (int r = bid_() * 8 + wid; r < ((l == DEPTH - 1) ? NLAT : NTOK); r += gridDim.x * 8) {
        const float* gate = (const float*)(P.ws + WS_MODS) + ((size_t)l * 9 + row_modrow(r)) * 6144 + 5 * 1024;
        const float w0 = sel_w[r * 2], w1 = sel_w[r * 2 + 1];
        const bf16_t* y0 = Ys + (size_t)srow[r * 2] * D; const bf16_t* y1 = Ys + (size_t)srow[r * 2 + 1] * D;
        float4 x[4];
#pragma unroll
        for (int i = 0; i < 4; ++i) {
            const int c = lane * 4 + 256 * i;
            x[i] = *(const float4*)(xres + (size_t)r * D + c);
            const uint2 a = *(const uint2*)(y0 + c), b = *(const uint2*)(y1 + c);
            const float4 gv = *(const float4*)(gate + c);
            x[i].x += gv.x * (w0 * bf_lo(a.x) + w1 * bf_lo(b.x)); x[i].y += gv.y * (w0 * bf_hi(a.x) + w1 * bf_hi(b.x));
            x[i].z += gv.z * (w0 * bf_lo(a.y) + w1 * bf_lo(b.y)); x[i].w += gv.w * (w0 * bf_hi(a.y) + w1 * bf_hi(b.y));
        }
        if (l < DEPTH - 1) {
#pragma unroll
            for (int i = 0; i < 4; ++i) *(float4*)((dry ? (float*)(P.ws + WS_END) + (size_t)NTOK * 512 : xres) + (size_t)r * D + lane * 4 + 256 * i) = x[i];
            const float* mod = (const float*)(P.ws + WS_MODS) + ((size_t)(l + 1) * 9 + row_modrow(r)) * 6144;
            float4 o[4];
            norm_row(x, P.in[I_GMIX] + (l + 1) * 1024, mod, mod + 1024, lane, o);
#pragma unroll
            for (int i = 0; i < 4; ++i) { uint2 u; u.x = pk_bf16(o[i].x, o[i].y); u.y = pk_bf16(o[i].z, o[i].w); *(uint2*)(h + (size_t)r * D + lane * 4 + 256 * i) = u; }
        } else if (r < NLAT) {
            float ss = 0.f;
#pragma unroll
            for (int i = 0; i < 4; ++i) ss += x[i].x * x[i].x + x[i].y * x[i].y + x[i].z * x[i].z + x[i].w * x[i].w;
            ss = wave_sum(ss);
            const float rstd = __builtin_amdgcn_rsqf(ss * (1.0f / 1024.0f) + 1e-6f);
#pragma unroll
            for (int i = 0; i < 4; ++i) {
                const int c = lane * 4 + 256 * i;
                const float4 gv = *(const float4*)(P.in[I_GFIN] + c);
                float4 o; o.x = x[i].x * rstd * gv.x; o.y = x[i].y * rstd * gv.y; o.z = x[i].z * rstd * gv.z; o.w = x[i].w * rstd * gv.w;
                *(float4*)((dry ? (float*)(P.ws + WS_END) : P.out) + (size_t)r * D + c) = o;
            }
        }
    }
}

constexpr int NPH_LAYER = 12, NPH = 1 + DEPTH * NPH_LAYER;
#define CAS __attribute__((address_space(4)))
__device__ __forceinline__ const Params& kparams() { const CAS Params* k = (const CAS Params*)__builtin_amdgcn_kernarg_segment_ptr(); asm volatile("" : "+s"(k)); return *(const Params*)k; }
__global__ void __launch_bounds__(NTHR, 2) fwd(Params P_) {
    extern __shared__ __attribute__((aligned(16))) unsigned char lds_raw[];
    LAS unsigned char* lds = (LAS unsigned char*)lds_raw;
    volatile LAS unsigned* xbw = (volatile LAS unsigned*)(lds + LDS_BYTES - 16);
    if (threadIdx.x == 0) { xbw[0] = 0u; xbw[1] = 0u; xbw[2] = 0u; xbw[3] = 0u; }
    __syncthreads();
    const int lo = P_.ph_lo, hi = P_.ph_hi;
    XcdBarrier bar; bar.bar = (unsigned*)(P_.ws + WS_BAR); bar.x = 0; bar.st = xbw;
    if (hi - lo > 1) bar = xcd_barrier_post((unsigned*)(P_.ws + WS_BAR), xbw);
#ifndef PHMASK
#define PHMASK 0xFFFF
#endif
#define EN(j) ((PHMASK >> (j)) & 1)
#define IN(k) (lo <= (k) && (k) < hi)
#define SEAM(k) do { if (IN(k) && IN((k) + 1)) xcd_barrier(bar); } while (0)
    if (EN(12) && IN(0)) for (int rep = 0; rep < NREP(12); ++rep) { ph_prologue(kparams(), lds); }
    SEAM(0);
    for (int l = 0; l < DEPTH; ++l) {
        const int p0 = 1 + l * NPH_LAYER;
        if (l == 0) { if (EN(0) && IN(p0 + 0)) for (int rep = 0; rep < NREP(0); ++rep) { ph_wconv(kparams(), lds, l); ph_norm1(kparams(), l); }
        SEAM(p0 + 0); }
        if (EN(1) && IN(p0 + 1)) for (int rep = 0; rep < NREP(1); ++rep) ph_g1(kparams(), lds);
        SEAM(p0 + 1);
        if (EN(2) && IN(p0 + 2)) for (int rep = 0; rep < NREP(2); ++rep) { ph_prep(kparams(), l); ph_navt(kparams(), lds); }
        SEAM(p0 + 2);
        if (EN(3) && IN(p0 + 3)) { ph_mix(kparams(), lds, (char*)lds_raw, l);
            if (REPEAT_MASK & 0x8) { xcd_barrier(bar); ph_mix(kparams(), lds, (char*)lds_raw, l, 1, 0); }
            if (REPEAT_MASK & 0x2000) { xcd_barrier(bar); ph_mix(kparams(), lds, (char*)lds_raw, l, 1, 1); }
            if (REPEAT_MASK & 0x4000) { xcd_barrier(bar); ph_mix(kparams(), lds, (char*)lds_raw, l, 1, 2); }
            if (REPEAT_MASK & 0x8000) { xcd_barrier(bar); ph_mix(kparams(), lds, (char*)lds_raw, l, 1, 3); } }
        SEAM(p0 + 3);
        if (EN(4) && IN(p0 + 4)) for (int rep = 0; rep < NREP(4); ++rep) {
#if defined(DIAG) && DIAG == 5
            { const Params& Pq = kparams(); const int G_ = gridDim.x, c_ = bid_(), vcu_ = (c_ % 8) * (G_ / 8) + c_ / 8; for (int u = vcu_; u < 320; u += G_) na_unit(Pq, lds, l, u, (bf16_t*)(Pq.ws + WS_BR), BRW); __syncthreads(); }
#endif
            ph_readout(kparams(), l);
#if defined(DIAG) && (DIAG == 1 || DIAG == 4)
            ph_diag_cmp(kparams());
#endif
#if defined(DIAG) && DIAG == 3
            { const Params& Pq = kparams(); const uint4* d1 = (const uint4*)(Pq.ws + WS_END); bf16_t* brq = (bf16_t*)(Pq.ws + WS_BR);
              for (size_t i = (size_t)bid_() * NTHR + tid_(); i < (size_t)NTOK * 64; i += (size_t)gridDim.x * NTHR) { const size_t r = i >> 6; const int c8 = (int)(i & 63) * 8; *(uint4*)(brq + r * BRW + c8) = d1[i]; } }
#endif
        }
        SEAM(p0 + 4);
        if (EN(5) && IN(p0 + 5)) for (int rep = 0; rep < NREP(5); ++rep) ph_merge(kparams(), lds, l);
        SEAM(p0 + 5);
        if (EN(6) && IN(p0 + 6)) for (int rep = 0; rep < NREP(6); ++rep) ph_wout(kparams(), lds, l, rep > 0);
        SEAM(p0 + 6);
        if (EN(7) && IN(p0 + 7)) for (int rep = 0; rep < NREP(7); ++rep) ph_norm2_route(kparams(), lds, l, rep > 0);
        SEAM(p0 + 7);
        if (EN(8) && IN(p0 + 8)) for (int rep = 0; rep < NREP(8); ++rep) ph_scatter(kparams(), l);
        SEAM(p0 + 8);
        if (EN(9) && IN(p0 + 9)) for (int rep = 0; rep < NREP(9); ++rep) ph_moe1(kparams(), lds, l);
        SEAM(p0 + 9);
        if (EN(10) && IN(p0 + 10)) for (int rep = 0; rep < NREP(10); ++rep) ph_moe2(kparams(), lds, l);
        SEAM(p0 + 10);
        if (EN(11) && IN(p0 + 11)) for (int rep = 0; rep < NREP(11); ++rep) { ph_combine(kparams(), l, rep > 0); if (l + 1 < DEPTH) ph_wconv(kparams(), lds, l + 1); }
        if (l + 1 < DEPTH) { if (IN(p0 + 11) && IN(p0 + 13)) xcd_barrier(bar); }
    }
#if defined(DIAG) && (DIAG == 1 || DIAG == 4)
    xcd_barrier(bar); ph_diag_out(kparams());
#endif
#undef IN
#undef SEAM
}

#ifndef MK_PER_PHASE
#define MK_PER_PHASE 0
#endif
extern "C" void kernel_launch(void* const* d_in, const int* in_sizes, int n_in, void* d_out, int out_size, void* d_ws, size_t ws_size, hipStream_t stream) {
    static int grid = 0;
    if (grid == 0) {
        if (n_in != 24 || out_size != NLAT * D || ws_size < WS_END + (size_t)NTOK * 4096 + 4096) { fprintf(stderr, "kernel_launch: unexpected shapes (n_in %d out %d ws %zu need %zu)\n", n_in, out_size, ws_size, (size_t)WS_END); grid = -1; return; }
        int dev = 0, cus = 0, per_cu = 0;
        if (hipGetDevice(&dev) != hipSuccess || hipDeviceGetAttribute(&cus, hipDeviceAttributeMultiprocessorCount, dev) != hipSuccess) { grid = -1; return; }
        if (hipFuncSetAttribute((const void*)fwd, hipFuncAttributeMaxDynamicSharedMemorySize, LDS_BYTES) != hipSuccess) { fprintf(stderr, "kernel_launch: hipFuncSetAttribute failed\n"); grid = -1; return; }
        if (hipOccupancyMaxActiveBlocksPerMultiprocessor(&per_cu, (const void*)fwd, NTHR, LDS_BYTES) != hipSuccess || per_cu < 1) { fprintf(stderr, "kernel_launch: occupancy query says %d\n", per_cu); }
        (void)hipGetLastError();
        grid = cus;
    }
    if (grid < 0) return;
    (void)hipMemsetAsync(d_ws, 0, WS_ZERO_BYTES, stream);
    Params p{};
    for (int i = 0; i < 24; ++i) p.in[i] = (const float*)d_in[i];
    p.out = (float*)d_out; p.ws = (unsigned char*)d_ws;
#if MK_PER_PHASE
    for (int ph = 0; ph < NPH; ++ph) { p.ph_lo = ph; p.ph_hi = ph + 1; hipLaunchKernelGGL(fwd, dim3(grid), dim3(NTHR), LDS_BYTES, stream, p); }
#else
    p.ph_lo = 0; p.ph_hi = NPH; hipLaunchKernelGGL(fwd, dim3(grid), dim3(NTHR), LDS_BYTES, stream, p);
#endif
}
```

```cpp
#include <hip/hip_runtime.h>
#include <cstdio>
#include <cstdint>

#define LAS __attribute__((address_space(3)))
typedef unsigned short bf16_t;
typedef short bf16x8 __attribute__((ext_vector_type(8)));
typedef float f32x4 __attribute__((ext_vector_type(4)));
typedef unsigned u32x4 __attribute__((ext_vector_type(4)));

constexpr int D = 1024, NB = 8, SEQ = 2048, DEPTH = 4, CTXL = 256;
constexpr int NLAT = NB * SEQ, NCTX = NB * CTXL, NTOK = NLAT + NCTX;
constexpr int INC = 7936;
constexpr int ZP = 4864;
constexpr int C_NAQ = 0, C_NAK = 512, C_NAV = 1024, C_HQ = 1536, C_HFF = 2048, C_HFB = 2560, C_HI = 3072, C_HG = 3584,
              C_GQ = 4096, C_GK = 4608, C_GV = 4736, C_GATE = 4864;
constexpr int BRW = 1536;
constexpr int NEXP = 16, EH = 512;
constexpr int MPAD = 40960;
constexpr int NTHR = 512;
constexpr int LDS_BYTES = 147456;

constexpr size_t WS_BAR = 0;
constexpr size_t WS_CNT = 16384;
constexpr size_t WS_ZERO_BYTES = 65536;
constexpr size_t WS_MODS = 65536;
constexpr size_t WS_LB = WS_MODS + 884736;
constexpr size_t WS_ROPE = WS_LB + 16384;
constexpr size_t WS_SELE = WS_ROPE + 12288;
constexpr size_t WS_SELW = WS_SELE + 147456;
constexpr size_t WS_SELP = WS_SELW + 147456;
constexpr size_t WS_SROW = WS_SELP + 147456;
constexpr size_t WS_X = 2097152;
constexpr size_t WS_H = WS_X + (size_t)NTOK * D * 4;
constexpr size_t WS_Z = WS_H + (size_t)NTOK * D * 2;
constexpr size_t WS_GT = WS_Z + (size_t)NTOK * ZP * 2;
constexpr size_t WS_BR = WS_GT + (size_t)NTOK * 3072 * 2;
constexpr size_t WS_Y = WS_BR + (size_t)NTOK * BRW * 2;
constexpr size_t WS_QN = WS_Y + (size_t)NTOK * D * 2;
constexpr size_t WS_KN = WS_QN + (size_t)NTOK * 512 * 2;
constexpr size_t WS_VN = WS_KN + (size_t)NTOK * 128 * 2;
constexpr size_t WS_NAVT = WS_VN + (size_t)NTOK * 128 * 2;
constexpr size_t WS_WIN = WS_NAVT + (size_t)NTOK * 512 * 2;
constexpr size_t WS_WBR = WS_WIN + (size_t)INC * D * 2;
constexpr size_t WS_WOUT = WS_WBR + (size_t)3 * D * 512 * 2;
constexpr size_t WS_WGU = WS_WOUT + (size_t)D * D * 2;
constexpr size_t WS_WDN = WS_WGU + (size_t)NEXP * 1024 * 1024 * 2;
constexpr size_t WS_PG = WS_WDN + (size_t)NEXP * 1024 * 512 * 2;
constexpr size_t WS_END = WS_PG + (size_t)96 * 65536 * 2;
constexpr size_t WS_FS = WS_Z;
constexpr size_t WS_HS = WS_FS + (size_t)MPAD * 1024 * 2;
constexpr size_t WS_YS = WS_HS + (size_t)MPAD * 512 * 2;
static_assert(WS_YS + (size_t)MPAD * 1024 * 2 <= WS_BR, "moe alias");
constexpr size_t WS_RT = WS_SROW + 147456;
static_assert(WS_RT + 327680 <= WS_X, "ctl");

#define XB_TMO      128
#define XB_XCNT(j)  (256  + 64 * (j))
#define XB_XSUB(j)  (1280 + 64 * (j))
#define XB_XGEN(j)  (2304 + 64 * (j))
#define XB_TOP      3328
#define XB_TOPGEN   3392
#define XCD_BAR_WORDS 3456
#define XB_SPIN_CAP (1u << 22)
__device__ __forceinline__ unsigned xb_ld(unsigned* p)              { return __hip_atomic_load(p, __ATOMIC_RELAXED, __HIP_MEMORY_SCOPE_AGENT); }
__device__ __forceinline__ unsigned xb_add(unsigned* p, unsigned v) { return __hip_atomic_fetch_add(p, v, __ATOMIC_RELAXED, __HIP_MEMORY_SCOPE_AGENT); }
__device__ __forceinline__ unsigned xb_xcc_id() { return (unsigned)__builtin_amdgcn_s_getreg((3 << 11) | 20) & 0xFu; }
#define XB_SPIN(cond, bar) do { unsigned _sp = 0; while (cond) { __builtin_amdgcn_s_sleep(1); \
    if ((++_sp & 255u) == 0u) { if (xb_ld(&(bar)[XB_TMO])) break; if (_sp > XB_SPIN_CAP) { atomicAdd(&(bar)[XB_TMO], 1u); break; } } } } while (0)
struct XcdBarrier { unsigned* bar; unsigned x; volatile LAS unsigned* st; };
__device__ __forceinline__ XcdBarrier xcd_barrier_post(unsigned* bar, volatile LAS unsigned* st) {
    XcdBarrier b; b.bar = bar; b.x = xb_xcc_id(); b.st = st;
    if (threadIdx.x == 0) (void)xb_add(&bar[XB_XCNT(b.x)], 1u);
    return b;
}
__device__ __forceinline__ void xcd_barrier_complete(unsigned* bar, unsigned x, unsigned& nloc, unsigned& nx) {
    const unsigned G = gridDim.x * gridDim.y * gridDim.z;
    unsigned sum, cnt, mine, sp = 0u;
    for (;;) {
        sum = 0u; cnt = 0u; mine = 0u;
#pragma unroll
        for (unsigned j = 0; j < 16; ++j) { const unsigned c = xb_ld(&bar[XB_XCNT(j)]); sum += c; cnt += (c > 0u) ? 1u : 0u; mine = (j == x) ? c : mine; }
        if (sum == G) break;
        __builtin_amdgcn_s_sleep(1);
        if ((++sp & 255u) == 0u) { if (xb_ld(&bar[XB_TMO])) break; if (sp > XB_SPIN_CAP) { atomicAdd(&bar[XB_TMO], 1u); break; } }
    }
    nloc = mine > 0u ? mine : 1u; nx = cnt > 0u ? cnt : 1u;
}
__device__ __forceinline__ void xcd_barrier(const XcdBarrier& b) {
    asm volatile("s_waitcnt vmcnt(0)" ::: "memory");
    __syncthreads();
    if (threadIdx.x == 0) {
        unsigned* bar = b.bar;
        __builtin_amdgcn_s_waitcnt(0);
        unsigned nloc = b.st[0], nx = b.st[1];
        if (nloc == 0u) { xcd_barrier_complete(bar, b.x, nloc, nx); b.st[0] = nloc; b.st[1] = nx; }
        const unsigned old = xb_add(&bar[XB_XSUB(b.x)], 1u);
        const unsigned gen = old / nloc;
        if (old + 1u == (gen + 1u) * nloc) {
            __builtin_amdgcn_fence(__ATOMIC_RELEASE, "agent");
            asm volatile("s_waitcnt vmcnt(0)" ::: "memory");
            const unsigned og = xb_add(&bar[XB_TOP], 1u);
            const unsigned tg = og / nx;
            if (og + 1u == (tg + 1u) * nx) xb_add(&bar[XB_TOPGEN], 1u);
            else XB_SPIN(xb_ld(&bar[XB_TOPGEN]) == tg, bar);
            __builtin_amdgcn_fence(__ATOMIC_ACQUIRE, "agent");
            xb_add(&bar[XB_XGEN(b.x)], 1u);
            asm volatile("s_waitcnt vmcnt(0)" ::: "memory");
        } else {
            XB_SPIN(xb_ld(&bar[XB_XGEN(b.x)]) == gen, bar);
            __builtin_amdgcn_fence(__ATOMIC_ACQUIRE, "agent");
            asm volatile("s_waitcnt vmcnt(0)" ::: "memory");
        }
    }
    __syncthreads();
}

__device__ __forceinline__ float bf_lo(unsigned u) { return __uint_as_float(u << 16); }
__device__ __forceinline__ float bf_hi(unsigned u) { return __uint_as_float(u & 0xffff0000u); }
__device__ __forceinline__ float bf2f(bf16_t b) { return __uint_as_float(((unsigned)b) << 16); }
typedef float pkf32x2_t __attribute__((ext_vector_type(2))); typedef __bf16 pkbf16x2_t __attribute__((ext_vector_type(2)));
__device__ __forceinline__ unsigned pk_bf16(float lo, float hi) { pkf32x2_t v = {lo, hi}; pkbf16x2_t b = __builtin_convertvector(v, pkbf16x2_t); return __builtin_bit_cast(unsigned, b); }
__device__ __forceinline__ bf16x8 pack8(const float (&v)[8]) { u32x4 u = {pk_bf16(v[0], v[1]), pk_bf16(v[2], v[3]), pk_bf16(v[4], v[5]), pk_bf16(v[6], v[7])}; return __builtin_bit_cast(bf16x8, u); }
__device__ __forceinline__ float sigmoidf_(float x) { return __builtin_amdgcn_rcpf(1.0f + __expf(-x)); }
__device__ __forceinline__ float siluf_(float x) { return x * __builtin_amdgcn_rcpf(1.0f + __expf(-x)); }
__device__ __forceinline__ float dpp_f(float v, const int ctrl_sel) {
    const int x = __float_as_int(v);
    int r;
    if (ctrl_sel == 0) r = __builtin_amdgcn_update_dpp(0, x, 0xB1, 0xF, 0xF, true);
    else if (ctrl_sel == 1) r = __builtin_amdgcn_update_dpp(0, x, 0x4E, 0xF, 0xF, true);
    else if (ctrl_sel == 2) r = __builtin_amdgcn_update_dpp(0, x, 0x141, 0xF, 0xF, true);
    else r = __builtin_amdgcn_update_dpp(0, x, 0x140, 0xF, 0xF, true);
    return __int_as_float(r);
}
__device__ __forceinline__ float wave_sum(float v) {
    v += dpp_f(v, 0); v += dpp_f(v, 1); v += dpp_f(v, 2); v += dpp_f(v, 3);
    { auto rr = __builtin_amdgcn_permlane16_swap(__float_as_uint(v), __float_as_uint(v), false, false); v = __uint_as_float(rr[0]) + __uint_as_float(rr[1]); }
    { auto rr = __builtin_amdgcn_permlane32_swap(__float_as_uint(v), __float_as_uint(v), false, false); v = __uint_as_float(rr[0]) + __uint_as_float(rr[1]); }
    return v;
}

__device__ __forceinline__ int tid_() { int t = threadIdx.x; asm volatile("" : "+v"(t)); return t; }
__device__ __forceinline__ int bid_() { int t = blockIdx.x; asm volatile("" : "+s"(t)); return t; }
#ifndef REPEAT_MASK
#define REPEAT_MASK 0
#endif
#define NREP(j) (((REPEAT_MASK >> (j)) & 1) ? 2 : 1)
struct Params {
    const float* in[24];
    float* out;
    unsigned char* ws;
    int ph_lo, ph_hi;
};
enum { I_X = 0, I_C, I_CTX, I_CCTX, I_WADA, I_BADA, I_GMIX, I_GFFN, I_WIN, I_RPB, I_LBL, I_HGN, I_QNG, I_KNG, I_WBR, I_WOUT,
       I_WGR, I_BGR, I_WER, I_BER, I_WEG, I_WEU, I_WED, I_GFIN };

__device__ __forceinline__ void g128_kloop(f32x4 (&acc)[4][4], LAS unsigned char* lds, const bf16_t* A, int lda, const bf16_t* Bt, int ldb, int K) {
    const int tid = tid_(), wid = tid >> 6, lane = tid & 63, wr = wid >> 2, wc = wid & 3, fr = lane & 15, fq = lane >> 4;
    LAS unsigned char* SA = lds; LAS unsigned char* SB = lds + 8192;
    const int srow = tid >> 2, skc = (tid & 3) * 8;
    const bf16_t* ap = A + (size_t)srow * lda + skc;
    const bf16_t* bp0 = Bt + (size_t)srow * ldb + skc;
    const bf16_t* bp1 = Bt + (size_t)(srow + 128) * ldb + skc;
    for (int k0 = 0; k0 < K; k0 += 32) {
        const uint4 va = *(const uint4*)(ap + k0);
        const uint4 vb0 = *(const uint4*)(bp0 + k0);
        const uint4 vb1 = *(const uint4*)(bp1 + k0);
        __syncthreads();
        *(LAS u32x4*)(SA + tid * 16) = (u32x4){va.x, va.y, va.z, va.w};
        *(LAS u32x4*)(SB + tid * 16) = (u32x4){vb0.x, vb0.y, vb0.z, vb0.w};
        *(LAS u32x4*)(SB + 8192 + tid * 16) = (u32x4){vb1.x, vb1.y, vb1.z, vb1.w};
        __syncthreads();
        bf16x8 At[4], Bf[4];
#pragma unroll
        for (int m = 0; m < 4; ++m) At[m] = *(const LAS bf16x8*)(SA + ((wr * 64 + m * 16 + fr) * 32 + fq * 8) * 2);
#pragma unroll
        for (int n = 0; n < 4; ++n) Bf[n] = *(const LAS bf16x8*)(SB + ((wc * 64 + n * 16 + fr) * 32 + fq * 8) * 2);
#pragma unroll
        for (int m = 0; m < 4; ++m)
#pragma unroll
            for (int n = 0; n < 4; ++n) acc[m][n] = __builtin_amdgcn_mfma_f32_16x16x32_bf16(Bf[n], At[m], acc[m][n], 0, 0, 0);
    }
}
__device__ __forceinline__ void acc_zero(f32x4 (&acc)[4][4]) {
#pragma unroll
    for (int m = 0; m < 4; ++m)
#pragma unroll
        for (int n = 0; n < 4; ++n) acc[m][n] = (f32x4){0.f, 0.f, 0.f, 0.f};
}
template <class Epi>
__device__ __forceinline__ void g128_epilogue(const f32x4 (&acc)[4][4], int row0, int col0, const Epi& E) {
    const int tid = tid_(), wid = tid >> 6, lane = tid & 63, wr = wid >> 2, wc = wid & 3, fr = lane & 15, fq = lane >> 4;
#pragma unroll
    for (int m = 0; m < 4; ++m)
#pragma unroll
        for (int n = 0; n < 4; n += 2) E(row0 + wr * 64 + m * 16 + fr, col0 + wc * 64 + n * 16 + fq * 4, acc[m][n], acc[m][n + 1]);
}


namespace pg8 {
constexpr int BM = 256, BK = 64, HALF = 128, HTB = HALF * BK * 2, STAGE_BYTES = 8 * HTB;
__device__ __forceinline__ int lds_byte(int r, int c) { const int st = (r >> 4) * 2 + (c >> 5), rr = r & 15, cc = c & 31, ob = rr * 64 + cc * 2; return st * 1024 + (ob ^ (((ob >> 9) & 1) << 5)); }
__device__ __forceinline__ void stage_rc(int b, int& R, int& C) { const int st = b / 1024, sb = b % 1024, swz = sb ^ (((sb >> 9) & 1) << 5); R = (st >> 1) * 16 + swz / 64; C = (st & 1) * 32 + (swz % 64) / 2; }
struct Unit { int row0, col0, aux; const char* A; const char* B; };
struct Gemm { int K, lda, ldb; };
template <class Epi, class Sched>
__device__ __forceinline__ void gemm_phase(LAS unsigned char* lds, const Gemm g, const Sched& S, const Epi& E) {
    const int tid = tid_(), wid = __builtin_amdgcn_readfirstlane(tid >> 6), lane = tid & 63, wr = wid >> 2, wc = wid & 3, fr = lane & 15, fq = lane >> 4;
    const int K = g.K, nt = K / BK;
    unsigned voffA[2], voffB[2];
#pragma unroll
    for (int i = 0; i < 2; ++i) { int R, C; stage_rc(tid * 16 + i * 8192, R, C);
        voffA[i] = (unsigned)(R * g.lda + C) * 2u; voffB[i] = (unsigned)(R * g.ldb + C) * 2u; }
    const size_t kstep = (size_t)(BK * 2);
    const size_t hstepA = (size_t)HALF * g.lda * 2, hstepB = (size_t)HALF * g.ldb * 2;
    const unsigned ldsw = (unsigned)wid * 1024u;
    const int aoff = lds_byte(wr * 64 + fr, fq * 8), boff = lds_byte(wc * 32 + fr, fq * 8);
#define PG8_SA(b, h) (((b) * 2 + (h)) * HTB)
#define PG8_SB(b, h) ((4 + (b) * 2 + (h)) * HTB)
#define PG8_STAGE(bufoff, gbase, voff) do { _Pragma("unroll") for (int _i = 0; _i < 2; ++_i) \
        __builtin_amdgcn_global_load_lds((const unsigned*)((const char*)(gbase) + (voff)[_i]), (LAS unsigned*)(lds + (bufoff) + ldsw + _i * 8192), 16, 0, 0); } while (0)
#define PG8_LDA(dst, b, h) do { _Pragma("unroll") for (int m = 0; m < 4; ++m) _Pragma("unroll") for (int k = 0; k < 2; ++k) dst[m][k] = *(const LAS bf16x8*)(lds + PG8_SA(b, h) + aoff + m * 2048 + k * 1024); } while (0)
#define PG8_LDB(dst, b, h) do { _Pragma("unroll") for (int n = 0; n < 2; ++n) _Pragma("unroll") for (int k = 0; k < 2; ++k) dst[n][k] = *(const LAS bf16x8*)(lds + PG8_SB(b, h) + boff + n * 2048 + k * 1024); } while (0)
#define PG8_MMA(ai, bj, At, Bt) do { __builtin_amdgcn_s_setprio(1); _Pragma("unroll") for (int m = 0; m < 4; ++m) _Pragma("unroll") for (int n = 0; n < 2; ++n) _Pragma("unroll") for (int k = 0; k < 2; ++k) \
        acc[ai][bj][m][n] = __builtin_amdgcn_mfma_f32_16x16x32_bf16(Bt[n][k], At[m][k], acc[ai][bj][m][n], 0, 0, 0); __builtin_amdgcn_s_setprio(0); } while (0)
#define PG8_WAIT_V(n) asm volatile("s_waitcnt vmcnt(" #n ")" ::: "memory")
#define PG8_WAIT_L(n) asm volatile("s_waitcnt lgkmcnt(" #n ")" ::: "memory")
#define PG8_BAR __builtin_amdgcn_s_barrier()
#define PG8_SCHED __builtin_amdgcn_sched_barrier(0)
    Unit cur, nxt; int ui = 0;
    if (!S.next(0, cur)) return;
    f32x4 acc[2][2][4][2];
#pragma unroll
    for (int a = 0; a < 2; ++a)
#pragma unroll
        for (int b = 0; b < 2; ++b)
#pragma unroll
            for (int m = 0; m < 4; ++m)
#pragma unroll
                for (int n = 0; n < 2; ++n) acc[a][b][m][n] = (f32x4){0.f, 0.f, 0.f, 0.f};
    bf16x8 At[4][2], B0[2][2], B1[2][2];
    const char* cA = cur.A; const char* cB = cur.B;
    PG8_STAGE(PG8_SB(0, 0), cB, voffB); PG8_STAGE(PG8_SA(0, 0), cA, voffA); PG8_STAGE(PG8_SB(0, 1), cB + hstepB, voffB); PG8_STAGE(PG8_SA(0, 1), cA + hstepA, voffA);
    if (wr == 1) PG8_BAR;
    PG8_WAIT_V(4); PG8_BAR;
    PG8_STAGE(PG8_SB(1, 0), cB + kstep, voffB); PG8_STAGE(PG8_SA(1, 0), cA + kstep, voffA); PG8_STAGE(PG8_SB(1, 1), cB + hstepB + kstep, voffB);
    PG8_WAIT_V(6); PG8_BAR;
    for (;;) {
        const bool has_next = S.next(ui + 1, nxt);
        const char* nA = has_next ? nxt.A : cA; const char* nB = has_next ? nxt.B : cB;
        for (int t = 0; t < nt; t += 2) {
            const bool last = (t == nt - 2);
            const char* a1 = cA + (size_t)(t + 1) * kstep;
            const char* a2 = last ? nA : cA + (size_t)(t + 2) * kstep; const char* b2 = last ? nB : cB + (size_t)(t + 2) * kstep;
            const char* a3 = a2 + kstep; const char* b3 = b2 + kstep;
            PG8_LDB(B0, 0, 0); PG8_SCHED; PG8_LDA(At, 0, 0); PG8_STAGE(PG8_SA(1, 1), a1 + hstepA, voffA);
            PG8_WAIT_L(8); PG8_BAR; PG8_WAIT_L(0); PG8_MMA(0, 0, At, B0); PG8_BAR; PG8_SCHED;
            PG8_LDB(B1, 0, 1); PG8_STAGE(PG8_SB(0, 0), b2, voffB);
            PG8_BAR; PG8_WAIT_L(0); PG8_MMA(0, 1, At, B1); PG8_BAR;
            PG8_LDA(At, 0, 1); PG8_STAGE(PG8_SA(0, 0), a2, voffA);
            PG8_BAR; PG8_WAIT_L(0); PG8_MMA(1, 0, At, B0); PG8_BAR; PG8_SCHED;
            PG8_STAGE(PG8_SB(0, 1), b2 + hstepB, voffB);
            PG8_WAIT_V(6); PG8_BAR; PG8_MMA(1, 1, At, B1); PG8_BAR;
            PG8_LDB(B0, 1, 0); PG8_SCHED; PG8_LDA(At, 1, 0); PG8_STAGE(PG8_SA(0, 1), a2 + hstepA, voffA);
            PG8_WAIT_L(8); PG8_BAR; PG8_WAIT_L(0); PG8_MMA(0, 0, At, B0); PG8_BAR; PG8_SCHED;
            PG8_LDB(B1, 1, 1); PG8_STAGE(PG8_SB(1, 0), b3, voffB);
            PG8_BAR; PG8_WAIT_L(0); PG8_MMA(0, 1, At, B1); PG8_BAR;
            PG8_LDA(At, 1, 1); PG8_STAGE(PG8_SA(1, 0), a3, voffA);
            PG8_BAR; PG8_WAIT_L(0); PG8_MMA(1, 0, At, B0); PG8_BAR; PG8_SCHED;
            PG8_STAGE(PG8_SB(1, 1), b3 + hstepB, voffB);
            PG8_WAIT_V(6); PG8_BAR; PG8_MMA(1, 1, At, B1); PG8_BAR;
        }
        E(acc, cur, wr, wc, fr, fq);
        if (!has_next) break;
#pragma unroll
        for (int a = 0; a < 2; ++a)
#pragma unroll
            for (int b = 0; b < 2; ++b)
#pragma unroll
                for (int m = 0; m < 4; ++m)
#pragma unroll
                    for (int n = 0; n < 2; ++n) acc[a][b][m][n] = (f32x4){0.f, 0.f, 0.f, 0.f};
        cur = nxt; cA = nA; cB = nB; ++ui;
    }
    PG8_WAIT_V(0);
    if (wr == 0) PG8_BAR;
    PG8_BAR;
#undef PG8_SA
#undef PG8_SB
#undef PG8_STAGE
#undef PG8_LDA
#undef PG8_LDB
#undef PG8_MMA
#undef PG8_WAIT_V
#undef PG8_WAIT_L
#undef PG8_BAR
#undef PG8_SCHED
}
template <class F> struct EpiPair { F f;
    __device__ __forceinline__ void operator()(const f32x4 (&acc)[2][2][4][2], const Unit& u, int wr, int wc, int fr, int fq) const {
#pragma unroll
        for (int ai = 0; ai < 2; ++ai)
#pragma unroll
            for (int m = 0; m < 4; ++m)
#pragma unroll
                for (int bj = 0; bj < 2; ++bj) f(u, u.row0 + ai * HALF + wr * 64 + m * 16 + fr, u.col0 + bj * HALF + wc * 32 + 4 * fq, acc[ai][bj][m][0], acc[ai][bj][m][1]);
    } };
struct SchedDense { int nM, nN, G, c; const char* A; const char* B; size_t tA, tB;
    __device__ __forceinline__ bool next(int i, Unit& u) const {
        const int nwg = nM * nN; const long L = (long)i * G + c; if (L >= nwg) return false;
        int wgid = (int)L; { const int q = nwg / 8, r = nwg % 8, xcd = wgid % 8, off = wgid / 8; wgid = (xcd < r ? xcd * (q + 1) : r * (q + 1) + (xcd - r) * q) + off; }
        const int nig = 8 * nN, gid = wgid / nig, fm = gid * 8, gsz = (nM - fm) < 8 ? (nM - fm) : 8;
        const int pm = fm + ((wgid % nig) % gsz), pn = (wgid % nig) / gsz;
        u.row0 = pm * 256; u.col0 = pn * 256; u.aux = 0; u.A = A + (size_t)pm * tA; u.B = B + (size_t)pn * tB; return true; } };
}


namespace gqa {
using f32x16 = __attribute__((ext_vector_type(16))) float;
using s16x4 = __attribute__((ext_vector_type(4))) short;
constexpr int QP = 512, KVP = 128, OP = BRW;
constexpr int NW = 8, QBLK = 32, KVBLK = 64;
__device__ __forceinline__ int crow(int r, int hi) { return (r & 3) + 8 * (r >> 2) + 4 * hi; }
#define SBAR() __builtin_amdgcn_sched_barrier(0)
constexpr int NSLOT = 3, SLOTB = 8192;
constexpr int LDS_K = 0, LDS_V = NSLOT * SLOTB, LDS_WS = 2 * NSLOT * SLOTB, LDS_OST = LDS_WS + NW * 64 * 4, LDS_BYTES_ = LDS_OST + NW * 4096;
__device__ __forceinline__ void glds16(const void* gsrc, unsigned lds_dst) { unsigned keep;
  asm volatile("s_mov_b32 %0, m0\n\ts_mov_b32 m0, %2\n\ts_nop 0\n\tglobal_load_lds_dwordx4 %1, off\n\ts_mov_b32 m0, %0" : "=&s"(keep) : "v"(gsrc), "s"(lds_dst) : "memory"); }
__device__ __forceinline__ float max3f(float a, float b, float c) { float r; asm("v_max3_f32 %0, %1, %2, %3" : "=v"(r) : "v"(a), "v"(b), "v"(c)); return r; }
__device__ __forceinline__ float max2f(float a, float b) { float r; asm("v_max_f32_e32 %0, %1, %2" : "=v"(r) : "v"(a), "v"(b)); return r; }
__device__ __forceinline__ float fadd_s(float a, float b) { float r; asm("v_add_f32_e32 %0, %1, %2" : "=v"(r) : "v"(a), "v"(b)); return r; }
__device__ __forceinline__ float fsub_s(float a, float b) { float r; asm("v_sub_f32_e32 %0, %1, %2" : "=v"(r) : "v"(a), "v"(b)); return r; }
typedef float f32x2_t __attribute__((ext_vector_type(2))); typedef __bf16 bf16x2_t __attribute__((ext_vector_type(2)));
__device__ __forceinline__ unsigned cvtpk_s(float lo, float hi) { f32x2_t v = {lo, hi}; bf16x2_t b = __builtin_convertvector(v, bf16x2_t); return __builtin_bit_cast(unsigned, b); }
#define WAIT_BAR(N) asm volatile("s_waitcnt vmcnt(" #N ") lgkmcnt(0)\n\ts_barrier" ::: "memory")
__device__ __forceinline__ void qkt(f32x16& p0, f32x16& p1, const char* Kslot, const bf16x8* qr, const f32x16& negm, int r32, int hi) {
  const char* kb = Kslot + hi * 1024 + r32 * 16;
  #pragma unroll
  for (int d0 = 0; d0 < 4; ++d0) {
    const bf16x8 b0 = *reinterpret_cast<const bf16x8*>(kb + d0 * 2048);
    const bf16x8 b1 = *reinterpret_cast<const bf16x8*>(kb + d0 * 2048 + 512);
    if (d0 == 0) { p0 = __builtin_amdgcn_mfma_f32_32x32x16_bf16(b0, qr[0], negm, 0, 0, 0); p1 = __builtin_amdgcn_mfma_f32_32x32x16_bf16(b1, qr[0], negm, 0, 0, 0); }
    else { p0 = __builtin_amdgcn_mfma_f32_32x32x16_bf16(b0, qr[d0], p0, 0, 0, 0); p1 = __builtin_amdgcn_mfma_f32_32x32x16_bf16(b1, qr[d0], p1, 0, 0, 0); } }
}
typedef __attribute__((address_space(3))) const char* lds_cptr;
typedef short v4i16_t __attribute__((ext_vector_type(4)));
__device__ __forceinline__ void kload8(bf16x8* kf, lds_cptr kp) {
  kf[0] = *(const LAS bf16x8*)(kp);        kf[1] = *(const LAS bf16x8*)(kp + 512);
  kf[2] = *(const LAS bf16x8*)(kp + 2048); kf[3] = *(const LAS bf16x8*)(kp + 2560);
  kf[4] = *(const LAS bf16x8*)(kp + 4096); kf[5] = *(const LAS bf16x8*)(kp + 4608);
  kf[6] = *(const LAS bf16x8*)(kp + 6144); kf[7] = *(const LAS bf16x8*)(kp + 6656);
}
__device__ __forceinline__ void kload2(bf16x8* kf, lds_cptr kp, int j) { kf[2 * j] = *(const LAS bf16x8*)(kp + j * 2048); kf[2 * j + 1] = *(const LAS bf16x8*)(kp + j * 2048 + 512); }
__device__ __forceinline__ s16x4 vtr(lds_cptr p) { return __builtin_bit_cast(s16x4, __builtin_amdgcn_ds_read_tr16_b64_v4i16((LAS v4i16_t*)p)); }
__device__ __forceinline__ float rowmax(const f32x16& p0, const f32x16& p1) {
  float a = max3f(p0[0], p0[1], p1[0]), b = max3f(p0[2], p0[3], p1[1]); a = max3f(a, p1[2], p1[3]);
  #pragma unroll
  for (int r = 4; r < 16; r += 4) { a = max3f(a, p0[r], p0[r + 1]); b = max3f(b, p0[r + 2], p0[r + 3]); a = max3f(a, p1[r], p1[r + 1]); b = max3f(b, p1[r + 2], p1[r + 3]); }
  const float m = max2f(a, b);
  auto rr = __builtin_amdgcn_permlane32_swap(__float_as_uint(m), __float_as_uint(m), false, false);
  return max2f(__uint_as_float(rr[0]), __uint_as_float(rr[1]));
}
__device__ __forceinline__ void pv(f32x16* o, int vb, bf16x8 pa0, bf16x8 pa1, bf16x8 pa2, bf16x8 pa3) {
  #pragma unroll
  for (int d0 = 0; d0 < 2; ++d0) { s16x4 lo[4], hi[4];
    #pragma unroll
    for (int ks = 0; ks < 4; ++ks) {
      asm volatile("ds_read_b64_tr_b16 %0,%1 offset:%c2" : "=&v"(lo[ks]) : "v"(vb), "i"(d0 * 4096 + ks * 1024) : "memory");
      asm volatile("ds_read_b64_tr_b16 %0,%1 offset:%c2" : "=&v"(hi[ks]) : "v"(vb), "i"(d0 * 4096 + ks * 1024 + 512) : "memory"); }
    asm volatile("s_waitcnt lgkmcnt(0)" ::: "memory"); SBAR();
    #define PK(k) (bf16x8){lo[k][0], lo[k][1], lo[k][2], lo[k][3], hi[k][0], hi[k][1], hi[k][2], hi[k][3]}
    o[d0] = __builtin_amdgcn_mfma_f32_32x32x16_bf16(pa0, PK(0), o[d0], 0, 0, 0);
    o[d0] = __builtin_amdgcn_mfma_f32_32x32x16_bf16(pa1, PK(1), o[d0], 0, 0, 0);
    o[d0] = __builtin_amdgcn_mfma_f32_32x32x16_bf16(pa2, PK(2), o[d0], 0, 0, 0);
    o[d0] = __builtin_amdgcn_mfma_f32_32x32x16_bf16(pa3, PK(3), o[d0], 0, 0, 0);
    #undef PK
  }
}
template <int THRL> __device__ __forceinline__ void attn_unit(const bf16_t* Qu, const float* qgain, const float* rope, const int tok0, const bf16_t* __restrict__ Kh, const bf16_t* __restrict__ Vh, bf16_t* Ou, const int NT, char* shm) {
  const int tid = tid_(), lane = tid & 63, r32 = lane & 31, hi = lane >> 5; const int wid = __builtin_amdgcn_readfirstlane(tid >> 6);
  const bf16_t* Qw = Qu + (long)wid * QBLK * ZP;
  const unsigned lds0 = (unsigned)(uintptr_t)shm;
  float* wsf = (float*)(shm + LDS_WS) + wid * 64;
  const bf16_t* ksrc = Kh + (long)lane * KVP + wid * 8;
  const bf16_t* vsrc = Vh + (long)(16 * (wid & 3) + (lane >> 2)) * KVP + (wid >> 2) * 32 + (lane & 3) * 8;
  const unsigned kdst = lds0 + LDS_K + wid * 1024, vdst = lds0 + LDS_V + wid * 1024;
  #define DMA_K(t, slot) glds16(ksrc + (long)(t) * KVBLK * KVP, (unsigned)__builtin_amdgcn_readfirstlane(kdst + (slot)))
  #define DMA_V(t, slot) glds16(vsrc + (long)(t) * KVBLK * KVP, (unsigned)__builtin_amdgcn_readfirstlane(vdst + (slot)))
  const int vb0 = (int)(lds0 + LDS_V) + ((lane >> 4) & 1) * 32 + (lane & 3) * 8 + (4 * hi + ((lane & 15) >> 2)) * 64;
  const char* Kbase = shm + LDS_K; bf16x8 kf[8];
  const lds_cptr shm3 = (lds_cptr)shm; const lds_cptr kp0 = shm3 + LDS_K + hi * 1024 + r32 * 16; const lds_cptr vp0 = shm3 + LDS_V + ((lane >> 4) & 1) * 32 + (lane & 3) * 8 + (4 * hi + ((lane & 15) >> 2)) * 64;
  DMA_K(0, 0); DMA_V(0, 0); DMA_K(1, SLOTB);
  bf16x8 qr[4];
  { float xq[4][8]; float ss = 0.f;
    #pragma unroll
    for (int d0 = 0; d0 < 4; ++d0) { const uint4 rw = *reinterpret_cast<const uint4*>(&Qw[(long)r32 * ZP + d0 * 16 + hi * 8]);
      xq[d0][0] = bf_lo(rw.x); xq[d0][1] = bf_hi(rw.x); xq[d0][2] = bf_lo(rw.y); xq[d0][3] = bf_hi(rw.y); xq[d0][4] = bf_lo(rw.z); xq[d0][5] = bf_hi(rw.z); xq[d0][6] = bf_lo(rw.w); xq[d0][7] = bf_hi(rw.w);
      #pragma unroll
      for (int j = 0; j < 8; ++j) ss += xq[d0][j] * xq[d0][j]; }
    { auto rr = __builtin_amdgcn_permlane32_swap(__float_as_uint(ss), __float_as_uint(ss), false, false); ss = __uint_as_float(rr[0]) + __uint_as_float(rr[1]); }
    const float rstd = __builtin_amdgcn_rsqf(ss * (1.0f / 64.0f) + 1e-6f) * (0.125f * 1.4426950408889634f);
    #pragma unroll
    for (int d0 = 0; d0 < 4; ++d0) { const f32x4 g0 = *(const f32x4*)(qgain + d0 * 16 + hi * 8), g1 = *(const f32x4*)(qgain + d0 * 16 + hi * 8 + 4);
      #pragma unroll
      for (int j = 0; j < 4; ++j) { xq[d0][j] *= rstd * g0[j]; xq[d0][4 + j] *= rstd * g1[j]; } }
    if (tok0 >= 0) { const int t = tok0 + wid * QBLK + r32, pr = t >> 6, pc = t & 63;
      #pragma unroll
      for (int hf = 0; hf < 2; ++hf) {
        const float* ct = rope + (hf ? (1024 + pc * 16) : (pr * 16)) + hi * 8; const float* st = ct + (hf ? 1024 : 512);
        const f32x4 c0 = *(const f32x4*)ct, c1 = *(const f32x4*)(ct + 4), s0 = *(const f32x4*)st, s1 = *(const f32x4*)(st + 4);
        #pragma unroll
        for (int j = 0; j < 8; ++j) { const float cs = j < 4 ? c0[j] : c1[j - 4], sn = j < 4 ? s0[j] : s1[j - 4];
          const float x1 = xq[2 * hf][j], x2 = xq[2 * hf + 1][j];
          xq[2 * hf][j] = x1 * cs - x2 * sn; xq[2 * hf + 1][j] = x2 * cs + x1 * sn; } } }
    #pragma unroll
    for (int d0 = 0; d0 < 4; ++d0) qr[d0] = pack8(xq[d0]); }
  float mhat = 0.f, l_reg = 0.f; f32x16 o[2]; o[0] = f32x16{}; o[1] = f32x16{}; f32x16 negm = f32x16{}; asm volatile("" : "+v"(negm));
  bool resc = false;
  #define START(P0, P1) do { const float rm = rowmax(P0, P1); resc = false; \
    { const float dl = rm; mhat = fadd_s(mhat, dl); \
      _Pragma("unroll") for (int r = 0; r < 16; ++r) { P0[r] = fsub_s(P0[r], dl); P1[r] = fsub_s(P1[r], dl); } \
      _Pragma("unroll") for (int r = 0; r < 16; ++r) negm[r] = -mhat; asm volatile("" : "+v"(negm)); } \
    _Pragma("unroll") for (int r = 0; r < 16; ++r) P0[r] = __builtin_amdgcn_exp2f(P0[r]); } while (0)
  #define RESC() do { if (resc) { asm volatile("s_waitcnt lgkmcnt(0)" ::: "memory"); \
      _Pragma("unroll") for (int d_ = 0; d_ < 2; ++d_) _Pragma("unroll") for (int r = 0; r < 16; ++r) o[d_][r] *= wsf[crow(r, hi)]; } } while (0)
  f32x16 pA0, pA1, pB0, pB1;
  int sl_prev = 0, sl_cur = 0, sl_next = SLOTB;
  #define ROT() do { sl_prev = sl_cur; sl_cur = sl_next; sl_next = (sl_next == (NSLOT - 1) * SLOTB) ? 0 : sl_next + SLOTB; } while (0)
  DMA_K(2, 2 * SLOTB);
  WAIT_BAR(3);
  qkt(pA0, pA1, Kbase, qr, negm, r32, hi); asm volatile("s_nop 15\n\ts_nop 7" : "+v"(pA0), "+v"(pA1));
  START(pA0, pA1);
  _Pragma("unroll") for (int r = 0; r < 16; ++r) pA1[r] = __builtin_amdgcn_exp2f(pA1[r]);
  WAIT_BAR(0);
  DMA_K(3, 0); DMA_V(1, SLOTB);
  ROT();
  kload8(kf, kp0 + sl_cur);
  WAIT_BAR(2);
  s16x4 vlo[8], vhi[8]; u32x4 pw0, pw1, pw2, pw3;
  #define PKW(P, B) cvtpk_s(P[B], P[B + 1])
  #define PAF(k) __builtin_bit_cast(bf16x8, pw##k)
  #define VFR(i) (bf16x8){vlo[i][0], vlo[i][1], vlo[i][2], vlo[i][3], vhi[i][0], vhi[i][1], vhi[i][2], vhi[i][3]}
  #define PIN(x) asm volatile("" : "+v"(x))
  #define MX3(a, b, c) __builtin_fmaxf(__builtin_fmaxf((a), (b)), (c))
  #define GAPA(MF, A0, A1, A2, A3, W0, W1, PW) do { MF; sacc += A0; sacc += A1; sacc += A2; sacc += A3; PIN(sacc); W0; W1; PIN(PW); SBAR(); } while (0)
  #define EX(v) __builtin_amdgcn_exp2f(v)
  #define GAPB(MF, X, B) do { MF; X[B] = EX(X[B]); X[B + 1] = EX(X[B + 1]); X[B + 2] = EX(X[B + 2]); X[B + 3] = EX(X[B + 3]); PIN(X); SBAR(); } while (0)
  #define VRD(i) do { vlo[i] = vtr(vp_ + (((i) >> 2) * 4096 + ((i) & 3) * 1024)); vhi[i] = vtr(vp_ + (((i) >> 2) * 4096 + ((i) & 3) * 1024 + 512)); } while (0)
  #define KRD(G, j) do { if (G) { kload2(kf, kp0 + sl_next, j); SBAR(); } } while (0)
  #define STEP(C0, C1, P0, P1, t, GK, GV, GL) do { SBAR(); \
    const lds_cptr vp_ = vp0 + sl_prev; \
    VRD(0); SBAR(); float sacc = (P0[0] + P0[1]); \
    GAPA(C0 = __builtin_amdgcn_mfma_f32_32x32x16_bf16(kf[0], qr[0], negm, 0, 0, 0), P0[2], P0[3], P0[4], P0[5],     pw0[0] = PKW(P0, 0), pw0[1] = PKW(P0, 2), pw0); \
    VRD(4); SBAR(); GAPA(C1 = __builtin_amdgcn_mfma_f32_32x32x16_bf16(kf[1], qr[0], negm, 0, 0, 0), P0[6], P0[7], P0[8], P0[9],     pw0[2] = PKW(P0, 4), pw0[3] = PKW(P0, 6), pw0); \
    VRD(1); SBAR(); GAPA(C0 = __builtin_amdgcn_mfma_f32_32x32x16_bf16(kf[2], qr[1], C0, 0, 0, 0),   P0[10], P0[11], P0[12], P0[13], pw1[0] = PKW(P0, 8), pw1[1] = PKW(P0, 10), pw1); \
    VRD(5); SBAR(); GAPA(C1 = __builtin_amdgcn_mfma_f32_32x32x16_bf16(kf[3], qr[1], C1, 0, 0, 0),   P0[14], P0[15], P1[0], P1[1],   pw1[2] = PKW(P0, 12), pw1[3] = PKW(P0, 14), pw1); \
    VRD(2); SBAR(); GAPA(C0 = __builtin_amdgcn_mfma_f32_32x32x16_bf16(kf[4], qr[2], C0, 0, 0, 0),   P1[2], P1[3], P1[4], P1[5],     pw2[0] = PKW(P1, 0), pw2[1] = PKW(P1, 2), pw2); \
    VRD(6); SBAR(); GAPA(C1 = __builtin_amdgcn_mfma_f32_32x32x16_bf16(kf[5], qr[2], C1, 0, 0, 0),   P1[6], P1[7], P1[8], P1[9],     pw2[2] = PKW(P1, 4), pw2[3] = PKW(P1, 6), pw2); \
    VRD(3); SBAR(); GAPA(C0 = __builtin_amdgcn_mfma_f32_32x32x16_bf16(kf[6], qr[3], C0, 0, 0, 0),   P1[10], P1[11], P1[12], P1[13], pw3[0] = PKW(P1, 8), pw3[1] = PKW(P1, 10), pw3); \
    VRD(7); SBAR(); GAPA(C1 = __builtin_amdgcn_mfma_f32_32x32x16_bf16(kf[7], qr[3], C1, 0, 0, 0),   P1[14], P1[15], 0.f, 0.f,       pw3[2] = PKW(P1, 12), pw3[3] = PKW(P1, 14), pw3); \
    l_reg += sacc; \
    if (GK) { DMA_K((t) + 3, sl_cur); } if (GV) { DMA_V((t) + 1, sl_next); } \
    { float a = MX3(C0[0], C0[1], C1[0]), b = MX3(C0[2], C0[3], C1[1]); a = MX3(a, C1[2], C1[3]); \
      _Pragma("unroll") for (int r = 4; r < 16; r += 4) { a = MX3(a, C0[r], C0[r + 1]); b = MX3(b, C0[r + 2], C0[r + 3]); a = MX3(a, C1[r], C1[r + 1]); b = MX3(b, C1[r + 2], C1[r + 3]); } \
      float rm = __builtin_fmaxf(a, b); { auto rr = __builtin_amdgcn_permlane32_swap(__float_as_uint(rm), __float_as_uint(rm), false, false); rm = __builtin_fmaxf(__uint_as_float(rr[0]), __uint_as_float(rr[1])); } \
      resc = false; \
      if (__builtin_expect(__any(rm > (float)THRL), 0)) { const float dl = __builtin_fmaxf(rm, 0.f); mhat += dl; \
        _Pragma("unroll") for (int r = 0; r < 16; ++r) { C0[r] -= dl; C1[r] -= dl; } \
        _Pragma("unroll") for (int r = 0; r < 16; ++r) negm[r] = -mhat; asm volatile("" : "+v"(negm)); \
        const float f = __builtin_amdgcn_exp2f(-dl); l_reg *= f; if (hi == 0) wsf[r32] = f; resc = true; } } \
    SBAR(); \
    GAPB(o[0] = __builtin_amdgcn_mfma_f32_32x32x16_bf16(PAF(0), VFR(0), o[0], 0, 0, 0), C0, 0); \
    GAPB(o[1] = __builtin_amdgcn_mfma_f32_32x32x16_bf16(PAF(0), VFR(4), o[1], 0, 0, 0), C0, 4); \
    KRD(GL, 0); GAPB(o[0] = __builtin_amdgcn_mfma_f32_32x32x16_bf16(PAF(1), VFR(1), o[0], 0, 0, 0), C0, 8); \
    KRD(GL, 1); GAPB(o[1] = __builtin_amdgcn_mfma_f32_32x32x16_bf16(PAF(1), VFR(5), o[1], 0, 0, 0), C0, 12); \
    KRD(GL, 2); GAPB(o[0] = __builtin_amdgcn_mfma_f32_32x32x16_bf16(PAF(2), VFR(2), o[0], 0, 0, 0), C1, 0); \
    KRD(GL, 3); GAPB(o[1] = __builtin_amdgcn_mfma_f32_32x32x16_bf16(PAF(2), VFR(6), o[1], 0, 0, 0), C1, 4); \
    GAPB(o[0] = __builtin_amdgcn_mfma_f32_32x32x16_bf16(PAF(3), VFR(3), o[0], 0, 0, 0), C1, 8); \
    GAPB(o[1] = __builtin_amdgcn_mfma_f32_32x32x16_bf16(PAF(3), VFR(7), o[1], 0, 0, 0), C1, 12); \
    } while (0)
  int t = 1;
  for (; t + 5 < NT; t += 2) {
    STEP(pB0, pB1, pA0, pA1, t, true, true, true);     WAIT_BAR(2); RESC(); ROT();
    STEP(pA0, pA1, pB0, pB1, t + 1, true, true, true); WAIT_BAR(2); RESC(); ROT();
  }
  #define ENDW(tt) do { if ((tt) + 3 < NT) { WAIT_BAR(2); } else if ((tt) + 2 < NT) { WAIT_BAR(1); } else { WAIT_BAR(0); } } while (0)
  for (; t + 1 < NT; t += 2) {
    STEP(pB0, pB1, pA0, pA1, t, (t + 3 < NT), (t + 1 < NT), (t + 1 < NT));         ENDW(t);     RESC(); ROT();
    STEP(pA0, pA1, pB0, pB1, t + 1, (t + 4 < NT), (t + 2 < NT), (t + 2 < NT));     ENDW(t + 1); RESC(); ROT();
  }
  STEP(pB0, pB1, pA0, pA1, NT - 1, false, false, false); RESC();
  { float sacc = pB0[0] + pB0[1]; _Pragma("unroll") for (int r = 2; r < 16; ++r) sacc += pB0[r]; _Pragma("unroll") for (int r = 0; r < 16; ++r) sacc += pB1[r]; l_reg += sacc;
    pw0 = (u32x4){PKW(pB0, 0), PKW(pB0, 2), PKW(pB0, 4), PKW(pB0, 6)}; pw1 = (u32x4){PKW(pB0, 8), PKW(pB0, 10), PKW(pB0, 12), PKW(pB0, 14)}; pw2 = (u32x4){PKW(pB1, 0), PKW(pB1, 2), PKW(pB1, 4), PKW(pB1, 6)}; pw3 = (u32x4){PKW(pB1, 8), PKW(pB1, 10), PKW(pB1, 12), PKW(pB1, 14)};
    SBAR(); pv(o, vb0 + sl_cur, PAF(0), PAF(1), PAF(2), PAF(3)); }
  #undef PKW
  #undef PAF
  #undef VFR
  #undef PIN
  #undef MX3
  #undef GAPA
  #undef GAPB
  #undef EX
  #undef VRD
  #undef KRD
  #undef STEP
  #undef ENDW
  { auto rr = __builtin_amdgcn_permlane32_swap(__float_as_uint(l_reg), __float_as_uint(l_reg), false, false); l_reg = __uint_as_float(rr[0]) + __uint_as_float(rr[1]); }
  if (hi == 0) wsf[32 + r32] = l_reg; asm volatile("s_waitcnt lgkmcnt(0)" ::: "memory");
  float rli[16];
  #pragma unroll
  for (int r = 0; r < 16; ++r) rli[r] = __builtin_amdgcn_rcpf(wsf[32 + crow(r, hi)]);
  bf16_t* Ow = Ou + (long)wid * QBLK * OP;
  { bf16_t* stg = (bf16_t*)(shm + LDS_OST) + wid * 2048;
    #pragma unroll
    for (int r = 0; r < 16; ++r) { const int orow = crow(r, hi);
      #pragma unroll
      for (int d0 = 0; d0 < 2; ++d0) stg[orow * 64 + d0 * 32 + r32] = (bf16_t)(cvtpk_s(o[d0][r] * rli[r], 0.f) & 0xffffu); }
    asm volatile("s_waitcnt lgkmcnt(0)" ::: "memory");
    #pragma unroll
    for (int i = 0; i < 4; ++i) { const int row = i * 8 + (lane >> 3), ch = lane & 7; const u32x4 v = *(const u32x4*)(stg + row * 64 + ch * 8); *(u32x4*)(Ow + (long)row * OP + ch * 8) = v; } }
  asm volatile("s_waitcnt lgkmcnt(0)\n\ts_barrier" ::: "memory");
  #undef DMA_K
  #undef DMA_V
  #undef START
  #undef RESC
  #undef ROT
}
#undef SBAR
#undef WAIT_BAR
}

__device__ __forceinline__ void ph_prologue(const Params& P, LAS unsigned char* lds) {
    const int tid = tid_(), bid = bid_(), G = gridDim.x, lane = tid & 63, wid = tid >> 6;
    float* mods = (float*)(P.ws + WS_MODS);
    LAS float* sc = (LAS float*)lds;
    LAS float* red = sc + 9 * 1024;
    for (int i = tid; i < 9 * 1024; i += NTHR) { const float v = (i < 8192) ? P.in[I_C][i] : P.in[I_CCTX][i - 8192]; sc[i] = siluf_(v); }
    __syncthreads();
    {
        const int c = lane & 31, slot = wid * 2 + (lane >> 5);
        for (int u = bid; u < 4 * 192; u += G) {
            const int l = u / 192, cg = u % 192;
            const float* w = P.in[I_WADA] + (size_t)l * 1024 * 6144 + cg * 32 + c;
            float a[9];
#pragma unroll
            for (int r = 0; r < 9; ++r) a[r] = 0.f;
#pragma unroll 8
            for (int i = 0; i < 64; ++i) { const int k = slot + 16 * i; const float wv = w[(size_t)k * 6144];
#pragma unroll
                for (int r = 0; r < 9; ++r) a[r] += sc[r * 1024 + k] * wv; }
#pragma unroll
            for (int r = 0; r < 9; ++r) red[(slot * 9 + r) * 32 + c] = a[r];
            __syncthreads();
            if (tid < 288) { const int r = tid >> 5, cc = tid & 31; float s_ = 0.f;
#pragma unroll
                for (int q = 0; q < 16; ++q) s_ += red[(q * 9 + r) * 32 + cc];
                mods[((size_t)l * 9 + r) * 6144 + cg * 32 + cc] = s_ + P.in[I_BADA][l * 6144 + cg * 32 + cc]; }
            __syncthreads();
        }
    }
    { float* rt = (float*)(P.ws + WS_RT);
      for (int i = bid * NTHR + tid; i < DEPTH * 20 * 1024; i += G * NTHR) { const int l = i / 20480, j = (i % 20480) >> 10, c = i & 1023;
          rt[i] = (j < 4) ? P.in[I_WGR][((size_t)l * 1024 + c) * 4 + j] : P.in[I_WER][((size_t)l * 1024 + c) * 16 + (j - 4)]; } }
    if (bid == G - 1) {
        float* lbv = (float*)(P.ws + WS_LB);
        for (int i = tid; i < 1024; i += NTHR) {
            float lg[DEPTH], mx = -1e30f;
#pragma unroll
            for (int l = 0; l < DEPTH; ++l) { lg[l] = P.in[I_LBL][l * 1024 + i]; mx = fmaxf(mx, lg[l]); }
            float s = 0.f;
#pragma unroll
            for (int l = 0; l < DEPTH; ++l) { lg[l] = expf(lg[l] - mx); s += lg[l]; }
            float cum = 0.f;
#pragma unroll
            for (int l = 0; l < DEPTH; ++l) { if (l > 0) cum += lg[l] / s; lbv[l * 1024 + i] = cum; }
        }
        float* rope = (float*)(P.ws + WS_ROPE);
        for (int i = tid; i < 96 * 16; i += NTHR) {
            const int pos = i >> 4, fi = i & 15;
            const float inv = powf(10000.0f, -(float)fi / 16.0f);
            const float p = (pos < 32) ? (float)pos : (float)(pos - 32);
            const float ang = p * inv;
            if (pos < 32) { rope[pos * 16 + fi] = cosf(ang); rope[512 + pos * 16 + fi] = sinf(ang); }
            else { rope[1024 + (pos - 32) * 16 + fi] = cosf(ang); rope[2048 + (pos - 32) * 16 + fi] = sinf(ang); }
        }
    }
    float4* xr = (float4*)(P.ws + WS_X);
    const float4* xs = (const float4*)P.in[I_X]; const float4* cs = (const float4*)P.in[I_CTX];
    const size_t nx4 = (size_t)NLAT * D / 4, nc4 = (size_t)NCTX * D / 4;
    for (size_t i = (size_t)bid * NTHR + tid; i < nx4 + nc4; i += (size_t)G * NTHR) xr[i] = (i < nx4) ? xs[i] : cs[i - nx4];
}

struct ConvJob { const float* srcA; const float* srcB; int ld; bool inter; bool perm; bf16_t* dst; int K, n0, k0; };
__device__ __forceinline__ int perm32(int rho) { const int n = rho >> 4, i = rho & 15; return 8 * (i >> 2) + 4 * n + (i & 3); }
__device__ __forceinline__ bool conv_job(const Params& P, int l, int u, ConvJob& J) {
    constexpr int T_IN = 16 * 124, T_BR = 3 * 8 * 16, T_OUT = 16 * 16, T_GU = 16 * 16 * 16, T_DN = 16 * 8 * 16;
    constexpr int TOT = T_IN + T_BR + T_OUT + T_GU + T_DN;
    if (u >= TOT) return false;
    int v = u;
    J.srcB = nullptr; J.inter = false; J.perm = false;
    if (v < T_IN) { const int kt = v % 16, nt = v / 16; J.perm = true; J.srcA = P.in[I_WIN] + (size_t)l * 1024 * INC; J.ld = INC; J.dst = (bf16_t*)(P.ws + WS_WIN); J.K = 1024; J.n0 = nt * 64; J.k0 = kt * 64; return true; }
    v -= T_IN;
    if (v < T_BR) { const int i = v / 128, w = v % 128, kt = w % 8, nt = w / 8; J.perm = true; J.srcA = P.in[I_WBR] + ((size_t)l * 3 + i) * 512 * 1024; J.ld = 1024; J.dst = (bf16_t*)(P.ws + WS_WBR) + (size_t)i * 1024 * 512; J.K = 512; J.n0 = nt * 64; J.k0 = kt * 64; return true; }
    v -= T_BR;
    if (v < T_OUT) { const int kt = v % 16, nt = v / 16; J.perm = true; J.srcA = P.in[I_WOUT] + (size_t)l * 1024 * 1024; J.ld = 1024; J.dst = (bf16_t*)(P.ws + WS_WOUT); J.K = 1024; J.n0 = nt * 64; J.k0 = kt * 64; return true; }
    v -= T_OUT;
    if (v < T_GU) { const int e = v / 256, w = v % 256, kt = w % 16, nt = w / 16; const size_t eo = ((size_t)l * NEXP + e) * 1024 * 512;
        J.srcA = P.in[I_WEG] + eo; J.srcB = P.in[I_WEU] + eo; J.inter = true; J.ld = 512; J.dst = (bf16_t*)(P.ws + WS_WGU) + (size_t)e * 1024 * 1024; J.K = 1024; J.n0 = nt * 64; J.k0 = kt * 64; return true; }
    v -= T_GU;
    { const int e = v / 128, w = v % 128, kt = w % 8, nt = w / 8; J.perm = true; J.srcA = P.in[I_WED] + ((size_t)l * NEXP + e) * 512 * 1024; J.ld = 1024; J.dst = (bf16_t*)(P.ws + WS_WDN) + (size_t)e * 1024 * 512; J.K = 512; J.n0 = nt * 64; J.k0 = kt * 64; return true; }
}
__device__ __forceinline__ void conv_load(const ConvJob& J, int tid, float (&v)[8]) {
    const int nn = tid & 63, kk = tid >> 6, n = J.n0 + nn;
    const float* cp;
    if (J.perm) cp = J.srcA + (n & ~31) + perm32(n & 31); else if (!J.inter) cp = J.srcA + n; else { const int g = n >> 5, i = n & 31; cp = (i < 16) ? (J.srcA + 16 * g + i) : (J.srcB + 16 * g + i - 16); }
#pragma unroll
    for (int p = 0; p < 8; ++p) v[p] = cp[(size_t)(J.k0 + kk + 8 * p) * J.ld];
}
__device__ __forceinline__ void wconv_range(const Params& P, LAS unsigned char* lds, int l, int t0, int t1, int widx, int nw) {
    LAS float* t = (LAS float*)lds;
    const int tid = tid_();
    int u = t0 + widx;
    ConvJob J; float v[8];
    bool have = (u < t1) && conv_job(P, l, u, J);
    if (have) conv_load(J, tid, v);
    while (have) {
        ConvJob Jn; float vn[8];
        const bool hn = (u + nw < t1) && conv_job(P, l, u + nw, Jn);
        if (hn) conv_load(Jn, tid, vn);
        { const int nn = tid & 63, kk = tid >> 6;
#pragma unroll
          for (int p = 0; p < 8; ++p) t[(kk + 8 * p) * 65 + nn] = v[p]; }
        __syncthreads();
        { const int n = tid >> 3, k8 = (tid & 7) * 8;
          float w[8];
#pragma unroll
          for (int j = 0; j < 8; ++j) w[j] = t[(k8 + j) * 65 + n];
          uint4 o; o.x = pk_bf16(w[0], w[1]); o.y = pk_bf16(w[2], w[3]); o.z = pk_bf16(w[4], w[5]); o.w = pk_bf16(w[6], w[7]);
          *(uint4*)(J.dst + (size_t)(J.n0 + n) * J.K + J.k0 + k8) = o; }
        __syncthreads();
        J = Jn; have = hn; u += nw;
#pragma unroll
        for (int p = 0; p < 8; ++p) v[p] = vn[p];
    }
}
constexpr int CONV_T_DENSE = 16 * 124 + 3 * 8 * 16 + 16 * 16;
constexpr int CONV_T_ALL = CONV_T_DENSE + 16 * 16 * 16 + 16 * 8 * 16;
__device__ __forceinline__ void ph_wconv(const Params& P, LAS unsigned char* lds, int l) { wconv_range(P, lds, l, 0, CONV_T_DENSE, bid_(), gridDim.x); }

__device__ __forceinline__ void norm_row(const float4 (&x)[4], const float* g, const float* shift, const float* scale, int lane, float4 (&o)[4]) {
    float ss = 0.f;
#pragma unroll
    for (int i = 0; i < 4; ++i) ss += x[i].x * x[i].x + x[i].y * x[i].y + x[i].z * x[i].z + x[i].w * x[i].w;
    ss = wave_sum(ss);
    const float rstd = __builtin_amdgcn_rsqf(ss * (1.0f / 1024.0f) + 1e-6f);
#pragma unroll
    for (int i = 0; i < 4; ++i) {
        const int c = lane * 4 + 256 * i;
        const float4 gv = *(const float4*)(g + c), sh = *(const float4*)(shift + c), sc = *(const float4*)(scale + c);
        o[i].x = x[i].x * rstd * gv.x * (1.0f + sc.x) + sh.x;
        o[i].y = x[i].y * rstd * gv.y * (1.0f + sc.y) + sh.y;
        o[i].z = x[i].z * rstd * gv.z * (1.0f + sc.z) + sh.z;
        o[i].w = x[i].w * rstd * gv.w * (1.0f + sc.w) + sh.w;
    }
}
__device__ __forceinline__ int row_modrow(int r) { return r < NLAT ? (r >> 11) : 8; }

__device__ __forceinline__ void ph_norm1(const Params& P, int l) {
    const int tid = tid_(), lane = tid & 63, wid = tid >> 6;
    const float* xres = (const float*)(P.ws + WS_X);
    bf16_t* h = (bf16_t*)(P.ws + WS_H);
    const float* g = P.in[I_GMIX] + l * 1024;
    for (int r = bid_() * 8 + wid; r < NTOK; r += gridDim.x * 8) {
        const float* mod = (const float*)(P.ws + WS_MODS) + ((size_t)l * 9 + row_modrow(r)) * 6144;
        float4 x[4], o[4];
#pragma unroll
        for (int i = 0; i < 4; ++i) x[i] = *(const float4*)(xres + (size_t)r * D + lane * 4 + 256 * i);
        norm_row(x, g, mod, mod + 1024, lane, o);
#pragma unroll
        for (int i = 0; i < 4; ++i) { uint2 u; u.x = pk_bf16(o[i].x, o[i].y); u.y = pk_bf16(o[i].z, o[i].w); *(uint2*)(h + (size_t)r * D + lane * 4 + 256 * i) = u; }
    }
}

struct EpiStoreBf16 { bf16_t* O; int ldc;
    __device__ __forceinline__ void operator()(int row, int col, const f32x4& v0, const f32x4& v1) const {
        uint2 a, b; a.x = pk_bf16(v0[0], v0[1]); a.y = pk_bf16(v0[2], v0[3]); b.x = pk_bf16(v1[0], v1[1]); b.y = pk_bf16(v1[2], v1[3]);
        *(uint2*)(O + (size_t)row * ldc + col) = a; *(uint2*)(O + (size_t)row * ldc + col + 16) = b; } };
struct EpiStore16 { bf16_t* O; int ldc;
    __device__ __forceinline__ void operator()(const f32x4 (&acc)[2][2][4][2], const pg8::Unit& u, int wr, int wc, int fr, int fq) const {
#pragma unroll
        for (int ai = 0; ai < 2; ++ai)
#pragma unroll
            for (int m = 0; m < 4; ++m)
#pragma unroll
                for (int bj = 0; bj < 2; ++bj) { const int row = u.row0 + ai * 128 + wr * 64 + m * 16 + fr, col = u.col0 + bj * 128 + wc * 32 + 8 * fq;
                    const f32x4 v0 = acc[ai][bj][m][0], v1 = acc[ai][bj][m][1];
                    uint4 o; o.x = pk_bf16(v0[0], v0[1]); o.y = pk_bf16(v0[2], v0[3]); o.z = pk_bf16(v1[0], v1[1]); o.w = pk_bf16(v1[2], v1[3]);
                    *(uint4*)(O + (size_t)row * ldc + col) = o; }
    } };
struct FStoreBf16 { bf16_t* O; int ldc;
    __device__ __forceinline__ void operator()(const pg8::Unit&, int row, int col, const f32x4& v0, const f32x4& v1) const {
        uint2 a, b; a.x = pk_bf16(v0[0], v0[1]); a.y = pk_bf16(v0[2], v0[3]); b.x = pk_bf16(v1[0], v1[1]); b.y = pk_bf16(v1[2], v1[3]);
        *(uint2*)(O + (size_t)row * ldc + col) = a; *(uint2*)(O + (size_t)row * ldc + col + 16) = b; } };
struct EpiG1 { bf16_t* Z; bf16_t* GT;
    __device__ __forceinline__ void operator()(const f32x4 (&acc)[2][2][4][2], const pg8::Unit& u, int wr, int wc, int fr, int fq) const {
        if (u.col0 < C_GATE) {
#pragma unroll
            for (int ai = 0; ai < 2; ++ai)
#pragma unroll
                for (int m = 0; m < 4; ++m)
#pragma unroll
                    for (int bj = 0; bj < 2; ++bj) { const int row = u.row0 + ai * 128 + wr * 64 + m * 16 + fr, col = u.col0 + bj * 128 + wc * 32 + 8 * fq;
                        const f32x4 v0 = acc[ai][bj][m][0], v1 = acc[ai][bj][m][1];
                        uint4 o; o.x = pk_bf16(v0[0], v0[1]); o.y = pk_bf16(v0[2], v0[3]); o.z = pk_bf16(v1[0], v1[1]); o.w = pk_bf16(v1[2], v1[3]);
                        *(uint4*)(Z + (size_t)row * ZP + col) = o; }
        } else {
            const int tidx = (wr * 4 + wc) * 64 + fq * 16 + fr;
            bf16_t* base = GT + ((size_t)(u.row0 >> 8) * 12 + ((u.col0 - C_GATE) >> 8)) * 65536 + tidx * 8;
#pragma unroll
            for (int ai = 0; ai < 2; ++ai)
#pragma unroll
                for (int bj = 0; bj < 2; ++bj)
#pragma unroll
                    for (int m = 0; m < 4; ++m) { const f32x4 v0 = acc[ai][bj][m][0], v1 = acc[ai][bj][m][1];
                        uint4 o; o.x = pk_bf16(sigmoidf_(v0[0]), sigmoidf_(v0[1])); o.y = pk_bf16(sigmoidf_(v0[2]), sigmoidf_(v0[3]));
                        o.z = pk_bf16(sigmoidf_(v1[0]), sigmoidf_(v1[1])); o.w = pk_bf16(sigmoidf_(v1[2]), sigmoidf_(v1[3]));
                        *(uint4*)(base + ((ai * 2 + bj) * 4 + m) * 4096) = o; }
        }
    } };
__device__ __forceinline__ void ph_g1(const Params& P, LAS unsigned char* lds) {
    pg8::SchedDense S{NTOK / 256, INC / 256, (int)gridDim.x, bid_(), (const char*)(P.ws + WS_H), (const char*)(P.ws + WS_WIN), (size_t)256 * D * 2, (size_t)256 * D * 2};
    EpiG1 E{(bf16_t*)(P.ws + WS_Z), (bf16_t*)(P.ws + WS_GT)};
    pg8::gemm_phase(lds, pg8::Gemm{D, D, D}, S, E);
}

__device__ __forceinline__ int kvrow(int r) { return r < NLAT ? ((r >> 11) * 2304 + 256 + (r & 2047)) : (((r - NLAT) >> 8) * 2304 + ((r - NLAT) & 255)); }
__device__ __forceinline__ void ph_prep(const Params& P, int l) {
    const int tid = tid_(), lane = tid & 63, wid = tid >> 6;
    const bf16_t* z = (const bf16_t*)(P.ws + WS_Z);
    bf16_t* qn = (bf16_t*)(P.ws + WS_QN); bf16_t* kn = (bf16_t*)(P.ws + WS_KN); bf16_t* vn = (bf16_t*)(P.ws + WS_VN);
    const float* rope = (const float*)(P.ws + WS_ROPE);
    const float gq = P.in[I_QNG][l * 64 + lane] * (0.125f * 1.4426950408889634f), gk = P.in[I_KNG][l * 64 + lane];
    for (int r = bid_() * 8 + wid; r < NTOK; r += gridDim.x * 8) {
        const bool lat = r < NLAT;
        const size_t kr = (size_t)kvrow(r);
        float cs = 1.f, sn = 0.f;
        if (lat) { const int t = r & 2047, fi = lane & 15;
            if (lane < 32) { const int pr = t >> 6; cs = rope[pr * 16 + fi]; sn = rope[512 + pr * 16 + fi]; }
            else { const int pc = t & 63; cs = rope[1024 + pc * 16 + fi]; sn = rope[2048 + pc * 16 + fi]; } }
        const float sgn = (lane & 16) ? 1.f : -1.f;
#pragma unroll
        for (int hh = 8; hh < 10; ++hh) {
            const int col = (hh < 8) ? (C_GQ + hh * 64) : (C_GK + (hh - 8) * 64);
            const float x = bf2f(z[(size_t)r * ZP + col + lane]);
            const float ss = wave_sum(x * x);
            const float xn = x * __builtin_amdgcn_rsqf(ss * (1.0f / 64.0f) + 1e-6f) * (hh < 8 ? gq : gk);
            const float pa = __shfl_xor(xn, 16, 64);
            const float o = xn * cs + sgn * pa * sn;
            const bf16_t ob = (bf16_t)(pk_bf16(o, 0.f) & 0xffffu);
            if (hh < 8) qn[(size_t)r * 512 + hh * 64 + lane] = ob; else kn[kr * 128 + (hh - 8) * 64 + lane] = ob;
        }
        *(unsigned*)(vn + kr * 128 + lane * 2) = *(const unsigned*)(z + (size_t)r * ZP + C_GV + lane * 2);
    }
}

__device__ __forceinline__ void ph_navt(const Params& P, LAS unsigned char* lds) {
    const int tid = tid_();
    const bf16_t* z = (const bf16_t*)(P.ws + WS_Z); bf16_t* vt = (bf16_t*)(P.ws + WS_NAVT);
    constexpr int PT = 1040;
    for (int u = bid_(); u < NB * 36; u += gridDim.x) {
        const int b = u / 36, tl = u % 36;
        const int row0 = (tl < 4) ? (NLAT + b * 256 + tl * 64) : (b * 2048 + (tl - 4) * 64);
        __syncthreads();
#pragma unroll
        for (int i = 0; i < 8; ++i) { const int ch = tid + i * NTHR, rr = ch >> 6, cc = ch & 63;
            const uint4 v = *(const uint4*)(z + (size_t)(row0 + rr) * ZP + C_NAV + cc * 8);
            *(LAS u32x4*)(lds + rr * PT + cc * 16) = (u32x4){v.x, v.y, v.z, v.w}; }
        __syncthreads();
#pragma unroll
        for (int i = 0; i < 8; ++i) { const int c = tid, tg = i;
            unsigned short e[8];
#pragma unroll
            for (int k = 0; k < 8; ++k) e[k] = *(const LAS unsigned short*)(lds + (tg * 8 + k) * PT + c * 2);
            uint4 o; o.x = e[0] | ((unsigned)e[1] << 16); o.y = e[2] | ((unsigned)e[3] << 16); o.z = e[4] | ((unsigned)e[5] << 16); o.w = e[6] | ((unsigned)e[7] << 16);
            *(uint4*)(vt + ((size_t)(b * 8 + (c >> 6)) * 64 + (c & 63)) * 2304 + tl * 64 + tg * 8) = o; }
    }
    __syncthreads();
}

#ifdef DIAG
__device__ __forceinline__ void load_q64(float (&q)[64], const bf16_t* p) {
#pragma unroll
    for (int i = 0; i < 8; ++i) { const uint4 u = ((const uint4*)p)[i];
        q[8 * i + 0] = bf_lo(u.x); q[8 * i + 1] = bf_hi(u.x); q[8 * i + 2] = bf_lo(u.y); q[8 * i + 3] = bf_hi(u.y);
        q[8 * i + 4] = bf_lo(u.z); q[8 * i + 5] = bf_hi(u.z); q[8 * i + 6] = bf_lo(u.w); q[8 * i + 7] = bf_hi(u.w); }
}
__device__ __forceinline__ void attn_key(const float (&q)[64], const bf16_t* kp, const bf16_t* vp, float bias, float& m, float& lsum, float (&o)[64]) {
    float s = 0.f;
#pragma unroll
    for (int i = 0; i < 8; ++i) { const uint4 u = ((const uint4*)kp)[i];
        s += q[8 * i + 0] * bf_lo(u.x) + q[8 * i + 1] * bf_hi(u.x) + q[8 * i + 2] * bf_lo(u.y) + q[8 * i + 3] * bf_hi(u.y)
           + q[8 * i + 4] * bf_lo(u.z) + q[8 * i + 5] * bf_hi(u.z) + q[8 * i + 6] * bf_lo(u.w) + q[8 * i + 7] * bf_hi(u.w); }
    s = s * 0.125f + bias;
    const float mn = fmaxf(m, s), corr = __expf(m - mn), pp = __expf(s - mn);
    lsum = lsum * corr + pp; m = mn;
#pragma unroll
    for (int i = 0; i < 8; ++i) { const uint4 u = ((const uint4*)vp)[i];
        o[8 * i + 0] = o[8 * i + 0] * corr + pp * bf_lo(u.x); o[8 * i + 1] = o[8 * i + 1] * corr + pp * bf_hi(u.x);
        o[8 * i + 2] = o[8 * i + 2] * corr + pp * bf_lo(u.y); o[8 * i + 3] = o[8 * i + 3] * corr + pp * bf_hi(u.y);
        o[8 * i + 4] = o[8 * i + 4] * corr + pp * bf_lo(u.z); o[8 * i + 5] = o[8 * i + 5] * corr + pp * bf_hi(u.z);
        o[8 * i + 6] = o[8 * i + 6] * corr + pp * bf_lo(u.w); o[8 * i + 7] = o[8 * i + 7] * corr + pp * bf_hi(u.w); }
}
__device__ __forceinline__ void store_o64(const float (&o)[64], float inv, bf16_t* p) {
#pragma unroll
    for (int i = 0; i < 8; ++i) { uint4 u;
        u.x = pk_bf16(o[8 * i + 0] * inv, o[8 * i + 1] * inv); u.y = pk_bf16(o[8 * i + 2] * inv, o[8 * i + 3] * inv);
        u.z = pk_bf16(o[8 * i + 4] * inv, o[8 * i + 5] * inv); u.w = pk_bf16(o[8 * i + 6] * inv, o[8 * i + 7] * inv);
        ((uint4*)p)[i] = u; }
}
__device__ __forceinline__ void na_thread(const Params& P, int l, int r, int h, bf16_t* br, int OPN) {
    const bf16_t* z = (const bf16_t*)(P.ws + WS_Z);
    float q[64], o[64]; float m = -INFINITY, ls = 0.f;
#pragma unroll
    for (int i = 0; i < 64; ++i) o[i] = 0.f;
    load_q64(q, z + (size_t)r * ZP + C_NAQ + h * 64);
    int b;
    if (r < NLAT) {
        b = r >> 11; const int t = r & 2047, qr = t >> 6, qc = t & 63;
        const int r0 = min(max(qr - 4, 0), 24), c0 = min(max(qc - 8, 0), 48);
        const float* rpb = P.in[I_RPB] + ((size_t)l * 8 + h) * 15 * 31;
        for (int kr = r0; kr < r0 + 8; ++kr)
            for (int kc = c0; kc < c0 + 16; ++kc) {
                const size_t krow = (size_t)(b * 2048 + kr * 64 + kc) * ZP;
                attn_key(q, z + krow + C_NAK + h * 64, z + krow + C_NAV + h * 64, rpb[(kr - qr + 7) * 31 + (kc - qc + 15)], m, ls, o);
            }
    } else b = (r - NLAT) >> 8;
    for (int j = 0; j < 256; ++j) {
        const size_t krow = (size_t)(NLAT + b * 256 + j) * ZP;
        attn_key(q, z + krow + C_NAK + h * 64, z + krow + C_NAV + h * 64, 0.f, m, ls, o);
    }
    store_o64(o, 1.0f / ls, br + (size_t)r * OPN + h * 64);
}
#endif
namespace na {
constexpr int KP = 144, VP = 528;
constexpr int L_K = 0, L_V = 256 * KP, L_B = L_V + 64 * VP, L_END = L_B + 480 * 4;
constexpr float C2 = 0.125f * 1.4426950408889634f, LOG2E = 1.4426950408889634f;
struct Acc { float m, l; f32x4 o[4]; };
__device__ __forceinline__ void absorb(Acc& A, f32x4 (&sa)[4], f32x4 (&sb)[4], const bf16x8 (&vfr)[4][4]) {
    float mx = -INFINITY;
#pragma unroll
    for (int g = 0; g < 4; ++g)
#pragma unroll
        for (int j = 0; j < 4; ++j) mx = fmaxf(mx, fmaxf(sa[g][j], sb[g][j]));
    mx = fmaxf(mx, __shfl_xor(mx, 16, 64)); mx = fmaxf(mx, __shfl_xor(mx, 32, 64));
    const float mn = fmaxf(A.m, mx), corr = __builtin_amdgcn_exp2f(A.m - mn);
    A.m = mn;
    float ps = 0.f;
    bf16x8 pf[4];
#pragma unroll
    for (int g = 0; g < 4; ++g) { float p[8];
#pragma unroll
        for (int j = 0; j < 4; ++j) { p[j] = __builtin_amdgcn_exp2f(sa[g][j] - mn); p[4 + j] = __builtin_amdgcn_exp2f(sb[g][j] - mn); ps += p[j] + p[4 + j]; }
        pf[g] = pack8(p); }
    A.l = A.l * corr + ps;
#pragma unroll
    for (int db = 0; db < 4; ++db) A.o[db] *= corr;
#pragma unroll
    for (int g = 0; g < 4; ++g)
#pragma unroll
        for (int db = 0; db < 4; ++db) A.o[db] = __builtin_amdgcn_mfma_f32_16x16x32_bf16(vfr[g][db], pf[g], A.o[db], 0, 0, 0);
}
}
__device__ __forceinline__ void na_unit(const Params& P, LAS unsigned char* lds, int l, int u, bf16_t* br, int OPN) {
    const int tid = tid_(), lane = tid & 63, wid = __builtin_amdgcn_readfirstlane(tid >> 6), c16 = lane & 15, kq = lane >> 4;
    const bool latu = u < 256;
    const int bh = latu ? (u >> 2) : (u - 256), b = bh >> 3, h = bh & 7, q4 = u & 3;
    const bf16_t* z = (const bf16_t*)(P.ws + WS_Z); const bf16_t* vt = (const bf16_t*)(P.ws + WS_NAVT) + (size_t)bh * 64 * 2304;
    LAS unsigned char* KL = lds + na::L_K; LAS unsigned char* VL = lds + na::L_V; LAS float* BL = (LAS float*)(lds + na::L_B);
    __syncthreads();
#pragma unroll
    for (int i = 0; i < 4; ++i) { const int ch = tid + i * NTHR, rr = ch >> 3, cc = ch & 7;
        const uint4 v = *(const uint4*)(z + (size_t)(NLAT + b * 256 + rr) * ZP + C_NAK + h * 64 + cc * 8);
        *(LAS u32x4*)(KL + rr * na::KP + cc * 16) = (u32x4){v.x, v.y, v.z, v.w}; }
#pragma unroll
    for (int i = 0; i < 4; ++i) { const int ch = tid + i * NTHR, rr = ch >> 5, cc = ch & 31;
        const uint4 v = *(const uint4*)(vt + (size_t)rr * 2304 + cc * 8);
        *(LAS u32x4*)(VL + rr * na::VP + cc * 16) = (u32x4){v.x, v.y, v.z, v.w}; }
    if (tid < 465) BL[tid] = P.in[I_RPB][((size_t)l * 8 + h) * 465 + tid] * na::LOG2E;
    __syncthreads();
    const int sA = 8 * (c16 >> 2) + (c16 & 3);
    const int ntask = latu ? 4 : 2;
    for (int it = 0; it < ntask; ++it) {
        const int tk = it * 8 + wid;
        int qrow, r = 0, jb = 0;
        if (latu) { r = q4 * 8 + (tk >> 2); jb = tk & 3; qrow = b * 2048 + r * 64 + jb * 16 + c16; }
        else qrow = NLAT + b * 256 + tk * 16 + c16;
        bf16x8 qf[2];
#pragma unroll
        for (int ks = 0; ks < 2; ++ks) qf[ks] = *(const bf16x8*)(z + (size_t)qrow * ZP + C_NAQ + h * 64 + 32 * ks + 8 * kq);
        bf16_t* op = br + (size_t)qrow * OPN + h * 64 + 4 * kq; asm volatile("" : "+v"(op));
        na::Acc A; A.m = -INFINITY; A.l = 0.f;
#pragma unroll
        for (int db = 0; db < 4; ++db) A.o[db] = (f32x4){0.f, 0.f, 0.f, 0.f};
        if (latu) {
            const int r0 = min(max(r - 4, 0), 24), kc0 = min(max(jb * 16 - 8, 0), 32), qc = jb * 16 + c16, c0 = min(max(qc - 8, 0), 48);
            int dcol[8]; bool ok[8];
#pragma unroll
            for (int j = 0; j < 8; ++j) { const int kc = kc0 + 8 * kq + j; ok[j] = (kc >= c0) && (kc < c0 + 16); dcol[j] = ok[j] ? (kc - qc + 15) : 0; }
#pragma unroll 1
            for (int ch = 0; ch < 2; ++ch) {
                f32x4 sa[4], sb[4];
                const size_t tokbase = (size_t)b * 2048 + (size_t)(r0 + ch * 4) * 64 + kc0;
                bf16x8 kf[4][4], vfr[4][4];
#pragma unroll
                for (int g = 0; g < 4; ++g) {
                    const bf16_t* kp = z + (tokbase + (size_t)g * 64 + sA) * ZP + C_NAK + h * 64 + 8 * kq;
                    kf[g][0] = *(const bf16x8*)kp; kf[g][1] = *(const bf16x8*)(kp + 32); kf[g][2] = *(const bf16x8*)(kp + 4 * ZP); kf[g][3] = *(const bf16x8*)(kp + 4 * ZP + 32);
                }
                {
                    const bf16_t* vp = vt + (size_t)c16 * 2304 + 256 + (r0 + ch * 4) * 64 + kc0 + 8 * kq;
#pragma unroll
                    for (int g = 0; g < 4; ++g)
#pragma unroll
                        for (int db = 0; db < 4; ++db) vfr[g][db] = *(const bf16x8*)(vp + (size_t)db * 16 * 2304 + g * 64);
                }
                float bv[4][8];
#pragma unroll
                for (int g = 0; g < 4; ++g) { const int brow = (r0 + ch * 4 + g - r + 7) * 31;
#pragma unroll
                    for (int j = 0; j < 8; ++j) bv[g][j] = BL[brow + dcol[j]]; }
#pragma unroll
                for (int g = 0; g < 4; ++g) {
                    f32x4 a = {0.f, 0.f, 0.f, 0.f}, bq = {0.f, 0.f, 0.f, 0.f};
                    a = __builtin_amdgcn_mfma_f32_16x16x32_bf16(kf[g][0], qf[0], a, 0, 0, 0); a = __builtin_amdgcn_mfma_f32_16x16x32_bf16(kf[g][1], qf[1], a, 0, 0, 0);
                    bq = __builtin_amdgcn_mfma_f32_16x16x32_bf16(kf[g][2], qf[0], bq, 0, 0, 0); bq = __builtin_amdgcn_mfma_f32_16x16x32_bf16(kf[g][3], qf[1], bq, 0, 0, 0);
#pragma unroll
                    for (int j = 0; j < 4; ++j) {
                        const float va = a[j] * na::C2 + bv[g][j], vb = bq[j] * na::C2 + bv[g][4 + j];
                        sa[g][j] = ok[j] ? va : -INFINITY;
                        sb[g][j] = ok[4 + j] ? vb : -INFINITY; }
                }
                na::absorb(A, sa, sb, vfr);
            }
        }
#pragma unroll 1
        for (int ch = 0; ch < 2; ++ch) {
            f32x4 sa[4], sb[4];
            bf16x8 kf[4][4], vfr[4][4];
            { const LAS unsigned char* vp = VL + c16 * na::VP + (ch * 128 + 8 * kq) * 2;
#pragma unroll
              for (int g = 0; g < 4; ++g)
#pragma unroll
                for (int db = 0; db < 4; ++db) vfr[g][db] = *(const LAS bf16x8*)(vp + db * 16 * na::VP + g * 64); }
#pragma unroll
            for (int g = 0; g < 4; ++g) {
                const LAS unsigned char* kp = KL + (ch * 128 + g * 32 + sA) * na::KP + kq * 16;
                kf[g][0] = *(const LAS bf16x8*)kp; kf[g][1] = *(const LAS bf16x8*)(kp + 64); kf[g][2] = *(const LAS bf16x8*)(kp + 4 * na::KP); kf[g][3] = *(const LAS bf16x8*)(kp + 4 * na::KP + 64);
            }
#pragma unroll
            for (int g = 0; g < 4; ++g) {
                f32x4 a = {0.f, 0.f, 0.f, 0.f}, bq = {0.f, 0.f, 0.f, 0.f};
                a = __builtin_amdgcn_mfma_f32_16x16x32_bf16(kf[g][0], qf[0], a, 0, 0, 0); a = __builtin_amdgcn_mfma_f32_16x16x32_bf16(kf[g][1], qf[1], a, 0, 0, 0);
                bq = __builtin_amdgcn_mfma_f32_16x16x32_bf16(kf[g][2], qf[0], bq, 0, 0, 0); bq = __builtin_amdgcn_mfma_f32_16x16x32_bf16(kf[g][3], qf[1], bq, 0, 0, 0);
                sa[g] = a * na::C2; sb[g] = bq * na::C2;
            }
            na::absorb(A, sa, sb, vfr);
        }
        float ls = A.l; ls += __shfl_xor(ls, 16, 64); ls += __shfl_xor(ls, 32, 64);
        const float inv = __builtin_amdgcn_rcpf(ls);
#pragma unroll
        for (int db = 0; db < 4; ++db) { uint2 o; o.x = pk_bf16(A.o[db][0] * inv, A.o[db][1] * inv); o.y = pk_bf16(A.o[db][2] * inv, A.o[db][3] * inv);
            *(uint2*)(op + 16 * db) = o; }
    }
}
__device__ __forceinline__ int hg_row(int b, int dir, int s) { return s < 256 ? (NLAT + b * 256 + (dir ? 255 - s : s)) : (b * 2048 + (dir ? 2047 - (s - 256) : (s - 256))); }
__device__ __forceinline__ bf16x8 tr2(const LAS unsigned char* p0, const LAS unsigned char* p1) {
    typedef short v4i16_t __attribute__((ext_vector_type(4)));
    const v4i16_t a = __builtin_amdgcn_ds_read_tr16_b64_v4i16((LAS v4i16_t*)p0), c = __builtin_amdgcn_ds_read_tr16_b64_v4i16((LAS v4i16_t*)p1);
    return (bf16x8){a[0], a[1], a[2], a[3], c[0], c[1], c[2], c[3]};
}
__device__ __forceinline__ void hgrn_unit(const Params& P, LAS unsigned char* lds, int l, int u) {
    const int tid = tid_(), lane = tid & 63, wid = __builtin_amdgcn_readfirstlane(tid >> 6), c16 = lane & 15, kq = lane >> 4;
    const int b = u >> 3, h = (u >> 1) & 3, dir = u & 1;
    const bf16_t* z = (const bf16_t*)(P.ws + WS_Z);
    float* O = (float*)(P.ws + (dir ? WS_Y : WS_H));
    const float* lbv = (const float*)(P.ws + WS_LB) + ((size_t)l * 2 + dir) * 512 + h * 128;
    constexpr int PQ = 272;
    LAS unsigned char* QH = lds; LAS unsigned char* KT = lds + 8704; LAS unsigned char* KH = lds + 17408; LAS unsigned char* VV = lds + 26112;
    LAS float* DL = (LAS float*)(lds + 34816); LAS float* WT = DL + 128;
    const int ch = 2 * lane;
    const float lb0 = lbv[ch], lb1 = lbv[ch + 1];
    const int cf = (dir ? C_HFB : C_HFF) + h * 128 + ch, cq = C_HQ + h * 128 + ch, cv = C_HI + h * 128 + ch;
    f32x4 SA[4], SB[4];
#pragma unroll
    for (int G = 0; G < 4; ++G) { SA[G] = (f32x4){0.f, 0.f, 0.f, 0.f}; SB[G] = (f32x4){0.f, 0.f, 0.f, 0.f}; }
    unsigned rf[4], rq[4], rv[4];
#pragma unroll
    for (int k = 0; k < 4; ++k) { const bf16_t* zr = z + (size_t)hg_row(b, dir, 4 * wid + k) * ZP; rf[k] = *(const unsigned*)(zr + cf); rq[k] = *(const unsigned*)(zr + cq); rv[k] = *(const unsigned*)(zr + cv); }
    const int sA = 8 * (c16 >> 2) + (c16 & 3);
    const int tq = c16 >> 2, tp = c16 & 3;
    for (int st = 0; st < 72; ++st) {
        unsigned xf[4], xq[4], xv[4];
#pragma unroll
        for (int k = 0; k < 4; ++k) { xf[k] = rf[k]; xq[k] = rq[k]; xv[k] = rv[k]; }
        if (st + 1 < 72) {
#pragma unroll
            for (int k = 0; k < 4; ++k) { const bf16_t* zr = z + (size_t)hg_row(b, dir, (st + 1) * 32 + 4 * wid + k) * ZP; rf[k] = *(const unsigned*)(zr + cf); rq[k] = *(const unsigned*)(zr + cq); rv[k] = *(const unsigned*)(zr + cv); }
        }
        float g0[4], g1[4], k0[4], k1[4], q0[4], q1[4];
        float c0 = 1.f, c1 = 1.f;
#pragma unroll
        for (int k = 0; k < 4; ++k) {
            const float f0 = lb0 + (1.0f - lb0) * sigmoidf_(bf_lo(xf[k])), f1 = lb1 + (1.0f - lb1) * sigmoidf_(bf_hi(xf[k]));
            c0 *= f0; c1 *= f1; g0[k] = c0; g1[k] = c1;
            k0[k] = 1.0f - f0; k1[k] = 1.0f - f1; q0[k] = siluf_(bf_lo(xq[k])); q1[k] = siluf_(bf_hi(xq[k]));
        }
        WT[wid * 128 + ch] = c0; WT[wid * 128 + ch + 1] = c1;
        __syncthreads();
        float pre0 = 1.f, pre1 = 1.f, tot0 = 1.f, tot1 = 1.f;
#pragma unroll
        for (int w = 0; w < 8; ++w) { const float a0 = WT[w * 128 + ch], a1 = WT[w * 128 + ch + 1]; tot0 *= a0; tot1 *= a1; if (w < wid) { pre0 *= a0; pre1 *= a1; } }
#pragma unroll
        for (int k = 0; k < 4; ++k) {
            const float e0 = g0[k] * pre0, e1 = g1[k] * pre1;
            const float r0 = __builtin_amdgcn_rcpf(e0), r1 = __builtin_amdgcn_rcpf(e1);
            const float kt0 = k0[k] * r0, kt1 = k1[k] * r1;
            const int ro = (4 * wid + k) * PQ + ch * 2;
            *(LAS unsigned*)(QH + ro) = pk_bf16(q0[k] * e0, q1[k] * e1);
            *(LAS unsigned*)(KT + ro) = pk_bf16(kt0, kt1);
            *(LAS unsigned*)(KH + ro) = pk_bf16(kt0 * tot0, kt1 * tot1);
            *(LAS unsigned*)(VV + ro) = xv[k];
        }
        if (wid == 0) { DL[ch] = tot0; DL[ch + 1] = tot1; }
        __syncthreads();
        const bf16x8 vfr = tr2(VV + (8 * kq + tq) * PQ + (16 * wid + 4 * tp) * 2, VV + (8 * kq + 4 + tq) * PQ + (16 * wid + 4 * tp) * 2);
        bf16x8 Sb[4];
#pragma unroll
        for (int G = 0; G < 4; ++G) { const float sv[8] = {SA[G][0], SA[G][1], SA[G][2], SA[G][3], SB[G][0], SB[G][1], SB[G][2], SB[G][3]}; Sb[G] = pack8(sv); }
#pragma unroll
        for (int T = 0; T < 2; ++T) {
            f32x4 aA = {0.f, 0.f, 0.f, 0.f}, aB = {0.f, 0.f, 0.f, 0.f};
            bf16x8 qf[4];
#pragma unroll
            for (int ks = 0; ks < 4; ++ks) {
                const bf16x8 kA = *(const LAS bf16x8*)(KT + sA * PQ + (32 * ks + 8 * kq) * 2);
                const bf16x8 kB = *(const LAS bf16x8*)(KT + (sA + 4) * PQ + (32 * ks + 8 * kq) * 2);
                qf[ks] = *(const LAS bf16x8*)(QH + (16 * T + c16) * PQ + (32 * ks + 8 * kq) * 2);
                aA = __builtin_amdgcn_mfma_f32_16x16x32_bf16(kA, qf[ks], aA, 0, 0, 0);
                aB = __builtin_amdgcn_mfma_f32_16x16x32_bf16(kB, qf[ks], aB, 0, 0, 0);
            }
            const int t = 16 * T + c16;
            float pv_[8];
#pragma unroll
            for (int jj = 0; jj < 4; ++jj) { pv_[jj] = (8 * kq + jj <= t) ? aA[jj] : 0.f; pv_[4 + jj] = (8 * kq + 4 + jj <= t) ? aB[jj] : 0.f; }
            f32x4 o = {0.f, 0.f, 0.f, 0.f};
            o = __builtin_amdgcn_mfma_f32_16x16x32_bf16(pack8(pv_), vfr, o, 0, 0, 0);
#pragma unroll
            for (int ks = 0; ks < 4; ++ks) o = __builtin_amdgcn_mfma_f32_16x16x32_bf16(qf[ks], Sb[ks], o, 0, 0, 0);
#pragma unroll
            for (int jj = 0; jj < 4; ++jj) O[(size_t)hg_row(b, dir, st * 32 + 16 * T + 4 * kq + jj) * 512 + h * 128 + 16 * wid + c16] = o[jj];
        }
#pragma unroll
        for (int G = 0; G < 4; ++G) {
            const f32x4 d0 = *(const LAS f32x4*)(DL + 32 * G + 8 * kq), d1 = *(const LAS f32x4*)(DL + 32 * G + 8 * kq + 4);
            const LAS unsigned char* ka = KH + (8 * kq + tq) * PQ + (32 * G + 8 * tp) * 2;
            const bf16x8 hA = tr2(ka, ka + 4 * PQ), hB = tr2(ka + 8, ka + 4 * PQ + 8);
            SA[G] = __builtin_amdgcn_mfma_f32_16x16x32_bf16(hA, vfr, SA[G] * d0, 0, 0, 0);
            SB[G] = __builtin_amdgcn_mfma_f32_16x16x32_bf16(hB, vfr, SB[G] * d1, 0, 0, 0);
        }
    }
    __syncthreads();
}
__device__ __forceinline__ void gqa_unit(const Params& P, char* shm, int l, int U) {
    const bf16_t* z = (const bf16_t*)(P.ws + WS_Z); const bf16_t* kn = (const bf16_t*)(P.ws + WS_KN); const bf16_t* vn = (const bf16_t*)(P.ws + WS_VN);
    bf16_t* br = (bf16_t*)(P.ws + WS_BR);
    int b, hq, row0, NT;
    if (U < 512) { const int bg = U >> 5; b = bg >> 1; hq = (bg & 1) * 4 + ((U & 31) >> 3); row0 = b * 2048 + (U & 7) * 256; NT = 36; }
    else { const int v = U - 512; b = v >> 3; hq = v & 7; row0 = NLAT + b * 256; NT = 4; }
    const int g = hq >> 2;
    gqa::attn_unit<8>(z + (size_t)row0 * ZP + C_GQ + hq * 64, P.in[I_QNG] + l * 64, (const float*)(P.ws + WS_ROPE), (U < 512) ? ((U & 7) * 256) : -1,
                      kn + (size_t)b * 2304 * 128 + g * 64, vn + (size_t)b * 2304 * 128 + g * 64, br + (size_t)row0 * BRW + 1024 + hq * 64, NT, shm);
}
__device__ __forceinline__ void ph_mix(const Params& P, LAS unsigned char* lds, char* shm, int l, int pass = 0, int filter = 0) {
    const int tid = tid_();
    unsigned* qctr = (unsigned*)(P.ws + WS_CNT + 512) + l + 4 * pass;
    volatile LAS unsigned* qslot = (volatile LAS unsigned*)(lds + LDS_BYTES - 32);
    for (;;) {
        if (tid == 0) *qslot = __hip_atomic_fetch_add(qctr, 1u, __ATOMIC_RELAXED, __HIP_MEMORY_SCOPE_AGENT);
        __syncthreads();
        const int u = (int)*qslot;
        __syncthreads();
        if (u >= 960) break;
        const int kind = (u < 64) ? 2 : ((u >= 64 && u < 320) || (u >= 832 && u < 896)) ? 3 : 1;
        if (filter != 0 && filter != kind) continue;
        if (u < 64) hgrn_unit(P, lds, l, u);
        else if (u < 320) na_unit(P, lds, l, u - 64, (bf16_t*)(P.ws + WS_BR), BRW);
        else if (u < 832) gqa_unit(P, shm, l, u - 320);
        else if (u < 896) { if (l < DEPTH - 1) na_unit(P, lds, l, 256 + (u - 832), (bf16_t*)(P.ws + WS_BR), BRW); }
        else { if (l < DEPTH - 1) gqa_unit(P, shm, l, 512 + (u - 896)); }
        __syncthreads();
    }
}
#ifdef DIAG
__device__ __forceinline__ void ph_diag_cmp(const Params& P) {
    const bf16_t* br = (const bf16_t*)(P.ws + WS_BR); const bf16_t* d1 = (const bf16_t*)(P.ws + WS_END); const bf16_t* d2 = d1 + (size_t)NTOK * 512;
    const bf16_t* z = (const bf16_t*)(P.ws + WS_Z); const bf16_t* vt = (const bf16_t*)(P.ws + WS_NAVT);
    unsigned* dg = (unsigned*)(P.ws + 20480);
    unsigned c1 = 0, c2 = 0, c3 = 0;
    for (size_t i = (size_t)bid_() * NTHR + tid_(); i < (size_t)NTOK * 512; i += (size_t)gridDim.x * NTHR) {
        const size_t r = i >> 9; const int c = (int)(i & 511);
        const float a = bf2f(br[r * BRW + c]), x = bf2f(d1[i]);
        if (!(fabsf(x - a) <= 0.004f + 0.02f * fabsf(a))) ++c1;
        if (DIAG != 4 && d1[i] != d2[i]) ++c3;
        const int rr = (int)r; const int bb = rr < NLAT ? (rr >> 11) : ((rr - NLAT) >> 8); const int tok = rr < NLAT ? (256 + (rr & 2047)) : ((rr - NLAT) & 255);
        if (vt[((size_t)(bb * 8 + (c >> 6)) * 64 + (c & 63)) * 2304 + tok] != z[r * ZP + C_NAV + c]) ++c2;
    }
    if (c1) atomicAdd(dg + 1, c1);
    if (c2) atomicAdd(dg + 2, c2);
    if (c3) atomicAdd(dg + 3, c3);
}
__device__ __forceinline__ void ph_diag_out(const Params& P) {
    const volatile unsigned* dg = (const volatile unsigned*)(P.ws + 20480);
    const unsigned c1 = dg[1], c2 = dg[2], c3 = dg[3];
    if ((c1 | c2 | c3) == 0) return;
    unsigned k = 0; { unsigned v = c1; while (v) { ++k; v >>= 1; } }
    if (c2) k += 30; if (c3) k += 60;
    const float cst = sqrtf(10.0f * (float)k + 9.0f);
    for (size_t i = (size_t)bid_() * NTHR + tid_(); i < (size_t)NLAT * D; i += (size_t)gridDim.x * NTHR) P.out[i] = cst;
}
#endif

__device__ __forceinline__ void ph_readout(const Params& P, int l) {
    const int tid = tid_(), lane = tid & 63, wid = tid >> 6;
    const float* OF = (const float*)(P.ws + WS_H); const float* OB = (const float*)(P.ws + WS_Y);
    const bf16_t* z = (const bf16_t*)(P.ws + WS_Z);
    bf16_t* br = (bf16_t*)(P.ws + WS_BR);
    const float g0 = P.in[I_HGN][l * 128 + lane * 2], g1 = P.in[I_HGN][l * 128 + lane * 2 + 1];
    for (int r = bid_() * 8 + wid; r < NTOK; r += gridDim.x * 8) {
#pragma unroll
        for (int h = 0; h < 4; ++h) {
            const int c = h * 128 + lane * 2;
            const float2 a = *(const float2*)(OF + (size_t)r * 512 + c), bb = *(const float2*)(OB + (size_t)r * 512 + c);
            const float o0 = a.x + bb.x, o1 = a.y + bb.y;
            const float ss = wave_sum(o0 * o0 + o1 * o1);
            const float rstd = __builtin_amdgcn_rsqf(ss * (1.0f / 128.0f) + 1e-6f);
            const unsigned gz = *(const unsigned*)(z + (size_t)r * ZP + C_HG + c);
            *(unsigned*)(br + (size_t)r * BRW + 512 + c) = pk_bf16(o0 * rstd * g0 * siluf_(bf_lo(gz)), o1 * rstd * g1 * siluf_(bf_hi(gz)));
        }
    }
}
struct SchedMerge { int G, c; const char* br; const char* wb; bool last;
    __device__ __forceinline__ bool next(int i, pg8::Unit& u) const {
        const int nl = (c < 256) ? (256 - c + G - 1) / G : 0;
        int tile, bi, mode;
        if (i < 3 * nl) { tile = c + (i / 3) * G; bi = i % 3; mode = 0; }
        else { if (last) return false; const int sidx = c + (i - 3 * nl) * G; if (sidx >= 96) return false; tile = 256 + sidx / 3; bi = sidx % 3; mode = 1; }
        const int pm = tile >> 2, pn = tile & 3;
        u.row0 = pm * 256; u.col0 = pn * 256; u.aux = bi | (mode << 4);
        u.A = br + ((size_t)pm * 256 * BRW + bi * 512) * 2; u.B = wb + ((size_t)bi * 1024 + pn * 256) * 512 * 2; return true; } };
struct EpiMerge { const bf16_t* GT; bf16_t* YP; bf16_t* Y; bf16_t* PG;
    __device__ __forceinline__ void operator()(const f32x4 (&acc)[2][2][4][2], const pg8::Unit& u, int wr, int wc, int fr, int fq) const {
        const int tidx = (wr * 4 + wc) * 64 + fq * 16 + fr, bi = u.aux & 15, mode = u.aux >> 4, pm = u.row0 >> 8, pn = u.col0 >> 8;
        const bf16_t* gb = GT + ((size_t)pm * 12 + bi * 4 + pn) * 65536 + tidx * 8;
        if (mode == 1) {
            bf16_t* pb = PG + ((size_t)bi * 32 + (pm - 64) * 4 + pn) * 65536 + tidx * 8;
#pragma unroll
            for (int ai = 0; ai < 2; ++ai)
#pragma unroll
                for (int bj = 0; bj < 2; ++bj) {
                    uint4 g[4];
#pragma unroll
                    for (int m = 0; m < 4; ++m) g[m] = *(const uint4*)(gb + ((ai * 2 + bj) * 4 + m) * 4096);
#pragma unroll
                    for (int m = 0; m < 4; ++m) { const f32x4 v0 = acc[ai][bj][m][0], v1 = acc[ai][bj][m][1];
                        uint4 o; o.x = pk_bf16(bf_lo(g[m].x) * v0[0], bf_hi(g[m].x) * v0[1]); o.y = pk_bf16(bf_lo(g[m].y) * v0[2], bf_hi(g[m].y) * v0[3]);
                        o.z = pk_bf16(bf_lo(g[m].z) * v1[0], bf_hi(g[m].z) * v1[1]); o.w = pk_bf16(bf_lo(g[m].w) * v1[2], bf_hi(g[m].w) * v1[3]);
                        *(uint4*)(pb + ((ai * 2 + bj) * 4 + m) * 4096) = o; }
                }
            return;
        }
        bf16_t* yb = YP + ((size_t)pm * 4 + pn) * 65536 + tidx * 8;
#pragma unroll
        for (int ai = 0; ai < 2; ++ai)
#pragma unroll
            for (int bj = 0; bj < 2; ++bj) {
                uint4 g[4], p[4];
#pragma unroll
                for (int m = 0; m < 4; ++m) g[m] = *(const uint4*)(gb + ((ai * 2 + bj) * 4 + m) * 4096);
                if (bi != 0) {
#pragma unroll
                    for (int m = 0; m < 4; ++m) p[m] = *(const uint4*)(yb + ((ai * 2 + bj) * 4 + m) * 4096);
                } else {
#pragma unroll
                    for (int m = 0; m < 4; ++m) p[m] = make_uint4(0u, 0u, 0u, 0u);
                }
#pragma unroll
                for (int m = 0; m < 4; ++m) { const int k = ((ai * 2 + bj) * 4 + m) * 4096;
                    const f32x4 v0 = acc[ai][bj][m][0], v1 = acc[ai][bj][m][1];
                    const float t[8] = {bf_lo(p[m].x) + bf_lo(g[m].x) * v0[0], bf_hi(p[m].x) + bf_hi(g[m].x) * v0[1], bf_lo(p[m].y) + bf_lo(g[m].y) * v0[2], bf_hi(p[m].y) + bf_hi(g[m].y) * v0[3],
                                        bf_lo(p[m].z) + bf_lo(g[m].z) * v1[0], bf_hi(p[m].z) + bf_hi(g[m].z) * v1[1], bf_lo(p[m].w) + bf_lo(g[m].w) * v1[2], bf_hi(p[m].w) + bf_hi(g[m].w) * v1[3]};
                    if (bi != 2) { uint4 o; o.x = pk_bf16(t[0], t[1]); o.y = pk_bf16(t[2], t[3]); o.z = pk_bf16(t[4], t[5]); o.w = pk_bf16(t[6], t[7]); *(uint4*)(yb + k) = o; }
                    else { const int row = u.row0 + ai * 128 + wr * 64 + m * 16 + fr, col = u.col0 + bj * 128 + wc * 32 + 8 * fq;
                        uint4 o; o.x = pk_bf16(t[0], t[1]); o.y = pk_bf16(t[2], t[3]); o.z = pk_bf16(t[4], t[5]); o.w = pk_bf16(t[6], t[7]);
                        *(uint4*)(Y + (size_t)row * D + col) = o; }
                }
            }
    } };
__device__ __forceinline__ void ph_merge(const Params& P, LAS unsigned char* lds, int l) {
    SchedMerge S{(int)gridDim.x, bid_(), (const char*)(P.ws + WS_BR), (const char*)(P.ws + WS_WBR), l == DEPTH - 1};
    EpiMerge E{(const bf16_t*)(P.ws + WS_GT), (bf16_t*)(P.ws + WS_H), (bf16_t*)(P.ws + WS_Y), (bf16_t*)(P.ws + WS_PG)};
    pg8::gemm_phase(lds, pg8::Gemm{512, BRW, 512}, S, E);
    if (l + 1 < DEPTH && (int)bid_() >= 96) wconv_range(P, lds, l + 1, 0, 16 * 124, (int)bid_() - 96, (int)gridDim.x - 96);
}
struct EpiDelta { bf16_t* DX; const float* mods; int l;
    __device__ __forceinline__ void operator()(const f32x4 (&acc)[2][2][4][2], const pg8::Unit& u, int wr, int wc, int fr, int fq) const {
        const float* gate = mods + ((size_t)l * 9 + row_modrow(u.row0)) * 6144 + 2 * 1024 + u.col0 + wc * 32 + 8 * fq;
        f32x4 gv[2][2];
#pragma unroll
        for (int bj = 0; bj < 2; ++bj)
#pragma unroll
            for (int n = 0; n < 2; ++n) gv[bj][n] = *(const f32x4*)(gate + bj * 128 + n * 4);
#pragma unroll
        for (int ai = 0; ai < 2; ++ai)
#pragma unroll
            for (int m = 0; m < 4; ++m)
#pragma unroll
                for (int bj = 0; bj < 2; ++bj) { const int row = u.row0 + ai * 128 + wr * 64 + m * 16 + fr, col = u.col0 + bj * 128 + wc * 32 + 8 * fq;
                    const f32x4 v0 = acc[ai][bj][m][0] * gv[bj][0], v1 = acc[ai][bj][m][1] * gv[bj][1];
                    uint4 o; o.x = pk_bf16(v0[0], v0[1]); o.y = pk_bf16(v0[2], v0[3]); o.z = pk_bf16(v1[0], v1[1]); o.w = pk_bf16(v1[2], v1[3]);
                    *(uint4*)(DX + (size_t)row * D + col) = o; }
    } };
struct SchedWout { int G, c; const char* A; const char* B; bool last;
    __device__ __forceinline__ bool next(int i, pg8::Unit& u) const {
        const int nc = (!last && c < 32) ? 1 : 0;
        int tile;
        if (i < nc) tile = 256 + c; else { tile = c + (i - nc) * G; if (tile >= 256) return false; }
        const int pm = tile >> 2, pn = tile & 3;
        u.row0 = pm * 256; u.col0 = pn * 256; u.aux = 0; u.A = A + (size_t)pm * 256 * D * 2; u.B = B + (size_t)pn * 256 * D * 2; return true; } };
__device__ __forceinline__ void ph_wout(const Params& P, LAS unsigned char* lds, int l, bool dry = false) {
    const bool last = (l == DEPTH - 1);
    const int c = bid_();
    if (!last && c < 32) {
        const int tid = tid_(), wid = tid >> 6, lane = tid & 63, wr = wid >> 2, wc = wid & 3, fr = lane & 15, fq = lane >> 4;
        const bf16_t* PG = (const bf16_t*)(P.ws + WS_PG); bf16_t* Y = (bf16_t*)(P.ws + WS_Y);
        const int pp = c >> 2;
        for (int pn = 0; pn < 4; ++pn)
#pragma unroll
            for (int kk = 0; kk < 16; ++kk) {
                const size_t off = ((size_t)pp * 4 + pn) * 65536 + kk * 4096 + tid * 8;
                const uint4 a = *(const uint4*)(PG + off), b = *(const uint4*)(PG + (size_t)32 * 65536 + off), d = *(const uint4*)(PG + (size_t)64 * 65536 + off);
                const int ai = kk >> 3, bj = (kk >> 2) & 1, m = kk & 3;
                const int row = (64 + pp) * 256 + ai * 128 + wr * 64 + m * 16 + fr, col = pn * 256 + bj * 128 + wc * 32 + 8 * fq;
                uint4 o;
                o.x = pk_bf16(bf_lo(a.x) + bf_lo(b.x) + bf_lo(d.x), bf_hi(a.x) + bf_hi(b.x) + bf_hi(d.x)); o.y = pk_bf16(bf_lo(a.y) + bf_lo(b.y) + bf_lo(d.y), bf_hi(a.y) + bf_hi(b.y) + bf_hi(d.y));
                o.z = pk_bf16(bf_lo(a.z) + bf_lo(b.z) + bf_lo(d.z), bf_hi(a.z) + bf_hi(b.z) + bf_hi(d.z)); o.w = pk_bf16(bf_lo(a.w) + bf_lo(b.w) + bf_lo(d.w), bf_hi(a.w) + bf_hi(b.w) + bf_hi(d.w));
                *(uint4*)(Y + (size_t)row * D + col) = o;
            }
        asm volatile("s_waitcnt vmcnt(0)" ::: "memory");
        __syncthreads();
    }
    SchedWout S{(int)gridDim.x, c, (const char*)(P.ws + WS_Y), (const char*)(P.ws + WS_WOUT), last};
    EpiDelta E{(bf16_t*)(P.ws + (dry ? WS_END : WS_BR)), (const float*)(P.ws + WS_MODS), l};
    pg8::gemm_phase(lds, pg8::Gemm{D, D, D}, S, E);
    if (!dry) { if (last) wconv_range(P, lds, l, CONV_T_DENSE, CONV_T_ALL, c, (int)gridDim.x); else if (c >= 32) wconv_range(P, lds, l, CONV_T_DENSE, CONV_T_ALL, c - 32, (int)gridDim.x - 32); }
}
__device__ __forceinline__ void ph_norm2_route(const Params& P, LAS unsigned char* lds, int l, bool dry = false) {
    const int tid = tid_(), lane = tid & 63, wid = tid >> 6;
    LAS float* Wt = (LAS float*)lds;
    LAS int* lcnt = (LAS int*)(lds + 81920); LAS int* lbase = lcnt + 16; LAS int* rinfo = lbase + 16;
    LAS float* rw = (LAS float*)(rinfo + 128 * 4);
    { const f32x4* rt4 = (const f32x4*)((const float*)(P.ws + WS_RT) + (size_t)l * 20480);
      for (int i = tid; i < 5 * 1024; i += NTHR) *(LAS f32x4*)(Wt + i * 4) = rt4[i]; }
    if (tid < 16) lcnt[tid] = 0;
    __syncthreads();
    const float* xres = (const float*)(P.ws + WS_X);
    const bf16_t* dx = (const bf16_t*)(P.ws + WS_BR);
    bf16_t* f = (bf16_t*)(P.ws + (dry ? WS_END : WS_H));
    const float* g = P.in[I_GFFN] + l * 1024;
    int* cnt = (int*)(P.ws + (dry ? 32768 : WS_CNT)) + l * 16;
    int* sel_e = (int*)(P.ws + (dry ? WS_END + 40000000 : WS_SELE)); float* sel_w = (float*)(P.ws + (dry ? WS_END + 41000000 : WS_SELW)); int* sel_p = (int*)(P.ws + (dry ? WS_END + 42000000 : WS_SELP));
    const int NR = (l == DEPTH - 1) ? NLAT : NTOK;
    const int r0 = bid_() * 8, rstep = gridDim.x * 8;
    int it = 0;
    for (int r = r0 + wid; r < NR; r += rstep, ++it) {
        const float* mod = (const float*)(P.ws + WS_MODS) + ((size_t)l * 9 + row_modrow(r)) * 6144;
        float4 x[4], o[4];
#pragma unroll
        for (int i = 0; i < 4; ++i) { x[i] = *(const float4*)(xres + (size_t)r * D + lane * 4 + 256 * i);
            const uint2 dv = *(const uint2*)(dx + (size_t)r * D + lane * 4 + 256 * i);
            x[i].x += bf_lo(dv.x); x[i].y += bf_hi(dv.x); x[i].z += bf_lo(dv.y); x[i].w += bf_hi(dv.y); }
        norm_row(x, g, mod + 3 * 1024, mod + 4 * 1024, lane, o);
#pragma unroll
        for (int i = 0; i < 4; ++i) { uint2 u; u.x = pk_bf16(o[i].x, o[i].y); u.y = pk_bf16(o[i].z, o[i].w); *(uint2*)(f + (size_t)r * D + lane * 4 + 256 * i) = u; }
        float lg[20];
#pragma unroll
        for (int j = 0; j < 20; ++j) {
            float s = 0.f;
#pragma unroll
            for (int i = 0; i < 4; ++i) { const f32x4 w = *(const LAS f32x4*)(Wt + j * 1024 + lane * 4 + 256 * i); s += o[i].x * w[0] + o[i].y * w[1] + o[i].z * w[2] + o[i].w * w[3]; }
            lg[j] = wave_sum(s);
        }
        if (lane == 0) {
            float gl[4]; int gi = 0;
#pragma unroll
            for (int j = 0; j < 4; ++j) gl[j] = lg[j] + P.in[I_BGR][l * 4 + j];
            float gm = gl[0];
#pragma unroll
            for (int j = 1; j < 4; ++j) if (gl[j] > gm) { gm = gl[j]; gi = j; }
            float se = 0.f;
#pragma unroll
            for (int j = 0; j < 4; ++j) se += __expf(gl[j] - gm);
            const float pg = __builtin_amdgcn_rcpf(se);
            float el[4];
#pragma unroll
            for (int j = 0; j < 4; ++j) {
                float v = 0.f;
#pragma unroll
                for (int q = 0; q < 4; ++q) v = (gi == q) ? lg[4 + q * 4 + j] : v;
                el[j] = v + P.in[I_BER][l * 16 + gi * 4 + j];
            }
            int i0 = 0; float v0 = el[0];
#pragma unroll
            for (int j = 1; j < 4; ++j) if (el[j] > v0) { v0 = el[j]; i0 = j; }
            int i1 = -1; float v1 = -INFINITY;
#pragma unroll
            for (int j = 0; j < 4; ++j) if (j != i0 && el[j] > v1) { v1 = el[j]; i1 = j; }
            const float w0 = __builtin_amdgcn_rcpf(1.0f + __expf(v1 - v0)), w1 = 1.0f - w0;
            const int e0 = gi * 4 + i0, e1 = gi * 4 + i1;
            const int slot = it * 8 + wid;
            rinfo[slot * 4 + 0] = e0 | (e1 << 8);
            rinfo[slot * 4 + 1] = __hip_atomic_fetch_add(&lcnt[e0], 1, __ATOMIC_RELAXED, __HIP_MEMORY_SCOPE_WORKGROUP);
            rinfo[slot * 4 + 2] = __hip_atomic_fetch_add(&lcnt[e1], 1, __ATOMIC_RELAXED, __HIP_MEMORY_SCOPE_WORKGROUP);
            rw[slot * 2] = w0 * pg; rw[slot * 2 + 1] = w1 * pg;
        }
    }
    __syncthreads();
    if (tid < 16) lbase[tid] = atomicAdd(&cnt[tid], lcnt[tid]);
    __syncthreads();
    for (int slot = tid; slot < 128; slot += NTHR) {
        const int r = r0 + (slot & 7) + (slot >> 3) * rstep;
        if (r < NR) { const int ee = rinfo[slot * 4], e0 = ee & 255, e1 = ee >> 8;
            sel_e[r * 2] = e0; sel_e[r * 2 + 1] = e1;
            sel_w[r * 2] = rw[slot * 2]; sel_w[r * 2 + 1] = rw[slot * 2 + 1];
            sel_p[r * 2] = lbase[e0] + rinfo[slot * 4 + 1]; sel_p[r * 2 + 1] = lbase[e1] + rinfo[slot * 4 + 2]; }
    }
    __syncthreads();
}
__device__ __forceinline__ void moe_offsets(const int* cnt, int (&off)[17]) {
    int a = 0;
#pragma unroll
    for (int e = 0; e < 16; ++e) { off[e] = a; a += (cnt[e] + 255) & ~255; }
    off[16] = a;
}
__device__ __forceinline__ void ph_scatter(const Params& P, int l) {
    const int tid = tid_(), lane = tid & 63, wid = tid >> 6;
    const int* cnt = (const int*)(P.ws + WS_CNT) + l * 16;
    int off[17]; moe_offsets(cnt, off);
    const bf16_t* f = (const bf16_t*)(P.ws + WS_H); bf16_t* Fs = (bf16_t*)(P.ws + WS_FS);
    const int* sel_e = (const int*)(P.ws + WS_SELE); const int* sel_p = (const int*)(P.ws + WS_SELP); int* srow = (int*)(P.ws + WS_SROW);
    for (int r = bid_() * 8 + wid; r < ((l == DEPTH - 1) ? NLAT : NTOK); r += gridDim.x * 8) {
        const uint4 a = *(const uint4*)(f + (size_t)r * D + lane * 8), b = *(const uint4*)(f + (size_t)r * D + 512 + lane * 8);
#pragma unroll
        for (int k = 0; k < 2; ++k) {
            const int e = sel_e[r * 2 + k];
            int o = 0;
#pragma unroll
            for (int q = 0; q < 16; ++q) o = (e == q) ? off[q] : o;
            const int d = o + sel_p[r * 2 + k];
            *(uint4*)(Fs + (size_t)d * D + lane * 8) = a; *(uint4*)(Fs + (size_t)d * D + 512 + lane * 8) = b;
            if (lane == 0) srow[r * 2 + k] = d;
        }
    }
}
struct SchedMoe { int NM, G, c; int tfirst[16]; const char* A; const char* W; size_t tA, eW, tW;
    __device__ __forceinline__ bool next(int i, pg8::Unit& u) const {
        const int L = i * G + c; if (L >= NM * 4) return false;
        const int pm = L >> 2, pn = L & 3;
        int e = 0;
#pragma unroll
        for (int q = 1; q < 16; ++q) e += (pm >= tfirst[q]) ? 1 : 0;
        u.row0 = pm * 256; u.col0 = pn * 256; u.aux = e; u.A = A + (size_t)pm * tA; u.B = W + (size_t)e * eW + (size_t)pn * tW; return true; } };
struct FSwiglu { bf16_t* H;
    __device__ __forceinline__ void operator()(const pg8::Unit&, int row, int col, const f32x4& v0, const f32x4& v1) const {
        const int hc = ((col & ~31) >> 1) + (col & 15);
        uint2 a; a.x = pk_bf16(siluf_(v0[0]) * v1[0], siluf_(v0[1]) * v1[1]); a.y = pk_bf16(siluf_(v0[2]) * v1[2], siluf_(v0[3]) * v1[3]);
        *(uint2*)(H + (size_t)row * EH + hc) = a; } };
__device__ __forceinline__ void moe_sched(const Params& P, int l, SchedMoe& S) {
    const int* cnt = (const int*)(P.ws + WS_CNT) + l * 16;
    int a = 0;
#pragma unroll
    for (int e = 0; e < 16; ++e) { S.tfirst[e] = a; a += (cnt[e] + 255) >> 8; }
    S.NM = a; S.G = (int)gridDim.x; S.c = bid_();
}
__device__ __forceinline__ void ph_moe1(const Params& P, LAS unsigned char* lds, int l) {
    SchedMoe S; moe_sched(P, l, S);
    S.A = (const char*)(P.ws + WS_FS); S.W = (const char*)(P.ws + WS_WGU); S.tA = (size_t)256 * D * 2; S.eW = (size_t)1024 * 1024 * 2; S.tW = (size_t)256 * 1024 * 2;
    pg8::EpiPair<FSwiglu> E{{(bf16_t*)(P.ws + WS_HS)}};
    pg8::gemm_phase(lds, pg8::Gemm{1024, 1024, 1024}, S, E);
}
__device__ __forceinline__ void ph_moe2(const Params& P, LAS unsigned char* lds, int l) {
    SchedMoe S; moe_sched(P, l, S);
    S.A = (const char*)(P.ws + WS_HS); S.W = (const char*)(P.ws + WS_WDN); S.tA = (size_t)256 * EH * 2; S.eW = (size_t)1024 * 512 * 2; S.tW = (size_t)256 * 512 * 2;
    EpiStore16 E{(bf16_t*)(P.ws + WS_YS), D};
    pg8::gemm_phase(lds, pg8::Gemm{512, 512, 512}, S, E);
}
__device__ __forceinline__ void ph_combine(const Params& P, int l, bool dry = false) {
    const int tid = tid_(), lane = tid & 63, wid = tid >> 6;
    float* xres = (float*)(P.ws + WS_X);
    const bf16_t* Ys = (const bf16_t*)(P.ws + WS_YS);
    const float* sel_w = (const float*)(P.ws + WS_SELW); const int* srow = (const int*)(P.ws + WS_SROW);
    bf16_t* h = (bf16_t*)(P.ws + (dry ? WS_END : WS_H));
    const bf16_t* dxb = (const bf16_t*)(P.ws + WS_BR);
    for (int r = bid_() * 8 + wid; r < ((l == DEPTH - 1) ? NLAT : NTOK); r += gridDim.x * 8) {
        const float* gate = (const float*)(P.ws + WS_MODS) + ((size_t)l * 9 + row_modrow(r)) * 6144 + 5 * 1024;
        const float w0 = sel_w[r * 2], w1 = sel_w[r * 2 + 1];
        const bf16_t* y0 = Ys + (size_t)srow[r * 2] * D; const bf16_t* y1 = Ys + (size_t)srow[r * 2 + 1] * D;
        float4 x[4];
#pragma unroll
        for (int i = 0; i < 4; ++i) {
            const int c = lane * 4 + 256 * i;
            x[i] = *(const float4*)(xres + (size_t)r * D + c);
            { const uint2 dv = *(const uint2*)(dxb + (size_t)r * D + c); x[i].x += bf_lo(dv.x); x[i].y += bf_hi(dv.x); x[i].z += bf_lo(dv.y); x[i].w += bf_hi(dv.y); }
            const uint2 a = *(const uint2*)(y0 + c), b = *(const uint2*)(y1 + c);
            const float4 gv = *(const float4*)(gate + c);
            x[i].x += gv.x * (w0 * bf_lo(a.x) + w1 * bf_lo(b.x)); x[i].y += gv.y * (w0 * bf_hi(a.x) + w1 * bf_hi(b.x));
            x[i].z += gv.z * (w0 * bf_lo(a.y) + w1 * bf_lo(b.y)); x[i].w += gv.w * (w0 * bf_hi(a.y) + w1 * bf_hi(b.y));
        }
        if (l < DEPTH - 1) {
#pragma unroll
            for (int i = 0; i < 4; ++i) *(float4*)((dry ? (float*)(P.ws + WS_END) + (size_t)NTOK * 512 : xres) + (size_t)r * D + lane * 4 + 256 * i) = x[i];
            const float* mod = (const float*)(P.ws + WS_MODS) + ((size_t)(l + 1) * 9 + row_modrow(r)) * 6144;
            float4 o[4];
            norm_row(x, P.in[I_GMIX] + (l + 1) * 1024, mod, mod + 1024, lane, o);
#pragma unroll
            for (int i = 0; i < 4; ++i) { uint2 u; u.x = pk_bf16(o[i].x, o[i].y); u.y = pk_bf16(o[i].z, o[i].w); *(uint2*)(h + (size_t)r * D + lane * 4 + 256 * i) = u; }
        } else if (r < NLAT) {
            float ss = 0.f;
#pragma unroll
            for (int i = 0; i < 4; ++i) ss += x[i].x * x[i].x + x[i].y * x[i].y + x[i].z * x[i].z + x[i].w * x[i].w;
            ss = wave_sum(ss);
            const float rstd = __builtin_amdgcn_rsqf(ss * (1.0f / 1024.0f) + 1e-6f);
#pragma unroll
            for (int i = 0; i < 4; ++i) {
                const int c = lane * 4 + 256 * i;
                const float4 gv = *(const float4*)(P.in[I_GFIN] + c);
                float4 o; o.x = x[i].x * rstd * gv.x; o.y = x[i].y * rstd * gv.y; o.z = x[i].z * rstd * gv.z; o.w = x[i].w * rstd * gv.w;
                *(float4*)((dry ? (float*)(P.ws + WS_END) : P.out) + (size_t)r * D + c) = o;
            }
        }
    }
}

constexpr int NPH_LAYER = 12, NPH = 1 + DEPTH * NPH_LAYER;
#define CAS __attribute__((address_space(4)))
__device__ __forceinline__ const Params& kparams() { const CAS Params* k = (const CAS Params*)__builtin_amdgcn_kernarg_segment_ptr(); asm volatile("" : "+s"(k)); return *(const Params*)k; }
__global__ void __launch_bounds__(NTHR, 2) fwd(Params P_) {
    extern __shared__ __attribute__((aligned(16))) unsigned char lds_raw[];
    LAS unsigned char* lds = (LAS unsigned char*)lds_raw;
    volatile LAS unsigned* xbw = (volatile LAS unsigned*)(lds + LDS_BYTES - 16);
    if (threadIdx.x == 0) { xbw[0] = 0u; xbw[1] = 0u; xbw[2] = 0u; xbw[3] = 0u; }
    __syncthreads();
    const int lo = P_.ph_lo, hi = P_.ph_hi;
    XcdBarrier bar; bar.bar = (unsigned*)(P_.ws + WS_BAR); bar.x = 0; bar.st = xbw;
    if (hi - lo > 1) bar = xcd_barrier_post((unsigned*)(P_.ws + WS_BAR), xbw);
#ifndef PHMASK
#define PHMASK 0xFFFF
#endif
#define EN(j) ((PHMASK >> (j)) & 1)
#define IN(k) (lo <= (k) && (k) < hi)
#define SEAM(k) do { if (IN(k) && IN((k) + 1)) xcd_barrier(bar); } while (0)
    if (EN(12) && IN(0)) for (int rep = 0; rep < NREP(12); ++rep) { ph_prologue(kparams(), lds); }
    SEAM(0);
    for (int l = 0; l < DEPTH; ++l) {
        const int p0 = 1 + l * NPH_LAYER;
        if (l == 0) { if (EN(0) && IN(p0 + 0)) for (int rep = 0; rep < NREP(0); ++rep) { ph_wconv(kparams(), lds, l); ph_norm1(kparams(), l); }
        SEAM(p0 + 0); }
        if (EN(1) && IN(p0 + 1)) for (int rep = 0; rep < NREP(1); ++rep) ph_g1(kparams(), lds);
        SEAM(p0 + 1);
        if (EN(2) && IN(p0 + 2)) for (int rep = 0; rep < NREP(2); ++rep) { ph_prep(kparams(), l); ph_navt(kparams(), lds); }
        SEAM(p0 + 2);
        if (EN(3) && IN(p0 + 3)) { ph_mix(kparams(), lds, (char*)lds_raw, l);
            if (REPEAT_MASK & 0x8) { xcd_barrier(bar); ph_mix(kparams(), lds, (char*)lds_raw, l, 1, 0); }
            if (REPEAT_MASK & 0x2000) { xcd_barrier(bar); ph_mix(kparams(), lds, (char*)lds_raw, l, 1, 1); }
            if (REPEAT_MASK & 0x4000) { xcd_barrier(bar); ph_mix(kparams(), lds, (char*)lds_raw, l, 1, 2); }
            if (REPEAT_MASK & 0x8000) { xcd_barrier(bar); ph_mix(kparams(), lds, (char*)lds_raw, l, 1, 3); } }
        SEAM(p0 + 3);
        if (EN(4) && IN(p0 + 4)) for (int rep = 0; rep < NREP(4); ++rep) {
#if defined(DIAG) && DIAG == 5
            { const Params& Pq = kparams(); const int G_ = gridDim.x, c_ = bid_(), vcu_ = (c_ % 8) * (G_ / 8) + c_ / 8; for (int u = vcu_; u < 320; u += G_) na_unit(Pq, lds, l, u, (bf16_t*)(Pq.ws + WS_BR), BRW); __syncthreads(); }
#endif
            ph_readout(kparams(), l);
#if defined(DIAG) && (DIAG == 1 || DIAG == 4)
            ph_diag_cmp(kparams());
#endif
#if defined(DIAG) && DIAG == 3
            { const Params& Pq = kparams(); const uint4* d1 = (const uint4*)(Pq.ws + WS_END); bf16_t* brq = (bf16_t*)(Pq.ws + WS_BR);
              for (size_t i = (size_t)bid_() * NTHR + tid_(); i < (size_t)NTOK * 64; i += (size_t)gridDim.x * NTHR) { const size_t r = i >> 6; const int c8 = (int)(i & 63) * 8; *(uint4*)(brq + r * BRW + c8) = d1[i]; } }
#endif
        }
        SEAM(p0 + 4);
        if (EN(5) && IN(p0 + 5)) for (int rep = 0; rep < NREP(5); ++rep) ph_merge(kparams(), lds, l);
        SEAM(p0 + 5);
        if (EN(6) && IN(p0 + 6)) for (int rep = 0; rep < NREP(6); ++rep) ph_wout(kparams(), lds, l, rep > 0);
        SEAM(p0 + 6);
        if (EN(7) && IN(p0 + 7)) for (int rep = 0; rep < NREP(7); ++rep) ph_norm2_route(kparams(), lds, l, rep > 0);
        SEAM(p0 + 7);
        if (EN(8) && IN(p0 + 8)) for (int rep = 0; rep < NREP(8); ++rep) ph_scatter(kparams(), l);
        SEAM(p0 + 8);
        if (EN(9) && IN(p0 + 9)) for (int rep = 0; rep < NREP(9); ++rep) ph_moe1(kparams(), lds, l);
        SEAM(p0 + 9);
        if (EN(10) && IN(p0 + 10)) for (int rep = 0; rep < NREP(10); ++rep) ph_moe2(kparams(), lds, l);
        SEAM(p0 + 10);
        if (EN(11) && IN(p0 + 11)) for (int rep = 0; rep < NREP(11); ++rep) { ph_combine(kparams(), l, rep > 0); if (l + 1 < DEPTH) wconv_range(kparams(), lds, l + 1, 16 * 124, CONV_T_DENSE, bid_(), gridDim.x); }
        if (l + 1 < DEPTH) { if (IN(p0 + 11) && IN(p0 + 13)) xcd_barrier(bar); }
    }
#if defined(DIAG) && (DIAG == 1 || DIAG == 4)
    xcd_barrier(bar); ph_diag_out(kparams());
#endif
#undef IN
#undef SEAM
}

#ifndef MK_PER_PHASE
#define MK_PER_PHASE 0
#endif
extern "C" void kernel_launch(void* const* d_in, const int* in_sizes, int n_in, void* d_out, int out_size, void* d_ws, size_t ws_size, hipStream_t stream) {
    static int grid = 0;
    if (grid == 0) {
        if (n_in != 24 || out_size != NLAT * D || ws_size < WS_END + (size_t)NTOK * 4096 + 4096) { fprintf(stderr, "kernel_launch: unexpected shapes (n_in %d out %d ws %zu need %zu)\n", n_in, out_size, ws_size, (size_t)WS_END); grid = -1; return; }
        int dev = 0, cus = 0, per_cu = 0;
        if (hipGetDevice(&dev) != hipSuccess || hipDeviceGetAttribute(&cus, hipDeviceAttributeMultiprocessorCount, dev) != hipSuccess) { grid = -1; return; }
        if (hipFuncSetAttribute((const void*)fwd, hipFuncAttributeMaxDynamicSharedMemorySize, LDS_BYTES) != hipSuccess) { fprintf(stderr, "kernel_launch: hipFuncSetAttribute failed\n"); grid = -1; return; }
        if (hipOccupancyMaxActiveBlocksPerMultiprocessor(&per_cu, (const void*)fwd, NTHR, LDS_BYTES) != hipSuccess || per_cu < 1) { fprintf(stderr, "kernel_launch: occupancy query says %d\n", per_cu); }
        (void)hipGetLastError();
        grid = cus;
    }
    if (grid < 0) return;
    (void)hipMemsetAsync(d_ws, 0, WS_ZERO_BYTES, stream);
    Params p{};
    for (int i = 0; i < 24; ++i) p.in[i] = (const float*)d_in[i];
    p.out = (float*)d_out; p.ws = (unsigned char*)d_ws;
#if MK_PER_PHASE
    for (int ph = 0; ph < NPH; ++ph) { p.ph_lo = ph; p.ph_hi = ph + 1; hipLaunchKernelGGL(fwd, dim3(grid), dim3(NTHR), LDS_BYTES, stream, p); }
#else
    p.ph_lo = 0; p.ph_hi = NPH; hipLaunchKernelGGL(fwd, dim3(grid), dim3(NTHR), LDS_BYTES, stream, p);
#endif
}
```

```cpp
#include <hip/hip_runtime.h>
#include <cstdio>
#include <cstdint>

#define LAS __attribute__((address_space(3)))
typedef unsigned short bf16_t;
typedef short bf16x8 __attribute__((ext_vector_type(8)));
typedef float f32x4 __attribute__((ext_vector_type(4)));
typedef unsigned u32x4 __attribute__((ext_vector_type(4)));

constexpr int D = 1024, NB = 8, SEQ = 2048, DEPTH = 4, CTXL = 256;
constexpr int NLAT = NB * SEQ, NCTX = NB * CTXL, NTOK = NLAT + NCTX;
constexpr int INC = 7936;
constexpr int ZP = 4864;
constexpr int C_NAQ = 0, C_NAK = 512, C_NAV = 1024, C_HQ = 1536, C_HFF = 2048, C_HFB = 2560, C_HI = 3072, C_HG = 3584,
              C_GQ = 4096, C_GK = 4608, C_GV = 4736, C_GATE = 4864;
constexpr int BRW = 1536;
constexpr int NEXP = 16, EH = 512;
constexpr int MPAD = 40960;
constexpr int NTHR = 512;
constexpr int LDS_BYTES = 147456;

constexpr size_t WS_BAR = 0;
constexpr size_t WS_CNT = 16384;
constexpr size_t WS_ZERO_BYTES = 65536;
constexpr size_t WS_MODS = 65536;
constexpr size_t WS_LB = WS_MODS + 884736;
constexpr size_t WS_ROPE = WS_LB + 16384;
constexpr size_t WS_SELE = WS_ROPE + 12288;
constexpr size_t WS_SELW = WS_SELE + 147456;
constexpr size_t WS_SELP = WS_SELW + 147456;
constexpr size_t WS_SROW = WS_SELP + 147456;
constexpr size_t WS_X = 2097152;
constexpr size_t WS_H = WS_X + (size_t)NTOK * D * 4;
constexpr size_t WS_Z = WS_H + (size_t)NTOK * D * 2;
constexpr size_t WS_GT = WS_Z + (size_t)NTOK * ZP * 2;
constexpr size_t WS_BR = WS_GT + (size_t)NTOK * 3072 * 2;
constexpr size_t WS_Y = WS_BR + (size_t)NTOK * BRW * 2;
constexpr size_t WS_QN = WS_Y + (size_t)NTOK * D * 2;
constexpr size_t WS_KN = WS_QN + (size_t)NTOK * 512 * 2;
constexpr size_t WS_VN = WS_KN + (size_t)NTOK * 128 * 2;
constexpr size_t WS_NAVT = WS_VN + (size_t)NTOK * 128 * 2;
constexpr size_t WS_WIN = WS_NAVT + (size_t)NTOK * 512 * 2;
constexpr size_t WS_WBR = WS_WIN + (size_t)INC * D * 2;
constexpr size_t WS_WOUT = WS_WBR + (size_t)3 * D * 512 * 2;
constexpr size_t WS_WGU = WS_WOUT + (size_t)D * D * 2;
constexpr size_t WS_WDN = WS_WGU + (size_t)NEXP * 1024 * 1024 * 2;
constexpr size_t WS_PG = WS_WDN + (size_t)NEXP * 1024 * 512 * 2;
constexpr size_t WS_END = WS_PG + (size_t)96 * 65536 * 2;
constexpr size_t WS_FS = WS_Z;
constexpr size_t WS_HS = WS_FS + (size_t)MPAD * 1024 * 2;
constexpr size_t WS_YS = WS_HS + (size_t)MPAD * 512 * 2;
static_assert(WS_YS + (size_t)MPAD * 1024 * 2 <= WS_BR, "moe alias");
constexpr size_t WS_RT = WS_SROW + 147456;
static_assert(WS_RT + 327680 <= WS_X, "ctl");

#define XB_TMO      128
#define XB_XCNT(j)  (256  + 64 * (j))
#define XB_XSUB(j)  (1280 + 64 * (j))
#define XB_XGEN(j)  (2304 + 64 * (j))
#define XB_TOP      3328
#define XB_TOPGEN   3392
#define XCD_BAR_WORDS 3456
#define XB_SPIN_CAP (1u << 22)
__device__ __forceinline__ unsigned xb_ld(unsigned* p)              { return __hip_atomic_load(p, __ATOMIC_RELAXED, __HIP_MEMORY_SCOPE_AGENT); }
__device__ __forceinline__ unsigned xb_add(unsigned* p, unsigned v) { return __hip_atomic_fetch_add(p, v, __ATOMIC_RELAXED, __HIP_MEMORY_SCOPE_AGENT); }
__device__ __forceinline__ unsigned xb_xcc_id() { return (unsigned)__builtin_amdgcn_s_getreg((3 << 11) | 20) & 0xFu; }
#define XB_SPIN(cond, bar) do { unsigned _sp = 0; while (cond) { __builtin_amdgcn_s_sleep(1); \
    if ((++_sp & 255u) == 0u) { if (xb_ld(&(bar)[XB_TMO])) break; if (_sp > XB_SPIN_CAP) { atomicAdd(&(bar)[XB_TMO], 1u); break; } } } } while (0)
struct XcdBarrier { unsigned* bar; unsigned x; volatile LAS unsigned* st; };
__device__ __forceinline__ XcdBarrier xcd_barrier_post(unsigned* bar, volatile LAS unsigned* st) {
    XcdBarrier b; b.bar = bar; b.x = xb_xcc_id(); b.st = st;
    if (threadIdx.x == 0) (void)xb_add(&bar[XB_XCNT(b.x)], 1u);
    return b;
}
__device__ __forceinline__ void xcd_barrier_complete(unsigned* bar, unsigned x, unsigned& nloc, unsigned& nx) {
    const unsigned G = gridDim.x * gridDim.y * gridDim.z;
    unsigned sum, cnt, mine, sp = 0u;
    for (;;) {
        sum = 0u; cnt = 0u; mine = 0u;
#pragma unroll
        for (unsigned j = 0; j < 16; ++j) { const unsigned c = xb_ld(&bar[XB_XCNT(j)]); sum += c; cnt += (c > 0u) ? 1u : 0u; mine = (j == x) ? c : mine; }
        if (sum == G) break;
        __builtin_amdgcn_s_sleep(1);
        if ((++sp & 255u) == 0u) { if (xb_ld(&bar[XB_TMO])) break; if (sp > XB_SPIN_CAP) { atomicAdd(&bar[XB_TMO], 1u); break; } }
    }
    nloc = mine > 0u ? mine : 1u; nx = cnt > 0u ? cnt : 1u;
}
__device__ __forceinline__ void xcd_barrier(const XcdBarrier& b) {
    asm volatile("s_waitcnt vmcnt(0)" ::: "memory");
    __syncthreads();
    if (threadIdx.x == 0) {
        unsigned* bar = b.bar;
        __builtin_amdgcn_s_waitcnt(0);
        unsigned nloc = b.st[0], nx = b.st[1];
        if (nloc == 0u) { xcd_barrier_complete(bar, b.x, nloc, nx); b.st[0] = nloc; b.st[1] = nx; }
        const unsigned old = xb_add(&bar[XB_XSUB(b.x)], 1u);
        const unsigned gen = old / nloc;
        if (old + 1u == (gen + 1u) * nloc) {
            __builtin_amdgcn_fence(__ATOMIC_RELEASE, "agent");
            asm volatile("s_waitcnt vmcnt(0)" ::: "memory");
            const unsigned og = xb_add(&bar[XB_TOP], 1u);
            const unsigned tg = og / nx;
            if (og + 1u == (tg + 1u) * nx) xb_add(&bar[XB_TOPGEN], 1u);
            else XB_SPIN(xb_ld(&bar[XB_TOPGEN]) == tg, bar);
            __builtin_amdgcn_fence(__ATOMIC_ACQUIRE, "agent");
            xb_add(&bar[XB_XGEN(b.x)], 1u);
            asm volatile("s_waitcnt vmcnt(0)" ::: "memory");
        } else {
            XB_SPIN(xb_ld(&bar[XB_XGEN(b.x)]) == gen, bar);
            __builtin_amdgcn_fence(__ATOMIC_ACQUIRE, "agent");
            asm volatile("s_waitcnt vmcnt(0)" ::: "memory");
        }
    }
    __syncthreads();
}

__device__ __forceinline__ float bf_lo(unsigned u) { return __uint_as_float(u << 16); }
__device__ __forceinline__ float bf_hi(unsigned u) { return __uint_as_float(u & 0xffff0000u); }
__device__ __forceinline__ float bf2f(bf16_t b) { return __uint_as_float(((unsigned)b) << 16); }
typedef float pkf32x2_t __attribute__((ext_vector_type(2))); typedef __bf16 pkbf16x2_t __attribute__((ext_vector_type(2)));
__device__ __forceinline__ unsigned pk_bf16(float lo, float hi) { pkf32x2_t v = {lo, hi}; pkbf16x2_t b = __builtin_convertvector(v, pkbf16x2_t); return __builtin_bit_cast(unsigned, b); }
__device__ __forceinline__ bf16x8 pack8(const float (&v)[8]) { u32x4 u = {pk_bf16(v[0], v[1]), pk_bf16(v[2], v[3]), pk_bf16(v[4], v[5]), pk_bf16(v[6], v[7])}; return __builtin_bit_cast(bf16x8, u); }
__device__ __forceinline__ float sigmoidf_(float x) { return __builtin_amdgcn_rcpf(1.0f + __expf(-x)); }
__device__ __forceinline__ float siluf_(float x) { return x * __builtin_amdgcn_rcpf(1.0f + __expf(-x)); }
__device__ __forceinline__ float dpp_f(float v, const int ctrl_sel) {
    const int x = __float_as_int(v);
    int r;
    if (ctrl_sel == 0) r = __builtin_amdgcn_update_dpp(0, x, 0xB1, 0xF, 0xF, true);
    else if (ctrl_sel == 1) r = __builtin_amdgcn_update_dpp(0, x, 0x4E, 0xF, 0xF, true);
    else if (ctrl_sel == 2) r = __builtin_amdgcn_update_dpp(0, x, 0x141, 0xF, 0xF, true);
    else r = __builtin_amdgcn_update_dpp(0, x, 0x140, 0xF, 0xF, true);
    return __int_as_float(r);
}
__device__ __forceinline__ float wave_sum(float v) {
    v += dpp_f(v, 0); v += dpp_f(v, 1); v += dpp_f(v, 2); v += dpp_f(v, 3);
    { auto rr = __builtin_amdgcn_permlane16_swap(__float_as_uint(v), __float_as_uint(v), false, false); v = __uint_as_float(rr[0]) + __uint_as_float(rr[1]); }
    { auto rr = __builtin_amdgcn_permlane32_swap(__float_as_uint(v), __float_as_uint(v), false, false); v = __uint_as_float(rr[0]) + __uint_as_float(rr[1]); }
    return v;
}

__device__ __forceinline__ int tid_() { int t = threadIdx.x; asm volatile("" : "+v"(t)); return t; }
__device__ __forceinline__ int bid_() { int t = blockIdx.x; asm volatile("" : "+s"(t)); return t; }
#ifndef REPEAT_MASK
#define REPEAT_MASK 0
#endif
#define NREP(j) (((REPEAT_MASK >> (j)) & 1) ? 2 : 1)
struct Params {
    const float* in[24];
    float* out;
    unsigned char* ws;
    int ph_lo, ph_hi;
};
enum { I_X = 0, I_C, I_CTX, I_CCTX, I_WADA, I_BADA, I_GMIX, I_GFFN, I_WIN, I_RPB, I_LBL, I_HGN, I_QNG, I_KNG, I_WBR, I_WOUT,
       I_WGR, I_BGR, I_WER, I_BER, I_WEG, I_WEU, I_WED, I_GFIN };

__device__ __forceinline__ void g128_kloop(f32x4 (&acc)[4][4], LAS unsigned char* lds, const bf16_t* A, int lda, const bf16_t* Bt, int ldb, int K) {
    const int tid = tid_(), wid = tid >> 6, lane = tid & 63, wr = wid >> 2, wc = wid & 3, fr = lane & 15, fq = lane >> 4;
    LAS unsigned char* SA = lds; LAS unsigned char* SB = lds + 8192;
    const int srow = tid >> 2, skc = (tid & 3) * 8;
    const bf16_t* ap = A + (size_t)srow * lda + skc;
    const bf16_t* bp0 = Bt + (size_t)srow * ldb + skc;
    const bf16_t* bp1 = Bt + (size_t)(srow + 128) * ldb + skc;
    for (int k0 = 0; k0 < K; k0 += 32) {
        const uint4 va = *(const uint4*)(ap + k0);
        const uint4 vb0 = *(const uint4*)(bp0 + k0);
        const uint4 vb1 = *(const uint4*)(bp1 + k0);
        __syncthreads();
        *(LAS u32x4*)(SA + tid * 16) = (u32x4){va.x, va.y, va.z, va.w};
        *(LAS u32x4*)(SB + tid * 16) = (u32x4){vb0.x, vb0.y, vb0.z, vb0.w};
        *(LAS u32x4*)(SB + 8192 + tid * 16) = (u32x4){vb1.x, vb1.y, vb1.z, vb1.w};
        __syncthreads();
        bf16x8 At[4], Bf[4];
#pragma unroll
        for (int m = 0; m < 4; ++m) At[m] = *(const LAS bf16x8*)(SA + ((wr * 64 + m * 16 + fr) * 32 + fq * 8) * 2);
#pragma unroll
        for (int n = 0; n < 4; ++n) Bf[n] = *(const LAS bf16x8*)(SB + ((wc * 64 + n * 16 + fr) * 32 + fq * 8) * 2);
#pragma unroll
        for (int m = 0; m < 4; ++m)
#pragma unroll
            for (int n = 0; n < 4; ++n) acc[m][n] = __builtin_amdgcn_mfma_f32_16x16x32_bf16(Bf[n], At[m], acc[m][n], 0, 0, 0);
    }
}
__device__ __forceinline__ void acc_zero(f32x4 (&acc)[4][4]) {
#pragma unroll
    for (int m = 0; m < 4; ++m)
#pragma unroll
        for (int n = 0; n < 4; ++n) acc[m][n] = (f32x4){0.f, 0.f, 0.f, 0.f};
}
template <class Epi>
__device__ __forceinline__ void g128_epilogue(const f32x4 (&acc)[4][4], int row0, int col0, const Epi& E) {
    const int tid = tid_(), wid = tid >> 6, lane = tid & 63, wr = wid >> 2, wc = wid & 3, fr = lane & 15, fq = lane >> 4;
#pragma unroll
    for (int m = 0; m < 4; ++m)
#pragma unroll
        for (int n = 0; n < 4; n += 2) E(row0 + wr * 64 + m * 16 + fr, col0 + wc * 64 + n * 16 + fq * 4, acc[m][n], acc[m][n + 1]);
}


namespace pg8 {
constexpr int BM = 256, BK = 64, HALF = 128, HTB = HALF * BK * 2, STAGE_BYTES = 8 * HTB;
__device__ __forceinline__ int lds_byte(int r, int c) { const int st = (r >> 4) * 2 + (c >> 5), rr = r & 15, cc = c & 31, ob = rr * 64 + cc * 2; return st * 1024 + (ob ^ (((ob >> 9) & 1) << 5)); }
__device__ __forceinline__ void stage_rc(int b, int& R, int& C) { const int st = b / 1024, sb = b % 1024, swz = sb ^ (((sb >> 9) & 1) << 5); R = (st >> 1) * 16 + swz / 64; C = (st & 1) * 32 + (swz % 64) / 2; }
struct Unit { int row0, col0, aux; const char* A; const char* B; };
struct Gemm { int K, lda, ldb; };
template <class Epi, class Sched>
__device__ __forceinline__ void gemm_phase(LAS unsigned char* lds, const Gemm g, const Sched& S, const Epi& E) {
    const int tid = tid_(), wid = __builtin_amdgcn_readfirstlane(tid >> 6), lane = tid & 63, wr = wid >> 2, wc = wid & 3, fr = lane & 15, fq = lane >> 4;
    const int K = g.K, nt = K / BK;
    unsigned voffA[2], voffB[2];
#pragma unroll
    for (int i = 0; i < 2; ++i) { int R, C; stage_rc(tid * 16 + i * 8192, R, C);
        voffA[i] = (unsigned)(R * g.lda + C) * 2u; voffB[i] = (unsigned)(R * g.ldb + C) * 2u; }
    const size_t kstep = (size_t)(BK * 2);
    const size_t hstepA = (size_t)HALF * g.lda * 2, hstepB = (size_t)HALF * g.ldb * 2;
    const unsigned ldsw = (unsigned)wid * 1024u;
    const int aoff = lds_byte(wr * 64 + fr, fq * 8), boff = lds_byte(wc * 32 + fr, fq * 8);
#define PG8_SA(b, h) (((b) * 2 + (h)) * HTB)
#define PG8_SB(b, h) ((4 + (b) * 2 + (h)) * HTB)
#define PG8_STAGE(bufoff, gbase, voff) do { _Pragma("unroll") for (int _i = 0; _i < 2; ++_i) \
        __builtin_amdgcn_global_load_lds((const unsigned*)((const char*)(gbase) + (voff)[_i]), (LAS unsigned*)(lds + (bufoff) + ldsw + _i * 8192), 16, 0, 0); } while (0)
#define PG8_LDA(dst, b, h) do { _Pragma("unroll") for (int m = 0; m < 4; ++m) _Pragma("unroll") for (int k = 0; k < 2; ++k) dst[m][k] = *(const LAS bf16x8*)(lds + PG8_SA(b, h) + aoff + m * 2048 + k * 1024); } while (0)
#define PG8_LDB(dst, b, h) do { _Pragma("unroll") for (int n = 0; n < 2; ++n) _Pragma("unroll") for (int k = 0; k < 2; ++k) dst[n][k] = *(const LAS bf16x8*)(lds + PG8_SB(b, h) + boff + n * 2048 + k * 1024); } while (0)
#define PG8_MMA(ai, bj, At, Bt) do { __builtin_amdgcn_s_setprio(1); _Pragma("unroll") for (int m = 0; m < 4; ++m) _Pragma("unroll") for (int n = 0; n < 2; ++n) _Pragma("unroll") for (int k = 0; k < 2; ++k) \
        acc[ai][bj][m][n] = __builtin_amdgcn_mfma_f32_16x16x32_bf16(Bt[n][k], At[m][k], acc[ai][bj][m][n], 0, 0, 0); __builtin_amdgcn_s_setprio(0); } while (0)
#define PG8_WAIT_V(n) asm volatile("s_waitcnt vmcnt(" #n ")" ::: "memory")
#define PG8_WAIT_L(n) asm volatile("s_waitcnt lgkmcnt(" #n ")" ::: "memory")
#define PG8_BAR __builtin_amdgcn_s_barrier()
#define PG8_SCHED __builtin_amdgcn_sched_barrier(0)
    Unit cur, nxt; int ui = 0;
    if (!S.next(0, cur)) return;
    f32x4 acc[2][2][4][2];
#pragma unroll
    for (int a = 0; a < 2; ++a)
#pragma unroll
        for (int b = 0; b < 2; ++b)
#pragma unroll
            for (int m = 0; m < 4; ++m)
#pragma unroll
                for (int n = 0; n < 2; ++n) acc[a][b][m][n] = (f32x4){0.f, 0.f, 0.f, 0.f};
    bf16x8 At[4][2], B0[2][2], B1[2][2];
    const char* cA = cur.A; const char* cB = cur.B;
    PG8_STAGE(PG8_SB(0, 0), cB, voffB); PG8_STAGE(PG8_SB(0, 1), cB + hstepB, voffB); PG8_STAGE(PG8_SA(0, 0), cA, voffA); PG8_STAGE(PG8_SA(0, 1), cA + hstepA, voffA);
    if (wr == 1) PG8_BAR;
    PG8_WAIT_V(2); PG8_BAR;
    PG8_STAGE(PG8_SB(1, 0), cB + kstep, voffB); PG8_STAGE(PG8_SA(1, 0), cA + kstep, voffA); PG8_STAGE(PG8_SB(1, 1), cB + hstepB + kstep, voffB);
    PG8_WAIT_V(6); PG8_BAR;
    for (;;) {
        const bool has_next = S.next(ui + 1, nxt);
        const char* nA = has_next ? nxt.A : cA; const char* nB = has_next ? nxt.B : cB;
        for (int t = 0; t < nt; t += 2) {
            const bool last = (t == nt - 2);
            const char* a1 = cA + (size_t)(t + 1) * kstep;
            const char* a2 = last ? nA : cA + (size_t)(t + 2) * kstep; const char* b2 = last ? nB : cB + (size_t)(t + 2) * kstep;
            const char* a3 = a2 + kstep; const char* b3 = b2 + kstep;
            PG8_LDB(B0, 0, 0); PG8_LDB(B1, 0, 1); PG8_SCHED; PG8_LDA(At, 0, 0); PG8_STAGE(PG8_SA(1, 1), a1 + hstepA, voffA);
            PG8_WAIT_V(8); PG8_WAIT_L(0); PG8_BAR; PG8_MMA(0, 0, At, B0); PG8_MMA(0, 1, At, B1); PG8_BAR; PG8_SCHED;
            PG8_LDA(At, 0, 1); PG8_STAGE(PG8_SB(0, 0), b2, voffB); PG8_STAGE(PG8_SB(0, 1), b2 + hstepB, voffB); PG8_STAGE(PG8_SA(0, 0), a2, voffA);
            PG8_WAIT_V(8); PG8_WAIT_L(0); PG8_BAR; PG8_MMA(1, 0, At, B0); PG8_MMA(1, 1, At, B1); PG8_BAR; PG8_SCHED;
            PG8_LDB(B0, 1, 0); PG8_LDB(B1, 1, 1); PG8_SCHED; PG8_LDA(At, 1, 0); PG8_STAGE(PG8_SA(0, 1), a2 + hstepA, voffA);
            PG8_WAIT_V(8); PG8_WAIT_L(0); PG8_BAR; PG8_MMA(0, 0, At, B0); PG8_MMA(0, 1, At, B1); PG8_BAR; PG8_SCHED;
            PG8_LDA(At, 1, 1); PG8_STAGE(PG8_SB(1, 0), b3, voffB); PG8_STAGE(PG8_SB(1, 1), b3 + hstepB, voffB); PG8_STAGE(PG8_SA(1, 0), a3, voffA);
            PG8_WAIT_V(8); PG8_WAIT_L(0); PG8_BAR; PG8_MMA(1, 0, At, B0); PG8_MMA(1, 1, At, B1); PG8_BAR; PG8_SCHED;
        }
        if (wr == 0) PG8_BAR;
        E(acc, cur, wr, wc, fr, fq);
        if (!has_next) break;
#pragma unroll
        for (int a = 0; a < 2; ++a)
#pragma unroll
            for (int b = 0; b < 2; ++b)
#pragma unroll
                for (int m = 0; m < 4; ++m)
#pragma unroll
                    for (int n = 0; n < 2; ++n) acc[a][b][m][n] = (f32x4){0.f, 0.f, 0.f, 0.f};
        cur = nxt; cA = nA; cB = nB; ++ui;
        if (wr == 1) PG8_BAR;
    }
    PG8_WAIT_V(0);
    PG8_BAR;
#undef PG8_SA
#undef PG8_SB
#undef PG8_STAGE
#undef PG8_LDA
#undef PG8_LDB
#undef PG8_MMA
#undef PG8_WAIT_V
#undef PG8_WAIT_L
#undef PG8_BAR
#undef PG8_SCHED
}
template <class F> struct EpiPair { F f;
    __device__ __forceinline__ void operator()(const f32x4 (&acc)[2][2][4][2], const Unit& u, int wr, int wc, int fr, int fq) const {
#pragma unroll
        for (int ai = 0; ai < 2; ++ai)
#pragma unroll
            for (int m = 0; m < 4; ++m)
#pragma unroll
                for (int bj = 0; bj < 2; ++bj) f(u, u.row0 + ai * HALF + wr * 64 + m * 16 + fr, u.col0 + bj * HALF + wc * 32 + 4 * fq, acc[ai][bj][m][0], acc[ai][bj][m][1]);
    } };
struct SchedDense { int nM, nN, G, c; const char* A; const char* B; size_t tA, tB;
    __device__ __forceinline__ bool next(int i, Unit& u) const {
        const int nwg = nM * nN; const long L = (long)i * G + c; if (L >= nwg) return false;
        int wgid = (int)L; { const int q = nwg / 8, r = nwg % 8, xcd = wgid % 8, off = wgid / 8; wgid = (xcd < r ? xcd * (q + 1) : r * (q + 1) + (xcd - r) * q) + off; }
        const int nig = 8 * nN, gid = wgid / nig, fm = gid * 8, gsz = (nM - fm) < 8 ? (nM - fm) : 8;
        const int pm = fm + ((wgid % nig) % gsz), pn = (wgid % nig) / gsz;
        u.row0 = pm * 256; u.col0 = pn * 256; u.aux = 0; u.A = A + (size_t)pm * tA; u.B = B + (size_t)pn * tB; return true; } };
}


namespace gqa {
using f32x16 = __attribute__((ext_vector_type(16))) float;
using s16x4 = __attribute__((ext_vector_type(4))) short;
constexpr int QP = 512, KVP = 128, OP = BRW;
constexpr int NW = 8, QBLK = 32, KVBLK = 64;
__device__ __forceinline__ int crow(int r, int hi) { return (r & 3) + 8 * (r >> 2) + 4 * hi; }
#define SBAR() __builtin_amdgcn_sched_barrier(0)
constexpr int NSLOT = 3, SLOTB = 8192;
constexpr int LDS_K = 0, LDS_V = NSLOT * SLOTB, LDS_WS = 2 * NSLOT * SLOTB, LDS_OST = LDS_WS + NW * 64 * 4, LDS_BYTES_ = LDS_OST + NW * 4096;
__device__ __forceinline__ void glds16(const void* gsrc, unsigned lds_dst) { unsigned keep;
  asm volatile("s_mov_b32 %0, m0\n\ts_mov_b32 m0, %2\n\ts_nop 0\n\tglobal_load_lds_dwordx4 %1, off\n\ts_mov_b32 m0, %0" : "=&s"(keep) : "v"(gsrc), "s"(lds_dst) : "memory"); }
__device__ __forceinline__ float max3f(float a, float b, float c) { float r; asm("v_max3_f32 %0, %1, %2, %3" : "=v"(r) : "v"(a), "v"(b), "v"(c)); return r; }
__device__ __forceinline__ float max2f(float a, float b) { float r; asm("v_max_f32_e32 %0, %1, %2" : "=v"(r) : "v"(a), "v"(b)); return r; }
__device__ __forceinline__ float fadd_s(float a, float b) { float r; asm("v_add_f32_e32 %0, %1, %2" : "=v"(r) : "v"(a), "v"(b)); return r; }
__device__ __forceinline__ float fsub_s(float a, float b) { float r; asm("v_sub_f32_e32 %0, %1, %2" : "=v"(r) : "v"(a), "v"(b)); return r; }
typedef float f32x2_t __attribute__((ext_vector_type(2))); typedef __bf16 bf16x2_t __attribute__((ext_vector_type(2)));
__device__ __forceinline__ unsigned cvtpk_s(float lo, float hi) { f32x2_t v = {lo, hi}; bf16x2_t b = __builtin_convertvector(v, bf16x2_t); return __builtin_bit_cast(unsigned, b); }
#define WAIT_BAR(N) asm volatile("s_waitcnt vmcnt(" #N ") lgkmcnt(0)\n\ts_barrier" ::: "memory")
__device__ __forceinline__ void qkt(f32x16& p0, f32x16& p1, const char* Kslot, const bf16x8* qr, const f32x16& negm, int r32, int hi) {
  const char* kb = Kslot + hi * 1024 + r32 * 16;
  #pragma unroll
  for (int d0 = 0; d0 < 4; ++d0) {
    const bf16x8 b0 = *reinterpret_cast<const bf16x8*>(kb + d0 * 2048);
    const bf16x8 b1 = *reinterpret_cast<const bf16x8*>(kb + d0 * 2048 + 512);
    if (d0 == 0) { p0 = __builtin_amdgcn_mfma_f32_32x32x16_bf16(b0, qr[0], negm, 0, 0, 0); p1 = __builtin_amdgcn_mfma_f32_32x32x16_bf16(b1, qr[0], negm, 0, 0, 0); }
    else { p0 = __builtin_amdgcn_mfma_f32_32x32x16_bf16(b0, qr[d0], p0, 0, 0, 0); p1 = __builtin_amdgcn_mfma_f32_32x32x16_bf16(b1, qr[d0], p1, 0, 0, 0); } }
}
typedef __attribute__((address_space(3))) const char* lds_cptr;
typedef short v4i16_t __attribute__((ext_vector_type(4)));
__device__ __forceinline__ void kload8(bf16x8* kf, lds_cptr kp) {
  kf[0] = *(const LAS bf16x8*)(kp);        kf[1] = *(const LAS bf16x8*)(kp + 512);
  kf[2] = *(const LAS bf16x8*)(kp + 2048); kf[3] = *(const LAS bf16x8*)(kp + 2560);
  kf[4] = *(const LAS bf16x8*)(kp + 4096); kf[5] = *(const LAS bf16x8*)(kp + 4608);
  kf[6] = *(const LAS bf16x8*)(kp + 6144); kf[7] = *(const LAS bf16x8*)(kp + 6656);
}
__device__ __forceinline__ void kload2(bf16x8* kf, lds_cptr kp, int j) { kf[2 * j] = *(const LAS bf16x8*)(kp + j * 2048); kf[2 * j + 1] = *(const LAS bf16x8*)(kp + j * 2048 + 512); }
__device__ __forceinline__ s16x4 vtr(lds_cptr p) { return __builtin_bit_cast(s16x4, __builtin_amdgcn_ds_read_tr16_b64_v4i16((LAS v4i16_t*)p)); }
__device__ __forceinline__ float rowmax(const f32x16& p0, const f32x16& p1) {
  float a = max3f(p0[0], p0[1], p1[0]), b = max3f(p0[2], p0[3], p1[1]); a = max3f(a, p1[2], p1[3]);
  #pragma unroll
  for (int r = 4; r < 16; r += 4) { a = max3f(a, p0[r], p0[r + 1]); b = max3f(b, p0[r + 2], p0[r + 3]); a = max3f(a, p1[r], p1[r + 1]); b = max3f(b, p1[r + 2], p1[r + 3]); }
  const float m = max2f(a, b);
  auto rr = __builtin_amdgcn_permlane32_swap(__float_as_uint(m), __float_as_uint(m), false, false);
  return max2f(__uint_as_float(rr[0]), __uint_as_float(rr[1]));
}
__device__ __forceinline__ void pv(f32x16* o, int vb, bf16x8 pa0, bf16x8 pa1, bf16x8 pa2, bf16x8 pa3) {
  #pragma unroll
  for (int d0 = 0; d0 < 2; ++d0) { s16x4 lo[4], hi[4];
    #pragma unroll
    for (int ks = 0; ks < 4; ++ks) {
      asm volatile("ds_read_b64_tr_b16 %0,%1 offset:%c2" : "=&v"(lo[ks]) : "v"(vb), "i"(d0 * 4096 + ks * 1024) : "memory");
      asm volatile("ds_read_b64_tr_b16 %0,%1 offset:%c2" : "=&v"(hi[ks]) : "v"(vb), "i"(d0 * 4096 + ks * 1024 + 512) : "memory"); }
    asm volatile("s_waitcnt lgkmcnt(0)" ::: "memory"); SBAR();
    #define PK(k) (bf16x8){lo[k][0], lo[k][1], lo[k][2], lo[k][3], hi[k][0], hi[k][1], hi[k][2], hi[k][3]}
    o[d0] = __builtin_amdgcn_mfma_f32_32x32x16_bf16(pa0, PK(0), o[d0], 0, 0, 0);
    o[d0] = __builtin_amdgcn_mfma_f32_32x32x16_bf16(pa1, PK(1), o[d0], 0, 0, 0);
    o[d0] = __builtin_amdgcn_mfma_f32_32x32x16_bf16(pa2, PK(2), o[d0], 0, 0, 0);
    o[d0] = __builtin_amdgcn_mfma_f32_32x32x16_bf16(pa3, PK(3), o[d0], 0, 0, 0);
    #undef PK
  }
}
template <int THRL> __device__ __forceinline__ void attn_unit(const bf16_t* Qu, const float* qgain, const float* rope, const int tok0, const bf16_t* __restrict__ Kh, const bf16_t* __restrict__ Vh, bf16_t* Ou, const int NT, char* shm) {
  const int tid = tid_(), lane = tid & 63, r32 = lane & 31, hi = lane >> 5; const int wid = __builtin_amdgcn_readfirstlane(tid >> 6);
  const bf16_t* Qw = Qu + (long)wid * QBLK * ZP;
  const unsigned lds0 = (unsigned)(uintptr_t)shm;
  float* wsf = (float*)(shm + LDS_WS) + wid * 64;
  const bf16_t* ksrc = Kh + (long)lane * KVP + wid * 8;
  const bf16_t* vsrc = Vh + (long)(16 * (wid & 3) + (lane >> 2)) * KVP + (wid >> 2) * 32 + (lane & 3) * 8;
  const unsigned kdst = lds0 + LDS_K + wid * 1024, vdst = lds0 + LDS_V + wid * 1024;
  #define DMA_K(t, slot) glds16(ksrc + (long)(t) * KVBLK * KVP, (unsigned)__builtin_amdgcn_readfirstlane(kdst + (slot)))
  #define DMA_V(t, slot) glds16(vsrc + (long)(t) * KVBLK * KVP, (unsigned)__builtin_amdgcn_readfirstlane(vdst + (slot)))
  const int vb0 = (int)(lds0 + LDS_V) + ((lane >> 4) & 1) * 32 + (lane & 3) * 8 + (4 * hi + ((lane & 15) >> 2)) * 64;
  const char* Kbase = shm + LDS_K; bf16x8 kf[8];
  const lds_cptr shm3 = (lds_cptr)shm; const lds_cptr kp0 = shm3 + LDS_K + hi * 1024 + r32 * 16; const lds_cptr vp0 = shm3 + LDS_V + ((lane >> 4) & 1) * 32 + (lane & 3) * 8 + (4 * hi + ((lane & 15) >> 2)) * 64;
  DMA_K(0, 0); DMA_V(0, 0); DMA_K(1, SLOTB);
  bf16x8 qr[4];
  { float xq[4][8]; float ss = 0.f;
    #pragma unroll
    for (int d0 = 0; d0 < 4; ++d0) { const uint4 rw = *reinterpret_cast<const uint4*>(&Qw[(long)r32 * ZP + d0 * 16 + hi * 8]);
      xq[d0][0] = bf_lo(rw.x); xq[d0][1] = bf_hi(rw.x); xq[d0][2] = bf_lo(rw.y); xq[d0][3] = bf_hi(rw.y); xq[d0][4] = bf_lo(rw.z); xq[d0][5] = bf_hi(rw.z); xq[d0][6] = bf_lo(rw.w); xq[d0][7] = bf_hi(rw.w);
      #pragma unroll
      for (int j = 0; j < 8; ++j) ss += xq[d0][j] * xq[d0][j]; }
    { auto rr = __builtin_amdgcn_permlane32_swap(__float_as_uint(ss), __float_as_uint(ss), false, false); ss = __uint_as_float(rr[0]) + __uint_as_float(rr[1]); }
    const float rstd = __builtin_amdgcn_rsqf(ss * (1.0f / 64.0f) + 1e-6f) * (0.125f * 1.4426950408889634f);
    #pragma unroll
    for (int d0 = 0; d0 < 4; ++d0) { const f32x4 g0 = *(const f32x4*)(qgain + d0 * 16 + hi * 8), g1 = *(const f32x4*)(qgain + d0 * 16 + hi * 8 + 4);
      #pragma unroll
      for (int j = 0; j < 4; ++j) { xq[d0][j] *= rstd * g0[j]; xq[d0][4 + j] *= rstd * g1[j]; } }
    if (tok0 >= 0) { const int t = tok0 + wid * QBLK + r32, pr = t >> 6, pc = t & 63;
      #pragma unroll
      for (int hf = 0; hf < 2; ++hf) {
        const float* ct = rope + (hf ? (1024 + pc * 16) : (pr * 16)) + hi * 8; const float* st = ct + (hf ? 1024 : 512);
        const f32x4 c0 = *(const f32x4*)ct, c1 = *(const f32x4*)(ct + 4), s0 = *(const f32x4*)st, s1 = *(const f32x4*)(st + 4);
        #pragma unroll
        for (int j = 0; j < 8; ++j) { const float cs = j < 4 ? c0[j] : c1[j - 4], sn = j < 4 ? s0[j] : s1[j - 4];
          const float x1 = xq[2 * hf][j], x2 = xq[2 * hf + 1][j];
          xq[2 * hf][j] = x1 * cs - x2 * sn; xq[2 * hf + 1][j] = x2 * cs + x1 * sn; } } }
    #pragma unroll
    for (int d0 = 0; d0 < 4; ++d0) qr[d0] = pack8(xq[d0]); }
  float mhat = 0.f, l_reg = 0.f; f32x16 o[2]; o[0] = f32x16{}; o[1] = f32x16{}; f32x16 negm = f32x16{}; asm volatile("" : "+v"(negm));
  bool resc = false;
  #define START(P0, P1) do { const float rm = rowmax(P0, P1); resc = false; \
    { const float dl = rm; mhat = fadd_s(mhat, dl); \
      _Pragma("unroll") for (int r = 0; r < 16; ++r) { P0[r] = fsub_s(P0[r], dl); P1[r] = fsub_s(P1[r], dl); } \
      _Pragma("unroll") for (int r = 0; r < 16; ++r) negm[r] = -mhat; asm volatile("" : "+v"(negm)); } \
    _Pragma("unroll") for (int r = 0; r < 16; ++r) P0[r] = __builtin_amdgcn_exp2f(P0[r]); } while (0)
  #define RESC() do { if (resc) { asm volatile("s_waitcnt lgkmcnt(0)" ::: "memory"); \
      _Pragma("unroll") for (int d_ = 0; d_ < 2; ++d_) _Pragma("unroll") for (int r = 0; r < 16; ++r) o[d_][r] *= wsf[crow(r, hi)]; } } while (0)
  f32x16 pA0, pA1, pB0, pB1;
  int sl_prev = 0, sl_cur = 0, sl_next = SLOTB;
  #define ROT() do { sl_prev = sl_cur; sl_cur = sl_next; sl_next = (sl_next == (NSLOT - 1) * SLOTB) ? 0 : sl_next + SLOTB; } while (0)
  DMA_K(2, 2 * SLOTB);
  WAIT_BAR(3);
  qkt(pA0, pA1, Kbase, qr, negm, r32, hi); asm volatile("s_nop 15\n\ts_nop 7" : "+v"(pA0), "+v"(pA1));
  START(pA0, pA1);
  _Pragma("unroll") for (int r = 0; r < 16; ++r) pA1[r] = __builtin_amdgcn_exp2f(pA1[r]);
  WAIT_BAR(0);
  DMA_K(3, 0); DMA_V(1, SLOTB);
  ROT();
  kload8(kf, kp0 + sl_cur);
  WAIT_BAR(2);
  s16x4 vlo[8], vhi[8]; u32x4 pw0, pw1, pw2, pw3;
  #define PKW(P, B) cvtpk_s(P[B], P[B + 1])
  #define PAF(k) __builtin_bit_cast(bf16x8, pw##k)
  #define VFR(i) (bf16x8){vlo[i][0], vlo[i][1], vlo[i][2], vlo[i][3], vhi[i][0], vhi[i][1], vhi[i][2], vhi[i][3]}
  #define PIN(x) asm volatile("" : "+v"(x))
  #define MX3(a, b, c) __builtin_fmaxf(__builtin_fmaxf((a), (b)), (c))
  #define GAPA(MF, A0, A1, A2, A3, W0, W1, PW) do { MF; sacc += A0; sacc += A1; sacc += A2; sacc += A3; PIN(sacc); W0; W1; PIN(PW); SBAR(); } while (0)
  #define EX(v) __builtin_amdgcn_exp2f(v)
  #define GAPB(MF, X, B) do { MF; X[B] = EX(X[B]); X[B + 1] = EX(X[B + 1]); X[B + 2] = EX(X[B + 2]); X[B + 3] = EX(X[B + 3]); PIN(X); SBAR(); } while (0)
  #define VRD(i) do { vlo[i] = vtr(vp_ + (((i) >> 2) * 4096 + ((i) & 3) * 1024)); vhi[i] = vtr(vp_ + (((i) >> 2) * 4096 + ((i) & 3) * 1024 + 512)); } while (0)
  #define KRD(G, j) do { if (G) { kload2(kf, kp0 + sl_next, j); SBAR(); } } while (0)
  #define STEP(C0, C1, P0, P1, t, GK, GV, GL) do { SBAR(); \
    const lds_cptr vp_ = vp0 + sl_prev; \
    VRD(0); SBAR(); float sacc = (P0[0] + P0[1]); \
    GAPA(C0 = __builtin_amdgcn_mfma_f32_32x32x16_bf16(kf[0], qr[0], negm, 0, 0, 0), P0[2], P0[3], P0[4], P0[5],     pw0[0] = PKW(P0, 0), pw0[1] = PKW(P0, 2), pw0); \
    VRD(4); SBAR(); GAPA(C1 = __builtin_amdgcn_mfma_f32_32x32x16_bf16(kf[1], qr[0], negm, 0, 0, 0), P0[6], P0[7], P0[8], P0[9],     pw0[2] = PKW(P0, 4), pw0[3] = PKW(P0, 6), pw0); \
    VRD(1); SBAR(); GAPA(C0 = __builtin_amdgcn_mfma_f32_32x32x16_bf16(kf[2], qr[1], C0, 0, 0, 0),   P0[10], P0[11], P0[12], P0[13], pw1[0] = PKW(P0, 8), pw1[1] = PKW(P0, 10), pw1); \
    VRD(5); SBAR(); GAPA(C1 = __builtin_amdgcn_mfma_f32_32x32x16_bf16(kf[3], qr[1], C1, 0, 0, 0),   P0[14], P0[15], P1[0], P1[1],   pw1[2] = PKW(P0, 12), pw1[3] = PKW(P0, 14), pw1); \
    VRD(2); SBAR(); GAPA(C0 = __builtin_amdgcn_mfma_f32_32x32x16_bf16(kf[4], qr[2], C0, 0, 0, 0),   P1[2], P1[3], P1[4], P1[5],     pw2[0] = PKW(P1, 0), pw2[1] = PKW(P1, 2), pw2); \
    VRD(6); SBAR(); GAPA(C1 = __builtin_amdgcn_mfma_f32_32x32x16_bf16(kf[5], qr[2], C1, 0, 0, 0),   P1[6], P1[7], P1[8], P1[9],     pw2[2] = PKW(P1, 4), pw2[3] = PKW(P1, 6), pw2); \
    VRD(3); SBAR(); GAPA(C0 = __builtin_amdgcn_mfma_f32_32x32x16_bf16(kf[6], qr[3], C0, 0, 0, 0),   P1[10], P1[11], P1[12], P1[13], pw3[0] = PKW(P1, 8), pw3[1] = PKW(P1, 10), pw3); \
    VRD(7); SBAR(); GAPA(C1 = __builtin_amdgcn_mfma_f32_32x32x16_bf16(kf[7], qr[3], C1, 0, 0, 0),   P1[14], P1[15], 0.f, 0.f,       pw3[2] = PKW(P1, 12), pw3[3] = PKW(P1, 14), pw3); \
    l_reg += sacc; \
    if (GK) { DMA_K((t) + 3, sl_cur); } if (GV) { DMA_V((t) + 1, sl_next); } \
    { float a = MX3(C0[0], C0[1], C1[0]), b = MX3(C0[2], C0[3], C1[1]); a = MX3(a, C1[2], C1[3]); \
      _Pragma("unroll") for (int r = 4; r < 16; r += 4) { a = MX3(a, C0[r], C0[r + 1]); b = MX3(b, C0[r + 2], C0[r + 3]); a = MX3(a, C1[r], C1[r + 1]); b = MX3(b, C1[r + 2], C1[r + 3]); } \
      float rm = __builtin_fmaxf(a, b); { auto rr = __builtin_amdgcn_permlane32_swap(__float_as_uint(rm), __float_as_uint(rm), false, false); rm = __builtin_fmaxf(__uint_as_float(rr[0]), __uint_as_float(rr[1])); } \
      resc = false; \
      if (__builtin_expect(__any(rm > (float)THRL), 0)) { const float dl = __builtin_fmaxf(rm, 0.f); mhat += dl; \
        _Pragma("unroll") for (int r = 0; r < 16; ++r) { C0[r] -= dl; C1[r] -= dl; } \
        _Pragma("unroll") for (int r = 0; r < 16; ++r) negm[r] = -mhat; asm volatile("" : "+v"(negm)); \
        const float f = __builtin_amdgcn_exp2f(-dl); l_reg *= f; if (hi == 0) wsf[r32] = f; resc = true; } } \
    SBAR(); \
    GAPB(o[0] = __builtin_amdgcn_mfma_f32_32x32x16_bf16(PAF(0), VFR(0), o[0], 0, 0, 0), C0, 0); \
    GAPB(o[1] = __builtin_amdgcn_mfma_f32_32x32x16_bf16(PAF(0), VFR(4), o[1], 0, 0, 0), C0, 4); \
    KRD(GL, 0); GAPB(o[0] = __builtin_amdgcn_mfma_f32_32x32x16_bf16(PAF(1), VFR(1), o[0], 0, 0, 0), C0, 8); \
    KRD(GL, 1); GAPB(o[1] = __builtin_amdgcn_mfma_f32_32x32x16_bf16(PAF(1), VFR(5), o[1], 0, 0, 0), C0, 12); \
    KRD(GL, 2); GAPB(o[0] = __builtin_amdgcn_mfma_f32_32x32x16_bf16(PAF(2), VFR(2), o[0], 0, 0, 0), C1, 0); \
    KRD(GL, 3); GAPB(o[1] = __builtin_amdgcn_mfma_f32_32x32x16_bf16(PAF(2), VFR(6), o[1], 0, 0, 0), C1, 4); \
    GAPB(o[0] = __builtin_amdgcn_mfma_f32_32x32x16_bf16(PAF(3), VFR(3), o[0], 0, 0, 0), C1, 8); \
    GAPB(o[1] = __builtin_amdgcn_mfma_f32_32x32x16_bf16(PAF(3), VFR(7), o[1], 0, 0, 0), C1, 12); \
    } while (0)
  int t = 1;
  for (; t + 5 < NT; t += 2) {
    STEP(pB0, pB1, pA0, pA1, t, true, true, true);     WAIT_BAR(2); RESC(); ROT();
    STEP(pA0, pA1, pB0, pB1, t + 1, true, true, true); WAIT_BAR(2); RESC(); ROT();
  }
  #define ENDW(tt) do { if ((tt) + 3 < NT) { WAIT_BAR(2); } else if ((tt) + 2 < NT) { WAIT_BAR(1); } else { WAIT_BAR(0); } } while (0)
  for (; t + 1 < NT; t += 2) {
    STEP(pB0, pB1, pA0, pA1, t, (t + 3 < NT), (t + 1 < NT), (t + 1 < NT));         ENDW(t);     RESC(); ROT();
    STEP(pA0, pA1, pB0, pB1, t + 1, (t + 4 < NT), (t + 2 < NT), (t + 2 < NT));     ENDW(t + 1); RESC(); ROT();
  }
  STEP(pB0, pB1, pA0, pA1, NT - 1, false, false, false); RESC();
  { float sacc = pB0[0] + pB0[1]; _Pragma("unroll") for (int r = 2; r < 16; ++r) sacc += pB0[r]; _Pragma("unroll") for (int r = 0; r < 16; ++r) sacc += pB1[r]; l_reg += sacc;
    pw0 = (u32x4){PKW(pB0, 0), PKW(pB0, 2), PKW(pB0, 4), PKW(pB0, 6)}; pw1 = (u32x4){PKW(pB0, 8), PKW(pB0, 10), PKW(pB0, 12), PKW(pB0, 14)}; pw2 = (u32x4){PKW(pB1, 0), PKW(pB1, 2), PKW(pB1, 4), PKW(pB1, 6)}; pw3 = (u32x4){PKW(pB1, 8), PKW(pB1, 10), PKW(pB1, 12), PKW(pB1, 14)};
    SBAR(); pv(o, vb0 + sl_cur, PAF(0), PAF(1), PAF(2), PAF(3)); }
  #undef PKW
  #undef PAF
  #undef VFR
  #undef PIN
  #undef MX3
  #undef GAPA
  #undef GAPB
  #undef EX
  #undef VRD
  #undef KRD
  #undef STEP
  #undef ENDW
  { auto rr = __builtin_amdgcn_permlane32_swap(__float_as_uint(l_reg), __float_as_uint(l_reg), false, false); l_reg = __uint_as_float(rr[0]) + __uint_as_float(rr[1]); }
  if (hi == 0) wsf[32 + r32] = l_reg; asm volatile("s_waitcnt lgkmcnt(0)" ::: "memory");
  float rli[16];
  #pragma unroll
  for (int r = 0; r < 16; ++r) rli[r] = __builtin_amdgcn_rcpf(wsf[32 + crow(r, hi)]);
  bf16_t* Ow = Ou + (long)wid * QBLK * OP;
  { bf16_t* stg = (bf16_t*)(shm + LDS_OST) + wid * 2048;
    #pragma unroll
    for (int r = 0; r < 16; ++r) { const int orow = crow(r, hi);
      #pragma unroll
      for (int d0 = 0; d0 < 2; ++d0) stg[orow * 64 + d0 * 32 + r32] = (bf16_t)(cvtpk_s(o[d0][r] * rli[r], 0.f) & 0xffffu); }
    asm volatile("s_waitcnt lgkmcnt(0)" ::: "memory");
    #pragma unroll
    for (int i = 0; i < 4; ++i) { const int row = i * 8 + (lane >> 3), ch = lane & 7; const u32x4 v = *(const u32x4*)(stg + row * 64 + ch * 8); *(u32x4*)(Ow + (long)row * OP + ch * 8) = v; } }
  asm volatile("s_waitcnt lgkmcnt(0)\n\ts_barrier" ::: "memory");
  #undef DMA_K
  #undef DMA_V
  #undef START
  #undef RESC
  #undef ROT
}
#undef SBAR
#undef WAIT_BAR
}

__device__ __forceinline__ void ph_prologue(const Params& P, LAS unsigned char* lds) {
    const int tid = tid_(), bid = bid_(), G = gridDim.x, lane = tid & 63, wid = tid >> 6;
    float* mods = (float*)(P.ws + WS_MODS);
    LAS float* sc = (LAS float*)lds;
    LAS float* red = sc + 9 * 1024;
    for (int i = tid; i < 9 * 1024; i += NTHR) { const float v = (i < 8192) ? P.in[I_C][i] : P.in[I_CCTX][i - 8192]; sc[i] = siluf_(v); }
    __syncthreads();
    {
        const int c = lane & 31, slot = wid * 2 + (lane >> 5);
        for (int u = bid; u < 4 * 192; u += G) {
            const int l = u / 192, cg = u % 192;
            const float* w = P.in[I_WADA] + (size_t)l * 1024 * 6144 + cg * 32 + c;
            float a[9];
#pragma unroll
            for (int r = 0; r < 9; ++r) a[r] = 0.f;
#pragma unroll 8
            for (int i = 0; i < 64; ++i) { const int k = slot + 16 * i; const float wv = w[(size_t)k * 6144];
#pragma unroll
                for (int r = 0; r < 9; ++r) a[r] += sc[r * 1024 + k] * wv; }
#pragma unroll
            for (int r = 0; r < 9; ++r) red[(slot * 9 + r) * 32 + c] = a[r];
            __syncthreads();
            if (tid < 288) { const int r = tid >> 5, cc = tid & 31; float s_ = 0.f;
#pragma unroll
                for (int q = 0; q < 16; ++q) s_ += red[(q * 9 + r) * 32 + cc];
                mods[((size_t)l * 9 + r) * 6144 + cg * 32 + cc] = s_ + P.in[I_BADA][l * 6144 + cg * 32 + cc]; }
            __syncthreads();
        }
    }
    { float* rt = (float*)(P.ws + WS_RT);
      for (int i = bid * NTHR + tid; i < DEPTH * 20 * 1024; i += G * NTHR) { const int l = i / 20480, j = (i % 20480) >> 10, c = i & 1023;
          rt[i] = (j < 4) ? P.in[I_WGR][((size_t)l * 1024 + c) * 4 + j] : P.in[I_WER][((size_t)l * 1024 + c) * 16 + (j - 4)]; } }
    if (bid == G - 1) {
        float* lbv = (float*)(P.ws + WS_LB);
        for (int i = tid; i < 1024; i += NTHR) {
            float lg[DEPTH], mx = -1e30f;
#pragma unroll
            for (int l = 0; l < DEPTH; ++l) { lg[l] = P.in[I_LBL][l * 1024 + i]; mx = fmaxf(mx, lg[l]); }
            float s = 0.f;
#pragma unroll
            for (int l = 0; l < DEPTH; ++l) { lg[l] = expf(lg[l] - mx); s += lg[l]; }
            float cum = 0.f;
#pragma unroll
            for (int l = 0; l < DEPTH; ++l) { if (l > 0) cum += lg[l] / s; lbv[l * 1024 + i] = cum; }
        }
        float* rope = (float*)(P.ws + WS_ROPE);
        for (int i = tid; i < 96 * 16; i += NTHR) {
            const int pos = i >> 4, fi = i & 15;
            const float inv = powf(10000.0f, -(float)fi / 16.0f);
            const float p = (pos < 32) ? (float)pos : (float)(pos - 32);
            const float ang = p * inv;
            if (pos < 32) { rope[pos * 16 + fi] = cosf(ang); rope[512 + pos * 16 + fi] = sinf(ang); }
            else { rope[1024 + (pos - 32) * 16 + fi] = cosf(ang); rope[2048 + (pos - 32) * 16 + fi] = sinf(ang); }
        }
    }
    float4* xr = (float4*)(P.ws + WS_X);
    const float4* xs = (const float4*)P.in[I_X]; const float4* cs = (const float4*)P.in[I_CTX];
    const size_t nx4 = (size_t)NLAT * D / 4, nc4 = (size_t)NCTX * D / 4;
    for (size_t i = (size_t)bid * NTHR + tid; i < nx4 + nc4; i += (size_t)G * NTHR) xr[i] = (i < nx4) ? xs[i] : cs[i - nx4];
}

struct ConvJob { const float* srcA; const float* srcB; int ld; bool inter; bool perm; bf16_t* dst; int K, n0, k0; };
__device__ __forceinline__ int perm32(int rho) { const int n = rho >> 4, i = rho & 15; return 8 * (i >> 2) + 4 * n + (i & 3); }
__device__ __forceinline__ bool conv_job(const Params& P, int l, int u, ConvJob& J) {
    constexpr int T_IN = 16 * 124, T_BR = 3 * 8 * 16, T_OUT = 16 * 16, T_GU = 16 * 16 * 16, T_DN = 16 * 8 * 16;
    constexpr int TOT = T_IN + T_BR + T_OUT + T_GU + T_DN;
    if (u >= TOT) return false;
    int v = u;
    J.srcB = nullptr; J.inter = false; J.perm = false;
    if (v < T_IN) { const int kt = v % 16, nt = v / 16; J.perm = true; J.srcA = P.in[I_WIN] + (size_t)l * 1024 * INC; J.ld = INC; J.dst = (bf16_t*)(P.ws + WS_WIN); J.K = 1024; J.n0 = nt * 64; J.k0 = kt * 64; return true; }
    v -= T_IN;
    if (v < T_BR) { const int i = v / 128, w = v % 128, kt = w % 8, nt = w / 8; J.perm = true; J.srcA = P.in[I_WBR] + ((size_t)l * 3 + i) * 512 * 1024; J.ld = 1024; J.dst = (bf16_t*)(P.ws + WS_WBR) + (size_t)i * 1024 * 512; J.K = 512; J.n0 = nt * 64; J.k0 = kt * 64; return true; }
    v -= T_BR;
    if (v < T_OUT) { const int kt = v % 16, nt = v / 16; J.perm = true; J.srcA = P.in[I_WOUT] + (size_t)l * 1024 * 1024; J.ld = 1024; J.dst = (bf16_t*)(P.ws + WS_WOUT); J.K = 1024; J.n0 = nt * 64; J.k0 = kt * 64; return true; }
    v -= T_OUT;
    if (v < T_GU) { const int e = v / 256, w = v % 256, kt = w % 16, nt = w / 16; const size_t eo = ((size_t)l * NEXP + e) * 1024 * 512;
        J.srcA = P.in[I_WEG] + eo; J.srcB = P.in[I_WEU] + eo; J.inter = true; J.ld = 512; J.dst = (bf16_t*)(P.ws + WS_WGU) + (size_t)e * 1024 * 1024; J.K = 1024; J.n0 = nt * 64; J.k0 = kt * 64; return true; }
    v -= T_GU;
    { const int e = v / 128, w = v % 128, kt = w % 8, nt = w / 8; J.perm = true; J.srcA = P.in[I_WED] + ((size_t)l * NEXP + e) * 512 * 1024; J.ld = 1024; J.dst = (bf16_t*)(P.ws + WS_WDN) + (size_t)e * 1024 * 512; J.K = 512; J.n0 = nt * 64; J.k0 = kt * 64; return true; }
}
__device__ __forceinline__ void conv_load(const ConvJob& J, int tid, float (&v)[8]) {
    const int nn = tid & 63, kk = tid >> 6, n = J.n0 + nn;
    const float* cp;
    if (J.perm) cp = J.srcA + (n & ~31) + perm32(n & 31); else if (!J.inter) cp = J.srcA + n; else { const int g = n >> 5, i = n & 31; cp = (i < 16) ? (J.srcA + 16 * g + i) : (J.srcB + 16 * g + i - 16); }
#pragma unroll
    for (int p = 0; p < 8; ++p) v[p] = cp[(size_t)(J.k0 + kk + 8 * p) * J.ld];
}
__device__ __forceinline__ void wconv_range(const Params& P, LAS unsigned char* lds, int l, int t0, int t1, int widx, int nw) {
    LAS float* t = (LAS float*)lds;
    const int tid = tid_();
    int u = t0 + widx;
    ConvJob J; float v[8];
    bool have = (u < t1) && conv_job(P, l, u, J);
    if (have) conv_load(J, tid, v);
    while (have) {
        ConvJob Jn; float vn[8];
        const bool hn = (u + nw < t1) && conv_job(P, l, u + nw, Jn);
        if (hn) conv_load(Jn, tid, vn);
        { const int nn = tid & 63, kk = tid >> 6;
#pragma unroll
          for (int p = 0; p < 8; ++p) t[(kk + 8 * p) * 65 + nn] = v[p]; }
        __syncthreads();
        { const int n = tid >> 3, k8 = (tid & 7) * 8;
          float w[8];
#pragma unroll
          for (int j = 0; j < 8; ++j) w[j] = t[(k8 + j) * 65 + n];
          uint4 o; o.x = pk_bf16(w[0], w[1]); o.y = pk_bf16(w[2], w[3]); o.z = pk_bf16(w[4], w[5]); o.w = pk_bf16(w[6], w[7]);
          *(uint4*)(J.dst + (size_t)(J.n0 + n) * J.K + J.k0 + k8) = o; }
        __syncthreads();
        J = Jn; have = hn; u += nw;
#pragma unroll
        for (int p = 0; p < 8; ++p) v[p] = vn[p];
    }
}
constexpr int CONV_T_DENSE = 16 * 124 + 3 * 8 * 16 + 16 * 16;
constexpr int CONV_T_ALL = CONV_T_DENSE + 16 * 16 * 16 + 16 * 8 * 16;
__device__ __forceinline__ void ph_wconv(const Params& P, LAS unsigned char* lds, int l) { wconv_range(P, lds, l, 0, CONV_T_DENSE, bid_(), gridDim.x); }

__device__ __forceinline__ void norm_row(const float4 (&x)[4], const float* g, const float* shift, const float* scale, int lane, float4 (&o)[4]) {
    float ss = 0.f;
#pragma unroll
    for (int i = 0; i < 4; ++i) ss += x[i].x * x[i].x + x[i].y * x[i].y + x[i].z * x[i].z + x[i].w * x[i].w;
    ss = wave_sum(ss);
    const float rstd = __builtin_amdgcn_rsqf(ss * (1.0f / 1024.0f) + 1e-6f);
#pragma unroll
    for (int i = 0; i < 4; ++i) {
        const int c = lane * 4 + 256 * i;
        const float4 gv = *(const float4*)(g + c), sh = *(const float4*)(shift + c), sc = *(const float4*)(scale + c);
        o[i].x = x[i].x * rstd * gv.x * (1.0f + sc.x) + sh.x;
        o[i].y = x[i].y * rstd * gv.y * (1.0f + sc.y) + sh.y;
        o[i].z = x[i].z * rstd * gv.z * (1.0f + sc.z) + sh.z;
        o[i].w = x[i].w * rstd * gv.w * (1.0f + sc.w) + sh.w;
    }
}
__device__ __forceinline__ int row_modrow(int r) { return r < NLAT ? (r >> 11) : 8; }

__device__ __forceinline__ void ph_norm1(const Params& P, int l) {
    const int tid = tid_(), lane = tid & 63, wid = tid >> 6;
    const float* xres = (const float*)(P.ws + WS_X);
    bf16_t* h = (bf16_t*)(P.ws + WS_H);
    const float* g = P.in[I_GMIX] + l * 1024;
    for (int r = bid_() * 8 + wid; r < NTOK; r += gridDim.x * 8) {
        const float* mod = (const float*)(P.ws + WS_MODS) + ((size_t)l * 9 + row_modrow(r)) * 6144;
        float4 x[4], o[4];
#pragma unroll
        for (int i = 0; i < 4; ++i) x[i] = *(const float4*)(xres + (size_t)r * D + lane * 4 + 256 * i);
        norm_row(x, g, mod, mod + 1024, lane, o);
#pragma unroll
        for (int i = 0; i < 4; ++i) { uint2 u; u.x = pk_bf16(o[i].x, o[i].y); u.y = pk_bf16(o[i].z, o[i].w); *(uint2*)(h + (size_t)r * D + lane * 4 + 256 * i) = u; }
    }
}

struct EpiStoreBf16 { bf16_t* O; int ldc;
    __device__ __forceinline__ void operator()(int row, int col, const f32x4& v0, const f32x4& v1) const {
        uint2 a, b; a.x = pk_bf16(v0[0], v0[1]); a.y = pk_bf16(v0[2], v0[3]); b.x = pk_bf16(v1[0], v1[1]); b.y = pk_bf16(v1[2], v1[3]);
        *(uint2*)(O + (size_t)row * ldc + col) = a; *(uint2*)(O + (size_t)row * ldc + col + 16) = b; } };
struct EpiStore16 { bf16_t* O; int ldc;
    __device__ __forceinline__ void operator()(const f32x4 (&acc)[2][2][4][2], const pg8::Unit& u, int wr, int wc, int fr, int fq) const {
#pragma unroll
        for (int ai = 0; ai < 2; ++ai)
#pragma unroll
            for (int m = 0; m < 4; ++m)
#pragma unroll
                for (int bj = 0; bj < 2; ++bj) { const int row = u.row0 + ai * 128 + wr * 64 + m * 16 + fr, col = u.col0 + bj * 128 + wc * 32 + 8 * fq;
                    const f32x4 v0 = acc[ai][bj][m][0], v1 = acc[ai][bj][m][1];
                    uint4 o; o.x = pk_bf16(v0[0], v0[1]); o.y = pk_bf16(v0[2], v0[3]); o.z = pk_bf16(v1[0], v1[1]); o.w = pk_bf16(v1[2], v1[3]);
                    *(uint4*)(O + (size_t)row * ldc + col) = o; }
    } };
struct FStoreBf16 { bf16_t* O; int ldc;
    __device__ __forceinline__ void operator()(const pg8::Unit&, int row, int col, const f32x4& v0, const f32x4& v1) const {
        uint2 a, b; a.x = pk_bf16(v0[0], v0[1]); a.y = pk_bf16(v0[2], v0[3]); b.x = pk_bf16(v1[0], v1[1]); b.y = pk_bf16(v1[2], v1[3]);
        *(uint2*)(O + (size_t)row * ldc + col) = a; *(uint2*)(O + (size_t)row * ldc + col + 16) = b; } };
struct EpiG1 { bf16_t* Z; bf16_t* GT;
    __device__ __forceinline__ void operator()(const f32x4 (&acc)[2][2][4][2], const pg8::Unit& u, int wr, int wc, int fr, int fq) const {
        if (u.col0 < C_GATE) {
#pragma unroll
            for (int ai = 0; ai < 2; ++ai)
#pragma unroll
                for (int m = 0; m < 4; ++m)
#pragma unroll
                    for (int bj = 0; bj < 2; ++bj) { const int row = u.row0 + ai * 128 + wr * 64 + m * 16 + fr, col = u.col0 + bj * 128 + wc * 32 + 8 * fq;
                        const f32x4 v0 = acc[ai][bj][m][0], v1 = acc[ai][bj][m][1];
                        uint4 o; o.x = pk_bf16(v0[0], v0[1]); o.y = pk_bf16(v0[2], v0[3]); o.z = pk_bf16(v1[0], v1[1]); o.w = pk_bf16(v1[2], v1[3]);
                        *(uint4*)(Z + (size_t)row * ZP + col) = o; }
        } else {
            const int tidx = (wr * 4 + wc) * 64 + fq * 16 + fr;
            bf16_t* base = GT + ((size_t)(u.row0 >> 8) * 12 + ((u.col0 - C_GATE) >> 8)) * 65536 + tidx * 8;
#pragma unroll
            for (int ai = 0; ai < 2; ++ai)
#pragma unroll
                for (int bj = 0; bj < 2; ++bj)
#pragma unroll
                    for (int m = 0; m < 4; ++m) { const f32x4 v0 = acc[ai][bj][m][0], v1 = acc[ai][bj][m][1];
                        uint4 o; o.x = pk_bf16(sigmoidf_(v0[0]), sigmoidf_(v0[1])); o.y = pk_bf16(sigmoidf_(v0[2]), sigmoidf_(v0[3]));
                        o.z = pk_bf16(sigmoidf_(v1[0]), sigmoidf_(v1[1])); o.w = pk_bf16(sigmoidf_(v1[2]), sigmoidf_(v1[3]));
                        *(uint4*)(base + ((ai * 2 + bj) * 4 + m) * 4096) = o; }
        }
    } };
__device__ __forceinline__ void ph_g1(const Params& P, LAS unsigned char* lds) {
    pg8::SchedDense S{NTOK / 256, INC / 256, (int)gridDim.x, bid_(), (const char*)(P.ws + WS_H), (const char*)(P.ws + WS_WIN), (size_t)256 * D * 2, (size_t)256 * D * 2};
    EpiG1 E{(bf16_t*)(P.ws + WS_Z), (bf16_t*)(P.ws + WS_GT)};
    pg8::gemm_phase(lds, pg8::Gemm{D, D, D}, S, E);
}

__device__ __forceinline__ int kvrow(int r) { return r < NLAT ? ((r >> 11) * 2304 + 256 + (r & 2047)) : (((r - NLAT) >> 8) * 2304 + ((r - NLAT) & 255)); }
__device__ __forceinline__ void ph_prep(const Params& P, int l) {
    const int tid = tid_(), lane = tid & 63, wid = tid >> 6;
    const bf16_t* z = (const bf16_t*)(P.ws + WS_Z);
    bf16_t* qn = (bf16_t*)(P.ws + WS_QN); bf16_t* kn = (bf16_t*)(P.ws + WS_KN); bf16_t* vn = (bf16_t*)(P.ws + WS_VN);
    const float* rope = (const float*)(P.ws + WS_ROPE);
    const float gq = P.in[I_QNG][l * 64 + lane] * (0.125f * 1.4426950408889634f), gk = P.in[I_KNG][l * 64 + lane];
    for (int r = bid_() * 8 + wid; r < NTOK; r += gridDim.x * 8) {
        const bool lat = r < NLAT;
        const size_t kr = (size_t)kvrow(r);
        float cs = 1.f, sn = 0.f;
        if (lat) { const int t = r & 2047, fi = lane & 15;
            if (lane < 32) { const int pr = t >> 6; cs = rope[pr * 16 + fi]; sn = rope[512 + pr * 16 + fi]; }
            else { const int pc = t & 63; cs = rope[1024 + pc * 16 + fi]; sn = rope[2048 + pc * 16 + fi]; } }
        const float sgn = (lane & 16) ? 1.f : -1.f;
#pragma unroll
        for (int hh = 8; hh < 10; ++hh) {
            const int col = (hh < 8) ? (C_GQ + hh * 64) : (C_GK + (hh - 8) * 64);
            const float x = bf2f(z[(size_t)r * ZP + col + lane]);
            const float ss = wave_sum(x * x);
            const float xn = x * __builtin_amdgcn_rsqf(ss * (1.0f / 64.0f) + 1e-6f) * (hh < 8 ? gq : gk);
            const float pa = __shfl_xor(xn, 16, 64);
            const float o = xn * cs + sgn * pa * sn;
            const bf16_t ob = (bf16_t)(pk_bf16(o, 0.f) & 0xffffu);
            if (hh < 8) qn[(size_t)r * 512 + hh * 64 + lane] = ob; else kn[kr * 128 + (hh - 8) * 64 + lane] = ob;
        }
        *(unsigned*)(vn + kr * 128 + lane * 2) = *(const unsigned*)(z + (size_t)r * ZP + C_GV + lane * 2);
    }
}

__device__ __forceinline__ void ph_navt(const Params& P, LAS unsigned char* lds) {
    const int tid = tid_();
    const bf16_t* z = (const bf16_t*)(P.ws + WS_Z); bf16_t* vt = (bf16_t*)(P.ws + WS_NAVT);
    constexpr int PT = 1040;
    for (int u = bid_(); u < NB * 36; u += gridDim.x) {
        const int b = u / 36, tl = u % 36;
        const int row0 = (tl < 4) ? (NLAT + b * 256 + tl * 64) : (b * 2048 + (tl - 4) * 64);
        __syncthreads();
#pragma unroll
        for (int i = 0; i < 8; ++i) { const int ch = tid + i * NTHR, rr = ch >> 6, cc = ch & 63;
            const uint4 v = *(const uint4*)(z + (size_t)(row0 + rr) * ZP + C_NAV + cc * 8);
            *(LAS u32x4*)(lds + rr * PT + cc * 16) = (u32x4){v.x, v.y, v.z, v.w}; }
        __syncthreads();
#pragma unroll
        for (int i = 0; i < 8; ++i) { const int c = tid, tg = i;
            unsigned short e[8];
#pragma unroll
            for (int k = 0; k < 8; ++k) e[k] = *(const LAS unsigned short*)(lds + (tg * 8 + k) * PT + c * 2);
            uint4 o; o.x = e[0] | ((unsigned)e[1] << 16); o.y = e[2] | ((unsigned)e[3] << 16); o.z = e[4] | ((unsigned)e[5] << 16); o.w = e[6] | ((unsigned)e[7] << 16);
            *(uint4*)(vt + ((size_t)(b * 8 + (c >> 6)) * 64 + (c & 63)) * 2304 + tl * 64 + tg * 8) = o; }
    }
    __syncthreads();
}

#ifdef DIAG
__device__ __forceinline__ void load_q64(float (&q)[64], const bf16_t* p) {
#pragma unroll
    for (int i = 0; i < 8; ++i) { const uint4 u = ((const uint4*)p)[i];
        q[8 * i + 0] = bf_lo(u.x); q[8 * i + 1] = bf_hi(u.x); q[8 * i + 2] = bf_lo(u.y); q[8 * i + 3] = bf_hi(u.y);
        q[8 * i + 4] = bf_lo(u.z); q[8 * i + 5] = bf_hi(u.z); q[8 * i + 6] = bf_lo(u.w); q[8 * i + 7] = bf_hi(u.w); }
}
__device__ __forceinline__ void attn_key(const float (&q)[64], const bf16_t* kp, const bf16_t* vp, float bias, float& m, float& lsum, float (&o)[64]) {
    float s = 0.f;
#pragma unroll
    for (int i = 0; i < 8; ++i) { const uint4 u = ((const uint4*)kp)[i];
        s += q[8 * i + 0] * bf_lo(u.x) + q[8 * i + 1] * bf_hi(u.x) + q[8 * i + 2] * bf_lo(u.y) + q[8 * i + 3] * bf_hi(u.y)
           + q[8 * i + 4] * bf_lo(u.z) + q[8 * i + 5] * bf_hi(u.z) + q[8 * i + 6] * bf_lo(u.w) + q[8 * i + 7] * bf_hi(u.w); }
    s = s * 0.125f + bias;
    const float mn = fmaxf(m, s), corr = __expf(m - mn), pp = __expf(s - mn);
    lsum = lsum * corr + pp; m = mn;
#pragma unroll
    for (int i = 0; i < 8; ++i) { const uint4 u = ((const uint4*)vp)[i];
        o[8 * i + 0] = o[8 * i + 0] * corr + pp * bf_lo(u.x); o[8 * i + 1] = o[8 * i + 1] * corr + pp * bf_hi(u.x);
        o[8 * i + 2] = o[8 * i + 2] * corr + pp * bf_lo(u.y); o[8 * i + 3] = o[8 * i + 3] * corr + pp * bf_hi(u.y);
        o[8 * i + 4] = o[8 * i + 4] * corr + pp * bf_lo(u.z); o[8 * i + 5] = o[8 * i + 5] * corr + pp * bf_hi(u.z);
        o[8 * i + 6] = o[8 * i + 6] * corr + pp * bf_lo(u.w); o[8 * i + 7] = o[8 * i + 7] * corr + pp * bf_hi(u.w); }
}
__device__ __forceinline__ void store_o64(const float (&o)[64], float inv, bf16_t* p) {
#pragma unroll
    for (int i = 0; i < 8; ++i) { uint4 u;
        u.x = pk_bf16(o[8 * i + 0] * inv, o[8 * i + 1] * inv); u.y = pk_bf16(o[8 * i + 2] * inv, o[8 * i + 3] * inv);
        u.z = pk_bf16(o[8 * i + 4] * inv, o[8 * i + 5] * inv); u.w = pk_bf16(o[8 * i + 6] * inv, o[8 * i + 7] * inv);
        ((uint4*)p)[i] = u; }
}
__device__ __forceinline__ void na_thread(const Params& P, int l, int r, int h, bf16_t* br, int OPN) {
    const bf16_t* z = (const bf16_t*)(P.ws + WS_Z);
    float q[64], o[64]; float m = -INFINITY, ls = 0.f;
#pragma unroll
    for (int i = 0; i < 64; ++i) o[i] = 0.f;
    load_q64(q, z + (size_t)r * ZP + C_NAQ + h * 64);
    int b;
    if (r < NLAT) {
        b = r >> 11; const int t = r & 2047, qr = t >> 6, qc = t & 63;
        const int r0 = min(max(qr - 4, 0), 24), c0 = min(max(qc - 8, 0), 48);
        const float* rpb = P.in[I_RPB] + ((size_t)l * 8 + h) * 15 * 31;
        for (int kr = r0; kr < r0 + 8; ++kr)
            for (int kc = c0; kc < c0 + 16; ++kc) {
                const size_t krow = (size_t)(b * 2048 + kr * 64 + kc) * ZP;
                attn_key(q, z + krow + C_NAK + h * 64, z + krow + C_NAV + h * 64, rpb[(kr - qr + 7) * 31 + (kc - qc + 15)], m, ls, o);
            }
    } else b = (r - NLAT) >> 8;
    for (int j = 0; j < 256; ++j) {
        const size_t krow = (size_t)(NLAT + b * 256 + j) * ZP;
        attn_key(q, z + krow + C_NAK + h * 64, z + krow + C_NAV + h * 64, 0.f, m, ls, o);
    }
    store_o64(o, 1.0f / ls, br + (size_t)r * OPN + h * 64);
}
#endif
namespace na {
constexpr int KP = 144, VP = 528;
constexpr int L_K = 0, L_V = 256 * KP, L_B = L_V + 64 * VP, L_END = L_B + 480 * 4;
constexpr float C2 = 0.125f * 1.4426950408889634f, LOG2E = 1.4426950408889634f;
struct Acc { float m, l; f32x4 o[4]; };
template <int NG> __device__ __forceinline__ void absorb(Acc& A, f32x4 (&sa)[NG], f32x4 (&sb)[NG], const bf16x8 (&vfr)[NG][4]) {
    float mx = -INFINITY;
#pragma unroll
    for (int g = 0; g < NG; ++g)
#pragma unroll
        for (int j = 0; j < 4; ++j) mx = fmaxf(mx, fmaxf(sa[g][j], sb[g][j]));
    mx = fmaxf(mx, __shfl_xor(mx, 16, 64)); mx = fmaxf(mx, __shfl_xor(mx, 32, 64));
    const float mn = fmaxf(A.m, mx), corr = __builtin_amdgcn_exp2f(A.m - mn);
    A.m = mn;
    float ps = 0.f;
    bf16x8 pf[NG];
#pragma unroll
    for (int g = 0; g < NG; ++g) { float p[8];
#pragma unroll
        for (int j = 0; j < 4; ++j) { p[j] = __builtin_amdgcn_exp2f(sa[g][j] - mn); p[4 + j] = __builtin_amdgcn_exp2f(sb[g][j] - mn); ps += p[j] + p[4 + j]; }
        pf[g] = pack8(p); }
    A.l = A.l * corr + ps;
#pragma unroll
    for (int db = 0; db < 4; ++db) A.o[db] *= corr;
#pragma unroll
    for (int g = 0; g < NG; ++g)
#pragma unroll
        for (int db = 0; db < 4; ++db) A.o[db] = __builtin_amdgcn_mfma_f32_16x16x32_bf16(vfr[g][db], pf[g], A.o[db], 0, 0, 0);
}
}
__device__ __forceinline__ void na_unit(const Params& P, LAS unsigned char* lds, int l, int u, bf16_t* br, int OPN) {
    const int tid = tid_(), lane = tid & 63, wid = __builtin_amdgcn_readfirstlane(tid >> 6), c16 = lane & 15, kq = lane >> 4;
    const bool latu = u < 256;
    const int bh = latu ? (u >> 2) : (u - 256), b = bh >> 3, h = bh & 7, q4 = u & 3;
    const bf16_t* z = (const bf16_t*)(P.ws + WS_Z); const bf16_t* vt = (const bf16_t*)(P.ws + WS_NAVT) + (size_t)bh * 64 * 2304;
    LAS unsigned char* KL = lds + na::L_K; LAS unsigned char* VL = lds + na::L_V; LAS float* BL = (LAS float*)(lds + na::L_B);
    __syncthreads();
#pragma unroll
    for (int i = 0; i < 4; ++i) { const int ch = tid + i * NTHR, rr = ch >> 3, cc = ch & 7;
        const uint4 v = *(const uint4*)(z + (size_t)(NLAT + b * 256 + rr) * ZP + C_NAK + h * 64 + cc * 8);
        *(LAS u32x4*)(KL + rr * na::KP + cc * 16) = (u32x4){v.x, v.y, v.z, v.w}; }
#pragma unroll
    for (int i = 0; i < 4; ++i) { const int ch = tid + i * NTHR, rr = ch >> 5, cc = ch & 31;
        const uint4 v = *(const uint4*)(vt + (size_t)rr * 2304 + cc * 8);
        *(LAS u32x4*)(VL + rr * na::VP + cc * 16) = (u32x4){v.x, v.y, v.z, v.w}; }
    if (tid < 465) BL[tid] = P.in[I_RPB][((size_t)l * 8 + h) * 465 + tid] * na::LOG2E;
    __syncthreads();
    const int sA = 8 * (c16 >> 2) + (c16 & 3);
    const int ntask = latu ? 4 : 2;
    struct TaskP { int qrow, r, jb, r0, kc0; };
#define NA_FENCE() asm volatile("" ::: "memory")
#define NA_TASKP(it_, t_) do { const int tk_ = (it_) * 8 + wid; t_.r = 0; t_.jb = 0; t_.r0 = 0; t_.kc0 = 0; \
        if (latu) { t_.r = q4 * 8 + (tk_ >> 2); t_.jb = tk_ & 3; t_.qrow = b * 2048 + t_.r * 64 + t_.jb * 16 + c16; t_.r0 = min(max(t_.r - 4, 0), 24); t_.kc0 = min(max(t_.jb * 16 - 8, 0), 32); } \
        else t_.qrow = NLAT + b * 256 + tk_ * 16 + c16; } while (0)
#define NA_LOADK(t_, c_, kf_) do { _Pragma("unroll") for (int g = 0; g < 2; ++g) { const bf16_t* kp_ = z + ((size_t)b * 2048 + (size_t)(t_.r0 + 2 * (c_) + g) * 64 + t_.kc0 + sA) * ZP + C_NAK + h * 64 + 8 * kq; \
            kf_[g][0] = *(const bf16x8*)kp_; kf_[g][1] = *(const bf16x8*)(kp_ + 32); kf_[g][2] = *(const bf16x8*)(kp_ + 4 * ZP); kf_[g][3] = *(const bf16x8*)(kp_ + 4 * ZP + 32); } } while (0)
#define NA_LOADV(t_, c_, vf_) do { const bf16_t* vp_ = vt + (size_t)c16 * 2304 + 256 + (t_.r0 + 2 * (c_)) * 64 + t_.kc0 + 8 * kq; \
        _Pragma("unroll") for (int g = 0; g < 2; ++g) _Pragma("unroll") for (int db = 0; db < 4; ++db) vf_[g][db] = *(const bf16x8*)(vp_ + (size_t)db * 16 * 2304 + g * 64); } while (0)
    for (int it = 0; it < ntask; ++it) {
        TaskP T; NA_TASKP(it, T);
        bf16x8 qf[2];
#pragma unroll
        for (int ks = 0; ks < 2; ++ks) qf[ks] = *(const bf16x8*)(z + (size_t)T.qrow * ZP + C_NAQ + h * 64 + 32 * ks + 8 * kq);
        na::Acc A; A.m = -INFINITY; A.l = 0.f;
#pragma unroll
        for (int db = 0; db < 4; ++db) A.o[db] = (f32x4){0.f, 0.f, 0.f, 0.f};
        if (latu) {
            bf16x8 kA[2][4], vA[2][4], kB[2][4], vB[2][4];
            NA_LOADK(T, 0, kA); NA_LOADV(T, 0, vA); NA_LOADK(T, 1, kB); NA_LOADV(T, 1, vB);
            const int qc = T.jb * 16 + c16, c0 = min(max(qc - 8, 0), 48);
            int dcol[8]; bool ok[8];
#pragma unroll
            for (int j = 0; j < 8; ++j) { const int kc = T.kc0 + 8 * kq + j; ok[j] = (kc >= c0) && (kc < c0 + 16); dcol[j] = ok[j] ? (kc - qc + 15) : 0; }
#define NA_SCORES(KF, CI) do { \
                float bv[2][8]; \
                _Pragma("unroll") for (int g = 0; g < 2; ++g) { const int brow = (T.r0 + 2 * (CI) + g - T.r + 7) * 31; \
                    _Pragma("unroll") for (int j = 0; j < 8; ++j) bv[g][j] = BL[brow + dcol[j]]; } \
                _Pragma("unroll") for (int g = 0; g < 2; ++g) { \
                    f32x4 a_ = {0.f, 0.f, 0.f, 0.f}, b_ = {0.f, 0.f, 0.f, 0.f}; \
                    a_ = __builtin_amdgcn_mfma_f32_16x16x32_bf16(KF[g][0], qf[0], a_, 0, 0, 0); a_ = __builtin_amdgcn_mfma_f32_16x16x32_bf16(KF[g][1], qf[1], a_, 0, 0, 0); \
                    b_ = __builtin_amdgcn_mfma_f32_16x16x32_bf16(KF[g][2], qf[0], b_, 0, 0, 0); b_ = __builtin_amdgcn_mfma_f32_16x16x32_bf16(KF[g][3], qf[1], b_, 0, 0, 0); \
                    _Pragma("unroll") for (int j = 0; j < 4; ++j) { \
                        const float va_ = a_[j] * na::C2 + bv[g][j], vb_ = b_[j] * na::C2 + bv[g][4 + j]; \
                        sa[g][j] = ok[j] ? va_ : -INFINITY; sb[g][j] = ok[4 + j] ? vb_ : -INFINITY; } } } while (0)
            f32x4 sa[2], sb[2];
            NA_SCORES(kA, 0); NA_FENCE(); NA_LOADK(T, 2, kA); NA_FENCE(); na::absorb<2>(A, sa, sb, vA); NA_FENCE(); NA_LOADV(T, 2, vA); NA_FENCE();
            NA_SCORES(kB, 1); NA_FENCE(); NA_LOADK(T, 3, kB); NA_FENCE(); na::absorb<2>(A, sa, sb, vB); NA_FENCE(); NA_LOADV(T, 3, vB); NA_FENCE();
            NA_SCORES(kA, 2); na::absorb<2>(A, sa, sb, vA);
            NA_SCORES(kB, 3); na::absorb<2>(A, sa, sb, vB);
#undef NA_SCORES
        }
#pragma unroll 1
        for (int ch = 0; ch < 2; ++ch) {
            f32x4 sa[4], sb[4];
            bf16x8 kf[4][4], vfr[4][4];
            { const LAS unsigned char* vp = VL + c16 * na::VP + (ch * 128 + 8 * kq) * 2;
#pragma unroll
              for (int g = 0; g < 4; ++g)
#pragma unroll
                for (int db = 0; db < 4; ++db) vfr[g][db] = *(const LAS bf16x8*)(vp + db * 16 * na::VP + g * 64); }
#pragma unroll
            for (int g = 0; g < 4; ++g) {
                const LAS unsigned char* kp = KL + (ch * 128 + g * 32 + sA) * na::KP + kq * 16;
                kf[g][0] = *(const LAS bf16x8*)kp; kf[g][1] = *(const LAS bf16x8*)(kp + 64); kf[g][2] = *(const LAS bf16x8*)(kp + 4 * na::KP); kf[g][3] = *(const LAS bf16x8*)(kp + 4 * na::KP + 64);
            }
#pragma unroll
            for (int g = 0; g < 4; ++g) {
                f32x4 a = {0.f, 0.f, 0.f, 0.f}, bq = {0.f, 0.f, 0.f, 0.f};
                a = __builtin_amdgcn_mfma_f32_16x16x32_bf16(kf[g][0], qf[0], a, 0, 0, 0); a = __builtin_amdgcn_mfma_f32_16x16x32_bf16(kf[g][1], qf[1], a, 0, 0, 0);
                bq = __builtin_amdgcn_mfma_f32_16x16x32_bf16(kf[g][2], qf[0], bq, 0, 0, 0); bq = __builtin_amdgcn_mfma_f32_16x16x32_bf16(kf[g][3], qf[1], bq, 0, 0, 0);
                sa[g] = a * na::C2; sb[g] = bq * na::C2;
            }
            na::absorb<4>(A, sa, sb, vfr);
        }
        float ls = A.l; ls += __shfl_xor(ls, 16, 64); ls += __shfl_xor(ls, 32, 64);
        const float inv = __builtin_amdgcn_rcpf(ls);
        bf16_t* op = br + (size_t)T.qrow * OPN + h * 64 + 4 * kq;
#pragma unroll
        for (int db = 0; db < 4; ++db) { uint2 o; o.x = pk_bf16(A.o[db][0] * inv, A.o[db][1] * inv); o.y = pk_bf16(A.o[db][2] * inv, A.o[db][3] * inv);
            *(uint2*)(op + 16 * db) = o; }
    }
#undef NA_FENCE
#undef NA_TASKP
#undef NA_LOADK
#undef NA_LOADV
}
__device__ __forceinline__ int hg_row(int b, int dir, int s) { return s < 256 ? (NLAT + b * 256 + (dir ? 255 - s : s)) : (b * 2048 + (dir ? 2047 - (s - 256) : (s - 256))); }
__device__ __forceinline__ bf16x8 tr2(const LAS unsigned char* p0, const LAS unsigned char* p1) {
    typedef short v4i16_t __attribute__((ext_vector_type(4)));
    const v4i16_t a = __builtin_amdgcn_ds_read_tr16_b64_v4i16((LAS v4i16_t*)p0), c = __builtin_amdgcn_ds_read_tr16_b64_v4i16((LAS v4i16_t*)p1);
    return (bf16x8){a[0], a[1], a[2], a[3], c[0], c[1], c[2], c[3]};
}
__device__ __forceinline__ void hgrn_unit(const Params& P, LAS unsigned char* lds, int l, int u) {
    const int tid = tid_(), lane = tid & 63, wid = __builtin_amdgcn_readfirstlane(tid >> 6), c16 = lane & 15, kq = lane >> 4;
    const int b = u >> 3, h = (u >> 1) & 3, dir = u & 1;
    const bf16_t* z = (const bf16_t*)(P.ws + WS_Z);
    float* O = (float*)(P.ws + (dir ? WS_Y : WS_H));
    const float* lbv = (const float*)(P.ws + WS_LB) + ((size_t)l * 2 + dir) * 512 + h * 128;
    constexpr int PQ = 272;
    LAS unsigned char* QH = lds; LAS unsigned char* KT = lds + 8704; LAS unsigned char* KH = lds + 17408; LAS unsigned char* VV = lds + 26112;
    LAS float* DL = (LAS float*)(lds + 34816); LAS float* WT = DL + 128;
    const int ch = 2 * lane;
    const float lb0 = lbv[ch], lb1 = lbv[ch + 1];
    const int cf = (dir ? C_HFB : C_HFF) + h * 128 + ch, cq = C_HQ + h * 128 + ch, cv = C_HI + h * 128 + ch;
    f32x4 SA[4], SB[4];
#pragma unroll
    for (int G = 0; G < 4; ++G) { SA[G] = (f32x4){0.f, 0.f, 0.f, 0.f}; SB[G] = (f32x4){0.f, 0.f, 0.f, 0.f}; }
    unsigned rf[4], rq[4], rv[4];
#pragma unroll
    for (int k = 0; k < 4; ++k) { const bf16_t* zr = z + (size_t)hg_row(b, dir, 4 * wid + k) * ZP; rf[k] = *(const unsigned*)(zr + cf); rq[k] = *(const unsigned*)(zr + cq); rv[k] = *(const unsigned*)(zr + cv); }
    const int sA = 8 * (c16 >> 2) + (c16 & 3);
    const int tq = c16 >> 2, tp = c16 & 3;
    for (int st = 0; st < 72; ++st) {
        unsigned xf[4], xq[4], xv[4];
#pragma unroll
        for (int k = 0; k < 4; ++k) { xf[k] = rf[k]; xq[k] = rq[k]; xv[k] = rv[k]; }
        if (st + 1 < 72) {
#pragma unroll
            for (int k = 0; k < 4; ++k) { const bf16_t* zr = z + (size_t)hg_row(b, dir, (st + 1) * 32 + 4 * wid + k) * ZP; rf[k] = *(const unsigned*)(zr + cf); rq[k] = *(const unsigned*)(zr + cq); rv[k] = *(const unsigned*)(zr + cv); }
        }
        float g0[4], g1[4], k0[4], k1[4], q0[4], q1[4];
        float c0 = 1.f, c1 = 1.f;
#pragma unroll
        for (int k = 0; k < 4; ++k) {
            const float f0 = lb0 + (1.0f - lb0) * sigmoidf_(bf_lo(xf[k])), f1 = lb1 + (1.0f - lb1) * sigmoidf_(bf_hi(xf[k]));
            c0 *= f0; c1 *= f1; g0[k] = c0; g1[k] = c1;
            k0[k] = 1.0f - f0; k1[k] = 1.0f - f1; q0[k] = siluf_(bf_lo(xq[k])); q1[k] = siluf_(bf_hi(xq[k]));
        }
        WT[wid * 128 + ch] = c0; WT[wid * 128 + ch + 1] = c1;
        __syncthreads();
        float pre0 = 1.f, pre1 = 1.f, tot0 = 1.f, tot1 = 1.f;
#pragma unroll
        for (int w = 0; w < 8; ++w) { const float a0 = WT[w * 128 + ch], a1 = WT[w * 128 + ch + 1]; tot0 *= a0; tot1 *= a1; if (w < wid) { pre0 *= a0; pre1 *= a1; } }
#pragma unroll
        for (int k = 0; k < 4; ++k) {
            const float e0 = g0[k] * pre0, e1 = g1[k] * pre1;
            const float r0 = __builtin_amdgcn_rcpf(e0), r1 = __builtin_amdgcn_rcpf(e1);
            const float kt0 = k0[k] * r0, kt1 = k1[k] * r1;
            const int ro = (4 * wid + k) * PQ + ch * 2;
            *(LAS unsigned*)(QH + ro) = pk_bf16(q0[k] * e0, q1[k] * e1);
            *(LAS unsigned*)(KT + ro) = pk_bf16(kt0, kt1);
            *(LAS unsigned*)(KH + ro) = pk_bf16(kt0 * tot0, kt1 * tot1);
            *(LAS unsigned*)(VV + ro) = xv[k];
        }
        if (wid == 0) { DL[ch] = tot0; DL[ch + 1] = tot1; }
        __syncthreads();
        const bf16x8 vfr = tr2(VV + (8 * kq + tq) * PQ + (16 * wid + 4 * tp) * 2, VV + (8 * kq + 4 + tq) * PQ + (16 * wid + 4 * tp) * 2);
        bf16x8 Sb[4];
#pragma unroll
        for (int G = 0; G < 4; ++G) { const float sv[8] = {SA[G][0], SA[G][1], SA[G][2], SA[G][3], SB[G][0], SB[G][1], SB[G][2], SB[G][3]}; Sb[G] = pack8(sv); }
#pragma unroll
        for (int T = 0; T < 2; ++T) {
            f32x4 aA = {0.f, 0.f, 0.f, 0.f}, aB = {0.f, 0.f, 0.f, 0.f};
            bf16x8 qf[4];
#pragma unroll
            for (int ks = 0; ks < 4; ++ks) {
                const bf16x8 kA = *(const LAS bf16x8*)(KT + sA * PQ + (32 * ks + 8 * kq) * 2);
                const bf16x8 kB = *(const LAS bf16x8*)(KT + (sA + 4) * PQ + (32 * ks + 8 * kq) * 2);
                qf[ks] = *(const LAS bf16x8*)(QH + (16 * T + c16) * PQ + (32 * ks + 8 * kq) * 2);
                aA = __builtin_amdgcn_mfma_f32_16x16x32_bf16(kA, qf[ks], aA, 0, 0, 0);
                aB = __builtin_amdgcn_mfma_f32_16x16x32_bf16(kB, qf[ks], aB, 0, 0, 0);
            }
            const int t = 16 * T + c16;
            float pv_[8];
#pragma unroll
            for (int jj = 0; jj < 4; ++jj) { pv_[jj] = (8 * kq + jj <= t) ? aA[jj] : 0.f; pv_[4 + jj] = (8 * kq + 4 + jj <= t) ? aB[jj] : 0.f; }
            f32x4 o = {0.f, 0.f, 0.f, 0.f};
            o = __builtin_amdgcn_mfma_f32_16x16x32_bf16(pack8(pv_), vfr, o, 0, 0, 0);
#pragma unroll
            for (int ks = 0; ks < 4; ++ks) o = __builtin_amdgcn_mfma_f32_16x16x32_bf16(qf[ks], Sb[ks], o, 0, 0, 0);
#pragma unroll
            for (int jj = 0; jj < 4; ++jj) O[(size_t)hg_row(b, dir, st * 32 + 16 * T + 4 * kq + jj) * 512 + h * 128 + 16 * wid + c16] = o[jj];
        }
#pragma unroll
        for (int G = 0; G < 4; ++G) {
            const f32x4 d0 = *(const LAS f32x4*)(DL + 32 * G + 8 * kq), d1 = *(const LAS f32x4*)(DL + 32 * G + 8 * kq + 4);
            const LAS unsigned char* ka = KH + (8 * kq + tq) * PQ + (32 * G + 8 * tp) * 2;
            const bf16x8 hA = tr2(ka, ka + 4 * PQ), hB = tr2(ka + 8, ka + 4 * PQ + 8);
            SA[G] = __builtin_amdgcn_mfma_f32_16x16x32_bf16(hA, vfr, SA[G] * d0, 0, 0, 0);
            SB[G] = __builtin_amdgcn_mfma_f32_16x16x32_bf16(hB, vfr, SB[G] * d1, 0, 0, 0);
        }
    }
    __syncthreads();
}
__device__ __forceinline__ void gqa_unit(const Params& P, char* shm, int l, int U) {
    const bf16_t* z = (const bf16_t*)(P.ws + WS_Z); const bf16_t* kn = (const bf16_t*)(P.ws + WS_KN); const bf16_t* vn = (const bf16_t*)(P.ws + WS_VN);
    bf16_t* br = (bf16_t*)(P.ws + WS_BR);
    int b, hq, row0, NT;
    if (U < 512) { const int bg = U >> 5; b = bg >> 1; hq = (bg & 1) * 4 + ((U & 31) >> 3); row0 = b * 2048 + (U & 7) * 256; NT = 36; }
    else { const int v = U - 512; b = v >> 3; hq = v & 7; row0 = NLAT + b * 256; NT = 4; }
    const int g = hq >> 2;
    gqa::attn_unit<8>(z + (size_t)row0 * ZP + C_GQ + hq * 64, P.in[I_QNG] + l * 64, (const float*)(P.ws + WS_ROPE), (U < 512) ? ((U & 7) * 256) : -1,
                      kn + (size_t)b * 2304 * 128 + g * 64, vn + (size_t)b * 2304 * 128 + g * 64, br + (size_t)row0 * BRW + 1024 + hq * 64, NT, shm);
}
__device__ __forceinline__ void ph_mix(const Params& P, LAS unsigned char* lds, char* shm, int l, int pass = 0, int filter = 0) {
    const int tid = tid_();
    unsigned* qctr = (unsigned*)(P.ws + WS_CNT + 512) + l + 4 * pass;
    volatile LAS unsigned* qslot = (volatile LAS unsigned*)(lds + LDS_BYTES - 32);
    for (;;) {
        if (tid == 0) *qslot = __hip_atomic_fetch_add(qctr, 1u, __ATOMIC_RELAXED, __HIP_MEMORY_SCOPE_AGENT);
        __syncthreads();
        const int u = (int)*qslot;
        __syncthreads();
        if (u >= 960) break;
        const int kind = (u < 64) ? 2 : ((u >= 64 && u < 320) || (u >= 832 && u < 896)) ? 3 : 1;
        if (filter != 0 && filter != kind) continue;
        if (u < 64) hgrn_unit(P, lds, l, u);
        else if (u < 320) na_unit(P, lds, l, u - 64, (bf16_t*)(P.ws + WS_BR), BRW);
        else if (u < 832) gqa_unit(P, shm, l, u - 320);
        else if (u < 896) { if (l < DEPTH - 1) na_unit(P, lds, l, 256 + (u - 832), (bf16_t*)(P.ws + WS_BR), BRW); }
        else { if (l < DEPTH - 1) gqa_unit(P, shm, l, 512 + (u - 896)); }
        __syncthreads();
    }
}
#ifdef DIAG
__device__ __forceinline__ void ph_diag_cmp(const Params& P) {
    const bf16_t* br = (const bf16_t*)(P.ws + WS_BR); const bf16_t* d1 = (const bf16_t*)(P.ws + WS_END); const bf16_t* d2 = d1 + (size_t)NTOK * 512;
    const bf16_t* z = (const bf16_t*)(P.ws + WS_Z); const bf16_t* vt = (const bf16_t*)(P.ws + WS_NAVT);
    unsigned* dg = (unsigned*)(P.ws + 20480);
    unsigned c1 = 0, c2 = 0, c3 = 0;
    for (size_t i = (size_t)bid_() * NTHR + tid_(); i < (size_t)NTOK * 512; i += (size_t)gridDim.x * NTHR) {
        const size_t r = i >> 9; const int c = (int)(i & 511);
        const float a = bf2f(br[r * BRW + c]), x = bf2f(d1[i]);
        if (!(fabsf(x - a) <= 0.004f + 0.02f * fabsf(a))) ++c1;
        if (DIAG != 4 && d1[i] != d2[i]) ++c3;
        const int rr = (int)r; const int bb = rr < NLAT ? (rr >> 11) : ((rr - NLAT) >> 8); const int tok = rr < NLAT ? (256 + (rr & 2047)) : ((rr - NLAT) & 255);
        if (vt[((size_t)(bb * 8 + (c >> 6)) * 64 + (c & 63)) * 2304 + tok] != z[r * ZP + C_NAV + c]) ++c2;
    }
    if (c1) atomicAdd(dg + 1, c1);
    if (c2) atomicAdd(dg + 2, c2);
    if (c3) atomicAdd(dg + 3, c3);
}
__device__ __forceinline__ void ph_diag_out(const Params& P) {
    const volatile unsigned* dg = (const volatile unsigned*)(P.ws + 20480);
    const unsigned c1 = dg[1], c2 = dg[2], c3 = dg[3];
    if ((c1 | c2 | c3) == 0) return;
    unsigned k = 0; { unsigned v = c1; while (v) { ++k; v >>= 1; } }
    if (c2) k += 30; if (c3) k += 60;
    const float cst = sqrtf(10.0f * (float)k + 9.0f);
    for (size_t i = (size_t)bid_() * NTHR + tid_(); i < (size_t)NLAT * D; i += (size_t)gridDim.x * NTHR) P.out[i] = cst;
}
#endif

__device__ __forceinline__ void ph_readout(const Params& P, int l) {
    const int tid = tid_(), lane = tid & 63, wid = tid >> 6;
    const float* OF = (const float*)(P.ws + WS_H); const float* OB = (const float*)(P.ws + WS_Y);
    const bf16_t* z = (const bf16_t*)(P.ws + WS_Z);
    bf16_t* br = (bf16_t*)(P.ws + WS_BR);
    const float g0 = P.in[I_HGN][l * 128 + lane * 2], g1 = P.in[I_HGN][l * 128 + lane * 2 + 1];
    for (int r = bid_() * 8 + wid; r < NTOK; r += gridDim.x * 8) {
#pragma unroll
        for (int h = 0; h < 4; ++h) {
            const int c = h * 128 + lane * 2;
            const float2 a = *(const float2*)(OF + (size_t)r * 512 + c), bb = *(const float2*)(OB + (size_t)r * 512 + c);
            const float o0 = a.x + bb.x, o1 = a.y + bb.y;
            const float ss = wave_sum(o0 * o0 + o1 * o1);
            const float rstd = __builtin_amdgcn_rsqf(ss * (1.0f / 128.0f) + 1e-6f);
            const unsigned gz = *(const unsigned*)(z + (size_t)r * ZP + C_HG + c);
            *(unsigned*)(br + (size_t)r * BRW + 512 + c) = pk_bf16(o0 * rstd * g0 * siluf_(bf_lo(gz)), o1 * rstd * g1 * siluf_(bf_hi(gz)));
        }
    }
}
struct SchedMerge { int G, c; const char* br; const char* wb; bool last;
    __device__ __forceinline__ bool next(int i, pg8::Unit& u) const {
        const int nl = (c < 256) ? (256 - c + G - 1) / G : 0;
        int tile, bi, mode;
        if (i < 3 * nl) { tile = c + (i / 3) * G; bi = i % 3; mode = 0; }
        else { if (last) return false; const int sidx = c + (i - 3 * nl) * G; if (sidx >= 96) return false; tile = 256 + sidx / 3; bi = sidx % 3; mode = 1; }
        const int pm = tile >> 2, pn = tile & 3;
        u.row0 = pm * 256; u.col0 = pn * 256; u.aux = bi | (mode << 4);
        u.A = br + ((size_t)pm * 256 * BRW + bi * 512) * 2; u.B = wb + ((size_t)bi * 1024 + pn * 256) * 512 * 2; return true; } };
struct EpiMerge { const bf16_t* GT; bf16_t* YP; bf16_t* Y; bf16_t* PG;
    __device__ __forceinline__ void operator()(const f32x4 (&acc)[2][2][4][2], const pg8::Unit& u, int wr, int wc, int fr, int fq) const {
        const int tidx = (wr * 4 + wc) * 64 + fq * 16 + fr, bi = u.aux & 15, mode = u.aux >> 4, pm = u.row0 >> 8, pn = u.col0 >> 8;
        const bf16_t* gb = GT + ((size_t)pm * 12 + bi * 4 + pn) * 65536 + tidx * 8;
        if (mode == 1) {
            bf16_t* pb = PG + ((size_t)bi * 32 + (pm - 64) * 4 + pn) * 65536 + tidx * 8;
#pragma unroll
            for (int ai = 0; ai < 2; ++ai)
#pragma unroll
                for (int bj = 0; bj < 2; ++bj) {
                    uint4 g[4];
#pragma unroll
                    for (int m = 0; m < 4; ++m) g[m] = *(const uint4*)(gb + ((ai * 2 + bj) * 4 + m) * 4096);
#pragma unroll
                    for (int m = 0; m < 4; ++m) { const f32x4 v0 = acc[ai][bj][m][0], v1 = acc[ai][bj][m][1];
                        uint4 o; o.x = pk_bf16(bf_lo(g[m].x) * v0[0], bf_hi(g[m].x) * v0[1]); o.y = pk_bf16(bf_lo(g[m].y) * v0[2], bf_hi(g[m].y) * v0[3]);
                        o.z = pk_bf16(bf_lo(g[m].z) * v1[0], bf_hi(g[m].z) * v1[1]); o.w = pk_bf16(bf_lo(g[m].w) * v1[2], bf_hi(g[m].w) * v1[3]);
                        *(uint4*)(pb + ((ai * 2 + bj) * 4 + m) * 4096) = o; }
                }
            return;
        }
        bf16_t* yb = YP + ((size_t)pm * 4 + pn) * 65536 + tidx * 8;
#pragma unroll
        for (int ai = 0; ai < 2; ++ai)
#pragma unroll
            for (int bj = 0; bj < 2; ++bj) {
                uint4 g[4], p[4];
#pragma unroll
                for (int m = 0; m < 4; ++m) g[m] = *(const uint4*)(gb + ((ai * 2 + bj) * 4 + m) * 4096);
                if (bi != 0) {
#pragma unroll
                    for (int m = 0; m < 4; ++m) p[m] = *(const uint4*)(yb + ((ai * 2 + bj) * 4 + m) * 4096);
                } else {
#pragma unroll
                    for (int m = 0; m < 4; ++m) p[m] = make_uint4(0u, 0u, 0u, 0u);
                }
#pragma unroll
                for (int m = 0; m < 4; ++m) { const int k = ((ai * 2 + bj) * 4 + m) * 4096;
                    const f32x4 v0 = acc[ai][bj][m][0], v1 = acc[ai][bj][m][1];
                    const float t[8] = {bf_lo(p[m].x) + bf_lo(g[m].x) * v0[0], bf_hi(p[m].x) + bf_hi(g[m].x) * v0[1], bf_lo(p[m].y) + bf_lo(g[m].y) * v0[2], bf_hi(p[m].y) + bf_hi(g[m].y) * v0[3],
                                        bf_lo(p[m].z) + bf_lo(g[m].z) * v1[0], bf_hi(p[m].z) + bf_hi(g[m].z) * v1[1], bf_lo(p[m].w) + bf_lo(g[m].w) * v1[2], bf_hi(p[m].w) + bf_hi(g[m].w) * v1[3]};
                    if (bi != 2) { uint4 o; o.x = pk_bf16(t[0], t[1]); o.y = pk_bf16(t[2], t[3]); o.z = pk_bf16(t[4], t[5]); o.w = pk_bf16(t[6], t[7]); *(uint4*)(yb + k) = o; }
                    else { const int row = u.row0 + ai * 128 + wr * 64 + m * 16 + fr, col = u.col0 + bj * 128 + wc * 32 + 8 * fq;
                        uint4 o; o.x = pk_bf16(t[0], t[1]); o.y = pk_bf16(t[2], t[3]); o.z = pk_bf16(t[4], t[5]); o.w = pk_bf16(t[6], t[7]);
                        *(uint4*)(Y + (size_t)row * D + col) = o; }
                }
            }
    } };
__device__ __forceinline__ void ph_merge(const Params& P, LAS unsigned char* lds, int l) {
    SchedMerge S{(int)gridDim.x, bid_(), (const char*)(P.ws + WS_BR), (const char*)(P.ws + WS_WBR), l == DEPTH - 1};
    EpiMerge E{(const bf16_t*)(P.ws + WS_GT), (bf16_t*)(P.ws + WS_H), (bf16_t*)(P.ws + WS_Y), (bf16_t*)(P.ws + WS_PG)};
    pg8::gemm_phase(lds, pg8::Gemm{512, BRW, 512}, S, E);
    if (l + 1 < DEPTH && (int)bid_() >= 96) wconv_range(P, lds, l + 1, 0, 16 * 124, (int)bid_() - 96, (int)gridDim.x - 96);
}
struct EpiDelta { bf16_t* DX; const float* mods; int l;
    __device__ __forceinline__ void operator()(const f32x4 (&acc)[2][2][4][2], const pg8::Unit& u, int wr, int wc, int fr, int fq) const {
        const float* gate = mods + ((size_t)l * 9 + row_modrow(u.row0)) * 6144 + 2 * 1024 + u.col0 + wc * 32 + 8 * fq;
        f32x4 gv[2][2];
#pragma unroll
        for (int bj = 0; bj < 2; ++bj)
#pragma unroll
            for (int n = 0; n < 2; ++n) gv[bj][n] = *(const f32x4*)(gate + bj * 128 + n * 4);
#pragma unroll
        for (int ai = 0; ai < 2; ++ai)
#pragma unroll
            for (int m = 0; m < 4; ++m)
#pragma unroll
                for (int bj = 0; bj < 2; ++bj) { const int row = u.row0 + ai * 128 + wr * 64 + m * 16 + fr, col = u.col0 + bj * 128 + wc * 32 + 8 * fq;
                    const f32x4 v0 = acc[ai][bj][m][0] * gv[bj][0], v1 = acc[ai][bj][m][1] * gv[bj][1];
                    uint4 o; o.x = pk_bf16(v0[0], v0[1]); o.y = pk_bf16(v0[2], v0[3]); o.z = pk_bf16(v1[0], v1[1]); o.w = pk_bf16(v1[2], v1[3]);
                    *(uint4*)(DX + (size_t)row * D + col) = o; }
    } };
struct SchedWout { int G, c; const char* A; const char* B; bool last;
    __device__ __forceinline__ bool next(int i, pg8::Unit& u) const {
        const int nc = (!last && c < 32) ? 1 : 0;
        int tile;
        if (i < nc) tile = 256 + c; else { tile = c + (i - nc) * G; if (tile >= 256) return false; }
        const int pm = tile >> 2, pn = tile & 3;
        u.row0 = pm * 256; u.col0 = pn * 256; u.aux = 0; u.A = A + (size_t)pm * 256 * D * 2; u.B = B + (size_t)pn * 256 * D * 2; return true; } };
__device__ __forceinline__ void ph_wout(const Params& P, LAS unsigned char* lds, int l, bool dry = false) {
    const bool last = (l == DEPTH - 1);
    const int c = bid_();
    if (!last && c < 32) {
        const int tid = tid_(), wid = tid >> 6, lane = tid & 63, wr = wid >> 2, wc = wid & 3, fr = lane & 15, fq = lane >> 4;
        const bf16_t* PG = (const bf16_t*)(P.ws + WS_PG); bf16_t* Y = (bf16_t*)(P.ws + WS_Y);
        const int pp = c >> 2;
        for (int pn = 0; pn < 4; ++pn)
#pragma unroll
            for (int kk = 0; kk < 16; ++kk) {
                const size_t off = ((size_t)pp * 4 + pn) * 65536 + kk * 4096 + tid * 8;
                const uint4 a = *(const uint4*)(PG + off), b = *(const uint4*)(PG + (size_t)32 * 65536 + off), d = *(const uint4*)(PG + (size_t)64 * 65536 + off);
                const int ai = kk >> 3, bj = (kk >> 2) & 1, m = kk & 3;
                const int row = (64 + pp) * 256 + ai * 128 + wr * 64 + m * 16 + fr, col = pn * 256 + bj * 128 + wc * 32 + 8 * fq;
                uint4 o;
                o.x = pk_bf16(bf_lo(a.x) + bf_lo(b.x) + bf_lo(d.x), bf_hi(a.x) + bf_hi(b.x) + bf_hi(d.x)); o.y = pk_bf16(bf_lo(a.y) + bf_lo(b.y) + bf_lo(d.y), bf_hi(a.y) + bf_hi(b.y) + bf_hi(d.y));
                o.z = pk_bf16(bf_lo(a.z) + bf_lo(b.z) + bf_lo(d.z), bf_hi(a.z) + bf_hi(b.z) + bf_hi(d.z)); o.w = pk_bf16(bf_lo(a.w) + bf_lo(b.w) + bf_lo(d.w), bf_hi(a.w) + bf_hi(b.w) + bf_hi(d.w));
                *(uint4*)(Y + (size_t)row * D + col) = o;
            }
        asm volatile("s_waitcnt vmcnt(0)" ::: "memory");
        __syncthreads();
    }
    SchedWout S{(int)gridDim.x, c, (const char*)(P.ws + WS_Y), (const char*)(P.ws + WS_WOUT), last};
    EpiDelta E{(bf16_t*)(P.ws + (dry ? WS_END : WS_BR)), (const float*)(P.ws + WS_MODS), l};
    pg8::gemm_phase(lds, pg8::Gemm{D, D, D}, S, E);
    if (!dry) { if (last) wconv_range(P, lds, l, CONV_T_DENSE, CONV_T_ALL, c, (int)gridDim.x); else if (c >= 32) wconv_range(P, lds, l, CONV_T_DENSE, CONV_T_ALL, c - 32, (int)gridDim.x - 32); }
}
__device__ __forceinline__ void ph_norm2_route(const Params& P, LAS unsigned char* lds, int l, bool dry = false) {
    const int tid = tid_(), lane = tid & 63, wid = tid >> 6;
    LAS float* Wt = (LAS float*)lds;
    LAS int* lcnt = (LAS int*)(lds + 81920); LAS int* lbase = lcnt + 16; LAS int* rinfo = lbase + 16;
    LAS float* rw = (LAS float*)(rinfo + 128 * 4);
    { const f32x4* rt4 = (const f32x4*)((const float*)(P.ws + WS_RT) + (size_t)l * 20480);
      for (int i = tid; i < 5 * 1024; i += NTHR) *(LAS f32x4*)(Wt + i * 4) = rt4[i]; }
    if (tid < 16) lcnt[tid] = 0;
    __syncthreads();
    const float* xres = (const float*)(P.ws + WS_X);
    const bf16_t* dx = (const bf16_t*)(P.ws + WS_BR);
    bf16_t* f = (bf16_t*)(P.ws + (dry ? WS_END : WS_H));
    const float* g = P.in[I_GFFN] + l * 1024;
    int* cnt = (int*)(P.ws + (dry ? 32768 : WS_CNT)) + l * 16;
    int* sel_e = (int*)(P.ws + (dry ? WS_END + 40000000 : WS_SELE)); float* sel_w = (float*)(P.ws + (dry ? WS_END + 41000000 : WS_SELW)); int* sel_p = (int*)(P.ws + (dry ? WS_END + 42000000 : WS_SELP));
    const int NR = (l == DEPTH - 1) ? NLAT : NTOK;
    const int r0 = bid_() * 8, rstep = gridDim.x * 8;
    int it = 0;
    for (int r = r0 + wid; r < NR; r += rstep, ++it) {
        const float* mod = (const float*)(P.ws + WS_MODS) + ((size_t)l * 9 + row_modrow(r)) * 6144;
        float4 x[4], o[4];
#pragma unroll
        for (int i = 0; i < 4; ++i) { x[i] = *(const float4*)(xres + (size_t)r * D + lane * 4 + 256 * i);
            const uint2 dv = *(const uint2*)(dx + (size_t)r * D + lane * 4 + 256 * i);
            x[i].x += bf_lo(dv.x); x[i].y += bf_hi(dv.x); x[i].z += bf_lo(dv.y); x[i].w += bf_hi(dv.y); }
        norm_row(x, g, mod + 3 * 1024, mod + 4 * 1024, lane, o);
#pragma unroll
        for (int i = 0; i < 4; ++i) { uint2 u; u.x = pk_bf16(o[i].x, o[i].y); u.y = pk_bf16(o[i].z, o[i].w); *(uint2*)(f + (size_t)r * D + lane * 4 + 256 * i) = u; }
        float lg[20];
#pragma unroll
        for (int j = 0; j < 20; ++j) {
            float s = 0.f;
#pragma unroll
            for (int i = 0; i < 4; ++i) { const f32x4 w = *(const LAS f32x4*)(Wt + j * 1024 + lane * 4 + 256 * i); s += o[i].x * w[0] + o[i].y * w[1] + o[i].z * w[2] + o[i].w * w[3]; }
            lg[j] = wave_sum(s);
        }
        if (lane == 0) {
            float gl[4]; int gi = 0;
#pragma unroll
            for (int j = 0; j < 4; ++j) gl[j] = lg[j] + P.in[I_BGR][l * 4 + j];
            float gm = gl[0];
#pragma unroll
            for (int j = 1; j < 4; ++j) if (gl[j] > gm) { gm = gl[j]; gi = j; }
            float se = 0.f;
#pragma unroll
            for (int j = 0; j < 4; ++j) se += __expf(gl[j] - gm);
            const float pg = __builtin_amdgcn_rcpf(se);
            float el[4];
#pragma unroll
            for (int j = 0; j < 4; ++j) {
                float v = 0.f;
#pragma unroll
                for (int q = 0; q < 4; ++q) v = (gi == q) ? lg[4 + q * 4 + j] : v;
                el[j] = v + P.in[I_BER][l * 16 + gi * 4 + j];
            }
            int i0 = 0; float v0 = el[0];
#pragma unroll
            for (int j = 1; j < 4; ++j) if (el[j] > v0) { v0 = el[j]; i0 = j; }
            int i1 = -1; float v1 = -INFINITY;
#pragma unroll
            for (int j = 0; j < 4; ++j) if (j != i0 && el[j] > v1) { v1 = el[j]; i1 = j; }
            const float w0 = __builtin_amdgcn_rcpf(1.0f + __expf(v1 - v0)), w1 = 1.0f - w0;
            const int e0 = gi * 4 + i0, e1 = gi * 4 + i1;
            const int slot = it * 8 + wid;
            rinfo[slot * 4 + 0] = e0 | (e1 << 8);
            rinfo[slot * 4 + 1] = __hip_atomic_fetch_add(&lcnt[e0], 1, __ATOMIC_RELAXED, __HIP_MEMORY_SCOPE_WORKGROUP);
            rinfo[slot * 4 + 2] = __hip_atomic_fetch_add(&lcnt[e1], 1, __ATOMIC_RELAXED, __HIP_MEMORY_SCOPE_WORKGROUP);
            rw[slot * 2] = w0 * pg; rw[slot * 2 + 1] = w1 * pg;
        }
    }
    __syncthreads();
    if (tid < 16) lbase[tid] = atomicAdd(&cnt[tid], lcnt[tid]);
    __syncthreads();
    for (int slot = tid; slot < 128; slot += NTHR) {
        const int r = r0 + (slot & 7) + (slot >> 3) * rstep;
        if (r < NR) { const int ee = rinfo[slot * 4], e0 = ee & 255, e1 = ee >> 8;
            sel_e[r * 2] = e0; sel_e[r * 2 + 1] = e1;
            sel_w[r * 2] = rw[slot * 2]; sel_w[r * 2 + 1] = rw[slot * 2 + 1];
            sel_p[r * 2] = lbase[e0] + rinfo[slot * 4 + 1]; sel_p[r * 2 + 1] = lbase[e1] + rinfo[slot * 4 + 2]; }
    }
    __syncthreads();
}
__device__ __forceinline__ void moe_offsets(const int* cnt, int (&off)[17]) {
    int a = 0;
#pragma unroll
    for (int e = 0; e < 16; ++e) { off[e] = a; a += (cnt[e] + 255) & ~255; }
    off[16] = a;
}
__device__ __forceinline__ void ph_scatter(const Params& P, int l) {
    const int tid = tid_(), lane = tid & 63, wid = tid >> 6;
    const int* cnt = (const int*)(P.ws + WS_CNT) + l * 16;
    int off[17]; moe_offsets(cnt, off);
    const bf16_t* f = (const bf16_t*)(P.ws + WS_H); bf16_t* Fs = (bf16_t*)(P.ws + WS_FS);
    const int* sel_e = (const int*)(P.ws + WS_SELE); const int* sel_p = (const int*)(P.ws + WS_SELP); int* srow = (int*)(P.ws + WS_SROW);
    for (int r = bid_() * 8 + wid; r < ((l == DEPTH - 1) ? NLAT : NTOK); r += gridDim.x * 8) {
        const uint4 a = *(const uint4*)(f + (size_t)r * D + lane * 8), b = *(const uint4*)(f + (size_t)r * D + 512 + lane * 8);
#pragma unroll
        for (int k = 0; k < 2; ++k) {
            const int e = sel_e[r * 2 + k];
            int o = 0;
#pragma unroll
            for (int q = 0; q < 16; ++q) o = (e == q) ? off[q] : o;
            const int d = o + sel_p[r * 2 + k];
            *(uint4*)(Fs + (size_t)d * D + lane * 8) = a; *(uint4*)(Fs + (size_t)d * D + 512 + lane * 8) = b;
            if (lane == 0) srow[r * 2 + k] = d;
        }
    }
}
struct SchedMoe { int NM, G, c; int tfirst[16]; const char* A; const char* W; size_t tA, eW, tW;
    __device__ __forceinline__ bool next(int i, pg8::Unit& u) const {
        const int L = i * G + c; if (L >= NM * 4) return false;
        const int pm = L >> 2, pn = L & 3;
        int e = 0;
#pragma unroll
        for (int q = 1; q < 16; ++q) e += (pm >= tfirst[q]) ? 1 : 0;
        u.row0 = pm * 256; u.col0 = pn * 256; u.aux = e; u.A = A + (size_t)pm * tA; u.B = W + (size_t)e * eW + (size_t)pn * tW; return true; } };
struct FSwiglu { bf16_t* H;
    __device__ __forceinline__ void operator()(const pg8::Unit&, int row, int col, const f32x4& v0, const f32x4& v1) const {
        const int hc = ((col & ~31) >> 1) + (col & 15);
        uint2 a; a.x = pk_bf16(siluf_(v0[0]) * v1[0], siluf_(v0[1]) * v1[1]); a.y = pk_bf16(siluf_(v0[2]) * v1[2], siluf_(v0[3]) * v1[3]);
        *(uint2*)(H + (size_t)row * EH + hc) = a; } };
__device__ __forceinline__ void moe_sched(const Params& P, int l, SchedMoe& S) {
    const int* cnt = (const int*)(P.ws + WS_CNT) + l * 16;
    int a = 0;
#pragma unroll
    for (int e = 0; e < 16; ++e) { S.tfirst[e] = a; a += (cnt[e] + 255) >> 8; }
    S.NM = a; S.G = (int)gridDim.x; S.c = bid_();
}
__device__ __forceinline__ void ph_moe1(const Params& P, LAS unsigned char* lds, int l) {
    SchedMoe S; moe_sched(P, l, S);
    S.A = (const char*)(P.ws + WS_FS); S.W = (const char*)(P.ws + WS_WGU); S.tA = (size_t)256 * D * 2; S.eW = (size_t)1024 * 1024 * 2; S.tW = (size_t)256 * 1024 * 2;
    pg8::EpiPair<FSwiglu> E{{(bf16_t*)(P.ws + WS_HS)}};
    pg8::gemm_phase(lds, pg8::Gemm{1024, 1024, 1024}, S, E);
}
__device__ __forceinline__ void ph_moe2(const Params& P, LAS unsigned char* lds, int l) {
    SchedMoe S; moe_sched(P, l, S);
    S.A = (const char*)(P.ws + WS_HS); S.W = (const char*)(P.ws + WS_WDN); S.tA = (size_t)256 * EH * 2; S.eW = (size_t)1024 * 512 * 2; S.tW = (size_t)256 * 512 * 2;
    EpiStore16 E{(bf16_t*)(P.ws + WS_YS), D};
    pg8::gemm_phase(lds, pg8::Gemm{512, 512, 512}, S, E);
}
__device__ __forceinline__ void ph_combine(const Params& P, int l, bool dry = false) {
    const int tid = tid_(), lane = tid & 63, wid = tid >> 6;
    float* xres = (float*)(P.ws + WS_X);
    const bf16_t* Ys = (const bf16_t*)(P.ws + WS_YS);
    const float* sel_w = (const float*)(P.ws + WS_SELW); const int* srow = (const int*)(P.ws + WS_SROW);
    bf16_t* h = (bf16_t*)(P.ws + (dry ? WS_END : WS_H));
    const bf16_t* dxb = (const bf16_t*)(P.ws + WS_BR);
    for (int r = bid_() * 8 + wid; r < ((l == DEPTH - 1) ? NLAT : NTOK); r += gridDim.x * 8) {
        const float* gate = (const float*)(P.ws + WS_MODS) + ((size_t)l * 9 + row_modrow(r)) * 6144 + 5 * 1024;
        const float w0 = sel_w[r * 2], w1 = sel_w[r * 2 + 1];
        const bf16_t* y0 = Ys + (size_t)srow[r * 2] * D; const bf16_t* y1 = Ys + (size_t)srow[r * 2 + 1] * D;
        float4 x[4];
#pragma unroll
        for (int i = 0; i < 4; ++i) {
            const int c = lane * 4 + 256 * i;
            x[i] = *(const float4*)(xres + (size_t)r * D + c);
            { const uint2 dv = *(const uint2*)(dxb + (size_t)r * D + c); x[i].x += bf_lo(dv.x); x[i].y += bf_hi(dv.x); x[i].z += bf_lo(dv.y); x[i].w += bf_hi(dv.y); }
            const uint2 a = *(const uint2*)(y0 + c), b = *(const uint2*)(y1 + c);
            const float4 gv = *(const float4*)(gate + c);
            x[i].x += gv.x * (w0 * bf_lo(a.x) + w1 * bf_lo(b.x)); x[i].y += gv.y * (w0 * bf_hi(a.x) + w1 * bf_hi(b.x));
            x[i].z += gv.z * (w0 * bf_lo(a.y) + w1 * bf_lo(b.y)); x[i].w += gv.w * (w0 * bf_hi(a.y) + w1 * bf_hi(b.y));
        }
        if (l < DEPTH - 1) {
#pragma unroll
            for (int i = 0; i < 4; ++i) *(float4*)((dry ? (float*)(P.ws + WS_END) + (size_t)NTOK * 512 : xres) + (size_t)r * D + lane * 4 + 256 * i) = x[i];
            const float* mod = (const float*)(P.ws + WS_MODS) + ((size_t)(l + 1) * 9 + row_modrow(r)) * 6144;
            float4 o[4];
            norm_row(x, P.in[I_GMIX] + (l + 1) * 1024, mod, mod + 1024, lane, o);
#pragma unroll
            for (int i = 0; i < 4; ++i) { uint2 u; u.x = pk_bf16(o[i].x, o[i].y); u.y = pk_bf16(o[i].z, o[i].w); *(uint2*)(h + (size_t)r * D + lane * 4 + 256 * i) = u; }
        } else if (r < NLAT) {
            float ss = 0.f;
#pragma unroll
            for (int i = 0; i < 4; ++i) ss += x[i].x * x[i].x + x[i].y * x[i].y + x[i].z * x[i].z + x[i].w * x[i].w;
            ss = wave_sum(ss);
            const float rstd = __builtin_amdgcn_rsqf(ss * (1.0f / 1024.0f) + 1e-6f);
#pragma unroll
            for (int i = 0; i < 4; ++i) {
                const int c = lane * 4 + 256 * i;
                const float4 gv = *(const float4*)(P.in[I_GFIN] + c);
                float4 o; o.x = x[i].x * rstd * gv.x; o.y = x[i].y * rstd * gv.y; o.z = x[i].z * rstd * gv.z; o.w = x[i].w * rstd * gv.w;
                *(float4*)((dry ? (float*)(P.ws + WS_END) : P.out) + (size_t)r * D + c) = o;
            }
        }
    }
}

constexpr int NPH_LAYER = 12, NPH = 1 + DEPTH * NPH_LAYER;
#define CAS __attribute__((address_space(4)))
__device__ __forceinline__ const Params& kparams() { const CAS Params* k = (const CAS Params*)__builtin_amdgcn_kernarg_segment_ptr(); asm volatile("" : "+s"(k)); return *(const Params*)k; }
__global__ void __launch_bounds__(NTHR, 2) fwd(Params P_) {
    extern __shared__ __attribute__((aligned(16))) unsigned char lds_raw[];
    LAS unsigned char* lds = (LAS unsigned char*)lds_raw;
    volatile LAS unsigned* xbw = (volatile LAS unsigned*)(lds + LDS_BYTES - 16);
    if (threadIdx.x == 0) { xbw[0] = 0u; xbw[1] = 0u; xbw[2] = 0u; xbw[3] = 0u; }
    __syncthreads();
    const int lo = P_.ph_lo, hi = P_.ph_hi;
    XcdBarrier bar; bar.bar = (unsigned*)(P_.ws + WS_BAR); bar.x = 0; bar.st = xbw;
    if (hi - lo > 1) bar = xcd_barrier_post((unsigned*)(P_.ws + WS_BAR), xbw);
#ifndef PHMASK
#define PHMASK 0xFFFF
#endif
#define EN(j) ((PHMASK >> (j)) & 1)
#define IN(k) (lo <= (k) && (k) < hi)
#define SEAM(k) do { if (IN(k) && IN((k) + 1)) xcd_barrier(bar); } while (0)
    if (EN(12) && IN(0)) for (int rep = 0; rep < NREP(12); ++rep) { ph_prologue(kparams(), lds); }
    SEAM(0);
    for (int l = 0; l < DEPTH; ++l) {
        const int p0 = 1 + l * NPH_LAYER;
        if (l == 0) { if (EN(0) && IN(p0 + 0)) for (int rep = 0; rep < NREP(0); ++rep) { ph_wconv(kparams(), lds, l); ph_norm1(kparams(), l); }
        SEAM(p0 + 0); }
        if (EN(1) && IN(p0 + 1)) for (int rep = 0; rep < NREP(1); ++rep) ph_g1(kparams(), lds);
        SEAM(p0 + 1);
        if (EN(2) && IN(p0 + 2)) for (int rep = 0; rep < NREP(2); ++rep) { ph_prep(kparams(), l); ph_navt(kparams(), lds); }
        SEAM(p0 + 2);
        if (EN(3) && IN(p0 + 3)) { ph_mix(kparams(), lds, (char*)lds_raw, l);
            if (REPEAT_MASK & 0x8) { xcd_barrier(bar); ph_mix(kparams(), lds, (char*)lds_raw, l, 1, 0); }
            if (REPEAT_MASK & 0x2000) { xcd_barrier(bar); ph_mix(kparams(), lds, (char*)lds_raw, l, 1, 1); }
            if (REPEAT_MASK & 0x4000) { xcd_barrier(bar); ph_mix(kparams(), lds, (char*)lds_raw, l, 1, 2); }
            if (REPEAT_MASK & 0x8000) { xcd_barrier(bar); ph_mix(kparams(), lds, (char*)lds_raw, l, 1, 3); } }
        SEAM(p0 + 3);
        if (EN(4) && IN(p0 + 4)) for (int rep = 0; rep < NREP(4); ++rep) {
#if defined(DIAG) && DIAG == 5
            { const Params& Pq = kparams(); const int G_ = gridDim.x, c_ = bid_(), vcu_ = (c_ % 8) * (G_ / 8) + c_ / 8; for (int u = vcu_; u < 320; u += G_) na_unit(Pq, lds, l, u, (bf16_t*)(Pq.ws + WS_BR), BRW); __syncthreads(); }
#endif
            ph_readout(kparams(), l);
#if defined(DIAG) && (DIAG == 1 || DIAG == 4)
            ph_diag_cmp(kparams());
#endif
#if defined(DIAG) && DIAG == 3
            { const Params& Pq = kparams(); const uint4* d1 = (const uint4*)(Pq.ws + WS_END); bf16_t* brq = (bf16_t*)(Pq.ws + WS_BR);
              for (size_t i = (size_t)bid_() * NTHR + tid_(); i < (size_t)NTOK * 64; i += (size_t)gridDim.x * NTHR) { const size_t r = i >> 6; const int c8 = (int)(i & 63) * 8; *(uint4*)(brq + r * BRW + c8) = d1[i]; } }
#endif
        }
        SEAM(p0 + 4);
        if (EN(5) && IN(p0 + 5)) for (int rep = 0; rep < NREP(5); ++rep) ph_merge(kparams(), lds, l);
        SEAM(p0 + 5);
        if (EN(6) && IN(p0 + 6)) for (int rep = 0; rep < NREP(6); ++rep) ph_wout(kparams(), lds, l, rep > 0);
        SEAM(p0 + 6);
        if (EN(7) && IN(p0 + 7)) for (int rep = 0; rep < NREP(7); ++rep) ph_norm2_route(kparams(), lds, l, rep > 0);
        SEAM(p0 + 7);
        if (EN(8) && IN(p0 + 8)) for (int rep = 0; rep < NREP(8); ++rep) ph_scatter(kparams(), l);
        SEAM(p0 + 8);
        if (EN(9) && IN(p0 + 9)) for (int rep = 0; rep < NREP(9); ++rep) ph_moe1(kparams(), lds, l);
        SEAM(p0 + 9);
        if (EN(10) && IN(p0 + 10)) for (int rep = 0; rep < NREP(10); ++rep) ph_moe2(kparams(), lds, l);
        SEAM(p0 + 10);
        if (EN(11) && IN(p0 + 11)) for (int rep = 0; rep < NREP(11); ++rep) { ph_combine(kparams(), l, rep > 0); if (l + 1 < DEPTH) wconv_range(kparams(), lds, l + 1, 16 * 124, CONV_T_DENSE, bid_(), gridDim.x); }
        if (l + 1 < DEPTH) { if (IN(p0 + 11) && IN(p0 + 13)) xcd_barrier(bar); }
    }
#if defined(DIAG) && (DIAG == 1 || DIAG == 4)
    xcd_barrier(bar); ph_diag_out(kparams());
#endif
#undef IN
#undef SEAM
}

#ifndef MK_PER_PHASE
#define MK_PER_PHASE 0
#endif
extern "C" void kernel_launch(void* const* d_in, const int* in_sizes, int n_in, void* d_out, int out_size, void* d_ws, size_t ws_size, hipStream_t stream) {
    static int grid = 0;
    if (grid == 0) {
        if (n_in != 24 || out_size != NLAT * D || ws_size < WS_END + (size_t)NTOK * 4096 + 4096) { fprintf(stderr, "kernel_launch: unexpected shapes (n_in %d out %d ws %zu need %zu)\n", n_in, out_size, ws_size, (size_t)WS_END); grid = -1; return; }
        int dev = 0, cus = 0, per_cu = 0;
        if (hipGetDevice(&dev) != hipSuccess || hipDeviceGetAttribute(&cus, hipDeviceAttributeMultiprocessorCount, dev) != hipSuccess) { grid = -1; return; }
        if (hipFuncSetAttribute((const void*)fwd, hipFuncAttributeMaxDynamicSharedMemorySize, LDS_BYTES) != hipSuccess) { fprintf(stderr, "kernel_launch: hipFuncSetAttribute failed\n"); grid = -1; return; }
        if (hipOccupancyMaxActiveBlocksPerMultiprocessor(&per_cu, (const void*)fwd, NTHR, LDS_BYTES) != hipSuccess || per_cu < 1) { fprintf(stderr, "kernel_launch: occupancy query says %d\n", per_cu); }
        (void)hipGetLastError();
        grid = cus;
    }
    if (grid < 0) return;
    (void)hipMemsetAsync(d_ws, 0, WS_ZERO_BYTES, stream);
    Params p{};
    for (int i = 0; i < 24; ++i) p.in[i] = (const float*)d_in[i];
    p.out = (float*)d_out; p.ws = (unsigned char*)d_ws;
#if MK_PER_PHASE
    for (int ph = 0; ph < NPH; ++ph) { p.ph_lo = ph; p.ph_hi = ph + 1; hipLaunchKernelGGL(fwd, dim3(grid), dim3(NTHR), LDS_BYTES, stream, p); }
#else
    p.ph_lo = 0; p.ph_hi = NPH; hipLaunchKernelGGL(fwd, dim3(grid), dim3(NTHR), LDS_BYTES, stream, p);
#endif
}
```

```cpp
#include <hip/hip_runtime.h>
#include <cstdio>
#include <cstdint>

#define LAS __attribute__((address_space(3)))
typedef unsigned short bf16_t;
typedef short bf16x8 __attribute__((ext_vector_type(8)));
typedef float f32x4 __attribute__((ext_vector_type(4)));
typedef unsigned u32x4 __attribute__((ext_vector_type(4)));

constexpr int D = 1024, NB = 8, SEQ = 2048, DEPTH = 4, CTXL = 256;
constexpr int NLAT = NB * SEQ, NCTX = NB * CTXL, NTOK = NLAT + NCTX;
constexpr int INC = 7936;
constexpr int ZP = 4864;
constexpr int C_NAQ = 0, C_NAK = 512, C_NAV = 1024, C_HQ = 1536, C_HFF = 2048, C_HFB = 2560, C_HI = 3072, C_HG = 3584,
              C_GQ = 4096, C_GK = 4608, C_GV = 4736, C_GATE = 4864;
constexpr int BRW = 1536;
constexpr int NEXP = 16, EH = 512;
constexpr int MPAD = 40960;
constexpr int NTHR = 512;
constexpr int LDS_BYTES = 147456;

constexpr size_t WS_BAR = 0;
constexpr size_t WS_CNT = 16384;
constexpr size_t WS_ZERO_BYTES = 65536;
constexpr size_t WS_MODS = 65536;
constexpr size_t WS_LB = WS_MODS + 884736;
constexpr size_t WS_ROPE = WS_LB + 16384;
constexpr size_t WS_SELE = WS_ROPE + 12288;
constexpr size_t WS_SELW = WS_SELE + 147456;
constexpr size_t WS_SELP = WS_SELW + 147456;
constexpr size_t WS_SROW = WS_SELP + 147456;
constexpr size_t WS_X = 2097152;
constexpr size_t WS_H = WS_X + (size_t)NTOK * D * 4;
constexpr size_t WS_Z = WS_H + (size_t)NTOK * D * 2;
constexpr size_t WS_GT = WS_Z + (size_t)NTOK * ZP * 2;
constexpr size_t WS_BR = WS_GT + (size_t)NTOK * 3072 * 2;
constexpr size_t WS_Y = WS_BR + (size_t)NTOK * BRW * 2;
constexpr size_t WS_QN = WS_Y + (size_t)NTOK * D * 2;
constexpr size_t WS_KN = WS_QN + (size_t)NTOK * 512 * 2;
constexpr size_t WS_VN = WS_KN + (size_t)NTOK * 128 * 2;
constexpr size_t WS_NAVT = WS_VN + (size_t)NTOK * 128 * 2;
constexpr size_t WS_WIN = WS_NAVT + (size_t)NTOK * 512 * 2;
constexpr size_t WS_WBR = WS_WIN + (size_t)INC * D * 2;
constexpr size_t WS_WOUT = WS_WBR + (size_t)3 * D * 512 * 2;
constexpr size_t WS_WGU = WS_WOUT + (size_t)D * D * 2;
constexpr size_t WS_WDN = WS_WGU + (size_t)NEXP * 1024 * 1024 * 2;
constexpr size_t WS_PG = WS_WDN + (size_t)NEXP * 1024 * 512 * 2;
constexpr size_t WS_END = WS_PG + (size_t)96 * 65536 * 2;
constexpr size_t WS_FS = WS_Z;
constexpr size_t WS_HS = WS_FS + (size_t)MPAD * 1024 * 2;
constexpr size_t WS_YS = WS_HS + (size_t)MPAD * 512 * 2;
static_assert(WS_YS + (size_t)MPAD * 1024 * 2 <= WS_BR, "moe alias");
constexpr size_t WS_RT = WS_SROW + 147456;
static_assert(WS_RT + 327680 <= WS_X, "ctl");

#define XB_TMO      128
#define XB_XCNT(j)  (256  + 64 * (j))
#define XB_XSUB(j)  (1280 + 64 * (j))
#define XB_XGEN(j)  (2304 + 64 * (j))
#define XB_TOP      3328
#define XB_TOPGEN   3392
#define XCD_BAR_WORDS 3456
#define XB_SPIN_CAP (1u << 22)
__device__ __forceinline__ unsigned xb_ld(unsigned* p)              { return __hip_atomic_load(p, __ATOMIC_RELAXED, __HIP_MEMORY_SCOPE_AGENT); }
__device__ __forceinline__ unsigned xb_add(unsigned* p, unsigned v) { return __hip_atomic_fetch_add(p, v, __ATOMIC_RELAXED, __HIP_MEMORY_SCOPE_AGENT); }
__device__ __forceinline__ unsigned xb_xcc_id() { return (unsigned)__builtin_amdgcn_s_getreg((3 << 11) | 20) & 0xFu; }
#define XB_SPIN(cond, bar) do { unsigned _sp = 0; while (cond) { __builtin_amdgcn_s_sleep(1); \
    if ((++_sp & 255u) == 0u) { if (xb_ld(&(bar)[XB_TMO])) break; if (_sp > XB_SPIN_CAP) { atomicAdd(&(bar)[XB_TMO], 1u); break; } } } } while (0)
struct XcdBarrier { unsigned* bar; unsigned x; volatile LAS unsigned* st; };
__device__ __forceinline__ XcdBarrier xcd_barrier_post(unsigned* bar, volatile LAS unsigned* st) {
    XcdBarrier b; b.bar = bar; b.x = xb_xcc_id(); b.st = st;
    if (threadIdx.x == 0) (void)xb_add(&bar[XB_XCNT(b.x)], 1u);
    return b;
}
__device__ __forceinline__ void xcd_barrier_complete(unsigned* bar, unsigned x, unsigned& nloc, unsigned& nx) {
    const unsigned G = gridDim.x * gridDim.y * gridDim.z;
    unsigned sum, cnt, mine, sp = 0u;
    for (;;) {
        sum = 0u; cnt = 0u; mine = 0u;
#pragma unroll
        for (unsigned j = 0; j < 16; ++j) { const unsigned c = xb_ld(&bar[XB_XCNT(j)]); sum += c; cnt += (c > 0u) ? 1u : 0u; mine = (j == x) ? c : mine; }
        if (sum == G) break;
        __builtin_amdgcn_s_sleep(1);
        if ((++sp & 255u) == 0u) { if (xb_ld(&bar[XB_TMO])) break; if (sp > XB_SPIN_CAP) { atomicAdd(&bar[XB_TMO], 1u); break; } }
    }
    nloc = mine > 0u ? mine : 1u; nx = cnt > 0u ? cnt : 1u;
}
__device__ __forceinline__ void xcd_barrier(const XcdBarrier& b) {
    asm volatile("s_waitcnt vmcnt(0)" ::: "memory");
    __syncthreads();
    if (threadIdx.x == 0) {
        unsigned* bar = b.bar;
        __builtin_amdgcn_s_waitcnt(0);
        unsigned nloc = b.st[0], nx = b.st[1];
        if (nloc == 0u) { xcd_barrier_complete(bar, b.x, nloc, nx); b.st[0] = nloc; b.st[1] = nx; }
        const unsigned old = xb_add(&bar[XB_XSUB(b.x)], 1u);
        const unsigned gen = old / nloc;
        if (old + 1u == (gen + 1u) * nloc) {
            __builtin_amdgcn_fence(__ATOMIC_RELEASE, "agent");
            asm volatile("s_waitcnt vmcnt(0)" ::: "memory");
            const unsigned og = xb_add(&bar[XB_TOP], 1u);
            const unsigned tg = og / nx;
            if (og + 1u == (tg + 1u) * nx) xb_add(&bar[XB_TOPGEN], 1u);
            else XB_SPIN(xb_ld(&bar[XB_TOPGEN]) == tg, bar);
            __builtin_amdgcn_fence(__ATOMIC_ACQUIRE, "agent");
            xb_add(&bar[XB_XGEN(b.x)], 1u);
            asm volatile("s_waitcnt vmcnt(0)" ::: "memory");
        } else {
            XB_SPIN(xb_ld(&bar[XB_XGEN(b.x)]) == gen, bar);
            __builtin_amdgcn_fence(__ATOMIC_ACQUIRE, "agent");
            asm volatile("s_waitcnt vmcnt(0)" ::: "memory");
        }
    }
    __syncthreads();
}

__device__ __forceinline__ float bf_lo(unsigned u) { return __uint_as_float(u << 16); }
__device__ __forceinline__ float bf_hi(unsigned u) { return __uint_as_float(u & 0xffff0000u); }
__device__ __forceinline__ float bf2f(bf16_t b) { return __uint_as_float(((unsigned)b) << 16); }
typedef float pkf32x2_t __attribute__((ext_vector_type(2))); typedef __bf16 pkbf16x2_t __attribute__((ext_vector_type(2)));
__device__ __forceinline__ unsigned pk_bf16(float lo, float hi) { pkf32x2_t v = {lo, hi}; pkbf16x2_t b = __builtin_convertvector(v, pkbf16x2_t); return __builtin_bit_cast(unsigned, b); }
__device__ __forceinline__ bf16x8 pack8(const float (&v)[8]) { u32x4 u = {pk_bf16(v[0], v[1]), pk_bf16(v[2], v[3]), pk_bf16(v[4], v[5]), pk_bf16(v[6], v[7])}; return __builtin_bit_cast(bf16x8, u); }
__device__ __forceinline__ float sigmoidf_(float x) { return __builtin_amdgcn_rcpf(1.0f + __expf(-x)); }
__device__ __forceinline__ float siluf_(float x) { return x * __builtin_amdgcn_rcpf(1.0f + __expf(-x)); }
__device__ __forceinline__ float dpp_f(float v, const int ctrl_sel) {
    const int x = __float_as_int(v);
    int r;
    if (ctrl_sel == 0) r = __builtin_amdgcn_update_dpp(0, x, 0xB1, 0xF, 0xF, true);
    else if (ctrl_sel == 1) r = __builtin_amdgcn_update_dpp(0, x, 0x4E, 0xF, 0xF, true);
    else if (ctrl_sel == 2) r = __builtin_amdgcn_update_dpp(0, x, 0x141, 0xF, 0xF, true);
    else r = __builtin_amdgcn_update_dpp(0, x, 0x140, 0xF, 0xF, true);
    return __int_as_float(r);
}
__device__ __forceinline__ float wave_sum(float v) {
    v += dpp_f(v, 0); v += dpp_f(v, 1); v += dpp_f(v, 2); v += dpp_f(v, 3);
    { auto rr = __builtin_amdgcn_permlane16_swap(__float_as_uint(v), __float_as_uint(v), false, false); v = __uint_as_float(rr[0]) + __uint_as_float(rr[1]); }
    { auto rr = __builtin_amdgcn_permlane32_swap(__float_as_uint(v), __float_as_uint(v), false, false); v = __uint_as_float(rr[0]) + __uint_as_float(rr[1]); }
    return v;
}

__device__ __forceinline__ int tid_() { int t = threadIdx.x; asm volatile("" : "+v"(t)); return t; }
__device__ __forceinline__ int bid_() { int t = blockIdx.x; asm volatile("" : "+s"(t)); return t; }
#ifndef REPEAT_MASK
#define REPEAT_MASK 0
#endif
#define NREP(j) (((REPEAT_MASK >> (j)) & 1) ? 2 : 1)
struct Params {
    const float* in[24];
    float* out;
    unsigned char* ws;
    int ph_lo, ph_hi;
};
enum { I_X = 0, I_C, I_CTX, I_CCTX, I_WADA, I_BADA, I_GMIX, I_GFFN, I_WIN, I_RPB, I_LBL, I_HGN, I_QNG, I_KNG, I_WBR, I_WOUT,
       I_WGR, I_BGR, I_WER, I_BER, I_WEG, I_WEU, I_WED, I_GFIN };

__device__ __forceinline__ void g128_kloop(f32x4 (&acc)[4][4], LAS unsigned char* lds, const bf16_t* A, int lda, const bf16_t* Bt, int ldb, int K) {
    const int tid = tid_(), wid = tid >> 6, lane = tid & 63, wr = wid >> 2, wc = wid & 3, fr = lane & 15, fq = lane >> 4;
    LAS unsigned char* SA = lds; LAS unsigned char* SB = lds + 8192;
    const int srow = tid >> 2, skc = (tid & 3) * 8;
    const bf16_t* ap = A + (size_t)srow * lda + skc;
    const bf16_t* bp0 = Bt + (size_t)srow * ldb + skc;
    const bf16_t* bp1 = Bt + (size_t)(srow + 128) * ldb + skc;
    for (int k0 = 0; k0 < K; k0 += 32) {
        const uint4 va = *(const uint4*)(ap + k0);
        const uint4 vb0 = *(const uint4*)(bp0 + k0);
        const uint4 vb1 = *(const uint4*)(bp1 + k0);
        __syncthreads();
        *(LAS u32x4*)(SA + tid * 16) = (u32x4){va.x, va.y, va.z, va.w};
        *(LAS u32x4*)(SB + tid * 16) = (u32x4){vb0.x, vb0.y, vb0.z, vb0.w};
        *(LAS u32x4*)(SB + 8192 + tid * 16) = (u32x4){vb1.x, vb1.y, vb1.z, vb1.w};
        __syncthreads();
        bf16x8 At[4], Bf[4];
#pragma unroll
        for (int m = 0; m < 4; ++m) At[m] = *(const LAS bf16x8*)(SA + ((wr * 64 + m * 16 + fr) * 32 + fq * 8) * 2);
#pragma unroll
        for (int n = 0; n < 4; ++n) Bf[n] = *(const LAS bf16x8*)(SB + ((wc * 64 + n * 16 + fr) * 32 + fq * 8) * 2);
#pragma unroll
        for (int m = 0; m < 4; ++m)
#pragma unroll
            for (int n = 0; n < 4; ++n) acc[m][n] = __builtin_amdgcn_mfma_f32_16x16x32_bf16(Bf[n], At[m], acc[m][n], 0, 0, 0);
    }
}
__device__ __forceinline__ void acc_zero(f32x4 (&acc)[4][4]) {
#pragma unroll
    for (int m = 0; m < 4; ++m)
#pragma unroll
        for (int n = 0; n < 4; ++n) acc[m][n] = (f32x4){0.f, 0.f, 0.f, 0.f};
}
template <class Epi>
__device__ __forceinline__ void g128_epilogue(const f32x4 (&acc)[4][4], int row0, int col0, const Epi& E) {
    const int tid = tid_(), wid = tid >> 6, lane = tid & 63, wr = wid >> 2, wc = wid & 3, fr = lane & 15, fq = lane >> 4;
#pragma unroll
    for (int m = 0; m < 4; ++m)
#pragma unroll
        for (int n = 0; n < 4; n += 2) E(row0 + wr * 64 + m * 16 + fr, col0 + wc * 64 + n * 16 + fq * 4, acc[m][n], acc[m][n + 1]);
}


namespace pg8 {
constexpr int BM = 256, BK = 64, HALF = 128, HTB = HALF * BK * 2, STAGE_BYTES = 8 * HTB;
__device__ __forceinline__ int lds_byte(int r, int c) { const int st = (r >> 4) * 2 + (c >> 5), rr = r & 15, cc = c & 31, ob = rr * 64 + cc * 2; return st * 1024 + (ob ^ (((ob >> 9) & 1) << 5)); }
__device__ __forceinline__ void stage_rc(int b, int& R, int& C) { const int st = b / 1024, sb = b % 1024, swz = sb ^ (((sb >> 9) & 1) << 5); R = (st >> 1) * 16 + swz / 64; C = (st & 1) * 32 + (swz % 64) / 2; }
struct Unit { int row0, col0, aux; const char* A; const char* B; };
struct Gemm { int K, lda, ldb; };
template <class Epi, class Sched>
__device__ __forceinline__ void gemm_phase(LAS unsigned char* lds, const Gemm g, const Sched& S, const Epi& E) {
    const int tid = tid_(), wid = __builtin_amdgcn_readfirstlane(tid >> 6), lane = tid & 63, wr = wid >> 2, wc = wid & 3, fr = lane & 15, fq = lane >> 4;
    const int K = g.K, nt = K / BK;
    unsigned voffA[2], voffB[2];
#pragma unroll
    for (int i = 0; i < 2; ++i) { int R, C; stage_rc(tid * 16 + i * 8192, R, C);
        voffA[i] = (unsigned)(R * g.lda + C) * 2u; voffB[i] = (unsigned)(R * g.ldb + C) * 2u; }
    const size_t kstep = (size_t)(BK * 2);
    const size_t hstepA = (size_t)HALF * g.lda * 2, hstepB = (size_t)HALF * g.ldb * 2;
    const unsigned ldsw = (unsigned)wid * 1024u;
    const int aoff = lds_byte(wr * 64 + fr, fq * 8), boff = lds_byte(wc * 32 + fr, fq * 8);
#define PG8_SA(b, h) (((b) * 2 + (h)) * HTB)
#define PG8_SB(b, h) ((4 + (b) * 2 + (h)) * HTB)
#define PG8_STAGE(bufoff, gbase, voff) do { _Pragma("unroll") for (int _i = 0; _i < 2; ++_i) \
        __builtin_amdgcn_global_load_lds((const unsigned*)((const char*)(gbase) + (voff)[_i]), (LAS unsigned*)(lds + (bufoff) + ldsw + _i * 8192), 16, 0, 0); } while (0)
#define PG8_LDA(dst, b, h) do { _Pragma("unroll") for (int m = 0; m < 4; ++m) _Pragma("unroll") for (int k = 0; k < 2; ++k) dst[m][k] = *(const LAS bf16x8*)(lds + PG8_SA(b, h) + aoff + m * 2048 + k * 1024); } while (0)
#define PG8_LDB(dst, b, h) do { _Pragma("unroll") for (int n = 0; n < 2; ++n) _Pragma("unroll") for (int k = 0; k < 2; ++k) dst[n][k] = *(const LAS bf16x8*)(lds + PG8_SB(b, h) + boff + n * 2048 + k * 1024); } while (0)
#define PG8_MMA(ai, bj, At, Bt) do { __builtin_amdgcn_s_setprio(1); _Pragma("unroll") for (int m = 0; m < 4; ++m) _Pragma("unroll") for (int n = 0; n < 2; ++n) _Pragma("unroll") for (int k = 0; k < 2; ++k) \
        acc[ai][bj][m][n] = __builtin_amdgcn_mfma_f32_16x16x32_bf16(Bt[n][k], At[m][k], acc[ai][bj][m][n], 0, 0, 0); __builtin_amdgcn_s_setprio(0); } while (0)
#define PG8_WAIT_V(n) asm volatile("s_waitcnt vmcnt(" #n ")" ::: "memory")
#define PG8_WAIT_L(n) asm volatile("s_waitcnt lgkmcnt(" #n ")" ::: "memory")
#define PG8_BAR __builtin_amdgcn_s_barrier()
#define PG8_SCHED __builtin_amdgcn_sched_barrier(0)
    Unit cur, nxt; int ui = 0;
    if (!S.next(0, cur)) return;
    f32x4 acc[2][2][4][2];
#pragma unroll
    for (int a = 0; a < 2; ++a)
#pragma unroll
        for (int b = 0; b < 2; ++b)
#pragma unroll
            for (int m = 0; m < 4; ++m)
#pragma unroll
                for (int n = 0; n < 2; ++n) acc[a][b][m][n] = (f32x4){0.f, 0.f, 0.f, 0.f};
    bf16x8 At[4][2], B0[2][2], B1[2][2];
    const char* cA = cur.A; const char* cB = cur.B;
    PG8_STAGE(PG8_SB(0, 0), cB, voffB); PG8_STAGE(PG8_SB(0, 1), cB + hstepB, voffB); PG8_STAGE(PG8_SA(0, 0), cA, voffA); PG8_STAGE(PG8_SA(0, 1), cA + hstepA, voffA);
    if (wr == 1) PG8_BAR;
    PG8_WAIT_V(2); PG8_BAR;
    PG8_STAGE(PG8_SB(1, 0), cB + kstep, voffB); PG8_STAGE(PG8_SA(1, 0), cA + kstep, voffA); PG8_STAGE(PG8_SB(1, 1), cB + hstepB + kstep, voffB);
    PG8_WAIT_V(6); PG8_BAR;
    for (;;) {
        const bool has_next = S.next(ui + 1, nxt);
        const char* nA = has_next ? nxt.A : cA; const char* nB = has_next ? nxt.B : cB;
        for (int t = 0; t < nt; t += 2) {
            const bool last = (t == nt - 2);
            const char* a1 = cA + (size_t)(t + 1) * kstep;
            const char* a2 = last ? nA : cA + (size_t)(t + 2) * kstep; const char* b2 = last ? nB : cB + (size_t)(t + 2) * kstep;
            const char* a3 = a2 + kstep; const char* b3 = b2 + kstep;
            PG8_LDB(B0, 0, 0); PG8_LDB(B1, 0, 1); PG8_SCHED; PG8_LDA(At, 0, 0); PG8_STAGE(PG8_SA(1, 1), a1 + hstepA, voffA);
            PG8_WAIT_V(8); PG8_WAIT_L(0); PG8_BAR; PG8_MMA(0, 0, At, B0); PG8_MMA(0, 1, At, B1); PG8_BAR; PG8_SCHED;
            PG8_LDA(At, 0, 1); PG8_STAGE(PG8_SB(0, 0), b2, voffB); PG8_STAGE(PG8_SB(0, 1), b2 + hstepB, voffB); PG8_STAGE(PG8_SA(0, 0), a2, voffA);
            PG8_WAIT_V(8); PG8_WAIT_L(0); PG8_BAR; PG8_MMA(1, 0, At, B0); PG8_MMA(1, 1, At, B1); PG8_BAR; PG8_SCHED;
            PG8_LDB(B0, 1, 0); PG8_LDB(B1, 1, 1); PG8_SCHED; PG8_LDA(At, 1, 0); PG8_STAGE(PG8_SA(0, 1), a2 + hstepA, voffA);
            PG8_WAIT_V(8); PG8_WAIT_L(0); PG8_BAR; PG8_MMA(0, 0, At, B0); PG8_MMA(0, 1, At, B1); PG8_BAR; PG8_SCHED;
            PG8_LDA(At, 1, 1); PG8_STAGE(PG8_SB(1, 0), b3, voffB); PG8_STAGE(PG8_SB(1, 1), b3 + hstepB, voffB); PG8_STAGE(PG8_SA(1, 0), a3, voffA);
            PG8_WAIT_V(8); PG8_WAIT_L(0); PG8_BAR; PG8_MMA(1, 0, At, B0); PG8_MMA(1, 1, At, B1); PG8_BAR; PG8_SCHED;
        }
        if (wr == 0) PG8_BAR;
        E(acc, cur, wr, wc, fr, fq);
        if (!has_next) break;
#pragma unroll
        for (int a = 0; a < 2; ++a)
#pragma unroll
            for (int b = 0; b < 2; ++b)
#pragma unroll
                for (int m = 0; m < 4; ++m)
#pragma unroll
                    for (int n = 0; n < 2; ++n) acc[a][b][m][n] = (f32x4){0.f, 0.f, 0.f, 0.f};
        cur = nxt; cA = nA; cB = nB; ++ui;
        if (wr == 1) PG8_BAR;
    }
    PG8_WAIT_V(0);
    PG8_BAR;
#undef PG8_SA
#undef PG8_SB
#undef PG8_STAGE
#undef PG8_LDA
#undef PG8_LDB
#undef PG8_MMA
#undef PG8_WAIT_V
#undef PG8_WAIT_L
#undef PG8_BAR
#undef PG8_SCHED
}
template <class F> struct EpiPair { F f;
    __device__ __forceinline__ void operator()(const f32x4 (&acc)[2][2][4][2], const Unit& u, int wr, int wc, int fr, int fq) const {
#pragma unroll
        for (int ai = 0; ai < 2; ++ai)
#pragma unroll
            for (int m = 0; m < 4; ++m)
#pragma unroll
                for (int bj = 0; bj < 2; ++bj) f(u, u.row0 + ai * HALF + wr * 64 + m * 16 + fr, u.col0 + bj * HALF + wc * 32 + 4 * fq, acc[ai][bj][m][0], acc[ai][bj][m][1]);
    } };
struct SchedDense { int nM, nN, G, c; const char* A; const char* B; size_t tA, tB;
    __device__ __forceinline__ bool next(int i, Unit& u) const {
        const int nwg = nM * nN; const long L = (long)i * G + c; if (L >= nwg) return false;
        int wgid = (int)L; { const int q = nwg / 8, r = nwg % 8, xcd = wgid % 8, off = wgid / 8; wgid = (xcd < r ? xcd * (q + 1) : r * (q + 1) + (xcd - r) * q) + off; }
        const int nig = 8 * nN, gid = wgid / nig, fm = gid * 8, gsz = (nM - fm) < 8 ? (nM - fm) : 8;
        const int pm = fm + ((wgid % nig) % gsz), pn = (wgid % nig) / gsz;
        u.row0 = pm * 256; u.col0 = pn * 256; u.aux = 0; u.A = A + (size_t)pm * tA; u.B = B + (size_t)pn * tB; return true; } };
}


namespace gqa {
using f32x16 = __attribute__((ext_vector_type(16))) float;
using s16x4 = __attribute__((ext_vector_type(4))) short;
constexpr int QP = 512, KVP = 128, OP = BRW;
constexpr int NW = 8, QBLK = 32, KVBLK = 64;
__device__ __forceinline__ int crow(int r, int hi) { return (r & 3) + 8 * (r >> 2) + 4 * hi; }
#define SBAR() __builtin_amdgcn_sched_barrier(0)
constexpr int NSLOT = 3, SLOTB = 8192;
constexpr int LDS_K = 0, LDS_V = NSLOT * SLOTB, LDS_WS = 2 * NSLOT * SLOTB, LDS_OST = LDS_WS + NW * 64 * 4, LDS_BYTES_ = LDS_OST + NW * 4096;
__device__ __forceinline__ void glds16(const void* gsrc, unsigned lds_dst) { unsigned keep;
  asm volatile("s_mov_b32 %0, m0\n\ts_mov_b32 m0, %2\n\ts_nop 0\n\tglobal_load_lds_dwordx4 %1, off\n\ts_mov_b32 m0, %0" : "=&s"(keep) : "v"(gsrc), "s"(lds_dst) : "memory"); }
__device__ __forceinline__ float max3f(float a, float b, float c) { float r; asm("v_max3_f32 %0, %1, %2, %3" : "=v"(r) : "v"(a), "v"(b), "v"(c)); return r; }
__device__ __forceinline__ float max2f(float a, float b) { float r; asm("v_max_f32_e32 %0, %1, %2" : "=v"(r) : "v"(a), "v"(b)); return r; }
__device__ __forceinline__ float fadd_s(float a, float b) { float r; asm("v_add_f32_e32 %0, %1, %2" : "=v"(r) : "v"(a), "v"(b)); return r; }
__device__ __forceinline__ float fsub_s(float a, float b) { float r; asm("v_sub_f32_e32 %0, %1, %2" : "=v"(r) : "v"(a), "v"(b)); return r; }
typedef float f32x2_t __attribute__((ext_vector_type(2))); typedef __bf16 bf16x2_t __attribute__((ext_vector_type(2)));
__device__ __forceinline__ unsigned cvtpk_s(float lo, float hi) { f32x2_t v = {lo, hi}; bf16x2_t b = __builtin_convertvector(v, bf16x2_t); return __builtin_bit_cast(unsigned, b); }
#define WAIT_BAR(N) asm volatile("s_waitcnt vmcnt(" #N ") lgkmcnt(0)\n\ts_barrier" ::: "memory")
__device__ __forceinline__ void qkt(f32x16& p0, f32x16& p1, const char* Kslot, const bf16x8* qr, const f32x16& negm, int r32, int hi) {
  const char* kb = Kslot + hi * 1024 + r32 * 16;
  #pragma unroll
  for (int d0 = 0; d0 < 4; ++d0) {
    const bf16x8 b0 = *reinterpret_cast<const bf16x8*>(kb + d0 * 2048);
    const bf16x8 b1 = *reinterpret_cast<const bf16x8*>(kb + d0 * 2048 + 512);
    if (d0 == 0) { p0 = __builtin_amdgcn_mfma_f32_32x32x16_bf16(b0, qr[0], negm, 0, 0, 0); p1 = __builtin_amdgcn_mfma_f32_32x32x16_bf16(b1, qr[0], negm, 0, 0, 0); }
    else { p0 = __builtin_amdgcn_mfma_f32_32x32x16_bf16(b0, qr[d0], p0, 0, 0, 0); p1 = __builtin_amdgcn_mfma_f32_32x32x16_bf16(b1, qr[d0], p1, 0, 0, 0); } }
}
typedef __attribute__((address_space(3))) const char* lds_cptr;
typedef short v4i16_t __attribute__((ext_vector_type(4)));
__device__ __forceinline__ void kload8(bf16x8* kf, lds_cptr kp) {
  kf[0] = *(const LAS bf16x8*)(kp);        kf[1] = *(const LAS bf16x8*)(kp + 512);
  kf[2] = *(const LAS bf16x8*)(kp + 2048); kf[3] = *(const LAS bf16x8*)(kp + 2560);
  kf[4] = *(const LAS bf16x8*)(kp + 4096); kf[5] = *(const LAS bf16x8*)(kp + 4608);
  kf[6] = *(const LAS bf16x8*)(kp + 6144); kf[7] = *(const LAS bf16x8*)(kp + 6656);
}
__device__ __forceinline__ void kload2(bf16x8* kf, lds_cptr kp, int j) { kf[2 * j] = *(const LAS bf16x8*)(kp + j * 2048); kf[2 * j + 1] = *(const LAS bf16x8*)(kp + j * 2048 + 512); }
__device__ __forceinline__ s16x4 vtr(lds_cptr p) { return __builtin_bit_cast(s16x4, __builtin_amdgcn_ds_read_tr16_b64_v4i16((LAS v4i16_t*)p)); }
__device__ __forceinline__ float rowmax(const f32x16& p0, const f32x16& p1) {
  float a = max3f(p0[0], p0[1], p1[0]), b = max3f(p0[2], p0[3], p1[1]); a = max3f(a, p1[2], p1[3]);
  #pragma unroll
  for (int r = 4; r < 16; r += 4) { a = max3f(a, p0[r], p0[r + 1]); b = max3f(b, p0[r + 2], p0[r + 3]); a = max3f(a, p1[r], p1[r + 1]); b = max3f(b, p1[r + 2], p1[r + 3]); }
  const float m = max2f(a, b);
  auto rr = __builtin_amdgcn_permlane32_swap(__float_as_uint(m), __float_as_uint(m), false, false);
  return max2f(__uint_as_float(rr[0]), __uint_as_float(rr[1]));
}
__device__ __forceinline__ void pv(f32x16* o, int vb, bf16x8 pa0, bf16x8 pa1, bf16x8 pa2, bf16x8 pa3) {
  #pragma unroll
  for (int d0 = 0; d0 < 2; ++d0) { s16x4 lo[4], hi[4];
    #pragma unroll
    for (int ks = 0; ks < 4; ++ks) {
      asm volatile("ds_read_b64_tr_b16 %0,%1 offset:%c2" : "=&v"(lo[ks]) : "v"(vb), "i"(d0 * 4096 + ks * 1024) : "memory");
      asm volatile("ds_read_b64_tr_b16 %0,%1 offset:%c2" : "=&v"(hi[ks]) : "v"(vb), "i"(d0 * 4096 + ks * 1024 + 512) : "memory"); }
    asm volatile("s_waitcnt lgkmcnt(0)" ::: "memory"); SBAR();
    #define PK(k) (bf16x8){lo[k][0], lo[k][1], lo[k][2], lo[k][3], hi[k][0], hi[k][1], hi[k][2], hi[k][3]}
    o[d0] = __builtin_amdgcn_mfma_f32_32x32x16_bf16(pa0, PK(0), o[d0], 0, 0, 0);
    o[d0] = __builtin_amdgcn_mfma_f32_32x32x16_bf16(pa1, PK(1), o[d0], 0, 0, 0);
    o[d0] = __builtin_amdgcn_mfma_f32_32x32x16_bf16(pa2, PK(2), o[d0], 0, 0, 0);
    o[d0] = __builtin_amdgcn_mfma_f32_32x32x16_bf16(pa3, PK(3), o[d0], 0, 0, 0);
    #undef PK
  }
}
template <int THRL> __device__ __forceinline__ void attn_unit(const bf16_t* Qu, const float* qgain, const float* rope, const int tok0, const bf16_t* __restrict__ Kh, const bf16_t* __restrict__ Vh, bf16_t* Ou, const int NT, char* shm) {
  const int tid = tid_(), lane = tid & 63, r32 = lane & 31, hi = lane >> 5; const int wid = __builtin_amdgcn_readfirstlane(tid >> 6);
  const bf16_t* Qw = Qu + (long)wid * QBLK * ZP;
  const unsigned lds0 = (unsigned)(uintptr_t)shm;
  float* wsf = (float*)(shm + LDS_WS) + wid * 64;
  const bf16_t* ksrc = Kh + (long)lane * KVP + wid * 8;
  const bf16_t* vsrc = Vh + (long)(16 * (wid & 3) + (lane >> 2)) * KVP + (wid >> 2) * 32 + (lane & 3) * 8;
  const unsigned kdst = lds0 + LDS_K + wid * 1024, vdst = lds0 + LDS_V + wid * 1024;
  #define DMA_K(t, slot) glds16(ksrc + (long)(t) * KVBLK * KVP, (unsigned)__builtin_amdgcn_readfirstlane(kdst + (slot)))
  #define DMA_V(t, slot) glds16(vsrc + (long)(t) * KVBLK * KVP, (unsigned)__builtin_amdgcn_readfirstlane(vdst + (slot)))
  const int vb0 = (int)(lds0 + LDS_V) + ((lane >> 4) & 1) * 32 + (lane & 3) * 8 + (4 * hi + ((lane & 15) >> 2)) * 64;
  const char* Kbase = shm + LDS_K; bf16x8 kf[8];
  const lds_cptr shm3 = (lds_cptr)shm; const lds_cptr kp0 = shm3 + LDS_K + hi * 1024 + r32 * 16; const lds_cptr vp0 = shm3 + LDS_V + ((lane >> 4) & 1) * 32 + (lane & 3) * 8 + (4 * hi + ((lane & 15) >> 2)) * 64;
  DMA_K(0, 0); DMA_V(0, 0); DMA_K(1, SLOTB);
  bf16x8 qr[4];
  { float xq[4][8]; float ss = 0.f;
    #pragma unroll
    for (int d0 = 0; d0 < 4; ++d0) { const uint4 rw = *reinterpret_cast<const uint4*>(&Qw[(long)r32 * ZP + d0 * 16 + hi * 8]);
      xq[d0][0] = bf_lo(rw.x); xq[d0][1] = bf_hi(rw.x); xq[d0][2] = bf_lo(rw.y); xq[d0][3] = bf_hi(rw.y); xq[d0][4] = bf_lo(rw.z); xq[d0][5] = bf_hi(rw.z); xq[d0][6] = bf_lo(rw.w); xq[d0][7] = bf_hi(rw.w);
      #pragma unroll
      for (int j = 0; j < 8; ++j) ss += xq[d0][j] * xq[d0][j]; }
    { auto rr = __builtin_amdgcn_permlane32_swap(__float_as_uint(ss), __float_as_uint(ss), false, false); ss = __uint_as_float(rr[0]) + __uint_as_float(rr[1]); }
    const float rstd = __builtin_amdgcn_rsqf(ss * (1.0f / 64.0f) + 1e-6f) * (0.125f * 1.4426950408889634f);
    #pragma unroll
    for (int d0 = 0; d0 < 4; ++d0) { const f32x4 g0 = *(const f32x4*)(qgain + d0 * 16 + hi * 8), g1 = *(const f32x4*)(qgain + d0 * 16 + hi * 8 + 4);
      #pragma unroll
      for (int j = 0; j < 4; ++j) { xq[d0][j] *= rstd * g0[j]; xq[d0][4 + j] *= rstd * g1[j]; } }
    if (tok0 >= 0) { const int t = tok0 + wid * QBLK + r32, pr = t >> 6, pc = t & 63;
      #pragma unroll
      for (int hf = 0; hf < 2; ++hf) {
        const float* ct = rope + (hf ? (1024 + pc * 16) : (pr * 16)) + hi * 8; const float* st = ct + (hf ? 1024 : 512);
        const f32x4 c0 = *(const f32x4*)ct, c1 = *(const f32x4*)(ct + 4), s0 = *(const f32x4*)st, s1 = *(const f32x4*)(st + 4);
        #pragma unroll
        for (int j = 0; j < 8; ++j) { const float cs = j < 4 ? c0[j] : c1[j - 4], sn = j < 4 ? s0[j] : s1[j - 4];
          const float x1 = xq[2 * hf][j], x2 = xq[2 * hf + 1][j];
          xq[2 * hf][j] = x1 * cs - x2 * sn; xq[2 * hf + 1][j] = x2 * cs + x1 * sn; } } }
    #pragma unroll
    for (int d0 = 0; d0 < 4; ++d0) qr[d0] = pack8(xq[d0]); }
  float mhat = 0.f, l_reg = 0.f; f32x16 o[2]; o[0] = f32x16{}; o[1] = f32x16{}; f32x16 negm = f32x16{}; asm volatile("" : "+v"(negm));
  bool resc = false;
  #define START(P0, P1) do { const float rm = rowmax(P0, P1); resc = false; \
    { const float dl = rm; mhat = fadd_s(mhat, dl); \
      _Pragma("unroll") for (int r = 0; r < 16; ++r) { P0[r] = fsub_s(P0[r], dl); P1[r] = fsub_s(P1[r], dl); } \
      _Pragma("unroll") for (int r = 0; r < 16; ++r) negm[r] = -mhat; asm volatile("" : "+v"(negm)); } \
    _Pragma("unroll") for (int r = 0; r < 16; ++r) P0[r] = __builtin_amdgcn_exp2f(P0[r]); } while (0)
  #define RESC() do { if (resc) { asm volatile("s_waitcnt lgkmcnt(0)" ::: "memory"); \
      _Pragma("unroll") for (int d_ = 0; d_ < 2; ++d_) _Pragma("unroll") for (int r = 0; r < 16; ++r) o[d_][r] *= wsf[crow(r, hi)]; } } while (0)
  f32x16 pA0, pA1, pB0, pB1;
  int sl_prev = 0, sl_cur = 0, sl_next = SLOTB;
  #define ROT() do { sl_prev = sl_cur; sl_cur = sl_next; sl_next = (sl_next == (NSLOT - 1) * SLOTB) ? 0 : sl_next + SLOTB; } while (0)
  DMA_K(2, 2 * SLOTB);
  WAIT_BAR(3);
  qkt(pA0, pA1, Kbase, qr, negm, r32, hi); asm volatile("s_nop 15\n\ts_nop 7" : "+v"(pA0), "+v"(pA1));
  START(pA0, pA1);
  _Pragma("unroll") for (int r = 0; r < 16; ++r) pA1[r] = __builtin_amdgcn_exp2f(pA1[r]);
  WAIT_BAR(0);
  DMA_K(3, 0); DMA_V(1, SLOTB);
  ROT();
  kload8(kf, kp0 + sl_cur);
  WAIT_BAR(2);
  s16x4 vlo[8], vhi[8]; u32x4 pw0, pw1, pw2, pw3;
  #define PKW(P, B) cvtpk_s(P[B], P[B + 1])
  #define PAF(k) __builtin_bit_cast(bf16x8, pw##k)
  #define VFR(i) (bf16x8){vlo[i][0], vlo[i][1], vlo[i][2], vlo[i][3], vhi[i][0], vhi[i][1], vhi[i][2], vhi[i][3]}
  #define PIN(x) asm volatile("" : "+v"(x))
  #define MX3(a, b, c) __builtin_fmaxf(__builtin_fmaxf((a), (b)), (c))
  #define GAPA(MF, A0, A1, A2, A3, W0, W1, PW) do { MF; sacc += A0; sacc += A1; sacc += A2; sacc += A3; PIN(sacc); W0; W1; PIN(PW); SBAR(); } while (0)
  #define EX(v) __builtin_amdgcn_exp2f(v)
  #define GAPB(MF, X, B) do { MF; X[B] = EX(X[B]); X[B + 1] = EX(X[B + 1]); X[B + 2] = EX(X[B + 2]); X[B + 3] = EX(X[B + 3]); PIN(X); SBAR(); } while (0)
  #define VRD(i) do { vlo[i] = vtr(vp_ + (((i) >> 2) * 4096 + ((i) & 3) * 1024)); vhi[i] = vtr(vp_ + (((i) >> 2) * 4096 + ((i) & 3) * 1024 + 512)); } while (0)
  #define KRD(G, j) do { if (G) { kload2(kf, kp0 + sl_next, j); SBAR(); } } while (0)
  #define STEP(C0, C1, P0, P1, t, GK, GV, GL) do { SBAR(); \
    const lds_cptr vp_ = vp0 + sl_prev; \
    VRD(0); SBAR(); float sacc = (P0[0] + P0[1]); \
    GAPA(C0 = __builtin_amdgcn_mfma_f32_32x32x16_bf16(kf[0], qr[0], negm, 0, 0, 0), P0[2], P0[3], P0[4], P0[5],     pw0[0] = PKW(P0, 0), pw0[1] = PKW(P0, 2), pw0); \
    VRD(4); SBAR(); GAPA(C1 = __builtin_amdgcn_mfma_f32_32x32x16_bf16(kf[1], qr[0], negm, 0, 0, 0), P0[6], P0[7], P0[8], P0[9],     pw0[2] = PKW(P0, 4), pw0[3] = PKW(P0, 6), pw0); \
    VRD(1); SBAR(); GAPA(C0 = __builtin_amdgcn_mfma_f32_32x32x16_bf16(kf[2], qr[1], C0, 0, 0, 0),   P0[10], P0[11], P0[12], P0[13], pw1[0] = PKW(P0, 8), pw1[1] = PKW(P0, 10), pw1); \
    VRD(5); SBAR(); GAPA(C1 = __builtin_amdgcn_mfma_f32_32x32x16_bf16(kf[3], qr[1], C1, 0, 0, 0),   P0[14], P0[15], P1[0], P1[1],   pw1[2] = PKW(P0, 12), pw1[3] = PKW(P0, 14), pw1); \
    VRD(2); SBAR(); GAPA(C0 = __builtin_amdgcn_mfma_f32_32x32x16_bf16(kf[4], qr[2], C0, 0, 0, 0),   P1[2], P1[3], P1[4], P1[5],     pw2[0] = PKW(P1, 0), pw2[1] = PKW(P1, 2), pw2); \
    VRD(6); SBAR(); GAPA(C1 = __builtin_amdgcn_mfma_f32_32x32x16_bf16(kf[5], qr[2], C1, 0, 0, 0),   P1[6], P1[7], P1[8], P1[9],     pw2[2] = PKW(P1, 4), pw2[3] = PKW(P1, 6), pw2); \
    VRD(3); SBAR(); GAPA(C0 = __builtin_amdgcn_mfma_f32_32x32x16_bf16(kf[6], qr[3], C0, 0, 0, 0),   P1[10], P1[11], P1[12], P1[13], pw3[0] = PKW(P1, 8), pw3[1] = PKW(P1, 10), pw3); \
    VRD(7); SBAR(); GAPA(C1 = __builtin_amdgcn_mfma_f32_32x32x16_bf16(kf[7], qr[3], C1, 0, 0, 0),   P1[14], P1[15], 0.f, 0.f,       pw3[2] = PKW(P1, 12), pw3[3] = PKW(P1, 14), pw3); \
    l_reg += sacc; \
    if (GK) { DMA_K((t) + 3, sl_cur); } if (GV) { DMA_V((t) + 1, sl_next); } \
    { float a = MX3(C0[0], C0[1], C1[0]), b = MX3(C0[2], C0[3], C1[1]); a = MX3(a, C1[2], C1[3]); \
      _Pragma("unroll") for (int r = 4; r < 16; r += 4) { a = MX3(a, C0[r], C0[r + 1]); b = MX3(b, C0[r + 2], C0[r + 3]); a = MX3(a, C1[r], C1[r + 1]); b = MX3(b, C1[r + 2], C1[r + 3]); } \
      float rm = __builtin_fmaxf(a, b); { auto rr = __builtin_amdgcn_permlane32_swap(__float_as_uint(rm), __float_as_uint(rm), false, false); rm = __builtin_fmaxf(__uint_as_float(rr[0]), __uint_as_float(rr[1])); } \
      resc = false; \
      if (__builtin_expect(__any(rm > (float)THRL), 0)) { const float dl = __builtin_fmaxf(rm, 0.f); mhat += dl; \
        _Pragma("unroll") for (int r = 0; r < 16; ++r) { C0[r] -= dl; C1[r] -= dl; } \
        _Pragma("unroll") for (int r = 0; r < 16; ++r) negm[r] = -mhat; asm volatile("" : "+v"(negm)); \
        const float f = __builtin_amdgcn_exp2f(-dl); l_reg *= f; if (hi == 0) wsf[r32] = f; resc = true; } } \
    SBAR(); \
    GAPB(o[0] = __builtin_amdgcn_mfma_f32_32x32x16_bf16(PAF(0), VFR(0), o[0], 0, 0, 0), C0, 0); \
    GAPB(o[1] = __builtin_amdgcn_mfma_f32_32x32x16_bf16(PAF(0), VFR(4), o[1], 0, 0, 0), C0, 4); \
    KRD(GL, 0); GAPB(o[0] = __builtin_amdgcn_mfma_f32_32x32x16_bf16(PAF(1), VFR(1), o[0], 0, 0, 0), C0, 8); \
    KRD(GL, 1); GAPB(o[1] = __builtin_amdgcn_mfma_f32_32x32x16_bf16(PAF(1), VFR(5), o[1], 0, 0, 0), C0, 12); \
    KRD(GL, 2); GAPB(o[0] = __builtin_amdgcn_mfma_f32_32x32x16_bf16(PAF(2), VFR(2), o[0], 0, 0, 0), C1, 0); \
    KRD(GL, 3); GAPB(o[1] = __builtin_amdgcn_mfma_f32_32x32x16_bf16(PAF(2), VFR(6), o[1], 0, 0, 0), C1, 4); \
    GAPB(o[0] = __builtin_amdgcn_mfma_f32_32x32x16_bf16(PAF(3), VFR(3), o[0], 0, 0, 0), C1, 8); \
    GAPB(o[1] = __builtin_amdgcn_mfma_f32_32x32x16_bf16(PAF(3), VFR(7), o[1], 0, 0, 0), C1, 12); \
    } while (0)
  int t = 1;
  for (; t + 5 < NT; t += 2) {
    STEP(pB0, pB1, pA0, pA1, t, true, true, true);     WAIT_BAR(2); RESC(); ROT();
    STEP(pA0, pA1, pB0, pB1, t + 1, true, true, true); WAIT_BAR(2); RESC(); ROT();
  }
  #define ENDW(tt) do { if ((tt) + 3 < NT) { WAIT_BAR(2); } else if ((tt) + 2 < NT) { WAIT_BAR(1); } else { WAIT_BAR(0); } } while (0)
  for (; t + 1 < NT; t += 2) {
    STEP(pB0, pB1, pA0, pA1, t, (t + 3 < NT), (t + 1 < NT), (t + 1 < NT));         ENDW(t);     RESC(); ROT();
    STEP(pA0, pA1, pB0, pB1, t + 1, (t + 4 < NT), (t + 2 < NT), (t + 2 < NT));     ENDW(t + 1); RESC(); ROT();
  }
  STEP(pB0, pB1, pA0, pA1, NT - 1, false, false, false); RESC();
  { float sacc = pB0[0] + pB0[1]; _Pragma("unroll") for (int r = 2; r < 16; ++r) sacc += pB0[r]; _Pragma("unroll") for (int r = 0; r < 16; ++r) sacc += pB1[r]; l_reg += sacc;
    pw0 = (u32x4){PKW(pB0, 0), PKW(pB0, 2), PKW(pB0, 4), PKW(pB0, 6)}; pw1 = (u32x4){PKW(pB0, 8), PKW(pB0, 10), PKW(pB0, 12), PKW(pB0, 14)}; pw2 = (u32x4){PKW(pB1, 0), PKW(pB1, 2), PKW(pB1, 4), PKW(pB1, 6)}; pw3 = (u32x4){PKW(pB1, 8), PKW(pB1, 10), PKW(pB1, 12), PKW(pB1, 14)};
    SBAR(); pv(o, vb0 + sl_cur, PAF(0), PAF(1), PAF(2), PAF(3)); }
  #undef PKW
  #undef PAF
  #undef VFR
  #undef PIN
  #undef MX3
  #undef GAPA
  #undef GAPB
  #undef EX
  #undef VRD
  #undef KRD
  #undef STEP
  #undef ENDW
  { auto rr = __builtin_amdgcn_permlane32_swap(__float_as_uint(l_reg), __float_as_uint(l_reg), false, false); l_reg = __uint_as_float(rr[0]) + __uint_as_float(rr[1]); }
  if (hi == 0) wsf[32 + r32] = l_reg; asm volatile("s_waitcnt lgkmcnt(0)" ::: "memory");
  float rli[16];
  #pragma unroll
  for (int r = 0; r < 16; ++r) rli[r] = __builtin_amdgcn_rcpf(wsf[32 + crow(r, hi)]);
  bf16_t* Ow = Ou + (long)wid * QBLK * OP;
  { bf16_t* stg = (bf16_t*)(shm + LDS_OST) + wid * 2048;
    #pragma unroll
    for (int r = 0; r < 16; ++r) { const int orow = crow(r, hi);
      #pragma unroll
      for (int d0 = 0; d0 < 2; ++d0) stg[orow * 64 + d0 * 32 + r32] = (bf16_t)(cvtpk_s(o[d0][r] * rli[r], 0.f) & 0xffffu); }
    asm volatile("s_waitcnt lgkmcnt(0)" ::: "memory");
    #pragma unroll
    for (int i = 0; i < 4; ++i) { const int row = i * 8 + (lane >> 3), ch = lane & 7; const u32x4 v = *(const u32x4*)(stg + row * 64 + ch * 8); *(u32x4*)(Ow + (long)row * OP + ch * 8) = v; } }
  asm volatile("s_waitcnt lgkmcnt(0)\n\ts_barrier" ::: "memory");
  #undef DMA_K
  #undef DMA_V
  #undef START
  #undef RESC
  #undef ROT
}
#undef SBAR
#undef WAIT_BAR
}

__device__ __forceinline__ void ph_prologue(const Params& P, LAS unsigned char* lds) {
    const int tid = tid_(), bid = bid_(), G = gridDim.x, lane = tid & 63, wid = tid >> 6;
    float* mods = (float*)(P.ws + WS_MODS);
    LAS float* sc = (LAS float*)lds;
    LAS float* red = sc + 9 * 1024;
    for (int i = tid; i < 9 * 1024; i += NTHR) { const float v = (i < 8192) ? P.in[I_C][i] : P.in[I_CCTX][i - 8192]; sc[i] = siluf_(v); }
    __syncthreads();
    {
        const int c = lane & 31, slot = wid * 2 + (lane >> 5);
        for (int u = bid; u < 4 * 192; u += G) {
            const int l = u / 192, cg = u % 192;
            const float* w = P.in[I_WADA] + (size_t)l * 1024 * 6144 + cg * 32 + c;
            float a[9];
#pragma unroll
            for (int r = 0; r < 9; ++r) a[r] = 0.f;
#pragma unroll 8
            for (int i = 0; i < 64; ++i) { const int k = slot + 16 * i; const float wv = w[(size_t)k * 6144];
#pragma unroll
                for (int r = 0; r < 9; ++r) a[r] += sc[r * 1024 + k] * wv; }
#pragma unroll
            for (int r = 0; r < 9; ++r) red[(slot * 9 + r) * 32 + c] = a[r];
            __syncthreads();
            if (tid < 288) { const int r = tid >> 5, cc = tid & 31; float s_ = 0.f;
#pragma unroll
                for (int q = 0; q < 16; ++q) s_ += red[(q * 9 + r) * 32 + cc];
                mods[((size_t)l * 9 + r) * 6144 + cg * 32 + cc] = s_ + P.in[I_BADA][l * 6144 + cg * 32 + cc]; }
            __syncthreads();
        }
    }
    { float* rt = (float*)(P.ws + WS_RT);
      for (int i = bid * NTHR + tid; i < DEPTH * 20 * 1024; i += G * NTHR) { const int l = i / 20480, j = (i % 20480) >> 10, c = i & 1023;
          rt[i] = (j < 4) ? P.in[I_WGR][((size_t)l * 1024 + c) * 4 + j] : P.in[I_WER][((size_t)l * 1024 + c) * 16 + (j - 4)]; } }
    if (bid == G - 1) {
        float* lbv = (float*)(P.ws + WS_LB);
        for (int i = tid; i < 1024; i += NTHR) {
            float lg[DEPTH], mx = -1e30f;
#pragma unroll
            for (int l = 0; l < DEPTH; ++l) { lg[l] = P.in[I_LBL][l * 1024 + i]; mx = fmaxf(mx, lg[l]); }
            float s = 0.f;
#pragma unroll
            for (int l = 0; l < DEPTH; ++l) { lg[l] = expf(lg[l] - mx); s += lg[l]; }
            float cum = 0.f;
#pragma unroll
            for (int l = 0; l < DEPTH; ++l) { if (l > 0) cum += lg[l] / s; lbv[l * 1024 + i] = cum; }
        }
        float* rope = (float*)(P.ws + WS_ROPE);
        for (int i = tid; i < 96 * 16; i += NTHR) {
            const int pos = i >> 4, fi = i & 15;
            const float inv = powf(10000.0f, -(float)fi / 16.0f);
            const float p = (pos < 32) ? (float)pos : (float)(pos - 32);
            const float ang = p * inv;
            if (pos < 32) { rope[pos * 16 + fi] = cosf(ang); rope[512 + pos * 16 + fi] = sinf(ang); }
            else { rope[1024 + (pos - 32) * 16 + fi] = cosf(ang); rope[2048 + (pos - 32) * 16 + fi] = sinf(ang); }
        }
    }
    float4* xr = (float4*)(P.ws + WS_X);
    const float4* xs = (const float4*)P.in[I_X]; const float4* cs = (const float4*)P.in[I_CTX];
    const size_t nx4 = (size_t)NLAT * D / 4, nc4 = (size_t)NCTX * D / 4;
    for (size_t i = (size_t)bid * NTHR + tid; i < nx4 + nc4; i += (size_t)G * NTHR) xr[i] = (i < nx4) ? xs[i] : cs[i - nx4];
}

struct ConvJob { const float* srcA; const float* srcB; int ld; bool inter; bool perm; bf16_t* dst; int K, n0, k0; };
__device__ __forceinline__ int perm32(int rho) { const int n = rho >> 4, i = rho & 15; return 8 * (i >> 2) + 4 * n + (i & 3); }
__device__ __forceinline__ bool conv_job(const Params& P, int l, int u, ConvJob& J) {
    constexpr int T_IN = 16 * 124, T_BR = 3 * 8 * 16, T_OUT = 16 * 16, T_GU = 16 * 16 * 16, T_DN = 16 * 8 * 16;
    constexpr int TOT = T_IN + T_BR + T_OUT + T_GU + T_DN;
    if (u >= TOT) return false;
    int v = u;
    J.srcB = nullptr; J.inter = false; J.perm = false;
    if (v < T_IN) { const int kt = v % 16, nt = v / 16; J.perm = true; J.srcA = P.in[I_WIN] + (size_t)l * 1024 * INC; J.ld = INC; J.dst = (bf16_t*)(P.ws + WS_WIN); J.K = 1024; J.n0 = nt * 64; J.k0 = kt * 64; return true; }
    v -= T_IN;
    if (v < T_BR) { const int i = v / 128, w = v % 128, kt = w % 8, nt = w / 8; J.perm = true; J.srcA = P.in[I_WBR] + ((size_t)l * 3 + i) * 512 * 1024; J.ld = 1024; J.dst = (bf16_t*)(P.ws + WS_WBR) + (size_t)i * 1024 * 512; J.K = 512; J.n0 = nt * 64; J.k0 = kt * 64; return true; }
    v -= T_BR;
    if (v < T_OUT) { const int kt = v % 16, nt = v / 16; J.perm = true; J.srcA = P.in[I_WOUT] + (size_t)l * 1024 * 1024; J.ld = 1024; J.dst = (bf16_t*)(P.ws + WS_WOUT); J.K = 1024; J.n0 = nt * 64; J.k0 = kt * 64; return true; }
    v -= T_OUT;
    if (v < T_GU) { const int e = v / 256, w = v % 256, kt = w % 16, nt = w / 16; const size_t eo = ((size_t)l * NEXP + e) * 1024 * 512;
        J.srcA = P.in[I_WEG] + eo; J.srcB = P.in[I_WEU] + eo; J.inter = true; J.ld = 512; J.dst = (bf16_t*)(P.ws + WS_WGU) + (size_t)e * 1024 * 1024; J.K = 1024; J.n0 = nt * 64; J.k0 = kt * 64; return true; }
    v -= T_GU;
    { const int e = v / 128, w = v % 128, kt = w % 8, nt = w / 8; J.perm = true; J.srcA = P.in[I_WED] + ((size_t)l * NEXP + e) * 512 * 1024; J.ld = 1024; J.dst = (bf16_t*)(P.ws + WS_WDN) + (size_t)e * 1024 * 512; J.K = 512; J.n0 = nt * 64; J.k0 = kt * 64; return true; }
}
__device__ __forceinline__ void conv_load(const ConvJob& J, int tid, float (&v)[8]) {
    const int nn = tid & 63, kk = tid >> 6, n = J.n0 + nn;
    const float* cp;
    if (J.perm) cp = J.srcA + (n & ~31) + perm32(n & 31); else if (!J.inter) cp = J.srcA + n; else { const int g = n >> 5, i = n & 31; cp = (i < 16) ? (J.srcA + 16 * g + i) : (J.srcB + 16 * g + i - 16); }
#pragma unroll
    for (int p = 0; p < 8; ++p) v[p] = cp[(size_t)(J.k0 + kk + 8 * p) * J.ld];
}
__device__ __forceinline__ void wconv_range(const Params& P, LAS unsigned char* lds, int l, int t0, int t1, int widx, int nw) {
    LAS float* t = (LAS float*)lds;
    const int tid = tid_();
    int u = t0 + widx;
    ConvJob J; float v[8];
    bool have = (u < t1) && conv_job(P, l, u, J);
    if (have) conv_load(J, tid, v);
    while (have) {
        ConvJob Jn; float vn[8];
        const bool hn = (u + nw < t1) && conv_job(P, l, u + nw, Jn);
        if (hn) conv_load(Jn, tid, vn);
        { const int nn = tid & 63, kk = tid >> 6;
#pragma unroll
          for (int p = 0; p < 8; ++p) t[(kk + 8 * p) * 65 + nn] = v[p]; }
        __syncthreads();
        { const int n = tid >> 3, k8 = (tid & 7) * 8;
          float w[8];
#pragma unroll
          for (int j = 0; j < 8; ++j) w[j] = t[(k8 + j) * 65 + n];
          uint4 o; o.x = pk_bf16(w[0], w[1]); o.y = pk_bf16(w[2], w[3]); o.z = pk_bf16(w[4], w[5]); o.w = pk_bf16(w[6], w[7]);
          *(uint4*)(J.dst + (size_t)(J.n0 + n) * J.K + J.k0 + k8) = o; }
        __syncthreads();
        J = Jn; have = hn; u += nw;
#pragma unroll
        for (int p = 0; p < 8; ++p) v[p] = vn[p];
    }
}
constexpr int CONV_T_DENSE = 16 * 124 + 3 * 8 * 16 + 16 * 16;
constexpr int CONV_T_ALL = CONV_T_DENSE + 16 * 16 * 16 + 16 * 8 * 16;
__device__ __forceinline__ void ph_wconv(const Params& P, LAS unsigned char* lds, int l) { wconv_range(P, lds, l, 0, CONV_T_DENSE, bid_(), gridDim.x); }

__device__ __forceinline__ void norm_row(const float4 (&x)[4], const float* g, const float* shift, const float* scale, int lane, float4 (&o)[4]) {
    float ss = 0.f;
#pragma unroll
    for (int i = 0; i < 4; ++i) ss += x[i].x * x[i].x + x[i].y * x[i].y + x[i].z * x[i].z + x[i].w * x[i].w;
    ss = wave_sum(ss);
    const float rstd = __builtin_amdgcn_rsqf(ss * (1.0f / 1024.0f) + 1e-6f);
#pragma unroll
    for (int i = 0; i < 4; ++i) {
        const int c = lane * 4 + 256 * i;
        const float4 gv = *(const float4*)(g + c), sh = *(const float4*)(shift + c), sc = *(const float4*)(scale + c);
        o[i].x = x[i].x * rstd * gv.x * (1.0f + sc.x) + sh.x;
        o[i].y = x[i].y * rstd * gv.y * (1.0f + sc.y) + sh.y;
        o[i].z = x[i].z * rstd * gv.z * (1.0f + sc.z) + sh.z;
        o[i].w = x[i].w * rstd * gv.w * (1.0f + sc.w) + sh.w;
    }
}
__device__ __forceinline__ int row_modrow(int r) { return r < NLAT ? (r >> 11) : 8; }

__device__ __forceinline__ void ph_norm1(const Params& P, int l) {
    const int tid = tid_(), lane = tid & 63, wid = tid >> 6;
    const float* xres = (const float*)(P.ws + WS_X);
    bf16_t* h = (bf16_t*)(P.ws + WS_H);
    const float* g = P.in[I_GMIX] + l * 1024;
    for (int r = bid_() * 8 + wid; r < NTOK; r += gridDim.x * 8) {
        const float* mod = (const float*)(P.ws + WS_MODS) + ((size_t)l * 9 + row_modrow(r)) * 6144;
        float4 x[4], o[4];
#pragma unroll
        for (int i = 0; i < 4; ++i) x[i] = *(const float4*)(xres + (size_t)r * D + lane * 4 + 256 * i);
        norm_row(x, g, mod, mod + 1024, lane, o);
#pragma unroll
        for (int i = 0; i < 4; ++i) { uint2 u; u.x = pk_bf16(o[i].x, o[i].y); u.y = pk_bf16(o[i].z, o[i].w); *(uint2*)(h + (size_t)r * D + lane * 4 + 256 * i) = u; }
    }
}

struct EpiStoreBf16 { bf16_t* O; int ldc;
    __device__ __forceinline__ void operator()(int row, int col, const f32x4& v0, const f32x4& v1) const {
        uint2 a, b; a.x = pk_bf16(v0[0], v0[1]); a.y = pk_bf16(v0[2], v0[3]); b.x = pk_bf16(v1[0], v1[1]); b.y = pk_bf16(v1[2], v1[3]);
        *(uint2*)(O + (size_t)row * ldc + col) = a; *(uint2*)(O + (size_t)row * ldc + col + 16) = b; } };
struct EpiStore16 { bf16_t* O; int ldc;
    __device__ __forceinline__ void operator()(const f32x4 (&acc)[2][2][4][2], const pg8::Unit& u, int wr, int wc, int fr, int fq) const {
#pragma unroll
        for (int ai = 0; ai < 2; ++ai)
#pragma unroll
            for (int m = 0; m < 4; ++m)
#pragma unroll
                for (int bj = 0; bj < 2; ++bj) { const int row = u.row0 + ai * 128 + wr * 64 + m * 16 + fr, col = u.col0 + bj * 128 + wc * 32 + 8 * fq;
                    const f32x4 v0 = acc[ai][bj][m][0], v1 = acc[ai][bj][m][1];
                    uint4 o; o.x = pk_bf16(v0[0], v0[1]); o.y = pk_bf16(v0[2], v0[3]); o.z = pk_bf16(v1[0], v1[1]); o.w = pk_bf16(v1[2], v1[3]);
                    *(uint4*)(O + (size_t)row * ldc + col) = o; }
    } };
struct FStoreBf16 { bf16_t* O; int ldc;
    __device__ __forceinline__ void operator()(const pg8::Unit&, int row, int col, const f32x4& v0, const f32x4& v1) const {
        uint2 a, b; a.x = pk_bf16(v0[0], v0[1]); a.y = pk_bf16(v0[2], v0[3]); b.x = pk_bf16(v1[0], v1[1]); b.y = pk_bf16(v1[2], v1[3]);
        *(uint2*)(O + (size_t)row * ldc + col) = a; *(uint2*)(O + (size_t)row * ldc + col + 16) = b; } };
struct EpiG1 { bf16_t* Z; bf16_t* GT;
    __device__ __forceinline__ void operator()(const f32x4 (&acc)[2][2][4][2], const pg8::Unit& u, int wr, int wc, int fr, int fq) const {
        if (u.col0 < C_GATE) {
#pragma unroll
            for (int ai = 0; ai < 2; ++ai)
#pragma unroll
                for (int m = 0; m < 4; ++m)
#pragma unroll
                    for (int bj = 0; bj < 2; ++bj) { const int row = u.row0 + ai * 128 + wr * 64 + m * 16 + fr, col = u.col0 + bj * 128 + wc * 32 + 8 * fq;
                        const f32x4 v0 = acc[ai][bj][m][0], v1 = acc[ai][bj][m][1];
                        uint4 o; o.x = pk_bf16(v0[0], v0[1]); o.y = pk_bf16(v0[2], v0[3]); o.z = pk_bf16(v1[0], v1[1]); o.w = pk_bf16(v1[2], v1[3]);
                        *(uint4*)(Z + (size_t)row * ZP + col) = o; }
        } else {
            const int tidx = (wr * 4 + wc) * 64 + fq * 16 + fr;
            bf16_t* base = GT + ((size_t)(u.row0 >> 8) * 12 + ((u.col0 - C_GATE) >> 8)) * 65536 + tidx * 8;
#pragma unroll
            for (int ai = 0; ai < 2; ++ai)
#pragma unroll
                for (int bj = 0; bj < 2; ++bj)
#pragma unroll
                    for (int m = 0; m < 4; ++m) { const f32x4 v0 = acc[ai][bj][m][0], v1 = acc[ai][bj][m][1];
                        uint4 o; o.x = pk_bf16(sigmoidf_(v0[0]), sigmoidf_(v0[1])); o.y = pk_bf16(sigmoidf_(v0[2]), sigmoidf_(v0[3]));
                        o.z = pk_bf16(sigmoidf_(v1[0]), sigmoidf_(v1[1])); o.w = pk_bf16(sigmoidf_(v1[2]), sigmoidf_(v1[3]));
                        *(uint4*)(base + ((ai * 2 + bj) * 4 + m) * 4096) = o; }
        }
    } };
__device__ __forceinline__ void ph_g1(const Params& P, LAS unsigned char* lds) {
    pg8::SchedDense S{NTOK / 256, INC / 256, (int)gridDim.x, bid_(), (const char*)(P.ws + WS_H), (const char*)(P.ws + WS_WIN), (size_t)256 * D * 2, (size_t)256 * D * 2};
    EpiG1 E{(bf16_t*)(P.ws + WS_Z), (bf16_t*)(P.ws + WS_GT)};
    pg8::gemm_phase(lds, pg8::Gemm{D, D, D}, S, E);
}

__device__ __forceinline__ int kvrow(int r) { return r < NLAT ? ((r >> 11) * 2304 + 256 + (r & 2047)) : (((r - NLAT) >> 8) * 2304 + ((r - NLAT) & 255)); }
__device__ __forceinline__ void ph_prep(const Params& P, int l) {
    const int tid = tid_(), lane = tid & 63, wid = tid >> 6;
    const bf16_t* z = (const bf16_t*)(P.ws + WS_Z);
    bf16_t* qn = (bf16_t*)(P.ws + WS_QN); bf16_t* kn = (bf16_t*)(P.ws + WS_KN); bf16_t* vn = (bf16_t*)(P.ws + WS_VN);
    const float* rope = (const float*)(P.ws + WS_ROPE);
    const float gq = P.in[I_QNG][l * 64 + lane] * (0.125f * 1.4426950408889634f), gk = P.in[I_KNG][l * 64 + lane];
    for (int r = bid_() * 8 + wid; r < NTOK; r += gridDim.x * 8) {
        const bool lat = r < NLAT;
        const size_t kr = (size_t)kvrow(r);
        float cs = 1.f, sn = 0.f;
        if (lat) { const int t = r & 2047, fi = lane & 15;
            if (lane < 32) { const int pr = t >> 6; cs = rope[pr * 16 + fi]; sn = rope[512 + pr * 16 + fi]; }
            else { const int pc = t & 63; cs = rope[1024 + pc * 16 + fi]; sn = rope[2048 + pc * 16 + fi]; } }
        const float sgn = (lane & 16) ? 1.f : -1.f;
#pragma unroll
        for (int hh = 8; hh < 10; ++hh) {
            const int col = (hh < 8) ? (C_GQ + hh * 64) : (C_GK + (hh - 8) * 64);
            const float x = bf2f(z[(size_t)r * ZP + col + lane]);
            const float ss = wave_sum(x * x);
            const float xn = x * __builtin_amdgcn_rsqf(ss * (1.0f / 64.0f) + 1e-6f) * (hh < 8 ? gq : gk);
            const float pa = __shfl_xor(xn, 16, 64);
            const float o = xn * cs + sgn * pa * sn;
            const bf16_t ob = (bf16_t)(pk_bf16(o, 0.f) & 0xffffu);
            if (hh < 8) qn[(size_t)r * 512 + hh * 64 + lane] = ob; else kn[kr * 128 + (hh - 8) * 64 + lane] = ob;
        }
        *(unsigned*)(vn + kr * 128 + lane * 2) = *(const unsigned*)(z + (size_t)r * ZP + C_GV + lane * 2);
    }
}

__device__ __forceinline__ void ph_navt(const Params& P, LAS unsigned char* lds) {
    const int tid = tid_();
    const bf16_t* z = (const bf16_t*)(P.ws + WS_Z); bf16_t* vt = (bf16_t*)(P.ws + WS_NAVT);
    constexpr int PT = 1040;
    for (int u = bid_(); u < NB * 36; u += gridDim.x) {
        const int b = u / 36, tl = u % 36;
        const int row0 = (tl < 4) ? (NLAT + b * 256 + tl * 64) : (b * 2048 + (tl - 4) * 64);
        __syncthreads();
#pragma unroll
        for (int i = 0; i < 8; ++i) { const int ch = tid + i * NTHR, rr = ch >> 6, cc = ch & 63;
            const uint4 v = *(const uint4*)(z + (size_t)(row0 + rr) * ZP + C_NAV + cc * 8);
            *(LAS u32x4*)(lds + rr * PT + cc * 16) = (u32x4){v.x, v.y, v.z, v.w}; }
        __syncthreads();
#pragma unroll
        for (int i = 0; i < 8; ++i) { const int c = tid, tg = i;
            unsigned short e[8];
#pragma unroll
            for (int k = 0; k < 8; ++k) e[k] = *(const LAS unsigned short*)(lds + (tg * 8 + k) * PT + c * 2);
            uint4 o; o.x = e[0] | ((unsigned)e[1] << 16); o.y = e[2] | ((unsigned)e[3] << 16); o.z = e[4] | ((unsigned)e[5] << 16); o.w = e[6] | ((unsigned)e[7] << 16);
            *(uint4*)(vt + ((size_t)(b * 8 + (c >> 6)) * 64 + (c & 63)) * 2304 + tl * 64 + tg * 8) = o; }
    }
    __syncthreads();
}

#ifdef DIAG
__device__ __forceinline__ void load_q64(float (&q)[64], const bf16_t* p) {
#pragma unroll
    for (int i = 0; i < 8; ++i) { const uint4 u = ((const uint4*)p)[i];
        q[8 * i + 0] = bf_lo(u.x); q[8 * i + 1] = bf_hi(u.x); q[8 * i + 2] = bf_lo(u.y); q[8 * i + 3] = bf_hi(u.y);
        q[8 * i + 4] = bf_lo(u.z); q[8 * i + 5] = bf_hi(u.z); q[8 * i + 6] = bf_lo(u.w); q[8 * i + 7] = bf_hi(u.w); }
}
__device__ __forceinline__ void attn_key(const float (&q)[64], const bf16_t* kp, const bf16_t* vp, float bias, float& m, float& lsum, float (&o)[64]) {
    float s = 0.f;
#pragma unroll
    for (int i = 0; i < 8; ++i) { const uint4 u = ((const uint4*)kp)[i];
        s += q[8 * i + 0] * bf_lo(u.x) + q[8 * i + 1] * bf_hi(u.x) + q[8 * i + 2] * bf_lo(u.y) + q[8 * i + 3] * bf_hi(u.y)
           + q[8 * i + 4] * bf_lo(u.z) + q[8 * i + 5] * bf_hi(u.z) + q[8 * i + 6] * bf_lo(u.w) + q[8 * i + 7] * bf_hi(u.w); }
    s = s * 0.125f + bias;
    const float mn = fmaxf(m, s), corr = __expf(m - mn), pp = __expf(s - mn);
    lsum = lsum * corr + pp; m = mn;
#pragma unroll
    for (int i = 0; i < 8; ++i) { const uint4 u = ((const uint4*)vp)[i];
        o[8 * i + 0] = o[8 * i + 0] * corr + pp * bf_lo(u.x); o[8 * i + 1] = o[8 * i + 1] * corr + pp * bf_hi(u.x);
        o[8 * i + 2] = o[8 * i + 2] * corr + pp * bf_lo(u.y); o[8 * i + 3] = o[8 * i + 3] * corr + pp * bf_hi(u.y);
        o[8 * i + 4] = o[8 * i + 4] * corr + pp * bf_lo(u.z); o[8 * i + 5] = o[8 * i + 5] * corr + pp * bf_hi(u.z);
        o[8 * i + 6] = o[8 * i + 6] * corr + pp * bf_lo(u.w); o[8 * i + 7] = o[8 * i + 7] * corr + pp * bf_hi(u.w); }
}
__device__ __forceinline__ void store_o64(const float (&o)[64], float inv, bf16_t* p) {
#pragma unroll
    for (int i = 0; i < 8; ++i) { uint4 u;
        u.x = pk_bf16(o[8 * i + 0] * inv, o[8 * i + 1] * inv); u.y = pk_bf16(o[8 * i + 2] * inv, o[8 * i + 3] * inv);
        u.z = pk_bf16(o[8 * i + 4] * inv, o[8 * i + 5] * inv); u.w = pk_bf16(o[8 * i + 6] * inv, o[8 * i + 7] * inv);
        ((uint4*)p)[i] = u; }
}
__device__ __forceinline__ void na_thread(const Params& P, int l, int r, int h, bf16_t* br, int OPN) {
    const bf16_t* z = (const bf16_t*)(P.ws + WS_Z);
    float q[64], o[64]; float m = -INFINITY, ls = 0.f;
#pragma unroll
    for (int i = 0; i < 64; ++i) o[i] = 0.f;
    load_q64(q, z + (size_t)r * ZP + C_NAQ + h * 64);
    int b;
    if (r < NLAT) {
        b = r >> 11; const int t = r & 2047, qr = t >> 6, qc = t & 63;
        const int r0 = min(max(qr - 4, 0), 24), c0 = min(max(qc - 8, 0), 48);
        const float* rpb = P.in[I_RPB] + ((size_t)l * 8 + h) * 15 * 31;
        for (int kr = r0; kr < r0 + 8; ++kr)
            for (int kc = c0; kc < c0 + 16; ++kc) {
                const size_t krow = (size_t)(b * 2048 + kr * 64 + kc) * ZP;
                attn_key(q, z + krow + C_NAK + h * 64, z + krow + C_NAV + h * 64, rpb[(kr - qr + 7) * 31 + (kc - qc + 15)], m, ls, o);
            }
    } else b = (r - NLAT) >> 8;
    for (int j = 0; j < 256; ++j) {
        const size_t krow = (size_t)(NLAT + b * 256 + j) * ZP;
        attn_key(q, z + krow + C_NAK + h * 64, z + krow + C_NAV + h * 64, 0.f, m, ls, o);
    }
    store_o64(o, 1.0f / ls, br + (size_t)r * OPN + h * 64);
}
#endif
namespace na {
constexpr int KP = 144, VP = 528;
constexpr int L_K = 0, L_V = 256 * KP, L_B = L_V + 64 * VP, L_END = L_B + 480 * 4;
constexpr float C2 = 0.125f * 1.4426950408889634f, LOG2E = 1.4426950408889634f;
struct Acc { float m, l; f32x4 o[4]; };
template <int NG> __device__ __forceinline__ void absorb(Acc& A, f32x4 (&sa)[NG], f32x4 (&sb)[NG], const bf16x8 (&vfr)[NG][4]) {
    float mx = -INFINITY;
#pragma unroll
    for (int g = 0; g < NG; ++g)
#pragma unroll
        for (int j = 0; j < 4; ++j) mx = fmaxf(mx, fmaxf(sa[g][j], sb[g][j]));
    mx = fmaxf(mx, __shfl_xor(mx, 16, 64)); mx = fmaxf(mx, __shfl_xor(mx, 32, 64));
    const float mn = fmaxf(A.m, mx), corr = __builtin_amdgcn_exp2f(A.m - mn);
    A.m = mn;
    float ps = 0.f;
    bf16x8 pf[NG];
#pragma unroll
    for (int g = 0; g < NG; ++g) { float p[8];
#pragma unroll
        for (int j = 0; j < 4; ++j) { p[j] = __builtin_amdgcn_exp2f(sa[g][j] - mn); p[4 + j] = __builtin_amdgcn_exp2f(sb[g][j] - mn); ps += p[j] + p[4 + j]; }
        pf[g] = pack8(p); }
    A.l = A.l * corr + ps;
#pragma unroll
    for (int db = 0; db < 4; ++db) A.o[db] *= corr;
#pragma unroll
    for (int g = 0; g < NG; ++g)
#pragma unroll
        for (int db = 0; db < 4; ++db) A.o[db] = __builtin_amdgcn_mfma_f32_16x16x32_bf16(vfr[g][db], pf[g], A.o[db], 0, 0, 0);
}
}
__device__ __forceinline__ void na_unit(const Params& P, LAS unsigned char* lds, int l, int u, bf16_t* br, int OPN) {
    const int tid = tid_(), lane = tid & 63, wid = __builtin_amdgcn_readfirstlane(tid >> 6), c16 = lane & 15, kq = lane >> 4;
    const bool latu = u < 256;
    const int bh = latu ? (u >> 2) : (u - 256), b = bh >> 3, h = bh & 7, q4 = u & 3;
    const bf16_t* z = (const bf16_t*)(P.ws + WS_Z); const bf16_t* vt = (const bf16_t*)(P.ws + WS_NAVT) + (size_t)bh * 64 * 2304;
    LAS unsigned char* KL = lds + na::L_K; LAS unsigned char* VL = lds + na::L_V; LAS float* BL = (LAS float*)(lds + na::L_B);
    __syncthreads();
#pragma unroll
    for (int i = 0; i < 4; ++i) { const int ch = tid + i * NTHR, rr = ch >> 3, cc = ch & 7;
        const uint4 v = *(const uint4*)(z + (size_t)(NLAT + b * 256 + rr) * ZP + C_NAK + h * 64 + cc * 8);
        *(LAS u32x4*)(KL + rr * na::KP + cc * 16) = (u32x4){v.x, v.y, v.z, v.w}; }
#pragma unroll
    for (int i = 0; i < 4; ++i) { const int ch = tid + i * NTHR, rr = ch >> 5, cc = ch & 31;
        const uint4 v = *(const uint4*)(vt + (size_t)rr * 2304 + cc * 8);
        *(LAS u32x4*)(VL + rr * na::VP + cc * 16) = (u32x4){v.x, v.y, v.z, v.w}; }
    if (tid < 465) BL[tid] = P.in[I_RPB][((size_t)l * 8 + h) * 465 + tid] * na::LOG2E;
    __syncthreads();
    const int sA = 8 * (c16 >> 2) + (c16 & 3);
    const int ntask = latu ? 4 : 2;
    struct TaskP { int qrow, r, jb, r0, kc0; };
#define NA_FENCE() asm volatile("" ::: "memory")
#define NA_TASKP(it_, t_) do { const int tk_ = (it_) * 8 + wid; t_.r = 0; t_.jb = 0; t_.r0 = 0; t_.kc0 = 0; \
        if (latu) { t_.r = q4 * 8 + (tk_ >> 2); t_.jb = tk_ & 3; t_.qrow = b * 2048 + t_.r * 64 + t_.jb * 16 + c16; t_.r0 = min(max(t_.r - 4, 0), 24); t_.kc0 = min(max(t_.jb * 16 - 8, 0), 32); } \
        else t_.qrow = NLAT + b * 256 + tk_ * 16 + c16; } while (0)
#define NA_LOADK(t_, c_, kf_) do { _Pragma("unroll") for (int g = 0; g < 2; ++g) { const bf16_t* kp_ = z + ((size_t)b * 2048 + (size_t)(t_.r0 + 2 * (c_) + g) * 64 + t_.kc0 + sA) * ZP + C_NAK + h * 64 + 8 * kq; \
            kf_[g][0] = *(const bf16x8*)kp_; kf_[g][1] = *(const bf16x8*)(kp_ + 32); kf_[g][2] = *(const bf16x8*)(kp_ + 4 * ZP); kf_[g][3] = *(const bf16x8*)(kp_ + 4 * ZP + 32); } } while (0)
#define NA_LOADV(t_, c_, vf_) do { const bf16_t* vp_ = vt + (size_t)c16 * 2304 + 256 + (t_.r0 + 2 * (c_)) * 64 + t_.kc0 + 8 * kq; \
        _Pragma("unroll") for (int g = 0; g < 2; ++g) _Pragma("unroll") for (int db = 0; db < 4; ++db) vf_[g][db] = *(const bf16x8*)(vp_ + (size_t)db * 16 * 2304 + g * 64); } while (0)
    for (int it = 0; it < ntask; ++it) {
        TaskP T; NA_TASKP(it, T);
        bf16x8 qf[2];
#pragma unroll
        for (int ks = 0; ks < 2; ++ks) qf[ks] = *(const bf16x8*)(z + (size_t)T.qrow * ZP + C_NAQ + h * 64 + 32 * ks + 8 * kq);
        na::Acc A; A.m = -INFINITY; A.l = 0.f;
#pragma unroll
        for (int db = 0; db < 4; ++db) A.o[db] = (f32x4){0.f, 0.f, 0.f, 0.f};
        if (latu) {
            bf16x8 kA[2][4], vA[2][4], kB[2][4], vB[2][4];
            NA_LOADK(T, 0, kA); NA_LOADV(T, 0, vA); NA_LOADK(T, 1, kB); NA_LOADV(T, 1, vB);
            const int qc = T.jb * 16 + c16, c0 = min(max(qc - 8, 0), 48);
            int dcol[8]; bool ok[8];
#pragma unroll
            for (int j = 0; j < 8; ++j) { const int kc = T.kc0 + 8 * kq + j; ok[j] = (kc >= c0) && (kc < c0 + 16); dcol[j] = ok[j] ? (kc - qc + 15) : 0; }
#define NA_SCORES(KF, CI) do { \
                float bv[2][8]; \
                _Pragma("unroll") for (int g = 0; g < 2; ++g) { const int brow = (T.r0 + 2 * (CI) + g - T.r + 7) * 31; \
                    _Pragma("unroll") for (int j = 0; j < 8; ++j) bv[g][j] = BL[brow + dcol[j]]; } \
                _Pragma("unroll") for (int g = 0; g < 2; ++g) { \
                    f32x4 a_ = {0.f, 0.f, 0.f, 0.f}, b_ = {0.f, 0.f, 0.f, 0.f}; \
                    a_ = __builtin_amdgcn_mfma_f32_16x16x32_bf16(KF[g][0], qf[0], a_, 0, 0, 0); a_ = __builtin_amdgcn_mfma_f32_16x16x32_bf16(KF[g][1], qf[1], a_, 0, 0, 0); \
                    b_ = __builtin_amdgcn_mfma_f32_16x16x32_bf16(KF[g][2], qf[0], b_, 0, 0, 0); b_ = __builtin_amdgcn_mfma_f32_16x16x32_bf16(KF[g][3], qf[1], b_, 0, 0, 0); \
                    _Pragma("unroll") for (int j = 0; j < 4; ++j) { \
                        const float va_ = a_[j] * na::C2 + bv[g][j], vb_ = b_[j] * na::C2 + bv[g][4 + j]; \
                        sa[g][j] = ok[j] ? va_ : -INFINITY; sb[g][j] = ok[4 + j] ? vb_ : -INFINITY; } } } while (0)
            f32x4 sa[2], sb[2];
            NA_SCORES(kA, 0); NA_FENCE(); NA_LOADK(T, 2, kA); NA_FENCE(); na::absorb<2>(A, sa, sb, vA); NA_FENCE(); NA_LOADV(T, 2, vA); NA_FENCE();
            NA_SCORES(kB, 1); NA_FENCE(); NA_LOADK(T, 3, kB); NA_FENCE(); na::absorb<2>(A, sa, sb, vB); NA_FENCE(); NA_LOADV(T, 3, vB); NA_FENCE();
            NA_SCORES(kA, 2); na::absorb<2>(A, sa, sb, vA);
            NA_SCORES(kB, 3); na::absorb<2>(A, sa, sb, vB);
#undef NA_SCORES
        }
#pragma unroll 1
        for (int ch = 0; ch < 2; ++ch) {
            f32x4 sa[4], sb[4];
            bf16x8 kf[4][4], vfr[4][4];
            { const LAS unsigned char* vp = VL + c16 * na::VP + (ch * 128 + 8 * kq) * 2;
#pragma unroll
              for (int g = 0; g < 4; ++g)
#pragma unroll
                for (int db = 0; db < 4; ++db) vfr[g][db] = *(const LAS bf16x8*)(vp + db * 16 * na::VP + g * 64); }
#pragma unroll
            for (int g = 0; g < 4; ++g) {
                const LAS unsigned char* kp = KL + (ch * 128 + g * 32 + sA) * na::KP + kq * 16;
                kf[g][0] = *(const LAS bf16x8*)kp; kf[g][1] = *(const LAS bf16x8*)(kp + 64); kf[g][2] = *(const LAS bf16x8*)(kp + 4 * na::KP); kf[g][3] = *(const LAS bf16x8*)(kp + 4 * na::KP + 64);
            }
#pragma unroll
            for (int g = 0; g < 4; ++g) {
                f32x4 a = {0.f, 0.f, 0.f, 0.f}, bq = {0.f, 0.f, 0.f, 0.f};
                a = __builtin_amdgcn_mfma_f32_16x16x32_bf16(kf[g][0], qf[0], a, 0, 0, 0); a = __builtin_amdgcn_mfma_f32_16x16x32_bf16(kf[g][1], qf[1], a, 0, 0, 0);
                bq = __builtin_amdgcn_mfma_f32_16x16x32_bf16(kf[g][2], qf[0], bq, 0, 0, 0); bq = __builtin_amdgcn_mfma_f32_16x16x32_bf16(kf[g][3], qf[1], bq, 0, 0, 0);
                sa[g] = a * na::C2; sb[g] = bq * na::C2;
            }
            na::absorb<4>(A, sa, sb, vfr);
        }
        float ls = A.l; ls += __shfl_xor(ls, 16, 64); ls += __shfl_xor(ls, 32, 64);
        const float inv = __builtin_amdgcn_rcpf(ls);
        bf16_t* op = br + (size_t)T.qrow * OPN + h * 64 + 4 * kq;
#pragma unroll
        for (int db = 0; db < 4; ++db) { uint2 o; o.x = pk_bf16(A.o[db][0] * inv, A.o[db][1] * inv); o.y = pk_bf16(A.o[db][2] * inv, A.o[db][3] * inv);
            *(uint2*)(op + 16 * db) = o; }
    }
#undef NA_FENCE
#undef NA_TASKP
#undef NA_LOADK
#undef NA_LOADV
}
__device__ __forceinline__ int hg_row(int b, int dir, int s) { return s < 256 ? (NLAT + b * 256 + (dir ? 255 - s : s)) : (b * 2048 + (dir ? 2047 - (s - 256) : (s - 256))); }
__device__ __forceinline__ bf16x8 tr2(const LAS unsigned char* p0, const LAS unsigned char* p1) {
    typedef short v4i16_t __attribute__((ext_vector_type(4)));
    const v4i16_t a = __builtin_amdgcn_ds_read_tr16_b64_v4i16((LAS v4i16_t*)p0), c = __builtin_amdgcn_ds_read_tr16_b64_v4i16((LAS v4i16_t*)p1);
    return (bf16x8){a[0], a[1], a[2], a[3], c[0], c[1], c[2], c[3]};
}
__device__ __forceinline__ void hgrn_unit(const Params& P, LAS unsigned char* lds, int l, int u) {
    const int tid = tid_(), lane = tid & 63, wid = __builtin_amdgcn_readfirstlane(tid >> 6), c16 = lane & 15, kq = lane >> 4;
    const int b = u >> 3, h = (u >> 1) & 3, dir = u & 1;
    const bf16_t* z = (const bf16_t*)(P.ws + WS_Z);
    float* O = (float*)(P.ws + (dir ? WS_Y : WS_H));
    const float* lbv = (const float*)(P.ws + WS_LB) + ((size_t)l * 2 + dir) * 512 + h * 128;
    constexpr int PQ = 272;
    LAS unsigned char* QH = lds; LAS unsigned char* KT = lds + 8704; LAS unsigned char* KH = lds + 17408; LAS unsigned char* VV = lds + 26112;
    LAS float* DL = (LAS float*)(lds + 34816); LAS float* WT = DL + 128;
    const int ch = 2 * lane;
    const float lb0 = lbv[ch], lb1 = lbv[ch + 1];
    const int cf = (dir ? C_HFB : C_HFF) + h * 128 + ch, cq = C_HQ + h * 128 + ch, cv = C_HI + h * 128 + ch;
    f32x4 SA[4], SB[4];
#pragma unroll
    for (int G = 0; G < 4; ++G) { SA[G] = (f32x4){0.f, 0.f, 0.f, 0.f}; SB[G] = (f32x4){0.f, 0.f, 0.f, 0.f}; }
    unsigned rf[4], rq[4], rv[4];
#pragma unroll
    for (int k = 0; k < 4; ++k) { const bf16_t* zr = z + (size_t)hg_row(b, dir, 4 * wid + k) * ZP; rf[k] = *(const unsigned*)(zr + cf); rq[k] = *(const unsigned*)(zr + cq); rv[k] = *(const unsigned*)(zr + cv); }
    const int sA = 8 * (c16 >> 2) + (c16 & 3);
    const int tq = c16 >> 2, tp = c16 & 3;
    for (int st = 0; st < 72; ++st) {
        unsigned xf[4], xq[4], xv[4];
#pragma unroll
        for (int k = 0; k < 4; ++k) { xf[k] = rf[k]; xq[k] = rq[k]; xv[k] = rv[k]; }
        if (st + 1 < 72) {
#pragma unroll
            for (int k = 0; k < 4; ++k) { const bf16_t* zr = z + (size_t)hg_row(b, dir, (st + 1) * 32 + 4 * wid + k) * ZP; rf[k] = *(const unsigned*)(zr + cf); rq[k] = *(const unsigned*)(zr + cq); rv[k] = *(const unsigned*)(zr + cv); }
        }
        float g0[4], g1[4], k0[4], k1[4], q0[4], q1[4];
        float c0 = 1.f, c1 = 1.f;
#pragma unroll
        for (int k = 0; k < 4; ++k) {
            const float f0 = lb0 + (1.0f - lb0) * sigmoidf_(bf_lo(xf[k])), f1 = lb1 + (1.0f - lb1) * sigmoidf_(bf_hi(xf[k]));
            c0 *= f0; c1 *= f1; g0[k] = c0; g1[k] = c1;
            k0[k] = 1.0f - f0; k1[k] = 1.0f - f1; q0[k] = siluf_(bf_lo(xq[k])); q1[k] = siluf_(bf_hi(xq[k]));
        }
        WT[wid * 128 + ch] = c0; WT[wid * 128 + ch + 1] = c1;
        __syncthreads();
        float pre0 = 1.f, pre1 = 1.f, tot0 = 1.f, tot1 = 1.f;
#pragma unroll
        for (int w = 0; w < 8; ++w) { const float a0 = WT[w * 128 + ch], a1 = WT[w * 128 + ch + 1]; tot0 *= a0; tot1 *= a1; if (w < wid) { pre0 *= a0; pre1 *= a1; } }
#pragma unroll
        for (int k = 0; k < 4; ++k) {
            const float e0 = g0[k] * pre0, e1 = g1[k] * pre1;
            const float r0 = __builtin_amdgcn_rcpf(e0), r1 = __builtin_amdgcn_rcpf(e1);
            const float kt0 = k0[k] * r0, kt1 = k1[k] * r1;
            const int ro = (4 * wid + k) * PQ + ch * 2;
            *(LAS unsigned*)(QH + ro) = pk_bf16(q0[k] * e0, q1[k] * e1);
            *(LAS unsigned*)(KT + ro) = pk_bf16(kt0, kt1);
            *(LAS unsigned*)(KH + ro) = pk_bf16(kt0 * tot0, kt1 * tot1);
            *(LAS unsigned*)(VV + ro) = xv[k];
        }
        if (wid == 0) { DL[ch] = tot0; DL[ch + 1] = tot1; }
        __syncthreads();
        const bf16x8 vfr = tr2(VV + (8 * kq + tq) * PQ + (16 * wid + 4 * tp) * 2, VV + (8 * kq + 4 + tq) * PQ + (16 * wid + 4 * tp) * 2);
        bf16x8 Sb[4];
#pragma unroll
        for (int G = 0; G < 4; ++G) { const float sv[8] = {SA[G][0], SA[G][1], SA[G][2], SA[G][3], SB[G][0], SB[G][1], SB[G][2], SB[G][3]}; Sb[G] = pack8(sv); }
#pragma unroll
        for (int T = 0; T < 2; ++T) {
            f32x4 aA = {0.f, 0.f, 0.f, 0.f}, aB = {0.f, 0.f, 0.f, 0.f};
            bf16x8 qf[4];
#pragma unroll
            for (int ks = 0; ks < 4; ++ks) {
                const bf16x8 kA = *(const LAS bf16x8*)(KT + sA * PQ + (32 * ks + 8 * kq) * 2);
                const bf16x8 kB = *(const LAS bf16x8*)(KT + (sA + 4) * PQ + (32 * ks + 8 * kq) * 2);
                qf[ks] = *(const LAS bf16x8*)(QH + (16 * T + c16) * PQ + (32 * ks + 8 * kq) * 2);
                aA = __builtin_amdgcn_mfma_f32_16x16x32_bf16(kA, qf[ks], aA, 0, 0, 0);
                aB = __builtin_amdgcn_mfma_f32_16x16x32_bf16(kB, qf[ks], aB, 0, 0, 0);
            }
            const int t = 16 * T + c16;
            float pv_[8];
#pragma unroll
            for (int jj = 0; jj < 4; ++jj) { pv_[jj] = (8 * kq + jj <= t) ? aA[jj] : 0.f; pv_[4 + jj] = (8 * kq + 4 + jj <= t) ? aB[jj] : 0.f; }
            f32x4 o = {0.f, 0.f, 0.f, 0.f};
            o = __builtin_amdgcn_mfma_f32_16x16x32_bf16(pack8(pv_), vfr, o, 0, 0, 0);
#pragma unroll
            for (int ks = 0; ks < 4; ++ks) o = __builtin_amdgcn_mfma_f32_16x16x32_bf16(qf[ks], Sb[ks], o, 0, 0, 0);
#pragma unroll
            for (int jj = 0; jj < 4; ++jj) O[(size_t)hg_row(b, dir, st * 32 + 16 * T + 4 * kq + jj) * 512 + h * 128 + 16 * wid + c16] = o[jj];
        }
#pragma unroll
        for (int G = 0; G < 4; ++G) {
            const f32x4 d0 = *(const LAS f32x4*)(DL + 32 * G + 8 * kq), d1 = *(const LAS f32x4*)(DL + 32 * G + 8 * kq + 4);
            const LAS unsigned char* ka = KH + (8 * kq + tq) * PQ + (32 * G + 8 * tp) * 2;
            const bf16x8 hA = tr2(ka, ka + 4 * PQ), hB = tr2(ka + 8, ka + 4 * PQ + 8);
            SA[G] = __builtin_amdgcn_mfma_f32_16x16x32_bf16(hA, vfr, SA[G] * d0, 0, 0, 0);
            SB[G] = __builtin_amdgcn_mfma_f32_16x16x32_bf16(hB, vfr, SB[G] * d1, 0, 0, 0);
        }
    }
    __syncthreads();
}
__device__ __forceinline__ void gqa_unit(const Params& P, char* shm, int l, int U) {
    const bf16_t* z = (const bf16_t*)(P.ws + WS_Z); const bf16_t* kn = (const bf16_t*)(P.ws + WS_KN); const bf16_t* vn = (const bf16_t*)(P.ws + WS_VN);
    bf16_t* br = (bf16_t*)(P.ws + WS_BR);
    int b, hq, row0, NT;
    if (U < 512) { const int bg = U >> 5; b = bg >> 1; hq = (bg & 1) * 4 + ((U & 31) >> 3); row0 = b * 2048 + (U & 7) * 256; NT = 36; }
    else { const int v = U - 512; b = v >> 3; hq = v & 7; row0 = NLAT + b * 256; NT = 4; }
    const int g = hq >> 2;
    gqa::attn_unit<8>(z + (size_t)row0 * ZP + C_GQ + hq * 64, P.in[I_QNG] + l * 64, (const float*)(P.ws + WS_ROPE), (U < 512) ? ((U & 7) * 256) : -1,
                      kn + (size_t)b * 2304 * 128 + g * 64, vn + (size_t)b * 2304 * 128 + g * 64, br + (size_t)row0 * BRW + 1024 + hq * 64, NT, shm);
}
__device__ __forceinline__ void ph_mix(const Params& P, LAS unsigned char* lds, char* shm, int l, int pass = 0, int filter = 0) {
    const int tid = tid_();
    unsigned* qctr = (unsigned*)(P.ws + WS_CNT + 512) + l + 4 * pass;
    volatile LAS unsigned* qslot = (volatile LAS unsigned*)(lds + LDS_BYTES - 32);
    for (;;) {
        if (tid == 0) *qslot = __hip_atomic_fetch_add(qctr, 1u, __ATOMIC_RELAXED, __HIP_MEMORY_SCOPE_AGENT);
        __syncthreads();
        const int u = (int)*qslot;
        __syncthreads();
        if (u >= 960) break;
        const int kind = (u < 64) ? 2 : ((u >= 64 && u < 320) || (u >= 832 && u < 896)) ? 3 : 1;
        if (filter != 0 && filter != kind) continue;
        if (u < 64) hgrn_unit(P, lds, l, u);
        else if (u < 320) na_unit(P, lds, l, u - 64, (bf16_t*)(P.ws + WS_BR), BRW);
        else if (u < 832) gqa_unit(P, shm, l, u - 320);
        else if (u < 896) { if (l < DEPTH - 1) na_unit(P, lds, l, 256 + (u - 832), (bf16_t*)(P.ws + WS_BR), BRW); }
        else { if (l < DEPTH - 1) gqa_unit(P, shm, l, 512 + (u - 896)); }
        __syncthreads();
    }
}
#ifdef DIAG
__device__ __forceinline__ void ph_diag_cmp(const Params& P) {
    const bf16_t* br = (const bf16_t*)(P.ws + WS_BR); const bf16_t* d1 = (const bf16_t*)(P.ws + WS_END); const bf16_t* d2 = d1 + (size_t)NTOK * 512;
    const bf16_t* z = (const bf16_t*)(P.ws + WS_Z); const bf16_t* vt = (const bf16_t*)(P.ws + WS_NAVT);
    unsigned* dg = (unsigned*)(P.ws + 20480);
    unsigned c1 = 0, c2 = 0, c3 = 0;
    for (size_t i = (size_t)bid_() * NTHR + tid_(); i < (size_t)NTOK * 512; i += (size_t)gridDim.x * NTHR) {
        const size_t r = i >> 9; const int c = (int)(i & 511);
        const float a = bf2f(br[r * BRW + c]), x = bf2f(d1[i]);
        if (!(fabsf(x - a) <= 0.004f + 0.02f * fabsf(a))) ++c1;
        if (DIAG != 4 && d1[i] != d2[i]) ++c3;
        const int rr = (int)r; const int bb = rr < NLAT ? (rr >> 11) : ((rr - NLAT) >> 8); const int tok = rr < NLAT ? (256 + (rr & 2047)) : ((rr - NLAT) & 255);
        if (vt[((size_t)(bb * 8 + (c >> 6)) * 64 + (c & 63)) * 2304 + tok] != z[r * ZP + C_NAV + c]) ++c2;
    }
    if (c1) atomicAdd(dg + 1, c1);
    if (c2) atomicAdd(dg + 2, c2);
    if (c3) atomicAdd(dg + 3, c3);
}
__device__ __forceinline__ void ph_diag_out(const Params& P) {
    const volatile unsigned* dg = (const volatile unsigned*)(P.ws + 20480);
    const unsigned c1 = dg[1], c2 = dg[2], c3 = dg[3];
    if ((c1 | c2 | c3) == 0) return;
    unsigned k = 0; { unsigned v = c1; while (v) { ++k; v >>= 1; } }
    if (c2) k += 30; if (c3) k += 60;
    const float cst = sqrtf(10.0f * (float)k + 9.0f);
    for (size_t i = (size_t)bid_() * NTHR + tid_(); i < (size_t)NLAT * D; i += (size_t)gridDim.x * NTHR) P.out[i] = cst;
}
#endif

__device__ __forceinline__ void ph_readout(const Params& P, int l) {
    const int tid = tid_(), lane = tid & 63, wid = tid >> 6;
    const float* OF = (const float*)(P.ws + WS_H); const float* OB = (const float*)(P.ws + WS_Y);
    const bf16_t* z = (const bf16_t*)(P.ws + WS_Z);
    bf16_t* br = (bf16_t*)(P.ws + WS_BR);
    const float g0 = P.in[I_HGN][l * 128 + lane * 2], g1 = P.in[I_HGN][l * 128 + lane * 2 + 1];
    for (int r = bid_() * 8 + wid; r < NTOK; r += gridDim.x * 8) {
#pragma unroll
        for (int h = 0; h < 4; ++h) {
            const int c = h * 128 + lane * 2;
            const float2 a = *(const float2*)(OF + (size_t)r * 512 + c), bb = *(const float2*)(OB + (size_t)r * 512 + c);
            const float o0 = a.x + bb.x, o1 = a.y + bb.y;
            const float ss = wave_sum(o0 * o0 + o1 * o1);
            const float rstd = __builtin_amdgcn_rsqf(ss * (1.0f / 128.0f) + 1e-6f);
            const unsigned gz = *(const unsigned*)(z + (size_t)r * ZP + C_HG + c);
            *(unsigned*)(br + (size_t)r * BRW + 512 + c) = pk_bf16(o0 * rstd * g0 * siluf_(bf_lo(gz)), o1 * rstd * g1 * siluf_(bf_hi(gz)));
        }
    }
}
struct SchedMerge { int G, c; const char* br; const char* wb; bool last;
    __device__ __forceinline__ bool next(int i, pg8::Unit& u) const {
        const int nl = (c < 256) ? (256 - c + G - 1) / G : 0;
        int tile, bi, mode;
        if (i < 3 * nl) { tile = c + (i / 3) * G; bi = i % 3; mode = 0; }
        else { if (last) return false; const int sidx = c + (i - 3 * nl) * G; if (sidx >= 96) return false; tile = 256 + sidx / 3; bi = sidx % 3; mode = 1; }
        const int pm = tile >> 2, pn = tile & 3;
        u.row0 = pm * 256; u.col0 = pn * 256; u.aux = bi | (mode << 4);
        u.A = br + ((size_t)pm * 256 * BRW + bi * 512) * 2; u.B = wb + ((size_t)bi * 1024 + pn * 256) * 512 * 2; return true; } };
struct EpiMerge { const bf16_t* GT; bf16_t* YP; bf16_t* Y; bf16_t* PG;
    __device__ __forceinline__ void operator()(const f32x4 (&acc)[2][2][4][2], const pg8::Unit& u, int wr, int wc, int fr, int fq) const {
        const int tidx = (wr * 4 + wc) * 64 + fq * 16 + fr, bi = u.aux & 15, mode = u.aux >> 4, pm = u.row0 >> 8, pn = u.col0 >> 8;
        const bf16_t* gb = GT + ((size_t)pm * 12 + bi * 4 + pn) * 65536 + tidx * 8;
        if (mode == 1) {
            bf16_t* pb = PG + ((size_t)bi * 32 + (pm - 64) * 4 + pn) * 65536 + tidx * 8;
#pragma unroll
            for (int ai = 0; ai < 2; ++ai)
#pragma unroll
                for (int bj = 0; bj < 2; ++bj) {
                    uint4 g[4];
#pragma unroll
                    for (int m = 0; m < 4; ++m) g[m] = *(const uint4*)(gb + ((ai * 2 + bj) * 4 + m) * 4096);
#pragma unroll
                    for (int m = 0; m < 4; ++m) { const f32x4 v0 = acc[ai][bj][m][0], v1 = acc[ai][bj][m][1];
                        uint4 o; o.x = pk_bf16(bf_lo(g[m].x) * v0[0], bf_hi(g[m].x) * v0[1]); o.y = pk_bf16(bf_lo(g[m].y) * v0[2], bf_hi(g[m].y) * v0[3]);
                        o.z = pk_bf16(bf_lo(g[m].z) * v1[0], bf_hi(g[m].z) * v1[1]); o.w = pk_bf16(bf_lo(g[m].w) * v1[2], bf_hi(g[m].w) * v1[3]);
                        *(uint4*)(pb + ((ai * 2 + bj) * 4 + m) * 4096) = o; }
                }
            return;
        }
        bf16_t* yb = YP + ((size_t)pm * 4 + pn) * 65536 + tidx * 8;
#pragma unroll
        for (int ai = 0; ai < 2; ++ai)
#pragma unroll
            for (int bj = 0; bj < 2; ++bj) {
                uint4 g[4], p[4];
#pragma unroll
                for (int m = 0; m < 4; ++m) g[m] = *(const uint4*)(gb + ((ai * 2 + bj) * 4 + m) * 4096);
                if (bi != 0) {
#pragma unroll
                    for (int m = 0; m < 4; ++m) p[m] = *(const uint4*)(yb + ((ai * 2 + bj) * 4 + m) * 4096);
                } else {
#pragma unroll
                    for (int m = 0; m < 4; ++m) p[m] = make_uint4(0u, 0u, 0u, 0u);
                }
#pragma unroll
                for (int m = 0; m < 4; ++m) { const int k = ((ai * 2 + bj) * 4 + m) * 4096;
                    const f32x4 v0 = acc[ai][bj][m][0], v1 = acc[ai][bj][m][1];
                    const float t[8] = {bf_lo(p[m].x) + bf_lo(g[m].x) * v0[0], bf_hi(p[m].x) + bf_hi(g[m].x) * v0[1], bf_lo(p[m].y) + bf_lo(g[m].y) * v0[2], bf_hi(p[m].y) + bf_hi(g[m].y) * v0[3],
                                        bf_lo(p[m].z) + bf_lo(g[m].z) * v1[0], bf_hi(p[m].z) + bf_hi(g[m].z) * v1[1], bf_lo(p[m].w) + bf_lo(g[m].w) * v1[2], bf_hi(p[m].w) + bf_hi(g[m].w) * v1[3]};
                    if (bi != 2) { uint4 o; o.x = pk_bf16(t[0], t[1]); o.y = pk_bf16(t[2], t[3]); o.z = pk_bf16(t[4], t[5]); o.w = pk_bf16(t[6], t[7]); *(uint4*)(yb + k) = o; }
                    else { const int row = u.row0 + ai * 128 + wr * 64 + m * 16 + fr, col = u.col0 + bj * 128 + wc * 32 + 8 * fq;
                        uint4 o; o.x = pk_bf16(t[0], t[1]); o.y = pk_bf16(t[2], t[3]); o.z = pk_bf16(t[4], t[5]); o.w = pk_bf16(t[6], t[7]);
                        *(uint4*)(Y + (size_t)row * D + col) = o; }
                }
            }
    } };
__device__ __forceinline__ void ph_merge(const Params& P, LAS unsigned char* lds, int l) {
    SchedMerge S{(int)gridDim.x, bid_(), (const char*)(P.ws + WS_BR), (const char*)(P.ws + WS_WBR), l == DEPTH - 1};
    EpiMerge E{(const bf16_t*)(P.ws + WS_GT), (bf16_t*)(P.ws + WS_H), (bf16_t*)(P.ws + WS_Y), (bf16_t*)(P.ws + WS_PG)};
    pg8::gemm_phase(lds, pg8::Gemm{512, BRW, 512}, S, E);
    if (l + 1 < DEPTH && (int)bid_() >= 96) wconv_range(P, lds, l + 1, 0, 16 * 124, (int)bid_() - 96, (int)gridDim.x - 96);
}
struct EpiDelta { bf16_t* DX; const float* mods; int l;
    __device__ __forceinline__ void operator()(const f32x4 (&acc)[2][2][4][2], const pg8::Unit& u, int wr, int wc, int fr, int fq) const {
        const float* gate = mods + ((size_t)l * 9 + row_modrow(u.row0)) * 6144 + 2 * 1024 + u.col0 + wc * 32 + 8 * fq;
        f32x4 gv[2][2];
#pragma unroll
        for (int bj = 0; bj < 2; ++bj)
#pragma unroll
            for (int n = 0; n < 2; ++n) gv[bj][n] = *(const f32x4*)(gate + bj * 128 + n * 4);
#pragma unroll
        for (int ai = 0; ai < 2; ++ai)
#pragma unroll
            for (int m = 0; m < 4; ++m)
#pragma unroll
                for (int bj = 0; bj < 2; ++bj) { const int row = u.row0 + ai * 128 + wr * 64 + m * 16 + fr, col = u.col0 + bj * 128 + wc * 32 + 8 * fq;
                    const f32x4 v0 = acc[ai][bj][m][0] * gv[bj][0], v1 = acc[ai][bj][m][1] * gv[bj][1];
                    uint4 o; o.x = pk_bf16(v0[0], v0[1]); o.y = pk_bf16(v0[2], v0[3]); o.z = pk_bf16(v1[0], v1[1]); o.w = pk_bf16(v1[2], v1[3]);
                    *(uint4*)(DX + (size_t)row * D + col) = o; }
    } };
struct SchedWout { int G, c; const char* A; const char* B; bool last;
    __device__ __forceinline__ bool next(int i, pg8::Unit& u) const {
        const int nc = (!last && c < 32) ? 1 : 0;
        int tile;
        if (i < nc) tile = 256 + c; else { tile = c + (i - nc) * G; if (tile >= 256) return false; }
        const int pm = tile >> 2, pn = tile & 3;
        u.row0 = pm * 256; u.col0 = pn * 256; u.aux = 0; u.A = A + (size_t)pm * 256 * D * 2; u.B = B + (size_t)pn * 256 * D * 2; return true; } };
__device__ __forceinline__ void ph_wout(const Params& P, LAS unsigned char* lds, int l, bool dry = false) {
    const bool last = (l == DEPTH - 1);
    const int c = bid_();
    if (!last && c < 32) {
        const int tid = tid_(), wid = tid >> 6, lane = tid & 63, wr = wid >> 2, wc = wid & 3, fr = lane & 15, fq = lane >> 4;
        const bf16_t* PG = (const bf16_t*)(P.ws + WS_PG); bf16_t* Y = (bf16_t*)(P.ws + WS_Y);
        const int pp = c >> 2;
        for (int pn = 0; pn < 4; ++pn)
#pragma unroll
            for (int kk = 0; kk < 16; ++kk) {
                const size_t off = ((size_t)pp * 4 + pn) * 65536 + kk * 4096 + tid * 8;
                const uint4 a = *(const uint4*)(PG + off), b = *(const uint4*)(PG + (size_t)32 * 65536 + off), d = *(const uint4*)(PG + (size_t)64 * 65536 + off);
                const int ai = kk >> 3, bj = (kk >> 2) & 1, m = kk & 3;
                const int row = (64 + pp) * 256 + ai * 128 + wr * 64 + m * 16 + fr, col = pn * 256 + bj * 128 + wc * 32 + 8 * fq;
                uint4 o;
                o.x = pk_bf16(bf_lo(a.x) + bf_lo(b.x) + bf_lo(d.x), bf_hi(a.x) + bf_hi(b.x) + bf_hi(d.x)); o.y = pk_bf16(bf_lo(a.y) + bf_lo(b.y) + bf_lo(d.y), bf_hi(a.y) + bf_hi(b.y) + bf_hi(d.y));
                o.z = pk_bf16(bf_lo(a.z) + bf_lo(b.z) + bf_lo(d.z), bf_hi(a.z) + bf_hi(b.z) + bf_hi(d.z)); o.w = pk_bf16(bf_lo(a.w) + bf_lo(b.w) + bf_lo(d.w), bf_hi(a.w) + bf_hi(b.w) + bf_hi(d.w));
                *(uint4*)(Y + (size_t)row * D + col) = o;
            }
        asm volatile("s_waitcnt vmcnt(0)" ::: "memory");
        __syncthreads();
    }
    SchedWout S{(int)gridDim.x, c, (const char*)(P.ws + WS_Y), (const char*)(P.ws + WS_WOUT), last};
    EpiDelta E{(bf16_t*)(P.ws + (dry ? WS_END : WS_BR)), (const float*)(P.ws + WS_MODS), l};
    pg8::gemm_phase(lds, pg8::Gemm{D, D, D}, S, E);
    if (!dry) { if (last) wconv_range(P, lds, l, CONV_T_DENSE, CONV_T_ALL, c, (int)gridDim.x); else if (c >= 32) wconv_range(P, lds, l, CONV_T_DENSE, CONV_T_ALL, c - 32, (int)gridDim.x - 32); }
}
__device__ __forceinline__ void ph_norm2_route(const Params& P, LAS unsigned char* lds, int l, bool dry = false) {
    const int tid = tid_(), lane = tid & 63, wid = tid >> 6;
    LAS float* Wt = (LAS float*)lds;
    LAS int* lcnt = (LAS int*)(lds + 81920); LAS int* lbase = lcnt + 16; LAS int* rinfo = lbase + 16;
    LAS float* rw = (LAS float*)(rinfo + 128 * 4);
    { const f32x4* rt4 = (const f32x4*)((const float*)(P.ws + WS_RT) + (size_t)l * 20480);
      for (int i = tid; i < 5 * 1024; i += NTHR) *(LAS f32x4*)(Wt + i * 4) = rt4[i]; }
    if (tid < 16) lcnt[tid] = 0;
    __syncthreads();
    const float* xres = (const float*)(P.ws + WS_X);
    const bf16_t* dx = (const bf16_t*)(P.ws + WS_BR);
    bf16_t* f = (bf16_t*)(P.ws + (dry ? WS_END : WS_H));
    const float* g = P.in[I_GFFN] + l * 1024;
    int* cnt = (int*)(P.ws + (dry ? 32768 : WS_CNT)) + l * 16;
    int* sel_e = (int*)(P.ws + (dry ? WS_END + 40000000 : WS_SELE)); float* sel_w = (float*)(P.ws + (dry ? WS_END + 41000000 : WS_SELW)); int* sel_p = (int*)(P.ws + (dry ? WS_END + 42000000 : WS_SELP));
    const int NR = (l == DEPTH - 1) ? NLAT : NTOK;
    const int r0 = bid_() * 8, rstep = gridDim.x * 8;
    int it = 0;
    for (int r = r0 + wid; r < NR; r += rstep, ++it) {
        const float* mod = (const float*)(P.ws + WS_MODS) + ((size_t)l * 9 + row_modrow(r)) * 6144;
        float4 x[4], o[4];
#pragma unroll
        for (int i = 0; i < 4; ++i) { x[i] = *(const float4*)(xres + (size_t)r * D + lane * 4 + 256 * i);
            const uint2 dv = *(const uint2*)(dx + (size_t)r * D + lane * 4 + 256 * i);
            x[i].x += bf_lo(dv.x); x[i].y += bf_hi(dv.x); x[i].z += bf_lo(dv.y); x[i].w += bf_hi(dv.y); }
        norm_row(x, g, mod + 3 * 1024, mod + 4 * 1024, lane, o);
#pragma unroll
        for (int i = 0; i < 4; ++i) { uint2 u; u.x = pk_bf16(o[i].x, o[i].y); u.y = pk_bf16(o[i].z, o[i].w); *(uint2*)(f + (size_t)r * D + lane * 4 + 256 * i) = u; }
        float lg[20];
#pragma unroll
        for (int j = 0; j < 20; ++j) {
            float s = 0.f;
#pragma unroll
            for (int i = 0; i < 4; ++i) { const f32x4 w = *(const LAS f32x4*)(Wt + j * 1024 + lane * 4 + 256 * i); s += o[i].x * w[0] + o[i].y * w[1] + o[i].z * w[2] + o[i].w * w[3]; }
            lg[j] = wave_sum(s);
        }
        if (lane == 0) {
            float gl[4]; int gi = 0;
#pragma unroll
            for (int j = 0; j < 4; ++j) gl[j] = lg[j] + P.in[I_BGR][l * 4 + j];
            float gm = gl[0];
#pragma unroll
            for (int j = 1; j < 4; ++j) if (gl[j] > gm) { gm = gl[j]; gi = j; }
            float se = 0.f;
#pragma unroll
            for (int j = 0; j < 4; ++j) se += __expf(gl[j] - gm);
            const float pg = __builtin_amdgcn_rcpf(se);
            float el[4];
#pragma unroll
            for (int j = 0; j < 4; ++j) {
                float v = 0.f;
#pragma unroll
                for (int q = 0; q < 4; ++q) v = (gi == q) ? lg[4 + q * 4 + j] : v;
                el[j] = v + P.in[I_BER][l * 16 + gi * 4 + j];
            }
            int i0 = 0; float v0 = el[0];
#pragma unroll
            for (int j = 1; j < 4; ++j) if (el[j] > v0) { v0 = el[j]; i0 = j; }
            int i1 = -1; float v1 = -INFINITY;
#pragma unroll
            for (int j = 0; j < 4; ++j) if (j != i0 && el[j] > v1) { v1 = el[j]; i1 = j; }
            const float w0 = __builtin_amdgcn_rcpf(1.0f + __expf(v1 - v0)), w1 = 1.0f - w0;
            const int e0 = gi * 4 + i0, e1 = gi * 4 + i1;
            const int slot = it * 8 + wid;
            rinfo[slot * 4 + 0] = e0 | (e1 << 8);
            rinfo[slot * 4 + 1] = __hip_atomic_fetch_add(&lcnt[e0], 1, __ATOMIC_RELAXED, __HIP_MEMORY_SCOPE_WORKGROUP);
            rinfo[slot * 4 + 2] = __hip_atomic_fetch_add(&lcnt[e1], 1, __ATOMIC_RELAXED, __HIP_MEMORY_SCOPE_WORKGROUP);
            rw[slot * 2] = w0 * pg; rw[slot * 2 + 1] = w1 * pg;
        }
    }
    __syncthreads();
    if (tid < 16) lbase[tid] = atomicAdd(&cnt[tid], lcnt[tid]);
    __syncthreads();
    for (int slot = tid; slot < 128; slot += NTHR) {
        const int r = r0 + (slot & 7) + (slot >> 3) * rstep;
        if (r < NR) { const int ee = rinfo[slot * 4], e0 = ee & 255, e1 = ee >> 8;
            sel_e[r * 2] = e0; sel_e[r * 2 + 1] = e1;
            sel_w[r * 2] = rw[slot * 2]; sel_w[r * 2 + 1] = rw[slot * 2 + 1];
            sel_p[r * 2] = lbase[e0] + rinfo[slot * 4 + 1]; sel_p[r * 2 + 1] = lbase[e1] + rinfo[slot * 4 + 2]; }
    }
    __syncthreads();
}
__device__ __forceinline__ void moe_offsets(const int* cnt, int (&off)[17]) {
    int a = 0;
#pragma unroll
    for (int e = 0; e < 16; ++e) { off[e] = a; a += (cnt[e] + 255) & ~255; }
    off[16] = a;
}
__device__ __forceinline__ void ph_scatter(const Params& P, int l) {
    const int tid = tid_(), lane = tid & 63, wid = tid >> 6;
    const int* cnt = (const int*)(P.ws + WS_CNT) + l * 16;
    int off[17]; moe_offsets(cnt, off);
    const bf16_t* f = (const bf16_t*)(P.ws + WS_H); bf16_t* Fs = (bf16_t*)(P.ws + WS_FS);
    const int* sel_e = (const int*)(P.ws + WS_SELE); const int* sel_p = (const int*)(P.ws + WS_SELP); int* srow = (int*)(P.ws + WS_SROW);
    for (int r = bid_() * 8 + wid; r < ((l == DEPTH - 1) ? NLAT : NTOK); r += gridDim.x * 8) {
        const uint4 a = *(const uint4*)(f + (size_t)r * D + lane * 8), b = *(const uint4*)(f + (size_t)r * D + 512 + lane * 8);
#pragma unroll
        for (int k = 0; k < 2; ++k) {
            const int e = sel_e[r * 2 + k];
            int o = 0;
#pragma unroll
            for (int q = 0; q < 16; ++q) o = (e == q) ? off[q] : o;
            const int d = o + sel_p[r * 2 + k];
            *(uint4*)(Fs + (size_t)d * D + lane * 8) = a; *(uint4*)(Fs + (size_t)d * D + 512 + lane * 8) = b;
            if (lane == 0) srow[r * 2 + k] = d;
        }
    }
}
struct SchedMoe { int NM, G, c; int tfirst[16]; const char* A; const char* W; size_t tA, eW, tW;
    __device__ __forceinline__ bool next(int i, pg8::Unit& u) const {
        const int L = i * G + c; if (L >= NM * 4) return false;
        const int pm = L >> 2, pn = L & 3;
        int e = 0;
#pragma unroll
        for (int q = 1; q < 16; ++q) e += (pm >= tfirst[q]) ? 1 : 0;
        u.row0 = pm * 256; u.col0 = pn * 256; u.aux = e; u.A = A + (size_t)pm * tA; u.B = W + (size_t)e * eW + (size_t)pn * tW; return true; } };
struct FSwiglu { bf16_t* H;
    __device__ __forceinline__ void operator()(const pg8::Unit&, int row, int col, const f32x4& v0, const f32x4& v1) const {
        const int hc = ((col & ~31) >> 1) + (col & 15);
        uint2 a; a.x = pk_bf16(siluf_(v0[0]) * v1[0], siluf_(v0[1]) * v1[1]); a.y = pk_bf16(siluf_(v0[2]) * v1[2], siluf_(v0[3]) * v1[3]);
        *(uint2*)(H + (size_t)row * EH + hc) = a; } };
__device__ __forceinline__ void moe_sched(const Params& P, int l, SchedMoe& S) {
    const int* cnt = (const int*)(P.ws + WS_CNT) + l * 16;
    int a = 0;
#pragma unroll
    for (int e = 0; e < 16; ++e) { S.tfirst[e] = a; a += (cnt[e] + 255) >> 8; }
    S.NM = a; S.G = (int)gridDim.x; S.c = bid_();
}
__device__ __forceinline__ void ph_moe1(const Params& P, LAS unsigned char* lds, int l) {
    SchedMoe S; moe_sched(P, l, S);
    S.A = (const char*)(P.ws + WS_FS); S.W = (const char*)(P.ws + WS_WGU); S.tA = (size_t)256 * D * 2; S.eW = (size_t)1024 * 1024 * 2; S.tW = (size_t)256 * 1024 * 2;
    pg8::EpiPair<FSwiglu> E{{(bf16_t*)(P.ws + WS_HS)}};
    pg8::gemm_phase(lds, pg8::Gemm{1024, 1024, 1024}, S, E);
}
__device__ __forceinline__ void ph_moe2(const Params& P, LAS unsigned char* lds, int l) {
    SchedMoe S; moe_sched(P, l, S);
    S.A = (const char*)(P.ws + WS_HS); S.W = (const char*)(P.ws + WS_WDN); S.tA = (size_t)256 * EH * 2; S.eW = (size_t)1024 * 512 * 2; S.tW = (size_t)256 * 512 * 2;
    EpiStore16 E{(bf16_t*)(P.ws + WS_YS), D};
    pg8::gemm_phase(lds, pg8::Gemm{512, 512, 512}, S, E);
}
__device__ __forceinline__ void ph_combine(const Params& P, int l, bool dry = false) {
    const int tid = tid_(), lane = tid & 63, wid = tid >> 6;
    float* xres = (float*)(P.ws + WS_X);
    const bf16_t* Ys = (const bf16_t*)(P.ws + WS_YS);
    const float* sel_w = (const float*)(P.ws + WS_SELW); const int* srow = (const int*)(P.ws + WS_SROW);
    bf16_t* h = (bf16_t*)(P.ws + (dry ? WS_END : WS_H));
    const bf16_t* dxb = (const bf16_t*)(P.ws + WS_BR);
    const int NR_ = (l == DEPTH - 1) ? NLAT : NTOK, rs_ = gridDim.x * 8;
    int rq = bid_() * 8 + wid;
    float nw0 = 0.f, nw1 = 0.f; int ns0 = 0, ns1 = 0;
    if (rq < NR_) { nw0 = sel_w[rq * 2]; nw1 = sel_w[rq * 2 + 1]; ns0 = srow[rq * 2]; ns1 = srow[rq * 2 + 1]; }
    float4 xn[4]; uint2 dn[4], an[4], bn[4]; float cw0 = 0.f, cw1 = 0.f;
    if (rq < NR_) {
        cw0 = nw0; cw1 = nw1;
#pragma unroll
        for (int i = 0; i < 4; ++i) { const int c = lane * 4 + 256 * i; xn[i] = *(const float4*)(xres + (size_t)rq * D + c); dn[i] = *(const uint2*)(dxb + (size_t)rq * D + c);
            an[i] = *(const uint2*)(Ys + (size_t)ns0 * D + c); bn[i] = *(const uint2*)(Ys + (size_t)ns1 * D + c); }
        if (rq + rs_ < NR_) { nw0 = sel_w[(rq + rs_) * 2]; nw1 = sel_w[(rq + rs_) * 2 + 1]; ns0 = srow[(rq + rs_) * 2]; ns1 = srow[(rq + rs_) * 2 + 1]; }
    }
    for (int r = rq; r < NR_; r += rs_) {
        const float* gate = (const float*)(P.ws + WS_MODS) + ((size_t)l * 9 + row_modrow(r)) * 6144 + 5 * 1024;
        const float w0 = cw0, w1 = cw1;
        float4 x[4]; uint2 dv_[4], a_[4], b_[4];
#pragma unroll
        for (int i = 0; i < 4; ++i) { x[i] = xn[i]; dv_[i] = dn[i]; a_[i] = an[i]; b_[i] = bn[i]; }
        if (r + rs_ < NR_) {
            cw0 = nw0; cw1 = nw1;
#pragma unroll
            for (int i = 0; i < 4; ++i) { const int c = lane * 4 + 256 * i; xn[i] = *(const float4*)(xres + (size_t)(r + rs_) * D + c); dn[i] = *(const uint2*)(dxb + (size_t)(r + rs_) * D + c);
                an[i] = *(const uint2*)(Ys + (size_t)ns0 * D + c); bn[i] = *(const uint2*)(Ys + (size_t)ns1 * D + c); }
            if (r + 2 * rs_ < NR_) { nw0 = sel_w[(r + 2 * rs_) * 2]; nw1 = sel_w[(r + 2 * rs_) * 2 + 1]; ns0 = srow[(r + 2 * rs_) * 2]; ns1 = srow[(r + 2 * rs_) * 2 + 1]; }
        }
#pragma unroll
        for (int i = 0; i < 4; ++i) {
            const int c = lane * 4 + 256 * i;
            x[i].x += bf_lo(dv_[i].x); x[i].y += bf_hi(dv_[i].x); x[i].z += bf_lo(dv_[i].y); x[i].w += bf_hi(dv_[i].y);
            const uint2 a = a_[i], b = b_[i];
            const float4 gv = *(const float4*)(gate + c);
            x[i].x += gv.x * (w0 * bf_lo(a.x) + w1 * bf_lo(b.x)); x[i].y += gv.y * (w0 * bf_hi(a.x) + w1 * bf_hi(b.x));
            x[i].z += gv.z * (w0 * bf_lo(a.y) + w1 * bf_lo(b.y)); x[i].w += gv.w * (w0 * bf_hi(a.y) + w1 * bf_hi(b.y));
        }
        if (l < DEPTH - 1) {
#pragma unroll
            for (int i = 0; i < 4; ++i) *(float4*)((dry ? (float*)(P.ws + WS_END) + (size_t)NTOK * 512 : xres) + (size_t)r * D + lane * 4 + 256 * i) = x[i];
            const float* mod = (const float*)(P.ws + WS_MODS) + ((size_t)(l + 1) * 9 + row_modrow(r)) * 6144;
            float4 o[4];
            norm_row(x, P.in[I_GMIX] + (l + 1) * 1024, mod, mod + 1024, lane, o);
#pragma unroll
            for (int i = 0; i < 4; ++i) { uint2 u; u.x = pk_bf16(o[i].x, o[i].y); u.y = pk_bf16(o[i].z, o[i].w); *(uint2*)(h + (size_t)r * D + lane * 4 + 256 * i) = u; }
        } else if (r < NLAT) {
            float ss = 0.f;
#pragma unroll
            for (int i = 0; i < 4; ++i) ss += x[i].x * x[i].x + x[i].y * x[i].y + x[i].z * x[i].z + x[i].w * x[i].w;
            ss = wave_sum(ss);
            const float rstd = __builtin_amdgcn_rsqf(ss * (1.0f / 1024.0f) + 1e-6f);
#pragma unroll
            for (int i = 0; i < 4; ++i) {
                const int c = lane * 4 + 256 * i;
                const float4 gv = *(const float4*)(P.in[I_GFIN] + c);
                float4 o; o.x = x[i].x * rstd * gv.x; o.y = x[i].y * rstd * gv.y; o.z = x[i].z * rstd * gv.z; o.w = x[i].w * rstd * gv.w;
                *(float4*)((dry ? (float*)(P.ws + WS_END) : P.out) + (size_t)r * D + c) = o;
            }
        }
    }
}

constexpr int NPH_LAYER = 12, NPH = 1 + DEPTH * NPH_LAYER;
#define CAS __attribute__((address_space(4)))
__device__ __forceinline__ const Params& kparams() { const CAS Params* k = (const CAS Params*)__builtin_amdgcn_kernarg_segment_ptr(); asm volatile("" : "+s"(k)); return *(const Params*)k; }
__global__ void __launch_bounds__(NTHR, 2) fwd(Params P_) {
    extern __shared__ __attribute__((aligned(16))) unsigned char lds_raw[];
    LAS unsigned char* lds = (LAS unsigned char*)lds_raw;
    volatile LAS unsigned* xbw = (volatile LAS unsigned*)(lds + LDS_BYTES - 16);
    if (threadIdx.x == 0) { xbw[0] = 0u; xbw[1] = 0u; xbw[2] = 0u; xbw[3] = 0u; }
    __syncthreads();
    const int lo = P_.ph_lo, hi = P_.ph_hi;
    XcdBarrier bar; bar.bar = (unsigned*)(P_.ws + WS_BAR); bar.x = 0; bar.st = xbw;
    if (hi - lo > 1) bar = xcd_barrier_post((unsigned*)(P_.ws + WS_BAR), xbw);
#ifndef PHMASK
#define PHMASK 0xFFFF
#endif
#define EN(j) ((PHMASK >> (j)) & 1)
#define IN(k) (lo <= (k) && (k) < hi)
#define SEAM(k) do { if (IN(k) && IN((k) + 1)) xcd_barrier(bar); } while (0)
    if (EN(12) && IN(0)) for (int rep = 0; rep < NREP(12); ++rep) { ph_prologue(kparams(), lds); }
    SEAM(0);
    for (int l = 0; l < DEPTH; ++l) {
        const int p0 = 1 + l * NPH_LAYER;
        if (l == 0) { if (EN(0) && IN(p0 + 0)) for (int rep = 0; rep < NREP(0); ++rep) { ph_wconv(kparams(), lds, l); ph_norm1(kparams(), l); }
        SEAM(p0 + 0); }
        if (EN(1) && IN(p0 + 1)) for (int rep = 0; rep < NREP(1); ++rep) ph_g1(kparams(), lds);
        SEAM(p0 + 1);
        if (EN(2) && IN(p0 + 2)) for (int rep = 0; rep < NREP(2); ++rep) { ph_prep(kparams(), l); ph_navt(kparams(), lds); }
        SEAM(p0 + 2);
        if (EN(3) && IN(p0 + 3)) { ph_mix(kparams(), lds, (char*)lds_raw, l);
            if (REPEAT_MASK & 0x8) { xcd_barrier(bar); ph_mix(kparams(), lds, (char*)lds_raw, l, 1, 0); }
            if (REPEAT_MASK & 0x2000) { xcd_barrier(bar); ph_mix(kparams(), lds, (char*)lds_raw, l, 1, 1); }
            if (REPEAT_MASK & 0x4000) { xcd_barrier(bar); ph_mix(kparams(), lds, (char*)lds_raw, l, 1, 2); }
            if (REPEAT_MASK & 0x8000) { xcd_barrier(bar); ph_mix(kparams(), lds, (char*)lds_raw, l, 1, 3); } }
        SEAM(p0 + 3);
        if (EN(4) && IN(p0 + 4)) for (int rep = 0; rep < NREP(4); ++rep) {
#if defined(DIAG) && DIAG == 5
            { const Params& Pq = kparams(); const int G_ = gridDim.x, c_ = bid_(), vcu_ = (c_ % 8) * (G_ / 8) + c_ / 8; for (int u = vcu_; u < 320; u += G_) na_unit(Pq, lds, l, u, (bf16_t*)(Pq.ws + WS_BR), BRW); __syncthreads(); }
#endif
            ph_readout(kparams(), l);
#if defined(DIAG) && (DIAG == 1 || DIAG == 4)
            ph_diag_cmp(kparams());
#endif
#if defined(DIAG) && DIAG == 3
            { const Params& Pq = kparams(); const uint4* d1 = (const uint4*)(Pq.ws + WS_END); bf16_t* brq = (bf16_t*)(Pq.ws + WS_BR);
              for (size_t i = (size_t)bid_() * NTHR + tid_(); i < (size_t)NTOK * 64; i += (size_t)gridDim.x * NTHR) { const size_t r = i >> 6; const int c8 = (int)(i & 63) * 8; *(uint4*)(brq + r * BRW + c8) = d1[i]; } }
#endif
        }
        SEAM(p0 + 4);
        if (EN(5) && IN(p0 + 5)) for (int rep = 0; rep < NREP(5); ++rep) ph_merge(kparams(), lds, l);
        SEAM(p0 + 5);
        if (EN(6) && IN(p0 + 6)) for (int rep = 0; rep < NREP(6); ++rep) ph_wout(kparams(), lds, l, rep > 0);
        SEAM(p0 + 6);
        if (EN(7) && IN(p0 + 7)) for (int rep = 0; rep < NREP(7); ++rep) ph_norm2_route(kparams(), lds, l, rep > 0);
        SEAM(p0 + 7);
        if (EN(8) && IN(p0 + 8)) for (int rep = 0; rep < NREP(8); ++rep) ph_scatter(kparams(), l);
        SEAM(p0 + 8);
        if (EN(9) && IN(p0 + 9)) for (int rep = 0; rep < NREP(9); ++rep) ph_moe1(kparams(), lds, l);
        SEAM(p0 + 9);
        if (EN(10) && IN(p0 + 10)) for (int rep = 0; rep < NREP(10); ++rep) ph_moe2(kparams(), lds, l);
        SEAM(p0 + 10);
        if (EN(11) && IN(p0 + 11)) for (int rep = 0; rep < NREP(11); ++rep) { ph_combine(kparams(), l, rep > 0); if (l + 1 < DEPTH) wconv_range(kparams(), lds, l + 1, 16 * 124, CONV_T_DENSE, bid_(), gridDim.x); }
        if (l + 1 < DEPTH) { if (IN(p0 + 11) && IN(p0 + 13)) xcd_barrier(bar); }
    }
#if defined(DIAG) && (DIAG == 1 || DIAG == 4)
    xcd_barrier(bar); ph_diag_out(kparams());
#endif
#undef IN
#undef SEAM
}

#ifndef MK_PER_PHASE
#define MK_PER_PHASE 0
#endif
extern "C" void kernel_launch(void* const* d_in, const int* in_sizes, int n_in, void* d_out, int out_size, void* d_ws, size_t ws_size, hipStream_t stream) {
    static int grid = 0;
    if (grid == 0) {
        if (n_in != 24 || out_size != NLAT * D || ws_size < WS_END + (size_t)NTOK * 4096 + 4096) { fprintf(stderr, "kernel_launch: unexpected shapes (n_in %d out %d ws %zu need %zu)\n", n_in, out_size, ws_size, (size_t)WS_END); grid = -1; return; }
        int dev = 0, cus = 0, per_cu = 0;
        if (hipGetDevice(&dev) != hipSuccess || hipDeviceGetAttribute(&cus, hipDeviceAttributeMultiprocessorCount, dev) != hipSuccess) { grid = -1; return; }
        if (hipFuncSetAttribute((const void*)fwd, hipFuncAttributeMaxDynamicSharedMemorySize, LDS_BYTES) != hipSuccess) { fprintf(stderr, "kernel_launch: hipFuncSetAttribute failed\n"); grid = -1; return; }
        if (hipOccupancyMaxActiveBlocksPerMultiprocessor(&per_cu, (const void*)fwd, NTHR, LDS_BYTES) != hipSuccess || per_cu < 1) { fprintf(stderr, "kernel_launch: occupancy query says %d\n", per_cu); }
        (void)hipGetLastError();
        grid = cus;
    }
    if (grid < 0) return;
    (void)hipMemsetAsync(d_ws, 0, WS_ZERO_BYTES, stream);
    Params p{};
    for (int i = 0; i < 24; ++i) p.in[i] = (const float*)d_in[i];
    p.out = (float*)d_out; p.ws = (unsigned char*)d_ws;
#if MK_PER_PHASE
    for (int ph = 0; ph < NPH; ++ph) { p.ph_lo = ph; p.ph_hi = ph + 1; hipLaunchKernelGGL(fwd, dim3(grid), dim3(NTHR), LDS_BYTES, stream, p); }
#else
    p.ph_lo = 0; p.ph_hi = NPH; hipLaunchKernelGGL(fwd, dim3(grid), dim3(NTHR), LDS_BYTES, stream, p);
#endif
}
```

```cpp
#include <hip/hip_runtime.h>
#include <cstdio>
#include <cstdint>

#define LAS __attribute__((address_space(3)))
typedef unsigned short bf16_t;
typedef short bf16x8 __attribute__((ext_vector_type(8)));
typedef float f32x4 __attribute__((ext_vector_type(4)));
typedef unsigned u32x4 __attribute__((ext_vector_type(4)));

constexpr int D = 1024, NB = 8, SEQ = 2048, DEPTH = 4, CTXL = 256;
constexpr int NLAT = NB * SEQ, NCTX = NB * CTXL, NTOK = NLAT + NCTX;
constexpr int INC = 7936;
constexpr int ZP = 4864;
constexpr int C_NAQ = 0, C_NAK = 512, C_NAV = 1024, C_HQ = 1536, C_HFF = 2048, C_HFB = 2560, C_HI = 3072, C_HG = 3584,
              C_GQ = 4096, C_GK = 4608, C_GV = 4736, C_GATE = 4864;
constexpr int BRW = 1536;
constexpr int NEXP = 16, EH = 512;
constexpr int MPAD = 40960;
constexpr int NTHR = 512;
constexpr int LDS_BYTES = 147456;

constexpr size_t WS_BAR = 0;
constexpr size_t WS_CNT = 16384;
constexpr size_t WS_ZERO_BYTES = 65536;
constexpr size_t WS_MODS = 65536;
constexpr size_t WS_LB = WS_MODS + 884736;
constexpr size_t WS_ROPE = WS_LB + 16384;
constexpr size_t WS_SELE = WS_ROPE + 12288;
constexpr size_t WS_SELW = WS_SELE + 147456;
constexpr size_t WS_SELP = WS_SELW + 147456;
constexpr size_t WS_SROW = WS_SELP + 147456;
constexpr size_t WS_X = 2097152;
constexpr size_t WS_H = WS_X + (size_t)NTOK * D * 4;
constexpr size_t WS_Z = WS_H + (size_t)NTOK * D * 2;
constexpr size_t WS_GT = WS_Z + (size_t)NTOK * ZP * 2;
constexpr size_t WS_BR = WS_GT + (size_t)NTOK * 3072 * 2;
constexpr size_t WS_Y = WS_BR + (size_t)NTOK * BRW * 2;
constexpr size_t WS_QN = WS_Y + (size_t)NTOK * D * 2;
constexpr size_t WS_KN = WS_QN + (size_t)NTOK * 512 * 2;
constexpr size_t WS_VN = WS_KN + (size_t)NTOK * 128 * 2;
constexpr size_t WS_NAVT = WS_VN + (size_t)NTOK * 128 * 2;
constexpr size_t WS_WIN = WS_NAVT + (size_t)NTOK * 512 * 2;
constexpr size_t WS_WBR = WS_WIN + (size_t)INC * D * 2;
constexpr size_t WS_WOUT = WS_WBR + (size_t)3 * D * 512 * 2;
constexpr size_t WS_WGU = WS_WOUT + (size_t)D * D * 2;
constexpr size_t WS_WDN = WS_WGU + (size_t)NEXP * 1024 * 1024 * 2;
constexpr size_t WS_PG = WS_WDN + (size_t)NEXP * 1024 * 512 * 2;
constexpr size_t WS_INV = WS_PG + (size_t)96 * 65536 * 2;
constexpr size_t WS_END = WS_INV + (size_t)16 * NTOK * 4;
constexpr size_t WS_FS = WS_Z;
constexpr size_t WS_HS = WS_FS + (size_t)MPAD * 1024 * 2;
constexpr size_t WS_YS = WS_HS + (size_t)MPAD * 512 * 2;
static_assert(WS_YS + (size_t)MPAD * 1024 * 2 <= WS_BR, "moe alias");
constexpr size_t WS_RT = WS_SROW + 147456;
static_assert(WS_RT + 327680 <= WS_X, "ctl");

#define XB_TMO      128
#define XB_XCNT(j)  (256  + 64 * (j))
#define XB_XSUB(j)  (1280 + 64 * (j))
#define XB_XGEN(j)  (2304 + 64 * (j))
#define XB_TOP      3328
#define XB_TOPGEN   3392
#define XCD_BAR_WORDS 3456
#define XB_SPIN_CAP (1u << 22)
__device__ __forceinline__ unsigned xb_ld(unsigned* p)              { return __hip_atomic_load(p, __ATOMIC_RELAXED, __HIP_MEMORY_SCOPE_AGENT); }
__device__ __forceinline__ unsigned xb_add(unsigned* p, unsigned v) { return __hip_atomic_fetch_add(p, v, __ATOMIC_RELAXED, __HIP_MEMORY_SCOPE_AGENT); }
__device__ __forceinline__ unsigned xb_xcc_id() { return (unsigned)__builtin_amdgcn_s_getreg((3 << 11) | 20) & 0xFu; }
#define XB_SPIN(cond, bar) do { unsigned _sp = 0; while (cond) { __builtin_amdgcn_s_sleep(1); \
    if ((++_sp & 255u) == 0u) { if (xb_ld(&(bar)[XB_TMO])) break; if (_sp > XB_SPIN_CAP) { atomicAdd(&(bar)[XB_TMO], 1u); break; } } } } while (0)
struct XcdBarrier { unsigned* bar; unsigned x; volatile LAS unsigned* st; };
__device__ __forceinline__ XcdBarrier xcd_barrier_post(unsigned* bar, volatile LAS unsigned* st) {
    XcdBarrier b; b.bar = bar; b.x = xb_xcc_id(); b.st = st;
    if (threadIdx.x == 0) (void)xb_add(&bar[XB_XCNT(b.x)], 1u);
    return b;
}
__device__ __forceinline__ void xcd_barrier_complete(unsigned* bar, unsigned x, unsigned& nloc, unsigned& nx) {
    const unsigned G = gridDim.x * gridDim.y * gridDim.z;
    unsigned sum, cnt, mine, sp = 0u;
    for (;;) {
        sum = 0u; cnt = 0u; mine = 0u;
#pragma unroll
        for (unsigned j = 0; j < 16; ++j) { const unsigned c = xb_ld(&bar[XB_XCNT(j)]); sum += c; cnt += (c > 0u) ? 1u : 0u; mine = (j == x) ? c : mine; }
        if (sum == G) break;
        __builtin_amdgcn_s_sleep(1);
        if ((++sp & 255u) == 0u) { if (xb_ld(&bar[XB_TMO])) break; if (sp > XB_SPIN_CAP) { atomicAdd(&bar[XB_TMO], 1u); break; } }
    }
    nloc = mine > 0u ? mine : 1u; nx = cnt > 0u ? cnt : 1u;
}
__device__ __forceinline__ void xcd_barrier(const XcdBarrier& b) {
    asm volatile("s_waitcnt vmcnt(0)" ::: "memory");
    __syncthreads();
    if (threadIdx.x == 0) {
        unsigned* bar = b.bar;
        __builtin_amdgcn_s_waitcnt(0);
        unsigned nloc = b.st[0], nx = b.st[1];
        if (nloc == 0u) { xcd_barrier_complete(bar, b.x, nloc, nx); b.st[0] = nloc; b.st[1] = nx; }
        const unsigned old = xb_add(&bar[XB_XSUB(b.x)], 1u);
        const unsigned gen = old / nloc;
        if (old + 1u == (gen + 1u) * nloc) {
            __builtin_amdgcn_fence(__ATOMIC_RELEASE, "agent");
            asm volatile("s_waitcnt vmcnt(0)" ::: "memory");
            const unsigned og = xb_add(&bar[XB_TOP], 1u);
            const unsigned tg = og / nx;
            if (og + 1u == (tg + 1u) * nx) xb_add(&bar[XB_TOPGEN], 1u);
            else XB_SPIN(xb_ld(&bar[XB_TOPGEN]) == tg, bar);
            __builtin_amdgcn_fence(__ATOMIC_ACQUIRE, "agent");
            xb_add(&bar[XB_XGEN(b.x)], 1u);
            asm volatile("s_waitcnt vmcnt(0)" ::: "memory");
        } else {
            XB_SPIN(xb_ld(&bar[XB_XGEN(b.x)]) == gen, bar);
            __builtin_amdgcn_fence(__ATOMIC_ACQUIRE, "agent");
            asm volatile("s_waitcnt vmcnt(0)" ::: "memory");
        }
    }
    __syncthreads();
}

__device__ __forceinline__ float bf_lo(unsigned u) { return __uint_as_float(u << 16); }
__device__ __forceinline__ float bf_hi(unsigned u) { return __uint_as_float(u & 0xffff0000u); }
__device__ __forceinline__ float bf2f(bf16_t b) { return __uint_as_float(((unsigned)b) << 16); }
typedef float pkf32x2_t __attribute__((ext_vector_type(2))); typedef __bf16 pkbf16x2_t __attribute__((ext_vector_type(2)));
__device__ __forceinline__ unsigned pk_bf16(float lo, float hi) { pkf32x2_t v = {lo, hi}; pkbf16x2_t b = __builtin_convertvector(v, pkbf16x2_t); return __builtin_bit_cast(unsigned, b); }
__device__ __forceinline__ bf16x8 pack8(const float (&v)[8]) { u32x4 u = {pk_bf16(v[0], v[1]), pk_bf16(v[2], v[3]), pk_bf16(v[4], v[5]), pk_bf16(v[6], v[7])}; return __builtin_bit_cast(bf16x8, u); }
__device__ __forceinline__ float sigmoidf_(float x) { return __builtin_amdgcn_rcpf(1.0f + __expf(-x)); }
__device__ __forceinline__ float siluf_(float x) { return x * __builtin_amdgcn_rcpf(1.0f + __expf(-x)); }
__device__ __forceinline__ float dpp_f(float v, const int ctrl_sel) {
    const int x = __float_as_int(v);
    int r;
    if (ctrl_sel == 0) r = __builtin_amdgcn_update_dpp(0, x, 0xB1, 0xF, 0xF, true);
    else if (ctrl_sel == 1) r = __builtin_amdgcn_update_dpp(0, x, 0x4E, 0xF, 0xF, true);
    else if (ctrl_sel == 2) r = __builtin_amdgcn_update_dpp(0, x, 0x141, 0xF, 0xF, true);
    else r = __builtin_amdgcn_update_dpp(0, x, 0x140, 0xF, 0xF, true);
    return __int_as_float(r);
}
__device__ __forceinline__ float wave_sum(float v) {
    v += dpp_f(v, 0); v += dpp_f(v, 1); v += dpp_f(v, 2); v += dpp_f(v, 3);
    { auto rr = __builtin_amdgcn_permlane16_swap(__float_as_uint(v), __float_as_uint(v), false, false); v = __uint_as_float(rr[0]) + __uint_as_float(rr[1]); }
    { auto rr = __builtin_amdgcn_permlane32_swap(__float_as_uint(v), __float_as_uint(v), false, false); v = __uint_as_float(rr[0]) + __uint_as_float(rr[1]); }
    return v;
}

__device__ __forceinline__ int tid_() { int t = threadIdx.x; asm volatile("" : "+v"(t)); return t; }
__device__ __forceinline__ int bid_() { int t = blockIdx.x; asm volatile("" : "+s"(t)); return t; }
#ifndef REPEAT_MASK
#define REPEAT_MASK 0
#endif
#define NREP(j) (((REPEAT_MASK >> (j)) & 1) ? 2 : 1)
struct Params {
    const float* in[24];
    float* out;
    unsigned char* ws;
    int ph_lo, ph_hi;
};
enum { I_X = 0, I_C, I_CTX, I_CCTX, I_WADA, I_BADA, I_GMIX, I_GFFN, I_WIN, I_RPB, I_LBL, I_HGN, I_QNG, I_KNG, I_WBR, I_WOUT,
       I_WGR, I_BGR, I_WER, I_BER, I_WEG, I_WEU, I_WED, I_GFIN };

__device__ __forceinline__ void g128_kloop(f32x4 (&acc)[4][4], LAS unsigned char* lds, const bf16_t* A, int lda, const bf16_t* Bt, int ldb, int K) {
    const int tid = tid_(), wid = tid >> 6, lane = tid & 63, wr = wid >> 2, wc = wid & 3, fr = lane & 15, fq = lane >> 4;
    LAS unsigned char* SA = lds; LAS unsigned char* SB = lds + 8192;
    const int srow = tid >> 2, skc = (tid & 3) * 8;
    const bf16_t* ap = A + (size_t)srow * lda + skc;
    const bf16_t* bp0 = Bt + (size_t)srow * ldb + skc;
    const bf16_t* bp1 = Bt + (size_t)(srow + 128) * ldb + skc;
    for (int k0 = 0; k0 < K; k0 += 32) {
        const uint4 va = *(const uint4*)(ap + k0);
        const uint4 vb0 = *(const uint4*)(bp0 + k0);
        const uint4 vb1 = *(const uint4*)(bp1 + k0);
        __syncthreads();
        *(LAS u32x4*)(SA + tid * 16) = (u32x4){va.x, va.y, va.z, va.w};
        *(LAS u32x4*)(SB + tid * 16) = (u32x4){vb0.x, vb0.y, vb0.z, vb0.w};
        *(LAS u32x4*)(SB + 8192 + tid * 16) = (u32x4){vb1.x, vb1.y, vb1.z, vb1.w};
        __syncthreads();
        bf16x8 At[4], Bf[4];
#pragma unroll
        for (int m = 0; m < 4; ++m) At[m] = *(const LAS bf16x8*)(SA + ((wr * 64 + m * 16 + fr) * 32 + fq * 8) * 2);
#pragma unroll
        for (int n = 0; n < 4; ++n) Bf[n] = *(const LAS bf16x8*)(SB + ((wc * 64 + n * 16 + fr) * 32 + fq * 8) * 2);
#pragma unroll
        for (int m = 0; m < 4; ++m)
#pragma unroll
            for (int n = 0; n < 4; ++n) acc[m][n] = __builtin_amdgcn_mfma_f32_16x16x32_bf16(Bf[n], At[m], acc[m][n], 0, 0, 0);
    }
}
__device__ __forceinline__ void acc_zero(f32x4 (&acc)[4][4]) {
#pragma unroll
    for (int m = 0; m < 4; ++m)
#pragma unroll
        for (int n = 0; n < 4; ++n) acc[m][n] = (f32x4){0.f, 0.f, 0.f, 0.f};
}
template <class Epi>
__device__ __forceinline__ void g128_epilogue(const f32x4 (&acc)[4][4], int row0, int col0, const Epi& E) {
    const int tid = tid_(), wid = tid >> 6, lane = tid & 63, wr = wid >> 2, wc = wid & 3, fr = lane & 15, fq = lane >> 4;
#pragma unroll
    for (int m = 0; m < 4; ++m)
#pragma unroll
        for (int n = 0; n < 4; n += 2) E(row0 + wr * 64 + m * 16 + fr, col0 + wc * 64 + n * 16 + fq * 4, acc[m][n], acc[m][n + 1]);
}


namespace pg8 {
constexpr int BM = 256, BK = 64, HALF = 128, HTB = HALF * BK * 2, STAGE_BYTES = 8 * HTB;
__device__ __forceinline__ int lds_byte(int r, int c) { const int st = (r >> 4) * 2 + (c >> 5), rr = r & 15, cc = c & 31, ob = rr * 64 + cc * 2; return st * 1024 + (ob ^ (((ob >> 9) & 1) << 5)); }
__device__ __forceinline__ void stage_rc(int b, int& R, int& C) { const int st = b / 1024, sb = b % 1024, swz = sb ^ (((sb >> 9) & 1) << 5); R = (st >> 1) * 16 + swz / 64; C = (st & 1) * 32 + (swz % 64) / 2; }
struct Unit { int row0, col0, aux; const char* A; const char* B; };
struct Gemm { int K, lda, ldb; };
template <class Epi, class Sched, bool GATHER = false>
__device__ __forceinline__ void gemm_phase(LAS unsigned char* lds, const Gemm g, const Sched& S, const Epi& E) {
    const int tid = tid_(), wid = __builtin_amdgcn_readfirstlane(tid >> 6), lane = tid & 63, wr = wid >> 2, wc = wid & 3, fr = lane & 15, fq = lane >> 4;
    const int K = g.K, nt = K / BK;
    unsigned voffA[2], voffB[2];
#pragma unroll
    for (int i = 0; i < 2; ++i) { int R, C; stage_rc(tid * 16 + i * 8192, R, C);
        voffA[i] = (unsigned)(R * g.lda + C) * 2u; voffB[i] = (unsigned)(R * g.ldb + C) * 2u; }
    const size_t kstep = (size_t)(BK * 2);
    const size_t hstepA = (size_t)HALF * g.lda * 2, hstepB = (size_t)HALF * g.ldb * 2;
    const unsigned ldsw = (unsigned)wid * 1024u;
    const int aoff = lds_byte(wr * 64 + fr, fq * 8), boff = lds_byte(wc * 32 + fr, fq * 8);
#define PG8_SA(b, h) (((b) * 2 + (h)) * HTB)
#define PG8_SB(b, h) ((4 + (b) * 2 + (h)) * HTB)
#define PG8_STAGE(bufoff, gbase, voff) do { _Pragma("unroll") for (int _i = 0; _i < 2; ++_i) \
        __builtin_amdgcn_global_load_lds((const unsigned*)((const char*)(gbase) + (voff)[_i]), (LAS unsigned*)(lds + (bufoff) + ldsw + _i * 8192), 16, 0, 0); } while (0)
#define PG8_STAGE_A(b, h, ptr, nx) do { if constexpr (GATHER) { const unsigned gsel_[2] = {(nx) ? ngv[h][0] : cgv[h][0], (nx) ? ngv[h][1] : cgv[h][1]}; PG8_STAGE(PG8_SA(b, h), (ptr), gsel_); } \
        else { PG8_STAGE(PG8_SA(b, h), (ptr) + ((h) ? hstepA : 0), voffA); } } while (0)
#define PG8_LDA(dst, b, h) do { _Pragma("unroll") for (int m = 0; m < 4; ++m) _Pragma("unroll") for (int k = 0; k < 2; ++k) dst[m][k] = *(const LAS bf16x8*)(lds + PG8_SA(b, h) + aoff + m * 2048 + k * 1024); } while (0)
#define PG8_LDB(dst, b, h) do { _Pragma("unroll") for (int n = 0; n < 2; ++n) _Pragma("unroll") for (int k = 0; k < 2; ++k) dst[n][k] = *(const LAS bf16x8*)(lds + PG8_SB(b, h) + boff + n * 2048 + k * 1024); } while (0)
#define PG8_MMA(ai, bj, At, Bt) do { __builtin_amdgcn_s_setprio(1); _Pragma("unroll") for (int m = 0; m < 4; ++m) _Pragma("unroll") for (int n = 0; n < 2; ++n) _Pragma("unroll") for (int k = 0; k < 2; ++k) \
        acc[ai][bj][m][n] = __builtin_amdgcn_mfma_f32_16x16x32_bf16(Bt[n][k], At[m][k], acc[ai][bj][m][n], 0, 0, 0); __builtin_amdgcn_s_setprio(0); } while (0)
#define PG8_WAIT_V(n) asm volatile("s_waitcnt vmcnt(" #n ")" ::: "memory")
#define PG8_WAIT_L(n) asm volatile("s_waitcnt lgkmcnt(" #n ")" ::: "memory")
#define PG8_BAR __builtin_amdgcn_s_barrier()
#define PG8_SCHED __builtin_amdgcn_sched_barrier(0)
    Unit cur, nxt; int ui = 0;
    if (!S.next(0, cur)) return;
    f32x4 acc[2][2][4][2];
#pragma unroll
    for (int a = 0; a < 2; ++a)
#pragma unroll
        for (int b = 0; b < 2; ++b)
#pragma unroll
            for (int m = 0; m < 4; ++m)
#pragma unroll
                for (int n = 0; n < 2; ++n) acc[a][b][m][n] = (f32x4){0.f, 0.f, 0.f, 0.f};
    bf16x8 At[4][2], B0[2][2], B1[2][2];
    const char* cA = cur.A; const char* cB = cur.B;
    unsigned cgv[2][2] = {{0u, 0u}, {0u, 0u}}, ngv[2][2] = {{0u, 0u}, {0u, 0u}};
    if constexpr (GATHER) S.gather(cur, cgv);
    PG8_STAGE(PG8_SB(0, 0), cB, voffB); PG8_STAGE(PG8_SB(0, 1), cB + hstepB, voffB); PG8_STAGE_A(0, 0, cA, false); PG8_STAGE_A(0, 1, cA, false);
    if (wr == 1) PG8_BAR;
    PG8_WAIT_V(2); PG8_BAR;
    PG8_STAGE(PG8_SB(1, 0), cB + kstep, voffB); PG8_STAGE_A(1, 0, cA + kstep, false); PG8_STAGE(PG8_SB(1, 1), cB + hstepB + kstep, voffB);
    PG8_WAIT_V(6); PG8_BAR;
    for (;;) {
        const bool has_next = S.next(ui + 1, nxt);
        const char* nA = has_next ? nxt.A : cA; const char* nB = has_next ? nxt.B : cB;
        if constexpr (GATHER) {
            if (has_next) S.gather(nxt, ngv);
            else {
#pragma unroll
                for (int h_ = 0; h_ < 2; ++h_)
#pragma unroll
                    for (int i_ = 0; i_ < 2; ++i_) ngv[h_][i_] = cgv[h_][i_]; } }
        for (int t = 0; t < nt; t += 2) {
            const bool last = (t == nt - 2);
            const char* a1 = cA + (size_t)(t + 1) * kstep;
            const char* a2 = last ? nA : cA + (size_t)(t + 2) * kstep; const char* b2 = last ? nB : cB + (size_t)(t + 2) * kstep;
            const char* a3 = a2 + kstep; const char* b3 = b2 + kstep;
            PG8_LDB(B0, 0, 0); PG8_LDB(B1, 0, 1); PG8_SCHED; PG8_LDA(At, 0, 0); PG8_STAGE_A(1, 1, a1, false);
            PG8_WAIT_V(8); PG8_WAIT_L(0); PG8_BAR; PG8_MMA(0, 0, At, B0); PG8_MMA(0, 1, At, B1); PG8_BAR; PG8_SCHED;
            PG8_LDA(At, 0, 1); PG8_STAGE(PG8_SB(0, 0), b2, voffB); PG8_STAGE(PG8_SB(0, 1), b2 + hstepB, voffB); PG8_STAGE_A(0, 0, a2, last);
            PG8_WAIT_V(8); PG8_WAIT_L(0); PG8_BAR; PG8_MMA(1, 0, At, B0); PG8_MMA(1, 1, At, B1); PG8_BAR; PG8_SCHED;
            PG8_LDB(B0, 1, 0); PG8_LDB(B1, 1, 1); PG8_SCHED; PG8_LDA(At, 1, 0); PG8_STAGE_A(0, 1, a2, last);
            PG8_WAIT_V(8); PG8_WAIT_L(0); PG8_BAR; PG8_MMA(0, 0, At, B0); PG8_MMA(0, 1, At, B1); PG8_BAR; PG8_SCHED;
            PG8_LDA(At, 1, 1); PG8_STAGE(PG8_SB(1, 0), b3, voffB); PG8_STAGE(PG8_SB(1, 1), b3 + hstepB, voffB); PG8_STAGE_A(1, 0, a3, last);
            PG8_WAIT_V(8); PG8_WAIT_L(0); PG8_BAR; PG8_MMA(1, 0, At, B0); PG8_MMA(1, 1, At, B1); PG8_BAR; PG8_SCHED;
        }
        if (wr == 0) PG8_BAR;
        E(acc, cur, wr, wc, fr, fq);
        if (!has_next) break;
#pragma unroll
        for (int a = 0; a < 2; ++a)
#pragma unroll
            for (int b = 0; b < 2; ++b)
#pragma unroll
                for (int m = 0; m < 4; ++m)
#pragma unroll
                    for (int n = 0; n < 2; ++n) acc[a][b][m][n] = (f32x4){0.f, 0.f, 0.f, 0.f};
        cur = nxt; cA = nA; cB = nB; ++ui;
        if constexpr (GATHER) {
#pragma unroll
            for (int h_ = 0; h_ < 2; ++h_)
#pragma unroll
                for (int i_ = 0; i_ < 2; ++i_) cgv[h_][i_] = ngv[h_][i_]; }
        if (wr == 1) PG8_BAR;
    }
    PG8_WAIT_V(0);
    PG8_BAR;
#undef PG8_SA
#undef PG8_SB
#undef PG8_STAGE
#undef PG8_STAGE_A
#undef PG8_LDA
#undef PG8_LDB
#undef PG8_MMA
#undef PG8_WAIT_V
#undef PG8_WAIT_L
#undef PG8_BAR
#undef PG8_SCHED
}
template <class F> struct EpiPair { F f;
    __device__ __forceinline__ void operator()(const f32x4 (&acc)[2][2][4][2], const Unit& u, int wr, int wc, int fr, int fq) const {
#pragma unroll
        for (int ai = 0; ai < 2; ++ai)
#pragma unroll
            for (int m = 0; m < 4; ++m)
#pragma unroll
                for (int bj = 0; bj < 2; ++bj) f(u, u.row0 + ai * HALF + wr * 64 + m * 16 + fr, u.col0 + bj * HALF + wc * 32 + 4 * fq, acc[ai][bj][m][0], acc[ai][bj][m][1]);
    } };
struct SchedDense { int nM, nN, G, c; const char* A; const char* B; size_t tA, tB;
    __device__ __forceinline__ bool next(int i, Unit& u) const {
        const int nwg = nM * nN; const long L = (long)i * G + c; if (L >= nwg) return false;
        int wgid = (int)L; { const int q = nwg / 8, r = nwg % 8, xcd = wgid % 8, off = wgid / 8; wgid = (xcd < r ? xcd * (q + 1) : r * (q + 1) + (xcd - r) * q) + off; }
        const int nig = 8 * nN, gid = wgid / nig, fm = gid * 8, gsz = (nM - fm) < 8 ? (nM - fm) : 8;
        const int pm = fm + ((wgid % nig) % gsz), pn = (wgid % nig) / gsz;
        u.row0 = pm * 256; u.col0 = pn * 256; u.aux = 0; u.A = A + (size_t)pm * tA; u.B = B + (size_t)pn * tB; return true; } };
}


namespace gqa {
using f32x16 = __attribute__((ext_vector_type(16))) float;
using s16x4 = __attribute__((ext_vector_type(4))) short;
constexpr int QP = 512, KVP = 128, OP = BRW;
constexpr int NW = 8, QBLK = 32, KVBLK = 64;
__device__ __forceinline__ int crow(int r, int hi) { return (r & 3) + 8 * (r >> 2) + 4 * hi; }
#define SBAR() __builtin_amdgcn_sched_barrier(0)
constexpr int NSLOT = 3, SLOTB = 8192;
constexpr int LDS_K = 0, LDS_V = NSLOT * SLOTB, LDS_WS = 2 * NSLOT * SLOTB, LDS_OST = LDS_WS + NW * 64 * 4, LDS_BYTES_ = LDS_OST + NW * 4096;
__device__ __forceinline__ void glds16(const void* gsrc, unsigned lds_dst) { unsigned keep;
  asm volatile("s_mov_b32 %0, m0\n\ts_mov_b32 m0, %2\n\ts_nop 0\n\tglobal_load_lds_dwordx4 %1, off\n\ts_mov_b32 m0, %0" : "=&s"(keep) : "v"(gsrc), "s"(lds_dst) : "memory"); }
__device__ __forceinline__ float max3f(float a, float b, float c) { float r; asm("v_max3_f32 %0, %1, %2, %3" : "=v"(r) : "v"(a), "v"(b), "v"(c)); return r; }
__device__ __forceinline__ float max2f(float a, float b) { float r; asm("v_max_f32_e32 %0, %1, %2" : "=v"(r) : "v"(a), "v"(b)); return r; }
__device__ __forceinline__ float fadd_s(float a, float b) { float r; asm("v_add_f32_e32 %0, %1, %2" : "=v"(r) : "v"(a), "v"(b)); return r; }
__device__ __forceinline__ float fsub_s(float a, float b) { float r; asm("v_sub_f32_e32 %0, %1, %2" : "=v"(r) : "v"(a), "v"(b)); return r; }
typedef float f32x2_t __attribute__((ext_vector_type(2))); typedef __bf16 bf16x2_t __attribute__((ext_vector_type(2)));
__device__ __forceinline__ unsigned cvtpk_s(float lo, float hi) { f32x2_t v = {lo, hi}; bf16x2_t b = __builtin_convertvector(v, bf16x2_t); return __builtin_bit_cast(unsigned, b); }
#define WAIT_BAR(N) asm volatile("s_waitcnt vmcnt(" #N ") lgkmcnt(0)\n\ts_barrier" ::: "memory")
__device__ __forceinline__ void qkt(f32x16& p0, f32x16& p1, const char* Kslot, const bf16x8* qr, const f32x16& negm, int r32, int hi) {
  const char* kb = Kslot + hi * 1024 + r32 * 16;
  #pragma unroll
  for (int d0 = 0; d0 < 4; ++d0) {
    const bf16x8 b0 = *reinterpret_cast<const bf16x8*>(kb + d0 * 2048);
    const bf16x8 b1 = *reinterpret_cast<const bf16x8*>(kb + d0 * 2048 + 512);
    if (d0 == 0) { p0 = __builtin_amdgcn_mfma_f32_32x32x16_bf16(b0, qr[0], negm, 0, 0, 0); p1 = __builtin_amdgcn_mfma_f32_32x32x16_bf16(b1, qr[0], negm, 0, 0, 0); }
    else { p0 = __builtin_amdgcn_mfma_f32_32x32x16_bf16(b0, qr[d0], p0, 0, 0, 0); p1 = __builtin_amdgcn_mfma_f32_32x32x16_bf16(b1, qr[d0], p1, 0, 0, 0); } }
}
typedef __attribute__((address_space(3))) const char* lds_cptr;
typedef short v4i16_t __attribute__((ext_vector_type(4)));
__device__ __forceinline__ void kload8(bf16x8* kf, lds_cptr kp) {
  kf[0] = *(const LAS bf16x8*)(kp);        kf[1] = *(const LAS bf16x8*)(kp + 512);
  kf[2] = *(const LAS bf16x8*)(kp + 2048); kf[3] = *(const LAS bf16x8*)(kp + 2560);
  kf[4] = *(const LAS bf16x8*)(kp + 4096); kf[5] = *(const LAS bf16x8*)(kp + 4608);
  kf[6] = *(const LAS bf16x8*)(kp + 6144); kf[7] = *(const LAS bf16x8*)(kp + 6656);
}
__device__ __forceinline__ void kload2(bf16x8* kf, lds_cptr kp, int j) { kf[2 * j] = *(const LAS bf16x8*)(kp + j * 2048); kf[2 * j + 1] = *(const LAS bf16x8*)(kp + j * 2048 + 512); }
__device__ __forceinline__ s16x4 vtr(lds_cptr p) { return __builtin_bit_cast(s16x4, __builtin_amdgcn_ds_read_tr16_b64_v4i16((LAS v4i16_t*)p)); }
__device__ __forceinline__ float rowmax(const f32x16& p0, const f32x16& p1) {
  float a = max3f(p0[0], p0[1], p1[0]), b = max3f(p0[2], p0[3], p1[1]); a = max3f(a, p1[2], p1[3]);
  #pragma unroll
  for (int r = 4; r < 16; r += 4) { a = max3f(a, p0[r], p0[r + 1]); b = max3f(b, p0[r + 2], p0[r + 3]); a = max3f(a, p1[r], p1[r + 1]); b = max3f(b, p1[r + 2], p1[r + 3]); }
  const float m = max2f(a, b);
  auto rr = __builtin_amdgcn_permlane32_swap(__float_as_uint(m), __float_as_uint(m), false, false);
  return max2f(__uint_as_float(rr[0]), __uint_as_float(rr[1]));
}
__device__ __forceinline__ void pv(f32x16* o, int vb, bf16x8 pa0, bf16x8 pa1, bf16x8 pa2, bf16x8 pa3) {
  #pragma unroll
  for (int d0 = 0; d0 < 2; ++d0) { s16x4 lo[4], hi[4];
    #pragma unroll
    for (int ks = 0; ks < 4; ++ks) {
      asm volatile("ds_read_b64_tr_b16 %0,%1 offset:%c2" : "=&v"(lo[ks]) : "v"(vb), "i"(d0 * 4096 + ks * 1024) : "memory");
      asm volatile("ds_read_b64_tr_b16 %0,%1 offset:%c2" : "=&v"(hi[ks]) : "v"(vb), "i"(d0 * 4096 + ks * 1024 + 512) : "memory"); }
    asm volatile("s_waitcnt lgkmcnt(0)" ::: "memory"); SBAR();
    #define PK(k) (bf16x8){lo[k][0], lo[k][1], lo[k][2], lo[k][3], hi[k][0], hi[k][1], hi[k][2], hi[k][3]}
    o[d0] = __builtin_amdgcn_mfma_f32_32x32x16_bf16(pa0, PK(0), o[d0], 0, 0, 0);
    o[d0] = __builtin_amdgcn_mfma_f32_32x32x16_bf16(pa1, PK(1), o[d0], 0, 0, 0);
    o[d0] = __builtin_amdgcn_mfma_f32_32x32x16_bf16(pa2, PK(2), o[d0], 0, 0, 0);
    o[d0] = __builtin_amdgcn_mfma_f32_32x32x16_bf16(pa3, PK(3), o[d0], 0, 0, 0);
    #undef PK
  }
}
template <int THRL> __device__ __forceinline__ void attn_unit(const bf16_t* Qu, const float* qgain, const float* rope, const int tok0, const bf16_t* __restrict__ Kh, const bf16_t* __restrict__ Vh, bf16_t* Ou, const int NT, char* shm) {
  const int tid = tid_(), lane = tid & 63, r32 = lane & 31, hi = lane >> 5; const int wid = __builtin_amdgcn_readfirstlane(tid >> 6);
  const bf16_t* Qw = Qu + (long)wid * QBLK * ZP;
  const unsigned lds0 = (unsigned)(uintptr_t)shm;
  float* wsf = (float*)(shm + LDS_WS) + wid * 64;
  const bf16_t* ksrc = Kh + (long)lane * KVP + wid * 8;
  const bf16_t* vsrc = Vh + (long)(16 * (wid & 3) + (lane >> 2)) * KVP + (wid >> 2) * 32 + (lane & 3) * 8;
  const unsigned kdst = lds0 + LDS_K + wid * 1024, vdst = lds0 + LDS_V + wid * 1024;
  #define DMA_K(t, slot) glds16(ksrc + (long)(t) * KVBLK * KVP, (unsigned)__builtin_amdgcn_readfirstlane(kdst + (slot)))
  #define DMA_V(t, slot) glds16(vsrc + (long)(t) * KVBLK * KVP, (unsigned)__builtin_amdgcn_readfirstlane(vdst + (slot)))
  const int vb0 = (int)(lds0 + LDS_V) + ((lane >> 4) & 1) * 32 + (lane & 3) * 8 + (4 * hi + ((lane & 15) >> 2)) * 64;
  const char* Kbase = shm + LDS_K; bf16x8 kf[8];
  const lds_cptr shm3 = (lds_cptr)shm; const lds_cptr kp0 = shm3 + LDS_K + hi * 1024 + r32 * 16; const lds_cptr vp0 = shm3 + LDS_V + ((lane >> 4) & 1) * 32 + (lane & 3) * 8 + (4 * hi + ((lane & 15) >> 2)) * 64;
  DMA_K(0, 0); DMA_V(0, 0); DMA_K(1, SLOTB);
  bf16x8 qr[4];
  { float xq[4][8]; float ss = 0.f;
    #pragma unroll
    for (int d0 = 0; d0 < 4; ++d0) { const uint4 rw = *reinterpret_cast<const uint4*>(&Qw[(long)r32 * ZP + d0 * 16 + hi * 8]);
      xq[d0][0] = bf_lo(rw.x); xq[d0][1] = bf_hi(rw.x); xq[d0][2] = bf_lo(rw.y); xq[d0][3] = bf_hi(rw.y); xq[d0][4] = bf_lo(rw.z); xq[d0][5] = bf_hi(rw.z); xq[d0][6] = bf_lo(rw.w); xq[d0][7] = bf_hi(rw.w);
      #pragma unroll
      for (int j = 0; j < 8; ++j) ss += xq[d0][j] * xq[d0][j]; }
    { auto rr = __builtin_amdgcn_permlane32_swap(__float_as_uint(ss), __float_as_uint(ss), false, false); ss = __uint_as_float(rr[0]) + __uint_as_float(rr[1]); }
    const float rstd = __builtin_amdgcn_rsqf(ss * (1.0f / 64.0f) + 1e-6f) * (0.125f * 1.4426950408889634f);
    #pragma unroll
    for (int d0 = 0; d0 < 4; ++d0) { const f32x4 g0 = *(const f32x4*)(qgain + d0 * 16 + hi * 8), g1 = *(const f32x4*)(qgain + d0 * 16 + hi * 8 + 4);
      #pragma unroll
      for (int j = 0; j < 4; ++j) { xq[d0][j] *= rstd * g0[j]; xq[d0][4 + j] *= rstd * g1[j]; } }
    if (tok0 >= 0) { const int t = tok0 + wid * QBLK + r32, pr = t >> 6, pc = t & 63;
      #pragma unroll
      for (int hf = 0; hf < 2; ++hf) {
        const float* ct = rope + (hf ? (1024 + pc * 16) : (pr * 16)) + hi * 8; const float* st = ct + (hf ? 1024 : 512);
        const f32x4 c0 = *(const f32x4*)ct, c1 = *(const f32x4*)(ct + 4), s0 = *(const f32x4*)st, s1 = *(const f32x4*)(st + 4);
        #pragma unroll
        for (int j = 0; j < 8; ++j) { const float cs = j < 4 ? c0[j] : c1[j - 4], sn = j < 4 ? s0[j] : s1[j - 4];
          const float x1 = xq[2 * hf][j], x2 = xq[2 * hf + 1][j];
          xq[2 * hf][j] = x1 * cs - x2 * sn; xq[2 * hf + 1][j] = x2 * cs + x1 * sn; } } }
    #pragma unroll
    for (int d0 = 0; d0 < 4; ++d0) qr[d0] = pack8(xq[d0]); }
  float mhat = 0.f, l_reg = 0.f; f32x16 o[2]; o[0] = f32x16{}; o[1] = f32x16{}; f32x16 negm = f32x16{}; asm volatile("" : "+v"(negm));
  bool resc = false;
  #define START(P0, P1) do { const float rm = rowmax(P0, P1); resc = false; \
    { const float dl = rm; mhat = fadd_s(mhat, dl); \
      _Pragma("unroll") for (int r = 0; r < 16; ++r) { P0[r] = fsub_s(P0[r], dl); P1[r] = fsub_s(P1[r], dl); } \
      _Pragma("unroll") for (int r = 0; r < 16; ++r) negm[r] = -mhat; asm volatile("" : "+v"(negm)); } \
    _Pragma("unroll") for (int r = 0; r < 16; ++r) P0[r] = __builtin_amdgcn_exp2f(P0[r]); } while (0)
  #define RESC() do { if (resc) { asm volatile("s_waitcnt lgkmcnt(0)" ::: "memory"); \
      _Pragma("unroll") for (int d_ = 0; d_ < 2; ++d_) _Pragma("unroll") for (int r = 0; r < 16; ++r) o[d_][r] *= wsf[crow(r, hi)]; } } while (0)
  f32x16 pA0, pA1, pB0, pB1;
  int sl_prev = 0, sl_cur = 0, sl_next = SLOTB;
  #define ROT() do { sl_prev = sl_cur; sl_cur = sl_next; sl_next = (sl_next == (NSLOT - 1) * SLOTB) ? 0 : sl_next + SLOTB; } while (0)
  DMA_K(2, 2 * SLOTB);
  WAIT_BAR(3);
  qkt(pA0, pA1, Kbase, qr, negm, r32, hi); asm volatile("s_nop 15\n\ts_nop 7" : "+v"(pA0), "+v"(pA1));
  START(pA0, pA1);
  _Pragma("unroll") for (int r = 0; r < 16; ++r) pA1[r] = __builtin_amdgcn_exp2f(pA1[r]);
  WAIT_BAR(0);
  DMA_K(3, 0); DMA_V(1, SLOTB);
  ROT();
  kload8(kf, kp0 + sl_cur);
  WAIT_BAR(2);
  s16x4 vlo[8], vhi[8]; u32x4 pw0, pw1, pw2, pw3;
  #define PKW(P, B) cvtpk_s(P[B], P[B + 1])
  #define PAF(k) __builtin_bit_cast(bf16x8, pw##k)
  #define VFR(i) (bf16x8){vlo[i][0], vlo[i][1], vlo[i][2], vlo[i][3], vhi[i][0], vhi[i][1], vhi[i][2], vhi[i][3]}
  #define PIN(x) asm volatile("" : "+v"(x))
  #define MX3(a, b, c) __builtin_fmaxf(__builtin_fmaxf((a), (b)), (c))
  #define GAPA(MF, A0, A1, A2, A3, W0, W1, PW) do { MF; sacc += A0; sacc += A1; sacc += A2; sacc += A3; PIN(sacc); W0; W1; PIN(PW); SBAR(); } while (0)
  #define EX(v) __builtin_amdgcn_exp2f(v)
  #define GAPB(MF, X, B) do { MF; X[B] = EX(X[B]); X[B + 1] = EX(X[B + 1]); X[B + 2] = EX(X[B + 2]); X[B + 3] = EX(X[B + 3]); PIN(X); SBAR(); } while (0)
  #define VRD(i) do { vlo[i] = vtr(vp_ + (((i) >> 2) * 4096 + ((i) & 3) * 1024)); vhi[i] = vtr(vp_ + (((i) >> 2) * 4096 + ((i) & 3) * 1024 + 512)); } while (0)
  #define KRD(G, j) do { if (G) { kload2(kf, kp0 + sl_next, j); SBAR(); } } while (0)
  #define STEP(C0, C1, P0, P1, t, GK, GV, GL) do { SBAR(); \
    const lds_cptr vp_ = vp0 + sl_prev; \
    VRD(0); SBAR(); float sacc = (P0[0] + P0[1]); \
    GAPA(C0 = __builtin_amdgcn_mfma_f32_32x32x16_bf16(kf[0], qr[0], negm, 0, 0, 0), P0[2], P0[3], P0[4], P0[5],     pw0[0] = PKW(P0, 0), pw0[1] = PKW(P0, 2), pw0); \
    VRD(4); SBAR(); GAPA(C1 = __builtin_amdgcn_mfma_f32_32x32x16_bf16(kf[1], qr[0], negm, 0, 0, 0), P0[6], P0[7], P0[8], P0[9],     pw0[2] = PKW(P0, 4), pw0[3] = PKW(P0, 6), pw0); \
    VRD(1); SBAR(); GAPA(C0 = __builtin_amdgcn_mfma_f32_32x32x16_bf16(kf[2], qr[1], C0, 0, 0, 0),   P0[10], P0[11], P0[12], P0[13], pw1[0] = PKW(P0, 8), pw1[1] = PKW(P0, 10), pw1); \
    VRD(5); SBAR(); GAPA(C1 = __builtin_amdgcn_mfma_f32_32x32x16_bf16(kf[3], qr[1], C1, 0, 0, 0),   P0[14], P0[15], P1[0], P1[1],   pw1[2] = PKW(P0, 12), pw1[3] = PKW(P0, 14), pw1); \
    VRD(2); SBAR(); GAPA(C0 = __builtin_amdgcn_mfma_f32_32x32x16_bf16(kf[4], qr[2], C0, 0, 0, 0),   P1[2], P1[3], P1[4], P1[5],     pw2[0] = PKW(P1, 0), pw2[1] = PKW(P1, 2), pw2); \
    VRD(6); SBAR(); GAPA(C1 = __builtin_amdgcn_mfma_f32_32x32x16_bf16(kf[5], qr[2], C1, 0, 0, 0),   P1[6], P1[7], P1[8], P1[9],     pw2[2] = PKW(P1, 4), pw2[3] = PKW(P1, 6), pw2); \
    VRD(3); SBAR(); GAPA(C0 = __builtin_amdgcn_mfma_f32_32x32x16_bf16(kf[6], qr[3], C0, 0, 0, 0),   P1[10], P1[11], P1[12], P1[13], pw3[0] = PKW(P1, 8), pw3[1] = PKW(P1, 10), pw3); \
    VRD(7); SBAR(); GAPA(C1 = __builtin_amdgcn_mfma_f32_32x32x16_bf16(kf[7], qr[3], C1, 0, 0, 0),   P1[14], P1[15], 0.f, 0.f,       pw3[2] = PKW(P1, 12), pw3[3] = PKW(P1, 14), pw3); \
    l_reg += sacc; \
    if (GK) { DMA_K((t) + 3, sl_cur); } if (GV) { DMA_V((t) + 1, sl_next); } \
    { float a = MX3(C0[0], C0[1], C1[0]), b = MX3(C0[2], C0[3], C1[1]); a = MX3(a, C1[2], C1[3]); \
      _Pragma("unroll") for (int r = 4; r < 16; r += 4) { a = MX3(a, C0[r], C0[r + 1]); b = MX3(b, C0[r + 2], C0[r + 3]); a = MX3(a, C1[r], C1[r + 1]); b = MX3(b, C1[r + 2], C1[r + 3]); } \
      float rm = __builtin_fmaxf(a, b); { auto rr = __builtin_amdgcn_permlane32_swap(__float_as_uint(rm), __float_as_uint(rm), false, false); rm = __builtin_fmaxf(__uint_as_float(rr[0]), __uint_as_float(rr[1])); } \
      resc = false; \
      if (__builtin_expect(__any(rm > (float)THRL), 0)) { const float dl = __builtin_fmaxf(rm, 0.f); mhat += dl; \
        _Pragma("unroll") for (int r = 0; r < 16; ++r) { C0[r] -= dl; C1[r] -= dl; } \
        _Pragma("unroll") for (int r = 0; r < 16; ++r) negm[r] = -mhat; asm volatile("" : "+v"(negm)); \
        const float f = __builtin_amdgcn_exp2f(-dl); l_reg *= f; if (hi == 0) wsf[r32] = f; resc = true; } } \
    SBAR(); \
    GAPB(o[0] = __builtin_amdgcn_mfma_f32_32x32x16_bf16(PAF(0), VFR(0), o[0], 0, 0, 0), C0, 0); \
    GAPB(o[1] = __builtin_amdgcn_mfma_f32_32x32x16_bf16(PAF(0), VFR(4), o[1], 0, 0, 0), C0, 4); \
    KRD(GL, 0); GAPB(o[0] = __builtin_amdgcn_mfma_f32_32x32x16_bf16(PAF(1), VFR(1), o[0], 0, 0, 0), C0, 8); \
    KRD(GL, 1); GAPB(o[1] = __builtin_amdgcn_mfma_f32_32x32x16_bf16(PAF(1), VFR(5), o[1], 0, 0, 0), C0, 12); \
    KRD(GL, 2); GAPB(o[0] = __builtin_amdgcn_mfma_f32_32x32x16_bf16(PAF(2), VFR(2), o[0], 0, 0, 0), C1, 0); \
    KRD(GL, 3); GAPB(o[1] = __builtin_amdgcn_mfma_f32_32x32x16_bf16(PAF(2), VFR(6), o[1], 0, 0, 0), C1, 4); \
    GAPB(o[0] = __builtin_amdgcn_mfma_f32_32x32x16_bf16(PAF(3), VFR(3), o[0], 0, 0, 0), C1, 8); \
    GAPB(o[1] = __builtin_amdgcn_mfma_f32_32x32x16_bf16(PAF(3), VFR(7), o[1], 0, 0, 0), C1, 12); \
    } while (0)
  int t = 1;
  for (; t + 5 < NT; t += 2) {
    STEP(pB0, pB1, pA0, pA1, t, true, true, true);     WAIT_BAR(2); RESC(); ROT();
    STEP(pA0, pA1, pB0, pB1, t + 1, true, true, true); WAIT_BAR(2); RESC(); ROT();
  }
  #define ENDW(tt) do { if ((tt) + 3 < NT) { WAIT_BAR(2); } else if ((tt) + 2 < NT) { WAIT_BAR(1); } else { WAIT_BAR(0); } } while (0)
  for (; t + 1 < NT; t += 2) {
    STEP(pB0, pB1, pA0, pA1, t, (t + 3 < NT), (t + 1 < NT), (t + 1 < NT));         ENDW(t);     RESC(); ROT();
    STEP(pA0, pA1, pB0, pB1, t + 1, (t + 4 < NT), (t + 2 < NT), (t + 2 < NT));     ENDW(t + 1); RESC(); ROT();
  }
  STEP(pB0, pB1, pA0, pA1, NT - 1, false, false, false); RESC();
  { float sacc = pB0[0] + pB0[1]; _Pragma("unroll") for (int r = 2; r < 16; ++r) sacc += pB0[r]; _Pragma("unroll") for (int r = 0; r < 16; ++r) sacc += pB1[r]; l_reg += sacc;
    pw0 = (u32x4){PKW(pB0, 0), PKW(pB0, 2), PKW(pB0, 4), PKW(pB0, 6)}; pw1 = (u32x4){PKW(pB0, 8), PKW(pB0, 10), PKW(pB0, 12), PKW(pB0, 14)}; pw2 = (u32x4){PKW(pB1, 0), PKW(pB1, 2), PKW(pB1, 4), PKW(pB1, 6)}; pw3 = (u32x4){PKW(pB1, 8), PKW(pB1, 10), PKW(pB1, 12), PKW(pB1, 14)};
    SBAR(); pv(o, vb0 + sl_cur, PAF(0), PAF(1), PAF(2), PAF(3)); }
  #undef PKW
  #undef PAF
  #undef VFR
  #undef PIN
  #undef MX3
  #undef GAPA
  #undef GAPB
  #undef EX
  #undef VRD
  #undef KRD
  #undef STEP
  #undef ENDW
  { auto rr = __builtin_amdgcn_permlane32_swap(__float_as_uint(l_reg), __float_as_uint(l_reg), false, false); l_reg = __uint_as_float(rr[0]) + __uint_as_float(rr[1]); }
  if (hi == 0) wsf[32 + r32] = l_reg; asm volatile("s_waitcnt lgkmcnt(0)" ::: "memory");
  float rli[16];
  #pragma unroll
  for (int r = 0; r < 16; ++r) rli[r] = __builtin_amdgcn_rcpf(wsf[32 + crow(r, hi)]);
  bf16_t* Ow = Ou + (long)wid * QBLK * OP;
  { bf16_t* stg = (bf16_t*)(shm + LDS_OST) + wid * 2048;
    #pragma unroll
    for (int r = 0; r < 16; ++r) { const int orow = crow(r, hi);
      #pragma unroll
      for (int d0 = 0; d0 < 2; ++d0) stg[orow * 64 + d0 * 32 + r32] = (bf16_t)(cvtpk_s(o[d0][r] * rli[r], 0.f) & 0xffffu); }
    asm volatile("s_waitcnt lgkmcnt(0)" ::: "memory");
    #pragma unroll
    for (int i = 0; i < 4; ++i) { const int row = i * 8 + (lane >> 3), ch = lane & 7; const u32x4 v = *(const u32x4*)(stg + row * 64 + ch * 8); *(u32x4*)(Ow + (long)row * OP + ch * 8) = v; } }
  asm volatile("s_waitcnt lgkmcnt(0)\n\ts_barrier" ::: "memory");
  #undef DMA_K
  #undef DMA_V
  #undef START
  #undef RESC
  #undef ROT
}
#undef SBAR
#undef WAIT_BAR
}

__device__ __forceinline__ void ph_prologue(const Params& P, LAS unsigned char* lds) {
    const int tid = tid_(), bid = bid_(), G = gridDim.x, lane = tid & 63, wid = tid >> 6;
    float* mods = (float*)(P.ws + WS_MODS);
    LAS float* sc = (LAS float*)lds;
    LAS float* red = sc + 9 * 1024;
    for (int i = tid; i < 9 * 1024; i += NTHR) { const float v = (i < 8192) ? P.in[I_C][i] : P.in[I_CCTX][i - 8192]; sc[i] = siluf_(v); }
    __syncthreads();
    {
        const int c = lane & 31, slot = wid * 2 + (lane >> 5);
        for (int u = bid; u < 4 * 192; u += G) {
            const int l = u / 192, cg = u % 192;
            const float* w = P.in[I_WADA] + (size_t)l * 1024 * 6144 + cg * 32 + c;
            float a[9];
#pragma unroll
            for (int r = 0; r < 9; ++r) a[r] = 0.f;
#pragma unroll 8
            for (int i = 0; i < 64; ++i) { const int k = slot + 16 * i; const float wv = w[(size_t)k * 6144];
#pragma unroll
                for (int r = 0; r < 9; ++r) a[r] += sc[r * 1024 + k] * wv; }
#pragma unroll
            for (int r = 0; r < 9; ++r) red[(slot * 9 + r) * 32 + c] = a[r];
            __syncthreads();
            if (tid < 288) { const int r = tid >> 5, cc = tid & 31; float s_ = 0.f;
#pragma unroll
                for (int q = 0; q < 16; ++q) s_ += red[(q * 9 + r) * 32 + cc];
                mods[((size_t)l * 9 + r) * 6144 + cg * 32 + cc] = s_ + P.in[I_BADA][l * 6144 + cg * 32 + cc]; }
            __syncthreads();
        }
    }
    { float* rt = (float*)(P.ws + WS_RT);
      for (int i = bid * NTHR + tid; i < DEPTH * 20 * 1024; i += G * NTHR) { const int l = i / 20480, j = (i % 20480) >> 10, c = i & 1023;
          rt[i] = (j < 4) ? P.in[I_WGR][((size_t)l * 1024 + c) * 4 + j] : P.in[I_WER][((size_t)l * 1024 + c) * 16 + (j - 4)]; } }
    if (bid == G - 1) {
        float* lbv = (float*)(P.ws + WS_LB);
        for (int i = tid; i < 1024; i += NTHR) {
            float lg[DEPTH], mx = -1e30f;
#pragma unroll
            for (int l = 0; l < DEPTH; ++l) { lg[l] = P.in[I_LBL][l * 1024 + i]; mx = fmaxf(mx, lg[l]); }
            float s = 0.f;
#pragma unroll
            for (int l = 0; l < DEPTH; ++l) { lg[l] = expf(lg[l] - mx); s += lg[l]; }
            float cum = 0.f;
#pragma unroll
            for (int l = 0; l < DEPTH; ++l) { if (l > 0) cum += lg[l] / s; lbv[l * 1024 + i] = cum; }
        }
        float* rope = (float*)(P.ws + WS_ROPE);
        for (int i = tid; i < 96 * 16; i += NTHR) {
            const int pos = i >> 4, fi = i & 15;
            const float inv = powf(10000.0f, -(float)fi / 16.0f);
            const float p = (pos < 32) ? (float)pos : (float)(pos - 32);
            const float ang = p * inv;
            if (pos < 32) { rope[pos * 16 + fi] = cosf(ang); rope[512 + pos * 16 + fi] = sinf(ang); }
            else { rope[1024 + (pos - 32) * 16 + fi] = cosf(ang); rope[2048 + (pos - 32) * 16 + fi] = sinf(ang); }
        }
    }
    float4* xr = (float4*)(P.ws + WS_X);
    const float4* xs = (const float4*)P.in[I_X]; const float4* cs = (const float4*)P.in[I_CTX];
    const size_t nx4 = (size_t)NLAT * D / 4, nc4 = (size_t)NCTX * D / 4;
    for (size_t i = (size_t)bid * NTHR + tid; i < nx4 + nc4; i += (size_t)G * NTHR) xr[i] = (i < nx4) ? xs[i] : cs[i - nx4];
}

struct ConvJob { const float* srcA; const float* srcB; int ld; bool inter; bool perm; bf16_t* dst; int K, n0, k0; };
__device__ __forceinline__ int perm32(int rho) { const int n = rho >> 4, i = rho & 15; return 8 * (i >> 2) + 4 * n + (i & 3); }
__device__ __forceinline__ bool conv_job(const Params& P, int l, int u, ConvJob& J) {
    constexpr int T_IN = 16 * 124, T_BR = 3 * 8 * 16, T_OUT = 16 * 16, T_GU = 16 * 16 * 16, T_DN = 16 * 8 * 16;
    constexpr int TOT = T_IN + T_BR + T_OUT + T_GU + T_DN;
    if (u >= TOT) return false;
    int v = u;
    J.srcB = nullptr; J.inter = false; J.perm = false;
    if (v < T_IN) { const int kt = v % 16, nt = v / 16; J.perm = true; J.srcA = P.in[I_WIN] + (size_t)l * 1024 * INC; J.ld = INC; J.dst = (bf16_t*)(P.ws + WS_WIN); J.K = 1024; J.n0 = nt * 64; J.k0 = kt * 64; return true; }
    v -= T_IN;
    if (v < T_BR) { const int i = v / 128, w = v % 128, kt = w % 8, nt = w / 8; J.perm = true; J.srcA = P.in[I_WBR] + ((size_t)l * 3 + i) * 512 * 1024; J.ld = 1024; J.dst = (bf16_t*)(P.ws + WS_WBR) + (size_t)i * 1024 * 512; J.K = 512; J.n0 = nt * 64; J.k0 = kt * 64; return true; }
    v -= T_BR;
    if (v < T_OUT) { const int kt = v % 16, nt = v / 16; J.perm = true; J.srcA = P.in[I_WOUT] + (size_t)l * 1024 * 1024; J.ld = 1024; J.dst = (bf16_t*)(P.ws + WS_WOUT); J.K = 1024; J.n0 = nt * 64; J.k0 = kt * 64; return true; }
    v -= T_OUT;
    if (v < T_GU) { const int e = v / 256, w = v % 256, kt = w % 16, nt = w / 16; const size_t eo = ((size_t)l * NEXP + e) * 1024 * 512;
        J.srcA = P.in[I_WEG] + eo; J.srcB = P.in[I_WEU] + eo; J.inter = true; J.ld = 512; J.dst = (bf16_t*)(P.ws + WS_WGU) + (size_t)e * 1024 * 1024; J.K = 1024; J.n0 = nt * 64; J.k0 = kt * 64; return true; }
    v -= T_GU;
    { const int e = v / 128, w = v % 128, kt = w % 8, nt = w / 8; J.perm = true; J.srcA = P.in[I_WED] + ((size_t)l * NEXP + e) * 512 * 1024; J.ld = 1024; J.dst = (bf16_t*)(P.ws + WS_WDN) + (size_t)e * 1024 * 512; J.K = 512; J.n0 = nt * 64; J.k0 = kt * 64; return true; }
}
__device__ __forceinline__ void conv_load(const ConvJob& J, int tid, float (&v)[8]) {
    const int nn = tid & 63, kk = tid >> 6, n = J.n0 + nn;
    const float* cp;
    if (J.perm) cp = J.srcA + (n & ~31) + perm32(n & 31); else if (!J.inter) cp = J.srcA + n; else { const int g = n >> 5, i = n & 31; cp = (i < 16) ? (J.srcA + 16 * g + i) : (J.srcB + 16 * g + i - 16); }
#pragma unroll
    for (int p = 0; p < 8; ++p) v[p] = cp[(size_t)(J.k0 + kk + 8 * p) * J.ld];
}
__device__ __forceinline__ void wconv_range(const Params& P, LAS unsigned char* lds, int l, int t0, int t1, int widx, int nw) {
    LAS float* t = (LAS float*)lds;
    const int tid = tid_();
    int u = t0 + widx;
    ConvJob J; float v[8];
    bool have = (u < t1) && conv_job(P, l, u, J);
    if (have) conv_load(J, tid, v);
    while (have) {
        ConvJob Jn; float vn[8];
        const bool hn = (u + nw < t1) && conv_job(P, l, u + nw, Jn);
        if (hn) conv_load(Jn, tid, vn);
        { const int nn = tid & 63, kk = tid >> 6;
#pragma unroll
          for (int p = 0; p < 8; ++p) t[(kk + 8 * p) * 65 + nn] = v[p]; }
        __syncthreads();
        { const int n = tid >> 3, k8 = (tid & 7) * 8;
          float w[8];
#pragma unroll
          for (int j = 0; j < 8; ++j) w[j] = t[(k8 + j) * 65 + n];
          uint4 o; o.x = pk_bf16(w[0], w[1]); o.y = pk_bf16(w[2], w[3]); o.z = pk_bf16(w[4], w[5]); o.w = pk_bf16(w[6], w[7]);
          *(uint4*)(J.dst + (size_t)(J.n0 + n) * J.K + J.k0 + k8) = o; }
        __syncthreads();
        J = Jn; have = hn; u += nw;
#pragma unroll
        for (int p = 0; p < 8; ++p) v[p] = vn[p];
    }
}
constexpr int CONV_T_DENSE = 16 * 124 + 3 * 8 * 16 + 16 * 16;
constexpr int CONV_T_ALL = CONV_T_DENSE + 16 * 16 * 16 + 16 * 8 * 16;
__device__ __forceinline__ void ph_wconv(const Params& P, LAS unsigned char* lds, int l) { wconv_range(P, lds, l, 0, CONV_T_DENSE, bid_(), gridDim.x); }

__device__ __forceinline__ void norm_row(const float4 (&x)[4], const float* g, const float* shift, const float* scale, int lane, float4 (&o)[4]) {
    float ss = 0.f;
#pragma unroll
    for (int i = 0; i < 4; ++i) ss += x[i].x * x[i].x + x[i].y * x[i].y + x[i].z * x[i].z + x[i].w * x[i].w;
    ss = wave_sum(ss);
    const float rstd = __builtin_amdgcn_rsqf(ss * (1.0f / 1024.0f) + 1e-6f);
#pragma unroll
    for (int i = 0; i < 4; ++i) {
        const int c = lane * 4 + 256 * i;
        const float4 gv = *(const float4*)(g + c), sh = *(const float4*)(shift + c), sc = *(const float4*)(scale + c);
        o[i].x = x[i].x * rstd * gv.x * (1.0f + sc.x) + sh.x;
        o[i].y = x[i].y * rstd * gv.y * (1.0f + sc.y) + sh.y;
        o[i].z = x[i].z * rstd * gv.z * (1.0f + sc.z) + sh.z;
        o[i].w = x[i].w * rstd * gv.w * (1.0f + sc.w) + sh.w;
    }
}
__device__ __forceinline__ int row_modrow(int r) { return r < NLAT ? (r >> 11) : 8; }

__device__ __forceinline__ void ph_norm1(const Params& P, int l) {
    const int tid = tid_(), lane = tid & 63, wid = tid >> 6;
    const float* xres = (const float*)(P.ws + WS_X);
    bf16_t* h = (bf16_t*)(P.ws + WS_H);
    const float* g = P.in[I_GMIX] + l * 1024;
    for (int r = bid_() * 8 + wid; r < NTOK; r += gridDim.x * 8) {
        const float* mod = (const float*)(P.ws + WS_MODS) + ((size_t)l * 9 + row_modrow(r)) * 6144;
        float4 x[4], o[4];
#pragma unroll
        for (int i = 0; i < 4; ++i) x[i] = *(const float4*)(xres + (size_t)r * D + lane * 4 + 256 * i);
        norm_row(x, g, mod, mod + 1024, lane, o);
#pragma unroll
        for (int i = 0; i < 4; ++i) { uint2 u; u.x = pk_bf16(o[i].x, o[i].y); u.y = pk_bf16(o[i].z, o[i].w); *(uint2*)(h + (size_t)r * D + lane * 4 + 256 * i) = u; }
    }
}

struct EpiStoreBf16 { bf16_t* O; int ldc;
    __device__ __forceinline__ void operator()(int row, int col, const f32x4& v0, const f32x4& v1) const {
        uint2 a, b; a.x = pk_bf16(v0[0], v0[1]); a.y = pk_bf16(v0[2], v0[3]); b.x = pk_bf16(v1[0], v1[1]); b.y = pk_bf16(v1[2], v1[3]);
        *(uint2*)(O + (size_t)row * ldc + col) = a; *(uint2*)(O + (size_t)row * ldc + col + 16) = b; } };
struct EpiStore16 { bf16_t* O; int ldc;
    __device__ __forceinline__ void operator()(const f32x4 (&acc)[2][2][4][2], const pg8::Unit& u, int wr, int wc, int fr, int fq) const {
#pragma unroll
        for (int ai = 0; ai < 2; ++ai)
#pragma unroll
            for (int m = 0; m < 4; ++m)
#pragma unroll
                for (int bj = 0; bj < 2; ++bj) { const int row = u.row0 + ai * 128 + wr * 64 + m * 16 + fr, col = u.col0 + bj * 128 + wc * 32 + 8 * fq;
                    const f32x4 v0 = acc[ai][bj][m][0], v1 = acc[ai][bj][m][1];
                    uint4 o; o.x = pk_bf16(v0[0], v0[1]); o.y = pk_bf16(v0[2], v0[3]); o.z = pk_bf16(v1[0], v1[1]); o.w = pk_bf16(v1[2], v1[3]);
                    *(uint4*)(O + (size_t)row * ldc + col) = o; }
    } };
struct FStoreBf16 { bf16_t* O; int ldc;
    __device__ __forceinline__ void operator()(const pg8::Unit&, int row, int col, const f32x4& v0, const f32x4& v1) const {
        uint2 a, b; a.x = pk_bf16(v0[0], v0[1]); a.y = pk_bf16(v0[2], v0[3]); b.x = pk_bf16(v1[0], v1[1]); b.y = pk_bf16(v1[2], v1[3]);
        *(uint2*)(O + (size_t)row * ldc + col) = a; *(uint2*)(O + (size_t)row * ldc + col + 16) = b; } };
struct EpiG1 { bf16_t* Z; bf16_t* GT;
    __device__ __forceinline__ void operator()(const f32x4 (&acc)[2][2][4][2], const pg8::Unit& u, int wr, int wc, int fr, int fq) const {
        if (u.col0 < C_GATE) {
#pragma unroll
            for (int ai = 0; ai < 2; ++ai)
#pragma unroll
                for (int m = 0; m < 4; ++m)
#pragma unroll
                    for (int bj = 0; bj < 2; ++bj) { const int row = u.row0 + ai * 128 + wr * 64 + m * 16 + fr, col = u.col0 + bj * 128 + wc * 32 + 8 * fq;
                        const f32x4 v0 = acc[ai][bj][m][0], v1 = acc[ai][bj][m][1];
                        uint4 o; o.x = pk_bf16(v0[0], v0[1]); o.y = pk_bf16(v0[2], v0[3]); o.z = pk_bf16(v1[0], v1[1]); o.w = pk_bf16(v1[2], v1[3]);
                        *(uint4*)(Z + (size_t)row * ZP + col) = o; }
        } else {
            const int tidx = (wr * 4 + wc) * 64 + fq * 16 + fr;
            bf16_t* base = GT + ((size_t)(u.row0 >> 8) * 12 + ((u.col0 - C_GATE) >> 8)) * 65536 + tidx * 8;
#pragma unroll
            for (int ai = 0; ai < 2; ++ai)
#pragma unroll
                for (int bj = 0; bj < 2; ++bj)
#pragma unroll
                    for (int m = 0; m < 4; ++m) { const f32x4 v0 = acc[ai][bj][m][0], v1 = acc[ai][bj][m][1];
                        uint4 o; o.x = pk_bf16(sigmoidf_(v0[0]), sigmoidf_(v0[1])); o.y = pk_bf16(sigmoidf_(v0[2]), sigmoidf_(v0[3]));
                        o.z = pk_bf16(sigmoidf_(v1[0]), sigmoidf_(v1[1])); o.w = pk_bf16(sigmoidf_(v1[2]), sigmoidf_(v1[3]));
                        *(uint4*)(base + ((ai * 2 + bj) * 4 + m) * 4096) = o; }
        }
    } };
__device__ __forceinline__ void ph_g1(const Params& P, LAS unsigned char* lds) {
    pg8::SchedDense S{NTOK / 256, INC / 256, (int)gridDim.x, bid_(), (const char*)(P.ws + WS_H), (const char*)(P.ws + WS_WIN), (size_t)256 * D * 2, (size_t)256 * D * 2};
    EpiG1 E{(bf16_t*)(P.ws + WS_Z), (bf16_t*)(P.ws + WS_GT)};
    pg8::gemm_phase(lds, pg8::Gemm{D, D, D}, S, E);
}

__device__ __forceinline__ int kvrow(int r) { return r < NLAT ? ((r >> 11) * 2304 + 256 + (r & 2047)) : (((r - NLAT) >> 8) * 2304 + ((r - NLAT) & 255)); }
__device__ __forceinline__ void ph_prep(const Params& P, int l) {
    const int tid = tid_(), lane = tid & 63, wid = tid >> 6;
    const bf16_t* z = (const bf16_t*)(P.ws + WS_Z);
    bf16_t* qn = (bf16_t*)(P.ws + WS_QN); bf16_t* kn = (bf16_t*)(P.ws + WS_KN); bf16_t* vn = (bf16_t*)(P.ws + WS_VN);
    const float* rope = (const float*)(P.ws + WS_ROPE);
    const float gq = P.in[I_QNG][l * 64 + lane] * (0.125f * 1.4426950408889634f), gk = P.in[I_KNG][l * 64 + lane];
    for (int r = bid_() * 8 + wid; r < NTOK; r += gridDim.x * 8) {
        const bool lat = r < NLAT;
        const size_t kr = (size_t)kvrow(r);
        float cs = 1.f, sn = 0.f;
        if (lat) { const int t = r & 2047, fi = lane & 15;
            if (lane < 32) { const int pr = t >> 6; cs = rope[pr * 16 + fi]; sn = rope[512 + pr * 16 + fi]; }
            else { const int pc = t & 63; cs = rope[1024 + pc * 16 + fi]; sn = rope[2048 + pc * 16 + fi]; } }
        const float sgn = (lane & 16) ? 1.f : -1.f;
#pragma unroll
        for (int hh = 8; hh < 10; ++hh) {
            const int col = (hh < 8) ? (C_GQ + hh * 64) : (C_GK + (hh - 8) * 64);
            const float x = bf2f(z[(size_t)r * ZP + col + lane]);
            const float ss = wave_sum(x * x);
            const float xn = x * __builtin_amdgcn_rsqf(ss * (1.0f / 64.0f) + 1e-6f) * (hh < 8 ? gq : gk);
            const float pa = __shfl_xor(xn, 16, 64);
            const float o = xn * cs + sgn * pa * sn;
            const bf16_t ob = (bf16_t)(pk_bf16(o, 0.f) & 0xffffu);
            if (hh < 8) qn[(size_t)r * 512 + hh * 64 + lane] = ob; else kn[kr * 128 + (hh - 8) * 64 + lane] = ob;
        }
        *(unsigned*)(vn + kr * 128 + lane * 2) = *(const unsigned*)(z + (size_t)r * ZP + C_GV + lane * 2);
    }
}

__device__ __forceinline__ void ph_navt(const Params& P, LAS unsigned char* lds) {
    const int tid = tid_();
    const bf16_t* z = (const bf16_t*)(P.ws + WS_Z); bf16_t* vt = (bf16_t*)(P.ws + WS_NAVT);
    constexpr int PT = 1040;
    for (int u = bid_(); u < NB * 36; u += gridDim.x) {
        const int b = u / 36, tl = u % 36;
        const int row0 = (tl < 4) ? (NLAT + b * 256 + tl * 64) : (b * 2048 + (tl - 4) * 64);
        __syncthreads();
#pragma unroll
        for (int i = 0; i < 8; ++i) { const int ch = tid + i * NTHR, rr = ch >> 6, cc = ch & 63;
            const uint4 v = *(const uint4*)(z + (size_t)(row0 + rr) * ZP + C_NAV + cc * 8);
            *(LAS u32x4*)(lds + rr * PT + cc * 16) = (u32x4){v.x, v.y, v.z, v.w}; }
        __syncthreads();
#pragma unroll
        for (int i = 0; i < 8; ++i) { const int c = tid, tg = i;
            unsigned short e[8];
#pragma unroll
            for (int k = 0; k < 8; ++k) e[k] = *(const LAS unsigned short*)(lds + (tg * 8 + k) * PT + c * 2);
            uint4 o; o.x = e[0] | ((unsigned)e[1] << 16); o.y = e[2] | ((unsigned)e[3] << 16); o.z = e[4] | ((unsigned)e[5] << 16); o.w = e[6] | ((unsigned)e[7] << 16);
            *(uint4*)(vt + ((size_t)(b * 8 + (c >> 6)) * 64 + (c & 63)) * 2304 + tl * 64 + tg * 8) = o; }
    }
    __syncthreads();
}

#ifdef DIAG
__device__ __forceinline__ void load_q64(float (&q)[64], const bf16_t* p) {
#pragma unroll
    for (int i = 0; i < 8; ++i) { const uint4 u = ((const uint4*)p)[i];
        q[8 * i + 0] = bf_lo(u.x); q[8 * i + 1] = bf_hi(u.x); q[8 * i + 2] = bf_lo(u.y); q[8 * i + 3] = bf_hi(u.y);
        q[8 * i + 4] = bf_lo(u.z); q[8 * i + 5] = bf_hi(u.z); q[8 * i + 6] = bf_lo(u.w); q[8 * i + 7] = bf_hi(u.w); }
}
__device__ __forceinline__ void attn_key(const float (&q)[64], const bf16_t* kp, const bf16_t* vp, float bias, float& m, float& lsum, float (&o)[64]) {
    float s = 0.f;
#pragma unroll
    for (int i = 0; i < 8; ++i) { const uint4 u = ((const uint4*)kp)[i];
        s += q[8 * i + 0] * bf_lo(u.x) + q[8 * i + 1] * bf_hi(u.x) + q[8 * i + 2] * bf_lo(u.y) + q[8 * i + 3] * bf_hi(u.y)
           + q[8 * i + 4] * bf_lo(u.z) + q[8 * i + 5] * bf_hi(u.z) + q[8 * i + 6] * bf_lo(u.w) + q[8 * i + 7] * bf_hi(u.w); }
    s = s * 0.125f + bias;
    const float mn = fmaxf(m, s), corr = __expf(m - mn), pp = __expf(s - mn);
    lsum = lsum * corr + pp; m = mn;
#pragma unroll
    for (int i = 0; i < 8; ++i) { const uint4 u = ((const uint4*)vp)[i];
        o[8 * i + 0] = o[8 * i + 0] * corr + pp * bf_lo(u.x); o[8 * i + 1] = o[8 * i + 1] * corr + pp * bf_hi(u.x);
        o[8 * i + 2] = o[8 * i + 2] * corr + pp * bf_lo(u.y); o[8 * i + 3] = o[8 * i + 3] * corr + pp * bf_hi(u.y);
        o[8 * i + 4] = o[8 * i + 4] * corr + pp * bf_lo(u.z); o[8 * i + 5] = o[8 * i + 5] * corr + pp * bf_hi(u.z);
        o[8 * i + 6] = o[8 * i + 6] * corr + pp * bf_lo(u.w); o[8 * i + 7] = o[8 * i + 7] * corr + pp * bf_hi(u.w); }
}
__device__ __forceinline__ void store_o64(const float (&o)[64], float inv, bf16_t* p) {
#pragma unroll
    for (int i = 0; i < 8; ++i) { uint4 u;
        u.x = pk_bf16(o[8 * i + 0] * inv, o[8 * i + 1] * inv); u.y = pk_bf16(o[8 * i + 2] * inv, o[8 * i + 3] * inv);
        u.z = pk_bf16(o[8 * i + 4] * inv, o[8 * i + 5] * inv); u.w = pk_bf16(o[8 * i + 6] * inv, o[8 * i + 7] * inv);
        ((uint4*)p)[i] = u; }
}
__device__ __forceinline__ void na_thread(const Params& P, int l, int r, int h, bf16_t* br, int OPN) {
    const bf16_t* z = (const bf16_t*)(P.ws + WS_Z);
    float q[64], o[64]; float m = -INFINITY, ls = 0.f;
#pragma unroll
    for (int i = 0; i < 64; ++i) o[i] = 0.f;
    load_q64(q, z + (size_t)r * ZP + C_NAQ + h * 64);
    int b;
    if (r < NLAT) {
        b = r >> 11; const int t = r & 2047, qr = t >> 6, qc = t & 63;
        const int r0 = min(max(qr - 4, 0), 24), c0 = min(max(qc - 8, 0), 48);
        const float* rpb = P.in[I_RPB] + ((size_t)l * 8 + h) * 15 * 31;
        for (int kr = r0; kr < r0 + 8; ++kr)
            for (int kc = c0; kc < c0 + 16; ++kc) {
                const size_t krow = (size_t)(b * 2048 + kr * 64 + kc) * ZP;
                attn_key(q, z + krow + C_NAK + h * 64, z + krow + C_NAV + h * 64, rpb[(kr - qr + 7) * 31 + (kc - qc + 15)], m, ls, o);
            }
    } else b = (r - NLAT) >> 8;
    for (int j = 0; j < 256; ++j) {
        const size_t krow = (size_t)(NLAT + b * 256 + j) * ZP;
        attn_key(q, z + krow + C_NAK + h * 64, z + krow + C_NAV + h * 64, 0.f, m, ls, o);
    }
    store_o64(o, 1.0f / ls, br + (size_t)r * OPN + h * 64);
}
#endif
namespace na {
constexpr int KP = 144, VP = 528;
constexpr int L_K = 0, L_V = 256 * KP, L_B = L_V + 64 * VP, L_END = L_B + 480 * 4;
constexpr float C2 = 0.125f * 1.4426950408889634f, LOG2E = 1.4426950408889634f;
struct Acc { float m, l; f32x4 o[4]; };
template <int NG> __device__ __forceinline__ void absorb(Acc& A, f32x4 (&sa)[NG], f32x4 (&sb)[NG], const bf16x8 (&vfr)[NG][4]) {
    float mx = -INFINITY;
#pragma unroll
    for (int g = 0; g < NG; ++g)
#pragma unroll
        for (int j = 0; j < 4; ++j) mx = fmaxf(mx, fmaxf(sa[g][j], sb[g][j]));
    mx = fmaxf(mx, __shfl_xor(mx, 16, 64)); mx = fmaxf(mx, __shfl_xor(mx, 32, 64));
    const float mn = fmaxf(A.m, mx), corr = __builtin_amdgcn_exp2f(A.m - mn);
    A.m = mn;
    float ps = 0.f;
    bf16x8 pf[NG];
#pragma unroll
    for (int g = 0; g < NG; ++g) { float p[8];
#pragma unroll
        for (int j = 0; j < 4; ++j) { p[j] = __builtin_amdgcn_exp2f(sa[g][j] - mn); p[4 + j] = __builtin_amdgcn_exp2f(sb[g][j] - mn); ps += p[j] + p[4 + j]; }
        pf[g] = pack8(p); }
    A.l = A.l * corr + ps;
#pragma unroll
    for (int db = 0; db < 4; ++db) A.o[db] *= corr;
#pragma unroll
    for (int g = 0; g < NG; ++g)
#pragma unroll
        for (int db = 0; db < 4; ++db) A.o[db] = __builtin_amdgcn_mfma_f32_16x16x32_bf16(vfr[g][db], pf[g], A.o[db], 0, 0, 0);
}
}
__device__ __forceinline__ void na_unit(const Params& P, LAS unsigned char* lds, int l, int u, bf16_t* br, int OPN) {
    const int tid = tid_(), lane = tid & 63, wid = __builtin_amdgcn_readfirstlane(tid >> 6), c16 = lane & 15, kq = lane >> 4;
    const bool latu = u < 256;
    const int bh = latu ? (u >> 2) : (u - 256), b = bh >> 3, h = bh & 7, q4 = u & 3;
    const bf16_t* z = (const bf16_t*)(P.ws + WS_Z); const bf16_t* vt = (const bf16_t*)(P.ws + WS_NAVT) + (size_t)bh * 64 * 2304;
    LAS unsigned char* KL = lds + na::L_K; LAS unsigned char* VL = lds + na::L_V; LAS float* BL = (LAS float*)(lds + na::L_B);
    __syncthreads();
#pragma unroll
    for (int i = 0; i < 4; ++i) { const int ch = tid + i * NTHR, rr = ch >> 3, cc = ch & 7;
        const uint4 v = *(const uint4*)(z + (size_t)(NLAT + b * 256 + rr) * ZP + C_NAK + h * 64 + cc * 8);
        *(LAS u32x4*)(KL + rr * na::KP + cc * 16) = (u32x4){v.x, v.y, v.z, v.w}; }
#pragma unroll
    for (int i = 0; i < 4; ++i) { const int ch = tid + i * NTHR, rr = ch >> 5, cc = ch & 31;
        const uint4 v = *(const uint4*)(vt + (size_t)rr * 2304 + cc * 8);
        *(LAS u32x4*)(VL + rr * na::VP + cc * 16) = (u32x4){v.x, v.y, v.z, v.w}; }
    if (tid < 465) BL[tid] = P.in[I_RPB][((size_t)l * 8 + h) * 465 + tid] * na::LOG2E;
    __syncthreads();
    const int sA = 8 * (c16 >> 2) + (c16 & 3);
    const int ntask = latu ? 4 : 2;
    struct TaskP { int qrow, r, jb, r0, kc0; };
#define NA_FENCE() asm volatile("" ::: "memory")
#define NA_TASKP(it_, t_) do { const int tk_ = (it_) * 8 + wid; t_.r = 0; t_.jb = 0; t_.r0 = 0; t_.kc0 = 0; \
        if (latu) { t_.r = q4 * 8 + (tk_ >> 2); t_.jb = tk_ & 3; t_.qrow = b * 2048 + t_.r * 64 + t_.jb * 16 + c16; t_.r0 = min(max(t_.r - 4, 0), 24); t_.kc0 = min(max(t_.jb * 16 - 8, 0), 32); } \
        else t_.qrow = NLAT + b * 256 + tk_ * 16 + c16; } while (0)
#define NA_LOADK(t_, c_, kf_) do { _Pragma("unroll") for (int g = 0; g < 2; ++g) { const bf16_t* kp_ = z + ((size_t)b * 2048 + (size_t)(t_.r0 + 2 * (c_) + g) * 64 + t_.kc0 + sA) * ZP + C_NAK + h * 64 + 8 * kq; \
            kf_[g][0] = *(const bf16x8*)kp_; kf_[g][1] = *(const bf16x8*)(kp_ + 32); kf_[g][2] = *(const bf16x8*)(kp_ + 4 * ZP); kf_[g][3] = *(const bf16x8*)(kp_ + 4 * ZP + 32); } } while (0)
#define NA_LOADV(t_, c_, vf_) do { const bf16_t* vp_ = vt + (size_t)c16 * 2304 + 256 + (t_.r0 + 2 * (c_)) * 64 + t_.kc0 + 8 * kq; \
        _Pragma("unroll") for (int g = 0; g < 2; ++g) _Pragma("unroll") for (int db = 0; db < 4; ++db) vf_[g][db] = *(const bf16x8*)(vp_ + (size_t)db * 16 * 2304 + g * 64); } while (0)
    for (int it = 0; it < ntask; ++it) {
        TaskP T; NA_TASKP(it, T);
        bf16x8 qf[2];
#pragma unroll
        for (int ks = 0; ks < 2; ++ks) qf[ks] = *(const bf16x8*)(z + (size_t)T.qrow * ZP + C_NAQ + h * 64 + 32 * ks + 8 * kq);
        na::Acc A; A.m = -INFINITY; A.l = 0.f;
#pragma unroll
        for (int db = 0; db < 4; ++db) A.o[db] = (f32x4){0.f, 0.f, 0.f, 0.f};
        if (latu) {
            bf16x8 kA[2][4], vA[2][4], kB[2][4], vB[2][4];
            NA_LOADK(T, 0, kA); NA_LOADV(T, 0, vA); NA_LOADK(T, 1, kB); NA_LOADV(T, 1, vB);
            const int qc = T.jb * 16 + c16, c0 = min(max(qc - 8, 0), 48);
            int dcol[8]; bool ok[8];
#pragma unroll
            for (int j = 0; j < 8; ++j) { const int kc = T.kc0 + 8 * kq + j; ok[j] = (kc >= c0) && (kc < c0 + 16); dcol[j] = ok[j] ? (kc - qc + 15) : 0; }
#define NA_SCORES(KF, CI) do { \
                float bv[2][8]; \
                _Pragma("unroll") for (int g = 0; g < 2; ++g) { const int brow = (T.r0 + 2 * (CI) + g - T.r + 7) * 31; \
                    _Pragma("unroll") for (int j = 0; j < 8; ++j) bv[g][j] = BL[brow + dcol[j]]; } \
                _Pragma("unroll") for (int g = 0; g < 2; ++g) { \
                    f32x4 a_ = {0.f, 0.f, 0.f, 0.f}, b_ = {0.f, 0.f, 0.f, 0.f}; \
                    a_ = __builtin_amdgcn_mfma_f32_16x16x32_bf16(KF[g][0], qf[0], a_, 0, 0, 0); a_ = __builtin_amdgcn_mfma_f32_16x16x32_bf16(KF[g][1], qf[1], a_, 0, 0, 0); \
                    b_ = __builtin_amdgcn_mfma_f32_16x16x32_bf16(KF[g][2], qf[0], b_, 0, 0, 0); b_ = __builtin_amdgcn_mfma_f32_16x16x32_bf16(KF[g][3], qf[1], b_, 0, 0, 0); \
                    _Pragma("unroll") for (int j = 0; j < 4; ++j) { \
                        const float va_ = a_[j] * na::C2 + bv[g][j], vb_ = b_[j] * na::C2 + bv[g][4 + j]; \
                        sa[g][j] = ok[j] ? va_ : -INFINITY; sb[g][j] = ok[4 + j] ? vb_ : -INFINITY; } } } while (0)
            f32x4 sa[2], sb[2];
            NA_SCORES(kA, 0); NA_FENCE(); NA_LOADK(T, 2, kA); NA_FENCE(); na::absorb<2>(A, sa, sb, vA); NA_FENCE(); NA_LOADV(T, 2, vA); NA_FENCE();
            NA_SCORES(kB, 1); NA_FENCE(); NA_LOADK(T, 3, kB); NA_FENCE(); na::absorb<2>(A, sa, sb, vB); NA_FENCE(); NA_LOADV(T, 3, vB); NA_FENCE();
            NA_SCORES(kA, 2); na::absorb<2>(A, sa, sb, vA);
            NA_SCORES(kB, 3); na::absorb<2>(A, sa, sb, vB);
#undef NA_SCORES
        }
#pragma unroll 1
        for (int ch = 0; ch < 2; ++ch) {
            f32x4 sa[4], sb[4];
            bf16x8 kf[4][4], vfr[4][4];
            { const LAS unsigned char* vp = VL + c16 * na::VP + (ch * 128 + 8 * kq) * 2;
#pragma unroll
              for (int g = 0; g < 4; ++g)
#pragma unroll
                for (int db = 0; db < 4; ++db) vfr[g][db] = *(const LAS bf16x8*)(vp + db * 16 * na::VP + g * 64); }
#pragma unroll
            for (int g = 0; g < 4; ++g) {
                const LAS unsigned char* kp = KL + (ch * 128 + g * 32 + sA) * na::KP + kq * 16;
                kf[g][0] = *(const LAS bf16x8*)kp; kf[g][1] = *(const LAS bf16x8*)(kp + 64); kf[g][2] = *(const LAS bf16x8*)(kp + 4 * na::KP); kf[g][3] = *(const LAS bf16x8*)(kp + 4 * na::KP + 64);
            }
#pragma unroll
            for (int g = 0; g < 4; ++g) {
                f32x4 a = {0.f, 0.f, 0.f, 0.f}, bq = {0.f, 0.f, 0.f, 0.f};
                a = __builtin_amdgcn_mfma_f32_16x16x32_bf16(kf[g][0], qf[0], a, 0, 0, 0); a = __builtin_amdgcn_mfma_f32_16x16x32_bf16(kf[g][1], qf[1], a, 0, 0, 0);
                bq = __builtin_amdgcn_mfma_f32_16x16x32_bf16(kf[g][2], qf[0], bq, 0, 0, 0); bq = __builtin_amdgcn_mfma_f32_16x16x32_bf16(kf[g][3], qf[1], bq, 0, 0, 0);
                sa[g] = a * na::C2; sb[g] = bq * na::C2;
            }
            na::absorb<4>(A, sa, sb, vfr);
        }
        float ls = A.l; ls += __shfl_xor(ls, 16, 64); ls += __shfl_xor(ls, 32, 64);
        const float inv = __builtin_amdgcn_rcpf(ls);
        bf16_t* op = br + (size_t)T.qrow * OPN + h * 64 + 4 * kq;
#pragma unroll
        for (int db = 0; db < 4; ++db) { uint2 o; o.x = pk_bf16(A.o[db][0] * inv, A.o[db][1] * inv); o.y = pk_bf16(A.o[db][2] * inv, A.o[db][3] * inv);
            *(uint2*)(op + 16 * db) = o; }
    }
#undef NA_FENCE
#undef NA_TASKP
#undef NA_LOADK
#undef NA_LOADV
}
__device__ __forceinline__ int hg_row(int b, int dir, int s) { return s < 256 ? (NLAT + b * 256 + (dir ? 255 - s : s)) : (b * 2048 + (dir ? 2047 - (s - 256) : (s - 256))); }
__device__ __forceinline__ bf16x8 tr2(const LAS unsigned char* p0, const LAS unsigned char* p1) {
    typedef short v4i16_t __attribute__((ext_vector_type(4)));
    const v4i16_t a = __builtin_amdgcn_ds_read_tr16_b64_v4i16((LAS v4i16_t*)p0), c = __builtin_amdgcn_ds_read_tr16_b64_v4i16((LAS v4i16_t*)p1);
    return (bf16x8){a[0], a[1], a[2], a[3], c[0], c[1], c[2], c[3]};
}
__device__ __forceinline__ void hgrn_unit(const Params& P, LAS unsigned char* lds, int l, int u) {
    const int tid = tid_(), lane = tid & 63, wid = __builtin_amdgcn_readfirstlane(tid >> 6), c16 = lane & 15, kq = lane >> 4;
    const int b = u >> 3, h = (u >> 1) & 3, dir = u & 1;
    const bf16_t* z = (const bf16_t*)(P.ws + WS_Z);
    float* O = (float*)(P.ws + (dir ? WS_Y : WS_H));
    const float* lbv = (const float*)(P.ws + WS_LB) + ((size_t)l * 2 + dir) * 512 + h * 128;
    constexpr int PQ = 272;
    LAS unsigned char* QH = lds; LAS unsigned char* KT = lds + 8704; LAS unsigned char* KH = lds + 17408; LAS unsigned char* VV = lds + 26112;
    LAS float* DL = (LAS float*)(lds + 34816); LAS float* WT = DL + 128;
    const int ch = 2 * lane;
    const float lb0 = lbv[ch], lb1 = lbv[ch + 1];
    const int cf = (dir ? C_HFB : C_HFF) + h * 128 + ch, cq = C_HQ + h * 128 + ch, cv = C_HI + h * 128 + ch;
    f32x4 SA[4], SB[4];
#pragma unroll
    for (int G = 0; G < 4; ++G) { SA[G] = (f32x4){0.f, 0.f, 0.f, 0.f}; SB[G] = (f32x4){0.f, 0.f, 0.f, 0.f}; }
    unsigned rf[4], rq[4], rv[4];
#pragma unroll
    for (int k = 0; k < 4; ++k) { const bf16_t* zr = z + (size_t)hg_row(b, dir, 4 * wid + k) * ZP; rf[k] = *(const unsigned*)(zr + cf); rq[k] = *(const unsigned*)(zr + cq); rv[k] = *(const unsigned*)(zr + cv); }
    const int sA = 8 * (c16 >> 2) + (c16 & 3);
    const int tq = c16 >> 2, tp = c16 & 3;
    for (int st = 0; st < 72; ++st) {
        unsigned xf[4], xq[4], xv[4];
#pragma unroll
        for (int k = 0; k < 4; ++k) { xf[k] = rf[k]; xq[k] = rq[k]; xv[k] = rv[k]; }
        if (st + 1 < 72) {
#pragma unroll
            for (int k = 0; k < 4; ++k) { const bf16_t* zr = z + (size_t)hg_row(b, dir, (st + 1) * 32 + 4 * wid + k) * ZP; rf[k] = *(const unsigned*)(zr + cf); rq[k] = *(const unsigned*)(zr + cq); rv[k] = *(const unsigned*)(zr + cv); }
        }
        float g0[4], g1[4], k0[4], k1[4], q0[4], q1[4];
        float c0 = 1.f, c1 = 1.f;
#pragma unroll
        for (int k = 0; k < 4; ++k) {
            const float f0 = lb0 + (1.0f - lb0) * sigmoidf_(bf_lo(xf[k])), f1 = lb1 + (1.0f - lb1) * sigmoidf_(bf_hi(xf[k]));
            c0 *= f0; c1 *= f1; g0[k] = c0; g1[k] = c1;
            k0[k] = 1.0f - f0; k1[k] = 1.0f - f1; q0[k] = siluf_(bf_lo(xq[k])); q1[k] = siluf_(bf_hi(xq[k]));
        }
        WT[wid * 128 + ch] = c0; WT[wid * 128 + ch + 1] = c1;
        __syncthreads();
        float pre0 = 1.f, pre1 = 1.f, tot0 = 1.f, tot1 = 1.f;
#pragma unroll
        for (int w = 0; w < 8; ++w) { const float a0 = WT[w * 128 + ch], a1 = WT[w * 128 + ch + 1]; tot0 *= a0; tot1 *= a1; if (w < wid) { pre0 *= a0; pre1 *= a1; } }
#pragma unroll
        for (int k = 0; k < 4; ++k) {
            const float e0 = g0[k] * pre0, e1 = g1[k] * pre1;
            const float r0 = __builtin_amdgcn_rcpf(e0), r1 = __builtin_amdgcn_rcpf(e1);
            const float kt0 = k0[k] * r0, kt1 = k1[k] * r1;
            const int ro = (4 * wid + k) * PQ + ch * 2;
            *(LAS unsigned*)(QH + ro) = pk_bf16(q0[k] * e0, q1[k] * e1);
            *(LAS unsigned*)(KT + ro) = pk_bf16(kt0, kt1);
            *(LAS unsigned*)(KH + ro) = pk_bf16(kt0 * tot0, kt1 * tot1);
            *(LAS unsigned*)(VV + ro) = xv[k];
        }
        if (wid == 0) { DL[ch] = tot0; DL[ch + 1] = tot1; }
        __syncthreads();
        const bf16x8 vfr = tr2(VV + (8 * kq + tq) * PQ + (16 * wid + 4 * tp) * 2, VV + (8 * kq + 4 + tq) * PQ + (16 * wid + 4 * tp) * 2);
        bf16x8 Sb[4];
#pragma unroll
        for (int G = 0; G < 4; ++G) { const float sv[8] = {SA[G][0], SA[G][1], SA[G][2], SA[G][3], SB[G][0], SB[G][1], SB[G][2], SB[G][3]}; Sb[G] = pack8(sv); }
#pragma unroll
        for (int T = 0; T < 2; ++T) {
            f32x4 aA = {0.f, 0.f, 0.f, 0.f}, aB = {0.f, 0.f, 0.f, 0.f};
            bf16x8 qf[4];
#pragma unroll
            for (int ks = 0; ks < 4; ++ks) {
                const bf16x8 kA = *(const LAS bf16x8*)(KT + sA * PQ + (32 * ks + 8 * kq) * 2);
                const bf16x8 kB = *(const LAS bf16x8*)(KT + (sA + 4) * PQ + (32 * ks + 8 * kq) * 2);
                qf[ks] = *(const LAS bf16x8*)(QH + (16 * T + c16) * PQ + (32 * ks + 8 * kq) * 2);
                aA = __builtin_amdgcn_mfma_f32_16x16x32_bf16(kA, qf[ks], aA, 0, 0, 0);
                aB = __builtin_amdgcn_mfma_f32_16x16x32_bf16(kB, qf[ks], aB, 0, 0, 0);
            }
            const int t = 16 * T + c16;
            float pv_[8];
#pragma unroll
            for (int jj = 0; jj < 4; ++jj) { pv_[jj] = (8 * kq + jj <= t) ? aA[jj] : 0.f; pv_[4 + jj] = (8 * kq + 4 + jj <= t) ? aB[jj] : 0.f; }
            f32x4 o = {0.f, 0.f, 0.f, 0.f};
            o = __builtin_amdgcn_mfma_f32_16x16x32_bf16(pack8(pv_), vfr, o, 0, 0, 0);
#pragma unroll
            for (int ks = 0; ks < 4; ++ks) o = __builtin_amdgcn_mfma_f32_16x16x32_bf16(qf[ks], Sb[ks], o, 0, 0, 0);
#pragma unroll
            for (int jj = 0; jj < 4; ++jj) O[(size_t)hg_row(b, dir, st * 32 + 16 * T + 4 * kq + jj) * 512 + h * 128 + 16 * wid + c16] = o[jj];
        }
#pragma unroll
        for (int G = 0; G < 4; ++G) {
            const f32x4 d0 = *(const LAS f32x4*)(DL + 32 * G + 8 * kq), d1 = *(const LAS f32x4*)(DL + 32 * G + 8 * kq + 4);
            const LAS unsigned char* ka = KH + (8 * kq + tq) * PQ + (32 * G + 8 * tp) * 2;
            const bf16x8 hA = tr2(ka, ka + 4 * PQ), hB = tr2(ka + 8, ka + 4 * PQ + 8);
            SA[G] = __builtin_amdgcn_mfma_f32_16x16x32_bf16(hA, vfr, SA[G] * d0, 0, 0, 0);
            SB[G] = __builtin_amdgcn_mfma_f32_16x16x32_bf16(hB, vfr, SB[G] * d1, 0, 0, 0);
        }
    }
    __syncthreads();
}
__device__ __forceinline__ void gqa_unit(const Params& P, char* shm, int l, int U) {
    const bf16_t* z = (const bf16_t*)(P.ws + WS_Z); const bf16_t* kn = (const bf16_t*)(P.ws + WS_KN); const bf16_t* vn = (const bf16_t*)(P.ws + WS_VN);
    bf16_t* br = (bf16_t*)(P.ws + WS_BR);
    int b, hq, row0, NT;
    if (U < 512) { const int bg = U >> 5; b = bg >> 1; hq = (bg & 1) * 4 + ((U & 31) >> 3); row0 = b * 2048 + (U & 7) * 256; NT = 36; }
    else { const int v = U - 512; b = v >> 3; hq = v & 7; row0 = NLAT + b * 256; NT = 4; }
    const int g = hq >> 2;
    gqa::attn_unit<8>(z + (size_t)row0 * ZP + C_GQ + hq * 64, P.in[I_QNG] + l * 64, (const float*)(P.ws + WS_ROPE), (U < 512) ? ((U & 7) * 256) : -1,
                      kn + (size_t)b * 2304 * 128 + g * 64, vn + (size_t)b * 2304 * 128 + g * 64, br + (size_t)row0 * BRW + 1024 + hq * 64, NT, shm);
}
__device__ __forceinline__ void ph_mix(const Params& P, LAS unsigned char* lds, char* shm, int l, int pass = 0, int filter = 0) {
    const int tid = tid_();
    unsigned* qctr = (unsigned*)(P.ws + WS_CNT + 512) + l + 4 * pass;
    volatile LAS unsigned* qslot = (volatile LAS unsigned*)(lds + LDS_BYTES - 32);
    for (;;) {
        if (tid == 0) *qslot = __hip_atomic_fetch_add(qctr, 1u, __ATOMIC_RELAXED, __HIP_MEMORY_SCOPE_AGENT);
        __syncthreads();
        const int u = (int)*qslot;
        __syncthreads();
        if (u >= 960) break;
        const int kind = (u < 64) ? 2 : ((u >= 64 && u < 320) || (u >= 832 && u < 896)) ? 3 : 1;
        if (filter != 0 && filter != kind) continue;
        if (u < 64) hgrn_unit(P, lds, l, u);
        else if (u < 320) na_unit(P, lds, l, u - 64, (bf16_t*)(P.ws + WS_BR), BRW);
        else if (u < 832) gqa_unit(P, shm, l, u - 320);
        else if (u < 896) { if (l < DEPTH - 1) na_unit(P, lds, l, 256 + (u - 832), (bf16_t*)(P.ws + WS_BR), BRW); }
        else { if (l < DEPTH - 1) gqa_unit(P, shm, l, 512 + (u - 896)); }
        __syncthreads();
    }
}
#ifdef DIAG
__device__ __forceinline__ void ph_diag_cmp(const Params& P) {
    const bf16_t* br = (const bf16_t*)(P.ws + WS_BR); const bf16_t* d1 = (const bf16_t*)(P.ws + WS_END); const bf16_t* d2 = d1 + (size_t)NTOK * 512;
    const bf16_t* z = (const bf16_t*)(P.ws + WS_Z); const bf16_t* vt = (const bf16_t*)(P.ws + WS_NAVT);
    unsigned* dg = (unsigned*)(P.ws + 20480);
    unsigned c1 = 0, c2 = 0, c3 = 0;
    for (size_t i = (size_t)bid_() * NTHR + tid_(); i < (size_t)NTOK * 512; i += (size_t)gridDim.x * NTHR) {
        const size_t r = i >> 9; const int c = (int)(i & 511);
        const float a = bf2f(br[r * BRW + c]), x = bf2f(d1[i]);
        if (!(fabsf(x - a) <= 0.004f + 0.02f * fabsf(a))) ++c1;
        if (DIAG != 4 && d1[i] != d2[i]) ++c3;
        const int rr = (int)r; const int bb = rr < NLAT ? (rr >> 11) : ((rr - NLAT) >> 8); const int tok = rr < NLAT ? (256 + (rr & 2047)) : ((rr - NLAT) & 255);
        if (vt[((size_t)(bb * 8 + (c >> 6)) * 64 + (c & 63)) * 2304 + tok] != z[r * ZP + C_NAV + c]) ++c2;
    }
    if (c1) atomicAdd(dg + 1, c1);
    if (c2) atomicAdd(dg + 2, c2);
    if (c3) atomicAdd(dg + 3, c3);
}
__device__ __forceinline__ void ph_diag_out(const Params& P) {
    const volatile unsigned* dg = (const volatile unsigned*)(P.ws + 20480);
    const unsigned c1 = dg[1], c2 = dg[2], c3 = dg[3];
    if ((c1 | c2 | c3) == 0) return;
    unsigned k = 0; { unsigned v = c1; while (v) { ++k; v >>= 1; } }
    if (c2) k += 30; if (c3) k += 60;
    const float cst = sqrtf(10.0f * (float)k + 9.0f);
    for (size_t i = (size_t)bid_() * NTHR + tid_(); i < (size_t)NLAT * D; i += (size_t)gridDim.x * NTHR) P.out[i] = cst;
}
#endif

__device__ __forceinline__ void ph_readout(const Params& P, int l) {
    const int tid = tid_(), lane = tid & 63, wid = tid >> 6;
    const float* OF = (const float*)(P.ws + WS_H); const float* OB = (const float*)(P.ws + WS_Y);
    const bf16_t* z = (const bf16_t*)(P.ws + WS_Z);
    bf16_t* br = (bf16_t*)(P.ws + WS_BR);
    const float g0 = P.in[I_HGN][l * 128 + lane * 2], g1 = P.in[I_HGN][l * 128 + lane * 2 + 1];
    for (int r = bid_() * 8 + wid; r < NTOK; r += gridDim.x * 8) {
#pragma unroll
        for (int h = 0; h < 4; ++h) {
            const int c = h * 128 + lane * 2;
            const float2 a = *(const float2*)(OF + (size_t)r * 512 + c), bb = *(const float2*)(OB + (size_t)r * 512 + c);
            const float o0 = a.x + bb.x, o1 = a.y + bb.y;
            const float ss = wave_sum(o0 * o0 + o1 * o1);
            const float rstd = __builtin_amdgcn_rsqf(ss * (1.0f / 128.0f) + 1e-6f);
            const unsigned gz = *(const unsigned*)(z + (size_t)r * ZP + C_HG + c);
            *(unsigned*)(br + (size_t)r * BRW + 512 + c) = pk_bf16(o0 * rstd * g0 * siluf_(bf_lo(gz)), o1 * rstd * g1 * siluf_(bf_hi(gz)));
        }
    }
}
struct SchedMerge { int G, c; const char* br; const char* wb; bool last;
    __device__ __forceinline__ bool next(int i, pg8::Unit& u) const {
        const int nl = (c < 256) ? (256 - c + G - 1) / G : 0;
        int tile, bi, mode;
        if (i < 3 * nl) { tile = c + (i / 3) * G; bi = i % 3; mode = 0; }
        else { if (last) return false; const int sidx = c + (i - 3 * nl) * G; if (sidx >= 96) return false; tile = 256 + sidx / 3; bi = sidx % 3; mode = 1; }
        const int pm = tile >> 2, pn = tile & 3;
        u.row0 = pm * 256; u.col0 = pn * 256; u.aux = bi | (mode << 4);
        u.A = br + ((size_t)pm * 256 * BRW + bi * 512) * 2; u.B = wb + ((size_t)bi * 1024 + pn * 256) * 512 * 2; return true; } };
struct EpiMerge { const bf16_t* GT; bf16_t* YP; bf16_t* Y; bf16_t* PG;
    __device__ __forceinline__ void operator()(const f32x4 (&acc)[2][2][4][2], const pg8::Unit& u, int wr, int wc, int fr, int fq) const {
        const int tidx = (wr * 4 + wc) * 64 + fq * 16 + fr, bi = u.aux & 15, mode = u.aux >> 4, pm = u.row0 >> 8, pn = u.col0 >> 8;
        const bf16_t* gb = GT + ((size_t)pm * 12 + bi * 4 + pn) * 65536 + tidx * 8;
        if (mode == 1) {
            bf16_t* pb = PG + ((size_t)bi * 32 + (pm - 64) * 4 + pn) * 65536 + tidx * 8;
#pragma unroll
            for (int ai = 0; ai < 2; ++ai)
#pragma unroll
                for (int bj = 0; bj < 2; ++bj) {
                    uint4 g[4];
#pragma unroll
                    for (int m = 0; m < 4; ++m) g[m] = *(const uint4*)(gb + ((ai * 2 + bj) * 4 + m) * 4096);
#pragma unroll
                    for (int m = 0; m < 4; ++m) { const f32x4 v0 = acc[ai][bj][m][0], v1 = acc[ai][bj][m][1];
                        uint4 o; o.x = pk_bf16(bf_lo(g[m].x) * v0[0], bf_hi(g[m].x) * v0[1]); o.y = pk_bf16(bf_lo(g[m].y) * v0[2], bf_hi(g[m].y) * v0[3]);
                        o.z = pk_bf16(bf_lo(g[m].z) * v1[0], bf_hi(g[m].z) * v1[1]); o.w = pk_bf16(bf_lo(g[m].w) * v1[2], bf_hi(g[m].w) * v1[3]);
                        *(uint4*)(pb + ((ai * 2 + bj) * 4 + m) * 4096) = o; }
                }
            return;
        }
        bf16_t* yb = YP + ((size_t)pm * 4 + pn) * 65536 + tidx * 8;
#pragma unroll
        for (int ai = 0; ai < 2; ++ai)
#pragma unroll
            for (int bj = 0; bj < 2; ++bj) {
                uint4 g[4], p[4];
#pragma unroll
                for (int m = 0; m < 4; ++m) g[m] = *(const uint4*)(gb + ((ai * 2 + bj) * 4 + m) * 4096);
                if (bi != 0) {
#pragma unroll
                    for (int m = 0; m < 4; ++m) p[m] = *(const uint4*)(yb + ((ai * 2 + bj) * 4 + m) * 4096);
                } else {
#pragma unroll
                    for (int m = 0; m < 4; ++m) p[m] = make_uint4(0u, 0u, 0u, 0u);
                }
#pragma unroll
                for (int m = 0; m < 4; ++m) { const int k = ((ai * 2 + bj) * 4 + m) * 4096;
                    const f32x4 v0 = acc[ai][bj][m][0], v1 = acc[ai][bj][m][1];
                    const float t[8] = {bf_lo(p[m].x) + bf_lo(g[m].x) * v0[0], bf_hi(p[m].x) + bf_hi(g[m].x) * v0[1], bf_lo(p[m].y) + bf_lo(g[m].y) * v0[2], bf_hi(p[m].y) + bf_hi(g[m].y) * v0[3],
                                        bf_lo(p[m].z) + bf_lo(g[m].z) * v1[0], bf_hi(p[m].z) + bf_hi(g[m].z) * v1[1], bf_lo(p[m].w) + bf_lo(g[m].w) * v1[2], bf_hi(p[m].w) + bf_hi(g[m].w) * v1[3]};
                    if (bi != 2) { uint4 o; o.x = pk_bf16(t[0], t[1]); o.y = pk_bf16(t[2], t[3]); o.z = pk_bf16(t[4], t[5]); o.w = pk_bf16(t[6], t[7]); *(uint4*)(yb + k) = o; }
                    else { const int row = u.row0 + ai * 128 + wr * 64 + m * 16 + fr, col = u.col0 + bj * 128 + wc * 32 + 8 * fq;
                        uint4 o; o.x = pk_bf16(t[0], t[1]); o.y = pk_bf16(t[2], t[3]); o.z = pk_bf16(t[4], t[5]); o.w = pk_bf16(t[6], t[7]);
                        *(uint4*)(Y + (size_t)row * D + col) = o; }
                }
            }
    } };
__device__ __forceinline__ void ph_merge(const Params& P, LAS unsigned char* lds, int l) {
    SchedMerge S{(int)gridDim.x, bid_(), (const char*)(P.ws + WS_BR), (const char*)(P.ws + WS_WBR), l == DEPTH - 1};
    EpiMerge E{(const bf16_t*)(P.ws + WS_GT), (bf16_t*)(P.ws + WS_H), (bf16_t*)(P.ws + WS_Y), (bf16_t*)(P.ws + WS_PG)};
    pg8::gemm_phase(lds, pg8::Gemm{512, BRW, 512}, S, E);
    if (l + 1 < DEPTH && (int)bid_() >= 96) wconv_range(P, lds, l + 1, 0, 16 * 124, (int)bid_() - 96, (int)gridDim.x - 96);
}
struct EpiDelta { bf16_t* DX; const float* mods; int l;
    __device__ __forceinline__ void operator()(const f32x4 (&acc)[2][2][4][2], const pg8::Unit& u, int wr, int wc, int fr, int fq) const {
        const float* gate = mods + ((size_t)l * 9 + row_modrow(u.row0)) * 6144 + 2 * 1024 + u.col0 + wc * 32 + 8 * fq;
        f32x4 gv[2][2];
#pragma unroll
        for (int bj = 0; bj < 2; ++bj)
#pragma unroll
            for (int n = 0; n < 2; ++n) gv[bj][n] = *(const f32x4*)(gate + bj * 128 + n * 4);
#pragma unroll
        for (int ai = 0; ai < 2; ++ai)
#pragma unroll
            for (int m = 0; m < 4; ++m)
#pragma unroll
                for (int bj = 0; bj < 2; ++bj) { const int row = u.row0 + ai * 128 + wr * 64 + m * 16 + fr, col = u.col0 + bj * 128 + wc * 32 + 8 * fq;
                    const f32x4 v0 = acc[ai][bj][m][0] * gv[bj][0], v1 = acc[ai][bj][m][1] * gv[bj][1];
                    uint4 o; o.x = pk_bf16(v0[0], v0[1]); o.y = pk_bf16(v0[2], v0[3]); o.z = pk_bf16(v1[0], v1[1]); o.w = pk_bf16(v1[2], v1[3]);
                    *(uint4*)(DX + (size_t)row * D + col) = o; }
    } };
struct SchedWout { int G, c; const char* A; const char* B; bool last;
    __device__ __forceinline__ bool next(int i, pg8::Unit& u) const {
        const int nc = (!last && c < 32) ? 1 : 0;
        int tile;
        if (i < nc) tile = 256 + c; else { tile = c + (i - nc) * G; if (tile >= 256) return false; }
        const int pm = tile >> 2, pn = tile & 3;
        u.row0 = pm * 256; u.col0 = pn * 256; u.aux = 0; u.A = A + (size_t)pm * 256 * D * 2; u.B = B + (size_t)pn * 256 * D * 2; return true; } };
__device__ __forceinline__ void ph_wout(const Params& P, LAS unsigned char* lds, int l, bool dry = false) {
    const bool last = (l == DEPTH - 1);
    const int c = bid_();
    if (!last && c < 32) {
        const int tid = tid_(), wid = tid >> 6, lane = tid & 63, wr = wid >> 2, wc = wid & 3, fr = lane & 15, fq = lane >> 4;
        const bf16_t* PG = (const bf16_t*)(P.ws + WS_PG); bf16_t* Y = (bf16_t*)(P.ws + WS_Y);
        const int pp = c >> 2;
        for (int pn = 0; pn < 4; ++pn)
#pragma unroll
            for (int kk = 0; kk < 16; ++kk) {
                const size_t off = ((size_t)pp * 4 + pn) * 65536 + kk * 4096 + tid * 8;
                const uint4 a = *(const uint4*)(PG + off), b = *(const uint4*)(PG + (size_t)32 * 65536 + off), d = *(const uint4*)(PG + (size_t)64 * 65536 + off);
                const int ai = kk >> 3, bj = (kk >> 2) & 1, m = kk & 3;
                const int row = (64 + pp) * 256 + ai * 128 + wr * 64 + m * 16 + fr, col = pn * 256 + bj * 128 + wc * 32 + 8 * fq;
                uint4 o;
                o.x = pk_bf16(bf_lo(a.x) + bf_lo(b.x) + bf_lo(d.x), bf_hi(a.x) + bf_hi(b.x) + bf_hi(d.x)); o.y = pk_bf16(bf_lo(a.y) + bf_lo(b.y) + bf_lo(d.y), bf_hi(a.y) + bf_hi(b.y) + bf_hi(d.y));
                o.z = pk_bf16(bf_lo(a.z) + bf_lo(b.z) + bf_lo(d.z), bf_hi(a.z) + bf_hi(b.z) + bf_hi(d.z)); o.w = pk_bf16(bf_lo(a.w) + bf_lo(b.w) + bf_lo(d.w), bf_hi(a.w) + bf_hi(b.w) + bf_hi(d.w));
                *(uint4*)(Y + (size_t)row * D + col) = o;
            }
        asm volatile("s_waitcnt vmcnt(0)" ::: "memory");
        __syncthreads();
    }
    SchedWout S{(int)gridDim.x, c, (const char*)(P.ws + WS_Y), (const char*)(P.ws + WS_WOUT), last};
    EpiDelta E{(bf16_t*)(P.ws + (dry ? WS_END : WS_BR)), (const float*)(P.ws + WS_MODS), l};
    pg8::gemm_phase(lds, pg8::Gemm{D, D, D}, S, E);
    if (!dry) { if (last) wconv_range(P, lds, l, CONV_T_DENSE, CONV_T_ALL, c, (int)gridDim.x); else if (c >= 32) wconv_range(P, lds, l, CONV_T_DENSE, CONV_T_ALL, c - 32, (int)gridDim.x - 32); }
}
__device__ __forceinline__ void ph_norm2_route(const Params& P, LAS unsigned char* lds, int l, bool dry = false) {
    const int tid = tid_(), lane = tid & 63, wid = tid >> 6;
    LAS float* Wt = (LAS float*)lds;
    LAS int* lcnt = (LAS int*)(lds + 81920); LAS int* lbase = lcnt + 16; LAS int* rinfo = lbase + 16;
    LAS float* rw = (LAS float*)(rinfo + 128 * 4);
    { const f32x4* rt4 = (const f32x4*)((const float*)(P.ws + WS_RT) + (size_t)l * 20480);
      for (int i = tid; i < 5 * 1024; i += NTHR) *(LAS f32x4*)(Wt + i * 4) = rt4[i]; }
    if (tid < 16) lcnt[tid] = 0;
    __syncthreads();
    const float* xres = (const float*)(P.ws + WS_X);
    const bf16_t* dx = (const bf16_t*)(P.ws + WS_BR);
    bf16_t* f = (bf16_t*)(P.ws + (dry ? WS_END : WS_H));
    const float* g = P.in[I_GFFN] + l * 1024;
    int* cnt = (int*)(P.ws + (dry ? 32768 : WS_CNT)) + l * 16;
    int* inv = (int*)(P.ws + WS_INV);
    int* sel_e = (int*)(P.ws + (dry ? WS_END + 40000000 : WS_SELE)); float* sel_w = (float*)(P.ws + (dry ? WS_END + 41000000 : WS_SELW)); int* sel_p = (int*)(P.ws + (dry ? WS_END + 42000000 : WS_SELP));
    const int NR = (l == DEPTH - 1) ? NLAT : NTOK;
    const int r0 = bid_() * 8, rstep = gridDim.x * 8;
    int it = 0;
    for (int r = r0 + wid; r < NR; r += rstep, ++it) {
        const float* mod = (const float*)(P.ws + WS_MODS) + ((size_t)l * 9 + row_modrow(r)) * 6144;
        float4 x[4], o[4];
#pragma unroll
        for (int i = 0; i < 4; ++i) { x[i] = *(const float4*)(xres + (size_t)r * D + lane * 4 + 256 * i);
            const uint2 dv = *(const uint2*)(dx + (size_t)r * D + lane * 4 + 256 * i);
            x[i].x += bf_lo(dv.x); x[i].y += bf_hi(dv.x); x[i].z += bf_lo(dv.y); x[i].w += bf_hi(dv.y); }
        norm_row(x, g, mod + 3 * 1024, mod + 4 * 1024, lane, o);
#pragma unroll
        for (int i = 0; i < 4; ++i) { uint2 u; u.x = pk_bf16(o[i].x, o[i].y); u.y = pk_bf16(o[i].z, o[i].w); *(uint2*)(f + (size_t)r * D + lane * 4 + 256 * i) = u; }
        float lg[20];
#pragma unroll
        for (int j = 0; j < 20; ++j) {
            float s = 0.f;
#pragma unroll
            for (int i = 0; i < 4; ++i) { const f32x4 w = *(const LAS f32x4*)(Wt + j * 1024 + lane * 4 + 256 * i); s += o[i].x * w[0] + o[i].y * w[1] + o[i].z * w[2] + o[i].w * w[3]; }
            lg[j] = wave_sum(s);
        }
        if (lane == 0) {
            float gl[4]; int gi = 0;
#pragma unroll
            for (int j = 0; j < 4; ++j) gl[j] = lg[j] + P.in[I_BGR][l * 4 + j];
            float gm = gl[0];
#pragma unroll
            for (int j = 1; j < 4; ++j) if (gl[j] > gm) { gm = gl[j]; gi = j; }
            float se = 0.f;
#pragma unroll
            for (int j = 0; j < 4; ++j) se += __expf(gl[j] - gm);
            const float pg = __builtin_amdgcn_rcpf(se);
            float el[4];
#pragma unroll
            for (int j = 0; j < 4; ++j) {
                float v = 0.f;
#pragma unroll
                for (int q = 0; q < 4; ++q) v = (gi == q) ? lg[4 + q * 4 + j] : v;
                el[j] = v + P.in[I_BER][l * 16 + gi * 4 + j];
            }
            int i0 = 0; float v0 = el[0];
#pragma unroll
            for (int j = 1; j < 4; ++j) if (el[j] > v0) { v0 = el[j]; i0 = j; }
            int i1 = -1; float v1 = -INFINITY;
#pragma unroll
            for (int j = 0; j < 4; ++j) if (j != i0 && el[j] > v1) { v1 = el[j]; i1 = j; }
            const float w0 = __builtin_amdgcn_rcpf(1.0f + __expf(v1 - v0)), w1 = 1.0f - w0;
            const int e0 = gi * 4 + i0, e1 = gi * 4 + i1;
            const int slot = it * 8 + wid;
            rinfo[slot * 4 + 0] = e0 | (e1 << 8);
            rinfo[slot * 4 + 1] = __hip_atomic_fetch_add(&lcnt[e0], 1, __ATOMIC_RELAXED, __HIP_MEMORY_SCOPE_WORKGROUP);
            rinfo[slot * 4 + 2] = __hip_atomic_fetch_add(&lcnt[e1], 1, __ATOMIC_RELAXED, __HIP_MEMORY_SCOPE_WORKGROUP);
            rw[slot * 2] = w0 * pg; rw[slot * 2 + 1] = w1 * pg;
        }
    }
    __syncthreads();
    if (tid < 16) lbase[tid] = atomicAdd(&cnt[tid], lcnt[tid]);
    __syncthreads();
    for (int slot = tid; slot < 128; slot += NTHR) {
        const int r = r0 + (slot & 7) + (slot >> 3) * rstep;
        if (r < NR) { const int ee = rinfo[slot * 4], e0 = ee & 255, e1 = ee >> 8;
            sel_e[r * 2] = e0; sel_e[r * 2 + 1] = e1;
            sel_w[r * 2] = rw[slot * 2]; sel_w[r * 2 + 1] = rw[slot * 2 + 1];
            const int p0_ = lbase[e0] + rinfo[slot * 4 + 1], p1_ = lbase[e1] + rinfo[slot * 4 + 2];
            sel_p[r * 2] = p0_; sel_p[r * 2 + 1] = p1_;
            if (!dry) { inv[(size_t)e0 * NTOK + p0_] = r; inv[(size_t)e1 * NTOK + p1_] = r; } }
    }
    __syncthreads();
}
__device__ __forceinline__ void moe_offsets(const int* cnt, int (&off)[17]) {
    int a = 0;
#pragma unroll
    for (int e = 0; e < 16; ++e) { off[e] = a; a += (cnt[e] + 255) & ~255; }
    off[16] = a;
}
__device__ __forceinline__ void ph_scatter(const Params& P, int l) {
    const int tid = tid_(), lane = tid & 63, wid = tid >> 6;
    const int* cnt = (const int*)(P.ws + WS_CNT) + l * 16;
    int off[17]; moe_offsets(cnt, off);
    const bf16_t* f = (const bf16_t*)(P.ws + WS_H); bf16_t* Fs = (bf16_t*)(P.ws + WS_FS);
    const int* sel_e = (const int*)(P.ws + WS_SELE); const int* sel_p = (const int*)(P.ws + WS_SELP); int* srow = (int*)(P.ws + WS_SROW);
    for (int r = bid_() * 8 + wid; r < ((l == DEPTH - 1) ? NLAT : NTOK); r += gridDim.x * 8) {
        const uint4 a = *(const uint4*)(f + (size_t)r * D + lane * 8), b = *(const uint4*)(f + (size_t)r * D + 512 + lane * 8);
#pragma unroll
        for (int k = 0; k < 2; ++k) {
            const int e = sel_e[r * 2 + k];
            int o = 0;
#pragma unroll
            for (int q = 0; q < 16; ++q) o = (e == q) ? off[q] : o;
            const int d = o + sel_p[r * 2 + k];
            *(uint4*)(Fs + (size_t)d * D + lane * 8) = a; *(uint4*)(Fs + (size_t)d * D + 512 + lane * 8) = b;
            if (lane == 0) srow[r * 2 + k] = d;
        }
    }
}
struct SchedMoe { int NM, G, c; int tfirst[16]; const char* A; const char* W; size_t tA, eW, tW;
    __device__ __forceinline__ bool next(int i, pg8::Unit& u) const {
        const int L = i * G + c; if (L >= NM * 4) return false;
        const int pm = L >> 2, pn = L & 3;
        int e = 0;
#pragma unroll
        for (int q = 1; q < 16; ++q) e += (pm >= tfirst[q]) ? 1 : 0;
        u.row0 = pm * 256; u.col0 = pn * 256; u.aux = e; u.A = A + (size_t)pm * tA; u.B = W + (size_t)e * eW + (size_t)pn * tW; return true; } };
struct FSwiglu { bf16_t* H;
    __device__ __forceinline__ void operator()(const pg8::Unit&, int row, int col, const f32x4& v0, const f32x4& v1) const {
        const int hc = ((col & ~31) >> 1) + (col & 15);
        uint2 a; a.x = pk_bf16(siluf_(v0[0]) * v1[0], siluf_(v0[1]) * v1[1]); a.y = pk_bf16(siluf_(v0[2]) * v1[2], siluf_(v0[3]) * v1[3]);
        *(uint2*)(H + (size_t)row * EH + hc) = a; } };
__device__ __forceinline__ void moe_sched(const Params& P, int l, SchedMoe& S) {
    const int* cnt = (const int*)(P.ws + WS_CNT) + l * 16;
    int a = 0;
#pragma unroll
    for (int e = 0; e < 16; ++e) { S.tfirst[e] = a; a += (cnt[e] + 255) >> 8; }
    S.NM = a; S.G = (int)gridDim.x; S.c = bid_();
}
struct SchedMoeG { int NM, G, c; int tfirst[16]; int cnt[16]; const int* inv; const char* A; const char* W; int R[2], C[2];
    __device__ __forceinline__ bool next(int i, pg8::Unit& u) const {
        const int L = i * G + c; if (L >= NM * 4) return false;
        const int pm = L >> 2, pn = L & 3;
        int e = 0;
#pragma unroll
        for (int q = 1; q < 16; ++q) e += (pm >= tfirst[q]) ? 1 : 0;
        int tf = 0, ne = 0;
#pragma unroll
        for (int q = 0; q < 16; ++q) { tf = (e == q) ? tfirst[q] : tf; ne = (e == q) ? cnt[q] : ne; }
        u.row0 = pm * 256; u.col0 = pn * 256; u.aux = e | (tf << 8) | (ne << 16); u.A = A; u.B = W + (size_t)e * (1024 * 1024 * 2) + (size_t)pn * (256 * 1024 * 2);
        return true; }
    __device__ __forceinline__ void gather(const pg8::Unit& u, unsigned (&gv)[2][2]) const {
        const int e = u.aux & 255, tf = (u.aux >> 8) & 255, ne = (int)((unsigned)u.aux >> 16), p0 = ((u.row0 >> 8) - tf) * 256;
#pragma unroll
        for (int h = 0; h < 2; ++h)
#pragma unroll
            for (int k = 0; k < 2; ++k) { const int idx = p0 + h * 128 + R[k];
                const int tok = (idx < ne) ? inv[(size_t)e * NTOK + idx] : 0;
                gv[h][k] = (unsigned)(tok * D + C[k]) * 2u; } } };
__device__ __forceinline__ void ph_moe1(const Params& P, LAS unsigned char* lds, int l) {
    SchedMoeG S;
    { const int* cnt = (const int*)(P.ws + WS_CNT) + l * 16; int a = 0;
#pragma unroll
      for (int e = 0; e < 16; ++e) { S.tfirst[e] = a; S.cnt[e] = cnt[e]; a += (cnt[e] + 255) >> 8; }
      S.NM = a; }
    S.G = (int)gridDim.x; S.c = bid_(); S.inv = (const int*)(P.ws + WS_INV); S.A = (const char*)(P.ws + WS_H); S.W = (const char*)(P.ws + WS_WGU);
    { const int tid = tid_();
#pragma unroll
      for (int k = 0; k < 2; ++k) { int R_, C_; pg8::stage_rc(tid * 16 + k * 8192, R_, C_); S.R[k] = R_; S.C[k] = C_; } }
    pg8::EpiPair<FSwiglu> E{{(bf16_t*)(P.ws + WS_HS)}};
    pg8::gemm_phase<pg8::EpiPair<FSwiglu>, SchedMoeG, true>(lds, pg8::Gemm{1024, 1024, 1024}, S, E);
}
__device__ __forceinline__ void ph_moe2(const Params& P, LAS unsigned char* lds, int l) {
    SchedMoe S; moe_sched(P, l, S);
    S.A = (const char*)(P.ws + WS_HS); S.W = (const char*)(P.ws + WS_WDN); S.tA = (size_t)256 * EH * 2; S.eW = (size_t)1024 * 512 * 2; S.tW = (size_t)256 * 512 * 2;
    EpiStore16 E{(bf16_t*)(P.ws + WS_YS), D};
    pg8::gemm_phase(lds, pg8::Gemm{512, 512, 512}, S, E);
}
__device__ __forceinline__ int srow_of(const int (&moff)[17], int e, int p) { int o = 0;
#pragma unroll
    for (int q = 0; q < 16; ++q) o = (e == q) ? moff[q] : o;
    return o + p; }
__device__ __forceinline__ void ph_combine(const Params& P, int l, bool dry = false) {
    const int tid = tid_(), lane = tid & 63, wid = tid >> 6;
    float* xres = (float*)(P.ws + WS_X);
    const bf16_t* Ys = (const bf16_t*)(P.ws + WS_YS);
    const float* sel_w = (const float*)(P.ws + WS_SELW); const int* sel_e = (const int*)(P.ws + WS_SELE); const int* sel_p = (const int*)(P.ws + WS_SELP);
    int moff[17]; moe_offsets((const int*)(P.ws + WS_CNT) + l * 16, moff);
#define SROW_(i_) srow_of(moff, sel_e[i_], sel_p[i_])
    bf16_t* h = (bf16_t*)(P.ws + (dry ? WS_END : WS_H));
    const bf16_t* dxb = (const bf16_t*)(P.ws + WS_BR);
    const int NR_ = (l == DEPTH - 1) ? NLAT : NTOK, rs_ = gridDim.x * 8;
    int rq = bid_() * 8 + wid;
    float nw0 = 0.f, nw1 = 0.f; int ns0 = 0, ns1 = 0;
    if (rq < NR_) { nw0 = sel_w[rq * 2]; nw1 = sel_w[rq * 2 + 1]; ns0 = SROW_(rq * 2); ns1 = SROW_(rq * 2 + 1); }
    float4 xn[4]; uint2 dn[4], an[4], bn[4]; float cw0 = 0.f, cw1 = 0.f;
    if (rq < NR_) {
        cw0 = nw0; cw1 = nw1;
#pragma unroll
        for (int i = 0; i < 4; ++i) { const int c = lane * 4 + 256 * i; xn[i] = *(const float4*)(xres + (size_t)rq * D + c); dn[i] = *(const uint2*)(dxb + (size_t)rq * D + c);
            an[i] = *(const uint2*)(Ys + (size_t)ns0 * D + c); bn[i] = *(const uint2*)(Ys + (size_t)ns1 * D + c); }
        if (rq + rs_ < NR_) { nw0 = sel_w[(rq + rs_) * 2]; nw1 = sel_w[(rq + rs_) * 2 + 1]; ns0 = SROW_((rq + rs_) * 2); ns1 = SROW_((rq + rs_) * 2 + 1); }
    }
    for (int r = rq; r < NR_; r += rs_) {
        const float* gate = (const float*)(P.ws + WS_MODS) + ((size_t)l * 9 + row_modrow(r)) * 6144 + 5 * 1024;
        const float w0 = cw0, w1 = cw1;
        float4 x[4]; uint2 dv_[4], a_[4], b_[4];
#pragma unroll
        for (int i = 0; i < 4; ++i) { x[i] = xn[i]; dv_[i] = dn[i]; a_[i] = an[i]; b_[i] = bn[i]; }
        if (r + rs_ < NR_) {
            cw0 = nw0; cw1 = nw1;
#pragma unroll
            for (int i = 0; i < 4; ++i) { const int c = lane * 4 + 256 * i; xn[i] = *(const float4*)(xres + (size_t)(r + rs_) * D + c); dn[i] = *(const uint2*)(dxb + (size_t)(r + rs_) * D + c);
                an[i] = *(const uint2*)(Ys + (size_t)ns0 * D + c); bn[i] = *(const uint2*)(Ys + (size_t)ns1 * D + c); }
            if (r + 2 * rs_ < NR_) { nw0 = sel_w[(r + 2 * rs_) * 2]; nw1 = sel_w[(r + 2 * rs_) * 2 + 1]; ns0 = SROW_((r + 2 * rs_) * 2); ns1 = SROW_((r + 2 * rs_) * 2 + 1); }
        }
#pragma unroll
        for (int i = 0; i < 4; ++i) {
            const int c = lane * 4 + 256 * i;
            x[i].x += bf_lo(dv_[i].x); x[i].y += bf_hi(dv_[i].x); x[i].z += bf_lo(dv_[i].y); x[i].w += bf_hi(dv_[i].y);
            const uint2 a = a_[i], b = b_[i];
            const float4 gv = *(const float4*)(gate + c);
            x[i].x += gv.x * (w0 * bf_lo(a.x) + w1 * bf_lo(b.x)); x[i].y += gv.y * (w0 * bf_hi(a.x) + w1 * bf_hi(b.x));
            x[i].z += gv.z * (w0 * bf_lo(a.y) + w1 * bf_lo(b.y)); x[i].w += gv.w * (w0 * bf_hi(a.y) + w1 * bf_hi(b.y));
        }
        if (l < DEPTH - 1) {
#pragma unroll
            for (int i = 0; i < 4; ++i) *(float4*)((dry ? (float*)(P.ws + WS_END) + (size_t)NTOK * 512 : xres) + (size_t)r * D + lane * 4 + 256 * i) = x[i];
            const float* mod = (const float*)(P.ws + WS_MODS) + ((size_t)(l + 1) * 9 + row_modrow(r)) * 6144;
            float4 o[4];
            norm_row(x, P.in[I_GMIX] + (l + 1) * 1024, mod, mod + 1024, lane, o);
#pragma unroll
            for (int i = 0; i < 4; ++i) { uint2 u; u.x = pk_bf16(o[i].x, o[i].y); u.y = pk_bf16(o[i].z, o[i].w); *(uint2*)(h + (size_t)r * D + lane * 4 + 256 * i) = u; }
        } else if (r < NLAT) {
            float ss = 0.f;
#pragma unroll
            for (int i = 0; i < 4; ++i) ss += x[i].x * x[i].x + x[i].y * x[i].y + x[i].z * x[i].z + x[i].w * x[i].w;
            ss = wave_sum(ss);
            const float rstd = __builtin_amdgcn_rsqf(ss * (1.0f / 1024.0f) + 1e-6f);
#pragma unroll
            for (int i = 0; i < 4; ++i) {
                const int c = lane * 4 + 256 * i;
                const float4 gv = *(const float4*)(P.in[I_GFIN] + c);
                float4 o; o.x = x[i].x * rstd * gv.x; o.y = x[i].y * rstd * gv.y; o.z = x[i].z * rstd * gv.z; o.w = x[i].w * rstd * gv.w;
                *(float4*)((dry ? (float*)(P.ws + WS_END) : P.out) + (size_t)r * D + c) = o;
            }
        }
    }
}

constexpr int NPH_LAYER = 12, NPH = 1 + DEPTH * NPH_LAYER;
#define CAS __attribute__((address_space(4)))
__device__ __forceinline__ const Params& kparams() { const CAS Params* k = (const CAS Params*)__builtin_amdgcn_kernarg_segment_ptr(); asm volatile("" : "+s"(k)); return *(const Params*)k; }
__global__ void __launch_bounds__(NTHR, 2) fwd(Params P_) {
    extern __shared__ __attribute__((aligned(16))) unsigned char lds_raw[];
    LAS unsigned char* lds = (LAS unsigned char*)lds_raw;
    volatile LAS unsigned* xbw = (volatile LAS unsigned*)(lds + LDS_BYTES - 16);
    if (threadIdx.x == 0) { xbw[0] = 0u; xbw[1] = 0u; xbw[2] = 0u; xbw[3] = 0u; }
    __syncthreads();
    const int lo = P_.ph_lo, hi = P_.ph_hi;
    XcdBarrier bar; bar.bar = (unsigned*)(P_.ws + WS_BAR); bar.x = 0; bar.st = xbw;
    if (hi - lo > 1) bar = xcd_barrier_post((unsigned*)(P_.ws + WS_BAR), xbw);
#ifndef PHMASK
#define PHMASK 0xFFFF
#endif
#define EN(j) ((PHMASK >> (j)) & 1)
#define IN(k) (lo <= (k) && (k) < hi)
#define SEAM(k) do { if (IN(k) && IN((k) + 1)) xcd_barrier(bar); } while (0)
    if (EN(12) && IN(0)) for (int rep = 0; rep < NREP(12); ++rep) { ph_prologue(kparams(), lds); }
    SEAM(0);
    for (int l = 0; l < DEPTH; ++l) {
        const int p0 = 1 + l * NPH_LAYER;
        if (l == 0) { if (EN(0) && IN(p0 + 0)) for (int rep = 0; rep < NREP(0); ++rep) { ph_wconv(kparams(), lds, l); ph_norm1(kparams(), l); }
        SEAM(p0 + 0); }
        if (EN(1) && IN(p0 + 1)) for (int rep = 0; rep < NREP(1); ++rep) ph_g1(kparams(), lds);
        SEAM(p0 + 1);
        if (EN(2) && IN(p0 + 2)) for (int rep = 0; rep < NREP(2); ++rep) { ph_prep(kparams(), l); ph_navt(kparams(), lds); }
        SEAM(p0 + 2);
        if (EN(3) && IN(p0 + 3)) { ph_mix(kparams(), lds, (char*)lds_raw, l);
            if (REPEAT_MASK & 0x8) { xcd_barrier(bar); ph_mix(kparams(), lds, (char*)lds_raw, l, 1, 0); }
            if (REPEAT_MASK & 0x2000) { xcd_barrier(bar); ph_mix(kparams(), lds, (char*)lds_raw, l, 1, 1); }
            if (REPEAT_MASK & 0x4000) { xcd_barrier(bar); ph_mix(kparams(), lds, (char*)lds_raw, l, 1, 2); }
            if (REPEAT_MASK & 0x8000) { xcd_barrier(bar); ph_mix(kparams(), lds, (char*)lds_raw, l, 1, 3); } }
        SEAM(p0 + 3);
        if (EN(4) && IN(p0 + 4)) for (int rep = 0; rep < NREP(4); ++rep) {
#if defined(DIAG) && DIAG == 5
            { const Params& Pq = kparams(); const int G_ = gridDim.x, c_ = bid_(), vcu_ = (c_ % 8) * (G_ / 8) + c_ / 8; for (int u = vcu_; u < 320; u += G_) na_unit(Pq, lds, l, u, (bf16_t*)(Pq.ws + WS_BR), BRW); __syncthreads(); }
#endif
            ph_readout(kparams(), l);
#if defined(DIAG) && (DIAG == 1 || DIAG == 4)
            ph_diag_cmp(kparams());
#endif
#if defined(DIAG) && DIAG == 3
            { const Params& Pq = kparams(); const uint4* d1 = (const uint4*)(Pq.ws + WS_END); bf16_t* brq = (bf16_t*)(Pq.ws + WS_BR);
              for (size_t i = (size_t)bid_() * NTHR + tid_(); i < (size_t)NTOK * 64; i += (size_t)gridDim.x * NTHR) { const size_t r = i >> 6; const int c8 = (int)(i & 63) * 8; *(uint4*)(brq + r * BRW + c8) = d1[i]; } }
#endif
        }
        SEAM(p0 + 4);
        if (EN(5) && IN(p0 + 5)) for (int rep = 0; rep < NREP(5); ++rep) ph_merge(kparams(), lds, l);
        SEAM(p0 + 5);
        if (EN(6) && IN(p0 + 6)) for (int rep = 0; rep < NREP(6); ++rep) ph_wout(kparams(), lds, l, rep > 0);
        SEAM(p0 + 6);
        if (EN(7) && IN(p0 + 7)) for (int rep = 0; rep < NREP(7); ++rep) ph_norm2_route(kparams(), lds, l, rep > 0);
        SEAM(p0 + 7);
        if (EN(9) && IN(p0 + 9)) for (int rep = 0; rep < NREP(9); ++rep) ph_moe1(kparams(), lds, l);
        SEAM(p0 + 9);
        if (EN(10) && IN(p0 + 10)) for (int rep = 0; rep < NREP(10); ++rep) ph_moe2(kparams(), lds, l);
        SEAM(p0 + 10);
        if (EN(11) && IN(p0 + 11)) for (int rep = 0; rep < NREP(11); ++rep) { ph_combine(kparams(), l, rep > 0); if (l + 1 < DEPTH) wconv_range(kparams(), lds, l + 1, 16 * 124, CONV_T_DENSE, bid_(), gridDim.x); }
        if (l + 1 < DEPTH) { if (IN(p0 + 11) && IN(p0 + 13)) xcd_barrier(bar); }
    }
#if defined(DIAG) && (DIAG == 1 || DIAG == 4)
    xcd_barrier(bar); ph_diag_out(kparams());
#endif
#undef IN
#undef SEAM
}

#ifndef MK_PER_PHASE
#define MK_PER_PHASE 0
#endif
extern "C" void kernel_launch(void* const* d_in, const int* in_sizes, int n_in, void* d_out, int out_size, void* d_ws, size_t ws_size, hipStream_t stream) {
    static int grid = 0;
    if (grid == 0) {
        if (n_in != 24 || out_size != NLAT * D || ws_size < WS_END + (size_t)NTOK * 4096 + 4096) { fprintf(stderr, "kernel_launch: unexpected shapes (n_in %d out %d ws %zu need %zu)\n", n_in, out_size, ws_size, (size_t)WS_END); grid = -1; return; }
        int dev = 0, cus = 0, per_cu = 0;
        if (hipGetDevice(&dev) != hipSuccess || hipDeviceGetAttribute(&cus, hipDeviceAttributeMultiprocessorCount, dev) != hipSuccess) { grid = -1; return; }
        if (hipFuncSetAttribute((const void*)fwd, hipFuncAttributeMaxDynamicSharedMemorySize, LDS_BYTES) != hipSuccess) { fprintf(stderr, "kernel_launch: hipFuncSetAttribute failed\n"); grid = -1; return; }
        if (hipOccupancyMaxActiveBlocksPerMultiprocessor(&per_cu, (const void*)fwd, NTHR, LDS_BYTES) != hipSuccess || per_cu < 1) { fprintf(stderr, "kernel_launch: occupancy query says %d\n", per_cu); }
        (void)hipGetLastError();
        grid = cus;
    }
    if (grid < 0) return;
    (void)hipMemsetAsync(d_ws, 0, WS_ZERO_BYTES, stream);
    Params p{};
    for (int i = 0; i < 24; ++i) p.in[i] = (const float*)d_in[i];
    p.out = (float*)d_out; p.ws = (unsigned char*)d_ws;
#if MK_PER_PHASE
    for (int ph = 0; ph < NPH; ++ph) { p.ph_lo = ph; p.ph_hi = ph + 1; hipLaunchKernelGGL(fwd, dim3(grid), dim3(NTHR), LDS_BYTES, stream, p); }
#else
    p.ph_lo = 0; p.ph_hi = NPH; hipLaunchKernelGGL(fwd, dim3(grid), dim3(NTHR), LDS_BYTES, stream, p);
#endif
}
```

```cpp
#include <hip/hip_runtime.h>
#include <cstdio>
#include <cstdint>

#define LAS __attribute__((address_space(3)))
typedef unsigned short bf16_t;
typedef short bf16x8 __attribute__((ext_vector_type(8)));
typedef float f32x4 __attribute__((ext_vector_type(4)));
typedef unsigned u32x4 __attribute__((ext_vector_type(4)));

constexpr int D = 1024, NB = 8, SEQ = 2048, DEPTH = 4, CTXL = 256;
constexpr int NLAT = NB * SEQ, NCTX = NB * CTXL, NTOK = NLAT + NCTX;
constexpr int INC = 7936;
constexpr int ZP = 4864;
constexpr int C_NAQ = 0, C_NAK = 512, C_NAV = 1024, C_HQ = 1536, C_HFF = 2048, C_HFB = 2560, C_HI = 3072, C_HG = 3584,
              C_GQ = 4096, C_GK = 4608, C_GV = 4736, C_GATE = 4864;
constexpr int BRW = 1536;
constexpr int NEXP = 16, EH = 512;
constexpr int MPAD = 40960;
constexpr int NTHR = 512;
constexpr int LDS_BYTES = 147456;

constexpr size_t WS_BAR = 0;
constexpr size_t WS_CNT = 16384;
constexpr size_t WS_ZERO_BYTES = 65536;
constexpr size_t WS_MODS = 65536;
constexpr size_t WS_LB = WS_MODS + 884736;
constexpr size_t WS_ROPE = WS_LB + 16384;
constexpr size_t WS_SELE = WS_ROPE + 12288;
constexpr size_t WS_SELW = WS_SELE + 147456;
constexpr size_t WS_SELP = WS_SELW + 147456;
constexpr size_t WS_SROW = WS_SELP + 147456;
constexpr size_t WS_X = 2097152;
constexpr size_t WS_H = WS_X + (size_t)NTOK * D * 4;
constexpr size_t WS_Z = WS_H + (size_t)NTOK * D * 2;
constexpr size_t WS_GT = WS_Z + (size_t)NTOK * ZP * 2;
constexpr size_t WS_BR = WS_GT + (size_t)NTOK * 3072 * 2;
constexpr size_t WS_Y = WS_BR + (size_t)NTOK * BRW * 2;
constexpr size_t WS_QN = WS_Y + (size_t)NTOK * D * 2;
constexpr size_t WS_KN = WS_QN + (size_t)NTOK * 512 * 2;
constexpr size_t WS_VN = WS_KN + (size_t)NTOK * 128 * 2;
constexpr size_t WS_NAVT = WS_VN + (size_t)NTOK * 128 * 2;
constexpr size_t WS_WIN = WS_NAVT + (size_t)NTOK * 512 * 2;
constexpr size_t WS_WBR = WS_WIN + (size_t)INC * D * 2;
constexpr size_t WS_WOUT = WS_WBR + (size_t)3 * D * 512 * 2;
constexpr size_t WS_WGU = WS_WOUT + (size_t)D * D * 2;
constexpr size_t WS_WDN = WS_WGU + (size_t)NEXP * 1024 * 1024 * 2;
constexpr size_t WS_PG = WS_WDN + (size_t)NEXP * 1024 * 512 * 2;
constexpr size_t WS_INV = WS_PG + (size_t)96 * 65536 * 2;
constexpr size_t WS_END = WS_INV + (size_t)16 * NTOK * 4;
constexpr size_t WS_FS = WS_Z;
constexpr size_t WS_HS = WS_FS + (size_t)MPAD * 1024 * 2;
constexpr size_t WS_YS = WS_HS + (size_t)MPAD * 512 * 2;
static_assert(WS_YS + (size_t)MPAD * 1024 * 2 <= WS_BR, "moe alias");
constexpr size_t WS_RT = WS_SROW + 147456;
static_assert(WS_RT + 327680 <= WS_X, "ctl");

#define XB_TMO      128
#define XB_XCNT(j)  (256  + 64 * (j))
#define XB_XSUB(j)  (1280 + 64 * (j))
#define XB_XGEN(j)  (2304 + 64 * (j))
#define XB_TOP      3328
#define XB_TOPGEN   3392
#define XCD_BAR_WORDS 3456
#define XB_SPIN_CAP (1u << 22)
__device__ __forceinline__ unsigned xb_ld(unsigned* p)              { return __hip_atomic_load(p, __ATOMIC_RELAXED, __HIP_MEMORY_SCOPE_AGENT); }
__device__ __forceinline__ unsigned xb_add(unsigned* p, unsigned v) { return __hip_atomic_fetch_add(p, v, __ATOMIC_RELAXED, __HIP_MEMORY_SCOPE_AGENT); }
__device__ __forceinline__ unsigned xb_xcc_id() { return (unsigned)__builtin_amdgcn_s_getreg((3 << 11) | 20) & 0xFu; }
#define XB_SPIN(cond, bar) do { unsigned _sp = 0; while (cond) { __builtin_amdgcn_s_sleep(1); \
    if ((++_sp & 255u) == 0u) { if (xb_ld(&(bar)[XB_TMO])) break; if (_sp > XB_SPIN_CAP) { atomicAdd(&(bar)[XB_TMO], 1u); break; } } } } while (0)
struct XcdBarrier { unsigned* bar; unsigned x; volatile LAS unsigned* st; };
__device__ __forceinline__ XcdBarrier xcd_barrier_post(unsigned* bar, volatile LAS unsigned* st) {
    XcdBarrier b; b.bar = bar; b.x = xb_xcc_id(); b.st = st;
    if (threadIdx.x == 0) (void)xb_add(&bar[XB_XCNT(b.x)], 1u);
    return b;
}
__device__ __forceinline__ void xcd_barrier_complete(unsigned* bar, unsigned x, unsigned& nloc, unsigned& nx) {
    const unsigned G = gridDim.x * gridDim.y * gridDim.z;
    unsigned sum, cnt, mine, sp = 0u;
    for (;;) {
        sum = 0u; cnt = 0u; mine = 0u;
#pragma unroll
        for (unsigned j = 0; j < 16; ++j) { const unsigned c = xb_ld(&bar[XB_XCNT(j)]); sum += c; cnt += (c > 0u) ? 1u : 0u; mine = (j == x) ? c : mine; }
        if (sum == G) break;
        __builtin_amdgcn_s_sleep(1);
        if ((++sp & 255u) == 0u) { if (xb_ld(&bar[XB_TMO])) break; if (sp > XB_SPIN_CAP) { atomicAdd(&bar[XB_TMO], 1u); break; } }
    }
    nloc = mine > 0u ? mine : 1u; nx = cnt > 0u ? cnt : 1u;
}
__device__ __forceinline__ void xcd_barrier(const XcdBarrier& b) {
    asm volatile("s_waitcnt vmcnt(0)" ::: "memory");
    __syncthreads();
    if (threadIdx.x == 0) {
        unsigned* bar = b.bar;
        __builtin_amdgcn_s_waitcnt(0);
        unsigned nloc = b.st[0], nx = b.st[1];
        if (nloc == 0u) { xcd_barrier_complete(bar, b.x, nloc, nx); b.st[0] = nloc; b.st[1] = nx; }
        const unsigned old = xb_add(&bar[XB_XSUB(b.x)], 1u);
        const unsigned gen = old / nloc;
        if (old + 1u == (gen + 1u) * nloc) {
            __builtin_amdgcn_fence(__ATOMIC_RELEASE, "agent");
            asm volatile("s_waitcnt vmcnt(0)" ::: "memory");
            const unsigned og = xb_add(&bar[XB_TOP], 1u);
            const unsigned tg = og / nx;
            if (og + 1u == (tg + 1u) * nx) xb_add(&bar[XB_TOPGEN], 1u);
            else XB_SPIN(xb_ld(&bar[XB_TOPGEN]) == tg, bar);
            __builtin_amdgcn_fence(__ATOMIC_ACQUIRE, "agent");
            xb_add(&bar[XB_XGEN(b.x)], 1u);
            asm volatile("s_waitcnt vmcnt(0)" ::: "memory");
        } else {
            XB_SPIN(xb_ld(&bar[XB_XGEN(b.x)]) == gen, bar);
            __builtin_amdgcn_fence(__ATOMIC_ACQUIRE, "agent");
            asm volatile("s_waitcnt vmcnt(0)" ::: "memory");
        }
    }
    __syncthreads();
}

__device__ __forceinline__ float bf_lo(unsigned u) { return __uint_as_float(u << 16); }
__device__ __forceinline__ float bf_hi(unsigned u) { return __uint_as_float(u & 0xffff0000u); }
__device__ __forceinline__ float bf2f(bf16_t b) { return __uint_as_float(((unsigned)b) << 16); }
typedef float pkf32x2_t __attribute__((ext_vector_type(2))); typedef __bf16 pkbf16x2_t __attribute__((ext_vector_type(2)));
__device__ __forceinline__ unsigned pk_bf16(float lo, float hi) { pkf32x2_t v = {lo, hi}; pkbf16x2_t b = __builtin_convertvector(v, pkbf16x2_t); return __builtin_bit_cast(unsigned, b); }
__device__ __forceinline__ bf16x8 pack8(const float (&v)[8]) { u32x4 u = {pk_bf16(v[0], v[1]), pk_bf16(v[2], v[3]), pk_bf16(v[4], v[5]), pk_bf16(v[6], v[7])}; return __builtin_bit_cast(bf16x8, u); }
__device__ __forceinline__ float sigmoidf_(float x) { return __builtin_amdgcn_rcpf(1.0f + __expf(-x)); }
__device__ __forceinline__ float siluf_(float x) { return x * __builtin_amdgcn_rcpf(1.0f + __expf(-x)); }
__device__ __forceinline__ float dpp_f(float v, const int ctrl_sel) {
    const int x = __float_as_int(v);
    int r;
    if (ctrl_sel == 0) r = __builtin_amdgcn_update_dpp(0, x, 0xB1, 0xF, 0xF, true);
    else if (ctrl_sel == 1) r = __builtin_amdgcn_update_dpp(0, x, 0x4E, 0xF, 0xF, true);
    else if (ctrl_sel == 2) r = __builtin_amdgcn_update_dpp(0, x, 0x141, 0xF, 0xF, true);
    else r = __builtin_amdgcn_update_dpp(0, x, 0x140, 0xF, 0xF, true);
    return __int_as_float(r);
}
__device__ __forceinline__ float wave_sum(float v) {
    v += dpp_f(v, 0); v += dpp_f(v, 1); v += dpp_f(v, 2); v += dpp_f(v, 3);
    { auto rr = __builtin_amdgcn_permlane16_swap(__float_as_uint(v), __float_as_uint(v), false, false); v = __uint_as_float(rr[0]) + __uint_as_float(rr[1]); }
    { auto rr = __builtin_amdgcn_permlane32_swap(__float_as_uint(v), __float_as_uint(v), false, false); v = __uint_as_float(rr[0]) + __uint_as_float(rr[1]); }
    return v;
}

__device__ __forceinline__ int tid_() { int t = threadIdx.x; asm volatile("" : "+v"(t)); return t; }
__device__ __forceinline__ int bid_() { int t = blockIdx.x; asm volatile("" : "+s"(t)); return t; }
#ifndef REPEAT_MASK
#define REPEAT_MASK 0
#endif
#define NREP(j) (((REPEAT_MASK >> (j)) & 1) ? 2 : 1)
struct Params {
    const float* in[24];
    float* out;
    unsigned char* ws;
    int ph_lo, ph_hi;
};
enum { I_X = 0, I_C, I_CTX, I_CCTX, I_WADA, I_BADA, I_GMIX, I_GFFN, I_WIN, I_RPB, I_LBL, I_HGN, I_QNG, I_KNG, I_WBR, I_WOUT,
       I_WGR, I_BGR, I_WER, I_BER, I_WEG, I_WEU, I_WED, I_GFIN };

__device__ __forceinline__ void g128_kloop(f32x4 (&acc)[4][4], LAS unsigned char* lds, const bf16_t* A, int lda, const bf16_t* Bt, int ldb, int K) {
    const int tid = tid_(), wid = tid >> 6, lane = tid & 63, wr = wid >> 2, wc = wid & 3, fr = lane & 15, fq = lane >> 4;
    LAS unsigned char* SA = lds; LAS unsigned char* SB = lds + 8192;
    const int srow = tid >> 2, skc = (tid & 3) * 8;
    const bf16_t* ap = A + (size_t)srow * lda + skc;
    const bf16_t* bp0 = Bt + (size_t)srow * ldb + skc;
    const bf16_t* bp1 = Bt + (size_t)(srow + 128) * ldb + skc;
    for (int k0 = 0; k0 < K; k0 += 32) {
        const uint4 va = *(const uint4*)(ap + k0);
        const uint4 vb0 = *(const uint4*)(bp0 + k0);
        const uint4 vb1 = *(const uint4*)(bp1 + k0);
        __syncthreads();
        *(LAS u32x4*)(SA + tid * 16) = (u32x4){va.x, va.y, va.z, va.w};
        *(LAS u32x4*)(SB + tid * 16) = (u32x4){vb0.x, vb0.y, vb0.z, vb0.w};
        *(LAS u32x4*)(SB + 8192 + tid * 16) = (u32x4){vb1.x, vb1.y, vb1.z, vb1.w};
        __syncthreads();
        bf16x8 At[4], Bf[4];
#pragma unroll
        for (int m = 0; m < 4; ++m) At[m] = *(const LAS bf16x8*)(SA + ((wr * 64 + m * 16 + fr) * 32 + fq * 8) * 2);
#pragma unroll
        for (int n = 0; n < 4; ++n) Bf[n] = *(const LAS bf16x8*)(SB + ((wc * 64 + n * 16 + fr) * 32 + fq * 8) * 2);
#pragma unroll
        for (int m = 0; m < 4; ++m)
#pragma unroll
            for (int n = 0; n < 4; ++n) acc[m][n] = __builtin_amdgcn_mfma_f32_16x16x32_bf16(Bf[n], At[m], acc[m][n], 0, 0, 0);
    }
}
__device__ __forceinline__ void acc_zero(f32x4 (&acc)[4][4]) {
#pragma unroll
    for (int m = 0; m < 4; ++m)
#pragma unroll
        for (int n = 0; n < 4; ++n) acc[m][n] = (f32x4){0.f, 0.f, 0.f, 0.f};
}
template <class Epi>
__device__ __forceinline__ void g128_epilogue(const f32x4 (&acc)[4][4], int row0, int col0, const Epi& E) {
    const int tid = tid_(), wid = tid >> 6, lane = tid & 63, wr = wid >> 2, wc = wid & 3, fr = lane & 15, fq = lane >> 4;
#pragma unroll
    for (int m = 0; m < 4; ++m)
#pragma unroll
        for (int n = 0; n < 4; n += 2) E(row0 + wr * 64 + m * 16 + fr, col0 + wc * 64 + n * 16 + fq * 4, acc[m][n], acc[m][n + 1]);
}


namespace pg8 {
constexpr int BM = 256, BK = 64, HALF = 128, HTB = HALF * BK * 2, STAGE_BYTES = 8 * HTB;
__device__ __forceinline__ int lds_byte(int r, int c) { const int st = (r >> 4) * 2 + (c >> 5), rr = r & 15, cc = c & 31, ob = rr * 64 + cc * 2; return st * 1024 + (ob ^ (((ob >> 9) & 1) << 5)); }
__device__ __forceinline__ void stage_rc(int b, int& R, int& C) { const int st = b / 1024, sb = b % 1024, swz = sb ^ (((sb >> 9) & 1) << 5); R = (st >> 1) * 16 + swz / 64; C = (st & 1) * 32 + (swz % 64) / 2; }
struct Unit { int row0, col0, aux; const char* A; const char* B; };
struct Gemm { int K, lda, ldb; };
template <class Epi, class Sched, bool GATHER = false>
__device__ __forceinline__ void gemm_phase(LAS unsigned char* lds, const Gemm g, const Sched& S, const Epi& E) {
    const int tid = tid_(), wid = __builtin_amdgcn_readfirstlane(tid >> 6), lane = tid & 63, wr = wid >> 2, wc = wid & 3, fr = lane & 15, fq = lane >> 4;
    const int K = g.K, nt = K / BK;
    unsigned voffA[2], voffB[2];
#pragma unroll
    for (int i = 0; i < 2; ++i) { int R, C; stage_rc(tid * 16 + i * 8192, R, C);
        voffA[i] = (unsigned)(R * g.lda + C) * 2u; voffB[i] = (unsigned)(R * g.ldb + C) * 2u; }
    const size_t kstep = (size_t)(BK * 2);
    const size_t hstepA = (size_t)HALF * g.lda * 2, hstepB = (size_t)HALF * g.ldb * 2;
    const unsigned ldsw = (unsigned)wid * 1024u;
    const int aoff = lds_byte(wr * 64 + fr, fq * 8), boff = lds_byte(wc * 32 + fr, fq * 8);
#define PG8_SA(b, h) (((b) * 2 + (h)) * HTB)
#define PG8_SB(b, h) ((4 + (b) * 2 + (h)) * HTB)
#define PG8_STAGE(bufoff, gbase, voff) do { _Pragma("unroll") for (int _i = 0; _i < 2; ++_i) \
        __builtin_amdgcn_global_load_lds((const unsigned*)((const char*)(gbase) + (voff)[_i]), (LAS unsigned*)(lds + (bufoff) + ldsw + _i * 8192), 16, 0, 0); } while (0)
#define PG8_STAGE_A(b, h, ptr, nx) do { if constexpr (GATHER) { const unsigned gsel_[2] = {(nx) ? ngv[h][0] : cgv[h][0], (nx) ? ngv[h][1] : cgv[h][1]}; PG8_STAGE(PG8_SA(b, h), (ptr), gsel_); } \
        else { PG8_STAGE(PG8_SA(b, h), (ptr) + ((h) ? hstepA : 0), voffA); } } while (0)
#define PG8_LDA(dst, b, h) do { _Pragma("unroll") for (int m = 0; m < 4; ++m) _Pragma("unroll") for (int k = 0; k < 2; ++k) dst[m][k] = *(const LAS bf16x8*)(lds + PG8_SA(b, h) + aoff + m * 2048 + k * 1024); } while (0)
#define PG8_LDB(dst, b, h) do { _Pragma("unroll") for (int n = 0; n < 2; ++n) _Pragma("unroll") for (int k = 0; k < 2; ++k) dst[n][k] = *(const LAS bf16x8*)(lds + PG8_SB(b, h) + boff + n * 2048 + k * 1024); } while (0)
#define PG8_MMA(ai, bj, At, Bt) do { __builtin_amdgcn_s_setprio(1); _Pragma("unroll") for (int m = 0; m < 4; ++m) _Pragma("unroll") for (int n = 0; n < 2; ++n) _Pragma("unroll") for (int k = 0; k < 2; ++k) \
        acc[ai][bj][m][n] = __builtin_amdgcn_mfma_f32_16x16x32_bf16(Bt[n][k], At[m][k], acc[ai][bj][m][n], 0, 0, 0); __builtin_amdgcn_s_setprio(0); } while (0)
#define PG8_WAIT_V(n) asm volatile("s_waitcnt vmcnt(" #n ")" ::: "memory")
#define PG8_WAIT_L(n) asm volatile("s_waitcnt lgkmcnt(" #n ")" ::: "memory")
#define PG8_BAR __builtin_amdgcn_s_barrier()
#define PG8_SCHED __builtin_amdgcn_sched_barrier(0)
    Unit cur, nxt; int ui = 0;
    if (!S.next(0, cur)) return;
    f32x4 acc[2][2][4][2];
#pragma unroll
    for (int a = 0; a < 2; ++a)
#pragma unroll
        for (int b = 0; b < 2; ++b)
#pragma unroll
            for (int m = 0; m < 4; ++m)
#pragma unroll
                for (int n = 0; n < 2; ++n) acc[a][b][m][n] = (f32x4){0.f, 0.f, 0.f, 0.f};
    bf16x8 At[4][2], B0[2][2], B1[2][2];
    const char* cA = cur.A; const char* cB = cur.B;
    unsigned cgv[2][2] = {{0u, 0u}, {0u, 0u}}, ngv[2][2] = {{0u, 0u}, {0u, 0u}};
    if constexpr (GATHER) S.gather(cur, cgv);
    PG8_STAGE(PG8_SB(0, 0), cB, voffB); PG8_STAGE(PG8_SB(0, 1), cB + hstepB, voffB); PG8_STAGE_A(0, 0, cA, false); PG8_STAGE_A(0, 1, cA, false);
    if (wr == 1) PG8_BAR;
    PG8_WAIT_V(2); PG8_BAR;
    PG8_STAGE(PG8_SB(1, 0), cB + kstep, voffB); PG8_STAGE_A(1, 0, cA + kstep, false); PG8_STAGE(PG8_SB(1, 1), cB + hstepB + kstep, voffB);
    PG8_WAIT_V(6); PG8_BAR;
    for (;;) {
        const bool has_next = S.next(ui + 1, nxt);
        const char* nA = has_next ? nxt.A : cA; const char* nB = has_next ? nxt.B : cB;
        if constexpr (GATHER) {
            if (has_next) S.gather(nxt, ngv);
            else {
#pragma unroll
                for (int h_ = 0; h_ < 2; ++h_)
#pragma unroll
                    for (int i_ = 0; i_ < 2; ++i_) ngv[h_][i_] = cgv[h_][i_]; } }
        for (int t = 0; t < nt; t += 2) {
            const bool last = (t == nt - 2);
            const char* a1 = cA + (size_t)(t + 1) * kstep;
            const char* a2 = last ? nA : cA + (size_t)(t + 2) * kstep; const char* b2 = last ? nB : cB + (size_t)(t + 2) * kstep;
            const char* a3 = a2 + kstep; const char* b3 = b2 + kstep;
            PG8_LDB(B0, 0, 0); PG8_LDB(B1, 0, 1); PG8_SCHED; PG8_LDA(At, 0, 0); PG8_STAGE_A(1, 1, a1, false);
            PG8_WAIT_V(8); PG8_WAIT_L(0); PG8_BAR; PG8_MMA(0, 0, At, B0); PG8_MMA(0, 1, At, B1); PG8_BAR; PG8_SCHED;
            PG8_LDA(At, 0, 1); PG8_STAGE(PG8_SB(0, 0), b2, voffB); PG8_STAGE(PG8_SB(0, 1), b2 + hstepB, voffB); PG8_STAGE_A(0, 0, a2, last);
            PG8_WAIT_V(8); PG8_WAIT_L(0); PG8_BAR; PG8_MMA(1, 0, At, B0); PG8_MMA(1, 1, At, B1); PG8_BAR; PG8_SCHED;
            PG8_LDB(B0, 1, 0); PG8_LDB(B1, 1, 1); PG8_SCHED; PG8_LDA(At, 1, 0); PG8_STAGE_A(0, 1, a2, last);
            PG8_WAIT_V(8); PG8_WAIT_L(0); PG8_BAR; PG8_MMA(0, 0, At, B0); PG8_MMA(0, 1, At, B1); PG8_BAR; PG8_SCHED;
            PG8_LDA(At, 1, 1); PG8_STAGE(PG8_SB(1, 0), b3, voffB); PG8_STAGE(PG8_SB(1, 1), b3 + hstepB, voffB); PG8_STAGE_A(1, 0, a3, last);
            PG8_WAIT_V(8); PG8_WAIT_L(0); PG8_BAR; PG8_MMA(1, 0, At, B0); PG8_MMA(1, 1, At, B1); PG8_BAR; PG8_SCHED;
        }
        if (wr == 0) PG8_BAR;
        E(acc, cur, wr, wc, fr, fq);
        if (!has_next) break;
#pragma unroll
        for (int a = 0; a < 2; ++a)
#pragma unroll
            for (int b = 0; b < 2; ++b)
#pragma unroll
                for (int m = 0; m < 4; ++m)
#pragma unroll
                    for (int n = 0; n < 2; ++n) acc[a][b][m][n] = (f32x4){0.f, 0.f, 0.f, 0.f};
        cur = nxt; cA = nA; cB = nB; ++ui;
        if constexpr (GATHER) {
#pragma unroll
            for (int h_ = 0; h_ < 2; ++h_)
#pragma unroll
                for (int i_ = 0; i_ < 2; ++i_) cgv[h_][i_] = ngv[h_][i_]; }
        if (wr == 1) PG8_BAR;
    }
    PG8_WAIT_V(0);
    PG8_BAR;
#undef PG8_SA
#undef PG8_SB
#undef PG8_STAGE
#undef PG8_STAGE_A
#undef PG8_LDA
#undef PG8_LDB
#undef PG8_MMA
#undef PG8_WAIT_V
#undef PG8_WAIT_L
#undef PG8_BAR
#undef PG8_SCHED
}
template <class F> struct EpiPair { F f;
    __device__ __forceinline__ void operator()(const f32x4 (&acc)[2][2][4][2], const Unit& u, int wr, int wc, int fr, int fq) const {
#pragma unroll
        for (int ai = 0; ai < 2; ++ai)
#pragma unroll
            for (int m = 0; m < 4; ++m)
#pragma unroll
                for (int bj = 0; bj < 2; ++bj) f(u, u.row0 + ai * HALF + wr * 64 + m * 16 + fr, u.col0 + bj * HALF + wc * 32 + 4 * fq, acc[ai][bj][m][0], acc[ai][bj][m][1]);
    } };
struct SchedDense { int nM, nN, G, c; const char* A; const char* B; size_t tA, tB;
    __device__ __forceinline__ bool next(int i, Unit& u) const {
        const int nwg = nM * nN; const long L = (long)i * G + c; if (L >= nwg) return false;
        int wgid = (int)L; { const int q = nwg / 8, r = nwg % 8, xcd = wgid % 8, off = wgid / 8; wgid = (xcd < r ? xcd * (q + 1) : r * (q + 1) + (xcd - r) * q) + off; }
        const int nig = 8 * nN, gid = wgid / nig, fm = gid * 8, gsz = (nM - fm) < 8 ? (nM - fm) : 8;
        const int pm = fm + ((wgid % nig) % gsz), pn = (wgid % nig) / gsz;
        u.row0 = pm * 256; u.col0 = pn * 256; u.aux = 0; u.A = A + (size_t)pm * tA; u.B = B + (size_t)pn * tB; return true; } };
}


namespace gqa {
using f32x16 = __attribute__((ext_vector_type(16))) float;
using s16x4 = __attribute__((ext_vector_type(4))) short;
constexpr int QP = 512, KVP = 128, OP = BRW;
constexpr int NW = 8, QBLK = 32, KVBLK = 64;
__device__ __forceinline__ int crow(int r, int hi) { return (r & 3) + 8 * (r >> 2) + 4 * hi; }
#define SBAR() __builtin_amdgcn_sched_barrier(0)
constexpr int NSLOT = 3, SLOTB = 8192;
constexpr int LDS_K = 0, LDS_V = NSLOT * SLOTB, LDS_WS = 2 * NSLOT * SLOTB, LDS_OST = LDS_WS + NW * 64 * 4, LDS_BYTES_ = LDS_OST + NW * 4096;
__device__ __forceinline__ void glds16(const void* gsrc, unsigned lds_dst) { unsigned keep;
  asm volatile("s_mov_b32 %0, m0\n\ts_mov_b32 m0, %2\n\ts_nop 0\n\tglobal_load_lds_dwordx4 %1, off\n\ts_mov_b32 m0, %0" : "=&s"(keep) : "v"(gsrc), "s"(lds_dst) : "memory"); }
__device__ __forceinline__ float max3f(float a, float b, float c) { float r; asm("v_max3_f32 %0, %1, %2, %3" : "=v"(r) : "v"(a), "v"(b), "v"(c)); return r; }
__device__ __forceinline__ float max2f(float a, float b) { float r; asm("v_max_f32_e32 %0, %1, %2" : "=v"(r) : "v"(a), "v"(b)); return r; }
__device__ __forceinline__ float fadd_s(float a, float b) { float r; asm("v_add_f32_e32 %0, %1, %2" : "=v"(r) : "v"(a), "v"(b)); return r; }
__device__ __forceinline__ float fsub_s(float a, float b) { float r; asm("v_sub_f32_e32 %0, %1, %2" : "=v"(r) : "v"(a), "v"(b)); return r; }
typedef float f32x2_t __attribute__((ext_vector_type(2))); typedef __bf16 bf16x2_t __attribute__((ext_vector_type(2)));
__device__ __forceinline__ unsigned cvtpk_s(float lo, float hi) { f32x2_t v = {lo, hi}; bf16x2_t b = __builtin_convertvector(v, bf16x2_t); return __builtin_bit_cast(unsigned, b); }
#define WAIT_BAR(N) asm volatile("s_waitcnt vmcnt(" #N ") lgkmcnt(0)\n\ts_barrier" ::: "memory")
__device__ __forceinline__ void qkt(f32x16& p0, f32x16& p1, const char* Kslot, const bf16x8* qr, const f32x16& negm, int r32, int hi) {
  const char* kb = Kslot + hi * 1024 + r32 * 16;
  #pragma unroll
  for (int d0 = 0; d0 < 4; ++d0) {
    const bf16x8 b0 = *reinterpret_cast<const bf16x8*>(kb + d0 * 2048);
    const bf16x8 b1 = *reinterpret_cast<const bf16x8*>(kb + d0 * 2048 + 512);
    if (d0 == 0) { p0 = __builtin_amdgcn_mfma_f32_32x32x16_bf16(b0, qr[0], negm, 0, 0, 0); p1 = __builtin_amdgcn_mfma_f32_32x32x16_bf16(b1, qr[0], negm, 0, 0, 0); }
    else { p0 = __builtin_amdgcn_mfma_f32_32x32x16_bf16(b0, qr[d0], p0, 0, 0, 0); p1 = __builtin_amdgcn_mfma_f32_32x32x16_bf16(b1, qr[d0], p1, 0, 0, 0); } }
}
typedef __attribute__((address_space(3))) const char* lds_cptr;
typedef short v4i16_t __attribute__((ext_vector_type(4)));
__device__ __forceinline__ void kload8(bf16x8* kf, lds_cptr kp) {
  kf[0] = *(const LAS bf16x8*)(kp);        kf[1] = *(const LAS bf16x8*)(kp + 512);
  kf[2] = *(const LAS bf16x8*)(kp + 2048); kf[3] = *(const LAS bf16x8*)(kp + 2560);
  kf[4] = *(const LAS bf16x8*)(kp + 4096); kf[5] = *(const LAS bf16x8*)(kp + 4608);
  kf[6] = *(const LAS bf16x8*)(kp + 6144); kf[7] = *(const LAS bf16x8*)(kp + 6656);
}
__device__ __forceinline__ void kload2(bf16x8* kf, lds_cptr kp, int j) { kf[2 * j] = *(const LAS bf16x8*)(kp + j * 2048); kf[2 * j + 1] = *(const LAS bf16x8*)(kp + j * 2048 + 512); }
__device__ __forceinline__ s16x4 vtr(lds_cptr p) { return __builtin_bit_cast(s16x4, __builtin_amdgcn_ds_read_tr16_b64_v4i16((LAS v4i16_t*)p)); }
__device__ __forceinline__ float rowmax(const f32x16& p0, const f32x16& p1) {
  float a = max3f(p0[0], p0[1], p1[0]), b = max3f(p0[2], p0[3], p1[1]); a = max3f(a, p1[2], p1[3]);
  #pragma unroll
  for (int r = 4; r < 16; r += 4) { a = max3f(a, p0[r], p0[r + 1]); b = max3f(b, p0[r + 2], p0[r + 3]); a = max3f(a, p1[r], p1[r + 1]); b = max3f(b, p1[r + 2], p1[r + 3]); }
  const float m = max2f(a, b);
  auto rr = __builtin_amdgcn_permlane32_swap(__float_as_uint(m), __float_as_uint(m), false, false);
  return max2f(__uint_as_float(rr[0]), __uint_as_float(rr[1]));
}
__device__ __forceinline__ void pv(f32x16* o, int vb, bf16x8 pa0, bf16x8 pa1, bf16x8 pa2, bf16x8 pa3) {
  #pragma unroll
  for (int d0 = 0; d0 < 2; ++d0) { s16x4 lo[4], hi[4];
    #pragma unroll
    for (int ks = 0; ks < 4; ++ks) {
      asm volatile("ds_read_b64_tr_b16 %0,%1 offset:%c2" : "=&v"(lo[ks]) : "v"(vb), "i"(d0 * 4096 + ks * 1024) : "memory");
      asm volatile("ds_read_b64_tr_b16 %0,%1 offset:%c2" : "=&v"(hi[ks]) : "v"(vb), "i"(d0 * 4096 + ks * 1024 + 512) : "memory"); }
    asm volatile("s_waitcnt lgkmcnt(0)" ::: "memory"); SBAR();
    #define PK(k) (bf16x8){lo[k][0], lo[k][1], lo[k][2], lo[k][3], hi[k][0], hi[k][1], hi[k][2], hi[k][3]}
    o[d0] = __builtin_amdgcn_mfma_f32_32x32x16_bf16(pa0, PK(0), o[d0], 0, 0, 0);
    o[d0] = __builtin_amdgcn_mfma_f32_32x32x16_bf16(pa1, PK(1), o[d0], 0, 0, 0);
    o[d0] = __builtin_amdgcn_mfma_f32_32x32x16_bf16(pa2, PK(2), o[d0], 0, 0, 0);
    o[d0] = __builtin_amdgcn_mfma_f32_32x32x16_bf16(pa3, PK(3), o[d0], 0, 0, 0);
    #undef PK
  }
}
template <int THRL> __device__ __forceinline__ void attn_unit(const bf16_t* Qu, const float* qgain, const float* rope, const int tok0, const bf16_t* __restrict__ Kh, const bf16_t* __restrict__ Vh, bf16_t* Ou, const int NT, char* shm) {
  const int tid = tid_(), lane = tid & 63, r32 = lane & 31, hi = lane >> 5; const int wid = __builtin_amdgcn_readfirstlane(tid >> 6);
  const bf16_t* Qw = Qu + (long)wid * QBLK * ZP;
  const unsigned lds0 = (unsigned)(uintptr_t)shm;
  float* wsf = (float*)(shm + LDS_WS) + wid * 64;
  const bf16_t* ksrc = Kh + (long)lane * KVP + wid * 8;
  const bf16_t* vsrc = Vh + (long)(16 * (wid & 3) + (lane >> 2)) * KVP + (wid >> 2) * 32 + (lane & 3) * 8;
  const unsigned kdst = lds0 + LDS_K + wid * 1024, vdst = lds0 + LDS_V + wid * 1024;
  #define DMA_K(t, slot) glds16(ksrc + (long)(t) * KVBLK * KVP, (unsigned)__builtin_amdgcn_readfirstlane(kdst + (slot)))
  #define DMA_V(t, slot) glds16(vsrc + (long)(t) * KVBLK * KVP, (unsigned)__builtin_amdgcn_readfirstlane(vdst + (slot)))
  const int vb0 = (int)(lds0 + LDS_V) + ((lane >> 4) & 1) * 32 + (lane & 3) * 8 + (4 * hi + ((lane & 15) >> 2)) * 64;
  const char* Kbase = shm + LDS_K; bf16x8 kf[8];
  const lds_cptr shm3 = (lds_cptr)shm; const lds_cptr kp0 = shm3 + LDS_K + hi * 1024 + r32 * 16; const lds_cptr vp0 = shm3 + LDS_V + ((lane >> 4) & 1) * 32 + (lane & 3) * 8 + (4 * hi + ((lane & 15) >> 2)) * 64;
  DMA_K(0, 0); DMA_V(0, 0); DMA_K(1, SLOTB);
  bf16x8 qr[4];
  { float xq[4][8]; float ss = 0.f;
    #pragma unroll
    for (int d0 = 0; d0 < 4; ++d0) { const uint4 rw = *reinterpret_cast<const uint4*>(&Qw[(long)r32 * ZP + d0 * 16 + hi * 8]);
      xq[d0][0] = bf_lo(rw.x); xq[d0][1] = bf_hi(rw.x); xq[d0][2] = bf_lo(rw.y); xq[d0][3] = bf_hi(rw.y); xq[d0][4] = bf_lo(rw.z); xq[d0][5] = bf_hi(rw.z); xq[d0][6] = bf_lo(rw.w); xq[d0][7] = bf_hi(rw.w);
      #pragma unroll
      for (int j = 0; j < 8; ++j) ss += xq[d0][j] * xq[d0][j]; }
    { auto rr = __builtin_amdgcn_permlane32_swap(__float_as_uint(ss), __float_as_uint(ss), false, false); ss = __uint_as_float(rr[0]) + __uint_as_float(rr[1]); }
    const float rstd = __builtin_amdgcn_rsqf(ss * (1.0f / 64.0f) + 1e-6f) * (0.125f * 1.4426950408889634f);
    #pragma unroll
    for (int d0 = 0; d0 < 4; ++d0) { const f32x4 g0 = *(const f32x4*)(qgain + d0 * 16 + hi * 8), g1 = *(const f32x4*)(qgain + d0 * 16 + hi * 8 + 4);
      #pragma unroll
      for (int j = 0; j < 4; ++j) { xq[d0][j] *= rstd * g0[j]; xq[d0][4 + j] *= rstd * g1[j]; } }
    if (tok0 >= 0) { const int t = tok0 + wid * QBLK + r32, pr = t >> 6, pc = t & 63;
      #pragma unroll
      for (int hf = 0; hf < 2; ++hf) {
        const float* ct = rope + (hf ? (1024 + pc * 16) : (pr * 16)) + hi * 8; const float* st = ct + (hf ? 1024 : 512);
        const f32x4 c0 = *(const f32x4*)ct, c1 = *(const f32x4*)(ct + 4), s0 = *(const f32x4*)st, s1 = *(const f32x4*)(st + 4);
        #pragma unroll
        for (int j = 0; j < 8; ++j) { const float cs = j < 4 ? c0[j] : c1[j - 4], sn = j < 4 ? s0[j] : s1[j - 4];
          const float x1 = xq[2 * hf][j], x2 = xq[2 * hf + 1][j];
          xq[2 * hf][j] = x1 * cs - x2 * sn; xq[2 * hf + 1][j] = x2 * cs + x1 * sn; } } }
    #pragma unroll
    for (int d0 = 0; d0 < 4; ++d0) qr[d0] = pack8(xq[d0]); }
  float mhat = 0.f, l_reg = 0.f; f32x16 o[2]; o[0] = f32x16{}; o[1] = f32x16{}; f32x16 negm = f32x16{}; asm volatile("" : "+v"(negm));
  bool resc = false;
  #define START(P0, P1) do { const float rm = rowmax(P0, P1); resc = false; \
    { const float dl = rm; mhat = fadd_s(mhat, dl); \
      _Pragma("unroll") for (int r = 0; r < 16; ++r) { P0[r] = fsub_s(P0[r], dl); P1[r] = fsub_s(P1[r], dl); } \
      _Pragma("unroll") for (int r = 0; r < 16; ++r) negm[r] = -mhat; asm volatile("" : "+v"(negm)); } \
    _Pragma("unroll") for (int r = 0; r < 16; ++r) P0[r] = __builtin_amdgcn_exp2f(P0[r]); } while (0)
  #define RESC() do { if (resc) { asm volatile("s_waitcnt lgkmcnt(0)" ::: "memory"); \
      _Pragma("unroll") for (int d_ = 0; d_ < 2; ++d_) _Pragma("unroll") for (int r = 0; r < 16; ++r) o[d_][r] *= wsf[crow(r, hi)]; } } while (0)
  f32x16 pA0, pA1, pB0, pB1;
  int sl_prev = 0, sl_cur = 0, sl_next = SLOTB;
  #define ROT() do { sl_prev = sl_cur; sl_cur = sl_next; sl_next = (sl_next == (NSLOT - 1) * SLOTB) ? 0 : sl_next + SLOTB; } while (0)
  DMA_K(2, 2 * SLOTB);
  WAIT_BAR(3);
  qkt(pA0, pA1, Kbase, qr, negm, r32, hi); asm volatile("s_nop 15\n\ts_nop 7" : "+v"(pA0), "+v"(pA1));
  START(pA0, pA1);
  _Pragma("unroll") for (int r = 0; r < 16; ++r) pA1[r] = __builtin_amdgcn_exp2f(pA1[r]);
  WAIT_BAR(0);
  DMA_K(3, 0); DMA_V(1, SLOTB);
  ROT();
  kload8(kf, kp0 + sl_cur);
  WAIT_BAR(2);
  s16x4 vlo[8], vhi[8]; u32x4 pw0, pw1, pw2, pw3;
  #define PKW(P, B) cvtpk_s(P[B], P[B + 1])
  #define PAF(k) __builtin_bit_cast(bf16x8, pw##k)
  #define VFR(i) (bf16x8){vlo[i][0], vlo[i][1], vlo[i][2], vlo[i][3], vhi[i][0], vhi[i][1], vhi[i][2], vhi[i][3]}
  #define PIN(x) asm volatile("" : "+v"(x))
  #define MX3(a, b, c) __builtin_fmaxf(__builtin_fmaxf((a), (b)), (c))
  #define GAPA(MF, A0, A1, A2, A3, W0, W1, PW) do { MF; sacc += A0; sacc += A1; sacc += A2; sacc += A3; PIN(sacc); W0; W1; PIN(PW); SBAR(); } while (0)
  #define EX(v) __builtin_amdgcn_exp2f(v)
  #define GAPB(MF, X, B) do { MF; X[B] = EX(X[B]); X[B + 1] = EX(X[B + 1]); X[B + 2] = EX(X[B + 2]); X[B + 3] = EX(X[B + 3]); PIN(X); SBAR(); } while (0)
  #define VRD(i) do { vlo[i] = vtr(vp_ + (((i) >> 2) * 4096 + ((i) & 3) * 1024)); vhi[i] = vtr(vp_ + (((i) >> 2) * 4096 + ((i) & 3) * 1024 + 512)); } while (0)
  #define KRD(G, j) do { if (G) { kload2(kf, kp0 + sl_next, j); SBAR(); } } while (0)
  #define STEP(C0, C1, P0, P1, t, GK, GV, GL) do { SBAR(); \
    const lds_cptr vp_ = vp0 + sl_prev; \
    VRD(0); SBAR(); float sacc = (P0[0] + P0[1]); \
    GAPA(C0 = __builtin_amdgcn_mfma_f32_32x32x16_bf16(kf[0], qr[0], negm, 0, 0, 0), P0[2], P0[3], P0[4], P0[5],     pw0[0] = PKW(P0, 0), pw0[1] = PKW(P0, 2), pw0); \
    VRD(4); SBAR(); GAPA(C1 = __builtin_amdgcn_mfma_f32_32x32x16_bf16(kf[1], qr[0], negm, 0, 0, 0), P0[6], P0[7], P0[8], P0[9],     pw0[2] = PKW(P0, 4), pw0[3] = PKW(P0, 6), pw0); \
    VRD(1); SBAR(); GAPA(C0 = __builtin_amdgcn_mfma_f32_32x32x16_bf16(kf[2], qr[1], C0, 0, 0, 0),   P0[10], P0[11], P0[12], P0[13], pw1[0] = PKW(P0, 8), pw1[1] = PKW(P0, 10), pw1); \
    VRD(5); SBAR(); GAPA(C1 = __builtin_amdgcn_mfma_f32_32x32x16_bf16(kf[3], qr[1], C1, 0, 0, 0),   P0[14], P0[15], P1[0], P1[1],   pw1[2] = PKW(P0, 12), pw1[3] = PKW(P0, 14), pw1); \
    VRD(2); SBAR(); GAPA(C0 = __builtin_amdgcn_mfma_f32_32x32x16_bf16(kf[4], qr[2], C0, 0, 0, 0),   P1[2], P1[3], P1[4], P1[5],     pw2[0] = PKW(P1, 0), pw2[1] = PKW(P1, 2), pw2); \
    VRD(6); SBAR(); GAPA(C1 = __builtin_amdgcn_mfma_f32_32x32x16_bf16(kf[5], qr[2], C1, 0, 0, 0),   P1[6], P1[7], P1[8], P1[9],     pw2[2] = PKW(P1, 4), pw2[3] = PKW(P1, 6), pw2); \
    VRD(3); SBAR(); GAPA(C0 = __builtin_amdgcn_mfma_f32_32x32x16_bf16(kf[6], qr[3], C0, 0, 0, 0),   P1[10], P1[11], P1[12], P1[13], pw3[0] = PKW(P1, 8), pw3[1] = PKW(P1, 10), pw3); \
    VRD(7); SBAR(); GAPA(C1 = __builtin_amdgcn_mfma_f32_32x32x16_bf16(kf[7], qr[3], C1, 0, 0, 0),   P1[14], P1[15], 0.f, 0.f,       pw3[2] = PKW(P1, 12), pw3[3] = PKW(P1, 14), pw3); \
    l_reg += sacc; \
    if (GK) { DMA_K((t) + 3, sl_cur); } if (GV) { DMA_V((t) + 1, sl_next); } \
    { float a = MX3(C0[0], C0[1], C1[0]), b = MX3(C0[2], C0[3], C1[1]); a = MX3(a, C1[2], C1[3]); \
      _Pragma("unroll") for (int r = 4; r < 16; r += 4) { a = MX3(a, C0[r], C0[r + 1]); b = MX3(b, C0[r + 2], C0[r + 3]); a = MX3(a, C1[r], C1[r + 1]); b = MX3(b, C1[r + 2], C1[r + 3]); } \
      float rm = __builtin_fmaxf(a, b); { auto rr = __builtin_amdgcn_permlane32_swap(__float_as_uint(rm), __float_as_uint(rm), false, false); rm = __builtin_fmaxf(__uint_as_float(rr[0]), __uint_as_float(rr[1])); } \
      resc = false; \
      if (__builtin_expect(__any(rm > (float)THRL), 0)) { const float dl = __builtin_fmaxf(rm, 0.f); mhat += dl; \
        _Pragma("unroll") for (int r = 0; r < 16; ++r) { C0[r] -= dl; C1[r] -= dl; } \
        _Pragma("unroll") for (int r = 0; r < 16; ++r) negm[r] = -mhat; asm volatile("" : "+v"(negm)); \
        const float f = __builtin_amdgcn_exp2f(-dl); l_reg *= f; if (hi == 0) wsf[r32] = f; resc = true; } } \
    SBAR(); \
    GAPB(o[0] = __builtin_amdgcn_mfma_f32_32x32x16_bf16(PAF(0), VFR(0), o[0], 0, 0, 0), C0, 0); \
    GAPB(o[1] = __builtin_amdgcn_mfma_f32_32x32x16_bf16(PAF(0), VFR(4), o[1], 0, 0, 0), C0, 4); \
    KRD(GL, 0); GAPB(o[0] = __builtin_amdgcn_mfma_f32_32x32x16_bf16(PAF(1), VFR(1), o[0], 0, 0, 0), C0, 8); \
    KRD(GL, 1); GAPB(o[1] = __builtin_amdgcn_mfma_f32_32x32x16_bf16(PAF(1), VFR(5), o[1], 0, 0, 0), C0, 12); \
    KRD(GL, 2); GAPB(o[0] = __builtin_amdgcn_mfma_f32_32x32x16_bf16(PAF(2), VFR(2), o[0], 0, 0, 0), C1, 0); \
    KRD(GL, 3); GAPB(o[1] = __builtin_amdgcn_mfma_f32_32x32x16_bf16(PAF(2), VFR(6), o[1], 0, 0, 0), C1, 4); \
    GAPB(o[0] = __builtin_amdgcn_mfma_f32_32x32x16_bf16(PAF(3), VFR(3), o[0], 0, 0, 0), C1, 8); \
    GAPB(o[1] = __builtin_amdgcn_mfma_f32_32x32x16_bf16(PAF(3), VFR(7), o[1], 0, 0, 0), C1, 12); \
    } while (0)
  int t = 1;
  for (; t + 5 < NT; t += 2) {
    STEP(pB0, pB1, pA0, pA1, t, true, true, true);     WAIT_BAR(2); RESC(); ROT();
    STEP(pA0, pA1, pB0, pB1, t + 1, true, true, true); WAIT_BAR(2); RESC(); ROT();
  }
  #define ENDW(tt) do { if ((tt) + 3 < NT) { WAIT_BAR(2); } else if ((tt) + 2 < NT) { WAIT_BAR(1); } else { WAIT_BAR(0); } } while (0)
  for (; t + 1 < NT; t += 2) {
    STEP(pB0, pB1, pA0, pA1, t, (t + 3 < NT), (t + 1 < NT), (t + 1 < NT));         ENDW(t);     RESC(); ROT();
    STEP(pA0, pA1, pB0, pB1, t + 1, (t + 4 < NT), (t + 2 < NT), (t + 2 < NT));     ENDW(t + 1); RESC(); ROT();
  }
  STEP(pB0, pB1, pA0, pA1, NT - 1, false, false, false); RESC();
  { float sacc = pB0[0] + pB0[1]; _Pragma("unroll") for (int r = 2; r < 16; ++r) sacc += pB0[r]; _Pragma("unroll") for (int r = 0; r < 16; ++r) sacc += pB1[r]; l_reg += sacc;
    pw0 = (u32x4){PKW(pB0, 0), PKW(pB0, 2), PKW(pB0, 4), PKW(pB0, 6)}; pw1 = (u32x4){PKW(pB0, 8), PKW(pB0, 10), PKW(pB0, 12), PKW(pB0, 14)}; pw2 = (u32x4){PKW(pB1, 0), PKW(pB1, 2), PKW(pB1, 4), PKW(pB1, 6)}; pw3 = (u32x4){PKW(pB1, 8), PKW(pB1, 10), PKW(pB1, 12), PKW(pB1, 14)};
    SBAR(); pv(o, vb0 + sl_cur, PAF(0), PAF(1), PAF(2), PAF(3)); }
  #undef PKW
  #undef PAF
  #undef VFR
  #undef PIN
  #undef MX3
  #undef GAPA
  #undef GAPB
  #undef EX
  #undef VRD
  #undef KRD
  #undef STEP
  #undef ENDW
  { auto rr = __builtin_amdgcn_permlane32_swap(__float_as_uint(l_reg), __float_as_uint(l_reg), false, false); l_reg = __uint_as_float(rr[0]) + __uint_as_float(rr[1]); }
  if (hi == 0) wsf[32 + r32] = l_reg; asm volatile("s_waitcnt lgkmcnt(0)" ::: "memory");
  float rli[16];
  #pragma unroll
  for (int r = 0; r < 16; ++r) rli[r] = __builtin_amdgcn_rcpf(wsf[32 + crow(r, hi)]);
  bf16_t* Ow = Ou + (long)wid * QBLK * OP;
  { bf16_t* stg = (bf16_t*)(shm + LDS_OST) + wid * 2048;
    #pragma unroll
    for (int r = 0; r < 16; ++r) { const int orow = crow(r, hi);
      #pragma unroll
      for (int d0 = 0; d0 < 2; ++d0) stg[orow * 64 + d0 * 32 + r32] = (bf16_t)(cvtpk_s(o[d0][r] * rli[r], 0.f) & 0xffffu); }
    asm volatile("s_waitcnt lgkmcnt(0)" ::: "memory");
    #pragma unroll
    for (int i = 0; i < 4; ++i) { const int row = i * 8 + (lane >> 3), ch = lane & 7; const u32x4 v = *(const u32x4*)(stg + row * 64 + ch * 8); *(u32x4*)(Ow + (long)row * OP + ch * 8) = v; } }
  asm volatile("s_waitcnt lgkmcnt(0)\n\ts_barrier" ::: "memory");
  #undef DMA_K
  #undef DMA_V
  #undef START
  #undef RESC
  #undef ROT
}
#undef SBAR
#undef WAIT_BAR
}

__device__ __forceinline__ void ph_prologue(const Params& P, LAS unsigned char* lds) {
    const int tid = tid_(), bid = bid_(), G = gridDim.x, lane = tid & 63, wid = tid >> 6;
    float* mods = (float*)(P.ws + WS_MODS);
    LAS float* sc = (LAS float*)lds;
    LAS float* red = sc + 9 * 1024;
    for (int i = tid; i < 9 * 1024; i += NTHR) { const float v = (i < 8192) ? P.in[I_C][i] : P.in[I_CCTX][i - 8192]; sc[i] = siluf_(v); }
    __syncthreads();
    {
        const int c = lane & 31, slot = wid * 2 + (lane >> 5);
        for (int u = bid; u < 4 * 192; u += G) {
            const int l = u / 192, cg = u % 192;
            const float* w = P.in[I_WADA] + (size_t)l * 1024 * 6144 + cg * 32 + c;
            float a[9];
#pragma unroll
            for (int r = 0; r < 9; ++r) a[r] = 0.f;
#pragma unroll 8
            for (int i = 0; i < 64; ++i) { const int k = slot + 16 * i; const float wv = w[(size_t)k * 6144];
#pragma unroll
                for (int r = 0; r < 9; ++r) a[r] += sc[r * 1024 + k] * wv; }
#pragma unroll
            for (int r = 0; r < 9; ++r) red[(slot * 9 + r) * 32 + c] = a[r];
            __syncthreads();
            if (tid < 288) { const int r = tid >> 5, cc = tid & 31; float s_ = 0.f;
#pragma unroll
                for (int q = 0; q < 16; ++q) s_ += red[(q * 9 + r) * 32 + cc];
                mods[((size_t)l * 9 + r) * 6144 + cg * 32 + cc] = s_ + P.in[I_BADA][l * 6144 + cg * 32 + cc]; }
            __syncthreads();
        }
    }
    { float* rt = (float*)(P.ws + WS_RT);
      for (int i = bid * NTHR + tid; i < DEPTH * 20 * 1024; i += G * NTHR) { const int l = i / 20480, j = (i % 20480) >> 10, c = i & 1023;
          rt[i] = (j < 4) ? P.in[I_WGR][((size_t)l * 1024 + c) * 4 + j] : P.in[I_WER][((size_t)l * 1024 + c) * 16 + (j - 4)]; } }
    if (bid == G - 1) {
        float* lbv = (float*)(P.ws + WS_LB);
        for (int i = tid; i < 1024; i += NTHR) {
            float lg[DEPTH], mx = -1e30f;
#pragma unroll
            for (int l = 0; l < DEPTH; ++l) { lg[l] = P.in[I_LBL][l * 1024 + i]; mx = fmaxf(mx, lg[l]); }
            float s = 0.f;
#pragma unroll
            for (int l = 0; l < DEPTH; ++l) { lg[l] = expf(lg[l] - mx); s += lg[l]; }
            float cum = 0.f;
#pragma unroll
            for (int l = 0; l < DEPTH; ++l) { if (l > 0) cum += lg[l] / s; lbv[l * 1024 + i] = cum; }
        }
        float* rope = (float*)(P.ws + WS_ROPE);
        for (int i = tid; i < 96 * 16; i += NTHR) {
            const int pos = i >> 4, fi = i & 15;
            const float inv = powf(10000.0f, -(float)fi / 16.0f);
            const float p = (pos < 32) ? (float)pos : (float)(pos - 32);
            const float ang = p * inv;
            if (pos < 32) { rope[pos * 16 + fi] = cosf(ang); rope[512 + pos * 16 + fi] = sinf(ang); }
            else { rope[1024 + (pos - 32) * 16 + fi] = cosf(ang); rope[2048 + (pos - 32) * 16 + fi] = sinf(ang); }
        }
    }
    float4* xr = (float4*)(P.ws + WS_X);
    const float4* xs = (const float4*)P.in[I_X]; const float4* cs = (const float4*)P.in[I_CTX];
    const size_t nx4 = (size_t)NLAT * D / 4, nc4 = (size_t)NCTX * D / 4;
    for (size_t i = (size_t)bid * NTHR + tid; i < nx4 + nc4; i += (size_t)G * NTHR) xr[i] = (i < nx4) ? xs[i] : cs[i - nx4];
}

struct ConvJob { const float* srcA; const float* srcB; int ld; bool inter; bool perm; bf16_t* dst; int K, n0, k0; };
__device__ __forceinline__ int perm32(int rho) { const int n = rho >> 4, i = rho & 15; return 8 * (i >> 2) + 4 * n + (i & 3); }
__device__ __forceinline__ bool conv_job(const Params& P, int l, int u, ConvJob& J) {
    constexpr int T_IN = 16 * 124, T_BR = 3 * 8 * 16, T_OUT = 16 * 16, T_GU = 16 * 16 * 16, T_DN = 16 * 8 * 16;
    constexpr int TOT = T_IN + T_BR + T_OUT + T_GU + T_DN;
    if (u >= TOT) return false;
    int v = u;
    J.srcB = nullptr; J.inter = false; J.perm = false;
    if (v < T_IN) { const int kt = v % 16, nt = v / 16; J.perm = true; J.srcA = P.in[I_WIN] + (size_t)l * 1024 * INC; J.ld = INC; J.dst = (bf16_t*)(P.ws + WS_WIN); J.K = 1024; J.n0 = nt * 64; J.k0 = kt * 64; return true; }
    v -= T_IN;
    if (v < T_BR) { const int i = v / 128, w = v % 128, kt = w % 8, nt = w / 8; J.perm = true; J.srcA = P.in[I_WBR] + ((size_t)l * 3 + i) * 512 * 1024; J.ld = 1024; J.dst = (bf16_t*)(P.ws + WS_WBR) + (size_t)i * 1024 * 512; J.K = 512; J.n0 = nt * 64; J.k0 = kt * 64; return true; }
    v -= T_BR;
    if (v < T_OUT) { const int kt = v % 16, nt = v / 16; J.perm = true; J.srcA = P.in[I_WOUT] + (size_t)l * 1024 * 1024; J.ld = 1024; J.dst = (bf16_t*)(P.ws + WS_WOUT); J.K = 1024; J.n0 = nt * 64; J.k0 = kt * 64; return true; }
    v -= T_OUT;
    if (v < T_GU) { const int e = v / 256, w = v % 256, kt = w % 16, nt = w / 16; const size_t eo = ((size_t)l * NEXP + e) * 1024 * 512;
        J.srcA = P.in[I_WEG] + eo; J.srcB = P.in[I_WEU] + eo; J.inter = true; J.ld = 512; J.dst = (bf16_t*)(P.ws + WS_WGU) + (size_t)e * 1024 * 1024; J.K = 1024; J.n0 = nt * 64; J.k0 = kt * 64; return true; }
    v -= T_GU;
    { const int e = v / 128, w = v % 128, kt = w % 8, nt = w / 8; J.perm = true; J.srcA = P.in[I_WED] + ((size_t)l * NEXP + e) * 512 * 1024; J.ld = 1024; J.dst = (bf16_t*)(P.ws + WS_WDN) + (size_t)e * 1024 * 512; J.K = 512; J.n0 = nt * 64; J.k0 = kt * 64; return true; }
}
__device__ __forceinline__ void conv_load(const ConvJob& J, int tid, float (&v)[8]) {
    const int nn = tid & 63, kk = tid >> 6, n = J.n0 + nn;
    const float* cp;
    if (J.perm) cp = J.srcA + (n & ~31) + perm32(n & 31); else if (!J.inter) cp = J.srcA + n; else { const int g = n >> 5, i = n & 31; cp = (i < 16) ? (J.srcA + 16 * g + i) : (J.srcB + 16 * g + i - 16); }
#pragma unroll
    for (int p = 0; p < 8; ++p) v[p] = cp[(size_t)(J.k0 + kk + 8 * p) * J.ld];
}
__device__ __forceinline__ void wconv_range(const Params& P, LAS unsigned char* lds, int l, int t0, int t1, int widx, int nw) {
    LAS float* t = (LAS float*)lds;
    const int tid = tid_();
    int u = t0 + widx;
    ConvJob J; float v[8];
    bool have = (u < t1) && conv_job(P, l, u, J);
    if (have) conv_load(J, tid, v);
    while (have) {
        ConvJob Jn; float vn[8];
        const bool hn = (u + nw < t1) && conv_job(P, l, u + nw, Jn);
        if (hn) conv_load(Jn, tid, vn);
        { const int nn = tid & 63, kk = tid >> 6;
#pragma unroll
          for (int p = 0; p < 8; ++p) t[(kk + 8 * p) * 65 + nn] = v[p]; }
        __syncthreads();
        { const int n = tid >> 3, k8 = (tid & 7) * 8;
          float w[8];
#pragma unroll
          for (int j = 0; j < 8; ++j) w[j] = t[(k8 + j) * 65 + n];
          uint4 o; o.x = pk_bf16(w[0], w[1]); o.y = pk_bf16(w[2], w[3]); o.z = pk_bf16(w[4], w[5]); o.w = pk_bf16(w[6], w[7]);
          *(uint4*)(J.dst + (size_t)(J.n0 + n) * J.K + J.k0 + k8) = o; }
        __syncthreads();
        J = Jn; have = hn; u += nw;
#pragma unroll
        for (int p = 0; p < 8; ++p) v[p] = vn[p];
    }
}
constexpr int CONV_T_DENSE = 16 * 124 + 3 * 8 * 16 + 16 * 16;
constexpr int CONV_T_ALL = CONV_T_DENSE + 16 * 16 * 16 + 16 * 8 * 16;
__device__ __forceinline__ void ph_wconv(const Params& P, LAS unsigned char* lds, int l) { wconv_range(P, lds, l, 0, CONV_T_DENSE, bid_(), gridDim.x); }

__device__ __forceinline__ void norm_row(const float4 (&x)[4], const float* g, const float* shift, const float* scale, int lane, float4 (&o)[4]) {
    float ss = 0.f;
#pragma unroll
    for (int i = 0; i < 4; ++i) ss += x[i].x * x[i].x + x[i].y * x[i].y + x[i].z * x[i].z + x[i].w * x[i].w;
    ss = wave_sum(ss);
    const float rstd = __builtin_amdgcn_rsqf(ss * (1.0f / 1024.0f) + 1e-6f);
#pragma unroll
    for (int i = 0; i < 4; ++i) {
        const int c = lane * 4 + 256 * i;
        const float4 gv = *(const float4*)(g + c), sh = *(const float4*)(shift + c), sc = *(const float4*)(scale + c);
        o[i].x = x[i].x * rstd * gv.x * (1.0f + sc.x) + sh.x;
        o[i].y = x[i].y * rstd * gv.y * (1.0f + sc.y) + sh.y;
        o[i].z = x[i].z * rstd * gv.z * (1.0f + sc.z) + sh.z;
        o[i].w = x[i].w * rstd * gv.w * (1.0f + sc.w) + sh.w;
    }
}
__device__ __forceinline__ int row_modrow(int r) { return r < NLAT ? (r >> 11) : 8; }

__device__ __forceinline__ void ph_norm1(const Params& P, int l) {
    const int tid = tid_(), lane = tid & 63, wid = tid >> 6;
    const float* xres = (const float*)(P.ws + WS_X);
    bf16_t* h = (bf16_t*)(P.ws + WS_H);
    const float* g = P.in[I_GMIX] + l * 1024;
    for (int r = bid_() * 8 + wid; r < NTOK; r += gridDim.x * 8) {
        const float* mod = (const float*)(P.ws + WS_MODS) + ((size_t)l * 9 + row_modrow(r)) * 6144;
        float4 x[4], o[4];
#pragma unroll
        for (int i = 0; i < 4; ++i) x[i] = *(const float4*)(xres + (size_t)r * D + lane * 4 + 256 * i);
        norm_row(x, g, mod, mod + 1024, lane, o);
#pragma unroll
        for (int i = 0; i < 4; ++i) { uint2 u; u.x = pk_bf16(o[i].x, o[i].y); u.y = pk_bf16(o[i].z, o[i].w); *(uint2*)(h + (size_t)r * D + lane * 4 + 256 * i) = u; }
    }
}

struct EpiStoreBf16 { bf16_t* O; int ldc;
    __device__ __forceinline__ void operator()(int row, int col, const f32x4& v0, const f32x4& v1) const {
        uint2 a, b; a.x = pk_bf16(v0[0], v0[1]); a.y = pk_bf16(v0[2], v0[3]); b.x = pk_bf16(v1[0], v1[1]); b.y = pk_bf16(v1[2], v1[3]);
        *(uint2*)(O + (size_t)row * ldc + col) = a; *(uint2*)(O + (size_t)row * ldc + col + 16) = b; } };
struct EpiStore16 { bf16_t* O; int ldc;
    __device__ __forceinline__ void operator()(const f32x4 (&acc)[2][2][4][2], const pg8::Unit& u, int wr, int wc, int fr, int fq) const {
#pragma unroll
        for (int ai = 0; ai < 2; ++ai)
#pragma unroll
            for (int m = 0; m < 4; ++m)
#pragma unroll
                for (int bj = 0; bj < 2; ++bj) { const int row = u.row0 + ai * 128 + wr * 64 + m * 16 + fr, col = u.col0 + bj * 128 + wc * 32 + 8 * fq;
                    const f32x4 v0 = acc[ai][bj][m][0], v1 = acc[ai][bj][m][1];
                    uint4 o; o.x = pk_bf16(v0[0], v0[1]); o.y = pk_bf16(v0[2], v0[3]); o.z = pk_bf16(v1[0], v1[1]); o.w = pk_bf16(v1[2], v1[3]);
                    *(uint4*)(O + (size_t)row * ldc + col) = o; }
    } };
struct FStoreBf16 { bf16_t* O; int ldc;
    __device__ __forceinline__ void operator()(const pg8::Unit&, int row, int col, const f32x4& v0, const f32x4& v1) const {
        uint2 a, b; a.x = pk_bf16(v0[0], v0[1]); a.y = pk_bf16(v0[2], v0[3]); b.x = pk_bf16(v1[0], v1[1]); b.y = pk_bf16(v1[2], v1[3]);
        *(uint2*)(O + (size_t)row * ldc + col) = a; *(uint2*)(O + (size_t)row * ldc + col + 16) = b; } };
struct EpiG1 { bf16_t* Z; bf16_t* GT;
    __device__ __forceinline__ void operator()(const f32x4 (&acc)[2][2][4][2], const pg8::Unit& u, int wr, int wc, int fr, int fq) const {
        if (u.col0 < C_GATE) {
#pragma unroll
            for (int ai = 0; ai < 2; ++ai)
#pragma unroll
                for (int m = 0; m < 4; ++m)
#pragma unroll
                    for (int bj = 0; bj < 2; ++bj) { const int row = u.row0 + ai * 128 + wr * 64 + m * 16 + fr, col = u.col0 + bj * 128 + wc * 32 + 8 * fq;
                        const f32x4 v0 = acc[ai][bj][m][0], v1 = acc[ai][bj][m][1];
                        uint4 o; o.x = pk_bf16(v0[0], v0[1]); o.y = pk_bf16(v0[2], v0[3]); o.z = pk_bf16(v1[0], v1[1]); o.w = pk_bf16(v1[2], v1[3]);
                        *(uint4*)(Z + (size_t)row * ZP + col) = o; }
        } else {
            const int tidx = (wr * 4 + wc) * 64 + fq * 16 + fr;
            bf16_t* base = GT + ((size_t)(u.row0 >> 8) * 12 + ((u.col0 - C_GATE) >> 8)) * 65536 + tidx * 8;
#pragma unroll
            for (int ai = 0; ai < 2; ++ai)
#pragma unroll
                for (int bj = 0; bj < 2; ++bj)
#pragma unroll
                    for (int m = 0; m < 4; ++m) { const f32x4 v0 = acc[ai][bj][m][0], v1 = acc[ai][bj][m][1];
                        uint4 o; o.x = pk_bf16(sigmoidf_(v0[0]), sigmoidf_(v0[1])); o.y = pk_bf16(sigmoidf_(v0[2]), sigmoidf_(v0[3]));
                        o.z = pk_bf16(sigmoidf_(v1[0]), sigmoidf_(v1[1])); o.w = pk_bf16(sigmoidf_(v1[2]), sigmoidf_(v1[3]));
                        *(uint4*)(base + ((ai * 2 + bj) * 4 + m) * 4096) = o; }
        }
    } };
__device__ __forceinline__ void ph_g1(const Params& P, LAS unsigned char* lds) {
    pg8::SchedDense S{NTOK / 256, INC / 256, (int)gridDim.x, bid_(), (const char*)(P.ws + WS_H), (const char*)(P.ws + WS_WIN), (size_t)256 * D * 2, (size_t)256 * D * 2};
    EpiG1 E{(bf16_t*)(P.ws + WS_Z), (bf16_t*)(P.ws + WS_GT)};
    pg8::gemm_phase(lds, pg8::Gemm{D, D, D}, S, E);
}

__device__ __forceinline__ int kvrow(int r) { return r < NLAT ? ((r >> 11) * 2304 + 256 + (r & 2047)) : (((r - NLAT) >> 8) * 2304 + ((r - NLAT) & 255)); }
__device__ __forceinline__ void ph_prep(const Params& P, int l) {
    const int tid = tid_(), lane = tid & 63, wid = tid >> 6;
    const bf16_t* z = (const bf16_t*)(P.ws + WS_Z);
    bf16_t* qn = (bf16_t*)(P.ws + WS_QN); bf16_t* kn = (bf16_t*)(P.ws + WS_KN); bf16_t* vn = (bf16_t*)(P.ws + WS_VN);
    const float* rope = (const float*)(P.ws + WS_ROPE);
    const float gq = P.in[I_QNG][l * 64 + lane] * (0.125f * 1.4426950408889634f), gk = P.in[I_KNG][l * 64 + lane];
    for (int r = bid_() * 8 + wid; r < NTOK; r += gridDim.x * 8) {
        const bool lat = r < NLAT;
        const size_t kr = (size_t)kvrow(r);
        float cs = 1.f, sn = 0.f;
        if (lat) { const int t = r & 2047, fi = lane & 15;
            if (lane < 32) { const int pr = t >> 6; cs = rope[pr * 16 + fi]; sn = rope[512 + pr * 16 + fi]; }
            else { const int pc = t & 63; cs = rope[1024 + pc * 16 + fi]; sn = rope[2048 + pc * 16 + fi]; } }
        const float sgn = (lane & 16) ? 1.f : -1.f;
#pragma unroll
        for (int hh = 8; hh < 10; ++hh) {
            const int col = (hh < 8) ? (C_GQ + hh * 64) : (C_GK + (hh - 8) * 64);
            const float x = bf2f(z[(size_t)r * ZP + col + lane]);
            const float ss = wave_sum(x * x);
            const float xn = x * __builtin_amdgcn_rsqf(ss * (1.0f / 64.0f) + 1e-6f) * (hh < 8 ? gq : gk);
            const float pa = __shfl_xor(xn, 16, 64);
            const float o = xn * cs + sgn * pa * sn;
            const bf16_t ob = (bf16_t)(pk_bf16(o, 0.f) & 0xffffu);
            if (hh < 8) qn[(size_t)r * 512 + hh * 64 + lane] = ob; else kn[kr * 128 + (hh - 8) * 64 + lane] = ob;
        }
        *(unsigned*)(vn + kr * 128 + lane * 2) = *(const unsigned*)(z + (size_t)r * ZP + C_GV + lane * 2);
    }
}

__device__ __forceinline__ void ph_navt(const Params& P, LAS unsigned char* lds) {
    const int tid = tid_();
    const bf16_t* z = (const bf16_t*)(P.ws + WS_Z); bf16_t* vt = (bf16_t*)(P.ws + WS_NAVT);
    constexpr int PT = 1040;
    for (int u = bid_(); u < NB * 36; u += gridDim.x) {
        const int b = u / 36, tl = u % 36;
        const int row0 = (tl < 4) ? (NLAT + b * 256 + tl * 64) : (b * 2048 + (tl - 4) * 64);
        __syncthreads();
#pragma unroll
        for (int i = 0; i < 8; ++i) { const int ch = tid + i * NTHR, rr = ch >> 6, cc = ch & 63;
            const uint4 v = *(const uint4*)(z + (size_t)(row0 + rr) * ZP + C_NAV + cc * 8);
            *(LAS u32x4*)(lds + rr * PT + cc * 16) = (u32x4){v.x, v.y, v.z, v.w}; }
        __syncthreads();
#pragma unroll
        for (int i = 0; i < 8; ++i) { const int c = tid, tg = i;
            unsigned short e[8];
#pragma unroll
            for (int k = 0; k < 8; ++k) e[k] = *(const LAS unsigned short*)(lds + (tg * 8 + k) * PT + c * 2);
            uint4 o; o.x = e[0] | ((unsigned)e[1] << 16); o.y = e[2] | ((unsigned)e[3] << 16); o.z = e[4] | ((unsigned)e[5] << 16); o.w = e[6] | ((unsigned)e[7] << 16);
            *(uint4*)(vt + ((size_t)(b * 8 + (c >> 6)) * 64 + (c & 63)) * 2304 + tl * 64 + tg * 8) = o; }
    }
    __syncthreads();
}

#ifdef DIAG
__device__ __forceinline__ void load_q64(float (&q)[64], const bf16_t* p) {
#pragma unroll
    for (int i = 0; i < 8; ++i) { const uint4 u = ((const uint4*)p)[i];
        q[8 * i + 0] = bf_lo(u.x); q[8 * i + 1] = bf_hi(u.x); q[8 * i + 2] = bf_lo(u.y); q[8 * i + 3] = bf_hi(u.y);
        q[8 * i + 4] = bf_lo(u.z); q[8 * i + 5] = bf_hi(u.z); q[8 * i + 6] = bf_lo(u.w); q[8 * i + 7] = bf_hi(u.w); }
}
__device__ __forceinline__ void attn_key(const float (&q)[64], const bf16_t* kp, const bf16_t* vp, float bias, float& m, float& lsum, float (&o)[64]) {
    float s = 0.f;
#pragma unroll
    for (int i = 0; i < 8; ++i) { const uint4 u = ((const uint4*)kp)[i];
        s += q[8 * i + 0] * bf_lo(u.x) + q[8 * i + 1] * bf_hi(u.x) + q[8 * i + 2] * bf_lo(u.y) + q[8 * i + 3] * bf_hi(u.y)
           + q[8 * i + 4] * bf_lo(u.z) + q[8 * i + 5] * bf_hi(u.z) + q[8 * i + 6] * bf_lo(u.w) + q[8 * i + 7] * bf_hi(u.w); }
    s = s * 0.125f + bias;
    const float mn = fmaxf(m, s), corr = __expf(m - mn), pp = __expf(s - mn);
    lsum = lsum * corr + pp; m = mn;
#pragma unroll
    for (int i = 0; i < 8; ++i) { const uint4 u = ((const uint4*)vp)[i];
        o[8 * i + 0] = o[8 * i + 0] * corr + pp * bf_lo(u.x); o[8 * i + 1] = o[8 * i + 1] * corr + pp * bf_hi(u.x);
        o[8 * i + 2] = o[8 * i + 2] * corr + pp * bf_lo(u.y); o[8 * i + 3] = o[8 * i + 3] * corr + pp * bf_hi(u.y);
        o[8 * i + 4] = o[8 * i + 4] * corr + pp * bf_lo(u.z); o[8 * i + 5] = o[8 * i + 5] * corr + pp * bf_hi(u.z);
        o[8 * i + 6] = o[8 * i + 6] * corr + pp * bf_lo(u.w); o[8 * i + 7] = o[8 * i + 7] * corr + pp * bf_hi(u.w); }
}
__device__ __forceinline__ void store_o64(const float (&o)[64], float inv, bf16_t* p) {
#pragma unroll
    for (int i = 0; i < 8; ++i) { uint4 u;
        u.x = pk_bf16(o[8 * i + 0] * inv, o[8 * i + 1] * inv); u.y = pk_bf16(o[8 * i + 2] * inv, o[8 * i + 3] * inv);
        u.z = pk_bf16(o[8 * i + 4] * inv, o[8 * i + 5] * inv); u.w = pk_bf16(o[8 * i + 6] * inv, o[8 * i + 7] * inv);
        ((uint4*)p)[i] = u; }
}
__device__ __forceinline__ void na_thread(const Params& P, int l, int r, int h, bf16_t* br, int OPN) {
    const bf16_t* z = (const bf16_t*)(P.ws + WS_Z);
    float q[64], o[64]; float m = -INFINITY, ls = 0.f;
#pragma unroll
    for (int i = 0; i < 64; ++i) o[i] = 0.f;
    load_q64(q, z + (size_t)r * ZP + C_NAQ + h * 64);
    int b;
    if (r < NLAT) {
        b = r >> 11; const int t = r & 2047, qr = t >> 6, qc = t & 63;
        const int r0 = min(max(qr - 4, 0), 24), c0 = min(max(qc - 8, 0), 48);
        const float* rpb = P.in[I_RPB] + ((size_t)l * 8 + h) * 15 * 31;
        for (int kr = r0; kr < r0 + 8; ++kr)
            for (int kc = c0; kc < c0 + 16; ++kc) {
                const size_t krow = (size_t)(b * 2048 + kr * 64 + kc) * ZP;
                attn_key(q, z + krow + C_NAK + h * 64, z + krow + C_NAV + h * 64, rpb[(kr - qr + 7) * 31 + (kc - qc + 15)], m, ls, o);
            }
    } else b = (r - NLAT) >> 8;
    for (int j = 0; j < 256; ++j) {
        const size_t krow = (size_t)(NLAT + b * 256 + j) * ZP;
        attn_key(q, z + krow + C_NAK + h * 64, z + krow + C_NAV + h * 64, 0.f, m, ls, o);
    }
    store_o64(o, 1.0f / ls, br + (size_t)r * OPN + h * 64);
}
#endif
namespace na {
constexpr int KP = 144, VP = 528;
constexpr int L_K = 0, L_V = 256 * KP, L_B = L_V + 64 * VP, L_END = L_B + 480 * 4;
constexpr float C2 = 0.125f * 1.4426950408889634f, LOG2E = 1.4426950408889634f;
struct Acc { float m, l; f32x4 o[4]; };
template <int NG> __device__ __forceinline__ void absorb(Acc& A, f32x4 (&sa)[NG], f32x4 (&sb)[NG], const bf16x8 (&vfr)[NG][4]) {
    float mx = -INFINITY;
#pragma unroll
    for (int g = 0; g < NG; ++g)
#pragma unroll
        for (int j = 0; j < 4; ++j) mx = fmaxf(mx, fmaxf(sa[g][j], sb[g][j]));
    mx = fmaxf(mx, __shfl_xor(mx, 16, 64)); mx = fmaxf(mx, __shfl_xor(mx, 32, 64));
    const float mn = fmaxf(A.m, mx), corr = __builtin_amdgcn_exp2f(A.m - mn);
    A.m = mn;
    float ps = 0.f;
    bf16x8 pf[NG];
#pragma unroll
    for (int g = 0; g < NG; ++g) { float p[8];
#pragma unroll
        for (int j = 0; j < 4; ++j) { p[j] = __builtin_amdgcn_exp2f(sa[g][j] - mn); p[4 + j] = __builtin_amdgcn_exp2f(sb[g][j] - mn); ps += p[j] + p[4 + j]; }
        pf[g] = pack8(p); }
    A.l = A.l * corr + ps;
#pragma unroll
    for (int db = 0; db < 4; ++db) A.o[db] *= corr;
#pragma unroll
    for (int g = 0; g < NG; ++g)
#pragma unroll
        for (int db = 0; db < 4; ++db) A.o[db] = __builtin_amdgcn_mfma_f32_16x16x32_bf16(vfr[g][db], pf[g], A.o[db], 0, 0, 0);
}
}
__device__ __forceinline__ void na_unit(const Params& P, LAS unsigned char* lds, int l, int u, bf16_t* br, int OPN) {
    const int tid = tid_(), lane = tid & 63, wid = __builtin_amdgcn_readfirstlane(tid >> 6), c16 = lane & 15, kq = lane >> 4;
    const bool latu = u < 256;
    const int bh = latu ? (u >> 2) : (u - 256), b = bh >> 3, h = bh & 7, q4 = u & 3;
    const bf16_t* z = (const bf16_t*)(P.ws + WS_Z); const bf16_t* vt = (const bf16_t*)(P.ws + WS_NAVT) + (size_t)bh * 64 * 2304;
    LAS unsigned char* KL = lds + na::L_K; LAS unsigned char* VL = lds + na::L_V; LAS float* BL = (LAS float*)(lds + na::L_B);
    __syncthreads();
#pragma unroll
    for (int i = 0; i < 4; ++i) { const int ch = tid + i * NTHR, rr = ch >> 3, cc = ch & 7;
        const uint4 v = *(const uint4*)(z + (size_t)(NLAT + b * 256 + rr) * ZP + C_NAK + h * 64 + cc * 8);
        *(LAS u32x4*)(KL + rr * na::KP + cc * 16) = (u32x4){v.x, v.y, v.z, v.w}; }
#pragma unroll
    for (int i = 0; i < 4; ++i) { const int ch = tid + i * NTHR, rr = ch >> 5, cc = ch & 31;
        const uint4 v = *(const uint4*)(vt + (size_t)rr * 2304 + cc * 8);
        *(LAS u32x4*)(VL + rr * na::VP + cc * 16) = (u32x4){v.x, v.y, v.z, v.w}; }
    if (tid < 465) BL[tid] = P.in[I_RPB][((size_t)l * 8 + h) * 465 + tid] * na::LOG2E;
    __syncthreads();
    const int sA = 8 * (c16 >> 2) + (c16 & 3);
    const int ntask = latu ? 4 : 2;
    struct TaskP { int qrow, r, jb, r0, kc0; };
#define NA_FENCE() asm volatile("" ::: "memory")
#define NA_TASKP(it_, t_) do { const int tk_ = (it_) * 8 + wid; t_.r = 0; t_.jb = 0; t_.r0 = 0; t_.kc0 = 0; \
        if (latu) { t_.r = q4 * 8 + (tk_ >> 2); t_.jb = tk_ & 3; t_.qrow = b * 2048 + t_.r * 64 + t_.jb * 16 + c16; t_.r0 = min(max(t_.r - 4, 0), 24); t_.kc0 = min(max(t_.jb * 16 - 8, 0), 32); } \
        else t_.qrow = NLAT + b * 256 + tk_ * 16 + c16; } while (0)
#define NA_LOADK(t_, c_, kf_) do { _Pragma("unroll") for (int g = 0; g < 2; ++g) { const bf16_t* kp_ = z + ((size_t)b * 2048 + (size_t)(t_.r0 + 2 * (c_) + g) * 64 + t_.kc0 + sA) * ZP + C_NAK + h * 64 + 8 * kq; \
            kf_[g][0] = *(const bf16x8*)kp_; kf_[g][1] = *(const bf16x8*)(kp_ + 32); kf_[g][2] = *(const bf16x8*)(kp_ + 4 * ZP); kf_[g][3] = *(const bf16x8*)(kp_ + 4 * ZP + 32); } } while (0)
#define NA_LOADV(t_, c_, vf_) do { const bf16_t* vp_ = vt + (size_t)c16 * 2304 + 256 + (t_.r0 + 2 * (c_)) * 64 + t_.kc0 + 8 * kq; \
        _Pragma("unroll") for (int g = 0; g < 2; ++g) _Pragma("unroll") for (int db = 0; db < 4; ++db) vf_[g][db] = *(const bf16x8*)(vp_ + (size_t)db * 16 * 2304 + g * 64); } while (0)
    for (int it = 0; it < ntask; ++it) {
        TaskP T; NA_TASKP(it, T);
        bf16x8 qf[2];
#pragma unroll
        for (int ks = 0; ks < 2; ++ks) qf[ks] = *(const bf16x8*)(z + (size_t)T.qrow * ZP + C_NAQ + h * 64 + 32 * ks + 8 * kq);
        na::Acc A; A.m = -INFINITY; A.l = 0.f;
#pragma unroll
        for (int db = 0; db < 4; ++db) A.o[db] = (f32x4){0.f, 0.f, 0.f, 0.f};
        if (latu) {
            bf16x8 kA[2][4], vA[2][4], kB[2][4], vB[2][4];
            NA_LOADK(T, 0, kA); NA_LOADV(T, 0, vA); NA_LOADK(T, 1, kB); NA_LOADV(T, 1, vB);
            const int qc = T.jb * 16 + c16, c0 = min(max(qc - 8, 0), 48);
            int dcol[8]; bool ok[8];
#pragma unroll
            for (int j = 0; j < 8; ++j) { const int kc = T.kc0 + 8 * kq + j; ok[j] = (kc >= c0) && (kc < c0 + 16); dcol[j] = ok[j] ? (kc - qc + 15) : 0; }
#define NA_SCORES(KF, CI) do { \
                float bv[2][8]; \
                _Pragma("unroll") for (int g = 0; g < 2; ++g) { const int brow = (T.r0 + 2 * (CI) + g - T.r + 7) * 31; \
                    _Pragma("unroll") for (int j = 0; j < 8; ++j) bv[g][j] = BL[brow + dcol[j]]; } \
                _Pragma("unroll") for (int g = 0; g < 2; ++g) { \
                    f32x4 a_ = {0.f, 0.f, 0.f, 0.f}, b_ = {0.f, 0.f, 0.f, 0.f}; \
                    a_ = __builtin_amdgcn_mfma_f32_16x16x32_bf16(KF[g][0], qf[0], a_, 0, 0, 0); a_ = __builtin_amdgcn_mfma_f32_16x16x32_bf16(KF[g][1], qf[1], a_, 0, 0, 0); \
                    b_ = __builtin_amdgcn_mfma_f32_16x16x32_bf16(KF[g][2], qf[0], b_, 0, 0, 0); b_ = __builtin_amdgcn_mfma_f32_16x16x32_bf16(KF[g][3], qf[1], b_, 0, 0, 0); \
                    _Pragma("unroll") for (int j = 0; j < 4; ++j) { \
                        const float va_ = a_[j] * na::C2 + bv[g][j], vb_ = b_[j] * na::C2 + bv[g][4 + j]; \
                        sa[g][j] = ok[j] ? va_ : -INFINITY; sb[g][j] = ok[4 + j] ? vb_ : -INFINITY; } } } while (0)
            f32x4 sa[2], sb[2];
            NA_SCORES(kA, 0); NA_FENCE(); NA_LOADK(T, 2, kA); NA_FENCE(); na::absorb<2>(A, sa, sb, vA); NA_FENCE(); NA_LOADV(T, 2, vA); NA_FENCE();
            NA_SCORES(kB, 1); NA_FENCE(); NA_LOADK(T, 3, kB); NA_FENCE(); na::absorb<2>(A, sa, sb, vB); NA_FENCE(); NA_LOADV(T, 3, vB); NA_FENCE();
            NA_SCORES(kA, 2); na::absorb<2>(A, sa, sb, vA);
            NA_SCORES(kB, 3); na::absorb<2>(A, sa, sb, vB);
#undef NA_SCORES
        }
#pragma unroll 1
        for (int ch = 0; ch < 2; ++ch) {
            f32x4 sa[4], sb[4];
            bf16x8 kf[4][4], vfr[4][4];
            { const LAS unsigned char* vp = VL + c16 * na::VP + (ch * 128 + 8 * kq) * 2;
#pragma unroll
              for (int g = 0; g < 4; ++g)
#pragma unroll
                for (int db = 0; db < 4; ++db) vfr[g][db] = *(const LAS bf16x8*)(vp + db * 16 * na::VP + g * 64); }
#pragma unroll
            for (int g = 0; g < 4; ++g) {
                const LAS unsigned char* kp = KL + (ch * 128 + g * 32 + sA) * na::KP + kq * 16;
                kf[g][0] = *(const LAS bf16x8*)kp; kf[g][1] = *(const LAS bf16x8*)(kp + 64); kf[g][2] = *(const LAS bf16x8*)(kp + 4 * na::KP); kf[g][3] = *(const LAS bf16x8*)(kp + 4 * na::KP + 64);
            }
#pragma unroll
            for (int g = 0; g < 4; ++g) {
                f32x4 a = {0.f, 0.f, 0.f, 0.f}, bq = {0.f, 0.f, 0.f, 0.f};
                a = __builtin_amdgcn_mfma_f32_16x16x32_bf16(kf[g][0], qf[0], a, 0, 0, 0); a = __builtin_amdgcn_mfma_f32_16x16x32_bf16(kf[g][1], qf[1], a, 0, 0, 0);
                bq = __builtin_amdgcn_mfma_f32_16x16x32_bf16(kf[g][2], qf[0], bq, 0, 0, 0); bq = __builtin_amdgcn_mfma_f32_16x16x32_bf16(kf[g][3], qf[1], bq, 0, 0, 0);
                sa[g] = a * na::C2; sb[g] = bq * na::C2;
            }
            na::absorb<4>(A, sa, sb, vfr);
        }
        float ls = A.l; ls += __shfl_xor(ls, 16, 64); ls += __shfl_xor(ls, 32, 64);
        const float inv = __builtin_amdgcn_rcpf(ls);
        bf16_t* op = br + (size_t)T.qrow * OPN + h * 64 + 4 * kq;
#pragma unroll
        for (int db = 0; db < 4; ++db) { uint2 o; o.x = pk_bf16(A.o[db][0] * inv, A.o[db][1] * inv); o.y = pk_bf16(A.o[db][2] * inv, A.o[db][3] * inv);
            *(uint2*)(op + 16 * db) = o; }
    }
#undef NA_FENCE
#undef NA_TASKP
#undef NA_LOADK
#undef NA_LOADV
}
__device__ __forceinline__ int hg_row(int b, int dir, int s) { return s < 256 ? (NLAT + b * 256 + (dir ? 255 - s : s)) : (b * 2048 + (dir ? 2047 - (s - 256) : (s - 256))); }
__device__ __forceinline__ bf16x8 tr2(const LAS unsigned char* p0, const LAS unsigned char* p1) {
    typedef short v4i16_t __attribute__((ext_vector_type(4)));
    const v4i16_t a = __builtin_amdgcn_ds_read_tr16_b64_v4i16((LAS v4i16_t*)p0), c = __builtin_amdgcn_ds_read_tr16_b64_v4i16((LAS v4i16_t*)p1);
    return (bf16x8){a[0], a[1], a[2], a[3], c[0], c[1], c[2], c[3]};
}
__device__ __forceinline__ void hgrn_unit(const Params& P, LAS unsigned char* lds, int l, int u) {
    const int tid = tid_(), lane = tid & 63, wid = __builtin_amdgcn_readfirstlane(tid >> 6), c16 = lane & 15, kq = lane >> 4;
    const int b = u >> 3, h = (u >> 1) & 3, dir = u & 1;
    const bf16_t* z = (const bf16_t*)(P.ws + WS_Z);
    float* O = (float*)(P.ws + (dir ? WS_Y : WS_H));
    const float* lbv = (const float*)(P.ws + WS_LB) + ((size_t)l * 2 + dir) * 512 + h * 128;
    constexpr int PQ = 272;
    LAS unsigned char* QH = lds; LAS unsigned char* KT = lds + 8704; LAS unsigned char* KH = lds + 17408; LAS unsigned char* VV = lds + 26112;
    LAS float* DL = (LAS float*)(lds + 34816); LAS float* WT = DL + 128;
    const int ch = 2 * lane;
    const float lb0 = lbv[ch], lb1 = lbv[ch + 1];
    const int cf = (dir ? C_HFB : C_HFF) + h * 128 + ch, cq = C_HQ + h * 128 + ch, cv = C_HI + h * 128 + ch;
    f32x4 SA[4], SB[4];
#pragma unroll
    for (int G = 0; G < 4; ++G) { SA[G] = (f32x4){0.f, 0.f, 0.f, 0.f}; SB[G] = (f32x4){0.f, 0.f, 0.f, 0.f}; }
    unsigned rf[4], rq[4], rv[4];
#pragma unroll
    for (int k = 0; k < 4; ++k) { const bf16_t* zr = z + (size_t)hg_row(b, dir, 4 * wid + k) * ZP; rf[k] = *(const unsigned*)(zr + cf); rq[k] = *(const unsigned*)(zr + cq); rv[k] = *(const unsigned*)(zr + cv); }
    const int sA = 8 * (c16 >> 2) + (c16 & 3);
    const int tq = c16 >> 2, tp = c16 & 3;
    for (int st = 0; st < 72; ++st) {
        unsigned xf[4], xq[4], xv[4];
#pragma unroll
        for (int k = 0; k < 4; ++k) { xf[k] = rf[k]; xq[k] = rq[k]; xv[k] = rv[k]; }
        if (st + 1 < 72) {
#pragma unroll
            for (int k = 0; k < 4; ++k) { const bf16_t* zr = z + (size_t)hg_row(b, dir, (st + 1) * 32 + 4 * wid + k) * ZP; rf[k] = *(const unsigned*)(zr + cf); rq[k] = *(const unsigned*)(zr + cq); rv[k] = *(const unsigned*)(zr + cv); }
        }
        float g0[4], g1[4], k0[4], k1[4], q0[4], q1[4];
        float c0 = 1.f, c1 = 1.f;
#pragma unroll
        for (int k = 0; k < 4; ++k) {
            const float f0 = lb0 + (1.0f - lb0) * sigmoidf_(bf_lo(xf[k])), f1 = lb1 + (1.0f - lb1) * sigmoidf_(bf_hi(xf[k]));
            c0 *= f0; c1 *= f1; g0[k] = c0; g1[k] = c1;
            k0[k] = 1.0f - f0; k1[k] = 1.0f - f1; q0[k] = siluf_(bf_lo(xq[k])); q1[k] = siluf_(bf_hi(xq[k]));
        }
        WT[wid * 128 + ch] = c0; WT[wid * 128 + ch + 1] = c1;
        __syncthreads();
        float pre0 = 1.f, pre1 = 1.f, tot0 = 1.f, tot1 = 1.f;
#pragma unroll
        for (int w = 0; w < 8; ++w) { const float a0 = WT[w * 128 + ch], a1 = WT[w * 128 + ch + 1]; tot0 *= a0; tot1 *= a1; if (w < wid) { pre0 *= a0; pre1 *= a1; } }
#pragma unroll
        for (int k = 0; k < 4; ++k) {
            const float e0 = g0[k] * pre0, e1 = g1[k] * pre1;
            const float r0 = __builtin_amdgcn_rcpf(e0), r1 = __builtin_amdgcn_rcpf(e1);
            const float kt0 = k0[k] * r0, kt1 = k1[k] * r1;
            const int ro = (4 * wid + k) * PQ + ch * 2;
            *(LAS unsigned*)(QH + ro) = pk_bf16(q0[k] * e0, q1[k] * e1);
            *(LAS unsigned*)(KT + ro) = pk_bf16(kt0, kt1);
            *(LAS unsigned*)(KH + ro) = pk_bf16(kt0 * tot0, kt1 * tot1);
            *(LAS unsigned*)(VV + ro) = xv[k];
        }
        if (wid == 0) { DL[ch] = tot0; DL[ch + 1] = tot1; }
        __syncthreads();
        const bf16x8 vfr = tr2(VV + (8 * kq + tq) * PQ + (16 * wid + 4 * tp) * 2, VV + (8 * kq + 4 + tq) * PQ + (16 * wid + 4 * tp) * 2);
        bf16x8 Sb[4];
#pragma unroll
        for (int G = 0; G < 4; ++G) { const float sv[8] = {SA[G][0], SA[G][1], SA[G][2], SA[G][3], SB[G][0], SB[G][1], SB[G][2], SB[G][3]}; Sb[G] = pack8(sv); }
#pragma unroll
        for (int T = 0; T < 2; ++T) {
            f32x4 aA = {0.f, 0.f, 0.f, 0.f}, aB = {0.f, 0.f, 0.f, 0.f};
            bf16x8 qf[4];
#pragma unroll
            for (int ks = 0; ks < 4; ++ks) {
                const bf16x8 kA = *(const LAS bf16x8*)(KT + sA * PQ + (32 * ks + 8 * kq) * 2);
                const bf16x8 kB = *(const LAS bf16x8*)(KT + (sA + 4) * PQ + (32 * ks + 8 * kq) * 2);
                qf[ks] = *(const LAS bf16x8*)(QH + (16 * T + c16) * PQ + (32 * ks + 8 * kq) * 2);
                aA = __builtin_amdgcn_mfma_f32_16x16x32_bf16(kA, qf[ks], aA, 0, 0, 0);
                aB = __builtin_amdgcn_mfma_f32_16x16x32_bf16(kB, qf[ks], aB, 0, 0, 0);
            }
            const int t = 16 * T + c16;
            float pv_[8];
#pragma unroll
            for (int jj = 0; jj < 4; ++jj) { pv_[jj] = (8 * kq + jj <= t) ? aA[jj] : 0.f; pv_[4 + jj] = (8 * kq + 4 + jj <= t) ? aB[jj] : 0.f; }
            f32x4 o = {0.f, 0.f, 0.f, 0.f};
            o = __builtin_amdgcn_mfma_f32_16x16x32_bf16(pack8(pv_), vfr, o, 0, 0, 0);
#pragma unroll
            for (int ks = 0; ks < 4; ++ks) o = __builtin_amdgcn_mfma_f32_16x16x32_bf16(qf[ks], Sb[ks], o, 0, 0, 0);
#pragma unroll
            for (int jj = 0; jj < 4; ++jj) O[(size_t)hg_row(b, dir, st * 32 + 16 * T + 4 * kq + jj) * 512 + h * 128 + 16 * wid + c16] = o[jj];
        }
#pragma unroll
        for (int G = 0; G < 4; ++G) {
            const f32x4 d0 = *(const LAS f32x4*)(DL + 32 * G + 8 * kq), d1 = *(const LAS f32x4*)(DL + 32 * G + 8 * kq + 4);
            const LAS unsigned char* ka = KH + (8 * kq + tq) * PQ + (32 * G + 8 * tp) * 2;
            const bf16x8 hA = tr2(ka, ka + 4 * PQ), hB = tr2(ka + 8, ka + 4 * PQ + 8);
            SA[G] = __builtin_amdgcn_mfma_f32_16x16x32_bf16(hA, vfr, SA[G] * d0, 0, 0, 0);
            SB[G] = __builtin_amdgcn_mfma_f32_16x16x32_bf16(hB, vfr, SB[G] * d1, 0, 0, 0);
        }
    }
    __syncthreads();
}
__device__ __forceinline__ void gqa_unit(const Params& P, char* shm, int l, int U) {
    const bf16_t* z = (const bf16_t*)(P.ws + WS_Z); const bf16_t* kn = (const bf16_t*)(P.ws + WS_KN); const bf16_t* vn = (const bf16_t*)(P.ws + WS_VN);
    bf16_t* br = (bf16_t*)(P.ws + WS_BR);
    int b, hq, row0, NT;
    if (U < 512) { const int bg = U >> 5; b = bg >> 1; hq = (bg & 1) * 4 + ((U & 31) >> 3); row0 = b * 2048 + (U & 7) * 256; NT = 36; }
    else { const int v = U - 512; b = v >> 3; hq = v & 7; row0 = NLAT + b * 256; NT = 4; }
    const int g = hq >> 2;
    gqa::attn_unit<8>(z + (size_t)row0 * ZP + C_GQ + hq * 64, P.in[I_QNG] + l * 64, (const float*)(P.ws + WS_ROPE), (U < 512) ? ((U & 7) * 256) : -1,
                      kn + (size_t)b * 2304 * 128 + g * 64, vn + (size_t)b * 2304 * 128 + g * 64, br + (size_t)row0 * BRW + 1024 + hq * 64, NT, shm);
}
__device__ __forceinline__ void ph_mix(const Params& P, LAS unsigned char* lds, char* shm, int l, int pass = 0, int filter = 0) {
    const int tid = tid_();
    unsigned* qctr = (unsigned*)(P.ws + WS_CNT + 512) + l + 4 * pass;
    volatile LAS unsigned* qslot = (volatile LAS unsigned*)(lds + LDS_BYTES - 32);
    for (;;) {
        if (tid == 0) *qslot = __hip_atomic_fetch_add(qctr, 1u, __ATOMIC_RELAXED, __HIP_MEMORY_SCOPE_AGENT);
        __syncthreads();
        const int u = (int)*qslot;
        __syncthreads();
        if (u >= 960) break;
        const int kind = (u < 64) ? 2 : ((u >= 64 && u < 320) || (u >= 832 && u < 896)) ? 3 : 1;
        if (filter != 0 && filter != kind) continue;
        if (u < 64) hgrn_unit(P, lds, l, u);
        else if (u < 320) na_unit(P, lds, l, u - 64, (bf16_t*)(P.ws + WS_BR), BRW);
        else if (u < 832) gqa_unit(P, shm, l, u - 320);
        else if (u < 896) { if (l < DEPTH - 1) na_unit(P, lds, l, 256 + (u - 832), (bf16_t*)(P.ws + WS_BR), BRW); }
        else { if (l < DEPTH - 1) gqa_unit(P, shm, l, 512 + (u - 896)); }
        __syncthreads();
    }
}
#ifdef DIAG
__device__ __forceinline__ void ph_diag_cmp(const Params& P) {
    const bf16_t* br = (const bf16_t*)(P.ws + WS_BR); const bf16_t* d1 = (const bf16_t*)(P.ws + WS_END); const bf16_t* d2 = d1 + (size_t)NTOK * 512;
    const bf16_t* z = (const bf16_t*)(P.ws + WS_Z); const bf16_t* vt = (const bf16_t*)(P.ws + WS_NAVT);
    unsigned* dg = (unsigned*)(P.ws + 20480);
    unsigned c1 = 0, c2 = 0, c3 = 0;
    for (size_t i = (size_t)bid_() * NTHR + tid_(); i < (size_t)NTOK * 512; i += (size_t)gridDim.x * NTHR) {
        const size_t r = i >> 9; const int c = (int)(i & 511);
        const float a = bf2f(br[r * BRW + c]), x = bf2f(d1[i]);
        if (!(fabsf(x - a) <= 0.004f + 0.02f * fabsf(a))) ++c1;
        if (DIAG != 4 && d1[i] != d2[i]) ++c3;
        const int rr = (int)r; const int bb = rr < NLAT ? (rr >> 11) : ((rr - NLAT) >> 8); const int tok = rr < NLAT ? (256 + (rr & 2047)) : ((rr - NLAT) & 255);
        if (vt[((size_t)(bb * 8 + (c >> 6)) * 64 + (c & 63)) * 2304 + tok] != z[r * ZP + C_NAV + c]) ++c2;
    }
    if (c1) atomicAdd(dg + 1, c1);
    if (c2) atomicAdd(dg + 2, c2);
    if (c3) atomicAdd(dg + 3, c3);
}
__device__ __forceinline__ void ph_diag_out(const Params& P) {
    const volatile unsigned* dg = (const volatile unsigned*)(P.ws + 20480);
    const unsigned c1 = dg[1], c2 = dg[2], c3 = dg[3];
    if ((c1 | c2 | c3) == 0) return;
    unsigned k = 0; { unsigned v = c1; while (v) { ++k; v >>= 1; } }
    if (c2) k += 30; if (c3) k += 60;
    const float cst = sqrtf(10.0f * (float)k + 9.0f);
    for (size_t i = (size_t)bid_() * NTHR + tid_(); i < (size_t)NLAT * D; i += (size_t)gridDim.x * NTHR) P.out[i] = cst;
}
#endif

__device__ __forceinline__ void ph_readout(const Params& P, int l) {
    const int tid = tid_(), lane = tid & 63, wid = tid >> 6;
    const float* OF = (const float*)(P.ws + WS_H); const float* OB = (const float*)(P.ws + WS_Y);
    const bf16_t* z = (const bf16_t*)(P.ws + WS_Z);
    bf16_t* br = (bf16_t*)(P.ws + WS_BR);
    const float g0 = P.in[I_HGN][l * 128 + lane * 2], g1 = P.in[I_HGN][l * 128 + lane * 2 + 1];
    for (int r = bid_() * 8 + wid; r < NTOK; r += gridDim.x * 8) {
#pragma unroll
        for (int h = 0; h < 4; ++h) {
            const int c = h * 128 + lane * 2;
            const float2 a = *(const float2*)(OF + (size_t)r * 512 + c), bb = *(const float2*)(OB + (size_t)r * 512 + c);
            const float o0 = a.x + bb.x, o1 = a.y + bb.y;
            const float ss = wave_sum(o0 * o0 + o1 * o1);
            const float rstd = __builtin_amdgcn_rsqf(ss * (1.0f / 128.0f) + 1e-6f);
            const unsigned gz = *(const unsigned*)(z + (size_t)r * ZP + C_HG + c);
            *(unsigned*)(br + (size_t)r * BRW + 512 + c) = pk_bf16(o0 * rstd * g0 * siluf_(bf_lo(gz)), o1 * rstd * g1 * siluf_(bf_hi(gz)));
        }
    }
}
struct SchedMerge { int G, c; const char* br; const char* wb; bool last;
    __device__ __forceinline__ bool next(int i, pg8::Unit& u) const {
        const int nl = (c < 256) ? (256 - c + G - 1) / G : 0;
        int tile, bi, mode;
        if (i < 3 * nl) { tile = c + (i / 3) * G; bi = i % 3; mode = 0; }
        else { if (last) return false; const int sidx = c + (i - 3 * nl) * G; if (sidx >= 96) return false; tile = 256 + sidx / 3; bi = sidx % 3; mode = 1; }
        const int pm = tile >> 2, pn = tile & 3;
        u.row0 = pm * 256; u.col0 = pn * 256; u.aux = bi | (mode << 4);
        u.A = br + ((size_t)pm * 256 * BRW + bi * 512) * 2; u.B = wb + ((size_t)bi * 1024 + pn * 256) * 512 * 2; return true; } };
struct EpiMerge { const bf16_t* GT; bf16_t* YP; bf16_t* Y; bf16_t* PG;
    __device__ __forceinline__ void operator()(const f32x4 (&acc)[2][2][4][2], const pg8::Unit& u, int wr, int wc, int fr, int fq) const {
        const int tidx = (wr * 4 + wc) * 64 + fq * 16 + fr, bi = u.aux & 15, mode = u.aux >> 4, pm = u.row0 >> 8, pn = u.col0 >> 8;
        const bf16_t* gb = GT + ((size_t)pm * 12 + bi * 4 + pn) * 65536 + tidx * 8;
        if (mode == 1) {
            bf16_t* pb = PG + ((size_t)bi * 32 + (pm - 64) * 4 + pn) * 65536 + tidx * 8;
#pragma unroll
            for (int ai = 0; ai < 2; ++ai)
#pragma unroll
                for (int bj = 0; bj < 2; ++bj) {
                    uint4 g[4];
#pragma unroll
                    for (int m = 0; m < 4; ++m) g[m] = *(const uint4*)(gb + ((ai * 2 + bj) * 4 + m) * 4096);
#pragma unroll
                    for (int m = 0; m < 4; ++m) { const f32x4 v0 = acc[ai][bj][m][0], v1 = acc[ai][bj][m][1];
                        uint4 o; o.x = pk_bf16(bf_lo(g[m].x) * v0[0], bf_hi(g[m].x) * v0[1]); o.y = pk_bf16(bf_lo(g[m].y) * v0[2], bf_hi(g[m].y) * v0[3]);
                        o.z = pk_bf16(bf_lo(g[m].z) * v1[0], bf_hi(g[m].z) * v1[1]); o.w = pk_bf16(bf_lo(g[m].w) * v1[2], bf_hi(g[m].w) * v1[3]);
                        *(uint4*)(pb + ((ai * 2 + bj) * 4 + m) * 4096) = o; }
                }
            return;
        }
        bf16_t* yb = YP + ((size_t)pm * 4 + pn) * 65536 + tidx * 8;
#pragma unroll
        for (int ai = 0; ai < 2; ++ai)
#pragma unroll
            for (int bj = 0; bj < 2; ++bj) {
                uint4 g[4], p[4];
#pragma unroll
                for (int m = 0; m < 4; ++m) g[m] = *(const uint4*)(gb + ((ai * 2 + bj) * 4 + m) * 4096);
                if (bi != 0) {
#pragma unroll
                    for (int m = 0; m < 4; ++m) p[m] = *(const uint4*)(yb + ((ai * 2 + bj) * 4 + m) * 4096);
                } else {
#pragma unroll
                    for (int m = 0; m < 4; ++m) p[m] = make_uint4(0u, 0u, 0u, 0u);
                }
#pragma unroll
                for (int m = 0; m < 4; ++m) { const int k = ((ai * 2 + bj) * 4 + m) * 4096;
                    const f32x4 v0 = acc[ai][bj][m][0], v1 = acc[ai][bj][m][1];
                    const float t[8] = {bf_lo(p[m].x) + bf_lo(g[m].x) * v0[0], bf_hi(p[m].x) + bf_hi(g[m].x) * v0[1], bf_lo(p[m].y) + bf_lo(g[m].y) * v0[2], bf_hi(p[m].y) + bf_hi(g[m].y) * v0[3],
                                        bf_lo(p[m].z) + bf_lo(g[m].z) * v1[0], bf_hi(p[m].z) + bf_hi(g[m].z) * v1[1], bf_lo(p[m].w) + bf_lo(g[m].w) * v1[2], bf_hi(p[m].w) + bf_hi(g[m].w) * v1[3]};
                    if (bi != 2) { uint4 o; o.x = pk_bf16(t[0], t[1]); o.y = pk_bf16(t[2], t[3]); o.z = pk_bf16(t[4], t[5]); o.w = pk_bf16(t[6], t[7]); *(uint4*)(yb + k) = o; }
                    else { const int row = u.row0 + ai * 128 + wr * 64 + m * 16 + fr, col = u.col0 + bj * 128 + wc * 32 + 8 * fq;
                        uint4 o; o.x = pk_bf16(t[0], t[1]); o.y = pk_bf16(t[2], t[3]); o.z = pk_bf16(t[4], t[5]); o.w = pk_bf16(t[6], t[7]);
                        *(uint4*)(Y + (size_t)row * D + col) = o; }
                }
            }
    } };
__device__ __forceinline__ void ph_merge(const Params& P, LAS unsigned char* lds, int l) {
    SchedMerge S{(int)gridDim.x, bid_(), (const char*)(P.ws + WS_BR), (const char*)(P.ws + WS_WBR), l == DEPTH - 1};
    EpiMerge E{(const bf16_t*)(P.ws + WS_GT), (bf16_t*)(P.ws + WS_H), (bf16_t*)(P.ws + WS_Y), (bf16_t*)(P.ws + WS_PG)};
    pg8::gemm_phase(lds, pg8::Gemm{512, BRW, 512}, S, E);
    if (l + 1 < DEPTH && (int)bid_() >= 96) wconv_range(P, lds, l + 1, 0, 16 * 124, (int)bid_() - 96, (int)gridDim.x - 96);
}
struct EpiDelta { bf16_t* DX; const float* mods; int l;
    __device__ __forceinline__ void operator()(const f32x4 (&acc)[2][2][4][2], const pg8::Unit& u, int wr, int wc, int fr, int fq) const {
        const float* gate = mods + ((size_t)l * 9 + row_modrow(u.row0)) * 6144 + 2 * 1024 + u.col0 + wc * 32 + 8 * fq;
        f32x4 gv[2][2];
#pragma unroll
        for (int bj = 0; bj < 2; ++bj)
#pragma unroll
            for (int n = 0; n < 2; ++n) gv[bj][n] = *(const f32x4*)(gate + bj * 128 + n * 4);
#pragma unroll
        for (int ai = 0; ai < 2; ++ai)
#pragma unroll
            for (int m = 0; m < 4; ++m)
#pragma unroll
                for (int bj = 0; bj < 2; ++bj) { const int row = u.row0 + ai * 128 + wr * 64 + m * 16 + fr, col = u.col0 + bj * 128 + wc * 32 + 8 * fq;
                    const f32x4 v0 = acc[ai][bj][m][0] * gv[bj][0], v1 = acc[ai][bj][m][1] * gv[bj][1];
                    uint4 o; o.x = pk_bf16(v0[0], v0[1]); o.y = pk_bf16(v0[2], v0[3]); o.z = pk_bf16(v1[0], v1[1]); o.w = pk_bf16(v1[2], v1[3]);
                    *(uint4*)(DX + (size_t)row * D + col) = o; }
    } };
struct SchedWout { int G, c; const char* A; const char* B; bool last;
    __device__ __forceinline__ bool next(int i, pg8::Unit& u) const {
        const int nc = (!last && c < 32) ? 1 : 0;
        int tile;
        if (i < nc) tile = 256 + c; else { tile = c + (i - nc) * G; if (tile >= 256) return false; }
        const int pm = tile >> 2, pn = tile & 3;
        u.row0 = pm * 256; u.col0 = pn * 256; u.aux = 0; u.A = A + (size_t)pm * 256 * D * 2; u.B = B + (size_t)pn * 256 * D * 2; return true; } };
__device__ __forceinline__ void ph_wout(const Params& P, LAS unsigned char* lds, int l, bool dry = false) {
    const bool last = (l == DEPTH - 1);
    const int c = bid_();
    if (!last && c < 32) {
        const int tid = tid_(), wid = tid >> 6, lane = tid & 63, wr = wid >> 2, wc = wid & 3, fr = lane & 15, fq = lane >> 4;
        const bf16_t* PG = (const bf16_t*)(P.ws + WS_PG); bf16_t* Y = (bf16_t*)(P.ws + WS_Y);
        const int pp = c >> 2;
        for (int pn = 0; pn < 4; ++pn)
#pragma unroll
            for (int kk = 0; kk < 16; ++kk) {
                const size_t off = ((size_t)pp * 4 + pn) * 65536 + kk * 4096 + tid * 8;
                const uint4 a = *(const uint4*)(PG + off), b = *(const uint4*)(PG + (size_t)32 * 65536 + off), d = *(const uint4*)(PG + (size_t)64 * 65536 + off);
                const int ai = kk >> 3, bj = (kk >> 2) & 1, m = kk & 3;
                const int row = (64 + pp) * 256 + ai * 128 + wr * 64 + m * 16 + fr, col = pn * 256 + bj * 128 + wc * 32 + 8 * fq;
                uint4 o;
                o.x = pk_bf16(bf_lo(a.x) + bf_lo(b.x) + bf_lo(d.x), bf_hi(a.x) + bf_hi(b.x) + bf_hi(d.x)); o.y = pk_bf16(bf_lo(a.y) + bf_lo(b.y) + bf_lo(d.y), bf_hi(a.y) + bf_hi(b.y) + bf_hi(d.y));
                o.z = pk_bf16(bf_lo(a.z) + bf_lo(b.z) + bf_lo(d.z), bf_hi(a.z) + bf_hi(b.z) + bf_hi(d.z)); o.w = pk_bf16(bf_lo(a.w) + bf_lo(b.w) + bf_lo(d.w), bf_hi(a.w) + bf_hi(b.w) + bf_hi(d.w));
                *(uint4*)(Y + (size_t)row * D + col) = o;
            }
        asm volatile("s_waitcnt vmcnt(0)" ::: "memory");
        __syncthreads();
    }
    SchedWout S{(int)gridDim.x, c, (const char*)(P.ws + WS_Y), (const char*)(P.ws + WS_WOUT), last};
    EpiDelta E{(bf16_t*)(P.ws + (dry ? WS_END : WS_BR)), (const float*)(P.ws + WS_MODS), l};
    pg8::gemm_phase(lds, pg8::Gemm{D, D, D}, S, E);
    if (!dry) { if (last) wconv_range(P, lds, l, CONV_T_DENSE, CONV_T_ALL, c, (int)gridDim.x); else if (c >= 32) wconv_range(P, lds, l, CONV_T_DENSE, CONV_T_ALL, c - 32, (int)gridDim.x - 32); }
}
__device__ __forceinline__ void ph_norm2_route(const Params& P, LAS unsigned char* lds, int l, bool dry = false) {
    const int tid = tid_(), lane = tid & 63, wid = tid >> 6;
    LAS float* Wt = (LAS float*)lds;
    LAS int* lcnt = (LAS int*)(lds + 81920); LAS int* lbase = lcnt + 16; LAS int* rinfo = lbase + 16;
    LAS float* rw = (LAS float*)(rinfo + 128 * 4); LAS float* rlog = rw + 256;
    { const f32x4* rt4 = (const f32x4*)((const float*)(P.ws + WS_RT) + (size_t)l * 20480);
      for (int i = tid; i < 5 * 1024; i += NTHR) *(LAS f32x4*)(Wt + i * 4) = rt4[i]; }
    if (tid < 16) lcnt[tid] = 0;
    __syncthreads();
    const float* xres = (const float*)(P.ws + WS_X);
    const bf16_t* dx = (const bf16_t*)(P.ws + WS_BR);
    bf16_t* f = (bf16_t*)(P.ws + (dry ? WS_END : WS_H));
    const float* g = P.in[I_GFFN] + l * 1024;
    int* cnt = (int*)(P.ws + (dry ? 32768 : WS_CNT)) + l * 16;
    int* inv = (int*)(P.ws + WS_INV);
    int* sel_e = (int*)(P.ws + (dry ? WS_END + 40000000 : WS_SELE)); float* sel_w = (float*)(P.ws + (dry ? WS_END + 41000000 : WS_SELW)); int* sel_p = (int*)(P.ws + (dry ? WS_END + 42000000 : WS_SELP));
    const int NR = (l == DEPTH - 1) ? NLAT : NTOK;
    const int RPW = (NR + 8 * (int)gridDim.x - 1) / (8 * (int)gridDim.x);
    const int widu = __builtin_amdgcn_readfirstlane(wid);
    const int r0 = bid_() * 8 * RPW;
    const float* modl = (const float*)(P.ws + WS_MODS) + (size_t)l * 9 * 6144;
    int cm = -1;
    f32x4 gsc[4], shv[4];
    for (int k = 0; k < RPW; k += 3) {
        const int slotA = widu * RPW + k, rA = r0 + slotA;
        if (rA >= NR) break;
        int nv = RPW - k; if (nv > 3) nv = 3; if (nv > NR - rA) nv = NR - rA;
        f32x4 x[3][4];
#pragma unroll
        for (int q = 0; q < 3; ++q) {
            const int r = rA + (q < nv ? q : 0);
#pragma unroll
            for (int i = 0; i < 4; ++i) { f32x4 v = *(const f32x4*)(xres + (size_t)r * D + lane * 4 + 256 * i);
                const uint2 dv = *(const uint2*)(dx + (size_t)r * D + lane * 4 + 256 * i);
                v[0] += bf_lo(dv.x); v[1] += bf_hi(dv.x); v[2] += bf_lo(dv.y); v[3] += bf_hi(dv.y); x[q][i] = v; }
        }
#pragma unroll
        for (int q = 0; q < 3; ++q) {
            const int r = rA + (q < nv ? q : 0);
            float ss = 0.f;
#pragma unroll
            for (int i = 0; i < 4; ++i) ss += x[q][i][0] * x[q][i][0] + x[q][i][1] * x[q][i][1] + x[q][i][2] * x[q][i][2] + x[q][i][3] * x[q][i][3];
            ss = wave_sum(ss);
            const float rstd = __builtin_amdgcn_rsqf(ss * (1.0f / 1024.0f) + 1e-6f);
            const int mr = row_modrow(r);
            if (mr != cm) {
                cm = mr;
                const float* mod = modl + (size_t)mr * 6144;
#pragma unroll
                for (int i = 0; i < 4; ++i) { const int c = lane * 4 + 256 * i;
                    const f32x4 gv = *(const f32x4*)(g + c), sc = *(const f32x4*)(mod + 4 * 1024 + c);
                    gsc[i] = gv * (1.0f + sc); shv[i] = *(const f32x4*)(mod + 3 * 1024 + c); }
            }
#pragma unroll
            for (int i = 0; i < 4; ++i) x[q][i] = x[q][i] * rstd * gsc[i] + shv[i];
            if (q < nv) {
#pragma unroll
                for (int i = 0; i < 4; ++i) { uint2 u; u.x = pk_bf16(x[q][i][0], x[q][i][1]); u.y = pk_bf16(x[q][i][2], x[q][i][3]); *(uint2*)(f + (size_t)r * D + lane * 4 + 256 * i) = u; }
            }
        }
#pragma unroll
        for (int jb = 0; jb < 5; ++jb) {
            pkf32x2_t s[3][4];
#pragma unroll
            for (int jj = 0; jj < 4; ++jj) {
                f32x4 w[4];
#pragma unroll
                for (int i = 0; i < 4; ++i) w[i] = *(const LAS f32x4*)(Wt + (jb * 4 + jj) * 1024 + lane * 4 + 256 * i);
#pragma unroll
                for (int q = 0; q < 3; ++q) { pkf32x2_t a = {0.f, 0.f};
#pragma unroll
                    for (int i = 0; i < 4; ++i) { a += x[q][i].lo * w[i].lo; a += x[q][i].hi * w[i].hi; }
                    s[q][jj] = a; }
            }
#pragma unroll
            for (int q = 0; q < 3; ++q) {
                const float a0 = s[q][0][0] + s[q][0][1], a1 = s[q][1][0] + s[q][1][1], a2 = s[q][2][0] + s[q][2][1], a3 = s[q][3][0] + s[q][3][1];
                auto r1 = __builtin_amdgcn_permlane32_swap(__float_as_uint(a0), __float_as_uint(a1), false, false);
                auto r2 = __builtin_amdgcn_permlane32_swap(__float_as_uint(a2), __float_as_uint(a3), false, false);
                const float c1 = __uint_as_float(r1[0]) + __uint_as_float(r1[1]), c2 = __uint_as_float(r2[0]) + __uint_as_float(r2[1]);
                auto r3 = __builtin_amdgcn_permlane16_swap(__float_as_uint(c1), __float_as_uint(c2), false, false);
                float e = __uint_as_float(r3[0]) + __uint_as_float(r3[1]);
                e += dpp_f(e, 0); e += dpp_f(e, 1); e += dpp_f(e, 2); e += dpp_f(e, 3);
                if ((lane & 15) == 0 && q < nv) { const int gq = lane >> 4; rlog[(slotA + q) * 20 + jb * 4 + ((gq & 1) << 1 | (gq >> 1))] = e; }
            }
        }
    }
    __syncthreads();
    for (int slot = tid; slot < 128; slot += NTHR) {
        const int r = r0 + slot;
        if (slot < 8 * RPW && r < NR) {
            float lg[20];
#pragma unroll
            for (int j = 0; j < 20; ++j) lg[j] = rlog[slot * 20 + j];
            float gl[4]; int gi = 0;
#pragma unroll
            for (int j = 0; j < 4; ++j) gl[j] = lg[j] + P.in[I_BGR][l * 4 + j];
            float gm = gl[0];
#pragma unroll
            for (int j = 1; j < 4; ++j) if (gl[j] > gm) { gm = gl[j]; gi = j; }
            float se = 0.f;
#pragma unroll
            for (int j = 0; j < 4; ++j) se += __expf(gl[j] - gm);
            const float pg = __builtin_amdgcn_rcpf(se);
            float el[4];
#pragma unroll
            for (int j = 0; j < 4; ++j) {
                float v = 0.f;
#pragma unroll
                for (int q = 0; q < 4; ++q) v = (gi == q) ? lg[4 + q * 4 + j] : v;
                el[j] = v + P.in[I_BER][l * 16 + gi * 4 + j];
            }
            int i0 = 0; float v0 = el[0];
#pragma unroll
            for (int j = 1; j < 4; ++j) if (el[j] > v0) { v0 = el[j]; i0 = j; }
            int i1 = -1; float v1 = -INFINITY;
#pragma unroll
            for (int j = 0; j < 4; ++j) if (j != i0 && el[j] > v1) { v1 = el[j]; i1 = j; }
            const float w0 = __builtin_amdgcn_rcpf(1.0f + __expf(v1 - v0)), w1 = 1.0f - w0;
            const int e0 = gi * 4 + i0, e1 = gi * 4 + i1;
            rinfo[slot * 4 + 0] = e0 | (e1 << 8);
            rinfo[slot * 4 + 1] = __hip_atomic_fetch_add(&lcnt[e0], 1, __ATOMIC_RELAXED, __HIP_MEMORY_SCOPE_WORKGROUP);
            rinfo[slot * 4 + 2] = __hip_atomic_fetch_add(&lcnt[e1], 1, __ATOMIC_RELAXED, __HIP_MEMORY_SCOPE_WORKGROUP);
            rw[slot * 2] = w0 * pg; rw[slot * 2 + 1] = w1 * pg;
        }
    }
    __syncthreads();
    if (tid < 16) lbase[tid] = atomicAdd(&cnt[tid], lcnt[tid]);
    __syncthreads();
    for (int slot = tid; slot < 128; slot += NTHR) {
        const int r = r0 + slot;
        if (slot < 8 * RPW && r < NR) { const int ee = rinfo[slot * 4], e0 = ee & 255, e1 = ee >> 8;
            sel_e[r * 2] = e0; sel_e[r * 2 + 1] = e1;
            sel_w[r * 2] = rw[slot * 2]; sel_w[r * 2 + 1] = rw[slot * 2 + 1];
            const int p0_ = lbase[e0] + rinfo[slot * 4 + 1], p1_ = lbase[e1] + rinfo[slot * 4 + 2];
            sel_p[r * 2] = p0_; sel_p[r * 2 + 1] = p1_;
            if (!dry) { inv[(size_t)e0 * NTOK + p0_] = r; inv[(size_t)e1 * NTOK + p1_] = r; } }
    }
    __syncthreads();
}
__device__ __forceinline__ void moe_offsets(const int* cnt, int (&off)[17]) {
    int a = 0;
#pragma unroll
    for (int e = 0; e < 16; ++e) { off[e] = a; a += (cnt[e] + 255) & ~255; }
    off[16] = a;
}
__device__ __forceinline__ void ph_scatter(const Params& P, int l) {
    const int tid = tid_(), lane = tid & 63, wid = tid >> 6;
    const int* cnt = (const int*)(P.ws + WS_CNT) + l * 16;
    int off[17]; moe_offsets(cnt, off);
    const bf16_t* f = (const bf16_t*)(P.ws + WS_H); bf16_t* Fs = (bf16_t*)(P.ws + WS_FS);
    const int* sel_e = (const int*)(P.ws + WS_SELE); const int* sel_p = (const int*)(P.ws + WS_SELP); int* srow = (int*)(P.ws + WS_SROW);
    for (int r = bid_() * 8 + wid; r < ((l == DEPTH - 1) ? NLAT : NTOK); r += gridDim.x * 8) {
        const uint4 a = *(const uint4*)(f + (size_t)r * D + lane * 8), b = *(const uint4*)(f + (size_t)r * D + 512 + lane * 8);
#pragma unroll
        for (int k = 0; k < 2; ++k) {
            const int e = sel_e[r * 2 + k];
            int o = 0;
#pragma unroll
            for (int q = 0; q < 16; ++q) o = (e == q) ? off[q] : o;
            const int d = o + sel_p[r * 2 + k];
            *(uint4*)(Fs + (size_t)d * D + lane * 8) = a; *(uint4*)(Fs + (size_t)d * D + 512 + lane * 8) = b;
            if (lane == 0) srow[r * 2 + k] = d;
        }
    }
}
struct SchedMoe { int NM, G, c; int tfirst[16]; const char* A; const char* W; size_t tA, eW, tW;
    __device__ __forceinline__ bool next(int i, pg8::Unit& u) const {
        const int L = i * G + c; if (L >= NM * 4) return false;
        const int pm = L >> 2, pn = L & 3;
        int e = 0;
#pragma unroll
        for (int q = 1; q < 16; ++q) e += (pm >= tfirst[q]) ? 1 : 0;
        u.row0 = pm * 256; u.col0 = pn * 256; u.aux = e; u.A = A + (size_t)pm * tA; u.B = W + (size_t)e * eW + (size_t)pn * tW; return true; } };
struct FSwiglu { bf16_t* H;
    __device__ __forceinline__ void operator()(const pg8::Unit&, int row, int col, const f32x4& v0, const f32x4& v1) const {
        const int hc = ((col & ~31) >> 1) + (col & 15);
        uint2 a; a.x = pk_bf16(siluf_(v0[0]) * v1[0], siluf_(v0[1]) * v1[1]); a.y = pk_bf16(siluf_(v0[2]) * v1[2], siluf_(v0[3]) * v1[3]);
        *(uint2*)(H + (size_t)row * EH + hc) = a; } };
__device__ __forceinline__ void moe_sched(const Params& P, int l, SchedMoe& S) {
    const int* cnt = (const int*)(P.ws + WS_CNT) + l * 16;
    int a = 0;
#pragma unroll
    for (int e = 0; e < 16; ++e) { S.tfirst[e] = a; a += (cnt[e] + 255) >> 8; }
    S.NM = a; S.G = (int)gridDim.x; S.c = bid_();
}
struct SchedMoeG { int NM, G, c; int tfirst[16]; int cnt[16]; const int* inv; const char* A; const char* W; int R[2], C[2];
    __device__ __forceinline__ bool next(int i, pg8::Unit& u) const {
        const int L = i * G + c; if (L >= NM * 4) return false;
        const int pm = L >> 2, pn = L & 3;
        int e = 0;
#pragma unroll
        for (int q = 1; q < 16; ++q) e += (pm >= tfirst[q]) ? 1 : 0;
        int tf = 0, ne = 0;
#pragma unroll
        for (int q = 0; q < 16; ++q) { tf = (e == q) ? tfirst[q] : tf; ne = (e == q) ? cnt[q] : ne; }
        u.row0 = pm * 256; u.col0 = pn * 256; u.aux = e | (tf << 8) | (ne << 16); u.A = A; u.B = W + (size_t)e * (1024 * 1024 * 2) + (size_t)pn * (256 * 1024 * 2);
        return true; }
    __device__ __forceinline__ void gather(const pg8::Unit& u, unsigned (&gv)[2][2]) const {
        const int e = u.aux & 255, tf = (u.aux >> 8) & 255, ne = (int)((unsigned)u.aux >> 16), p0 = ((u.row0 >> 8) - tf) * 256;
#pragma unroll
        for (int h = 0; h < 2; ++h)
#pragma unroll
            for (int k = 0; k < 2; ++k) { const int idx = p0 + h * 128 + R[k];
                const int tok = (idx < ne) ? inv[(size_t)e * NTOK + idx] : 0;
                gv[h][k] = (unsigned)(tok * D + C[k]) * 2u; } } };
__device__ __forceinline__ void ph_moe1(const Params& P, LAS unsigned char* lds, int l) {
    SchedMoeG S;
    { const int* cnt = (const int*)(P.ws + WS_CNT) + l * 16; int a = 0;
#pragma unroll
      for (int e = 0; e < 16; ++e) { S.tfirst[e] = a; S.cnt[e] = cnt[e]; a += (cnt[e] + 255) >> 8; }
      S.NM = a; }
    S.G = (int)gridDim.x; S.c = bid_(); S.inv = (const int*)(P.ws + WS_INV); S.A = (const char*)(P.ws + WS_H); S.W = (const char*)(P.ws + WS_WGU);
    { const int tid = tid_();
#pragma unroll
      for (int k = 0; k < 2; ++k) { int R_, C_; pg8::stage_rc(tid * 16 + k * 8192, R_, C_); S.R[k] = R_; S.C[k] = C_; } }
    pg8::EpiPair<FSwiglu> E{{(bf16_t*)(P.ws + WS_HS)}};
    pg8::gemm_phase<pg8::EpiPair<FSwiglu>, SchedMoeG, true>(lds, pg8::Gemm{1024, 1024, 1024}, S, E);
}
__device__ __forceinline__ void ph_moe2(const Params& P, LAS unsigned char* lds, int l) {
    SchedMoe S; moe_sched(P, l, S);
    S.A = (const char*)(P.ws + WS_HS); S.W = (const char*)(P.ws + WS_WDN); S.tA = (size_t)256 * EH * 2; S.eW = (size_t)1024 * 512 * 2; S.tW = (size_t)256 * 512 * 2;
    EpiStore16 E{(bf16_t*)(P.ws + WS_YS), D};
    pg8::gemm_phase(lds, pg8::Gemm{512, 512, 512}, S, E);
}
__device__ __forceinline__ int srow_of(const int (&moff)[17], int e, int p) { int o = 0;
#pragma unroll
    for (int q = 0; q < 16; ++q) o = (e == q) ? moff[q] : o;
    return o + p; }
__device__ __forceinline__ void ph_combine(const Params& P, int l, bool dry = false) {
    const int tid = tid_(), lane = tid & 63, wid = tid >> 6;
    float* xres = (float*)(P.ws + WS_X);
    const bf16_t* Ys = (const bf16_t*)(P.ws + WS_YS);
    const float* sel_w = (const float*)(P.ws + WS_SELW); const int* sel_e = (const int*)(P.ws + WS_SELE); const int* sel_p = (const int*)(P.ws + WS_SELP);
    int moff[17]; moe_offsets((const int*)(P.ws + WS_CNT) + l * 16, moff);
#define SROW_(i_) srow_of(moff, sel_e[i_], sel_p[i_])
    bf16_t* h = (bf16_t*)(P.ws + (dry ? WS_END : WS_H));
    const bf16_t* dxb = (const bf16_t*)(P.ws + WS_BR);
    const int NR_ = (l == DEPTH - 1) ? NLAT : NTOK, rs_ = gridDim.x * 8;
    int rq = bid_() * 8 + wid;
    float nw0 = 0.f, nw1 = 0.f; int ns0 = 0, ns1 = 0;
    if (rq < NR_) { nw0 = sel_w[rq * 2]; nw1 = sel_w[rq * 2 + 1]; ns0 = SROW_(rq * 2); ns1 = SROW_(rq * 2 + 1); }
    float4 xn[4]; uint2 dn[4], an[4], bn[4]; float cw0 = 0.f, cw1 = 0.f;
    if (rq < NR_) {
        cw0 = nw0; cw1 = nw1;
#pragma unroll
        for (int i = 0; i < 4; ++i) { const int c = lane * 4 + 256 * i; xn[i] = *(const float4*)(xres + (size_t)rq * D + c); dn[i] = *(const uint2*)(dxb + (size_t)rq * D + c);
            an[i] = *(const uint2*)(Ys + (size_t)ns0 * D + c); bn[i] = *(const uint2*)(Ys + (size_t)ns1 * D + c); }
        if (rq + rs_ < NR_) { nw0 = sel_w[(rq + rs_) * 2]; nw1 = sel_w[(rq + rs_) * 2 + 1]; ns0 = SROW_((rq + rs_) * 2); ns1 = SROW_((rq + rs_) * 2 + 1); }
    }
    for (int r = rq; r < NR_; r += rs_) {
        const float* gate = (const float*)(P.ws + WS_MODS) + ((size_t)l * 9 + row_modrow(r)) * 6144 + 5 * 1024;
        const float w0 = cw0, w1 = cw1;
        float4 x[4]; uint2 dv_[4], a_[4], b_[4];
#pragma unroll
        for (int i = 0; i < 4; ++i) { x[i] = xn[i]; dv_[i] = dn[i]; a_[i] = an[i]; b_[i] = bn[i]; }
        if (r + rs_ < NR_) {
            cw0 = nw0; cw1 = nw1;
#pragma unroll
            for (int i = 0; i < 4; ++i) { const int c = lane * 4 + 256 * i; xn[i] = *(const float4*)(xres + (size_t)(r + rs_) * D + c); dn[i] = *(const uint2*)(dxb + (size_t)(r + rs_) * D + c);
                an[i] = *(const uint2*)(Ys + (size_t)ns0 * D + c); bn[i] = *(const uint2*)(Ys + (size_t)ns1 * D + c); }
            if (r + 2 * rs_ < NR_) { nw0 = sel_w[(r + 2 * rs_) * 2]; nw1 = sel_w[(r + 2 * rs_) * 2 + 1]; ns0 = SROW_((r + 2 * rs_) * 2); ns1 = SROW_((r + 2 * rs_) * 2 + 1); }
        }
#pragma unroll
        for (int i = 0; i < 4; ++i) {
            const int c = lane * 4 + 256 * i;
            x[i].x += bf_lo(dv_[i].x); x[i].y += bf_hi(dv_[i].x); x[i].z += bf_lo(dv_[i].y); x[i].w += bf_hi(dv_[i].y);
            const uint2 a = a_[i], b = b_[i];
            const float4 gv = *(const float4*)(gate + c);
            x[i].x += gv.x * (w0 * bf_lo(a.x) + w1 * bf_lo(b.x)); x[i].y += gv.y * (w0 * bf_hi(a.x) + w1 * bf_hi(b.x));
            x[i].z += gv.z * (w0 * bf_lo(a.y) + w1 * bf_lo(b.y)); x[i].w += gv.w * (w0 * bf_hi(a.y) + w1 * bf_hi(b.y));
        }
        if (l < DEPTH - 1) {
#pragma unroll
            for (int i = 0; i < 4; ++i) *(float4*)((dry ? (float*)(P.ws + WS_END) + (size_t)NTOK * 512 : xres) + (size_t)r * D + lane * 4 + 256 * i) = x[i];
            const float* mod = (const float*)(P.ws + WS_MODS) + ((size_t)(l + 1) * 9 + row_modrow(r)) * 6144;
            float4 o[4];
            norm_row(x, P.in[I_GMIX] + (l + 1) * 1024, mod, mod + 1024, lane, o);
#pragma unroll
            for (int i = 0; i < 4; ++i) { uint2 u; u.x = pk_bf16(o[i].x, o[i].y); u.y = pk_bf16(o[i].z, o[i].w); *(uint2*)(h + (size_t)r * D + lane * 4 + 256 * i) = u; }
        } else if (r < NLAT) {
            float ss = 0.f;
#pragma unroll
            for (int i = 0; i < 4; ++i) ss += x[i].x * x[i].x + x[i].y * x[i].y + x[i].z * x[i].z + x[i].w * x[i].w;
            ss = wave_sum(ss);
            const float rstd = __builtin_amdgcn_rsqf(ss * (1.0f / 1024.0f) + 1e-6f);
#pragma unroll
            for (int i = 0; i < 4; ++i) {
                const int c = lane * 4 + 256 * i;
                const float4 gv = *(const float4*)(P.in[I_GFIN] + c);
                float4 o; o.x = x[i].x * rstd * gv.x; o.y = x[i].y * rstd * gv.y; o.z = x[i].z * rstd * gv.z; o.w = x[i].w * rstd * gv.w;
                *(float4*)((dry ? (float*)(P.ws + WS_END) : P.out) + (size_t)r * D + c) = o;
            }
        }
    }
}

constexpr int NPH_LAYER = 12, NPH = 1 + DEPTH * NPH_LAYER;
#define CAS __attribute__((address_space(4)))
__device__ __forceinline__ const Params& kparams() { const CAS Params* k = (const CAS Params*)__builtin_amdgcn_kernarg_segment_ptr(); asm volatile("" : "+s"(k)); return *(const Params*)k; }
__global__ void __launch_bounds__(NTHR, 2) fwd(Params P_) {
    extern __shared__ __attribute__((aligned(16))) unsigned char lds_raw[];
    LAS unsigned char* lds = (LAS unsigned char*)lds_raw;
    volatile LAS unsigned* xbw = (volatile LAS unsigned*)(lds + LDS_BYTES - 16);
    if (threadIdx.x == 0) { xbw[0] = 0u; xbw[1] = 0u; xbw[2] = 0u; xbw[3] = 0u; }
    __syncthreads();
    const int lo = P_.ph_lo, hi = P_.ph_hi;
    XcdBarrier bar; bar.bar = (unsigned*)(P_.ws + WS_BAR); bar.x = 0; bar.st = xbw;
    if (hi - lo > 1) bar = xcd_barrier_post((unsigned*)(P_.ws + WS_BAR), xbw);
#ifndef PHMASK
#define PHMASK 0xFFFF
#endif
#define EN(j) ((PHMASK >> (j)) & 1)
#define IN(k) (lo <= (k) && (k) < hi)
#define SEAM(k) do { if (IN(k) && IN((k) + 1)) xcd_barrier(bar); } while (0)
    if (EN(12) && IN(0)) for (int rep = 0; rep < NREP(12); ++rep) { ph_prologue(kparams(), lds); }
    SEAM(0);
    for (int l = 0; l < DEPTH; ++l) {
        const int p0 = 1 + l * NPH_LAYER;
        if (l == 0) { if (EN(0) && IN(p0 + 0)) for (int rep = 0; rep < NREP(0); ++rep) { ph_wconv(kparams(), lds, l); ph_norm1(kparams(), l); }
        SEAM(p0 + 0); }
        if (EN(1) && IN(p0 + 1)) for (int rep = 0; rep < NREP(1); ++rep) ph_g1(kparams(), lds);
        SEAM(p0 + 1);
        if (EN(2) && IN(p0 + 2)) for (int rep = 0; rep < NREP(2); ++rep) { ph_prep(kparams(), l); ph_navt(kparams(), lds); }
        SEAM(p0 + 2);
        if (EN(3) && IN(p0 + 3)) { ph_mix(kparams(), lds, (char*)lds_raw, l);
            if (REPEAT_MASK & 0x8) { xcd_barrier(bar); ph_mix(kparams(), lds, (char*)lds_raw, l, 1, 0); }
            if (REPEAT_MASK & 0x2000) { xcd_barrier(bar); ph_mix(kparams(), lds, (char*)lds_raw, l, 1, 1); }
            if (REPEAT_MASK & 0x4000) { xcd_barrier(bar); ph_mix(kparams(), lds, (char*)lds_raw, l, 1, 2); }
            if (REPEAT_MASK & 0x8000) { xcd_barrier(bar); ph_mix(kparams(), lds, (char*)lds_raw, l, 1, 3); } }
        SEAM(p0 + 3);
        if (EN(4) && IN(p0 + 4)) for (int rep = 0; rep < NREP(4); ++rep) {
#if defined(DIAG) && DIAG == 5
            { const Params& Pq = kparams(); const int G_ = gridDim.x, c_ = bid_(), vcu_ = (c_ % 8) * (G_ / 8) + c_ / 8; for (int u = vcu_; u < 320; u += G_) na_unit(Pq, lds, l, u, (bf16_t*)(Pq.ws + WS_BR), BRW); __syncthreads(); }
#endif
            ph_readout(kparams(), l);
#if defined(DIAG) && (DIAG == 1 || DIAG == 4)
            ph_diag_cmp(kparams());
#endif
#if defined(DIAG) && DIAG == 3
            { const Params& Pq = kparams(); const uint4* d1 = (const uint4*)(Pq.ws + WS_END); bf16_t* brq = (bf16_t*)(Pq.ws + WS_BR);
              for (size_t i = (size_t)bid_() * NTHR + tid_(); i < (size_t)NTOK * 64; i += (size_t)gridDim.x * NTHR) { const size_t r = i >> 6; const int c8 = (int)(i & 63) * 8; *(uint4*)(brq + r * BRW + c8) = d1[i]; } }
#endif
        }
        SEAM(p0 + 4);
        if (EN(5) && IN(p0 + 5)) for (int rep = 0; rep < NREP(5); ++rep) ph_merge(kparams(), lds, l);
        SEAM(p0 + 5);
        if (EN(6) && IN(p0 + 6)) for (int rep = 0; rep < NREP(6); ++rep) ph_wout(kparams(), lds, l, rep > 0);
        SEAM(p0 + 6);
        if (EN(7) && IN(p0 + 7)) for (int rep = 0; rep < NREP(7); ++rep) ph_norm2_route(kparams(), lds, l, rep > 0);
        SEAM(p0 + 7);
        if (EN(9) && IN(p0 + 9)) for (int rep = 0; rep < NREP(9); ++rep) ph_moe1(kparams(), lds, l);
        SEAM(p0 + 9);
        if (EN(10) && IN(p0 + 10)) for (int rep = 0; rep < NREP(10); ++rep) ph_moe2(kparams(), lds, l);
        SEAM(p0 + 10);
        if (EN(11) && IN(p0 + 11)) for (int rep = 0; rep < NREP(11); ++rep) { ph_combine(kparams(), l, rep > 0); if (l + 1 < DEPTH) wconv_range(kparams(), lds, l + 1, 16 * 124, CONV_T_DENSE, bid_(), gridDim.x); }
        if (l + 1 < DEPTH) { if (IN(p0 + 11) && IN(p0 + 13)) xcd_barrier(bar); }
    }
#if defined(DIAG) && (DIAG == 1 || DIAG == 4)
    xcd_barrier(bar); ph_diag_out(kparams());
#endif
#undef IN
#undef SEAM
}

#ifndef MK_PER_PHASE
#define MK_PER_PHASE 0
#endif
extern "C" void kernel_launch(void* const* d_in, const int* in_sizes, int n_in, void* d_out, int out_size, void* d_ws, size_t ws_size, hipStream_t stream) {
    static int grid = 0;
    if (grid == 0) {
        if (n_in != 24 || out_size != NLAT * D || ws_size < WS_END + (size_t)NTOK * 4096 + 4096) { fprintf(stderr, "kernel_launch: unexpected shapes (n_in %d out %d ws %zu need %zu)\n", n_in, out_size, ws_size, (size_t)WS_END); grid = -1; return; }
        int dev = 0, cus = 0, per_cu = 0;
        if (hipGetDevice(&dev) != hipSuccess || hipDeviceGetAttribute(&cus, hipDeviceAttributeMultiprocessorCount, dev) != hipSuccess) { grid = -1; return; }
        if (hipFuncSetAttribute((const void*)fwd, hipFuncAttributeMaxDynamicSharedMemorySize, LDS_BYTES) != hipSuccess) { fprintf(stderr, "kernel_launch: hipFuncSetAttribute failed\n"); grid = -1; return; }
        if (hipOccupancyMaxActiveBlocksPerMultiprocessor(&per_cu, (const void*)fwd, NTHR, LDS_BYTES) != hipSuccess || per_cu < 1) { fprintf(stderr, "kernel_launch: occupancy query says %d\n", per_cu); }
        (void)hipGetLastError();
        grid = cus;
    }
    if (grid < 0) return;
    (void)hipMemsetAsync(d_ws, 0, WS_ZERO_BYTES, stream);
    Params p{};
    for (int i = 0; i < 24; ++i) p.in[i] = (const float*)d_in[i];
    p.out = (float*)d_out; p.ws = (unsigned char*)d_ws;
#if MK_PER_PHASE
    for (int ph = 0; ph < NPH; ++ph) { p.ph_lo = ph; p.ph_hi = ph + 1; hipLaunchKernelGGL(fwd, dim3(grid), dim3(NTHR), LDS_BYTES, stream, p); }
#else
    p.ph_lo = 0; p.ph_hi = NPH; hipLaunchKernelGGL(fwd, dim3(grid), dim3(NTHR), LDS_BYTES, stream, p);
#endif
}
```

```cpp
#include <hip/hip_runtime.h>
#include <cstdio>
#include <cstdint>

#define LAS __attribute__((address_space(3)))
typedef unsigned short bf16_t;
typedef short bf16x8 __attribute__((ext_vector_type(8)));
typedef float f32x4 __attribute__((ext_vector_type(4)));
typedef unsigned u32x4 __attribute__((ext_vector_type(4)));

constexpr int D = 1024, NB = 8, SEQ = 2048, DEPTH = 4, CTXL = 256;
constexpr int NLAT = NB * SEQ, NCTX = NB * CTXL, NTOK = NLAT + NCTX;
constexpr int INC = 7936;
constexpr int ZP = 4864;
constexpr int C_NAQ = 0, C_NAK = 512, C_NAV = 1024, C_HQ = 1536, C_HFF = 2048, C_HFB = 2560, C_HI = 3072, C_HG = 3584,
              C_GQ = 4096, C_GK = 4608, C_GV = 4736, C_GATE = 4864;
constexpr int BRW = 1536;
constexpr int NEXP = 16, EH = 512;
constexpr int MPAD = 40960;
constexpr int NTHR = 512;
constexpr int LDS_BYTES = 151552;

constexpr size_t WS_BAR = 0;
constexpr size_t WS_CNT = 16384;
constexpr size_t WS_ZERO_BYTES = 65536;
constexpr size_t WS_MODS = 65536;
constexpr size_t WS_LB = WS_MODS + 884736;
constexpr size_t WS_ROPE = WS_LB + 16384;
constexpr size_t WS_SELE = WS_ROPE + 12288;
constexpr size_t WS_SELW = WS_SELE + 147456;
constexpr size_t WS_SELP = WS_SELW + 147456;
constexpr size_t WS_SROW = WS_SELP + 147456;
constexpr size_t WS_X = 2097152;
constexpr size_t WS_H = WS_X + (size_t)NTOK * D * 4;
constexpr size_t WS_Z = WS_H + (size_t)NTOK * D * 2;
constexpr size_t WS_GT = WS_Z + (size_t)NTOK * ZP * 2;
constexpr size_t WS_BR = WS_GT + (size_t)NTOK * 3072 * 2;
constexpr size_t WS_Y = WS_BR + (size_t)NTOK * BRW * 2;
constexpr size_t WS_QN = WS_Y + (size_t)NTOK * D * 2;
constexpr size_t WS_KN = WS_QN + (size_t)NTOK * 512 * 2;
constexpr size_t WS_VN = WS_KN + (size_t)NTOK * 128 * 2;
constexpr size_t WS_NAVT = WS_VN + (size_t)NTOK * 128 * 2;
constexpr size_t WS_WIN = WS_NAVT + (size_t)NTOK * 512 * 2;
constexpr size_t WS_WBR = WS_WIN + (size_t)INC * D * 2;
constexpr size_t WS_WOUT = WS_WBR + (size_t)3 * D * 512 * 2;
constexpr size_t WS_WGU = WS_WOUT + (size_t)D * D * 2;
constexpr size_t WS_WDN = WS_WGU + (size_t)NEXP * 1024 * 1024 * 2;
constexpr size_t WS_PG = WS_WDN + (size_t)NEXP * 1024 * 512 * 2;
constexpr size_t WS_INV = WS_PG + (size_t)96 * 65536 * 2;
constexpr size_t WS_END = WS_INV + (size_t)16 * NTOK * 4;
constexpr size_t WS_FS = WS_Z;
constexpr size_t WS_HS = WS_FS + (size_t)MPAD * 1024 * 2;
constexpr size_t WS_YS = WS_HS + (size_t)MPAD * 512 * 2;
static_assert(WS_YS + (size_t)MPAD * 1024 * 2 <= WS_BR, "moe alias");
constexpr size_t WS_RT = WS_SROW + 147456;
static_assert(WS_RT + 327680 <= WS_X, "ctl");

#define XB_TMO      128
#define XB_XCNT(j)  (256  + 64 * (j))
#define XB_XSUB(j)  (1280 + 64 * (j))
#define XB_XGEN(j)  (2304 + 64 * (j))
#define XB_TOP      3328
#define XB_TOPGEN   3392
#define XCD_BAR_WORDS 3456
#define XB_SPIN_CAP (1u << 22)
__device__ __forceinline__ unsigned xb_ld(unsigned* p)              { return __hip_atomic_load(p, __ATOMIC_RELAXED, __HIP_MEMORY_SCOPE_AGENT); }
__device__ __forceinline__ unsigned xb_add(unsigned* p, unsigned v) { return __hip_atomic_fetch_add(p, v, __ATOMIC_RELAXED, __HIP_MEMORY_SCOPE_AGENT); }
__device__ __forceinline__ unsigned xb_xcc_id() { return (unsigned)__builtin_amdgcn_s_getreg((3 << 11) | 20) & 0xFu; }
#define XB_SPIN(cond, bar) do { unsigned _sp = 0; while (cond) { __builtin_amdgcn_s_sleep(1); \
    if ((++_sp & 255u) == 0u) { if (xb_ld(&(bar)[XB_TMO])) break; if (_sp > XB_SPIN_CAP) { atomicAdd(&(bar)[XB_TMO], 1u); break; } } } } while (0)
struct XcdBarrier { unsigned* bar; unsigned x; volatile LAS unsigned* st; };
__device__ __forceinline__ XcdBarrier xcd_barrier_post(unsigned* bar, volatile LAS unsigned* st) {
    XcdBarrier b; b.bar = bar; b.x = xb_xcc_id(); b.st = st;
    if (threadIdx.x == 0) (void)xb_add(&bar[XB_XCNT(b.x)], 1u);
    return b;
}
__device__ __forceinline__ void xcd_barrier_complete(unsigned* bar, unsigned x, unsigned& nloc, unsigned& nx) {
    const unsigned G = gridDim.x * gridDim.y * gridDim.z;
    unsigned sum, cnt, mine, sp = 0u;
    for (;;) {
        sum = 0u; cnt = 0u; mine = 0u;
#pragma unroll
        for (unsigned j = 0; j < 16; ++j) { const unsigned c = xb_ld(&bar[XB_XCNT(j)]); sum += c; cnt += (c > 0u) ? 1u : 0u; mine = (j == x) ? c : mine; }
        if (sum == G) break;
        __builtin_amdgcn_s_sleep(1);
        if ((++sp & 255u) == 0u) { if (xb_ld(&bar[XB_TMO])) break; if (sp > XB_SPIN_CAP) { atomicAdd(&bar[XB_TMO], 1u); break; } }
    }
    nloc = mine > 0u ? mine : 1u; nx = cnt > 0u ? cnt : 1u;
}
__device__ __forceinline__ void xcd_barrier(const XcdBarrier& b) {
    asm volatile("s_waitcnt vmcnt(0)" ::: "memory");
    __syncthreads();
    if (threadIdx.x == 0) {
        unsigned* bar = b.bar;
        __builtin_amdgcn_s_waitcnt(0);
        unsigned nloc = b.st[0], nx = b.st[1];
        if (nloc == 0u) { xcd_barrier_complete(bar, b.x, nloc, nx); b.st[0] = nloc; b.st[1] = nx; }
        const unsigned old = xb_add(&bar[XB_XSUB(b.x)], 1u);
        const unsigned gen = old / nloc;
        if (old + 1u == (gen + 1u) * nloc) {
            __builtin_amdgcn_fence(__ATOMIC_RELEASE, "agent");
            asm volatile("s_waitcnt vmcnt(0)" ::: "memory");
            const unsigned og = xb_add(&bar[XB_TOP], 1u);
            const unsigned tg = og / nx;
            if (og + 1u == (tg + 1u) * nx) xb_add(&bar[XB_TOPGEN], 1u);
            else XB_SPIN(xb_ld(&bar[XB_TOPGEN]) == tg, bar);
            __builtin_amdgcn_fence(__ATOMIC_ACQUIRE, "agent");
            xb_add(&bar[XB_XGEN(b.x)], 1u);
            asm volatile("s_waitcnt vmcnt(0)" ::: "memory");
        } else {
            XB_SPIN(xb_ld(&bar[XB_XGEN(b.x)]) == gen, bar);
            __builtin_amdgcn_fence(__ATOMIC_ACQUIRE, "agent");
            asm volatile("s_waitcnt vmcnt(0)" ::: "memory");
        }
    }
    __syncthreads();
}

__device__ __forceinline__ float bf_lo(unsigned u) { return __uint_as_float(u << 16); }
__device__ __forceinline__ float bf_hi(unsigned u) { return __uint_as_float(u & 0xffff0000u); }
__device__ __forceinline__ float bf2f(bf16_t b) { return __uint_as_float(((unsigned)b) << 16); }
typedef float pkf32x2_t __attribute__((ext_vector_type(2))); typedef __bf16 pkbf16x2_t __attribute__((ext_vector_type(2)));
__device__ __forceinline__ unsigned pk_bf16(float lo, float hi) { pkf32x2_t v = {lo, hi}; pkbf16x2_t b = __builtin_convertvector(v, pkbf16x2_t); return __builtin_bit_cast(unsigned, b); }
__device__ __forceinline__ bf16x8 pack8(const float (&v)[8]) { u32x4 u = {pk_bf16(v[0], v[1]), pk_bf16(v[2], v[3]), pk_bf16(v[4], v[5]), pk_bf16(v[6], v[7])}; return __builtin_bit_cast(bf16x8, u); }
__device__ __forceinline__ float sigmoidf_(float x) { return __builtin_amdgcn_rcpf(1.0f + __expf(-x)); }
__device__ __forceinline__ float siluf_(float x) { return x * __builtin_amdgcn_rcpf(1.0f + __expf(-x)); }
__device__ __forceinline__ float dpp_f(float v, const int ctrl_sel) {
    const int x = __float_as_int(v);
    int r;
    if (ctrl_sel == 0) r = __builtin_amdgcn_update_dpp(0, x, 0xB1, 0xF, 0xF, true);
    else if (ctrl_sel == 1) r = __builtin_amdgcn_update_dpp(0, x, 0x4E, 0xF, 0xF, true);
    else if (ctrl_sel == 2) r = __builtin_amdgcn_update_dpp(0, x, 0x141, 0xF, 0xF, true);
    else r = __builtin_amdgcn_update_dpp(0, x, 0x140, 0xF, 0xF, true);
    return __int_as_float(r);
}
__device__ __forceinline__ float wave_sum(float v) {
    v += dpp_f(v, 0); v += dpp_f(v, 1); v += dpp_f(v, 2); v += dpp_f(v, 3);
    { auto rr = __builtin_amdgcn_permlane16_swap(__float_as_uint(v), __float_as_uint(v), false, false); v = __uint_as_float(rr[0]) + __uint_as_float(rr[1]); }
    { auto rr = __builtin_amdgcn_permlane32_swap(__float_as_uint(v), __float_as_uint(v), false, false); v = __uint_as_float(rr[0]) + __uint_as_float(rr[1]); }
    return v;
}

__device__ __forceinline__ int tid_() { int t = threadIdx.x; asm volatile("" : "+v"(t)); return t; }
__device__ __forceinline__ int bid_() { int t = blockIdx.x; asm volatile("" : "+s"(t)); return t; }
#ifndef REPEAT_MASK
#define REPEAT_MASK 0
#endif
#define NREP(j) (((REPEAT_MASK >> (j)) & 1) ? 2 : 1)
struct Params {
    const float* in[24];
    float* out;
    unsigned char* ws;
    int ph_lo, ph_hi;
};
enum { I_X = 0, I_C, I_CTX, I_CCTX, I_WADA, I_BADA, I_GMIX, I_GFFN, I_WIN, I_RPB, I_LBL, I_HGN, I_QNG, I_KNG, I_WBR, I_WOUT,
       I_WGR, I_BGR, I_WER, I_BER, I_WEG, I_WEU, I_WED, I_GFIN };

__device__ __forceinline__ void g128_kloop(f32x4 (&acc)[4][4], LAS unsigned char* lds, const bf16_t* A, int lda, const bf16_t* Bt, int ldb, int K) {
    const int tid = tid_(), wid = tid >> 6, lane = tid & 63, wr = wid >> 2, wc = wid & 3, fr = lane & 15, fq = lane >> 4;
    LAS unsigned char* SA = lds; LAS unsigned char* SB = lds + 8192;
    const int srow = tid >> 2, skc = (tid & 3) * 8;
    const bf16_t* ap = A + (size_t)srow * lda + skc;
    const bf16_t* bp0 = Bt + (size_t)srow * ldb + skc;
    const bf16_t* bp1 = Bt + (size_t)(srow + 128) * ldb + skc;
    for (int k0 = 0; k0 < K; k0 += 32) {
        const uint4 va = *(const uint4*)(ap + k0);
        const uint4 vb0 = *(const uint4*)(bp0 + k0);
        const uint4 vb1 = *(const uint4*)(bp1 + k0);
        __syncthreads();
        *(LAS u32x4*)(SA + tid * 16) = (u32x4){va.x, va.y, va.z, va.w};
        *(LAS u32x4*)(SB + tid * 16) = (u32x4){vb0.x, vb0.y, vb0.z, vb0.w};
        *(LAS u32x4*)(SB + 8192 + tid * 16) = (u32x4){vb1.x, vb1.y, vb1.z, vb1.w};
        __syncthreads();
        bf16x8 At[4], Bf[4];
#pragma unroll
        for (int m = 0; m < 4; ++m) At[m] = *(const LAS bf16x8*)(SA + ((wr * 64 + m * 16 + fr) * 32 + fq * 8) * 2);
#pragma unroll
        for (int n = 0; n < 4; ++n) Bf[n] = *(const LAS bf16x8*)(SB + ((wc * 64 + n * 16 + fr) * 32 + fq * 8) * 2);
#pragma unroll
        for (int m = 0; m < 4; ++m)
#pragma unroll
            for (int n = 0; n < 4; ++n) acc[m][n] = __builtin_amdgcn_mfma_f32_16x16x32_bf16(Bf[n], At[m], acc[m][n], 0, 0, 0);
    }
}
__device__ __forceinline__ void acc_zero(f32x4 (&acc)[4][4]) {
#pragma unroll
    for (int m = 0; m < 4; ++m)
#pragma unroll
        for (int n = 0; n < 4; ++n) acc[m][n] = (f32x4){0.f, 0.f, 0.f, 0.f};
}
template <class Epi>
__device__ __forceinline__ void g128_epilogue(const f32x4 (&acc)[4][4], int row0, int col0, const Epi& E) {
    const int tid = tid_(), wid = tid >> 6, lane = tid & 63, wr = wid >> 2, wc = wid & 3, fr = lane & 15, fq = lane >> 4;
#pragma unroll
    for (int m = 0; m < 4; ++m)
#pragma unroll
        for (int n = 0; n < 4; n += 2) E(row0 + wr * 64 + m * 16 + fr, col0 + wc * 64 + n * 16 + fq * 4, acc[m][n], acc[m][n + 1]);
}


namespace pg8 {
constexpr int BM = 256, BK = 64, HALF = 128, HTB = HALF * BK * 2, STAGE_BYTES = 8 * HTB;
__device__ __forceinline__ int lds_byte(int r, int c) { const int st = (r >> 4) * 2 + (c >> 5), rr = r & 15, cc = c & 31, ob = rr * 64 + cc * 2; return st * 1024 + (ob ^ (((ob >> 9) & 1) << 5)); }
__device__ __forceinline__ void stage_rc(int b, int& R, int& C) { const int st = b / 1024, sb = b % 1024, swz = sb ^ (((sb >> 9) & 1) << 5); R = (st >> 1) * 16 + swz / 64; C = (st & 1) * 32 + (swz % 64) / 2; }
struct Unit { int row0, col0, aux; const char* A; const char* B; };
struct Gemm { int K, lda, ldb; };
template <class Epi, class Sched, bool GATHER = false>
__device__ __forceinline__ void gemm_phase(LAS unsigned char* lds, const Gemm g, const Sched& S, const Epi& E) {
    const int tid = tid_(), wid = __builtin_amdgcn_readfirstlane(tid >> 6), lane = tid & 63, wr = wid >> 2, wc = wid & 3, fr = lane & 15, fq = lane >> 4;
    const int K = g.K, nt = K / BK;
    unsigned voffA[2], voffB[2];
#pragma unroll
    for (int i = 0; i < 2; ++i) { int R, C; stage_rc(tid * 16 + i * 8192, R, C);
        voffA[i] = (unsigned)(R * g.lda + C) * 2u; voffB[i] = (unsigned)(R * g.ldb + C) * 2u; }
    const size_t kstep = (size_t)(BK * 2);
    const size_t hstepA = (size_t)HALF * g.lda * 2, hstepB = (size_t)HALF * g.ldb * 2;
    const unsigned ldsw = (unsigned)wid * 1024u;
    const int aoff = lds_byte(wr * 64 + fr, fq * 8), boff = lds_byte(wc * 32 + fr, fq * 8);
#define PG8_SA(b, h) (((b) * 2 + (h)) * HTB)
#define PG8_SB(b, h) ((4 + (b) * 2 + (h)) * HTB)
#define PG8_STAGE(bufoff, gbase, voff) do { _Pragma("unroll") for (int _i = 0; _i < 2; ++_i) \
        __builtin_amdgcn_global_load_lds((const unsigned*)((const char*)(gbase) + (voff)[_i]), (LAS unsigned*)(lds + (bufoff) + ldsw + _i * 8192), 16, 0, 0); } while (0)
#define PG8_STAGE_A(b, h, ptr, nx) do { if constexpr (GATHER) { const unsigned gsel_[2] = {(nx) ? ngv[h][0] : cgv[h][0], (nx) ? ngv[h][1] : cgv[h][1]}; PG8_STAGE(PG8_SA(b, h), (ptr), gsel_); } \
        else { PG8_STAGE(PG8_SA(b, h), (ptr) + ((h) ? hstepA : 0), voffA); } } while (0)
#define PG8_LDA(dst, b, h) do { _Pragma("unroll") for (int m = 0; m < 4; ++m) _Pragma("unroll") for (int k = 0; k < 2; ++k) dst[m][k] = *(const LAS bf16x8*)(lds + PG8_SA(b, h) + aoff + m * 2048 + k * 1024); } while (0)
#define PG8_LDB(dst, b, h) do { _Pragma("unroll") for (int n = 0; n < 2; ++n) _Pragma("unroll") for (int k = 0; k < 2; ++k) dst[n][k] = *(const LAS bf16x8*)(lds + PG8_SB(b, h) + boff + n * 2048 + k * 1024); } while (0)
#define PG8_MMA(ai, bj, At, Bt) do { __builtin_amdgcn_s_setprio(1); _Pragma("unroll") for (int m = 0; m < 4; ++m) _Pragma("unroll") for (int n = 0; n < 2; ++n) _Pragma("unroll") for (int k = 0; k < 2; ++k) \
        acc[ai][bj][m][n] = __builtin_amdgcn_mfma_f32_16x16x32_bf16(Bt[n][k], At[m][k], acc[ai][bj][m][n], 0, 0, 0); __builtin_amdgcn_s_setprio(0); } while (0)
#define PG8_WAIT_V(n) asm volatile("s_waitcnt vmcnt(" #n ")" ::: "memory")
#define PG8_WAIT_L(n) asm volatile("s_waitcnt lgkmcnt(" #n ")" ::: "memory")
#define PG8_BAR __builtin_amdgcn_s_barrier()
#define PG8_SCHED __builtin_amdgcn_sched_barrier(0)
    Unit cur, nxt; int ui = 0;
    if (!S.next(0, cur)) return;
    f32x4 acc[2][2][4][2];
#pragma unroll
    for (int a = 0; a < 2; ++a)
#pragma unroll
        for (int b = 0; b < 2; ++b)
#pragma unroll
            for (int m = 0; m < 4; ++m)
#pragma unroll
                for (int n = 0; n < 2; ++n) acc[a][b][m][n] = (f32x4){0.f, 0.f, 0.f, 0.f};
    bf16x8 At[4][2], B0[2][2], B1[2][2];
    const char* cA = cur.A; const char* cB = cur.B;
    unsigned cgv[2][2] = {{0u, 0u}, {0u, 0u}}, ngv[2][2] = {{0u, 0u}, {0u, 0u}};
    if constexpr (GATHER) S.gather(cur, cgv);
    PG8_STAGE(PG8_SB(0, 0), cB, voffB); PG8_STAGE(PG8_SB(0, 1), cB + hstepB, voffB); PG8_STAGE_A(0, 0, cA, false); PG8_STAGE_A(0, 1, cA, false);
    if (wr == 1) PG8_BAR;
    PG8_WAIT_V(2); PG8_BAR;
    PG8_STAGE(PG8_SB(1, 0), cB + kstep, voffB); PG8_STAGE_A(1, 0, cA + kstep, false); PG8_STAGE(PG8_SB(1, 1), cB + hstepB + kstep, voffB);
    PG8_WAIT_V(6); PG8_BAR;
    for (;;) {
        const bool has_next = S.next(ui + 1, nxt);
        const char* nA = has_next ? nxt.A : cA; const char* nB = has_next ? nxt.B : cB;
        if constexpr (GATHER) {
            if (has_next) S.gather(nxt, ngv);
            else {
#pragma unroll
                for (int h_ = 0; h_ < 2; ++h_)
#pragma unroll
                    for (int i_ = 0; i_ < 2; ++i_) ngv[h_][i_] = cgv[h_][i_]; } }
        for (int t = 0; t < nt; t += 2) {
            const bool last = (t == nt - 2);
            const char* a1 = cA + (size_t)(t + 1) * kstep;
            const char* a2 = last ? nA : cA + (size_t)(t + 2) * kstep; const char* b2 = last ? nB : cB + (size_t)(t + 2) * kstep;
            const char* a3 = a2 + kstep; const char* b3 = b2 + kstep;
            PG8_LDB(B0, 0, 0); PG8_LDB(B1, 0, 1); PG8_SCHED; PG8_LDA(At, 0, 0); PG8_STAGE_A(1, 1, a1, false);
            PG8_WAIT_V(8); PG8_WAIT_L(0); PG8_BAR; PG8_MMA(0, 0, At, B0); PG8_MMA(0, 1, At, B1); PG8_BAR; PG8_SCHED;
            PG8_LDA(At, 0, 1); PG8_STAGE(PG8_SB(0, 0), b2, voffB); PG8_STAGE(PG8_SB(0, 1), b2 + hstepB, voffB); PG8_STAGE_A(0, 0, a2, last);
            PG8_WAIT_V(8); PG8_WAIT_L(0); PG8_BAR; PG8_MMA(1, 0, At, B0); PG8_MMA(1, 1, At, B1); PG8_BAR; PG8_SCHED;
            PG8_LDB(B0, 1, 0); PG8_LDB(B1, 1, 1); PG8_SCHED; PG8_LDA(At, 1, 0); PG8_STAGE_A(0, 1, a2, last);
            PG8_WAIT_V(8); PG8_WAIT_L(0); PG8_BAR; PG8_MMA(0, 0, At, B0); PG8_MMA(0, 1, At, B1); PG8_BAR; PG8_SCHED;
            PG8_LDA(At, 1, 1); PG8_STAGE(PG8_SB(1, 0), b3, voffB); PG8_STAGE(PG8_SB(1, 1), b3 + hstepB, voffB); PG8_STAGE_A(1, 0, a3, last);
            PG8_WAIT_V(8); PG8_WAIT_L(0); PG8_BAR; PG8_MMA(1, 0, At, B0); PG8_MMA(1, 1, At, B1); PG8_BAR; PG8_SCHED;
        }
        if (wr == 0) PG8_BAR;
        E(acc, cur, wr, wc, fr, fq);
        if (!has_next) break;
#pragma unroll
        for (int a = 0; a < 2; ++a)
#pragma unroll
            for (int b = 0; b < 2; ++b)
#pragma unroll
                for (int m = 0; m < 4; ++m)
#pragma unroll
                    for (int n = 0; n < 2; ++n) acc[a][b][m][n] = (f32x4){0.f, 0.f, 0.f, 0.f};
        cur = nxt; cA = nA; cB = nB; ++ui;
        if constexpr (GATHER) {
#pragma unroll
            for (int h_ = 0; h_ < 2; ++h_)
#pragma unroll
                for (int i_ = 0; i_ < 2; ++i_) cgv[h_][i_] = ngv[h_][i_]; }
        if (wr == 1) PG8_BAR;
    }
    PG8_WAIT_V(0);
    PG8_BAR;
#undef PG8_SA
#undef PG8_SB
#undef PG8_STAGE
#undef PG8_STAGE_A
#undef PG8_LDA
#undef PG8_LDB
#undef PG8_MMA
#undef PG8_WAIT_V
#undef PG8_WAIT_L
#undef PG8_BAR
#undef PG8_SCHED
}
template <class F> struct EpiPair { F f;
    __device__ __forceinline__ void operator()(const f32x4 (&acc)[2][2][4][2], const Unit& u, int wr, int wc, int fr, int fq) const {
#pragma unroll
        for (int ai = 0; ai < 2; ++ai)
#pragma unroll
            for (int m = 0; m < 4; ++m)
#pragma unroll
                for (int bj = 0; bj < 2; ++bj) f(u, u.row0 + ai * HALF + wr * 64 + m * 16 + fr, u.col0 + bj * HALF + wc * 32 + 4 * fq, acc[ai][bj][m][0], acc[ai][bj][m][1]);
    } };
struct SchedDense { int nM, nN, G, c; const char* A; const char* B; size_t tA, tB;
    __device__ __forceinline__ bool next(int i, Unit& u) const {
        const int nwg = nM * nN; const long L = (long)i * G + c; if (L >= nwg) return false;
        int wgid = (int)L; { const int q = nwg / 8, r = nwg % 8, xcd = wgid % 8, off = wgid / 8; wgid = (xcd < r ? xcd * (q + 1) : r * (q + 1) + (xcd - r) * q) + off; }
        const int nig = 8 * nN, gid = wgid / nig, fm = gid * 8, gsz = (nM - fm) < 8 ? (nM - fm) : 8;
        const int pm = fm + ((wgid % nig) % gsz), pn = (wgid % nig) / gsz;
        u.row0 = pm * 256; u.col0 = pn * 256; u.aux = 0; u.A = A + (size_t)pm * tA; u.B = B + (size_t)pn * tB; return true; } };
}


namespace gqa {
using f32x16 = __attribute__((ext_vector_type(16))) float;
using s16x4 = __attribute__((ext_vector_type(4))) short;
constexpr int QP = 512, KVP = 128, OP = BRW;
constexpr int NW = 8, QBLK = 32, KVBLK = 64;
__device__ __forceinline__ int crow(int r, int hi) { return (r & 3) + 8 * (r >> 2) + 4 * hi; }
#define SBAR() __builtin_amdgcn_sched_barrier(0)
constexpr int NSLOT = 3, SLOTB = 8192;
constexpr int LDS_K = 0, LDS_V = NSLOT * SLOTB, LDS_WS = 2 * NSLOT * SLOTB, LDS_OST = LDS_WS + NW * 64 * 4, LDS_BYTES_ = LDS_OST + NW * 4096;
__device__ __forceinline__ void glds16(const void* gsrc, unsigned lds_dst) { unsigned keep;
  asm volatile("s_mov_b32 %0, m0\n\ts_mov_b32 m0, %2\n\ts_nop 0\n\tglobal_load_lds_dwordx4 %1, off\n\ts_mov_b32 m0, %0" : "=&s"(keep) : "v"(gsrc), "s"(lds_dst) : "memory"); }
__device__ __forceinline__ float max3f(float a, float b, float c) { float r; asm("v_max3_f32 %0, %1, %2, %3" : "=v"(r) : "v"(a), "v"(b), "v"(c)); return r; }
__device__ __forceinline__ float max2f(float a, float b) { float r; asm("v_max_f32_e32 %0, %1, %2" : "=v"(r) : "v"(a), "v"(b)); return r; }
__device__ __forceinline__ float fadd_s(float a, float b) { float r; asm("v_add_f32_e32 %0, %1, %2" : "=v"(r) : "v"(a), "v"(b)); return r; }
__device__ __forceinline__ float fsub_s(float a, float b) { float r; asm("v_sub_f32_e32 %0, %1, %2" : "=v"(r) : "v"(a), "v"(b)); return r; }
typedef float f32x2_t __attribute__((ext_vector_type(2))); typedef __bf16 bf16x2_t __attribute__((ext_vector_type(2)));
__device__ __forceinline__ unsigned cvtpk_s(float lo, float hi) { f32x2_t v = {lo, hi}; bf16x2_t b = __builtin_convertvector(v, bf16x2_t); return __builtin_bit_cast(unsigned, b); }
#define WAIT_BAR(N) asm volatile("s_waitcnt vmcnt(" #N ") lgkmcnt(0)\n\ts_barrier" ::: "memory")
__device__ __forceinline__ void qkt(f32x16& p0, f32x16& p1, const char* Kslot, const bf16x8* qr, const f32x16& negm, int r32, int hi) {
  const char* kb = Kslot + hi * 1024 + r32 * 16;
  #pragma unroll
  for (int d0 = 0; d0 < 4; ++d0) {
    const bf16x8 b0 = *reinterpret_cast<const bf16x8*>(kb + d0 * 2048);
    const bf16x8 b1 = *reinterpret_cast<const bf16x8*>(kb + d0 * 2048 + 512);
    if (d0 == 0) { p0 = __builtin_amdgcn_mfma_f32_32x32x16_bf16(b0, qr[0], negm, 0, 0, 0); p1 = __builtin_amdgcn_mfma_f32_32x32x16_bf16(b1, qr[0], negm, 0, 0, 0); }
    else { p0 = __builtin_amdgcn_mfma_f32_32x32x16_bf16(b0, qr[d0], p0, 0, 0, 0); p1 = __builtin_amdgcn_mfma_f32_32x32x16_bf16(b1, qr[d0], p1, 0, 0, 0); } }
}
typedef __attribute__((address_space(3))) const char* lds_cptr;
typedef short v4i16_t __attribute__((ext_vector_type(4)));
__device__ __forceinline__ void kload8(bf16x8* kf, lds_cptr kp) {
  kf[0] = *(const LAS bf16x8*)(kp);        kf[1] = *(const LAS bf16x8*)(kp + 512);
  kf[2] = *(const LAS bf16x8*)(kp + 2048); kf[3] = *(const LAS bf16x8*)(kp + 2560);
  kf[4] = *(const LAS bf16x8*)(kp + 4096); kf[5] = *(const LAS bf16x8*)(kp + 4608);
  kf[6] = *(const LAS bf16x8*)(kp + 6144); kf[7] = *(const LAS bf16x8*)(kp + 6656);
}
__device__ __forceinline__ void kload2(bf16x8* kf, lds_cptr kp, int j) { kf[2 * j] = *(const LAS bf16x8*)(kp + j * 2048); kf[2 * j + 1] = *(const LAS bf16x8*)(kp + j * 2048 + 512); }
__device__ __forceinline__ s16x4 vtr(lds_cptr p) { return __builtin_bit_cast(s16x4, __builtin_amdgcn_ds_read_tr16_b64_v4i16((LAS v4i16_t*)p)); }
__device__ __forceinline__ float rowmax(const f32x16& p0, const f32x16& p1) {
  float a = max3f(p0[0], p0[1], p1[0]), b = max3f(p0[2], p0[3], p1[1]); a = max3f(a, p1[2], p1[3]);
  #pragma unroll
  for (int r = 4; r < 16; r += 4) { a = max3f(a, p0[r], p0[r + 1]); b = max3f(b, p0[r + 2], p0[r + 3]); a = max3f(a, p1[r], p1[r + 1]); b = max3f(b, p1[r + 2], p1[r + 3]); }
  const float m = max2f(a, b);
  auto rr = __builtin_amdgcn_permlane32_swap(__float_as_uint(m), __float_as_uint(m), false, false);
  return max2f(__uint_as_float(rr[0]), __uint_as_float(rr[1]));
}
__device__ __forceinline__ void pv(f32x16* o, int vb, bf16x8 pa0, bf16x8 pa1, bf16x8 pa2, bf16x8 pa3) {
  #pragma unroll
  for (int d0 = 0; d0 < 2; ++d0) { s16x4 lo[4], hi[4];
    #pragma unroll
    for (int ks = 0; ks < 4; ++ks) {
      asm volatile("ds_read_b64_tr_b16 %0,%1 offset:%c2" : "=&v"(lo[ks]) : "v"(vb), "i"(d0 * 4096 + ks * 1024) : "memory");
      asm volatile("ds_read_b64_tr_b16 %0,%1 offset:%c2" : "=&v"(hi[ks]) : "v"(vb), "i"(d0 * 4096 + ks * 1024 + 512) : "memory"); }
    asm volatile("s_waitcnt lgkmcnt(0)" ::: "memory"); SBAR();
    #define PK(k) (bf16x8){lo[k][0], lo[k][1], lo[k][2], lo[k][3], hi[k][0], hi[k][1], hi[k][2], hi[k][3]}
    o[d0] = __builtin_amdgcn_mfma_f32_32x32x16_bf16(pa0, PK(0), o[d0], 0, 0, 0);
    o[d0] = __builtin_amdgcn_mfma_f32_32x32x16_bf16(pa1, PK(1), o[d0], 0, 0, 0);
    o[d0] = __builtin_amdgcn_mfma_f32_32x32x16_bf16(pa2, PK(2), o[d0], 0, 0, 0);
    o[d0] = __builtin_amdgcn_mfma_f32_32x32x16_bf16(pa3, PK(3), o[d0], 0, 0, 0);
    #undef PK
  }
}
template <int THRL> __device__ __forceinline__ void attn_unit(const bf16_t* Qu, const float* qgain, const float* rope, const int tok0, const bf16_t* __restrict__ Kh, const bf16_t* __restrict__ Vh, bf16_t* Ou, const int NT, char* shm) {
  const int tid = tid_(), lane = tid & 63, r32 = lane & 31, hi = lane >> 5; const int wid = __builtin_amdgcn_readfirstlane(tid >> 6);
  const bf16_t* Qw = Qu + (long)wid * QBLK * ZP;
  const unsigned lds0 = (unsigned)(uintptr_t)shm;
  float* wsf = (float*)(shm + LDS_WS) + wid * 64;
  const bf16_t* ksrc = Kh + (long)lane * KVP + wid * 8;
  const bf16_t* vsrc = Vh + (long)(16 * (wid & 3) + (lane >> 2)) * KVP + (wid >> 2) * 32 + (lane & 3) * 8;
  const unsigned kdst = lds0 + LDS_K + wid * 1024, vdst = lds0 + LDS_V + wid * 1024;
  #define DMA_K(t, slot) glds16(ksrc + (long)(t) * KVBLK * KVP, (unsigned)__builtin_amdgcn_readfirstlane(kdst + (slot)))
  #define DMA_V(t, slot) glds16(vsrc + (long)(t) * KVBLK * KVP, (unsigned)__builtin_amdgcn_readfirstlane(vdst + (slot)))
  const int vb0 = (int)(lds0 + LDS_V) + ((lane >> 4) & 1) * 32 + (lane & 3) * 8 + (4 * hi + ((lane & 15) >> 2)) * 64;
  const char* Kbase = shm + LDS_K; bf16x8 kf[8];
  const lds_cptr shm3 = (lds_cptr)shm; const lds_cptr kp0 = shm3 + LDS_K + hi * 1024 + r32 * 16; const lds_cptr vp0 = shm3 + LDS_V + ((lane >> 4) & 1) * 32 + (lane & 3) * 8 + (4 * hi + ((lane & 15) >> 2)) * 64;
  DMA_K(0, 0); DMA_V(0, 0); DMA_K(1, SLOTB);
  bf16x8 qr[4];
  { float xq[4][8]; float ss = 0.f;
    #pragma unroll
    for (int d0 = 0; d0 < 4; ++d0) { const uint4 rw = *reinterpret_cast<const uint4*>(&Qw[(long)r32 * ZP + d0 * 16 + hi * 8]);
      xq[d0][0] = bf_lo(rw.x); xq[d0][1] = bf_hi(rw.x); xq[d0][2] = bf_lo(rw.y); xq[d0][3] = bf_hi(rw.y); xq[d0][4] = bf_lo(rw.z); xq[d0][5] = bf_hi(rw.z); xq[d0][6] = bf_lo(rw.w); xq[d0][7] = bf_hi(rw.w);
      #pragma unroll
      for (int j = 0; j < 8; ++j) ss += xq[d0][j] * xq[d0][j]; }
    { auto rr = __builtin_amdgcn_permlane32_swap(__float_as_uint(ss), __float_as_uint(ss), false, false); ss = __uint_as_float(rr[0]) + __uint_as_float(rr[1]); }
    const float rstd = __builtin_amdgcn_rsqf(ss * (1.0f / 64.0f) + 1e-6f) * (0.125f * 1.4426950408889634f);
    #pragma unroll
    for (int d0 = 0; d0 < 4; ++d0) { const f32x4 g0 = *(const f32x4*)(qgain + d0 * 16 + hi * 8), g1 = *(const f32x4*)(qgain + d0 * 16 + hi * 8 + 4);
      #pragma unroll
      for (int j = 0; j < 4; ++j) { xq[d0][j] *= rstd * g0[j]; xq[d0][4 + j] *= rstd * g1[j]; } }
    if (tok0 >= 0) { const int t = tok0 + wid * QBLK + r32, pr = t >> 6, pc = t & 63;
      #pragma unroll
      for (int hf = 0; hf < 2; ++hf) {
        const float* ct = rope + (hf ? (1024 + pc * 16) : (pr * 16)) + hi * 8; const float* st = ct + (hf ? 1024 : 512);
        const f32x4 c0 = *(const f32x4*)ct, c1 = *(const f32x4*)(ct + 4), s0 = *(const f32x4*)st, s1 = *(const f32x4*)(st + 4);
        #pragma unroll
        for (int j = 0; j < 8; ++j) { const float cs = j < 4 ? c0[j] : c1[j - 4], sn = j < 4 ? s0[j] : s1[j - 4];
          const float x1 = xq[2 * hf][j], x2 = xq[2 * hf + 1][j];
          xq[2 * hf][j] = x1 * cs - x2 * sn; xq[2 * hf + 1][j] = x2 * cs + x1 * sn; } } }
    #pragma unroll
    for (int d0 = 0; d0 < 4; ++d0) qr[d0] = pack8(xq[d0]); }
  float mhat = 0.f, l_reg = 0.f; f32x16 o[2]; o[0] = f32x16{}; o[1] = f32x16{}; f32x16 negm = f32x16{}; asm volatile("" : "+v"(negm));
  bool resc = false;
  #define START(P0, P1) do { const float rm = rowmax(P0, P1); resc = false; \
    { const float dl = rm; mhat = fadd_s(mhat, dl); \
      _Pragma("unroll") for (int r = 0; r < 16; ++r) { P0[r] = fsub_s(P0[r], dl); P1[r] = fsub_s(P1[r], dl); } \
      _Pragma("unroll") for (int r = 0; r < 16; ++r) negm[r] = -mhat; asm volatile("" : "+v"(negm)); } \
    _Pragma("unroll") for (int r = 0; r < 16; ++r) P0[r] = __builtin_amdgcn_exp2f(P0[r]); } while (0)
  #define RESC() do { if (resc) { asm volatile("s_waitcnt lgkmcnt(0)" ::: "memory"); \
      _Pragma("unroll") for (int d_ = 0; d_ < 2; ++d_) _Pragma("unroll") for (int r = 0; r < 16; ++r) o[d_][r] *= wsf[crow(r, hi)]; } } while (0)
  f32x16 pA0, pA1, pB0, pB1;
  int sl_prev = 0, sl_cur = 0, sl_next = SLOTB;
  #define ROT() do { sl_prev = sl_cur; sl_cur = sl_next; sl_next = (sl_next == (NSLOT - 1) * SLOTB) ? 0 : sl_next + SLOTB; } while (0)
  DMA_K(2, 2 * SLOTB);
  WAIT_BAR(3);
  qkt(pA0, pA1, Kbase, qr, negm, r32, hi); asm volatile("s_nop 15\n\ts_nop 7" : "+v"(pA0), "+v"(pA1));
  START(pA0, pA1);
  _Pragma("unroll") for (int r = 0; r < 16; ++r) pA1[r] = __builtin_amdgcn_exp2f(pA1[r]);
  WAIT_BAR(0);
  DMA_K(3, 0); DMA_V(1, SLOTB);
  ROT();
  kload8(kf, kp0 + sl_cur);
  WAIT_BAR(2);
  s16x4 vlo[8], vhi[8]; u32x4 pw0, pw1, pw2, pw3;
  #define PKW(P, B) cvtpk_s(P[B], P[B + 1])
  #define PAF(k) __builtin_bit_cast(bf16x8, pw##k)
  #define VFR(i) (bf16x8){vlo[i][0], vlo[i][1], vlo[i][2], vlo[i][3], vhi[i][0], vhi[i][1], vhi[i][2], vhi[i][3]}
  #define PIN(x) asm volatile("" : "+v"(x))
  #define MX3(a, b, c) __builtin_fmaxf(__builtin_fmaxf((a), (b)), (c))
  #define GAPA(MF, A0, A1, A2, A3, W0, W1, PW) do { MF; sacc += A0; sacc += A1; sacc += A2; sacc += A3; PIN(sacc); W0; W1; PIN(PW); SBAR(); } while (0)
  #define EX(v) __builtin_amdgcn_exp2f(v)
  #define GAPB(MF, X, B) do { MF; X[B] = EX(X[B]); X[B + 1] = EX(X[B + 1]); X[B + 2] = EX(X[B + 2]); X[B + 3] = EX(X[B + 3]); PIN(X); SBAR(); } while (0)
  #define VRD(i) do { vlo[i] = vtr(vp_ + (((i) >> 2) * 4096 + ((i) & 3) * 1024)); vhi[i] = vtr(vp_ + (((i) >> 2) * 4096 + ((i) & 3) * 1024 + 512)); } while (0)
  #define KRD(G, j) do { if (G) { kload2(kf, kp0 + sl_next, j); SBAR(); } } while (0)
  #define STEP(C0, C1, P0, P1, t, GK, GV, GL) do { SBAR(); \
    const lds_cptr vp_ = vp0 + sl_prev; \
    VRD(0); SBAR(); float sacc = (P0[0] + P0[1]); \
    GAPA(C0 = __builtin_amdgcn_mfma_f32_32x32x16_bf16(kf[0], qr[0], negm, 0, 0, 0), P0[2], P0[3], P0[4], P0[5],     pw0[0] = PKW(P0, 0), pw0[1] = PKW(P0, 2), pw0); \
    VRD(4); SBAR(); GAPA(C1 = __builtin_amdgcn_mfma_f32_32x32x16_bf16(kf[1], qr[0], negm, 0, 0, 0), P0[6], P0[7], P0[8], P0[9],     pw0[2] = PKW(P0, 4), pw0[3] = PKW(P0, 6), pw0); \
    VRD(1); SBAR(); GAPA(C0 = __builtin_amdgcn_mfma_f32_32x32x16_bf16(kf[2], qr[1], C0, 0, 0, 0),   P0[10], P0[11], P0[12], P0[13], pw1[0] = PKW(P0, 8), pw1[1] = PKW(P0, 10), pw1); \
    VRD(5); SBAR(); GAPA(C1 = __builtin_amdgcn_mfma_f32_32x32x16_bf16(kf[3], qr[1], C1, 0, 0, 0),   P0[14], P0[15], P1[0], P1[1],   pw1[2] = PKW(P0, 12), pw1[3] = PKW(P0, 14), pw1); \
    VRD(2); SBAR(); GAPA(C0 = __builtin_amdgcn_mfma_f32_32x32x16_bf16(kf[4], qr[2], C0, 0, 0, 0),   P1[2], P1[3], P1[4], P1[5],     pw2[0] = PKW(P1, 0), pw2[1] = PKW(P1, 2), pw2); \
    VRD(6); SBAR(); GAPA(C1 = __builtin_amdgcn_mfma_f32_32x32x16_bf16(kf[5], qr[2], C1, 0, 0, 0),   P1[6], P1[7], P1[8], P1[9],     pw2[2] = PKW(P1, 4), pw2[3] = PKW(P1, 6), pw2); \
    VRD(3); SBAR(); GAPA(C0 = __builtin_amdgcn_mfma_f32_32x32x16_bf16(kf[6], qr[3], C0, 0, 0, 0),   P1[10], P1[11], P1[12], P1[13], pw3[0] = PKW(P1, 8), pw3[1] = PKW(P1, 10), pw3); \
    VRD(7); SBAR(); GAPA(C1 = __builtin_amdgcn_mfma_f32_32x32x16_bf16(kf[7], qr[3], C1, 0, 0, 0),   P1[14], P1[15], 0.f, 0.f,       pw3[2] = PKW(P1, 12), pw3[3] = PKW(P1, 14), pw3); \
    l_reg += sacc; \
    if (GK) { DMA_K((t) + 3, sl_cur); } if (GV) { DMA_V((t) + 1, sl_next); } \
    { float a = MX3(C0[0], C0[1], C1[0]), b = MX3(C0[2], C0[3], C1[1]); a = MX3(a, C1[2], C1[3]); \
      _Pragma("unroll") for (int r = 4; r < 16; r += 4) { a = MX3(a, C0[r], C0[r + 1]); b = MX3(b, C0[r + 2], C0[r + 3]); a = MX3(a, C1[r], C1[r + 1]); b = MX3(b, C1[r + 2], C1[r + 3]); } \
      float rm = __builtin_fmaxf(a, b); { auto rr = __builtin_amdgcn_permlane32_swap(__float_as_uint(rm), __float_as_uint(rm), false, false); rm = __builtin_fmaxf(__uint_as_float(rr[0]), __uint_as_float(rr[1])); } \
      resc = false; \
      if (__builtin_expect(__any(rm > (float)THRL), 0)) { const float dl = __builtin_fmaxf(rm, 0.f); mhat += dl; \
        _Pragma("unroll") for (int r = 0; r < 16; ++r) { C0[r] -= dl; C1[r] -= dl; } \
        _Pragma("unroll") for (int r = 0; r < 16; ++r) negm[r] = -mhat; asm volatile("" : "+v"(negm)); \
        const float f = __builtin_amdgcn_exp2f(-dl); l_reg *= f; if (hi == 0) wsf[r32] = f; resc = true; } } \
    SBAR(); \
    GAPB(o[0] = __builtin_amdgcn_mfma_f32_32x32x16_bf16(PAF(0), VFR(0), o[0], 0, 0, 0), C0, 0); \
    GAPB(o[1] = __builtin_amdgcn_mfma_f32_32x32x16_bf16(PAF(0), VFR(4), o[1], 0, 0, 0), C0, 4); \
    KRD(GL, 0); GAPB(o[0] = __builtin_amdgcn_mfma_f32_32x32x16_bf16(PAF(1), VFR(1), o[0], 0, 0, 0), C0, 8); \
    KRD(GL, 1); GAPB(o[1] = __builtin_amdgcn_mfma_f32_32x32x16_bf16(PAF(1), VFR(5), o[1], 0, 0, 0), C0, 12); \
    KRD(GL, 2); GAPB(o[0] = __builtin_amdgcn_mfma_f32_32x32x16_bf16(PAF(2), VFR(2), o[0], 0, 0, 0), C1, 0); \
    KRD(GL, 3); GAPB(o[1] = __builtin_amdgcn_mfma_f32_32x32x16_bf16(PAF(2), VFR(6), o[1], 0, 0, 0), C1, 4); \
    GAPB(o[0] = __builtin_amdgcn_mfma_f32_32x32x16_bf16(PAF(3), VFR(3), o[0], 0, 0, 0), C1, 8); \
    GAPB(o[1] = __builtin_amdgcn_mfma_f32_32x32x16_bf16(PAF(3), VFR(7), o[1], 0, 0, 0), C1, 12); \
    } while (0)
  int t = 1;
  for (; t + 5 < NT; t += 2) {
    STEP(pB0, pB1, pA0, pA1, t, true, true, true);     WAIT_BAR(2); RESC(); ROT();
    STEP(pA0, pA1, pB0, pB1, t + 1, true, true, true); WAIT_BAR(2); RESC(); ROT();
  }
  #define ENDW(tt) do { if ((tt) + 3 < NT) { WAIT_BAR(2); } else if ((tt) + 2 < NT) { WAIT_BAR(1); } else { WAIT_BAR(0); } } while (0)
  for (; t + 1 < NT; t += 2) {
    STEP(pB0, pB1, pA0, pA1, t, (t + 3 < NT), (t + 1 < NT), (t + 1 < NT));         ENDW(t);     RESC(); ROT();
    STEP(pA0, pA1, pB0, pB1, t + 1, (t + 4 < NT), (t + 2 < NT), (t + 2 < NT));     ENDW(t + 1); RESC(); ROT();
  }
  STEP(pB0, pB1, pA0, pA1, NT - 1, false, false, false); RESC();
  { float sacc = pB0[0] + pB0[1]; _Pragma("unroll") for (int r = 2; r < 16; ++r) sacc += pB0[r]; _Pragma("unroll") for (int r = 0; r < 16; ++r) sacc += pB1[r]; l_reg += sacc;
    pw0 = (u32x4){PKW(pB0, 0), PKW(pB0, 2), PKW(pB0, 4), PKW(pB0, 6)}; pw1 = (u32x4){PKW(pB0, 8), PKW(pB0, 10), PKW(pB0, 12), PKW(pB0, 14)}; pw2 = (u32x4){PKW(pB1, 0), PKW(pB1, 2), PKW(pB1, 4), PKW(pB1, 6)}; pw3 = (u32x4){PKW(pB1, 8), PKW(pB1, 10), PKW(pB1, 12), PKW(pB1, 14)};
    SBAR(); pv(o, vb0 + sl_cur, PAF(0), PAF(1), PAF(2), PAF(3)); }
  #undef PKW
  #undef PAF
  #undef VFR
  #undef PIN
  #undef MX3
  #undef GAPA
  #undef GAPB
  #undef EX
  #undef VRD
  #undef KRD
  #undef STEP
  #undef ENDW
  { auto rr = __builtin_amdgcn_permlane32_swap(__float_as_uint(l_reg), __float_as_uint(l_reg), false, false); l_reg = __uint_as_float(rr[0]) + __uint_as_float(rr[1]); }
  if (hi == 0) wsf[32 + r32] = l_reg; asm volatile("s_waitcnt lgkmcnt(0)" ::: "memory");
  float rli[16];
  #pragma unroll
  for (int r = 0; r < 16; ++r) rli[r] = __builtin_amdgcn_rcpf(wsf[32 + crow(r, hi)]);
  bf16_t* Ow = Ou + (long)wid * QBLK * OP;
  { bf16_t* stg = (bf16_t*)(shm + LDS_OST) + wid * 2048;
    #pragma unroll
    for (int r = 0; r < 16; ++r) { const int orow = crow(r, hi);
      #pragma unroll
      for (int d0 = 0; d0 < 2; ++d0) stg[orow * 64 + d0 * 32 + r32] = (bf16_t)(cvtpk_s(o[d0][r] * rli[r], 0.f) & 0xffffu); }
    asm volatile("s_waitcnt lgkmcnt(0)" ::: "memory");
    #pragma unroll
    for (int i = 0; i < 4; ++i) { const int row = i * 8 + (lane >> 3), ch = lane & 7; const u32x4 v = *(const u32x4*)(stg + row * 64 + ch * 8); *(u32x4*)(Ow + (long)row * OP + ch * 8) = v; } }
  asm volatile("s_waitcnt lgkmcnt(0)\n\ts_barrier" ::: "memory");
  #undef DMA_K
  #undef DMA_V
  #undef START
  #undef RESC
  #undef ROT
}
#undef SBAR
#undef WAIT_BAR
}

__device__ __forceinline__ void ph_prologue(const Params& P, LAS unsigned char* lds) {
    const int tid = tid_(), bid = bid_(), G = gridDim.x, lane = tid & 63, wid = tid >> 6;
    float* mods = (float*)(P.ws + WS_MODS);
    LAS float* sc = (LAS float*)lds;
    LAS float* red = sc + 9 * 1024;
    for (int i = tid; i < 9 * 1024; i += NTHR) { const float v = (i < 8192) ? P.in[I_C][i] : P.in[I_CCTX][i - 8192]; sc[i] = siluf_(v); }
    __syncthreads();
    {
        const bool act = lane < 48;
        for (int u = bid; u < 4 * 64; u += G) {
            const int l = u >> 6, cg = u & 63;
            const float* w = P.in[I_WADA] + (size_t)l * 1024 * 6144 + cg * 96 + 2 * (act ? lane : 0) + (size_t)(wid * 128) * 6144;
            float a0[9], a1[9];
#pragma unroll
            for (int r = 0; r < 9; ++r) { a0[r] = 0.f; a1[r] = 0.f; }
            float2 wn[8];
#pragma unroll
            for (int j = 0; j < 8; ++j) wn[j] = *(const float2*)(w + (size_t)j * 6144);
#pragma unroll 1
            for (int kb = 0; kb < 128; kb += 8) {
                float2 wv[8];
#pragma unroll
                for (int j = 0; j < 8; ++j) wv[j] = wn[j];
                const float* wk = w + (size_t)((kb + 8 < 128) ? kb + 8 : kb) * 6144;
#pragma unroll
                for (int j = 0; j < 8; ++j) wn[j] = *(const float2*)(wk + (size_t)j * 6144);
#pragma unroll
                for (int j4 = 0; j4 < 2; ++j4)
#pragma unroll
                    for (int r = 0; r < 9; ++r) { const f32x4 s4 = *(const LAS f32x4*)(sc + r * 1024 + wid * 128 + kb + 4 * j4);
                        a0[r] += s4[0] * wv[4 * j4].x + s4[1] * wv[4 * j4 + 1].x + s4[2] * wv[4 * j4 + 2].x + s4[3] * wv[4 * j4 + 3].x;
                        a1[r] += s4[0] * wv[4 * j4].y + s4[1] * wv[4 * j4 + 1].y + s4[2] * wv[4 * j4 + 2].y + s4[3] * wv[4 * j4 + 3].y; }
            }
            if (act) {
#pragma unroll
                for (int r = 0; r < 9; ++r) { red[(wid * 9 + r) * 96 + 2 * lane] = a0[r]; red[(wid * 9 + r) * 96 + 2 * lane + 1] = a1[r]; } }
            __syncthreads();
            for (int i = tid; i < 9 * 96; i += NTHR) { const int r = i / 96, cc = i % 96; float s_ = 0.f;
#pragma unroll
                for (int q = 0; q < 8; ++q) s_ += red[(q * 9 + r) * 96 + cc];
                mods[((size_t)l * 9 + r) * 6144 + cg * 96 + cc] = s_ + P.in[I_BADA][l * 6144 + cg * 96 + cc]; }
            __syncthreads();
        }
    }
    { float* rt = (float*)(P.ws + WS_RT);
      for (int i = bid * NTHR + tid; i < DEPTH * 20 * 1024; i += G * NTHR) { const int l = i / 20480, j = (i % 20480) >> 10, c = i & 1023;
          rt[i] = (j < 4) ? P.in[I_WGR][((size_t)l * 1024 + c) * 4 + j] : P.in[I_WER][((size_t)l * 1024 + c) * 16 + (j - 4)]; } }
    if (bid == G - 1) {
        float* lbv = (float*)(P.ws + WS_LB);
        for (int i = tid; i < 1024; i += NTHR) {
            float lg[DEPTH], mx = -1e30f;
#pragma unroll
            for (int l = 0; l < DEPTH; ++l) { lg[l] = P.in[I_LBL][l * 1024 + i]; mx = fmaxf(mx, lg[l]); }
            float s = 0.f;
#pragma unroll
            for (int l = 0; l < DEPTH; ++l) { lg[l] = expf(lg[l] - mx); s += lg[l]; }
            float cum = 0.f;
#pragma unroll
            for (int l = 0; l < DEPTH; ++l) { if (l > 0) cum += lg[l] / s; lbv[l * 1024 + i] = cum; }
        }
        float* rope = (float*)(P.ws + WS_ROPE);
        for (int i = tid; i < 96 * 16; i += NTHR) {
            const int pos = i >> 4, fi = i & 15;
            const float inv = powf(10000.0f, -(float)fi / 16.0f);
            const float p = (pos < 32) ? (float)pos : (float)(pos - 32);
            const float ang = p * inv;
            if (pos < 32) { rope[pos * 16 + fi] = cosf(ang); rope[512 + pos * 16 + fi] = sinf(ang); }
            else { rope[1024 + (pos - 32) * 16 + fi] = cosf(ang); rope[2048 + (pos - 32) * 16 + fi] = sinf(ang); }
        }
    }
}

struct ConvJob { const float* srcA; const float* srcB; int ld; bool inter; bool perm; bf16_t* dst; int K, n0, k0; };
__device__ __forceinline__ int perm32(int rho) { const int n = rho >> 4, i = rho & 15; return 8 * (i >> 2) + 4 * n + (i & 3); }
__device__ __forceinline__ bool conv_job(const Params& P, int l, int u, ConvJob& J) {
    constexpr int T_IN = 16 * 124, T_BR = 3 * 8 * 16, T_OUT = 16 * 16, T_GU = 16 * 16 * 16, T_DN = 16 * 8 * 16;
    constexpr int TOT = T_IN + T_BR + T_OUT + T_GU + T_DN;
    if (u >= TOT) return false;
    int v = u;
    J.srcB = nullptr; J.inter = false; J.perm = false;
    if (v < T_IN) { const int kt = v % 16, nt = v / 16; J.perm = true; J.srcA = P.in[I_WIN] + (size_t)l * 1024 * INC; J.ld = INC; J.dst = (bf16_t*)(P.ws + WS_WIN); J.K = 1024; J.n0 = nt * 64; J.k0 = kt * 64; return true; }
    v -= T_IN;
    if (v < T_BR) { const int i = v / 128, w = v % 128, kt = w % 8, nt = w / 8; J.perm = true; J.srcA = P.in[I_WBR] + ((size_t)l * 3 + i) * 512 * 1024; J.ld = 1024; J.dst = (bf16_t*)(P.ws + WS_WBR) + (size_t)i * 1024 * 512; J.K = 512; J.n0 = nt * 64; J.k0 = kt * 64; return true; }
    v -= T_BR;
    if (v < T_OUT) { const int kt = v % 16, nt = v / 16; J.perm = true; J.srcA = P.in[I_WOUT] + (size_t)l * 1024 * 1024; J.ld = 1024; J.dst = (bf16_t*)(P.ws + WS_WOUT); J.K = 1024; J.n0 = nt * 64; J.k0 = kt * 64; return true; }
    v -= T_OUT;
    if (v < T_GU) { const int e = v / 256, w = v % 256, kt = w % 16, nt = w / 16; const size_t eo = ((size_t)l * NEXP + e) * 1024 * 512;
        J.srcA = P.in[I_WEG] + eo; J.srcB = P.in[I_WEU] + eo; J.inter = true; J.ld = 512; J.dst = (bf16_t*)(P.ws + WS_WGU) + (size_t)e * 1024 * 1024; J.K = 1024; J.n0 = nt * 64; J.k0 = kt * 64; return true; }
    v -= T_GU;
    { const int e = v / 128, w = v % 128, kt = w % 8, nt = w / 8; J.perm = true; J.srcA = P.in[I_WED] + ((size_t)l * NEXP + e) * 512 * 1024; J.ld = 1024; J.dst = (bf16_t*)(P.ws + WS_WDN) + (size_t)e * 1024 * 512; J.K = 512; J.n0 = nt * 64; J.k0 = kt * 64; return true; }
}
__device__ __forceinline__ void conv_load(const ConvJob& J, int tid, float (&v)[8]) {
    const int nn = tid & 63, kk = tid >> 6, n = J.n0 + nn;
    const float* cp;
    if (J.perm) cp = J.srcA + (n & ~31) + perm32(n & 31); else if (!J.inter) cp = J.srcA + n; else { const int g = n >> 5, i = n & 31; cp = (i < 16) ? (J.srcA + 16 * g + i) : (J.srcB + 16 * g + i - 16); }
#pragma unroll
    for (int p = 0; p < 8; ++p) v[p] = cp[(size_t)(J.k0 + kk + 8 * p) * J.ld];
}
__device__ __forceinline__ void conv_put(LAS float* t, int tid, const float (&v)[8]) { const int nn = tid & 63, kk = tid >> 6;
#pragma unroll
    for (int p = 0; p < 8; ++p) t[(kk + 8 * p) * 65 + nn] = v[p]; }
__device__ __forceinline__ void conv_out(const LAS float* t, int tid, const ConvJob& J) { const int n = tid >> 3, k8 = (tid & 7) * 8;
    float w[8];
#pragma unroll
    for (int j = 0; j < 8; ++j) w[j] = t[(k8 + j) * 65 + n];
    uint4 o; o.x = pk_bf16(w[0], w[1]); o.y = pk_bf16(w[2], w[3]); o.z = pk_bf16(w[4], w[5]); o.w = pk_bf16(w[6], w[7]);
    *(uint4*)(J.dst + (size_t)(J.n0 + n) * J.K + J.k0 + k8) = o; }
__device__ __forceinline__ void wconv_range(const Params& P, LAS unsigned char* lds, int l, int t0, int t1, int widx, int nw) {
    constexpr int CNT = 4, CBUF = 64 * 65 + 16;
    LAS float* tb = (LAS float*)lds;
    const int tid = tid_();
    int u = t0 + widx;
    ConvJob J[CNT]; float v[CNT][8]; bool h[CNT];
    h[0] = (u < t1) && conv_job(P, l, u, J[0]);
    if (!h[0]) return;
#pragma unroll
    for (int k = 1; k < CNT; ++k) { J[k] = J[0]; h[k] = (u + k * nw < t1) && conv_job(P, l, u + k * nw, J[k]); }
#pragma unroll
    for (int k = 0; k < CNT; ++k) {
#pragma unroll
        for (int p = 0; p < 8; ++p) v[k][p] = 0.f;
        if (h[k]) conv_load(J[k], tid, v[k]); }
    while (h[0]) {
        ConvJob N[CNT]; float n[CNT][8]; bool g[CNT];
#pragma unroll
        for (int k = 0; k < CNT; ++k) { N[k] = J[k]; g[k] = (u + (CNT + k) * nw < t1) && conv_job(P, l, u + (CNT + k) * nw, N[k]);
#pragma unroll
            for (int p = 0; p < 8; ++p) n[k][p] = 0.f;
            if (g[k]) conv_load(N[k], tid, n[k]); }
#pragma unroll
        for (int k = 0; k < CNT; ++k) if (h[k]) conv_put(tb + k * CBUF, tid, v[k]);
        __syncthreads();
#pragma unroll
        for (int k = 0; k < CNT; ++k) if (h[k]) conv_out(tb + k * CBUF, tid, J[k]);
        __syncthreads();
#pragma unroll
        for (int k = 0; k < CNT; ++k) { J[k] = N[k]; h[k] = g[k];
#pragma unroll
            for (int p = 0; p < 8; ++p) v[k][p] = n[k][p]; }
        u += CNT * nw;
    }
}
constexpr int CONV_T_DENSE = 16 * 124 + 3 * 8 * 16 + 16 * 16;
constexpr int CONV_T_ALL = CONV_T_DENSE + 16 * 16 * 16 + 16 * 8 * 16;
__device__ __forceinline__ void ph_wconv(const Params& P, LAS unsigned char* lds, int l) { wconv_range(P, lds, l, 0, CONV_T_DENSE, bid_(), gridDim.x); }

__device__ __forceinline__ const float* xrow(const Params& P, int l, int r) {
    return (l == 0) ? ((r < NLAT) ? P.in[I_X] + (size_t)r * D : P.in[I_CTX] + (size_t)(r - NLAT) * D) : (const float*)(P.ws + WS_X) + (size_t)r * D; }
__device__ __forceinline__ void norm_row(const float4 (&x)[4], const float* g, const float* shift, const float* scale, int lane, float4 (&o)[4]) {
    float ss = 0.f;
#pragma unroll
    for (int i = 0; i < 4; ++i) ss += x[i].x * x[i].x + x[i].y * x[i].y + x[i].z * x[i].z + x[i].w * x[i].w;
    ss = wave_sum(ss);
    const float rstd = __builtin_amdgcn_rsqf(ss * (1.0f / 1024.0f) + 1e-6f);
#pragma unroll
    for (int i = 0; i < 4; ++i) {
        const int c = lane * 4 + 256 * i;
        const float4 gv = *(const float4*)(g + c), sh = *(const float4*)(shift + c), sc = *(const float4*)(scale + c);
        o[i].x = x[i].x * rstd * gv.x * (1.0f + sc.x) + sh.x;
        o[i].y = x[i].y * rstd * gv.y * (1.0f + sc.y) + sh.y;
        o[i].z = x[i].z * rstd * gv.z * (1.0f + sc.z) + sh.z;
        o[i].w = x[i].w * rstd * gv.w * (1.0f + sc.w) + sh.w;
    }
}
__device__ __forceinline__ int row_modrow(int r) { return r < NLAT ? (r >> 11) : 8; }

__device__ __forceinline__ void ph_norm1(const Params& P, int l) {
    const int tid = tid_(), lane = tid & 63, wid = tid >> 6;
    const float* xres = (const float*)(P.ws + WS_X);
    bf16_t* h = (bf16_t*)(P.ws + WS_H);
    const float* g = P.in[I_GMIX] + l * 1024;
    for (int r = bid_() * 8 + wid; r < NTOK; r += gridDim.x * 8) {
        const float* mod = (const float*)(P.ws + WS_MODS) + ((size_t)l * 9 + row_modrow(r)) * 6144;
        float4 x[4], o[4];
#pragma unroll
        for (int i = 0; i < 4; ++i) x[i] = *(const float4*)(xrow(P, l, r) + lane * 4 + 256 * i);
        norm_row(x, g, mod, mod + 1024, lane, o);
#pragma unroll
        for (int i = 0; i < 4; ++i) { uint2 u; u.x = pk_bf16(o[i].x, o[i].y); u.y = pk_bf16(o[i].z, o[i].w); *(uint2*)(h + (size_t)r * D + lane * 4 + 256 * i) = u; }
    }
}

struct EpiStoreBf16 { bf16_t* O; int ldc;
    __device__ __forceinline__ void operator()(int row, int col, const f32x4& v0, const f32x4& v1) const {
        uint2 a, b; a.x = pk_bf16(v0[0], v0[1]); a.y = pk_bf16(v0[2], v0[3]); b.x = pk_bf16(v1[0], v1[1]); b.y = pk_bf16(v1[2], v1[3]);
        *(uint2*)(O + (size_t)row * ldc + col) = a; *(uint2*)(O + (size_t)row * ldc + col + 16) = b; } };
struct EpiStore16 { bf16_t* O; int ldc;
    __device__ __forceinline__ void operator()(const f32x4 (&acc)[2][2][4][2], const pg8::Unit& u, int wr, int wc, int fr, int fq) const {
#pragma unroll
        for (int ai = 0; ai < 2; ++ai)
#pragma unroll
            for (int m = 0; m < 4; ++m)
#pragma unroll
                for (int bj = 0; bj < 2; ++bj) { const int row = u.row0 + ai * 128 + wr * 64 + m * 16 + fr, col = u.col0 + bj * 128 + wc * 32 + 8 * fq;
                    const f32x4 v0 = acc[ai][bj][m][0], v1 = acc[ai][bj][m][1];
                    uint4 o; o.x = pk_bf16(v0[0], v0[1]); o.y = pk_bf16(v0[2], v0[3]); o.z = pk_bf16(v1[0], v1[1]); o.w = pk_bf16(v1[2], v1[3]);
                    *(uint4*)(O + (size_t)row * ldc + col) = o; }
    } };
struct FStoreBf16 { bf16_t* O; int ldc;
    __device__ __forceinline__ void operator()(const pg8::Unit&, int row, int col, const f32x4& v0, const f32x4& v1) const {
        uint2 a, b; a.x = pk_bf16(v0[0], v0[1]); a.y = pk_bf16(v0[2], v0[3]); b.x = pk_bf16(v1[0], v1[1]); b.y = pk_bf16(v1[2], v1[3]);
        *(uint2*)(O + (size_t)row * ldc + col) = a; *(uint2*)(O + (size_t)row * ldc + col + 16) = b; } };
__device__ __forceinline__ float gq8(const uint2& g, int j) {
    const unsigned w = (j < 4) ? g.x : g.y; const int b = j & 3;
    return (float)((w >> (8 * b)) & 0xffu) * (1.0f / 255.0f); }
__device__ __forceinline__ unsigned gpack4(float a, float b, float c, float d) {
    const unsigned qa = (unsigned)(a * 255.0f + 0.5f), qb = (unsigned)(b * 255.0f + 0.5f), qc = (unsigned)(c * 255.0f + 0.5f), qd = (unsigned)(d * 255.0f + 0.5f);
    return qa | (qb << 8) | (qc << 16) | (qd << 24); }
struct EpiG1 { bf16_t* Z; bf16_t* GT;
    __device__ __forceinline__ void operator()(const f32x4 (&acc)[2][2][4][2], const pg8::Unit& u, int wr, int wc, int fr, int fq) const {
        if (u.col0 < C_GATE) {
#pragma unroll
            for (int ai = 0; ai < 2; ++ai)
#pragma unroll
                for (int m = 0; m < 4; ++m)
#pragma unroll
                    for (int bj = 0; bj < 2; ++bj) { const int row = u.row0 + ai * 128 + wr * 64 + m * 16 + fr, col = u.col0 + bj * 128 + wc * 32 + 8 * fq;
                        const f32x4 v0 = acc[ai][bj][m][0], v1 = acc[ai][bj][m][1];
                        uint4 o; o.x = pk_bf16(v0[0], v0[1]); o.y = pk_bf16(v0[2], v0[3]); o.z = pk_bf16(v1[0], v1[1]); o.w = pk_bf16(v1[2], v1[3]);
                        *(uint4*)(Z + (size_t)row * ZP + col) = o; }
        } else {
            const int tidx = (wr * 4 + wc) * 64 + fq * 16 + fr;
            unsigned char* base = (unsigned char*)GT + ((size_t)(u.row0 >> 8) * 12 + ((u.col0 - C_GATE) >> 8)) * 65536 + tidx * 8;
#pragma unroll
            for (int ai = 0; ai < 2; ++ai)
#pragma unroll
                for (int bj = 0; bj < 2; ++bj)
#pragma unroll
                    for (int m = 0; m < 4; ++m) { const f32x4 v0 = acc[ai][bj][m][0], v1 = acc[ai][bj][m][1];
                        uint2 o; o.x = gpack4(sigmoidf_(v0[0]), sigmoidf_(v0[1]), sigmoidf_(v0[2]), sigmoidf_(v0[3]));
                        o.y = gpack4(sigmoidf_(v1[0]), sigmoidf_(v1[1]), sigmoidf_(v1[2]), sigmoidf_(v1[3]));
                        *(uint2*)(base + ((ai * 2 + bj) * 4 + m) * 4096) = o; }
        }
    } };
__device__ __forceinline__ void ph_g1(const Params& P, LAS unsigned char* lds) {
    pg8::SchedDense S{NTOK / 256, INC / 256, (int)gridDim.x, bid_(), (const char*)(P.ws + WS_H), (const char*)(P.ws + WS_WIN), (size_t)256 * D * 2, (size_t)256 * D * 2};
    EpiG1 E{(bf16_t*)(P.ws + WS_Z), (bf16_t*)(P.ws + WS_GT)};
    pg8::gemm_phase(lds, pg8::Gemm{D, D, D}, S, E);
}

__device__ __forceinline__ int kvrow(int r) { return r < NLAT ? ((r >> 11) * 2304 + 256 + (r & 2047)) : (((r - NLAT) >> 8) * 2304 + ((r - NLAT) & 255)); }
__device__ __forceinline__ void ph_prep(const Params& P, int l) {
    const int tid = tid_(), lane = tid & 63, wid = tid >> 6;
    const bf16_t* z = (const bf16_t*)(P.ws + WS_Z);
    bf16_t* kn = (bf16_t*)(P.ws + WS_KN); bf16_t* vn = (bf16_t*)(P.ws + WS_VN);
    const float* rope = (const float*)(P.ws + WS_ROPE);
    const float gk = P.in[I_KNG][l * 64 + lane];
    const float sgn = (lane & 16) ? 1.f : -1.f;
    const int rstep = gridDim.x * 8;
    for (int r0 = bid_() * 8 + wid; r0 < NTOK; r0 += 3 * rstep) {
        float xk[3][2]; unsigned vv[3]; float cs[3], sn[3];
#pragma unroll
        for (int q = 0; q < 3; ++q) { const int r = (r0 + q * rstep < NTOK) ? r0 + q * rstep : r0;
            xk[q][0] = bf2f(z[(size_t)r * ZP + C_GK + lane]); xk[q][1] = bf2f(z[(size_t)r * ZP + C_GK + 64 + lane]);
            vv[q] = *(const unsigned*)(z + (size_t)r * ZP + C_GV + lane * 2);
            cs[q] = 1.f; sn[q] = 0.f;
            if (r < NLAT) { const int t = r & 2047, fi = lane & 15;
                if (lane < 32) { const int pr = t >> 6; cs[q] = rope[pr * 16 + fi]; sn[q] = rope[512 + pr * 16 + fi]; }
                else { const int pc = t & 63; cs[q] = rope[1024 + pc * 16 + fi]; sn[q] = rope[2048 + pc * 16 + fi]; } } }
#pragma unroll
        for (int q = 0; q < 3; ++q) { const int r = r0 + q * rstep;
            if (r < NTOK) { const size_t kr = (size_t)kvrow(r);
#pragma unroll
                for (int hh = 0; hh < 2; ++hh) {
                    const float x = xk[q][hh];
                    const float ss = wave_sum(x * x);
                    const float xn = x * __builtin_amdgcn_rsqf(ss * (1.0f / 64.0f) + 1e-6f) * gk;
                    const float pa = __shfl_xor(xn, 16, 64);
                    const float o = xn * cs[q] + sgn * pa * sn[q];
                    kn[kr * 128 + hh * 64 + lane] = (bf16_t)(pk_bf16(o, 0.f) & 0xffffu); }
                *(unsigned*)(vn + kr * 128 + lane * 2) = vv[q]; } }
    }
}

__device__ __forceinline__ void ph_prepnavt(const Params& P, LAS unsigned char* lds, int l) {
    const int tid = tid_();
    const bf16_t* z = (const bf16_t*)(P.ws + WS_Z); bf16_t* vt = (bf16_t*)(P.ws + WS_NAVT);
    constexpr int PT = 1040, TT = 72;
    bool prepped = false;
    for (int u = bid_(); u < NB * 32 || !prepped; u += gridDim.x) {
        const bool has = u < NB * 32;
        const int b = u >> 5, tl = u & 31;
        uint4 v[9];
        if (has) {
#pragma unroll
            for (int i = 0; i < 9; ++i) { const int ch = tid + i * NTHR, rr = ch >> 6, cc = ch & 63, tok = tl * TT + rr;
                const int row = (tok < 256) ? (NLAT + b * 256 + tok) : (b * 2048 + tok - 256);
                v[i] = *(const uint4*)(z + (size_t)row * ZP + C_NAV + cc * 8); } }
        if (!prepped) { ph_prep(P, l); prepped = true; }
        if (has) {
            __syncthreads();
#pragma unroll
            for (int i = 0; i < 9; ++i) { const int ch = tid + i * NTHR, rr = ch >> 6, cc = ch & 63; *(LAS u32x4*)(lds + rr * PT + cc * 16) = (u32x4){v[i].x, v[i].y, v[i].z, v[i].w}; }
            __syncthreads();
#pragma unroll
            for (int i = 0; i < 9; ++i) { const int c = tid, tg = i;
                unsigned short e[8];
#pragma unroll
                for (int k = 0; k < 8; ++k) e[k] = *(const LAS unsigned short*)(lds + (tg * 8 + k) * PT + c * 2);
                uint4 o; o.x = e[0] | ((unsigned)e[1] << 16); o.y = e[2] | ((unsigned)e[3] << 16); o.z = e[4] | ((unsigned)e[5] << 16); o.w = e[6] | ((unsigned)e[7] << 16);
                *(uint4*)(vt + ((size_t)(b * 8 + (c >> 6)) * 64 + (c & 63)) * 2304 + tl * TT + tg * 8) = o; }
        }
    }
    __syncthreads();
}

#ifdef DIAG
__device__ __forceinline__ void load_q64(float (&q)[64], const bf16_t* p) {
#pragma unroll
    for (int i = 0; i < 8; ++i) { const uint4 u = ((const uint4*)p)[i];
        q[8 * i + 0] = bf_lo(u.x); q[8 * i + 1] = bf_hi(u.x); q[8 * i + 2] = bf_lo(u.y); q[8 * i + 3] = bf_hi(u.y);
        q[8 * i + 4] = bf_lo(u.z); q[8 * i + 5] = bf_hi(u.z); q[8 * i + 6] = bf_lo(u.w); q[8 * i + 7] = bf_hi(u.w); }
}
__device__ __forceinline__ void attn_key(const float (&q)[64], const bf16_t* kp, const bf16_t* vp, float bias, float& m, float& lsum, float (&o)[64]) {
    float s = 0.f;
#pragma unroll
    for (int i = 0; i < 8; ++i) { const uint4 u = ((const uint4*)kp)[i];
        s += q[8 * i + 0] * bf_lo(u.x) + q[8 * i + 1] * bf_hi(u.x) + q[8 * i + 2] * bf_lo(u.y) + q[8 * i + 3] * bf_hi(u.y)
           + q[8 * i + 4] * bf_lo(u.z) + q[8 * i + 5] * bf_hi(u.z) + q[8 * i + 6] * bf_lo(u.w) + q[8 * i + 7] * bf_hi(u.w); }
    s = s * 0.125f + bias;
    const float mn = fmaxf(m, s), corr = __expf(m - mn), pp = __expf(s - mn);
    lsum = lsum * corr + pp; m = mn;
#pragma unroll
    for (int i = 0; i < 8; ++i) { const uint4 u = ((const uint4*)vp)[i];
        o[8 * i + 0] = o[8 * i + 0] * corr + pp * bf_lo(u.x); o[8 * i + 1] = o[8 * i + 1] * corr + pp * bf_hi(u.x);
        o[8 * i + 2] = o[8 * i + 2] * corr + pp * bf_lo(u.y); o[8 * i + 3] = o[8 * i + 3] * corr + pp * bf_hi(u.y);
        o[8 * i + 4] = o[8 * i + 4] * corr + pp * bf_lo(u.z); o[8 * i + 5] = o[8 * i + 5] * corr + pp * bf_hi(u.z);
        o[8 * i + 6] = o[8 * i + 6] * corr + pp * bf_lo(u.w); o[8 * i + 7] = o[8 * i + 7] * corr + pp * bf_hi(u.w); }
}
__device__ __forceinline__ void store_o64(const float (&o)[64], float inv, bf16_t* p) {
#pragma unroll
    for (int i = 0; i < 8; ++i) { uint4 u;
        u.x = pk_bf16(o[8 * i + 0] * inv, o[8 * i + 1] * inv); u.y = pk_bf16(o[8 * i + 2] * inv, o[8 * i + 3] * inv);
        u.z = pk_bf16(o[8 * i + 4] * inv, o[8 * i + 5] * inv); u.w = pk_bf16(o[8 * i + 6] * inv, o[8 * i + 7] * inv);
        ((uint4*)p)[i] = u; }
}
__device__ __forceinline__ void na_thread(const Params& P, int l, int r, int h, bf16_t* br, int OPN) {
    const bf16_t* z = (const bf16_t*)(P.ws + WS_Z);
    float q[64], o[64]; float m = -INFINITY, ls = 0.f;
#pragma unroll
    for (int i = 0; i < 64; ++i) o[i] = 0.f;
    load_q64(q, z + (size_t)r * ZP + C_NAQ + h * 64);
    int b;
    if (r < NLAT) {
        b = r >> 11; const int t = r & 2047, qr = t >> 6, qc = t & 63;
        const int r0 = min(max(qr - 4, 0), 24), c0 = min(max(qc - 8, 0), 48);
        const float* rpb = P.in[I_RPB] + ((size_t)l * 8 + h) * 15 * 31;
        for (int kr = r0; kr < r0 + 8; ++kr)
            for (int kc = c0; kc < c0 + 16; ++kc) {
                const size_t krow = (size_t)(b * 2048 + kr * 64 + kc) * ZP;
                attn_key(q, z + krow + C_NAK + h * 64, z + krow + C_NAV + h * 64, rpb[(kr - qr + 7) * 31 + (kc - qc + 15)], m, ls, o);
            }
    } else b = (r - NLAT) >> 8;
    for (int j = 0; j < 256; ++j) {
        const size_t krow = (size_t)(NLAT + b * 256 + j) * ZP;
        attn_key(q, z + krow + C_NAK + h * 64, z + krow + C_NAV + h * 64, 0.f, m, ls, o);
    }
    store_o64(o, 1.0f / ls, br + (size_t)r * OPN + h * 64);
}
#endif
namespace na {
constexpr int KP = 144, VP = 528;
constexpr int L_K = 0, L_V = 256 * KP, L_B = L_V + 64 * VP, L_END = L_B + 480 * 4;
constexpr float C2 = 0.125f * 1.4426950408889634f, LOG2E = 1.4426950408889634f;
struct Acc { float m, l; f32x4 o[4]; };
template <int NG> __device__ __forceinline__ void absorb(Acc& A, f32x4 (&sa)[NG], f32x4 (&sb)[NG], const bf16x8 (&vfr)[NG][4]) {
    float mx = -INFINITY;
#pragma unroll
    for (int g = 0; g < NG; ++g)
#pragma unroll
        for (int j = 0; j < 4; ++j) mx = fmaxf(mx, fmaxf(sa[g][j], sb[g][j]));
    { auto rr = __builtin_amdgcn_permlane16_swap(__float_as_uint(mx), __float_as_uint(mx), false, false); mx = fmaxf(__uint_as_float(rr[0]), __uint_as_float(rr[1])); }
    { auto rr = __builtin_amdgcn_permlane32_swap(__float_as_uint(mx), __float_as_uint(mx), false, false); mx = fmaxf(__uint_as_float(rr[0]), __uint_as_float(rr[1])); }
    const float mn = fmaxf(A.m, mx), corr = __builtin_amdgcn_exp2f(A.m - mn);
    A.m = mn;
    float ps = 0.f;
    bf16x8 pf[NG];
#pragma unroll
    for (int g = 0; g < NG; ++g) { float p[8];
#pragma unroll
        for (int j = 0; j < 4; ++j) { p[j] = __builtin_amdgcn_exp2f(sa[g][j] - mn); p[4 + j] = __builtin_amdgcn_exp2f(sb[g][j] - mn); ps += p[j] + p[4 + j]; }
        pf[g] = pack8(p); }
    A.l = A.l * corr + ps;
#pragma unroll
    for (int db = 0; db < 4; ++db) A.o[db] *= corr;
#pragma unroll
    for (int g = 0; g < NG; ++g)
#pragma unroll
        for (int db = 0; db < 4; ++db) A.o[db] = __builtin_amdgcn_mfma_f32_16x16x32_bf16(vfr[g][db], pf[g], A.o[db], 0, 0, 0);
}
}
__device__ __forceinline__ void na_unit(const Params& P, LAS unsigned char* lds, int l, int u, bf16_t* br, int OPN) {
    const int tid = tid_(), lane = tid & 63, wid = __builtin_amdgcn_readfirstlane(tid >> 6), c16 = lane & 15, kq = lane >> 4;
    const bool latu = u < 256;
    const int bh = latu ? (u >> 2) : (u - 256), b = bh >> 3, h = bh & 7, q4 = u & 3;
    const bf16_t* z = (const bf16_t*)(P.ws + WS_Z); const bf16_t* vt = (const bf16_t*)(P.ws + WS_NAVT) + (size_t)bh * 64 * 2304;
    LAS unsigned char* KL = lds + na::L_K; LAS unsigned char* VL = lds + na::L_V; LAS float* BL = (LAS float*)(lds + na::L_B);
    __syncthreads();
#pragma unroll
    for (int i = 0; i < 4; ++i) { const int ch = tid + i * NTHR, rr = ch >> 3, cc = ch & 7;
        const uint4 v = *(const uint4*)(z + (size_t)(NLAT + b * 256 + rr) * ZP + C_NAK + h * 64 + cc * 8);
        *(LAS u32x4*)(KL + rr * na::KP + cc * 16) = (u32x4){v.x, v.y, v.z, v.w}; }
#pragma unroll
    for (int i = 0; i < 4; ++i) { const int ch = tid + i * NTHR, rr = ch >> 5, cc = ch & 31;
        const uint4 v = *(const uint4*)(vt + (size_t)rr * 2304 + cc * 8);
        *(LAS u32x4*)(VL + rr * na::VP + cc * 16) = (u32x4){v.x, v.y, v.z, v.w}; }
    if (tid < 465) BL[tid] = P.in[I_RPB][((size_t)l * 8 + h) * 465 + tid] * na::LOG2E;
    __syncthreads();
    const int sA = 8 * (c16 >> 2) + (c16 & 3);
    const int ntask = latu ? 4 : 2;
    struct TaskP { int qrow, r, jb, r0, kc0; };
#define NA_FENCE() asm volatile("" ::: "memory")
#define NA_TASKP(it_, t_) do { const int tk_ = (it_) * 8 + wid; t_.r = 0; t_.jb = 0; t_.r0 = 0; t_.kc0 = 0; \
        if (latu) { t_.r = q4 * 8 + (tk_ >> 2); t_.jb = tk_ & 3; t_.qrow = b * 2048 + t_.r * 64 + t_.jb * 16 + c16; t_.r0 = min(max(t_.r - 4, 0), 24); t_.kc0 = min(max(t_.jb * 16 - 8, 0), 32); } \
        else t_.qrow = NLAT + b * 256 + tk_ * 16 + c16; } while (0)
#define NA_LOADK(t_, c_, kf_) do { _Pragma("unroll") for (int g = 0; g < 2; ++g) { const bf16_t* kp_ = z + ((size_t)b * 2048 + (size_t)(t_.r0 + 2 * (c_) + g) * 64 + t_.kc0 + sA) * ZP + C_NAK + h * 64 + 8 * kq; \
            kf_[g][0] = *(const bf16x8*)kp_; kf_[g][1] = *(const bf16x8*)(kp_ + 32); kf_[g][2] = *(const bf16x8*)(kp_ + 4 * ZP); kf_[g][3] = *(const bf16x8*)(kp_ + 4 * ZP + 32); } } while (0)
#define NA_LOADV(t_, c_, vf_) do { const bf16_t* vp_ = vt + (size_t)c16 * 2304 + 256 + (t_.r0 + 2 * (c_)) * 64 + t_.kc0 + 8 * kq; \
        _Pragma("unroll") for (int g = 0; g < 2; ++g) _Pragma("unroll") for (int db = 0; db < 4; ++db) vf_[g][db] = *(const bf16x8*)(vp_ + (size_t)db * 16 * 2304 + g * 64); } while (0)
    for (int it = 0; it < ntask; ++it) {
        TaskP T; NA_TASKP(it, T);
        bf16x8 qf[2];
#pragma unroll
        for (int ks = 0; ks < 2; ++ks) qf[ks] = *(const bf16x8*)(z + (size_t)T.qrow * ZP + C_NAQ + h * 64 + 32 * ks + 8 * kq);
        na::Acc A; A.m = -INFINITY; A.l = 0.f;
#pragma unroll
        for (int db = 0; db < 4; ++db) A.o[db] = (f32x4){0.f, 0.f, 0.f, 0.f};
        if (latu) {
            bf16x8 kA[2][4], vA[2][4], kB[2][4], vB[2][4];
            NA_LOADK(T, 0, kA); NA_LOADV(T, 0, vA); NA_LOADK(T, 1, kB); NA_LOADV(T, 1, vB);
            const int qc = T.jb * 16 + c16, c0 = min(max(qc - 8, 0), 48);
            int dcol[8]; bool ok[8];
#pragma unroll
            for (int j = 0; j < 8; ++j) { const int kc = T.kc0 + 8 * kq + j; ok[j] = (kc >= c0) && (kc < c0 + 16); dcol[j] = ok[j] ? (kc - qc + 15) : 0; }
#define NA_SCORES(KF, CI) do { \
                float bv[2][8]; \
                _Pragma("unroll") for (int g = 0; g < 2; ++g) { const int brow = (T.r0 + 2 * (CI) + g - T.r + 7) * 31; \
                    _Pragma("unroll") for (int j = 0; j < 8; ++j) bv[g][j] = BL[brow + dcol[j]]; } \
                _Pragma("unroll") for (int g = 0; g < 2; ++g) { \
                    f32x4 a_ = {0.f, 0.f, 0.f, 0.f}, b_ = {0.f, 0.f, 0.f, 0.f}; \
                    a_ = __builtin_amdgcn_mfma_f32_16x16x32_bf16(KF[g][0], qf[0], a_, 0, 0, 0); a_ = __builtin_amdgcn_mfma_f32_16x16x32_bf16(KF[g][1], qf[1], a_, 0, 0, 0); \
                    b_ = __builtin_amdgcn_mfma_f32_16x16x32_bf16(KF[g][2], qf[0], b_, 0, 0, 0); b_ = __builtin_amdgcn_mfma_f32_16x16x32_bf16(KF[g][3], qf[1], b_, 0, 0, 0); \
                    _Pragma("unroll") for (int j = 0; j < 4; ++j) { \
                        const float va_ = a_[j] * na::C2 + bv[g][j], vb_ = b_[j] * na::C2 + bv[g][4 + j]; \
                        sa[g][j] = ok[j] ? va_ : -INFINITY; sb[g][j] = ok[4 + j] ? vb_ : -INFINITY; } } } while (0)
            f32x4 sa[2], sb[2];
            NA_SCORES(kA, 0); NA_FENCE(); NA_LOADK(T, 2, kA); NA_FENCE(); na::absorb<2>(A, sa, sb, vA); NA_FENCE(); NA_LOADV(T, 2, vA); NA_FENCE();
            NA_SCORES(kB, 1); NA_FENCE(); NA_LOADK(T, 3, kB); NA_FENCE(); na::absorb<2>(A, sa, sb, vB); NA_FENCE(); NA_LOADV(T, 3, vB); NA_FENCE();
            NA_SCORES(kA, 2); na::absorb<2>(A, sa, sb, vA);
            NA_SCORES(kB, 3); na::absorb<2>(A, sa, sb, vB);
#undef NA_SCORES
        }
#pragma unroll 1
        for (int ch = 0; ch < 2; ++ch) {
            f32x4 sa[4], sb[4];
            bf16x8 kf[4][4], vfr[4][4];
            { const LAS unsigned char* vp = VL + c16 * na::VP + (ch * 128 + 8 * kq) * 2;
#pragma unroll
              for (int g = 0; g < 4; ++g)
#pragma unroll
                for (int db = 0; db < 4; ++db) vfr[g][db] = *(const LAS bf16x8*)(vp + db * 16 * na::VP + g * 64); }
#pragma unroll
            for (int g = 0; g < 4; ++g) {
                const LAS unsigned char* kp = KL + (ch * 128 + g * 32 + sA) * na::KP + kq * 16;
                kf[g][0] = *(const LAS bf16x8*)kp; kf[g][1] = *(const LAS bf16x8*)(kp + 64); kf[g][2] = *(const LAS bf16x8*)(kp + 4 * na::KP); kf[g][3] = *(const LAS bf16x8*)(kp + 4 * na::KP + 64);
            }
#pragma unroll
            for (int g = 0; g < 4; ++g) {
                f32x4 a = {0.f, 0.f, 0.f, 0.f}, bq = {0.f, 0.f, 0.f, 0.f};
                a = __builtin_amdgcn_mfma_f32_16x16x32_bf16(kf[g][0], qf[0], a, 0, 0, 0); a = __builtin_amdgcn_mfma_f32_16x16x32_bf16(kf[g][1], qf[1], a, 0, 0, 0);
                bq = __builtin_amdgcn_mfma_f32_16x16x32_bf16(kf[g][2], qf[0], bq, 0, 0, 0); bq = __builtin_amdgcn_mfma_f32_16x16x32_bf16(kf[g][3], qf[1], bq, 0, 0, 0);
                sa[g] = a * na::C2; sb[g] = bq * na::C2;
            }
            na::absorb<4>(A, sa, sb, vfr);
        }
        float ls = A.l; ls += __shfl_xor(ls, 16, 64); ls += __shfl_xor(ls, 32, 64);
        const float inv = __builtin_amdgcn_rcpf(ls);
        bf16_t* op = br + (size_t)T.qrow * OPN + h * 64 + 4 * kq;
#pragma unroll
        for (int db = 0; db < 4; ++db) { uint2 o; o.x = pk_bf16(A.o[db][0] * inv, A.o[db][1] * inv); o.y = pk_bf16(A.o[db][2] * inv, A.o[db][3] * inv);
            *(uint2*)(op + 16 * db) = o; }
    }
#undef NA_FENCE
#undef NA_TASKP
#undef NA_LOADK
#undef NA_LOADV
}
constexpr int NAR_SLOT = 16384, NAR_B = 9 * NAR_SLOT;
static_assert(NAR_B + 480 * 4 + 64 <= LDS_BYTES, "na ring");
__device__ __forceinline__ void na_unit_lat(const Params& P, LAS unsigned char* lds, int l, int u_, bf16_t* br, int OPN) {
    const int u = __builtin_amdgcn_readfirstlane(u_);
    const int tid = tid_(), lane = tid & 63, wid = __builtin_amdgcn_readfirstlane(tid >> 6), c16 = lane & 15, kq = lane >> 4;
    const int bh = u >> 2, b = bh >> 3, h = bh & 7, q4 = u & 3;
    const bf16_t* z = (const bf16_t*)(P.ws + WS_Z); const bf16_t* vt = (const bf16_t*)(P.ws + WS_NAVT) + (size_t)bh * 64 * 2304;
    LAS float* BL = (LAS float*)(lds + NAR_B);
    const int st = tid >> 3, sc = tid & 7;
    const bf16_t* gk = z + ((size_t)b * 2048 + st) * ZP + C_NAK + h * 64 + sc * 8;
    const bf16_t* gv = vt + (size_t)st * 2304 + 256 + sc * 8;
    const unsigned lk = (unsigned)(st * 128 + ((sc ^ ((((st >> 3) & 3) << 1) | ((st >> 1) & 1))) * 16));
    const unsigned lv = (unsigned)(8192 + st * 128 + ((sc ^ ((st >> 1) & 7)) * 16));
    const int rq0 = q4 * 8;
    __syncthreads();
    if (tid < 465) BL[tid] = P.in[I_RPB][((size_t)l * 8 + h) * 465 + tid] * na::LOG2E;
    int rmax;
    {   const int lo = min(max(rq0 - 4, 0), 24), hi = min(max(rq0 - 3, 0), 24) + 7;
        for (int w = lo; w <= hi; w += 3) {
            uint4 kk[3], vv[3];
#pragma unroll
            for (int j = 0; j < 3; ++j) { const int wj = min(w + j, hi); kk[j] = *(const uint4*)(gk + (size_t)wj * 64 * ZP); vv[j] = *(const uint4*)(gv + wj * 64); }
#pragma unroll
            for (int j = 0; j < 3; ++j) { const int wj = min(w + j, hi); LAS unsigned char* sb_ = lds + (wj % 9) * NAR_SLOT;
                *(LAS u32x4*)(sb_ + lk) = (u32x4){kk[j].x, kk[j].y, kk[j].z, kk[j].w}; *(LAS u32x4*)(sb_ + lv) = (u32x4){vv[j].x, vv[j].y, vv[j].z, vv[j].w}; }
        }
        rmax = hi; }
    __syncthreads();
    const int sA = 8 * (c16 >> 2) + (c16 & 3);
    const __amdgpu_buffer_rsrc_t rsK = __builtin_amdgcn_make_buffer_rsrc((void*)(z + (size_t)(NLAT + b * 256) * ZP + C_NAK + h * 64), (short)0, 256 * ZP * 2, 0x00020000);
    const __amdgpu_buffer_rsrc_t rsV = __builtin_amdgcn_make_buffer_rsrc((void*)vt, (short)0, 64 * 2304 * 2, 0x00020000);
    const unsigned lko = (unsigned)(sA * ZP + 8 * kq) * 2u, lvo = (unsigned)(c16 * 2304 + 8 * kq) * 2u;
#define NAR_FENCE() asm volatile("" ::: "memory")
    for (int it = 0; it < 4; ++it) {
        const int tk = it * 8 + wid, r = rq0 + (tk >> 2), jb = tk & 3;
        const int qrow = b * 2048 + r * 64 + jb * 16 + c16;
        const int r0 = min(max(r - 4, 0), 24), kc0 = min(max(jb * 16 - 8, 0), 32);
        bf16x8 qf[2];
#pragma unroll
        for (int ks = 0; ks < 2; ++ks) qf[ks] = *(const bf16x8*)(z + (size_t)qrow * ZP + C_NAQ + h * 64 + 32 * ks + 8 * kq);
        na::Acc A; A.m = -INFINITY; A.l = 0.f;
#pragma unroll
        for (int db = 0; db < 4; ++db) A.o[db] = (f32x4){0.f, 0.f, 0.f, 0.f};
        const int qc = jb * 16 + c16, c0 = min(max(qc - 8, 0), 48);
        const int dbase = kc0 + 8 * kq - qc + 15;
        bool ok[8];
#pragma unroll
        for (int j = 0; j < 8; ++j) { const int kc = kc0 + 8 * kq + j; ok[j] = (kc >= c0) && (kc < c0 + 16); }
        const int t0 = kc0 + sA;
        const unsigned ka = (unsigned)(t0 * 128 + ((kq ^ ((((t0 >> 3) & 3) << 1) | ((t0 >> 1) & 1))) * 16));
        const unsigned va = (unsigned)(8192 + c16 * 128 + ((((kc0 >> 3) + kq) ^ ((c16 >> 1) & 7)) * 16));
        const int s0 = r0 % 9;
        bf16x8 vA[2][4], cK[2][4], cV[2][4];
        f32x4 sa[2], sb[2];
#define NAR_LD(rs_, vo_, so_) __builtin_bit_cast(bf16x8, __builtin_amdgcn_raw_buffer_load_b128(rs_, vo_, (int)(so_), 0))
#define NAR_CTX(cc) do { _Pragma("unroll") for (int g = 0; g < 2; ++g) { \
            const unsigned ko_ = (unsigned)(((cc) * 64 + g * 32) * ZP) * 2u; \
            cK[g][0] = NAR_LD(rsK, lko, ko_); cK[g][1] = NAR_LD(rsK, lko, ko_ + 64u); cK[g][2] = NAR_LD(rsK, lko, ko_ + 4u * ZP * 2u); cK[g][3] = NAR_LD(rsK, lko, ko_ + 4u * ZP * 2u + 64u); \
            _Pragma("unroll") for (int db = 0; db < 4; ++db) cV[g][db] = NAR_LD(rsV, lvo, (unsigned)(db * 16 * 2304 + (cc) * 64 + g * 32) * 2u); } } while (0)
#define NAR_LOCALV(c_) do { _Pragma("unroll") for (int g = 0; g < 2; ++g) { int sl_ = s0 + 2 * (c_) + g; sl_ -= (sl_ >= 9) ? 9 : 0; \
            const LAS unsigned char* sb_ = lds + sl_ * NAR_SLOT; \
            _Pragma("unroll") for (int db = 0; db < 4; ++db) vA[g][db] = *(const LAS bf16x8*)(sb_ + va + db * 2048); } } while (0)
#define NAR_SCORES(CI) do { \
            _Pragma("unroll") for (int g = 0; g < 2; ++g) { int sl_ = s0 + 2 * (CI) + g; sl_ -= (sl_ >= 9) ? 9 : 0; \
                const LAS unsigned char* sb_ = lds + sl_ * NAR_SLOT; \
                const bf16x8 k0_ = *(const LAS bf16x8*)(sb_ + ka), k1_ = *(const LAS bf16x8*)(sb_ + (ka ^ 64u)), k2_ = *(const LAS bf16x8*)(sb_ + ka + 512), k3_ = *(const LAS bf16x8*)(sb_ + (ka ^ 64u) + 512); \
                const LAS float* bl_ = BL + (r0 + 2 * (CI) + g - r + 7) * 31; \
                f32x4 a_ = {0.f, 0.f, 0.f, 0.f}, b_ = {0.f, 0.f, 0.f, 0.f}; \
                a_ = __builtin_amdgcn_mfma_f32_16x16x32_bf16(k0_, qf[0], a_, 0, 0, 0); a_ = __builtin_amdgcn_mfma_f32_16x16x32_bf16(k1_, qf[1], a_, 0, 0, 0); \
                b_ = __builtin_amdgcn_mfma_f32_16x16x32_bf16(k2_, qf[0], b_, 0, 0, 0); b_ = __builtin_amdgcn_mfma_f32_16x16x32_bf16(k3_, qf[1], b_, 0, 0, 0); \
                _Pragma("unroll") for (int j = 0; j < 4; ++j) { \
                    const float va_ = a_[j] * na::C2 + bl_[dbase + j], vb_ = b_[j] * na::C2 + bl_[dbase + 4 + j];        \
                    sa[g][j] = ok[j] ? va_ : -INFINITY; sb[g][j] = ok[4 + j] ? vb_ : -INFINITY; } } } while (0)
#define NAR_CSCORES() do { _Pragma("unroll") for (int g = 0; g < 2; ++g) { \
                f32x4 a_ = {0.f, 0.f, 0.f, 0.f}, b_ = {0.f, 0.f, 0.f, 0.f}; \
                a_ = __builtin_amdgcn_mfma_f32_16x16x32_bf16(cK[g][0], qf[0], a_, 0, 0, 0); a_ = __builtin_amdgcn_mfma_f32_16x16x32_bf16(cK[g][1], qf[1], a_, 0, 0, 0); \
                b_ = __builtin_amdgcn_mfma_f32_16x16x32_bf16(cK[g][2], qf[0], b_, 0, 0, 0); b_ = __builtin_amdgcn_mfma_f32_16x16x32_bf16(cK[g][3], qf[1], b_, 0, 0, 0); \
                sa[g] = a_ * na::C2; sb[g] = b_ * na::C2; } } while (0)
        NAR_CTX(0); NAR_FENCE();
        NAR_SCORES(0); NAR_FENCE(); NAR_LOCALV(0); na::absorb<2>(A, sa, sb, vA); NAR_FENCE();
        NAR_CSCORES(); na::absorb<2>(A, sa, sb, cV); NAR_FENCE(); NAR_CTX(1); NAR_FENCE();
        NAR_SCORES(1); NAR_FENCE(); NAR_LOCALV(1); na::absorb<2>(A, sa, sb, vA); NAR_FENCE();
        NAR_CSCORES(); na::absorb<2>(A, sa, sb, cV); NAR_FENCE(); NAR_CTX(2); NAR_FENCE();
        NAR_SCORES(2); NAR_FENCE(); NAR_LOCALV(2); na::absorb<2>(A, sa, sb, vA); NAR_FENCE();
        NAR_CSCORES(); na::absorb<2>(A, sa, sb, cV); NAR_FENCE(); NAR_CTX(3); NAR_FENCE();
        NAR_SCORES(3); NAR_FENCE(); NAR_LOCALV(3); na::absorb<2>(A, sa, sb, vA); NAR_FENCE();
        NAR_CSCORES(); na::absorb<2>(A, sa, sb, cV);
#undef NAR_CTX
#undef NAR_LD
#undef NAR_LOCALV
#undef NAR_SCORES
#undef NAR_CSCORES
        float ls = A.l; ls += __shfl_xor(ls, 16, 64); ls += __shfl_xor(ls, 32, 64);
        const float inv = __builtin_amdgcn_rcpf(ls);
        bf16_t* op = br + (size_t)qrow * OPN + h * 64 + 4 * kq;
#pragma unroll
        for (int db = 0; db < 4; ++db) { uint2 o; o.x = pk_bf16(A.o[db][0] * inv, A.o[db][1] * inv); o.y = pk_bf16(A.o[db][2] * inv, A.o[db][3] * inv);
            *(uint2*)(op + 16 * db) = o; }
        int nnew = 0;
        uint4 nk0 = make_uint4(0u, 0u, 0u, 0u), nv0 = nk0, nk1 = nk0, nv1 = nk0;
        if (it < 3) { nnew = min(max(rq0 + 2 * it + 3 - 4, 0), 24) + 7 - rmax;
            if (nnew > 0) { nk0 = *(const uint4*)(gk + (size_t)(rmax + 1) * 64 * ZP); nv0 = *(const uint4*)(gv + (rmax + 1) * 64); }
            if (nnew > 1) { nk1 = *(const uint4*)(gk + (size_t)(rmax + 2) * 64 * ZP); nv1 = *(const uint4*)(gv + (rmax + 2) * 64); } }
        __syncthreads();
        if (nnew > 0) { LAS unsigned char* sb_ = lds + ((rmax + 1) % 9) * NAR_SLOT; *(LAS u32x4*)(sb_ + lk) = (u32x4){nk0.x, nk0.y, nk0.z, nk0.w}; *(LAS u32x4*)(sb_ + lv) = (u32x4){nv0.x, nv0.y, nv0.z, nv0.w}; }
        if (nnew > 1) { LAS unsigned char* sb_ = lds + ((rmax + 2) % 9) * NAR_SLOT; *(LAS u32x4*)(sb_ + lk) = (u32x4){nk1.x, nk1.y, nk1.z, nk1.w}; *(LAS u32x4*)(sb_ + lv) = (u32x4){nv1.x, nv1.y, nv1.z, nv1.w}; }
        rmax += nnew;
        __syncthreads();
    }
#undef NAR_FENCE
}
__device__ __forceinline__ int hg_row(int b, int dir, int s) { return s < 256 ? (NLAT + b * 256 + (dir ? 255 - s : s)) : (b * 2048 + (dir ? 2047 - (s - 256) : (s - 256))); }
__device__ __forceinline__ bf16x8 tr2(const LAS unsigned char* p0, const LAS unsigned char* p1) {
    typedef short v4i16_t __attribute__((ext_vector_type(4)));
    const v4i16_t a = __builtin_amdgcn_ds_read_tr16_b64_v4i16((LAS v4i16_t*)p0), c = __builtin_amdgcn_ds_read_tr16_b64_v4i16((LAS v4i16_t*)p1);
    return (bf16x8){a[0], a[1], a[2], a[3], c[0], c[1], c[2], c[3]};
}
__device__ __forceinline__ void hgrn_unit(const Params& P, LAS unsigned char* lds, int l, int u) {
    const int tid = tid_(), lane = tid & 63, wid = __builtin_amdgcn_readfirstlane(tid >> 6), c16 = lane & 15, kq = lane >> 4;
    const int b = u >> 3, h = (u >> 1) & 3, dir = u & 1;
    const bf16_t* z = (const bf16_t*)(P.ws + WS_Z);
    float* O = (float*)(P.ws + (dir ? WS_Y : WS_H));
    const float* lbv = (const float*)(P.ws + WS_LB) + ((size_t)l * 2 + dir) * 512 + h * 128;
    constexpr int PQ = 272;
    LAS unsigned char* QH = lds; LAS unsigned char* KT = lds + 8704; LAS unsigned char* KH = lds + 17408; LAS unsigned char* VV = lds + 26112;
    LAS float* DL = (LAS float*)(lds + 34816); LAS float* WT = DL + 128;
    const int ch = 2 * lane;
    const float lb0 = lbv[ch], lb1 = lbv[ch + 1];
    const int cf = (dir ? C_HFB : C_HFF) + h * 128 + ch, cq = C_HQ + h * 128 + ch, cv = C_HI + h * 128 + ch;
    f32x4 SA[4], SB[4];
#pragma unroll
    for (int G = 0; G < 4; ++G) { SA[G] = (f32x4){0.f, 0.f, 0.f, 0.f}; SB[G] = (f32x4){0.f, 0.f, 0.f, 0.f}; }
    unsigned rf[4], rq[4], rv[4];
#pragma unroll
    for (int k = 0; k < 4; ++k) { const bf16_t* zr = z + (size_t)hg_row(b, dir, 4 * wid + k) * ZP; rf[k] = *(const unsigned*)(zr + cf); rq[k] = *(const unsigned*)(zr + cq); rv[k] = *(const unsigned*)(zr + cv); }
    const int sA = 8 * (c16 >> 2) + (c16 & 3);
    const int tq = c16 >> 2, tp = c16 & 3;
    for (int st = 0; st < 72; ++st) {
        unsigned xf[4], xq[4], xv[4];
#pragma unroll
        for (int k = 0; k < 4; ++k) { xf[k] = rf[k]; xq[k] = rq[k]; xv[k] = rv[k]; }
        if (st + 1 < 72) {
#pragma unroll
            for (int k = 0; k < 4; ++k) { const bf16_t* zr = z + (size_t)hg_row(b, dir, (st + 1) * 32 + 4 * wid + k) * ZP; rf[k] = *(const unsigned*)(zr + cf); rq[k] = *(const unsigned*)(zr + cq); rv[k] = *(const unsigned*)(zr + cv); }
        }
        float g0[4], g1[4], k0[4], k1[4], q0[4], q1[4];
        float c0 = 1.f, c1 = 1.f;
#pragma unroll
        for (int k = 0; k < 4; ++k) {
            const float f0 = lb0 + (1.0f - lb0) * sigmoidf_(bf_lo(xf[k])), f1 = lb1 + (1.0f - lb1) * sigmoidf_(bf_hi(xf[k]));
            c0 *= f0; c1 *= f1; g0[k] = c0; g1[k] = c1;
            k0[k] = 1.0f - f0; k1[k] = 1.0f - f1; q0[k] = siluf_(bf_lo(xq[k])); q1[k] = siluf_(bf_hi(xq[k]));
        }
        WT[wid * 128 + ch] = c0; WT[wid * 128 + ch + 1] = c1;
        __syncthreads();
        float pre0 = 1.f, pre1 = 1.f, tot0 = 1.f, tot1 = 1.f;
#pragma unroll
        for (int w = 0; w < 8; ++w) { const float a0 = WT[w * 128 + ch], a1 = WT[w * 128 + ch + 1]; tot0 *= a0; tot1 *= a1; if (w < wid) { pre0 *= a0; pre1 *= a1; } }
#pragma unroll
        for (int k = 0; k < 4; ++k) {
            const float e0 = g0[k] * pre0, e1 = g1[k] * pre1;
            const float r0 = __builtin_amdgcn_rcpf(e0), r1 = __builtin_amdgcn_rcpf(e1);
            const float kt0 = k0[k] * r0, kt1 = k1[k] * r1;
            const int ro = (4 * wid + k) * PQ + ch * 2;
            *(LAS unsigned*)(QH + ro) = pk_bf16(q0[k] * e0, q1[k] * e1);
            *(LAS unsigned*)(KT + ro) = pk_bf16(kt0, kt1);
            *(LAS unsigned*)(KH + ro) = pk_bf16(kt0 * tot0, kt1 * tot1);
            *(LAS unsigned*)(VV + ro) = xv[k];
        }
        if (wid == 0) { DL[ch] = tot0; DL[ch + 1] = tot1; }
        __syncthreads();
        const bf16x8 vfr = tr2(VV + (8 * kq + tq) * PQ + (16 * wid + 4 * tp) * 2, VV + (8 * kq + 4 + tq) * PQ + (16 * wid + 4 * tp) * 2);
        bf16x8 Sb[4];
#pragma unroll
        for (int G = 0; G < 4; ++G) { const float sv[8] = {SA[G][0], SA[G][1], SA[G][2], SA[G][3], SB[G][0], SB[G][1], SB[G][2], SB[G][3]}; Sb[G] = pack8(sv); }
#pragma unroll
        for (int T = 0; T < 2; ++T) {
            f32x4 aA = {0.f, 0.f, 0.f, 0.f}, aB = {0.f, 0.f, 0.f, 0.f};
            bf16x8 qf[4];
#pragma unroll
            for (int ks = 0; ks < 4; ++ks) {
                const bf16x8 kA = *(const LAS bf16x8*)(KT + sA * PQ + (32 * ks + 8 * kq) * 2);
                const bf16x8 kB = *(const LAS bf16x8*)(KT + (sA + 4) * PQ + (32 * ks + 8 * kq) * 2);
                qf[ks] = *(const LAS bf16x8*)(QH + (16 * T + c16) * PQ + (32 * ks + 8 * kq) * 2);
                aA = __builtin_amdgcn_mfma_f32_16x16x32_bf16(kA, qf[ks], aA, 0, 0, 0);
                aB = __builtin_amdgcn_mfma_f32_16x16x32_bf16(kB, qf[ks], aB, 0, 0, 0);
            }
            const int t = 16 * T + c16;
            float pv_[8];
#pragma unroll
            for (int jj = 0; jj < 4; ++jj) { pv_[jj] = (8 * kq + jj <= t) ? aA[jj] : 0.f; pv_[4 + jj] = (8 * kq + 4 + jj <= t) ? aB[jj] : 0.f; }
            f32x4 o = {0.f, 0.f, 0.f, 0.f};
            o = __builtin_amdgcn_mfma_f32_16x16x32_bf16(pack8(pv_), vfr, o, 0, 0, 0);
#pragma unroll
            for (int ks = 0; ks < 4; ++ks) o = __builtin_amdgcn_mfma_f32_16x16x32_bf16(qf[ks], Sb[ks], o, 0, 0, 0);
#pragma unroll
            for (int jj = 0; jj < 4; ++jj) O[(size_t)hg_row(b, dir, st * 32 + 16 * T + 4 * kq + jj) * 512 + h * 128 + 16 * wid + c16] = o[jj];
        }
#pragma unroll
        for (int G = 0; G < 4; ++G) {
            const f32x4 d0 = *(const LAS f32x4*)(DL + 32 * G + 8 * kq), d1 = *(const LAS f32x4*)(DL + 32 * G + 8 * kq + 4);
            const LAS unsigned char* ka = KH + (8 * kq + tq) * PQ + (32 * G + 8 * tp) * 2;
            const bf16x8 hA = tr2(ka, ka + 4 * PQ), hB = tr2(ka + 8, ka + 4 * PQ + 8);
            SA[G] = __builtin_amdgcn_mfma_f32_16x16x32_bf16(hA, vfr, SA[G] * d0, 0, 0, 0);
            SB[G] = __builtin_amdgcn_mfma_f32_16x16x32_bf16(hB, vfr, SB[G] * d1, 0, 0, 0);
        }
    }
    __syncthreads();
}
__device__ __forceinline__ void gqa_unit(const Params& P, char* shm, int l, int U) {
    const bf16_t* z = (const bf16_t*)(P.ws + WS_Z); const bf16_t* kn = (const bf16_t*)(P.ws + WS_KN); const bf16_t* vn = (const bf16_t*)(P.ws + WS_VN);
    bf16_t* br = (bf16_t*)(P.ws + WS_BR);
    int b, hq, row0, NT;
    if (U < 512) { const int bg = U >> 5; b = bg >> 1; hq = (bg & 1) * 4 + ((U & 31) >> 3); row0 = b * 2048 + (U & 7) * 256; NT = 36; }
    else { const int v = U - 512; b = v >> 3; hq = v & 7; row0 = NLAT + b * 256; NT = 4; }
    const int g = hq >> 2;
    gqa::attn_unit<8>(z + (size_t)row0 * ZP + C_GQ + hq * 64, P.in[I_QNG] + l * 64, (const float*)(P.ws + WS_ROPE), (U < 512) ? ((U & 7) * 256) : -1,
                      kn + (size_t)b * 2304 * 128 + g * 64, vn + (size_t)b * 2304 * 128 + g * 64, br + (size_t)row0 * BRW + 1024 + hq * 64, NT, shm);
}
__device__ __forceinline__ void ph_mix(const Params& P, LAS unsigned char* lds, char* shm, int l, int pass = 0, int filter = 0) {
    const int tid = tid_();
    unsigned* qctr = (unsigned*)(P.ws + WS_CNT + 512) + l + 4 * pass;
    volatile LAS unsigned* qslot = (volatile LAS unsigned*)(lds + LDS_BYTES - 32);
    bool first = true;
    for (;;) {
        if (tid == 0) *qslot = first ? (unsigned)bid_() : (unsigned)gridDim.x + __hip_atomic_fetch_add(qctr, 1u, __ATOMIC_RELAXED, __HIP_MEMORY_SCOPE_AGENT);
        first = false;
        __syncthreads();
        const int u = (int)*qslot;
        __syncthreads();
        if (u >= 960) break;
        const int kind = (u < 64) ? 2 : ((u >= 64 && u < 320) || (u >= 832 && u < 896)) ? 3 : 1;
        if (filter != 0 && filter != kind) continue;
        if (u < 64) hgrn_unit(P, lds, l, u);
        else if (u < 320) na_unit_lat(P, lds, l, u - 64, (bf16_t*)(P.ws + WS_BR), BRW);
        else if (u < 832) gqa_unit(P, shm, l, u - 320);
        else if (u < 896) { if (l < DEPTH - 1) na_unit(P, lds, l, 256 + (u - 832), (bf16_t*)(P.ws + WS_BR), BRW); }
        else { if (l < DEPTH - 1) gqa_unit(P, shm, l, 512 + (u - 896)); }
        __syncthreads();
    }
}
#ifdef DIAG
__device__ __forceinline__ void ph_diag_cmp(const Params& P) {
    const bf16_t* br = (const bf16_t*)(P.ws + WS_BR); const bf16_t* d1 = (const bf16_t*)(P.ws + WS_END); const bf16_t* d2 = d1 + (size_t)NTOK * 512;
    const bf16_t* z = (const bf16_t*)(P.ws + WS_Z); const bf16_t* vt = (const bf16_t*)(P.ws + WS_NAVT);
    unsigned* dg = (unsigned*)(P.ws + 20480);
    unsigned c1 = 0, c2 = 0, c3 = 0;
    for (size_t i = (size_t)bid_() * NTHR + tid_(); i < (size_t)NTOK * 512; i += (size_t)gridDim.x * NTHR) {
        const size_t r = i >> 9; const int c = (int)(i & 511);
        const float a = bf2f(br[r * BRW + c]), x = bf2f(d1[i]);
        if (!(fabsf(x - a) <= 0.004f + 0.02f * fabsf(a))) ++c1;
        if (DIAG != 4 && d1[i] != d2[i]) ++c3;
        const int rr = (int)r; const int bb = rr < NLAT ? (rr >> 11) : ((rr - NLAT) >> 8); const int tok = rr < NLAT ? (256 + (rr & 2047)) : ((rr - NLAT) & 255);
        if (vt[((size_t)(bb * 8 + (c >> 6)) * 64 + (c & 63)) * 2304 + tok] != z[r * ZP + C_NAV + c]) ++c2;
    }
    if (c1) atomicAdd(dg + 1, c1);
    if (c2) atomicAdd(dg + 2, c2);
    if (c3) atomicAdd(dg + 3, c3);
}
__device__ __forceinline__ void ph_diag_out(const Params& P) {
    const volatile unsigned* dg = (const volatile unsigned*)(P.ws + 20480);
    const unsigned c1 = dg[1], c2 = dg[2], c3 = dg[3];
    if ((c1 | c2 | c3) == 0) return;
    unsigned k = 0; { unsigned v = c1; while (v) { ++k; v >>= 1; } }
    if (c2) k += 30; if (c3) k += 60;
    const float cst = sqrtf(10.0f * (float)k + 9.0f);
    for (size_t i = (size_t)bid_() * NTHR + tid_(); i < (size_t)NLAT * D; i += (size_t)gridDim.x * NTHR) P.out[i] = cst;
}
#endif

__device__ __forceinline__ void ph_readout(const Params& P, int l) {
    const int tid = tid_(), lane = tid & 63, wid = tid >> 6;
    const float* OF = (const float*)(P.ws + WS_H); const float* OB = (const float*)(P.ws + WS_Y);
    const bf16_t* z = (const bf16_t*)(P.ws + WS_Z);
    bf16_t* br = (bf16_t*)(P.ws + WS_BR);
    const float g0 = P.in[I_HGN][l * 128 + lane * 2], g1 = P.in[I_HGN][l * 128 + lane * 2 + 1];
    const int rstep = gridDim.x * 8;
    for (int r0 = bid_() * 8 + wid; r0 < NTOK; r0 += 3 * rstep) {
        float2 a[3][4], bb[3][4]; unsigned gz[3][4];
#pragma unroll
        for (int q = 0; q < 3; ++q) { const int r = (r0 + q * rstep < NTOK) ? r0 + q * rstep : r0;
#pragma unroll
            for (int h = 0; h < 4; ++h) { const int c = h * 128 + lane * 2;
                a[q][h] = *(const float2*)(OF + (size_t)r * 512 + c); bb[q][h] = *(const float2*)(OB + (size_t)r * 512 + c);
                gz[q][h] = *(const unsigned*)(z + (size_t)r * ZP + C_HG + c); } }
#pragma unroll
        for (int q = 0; q < 3; ++q) { const int r = r0 + q * rstep;
            if (r < NTOK) {
#pragma unroll
                for (int h = 0; h < 4; ++h) { const int c = h * 128 + lane * 2;
                    const float o0 = a[q][h].x + bb[q][h].x, o1 = a[q][h].y + bb[q][h].y;
                    const float ss = wave_sum(o0 * o0 + o1 * o1);
                    const float rstd = __builtin_amdgcn_rsqf(ss * (1.0f / 128.0f) + 1e-6f);
                    *(unsigned*)(br + (size_t)r * BRW + 512 + c) = pk_bf16(o0 * rstd * g0 * siluf_(bf_lo(gz[q][h])), o1 * rstd * g1 * siluf_(bf_hi(gz[q][h]))); } } }
    }
}
struct SchedMerge { int G, c; const char* br; const char* wb; bool last;
    __device__ __forceinline__ bool next(int i, pg8::Unit& u) const {
        const int nl = (c < 256) ? (256 - c + G - 1) / G : 0;
        int tile, bi, mode;
        if (i < 3 * nl) { tile = c + (i / 3) * G; bi = i % 3; mode = 0; }
        else { if (last) return false; const int sidx = c + (i - 3 * nl) * G; if (sidx >= 96) return false; tile = 256 + sidx / 3; bi = sidx % 3; mode = 1; }
        const int pm = tile >> 2, pn = tile & 3;
        u.row0 = pm * 256; u.col0 = pn * 256; u.aux = bi | (mode << 4);
        u.A = br + ((size_t)pm * 256 * BRW + bi * 512) * 2; u.B = wb + ((size_t)bi * 1024 + pn * 256) * 512 * 2; return true; } };
struct EpiMerge { const bf16_t* GT; bf16_t* YP; bf16_t* Y; bf16_t* PG;
    __device__ __forceinline__ void operator()(const f32x4 (&acc)[2][2][4][2], const pg8::Unit& u, int wr, int wc, int fr, int fq) const {
        const int tidx = (wr * 4 + wc) * 64 + fq * 16 + fr, bi = u.aux & 15, mode = u.aux >> 4, pm = u.row0 >> 8, pn = u.col0 >> 8;
        const unsigned char* gb = (const unsigned char*)GT + ((size_t)pm * 12 + bi * 4 + pn) * 65536 + tidx * 8;
        if (mode == 1) {
            bf16_t* pb = PG + ((size_t)bi * 32 + (pm - 64) * 4 + pn) * 65536 + tidx * 8;
#pragma unroll
            for (int ai = 0; ai < 2; ++ai)
#pragma unroll
                for (int bj = 0; bj < 2; ++bj) {
                    uint2 g[4];
#pragma unroll
                    for (int m = 0; m < 4; ++m) g[m] = *(const uint2*)(gb + ((ai * 2 + bj) * 4 + m) * 4096);
#pragma unroll
                    for (int m = 0; m < 4; ++m) { const f32x4 v0 = acc[ai][bj][m][0], v1 = acc[ai][bj][m][1];
                        uint4 o; o.x = pk_bf16(gq8(g[m], 0) * v0[0], gq8(g[m], 1) * v0[1]); o.y = pk_bf16(gq8(g[m], 2) * v0[2], gq8(g[m], 3) * v0[3]);
                        o.z = pk_bf16(gq8(g[m], 4) * v1[0], gq8(g[m], 5) * v1[1]); o.w = pk_bf16(gq8(g[m], 6) * v1[2], gq8(g[m], 7) * v1[3]);
                        *(uint4*)(pb + ((ai * 2 + bj) * 4 + m) * 4096) = o; }
                }
            return;
        }
        bf16_t* yb = YP + ((size_t)pm * 4 + pn) * 65536 + tidx * 8;
#pragma unroll
        for (int ai = 0; ai < 2; ++ai)
#pragma unroll
            for (int bj = 0; bj < 2; ++bj) {
                uint2 g[4]; uint4 p[4];
#pragma unroll
                for (int m = 0; m < 4; ++m) g[m] = *(const uint2*)(gb + ((ai * 2 + bj) * 4 + m) * 4096);
                if (bi != 0) {
#pragma unroll
                    for (int m = 0; m < 4; ++m) p[m] = *(const uint4*)(yb + ((ai * 2 + bj) * 4 + m) * 4096);
                } else {
#pragma unroll
                    for (int m = 0; m < 4; ++m) p[m] = make_uint4(0u, 0u, 0u, 0u);
                }
#pragma unroll
                for (int m = 0; m < 4; ++m) { const int k = ((ai * 2 + bj) * 4 + m) * 4096;
                    const f32x4 v0 = acc[ai][bj][m][0], v1 = acc[ai][bj][m][1];
                    const float t[8] = {bf_lo(p[m].x) + gq8(g[m], 0) * v0[0], bf_hi(p[m].x) + gq8(g[m], 1) * v0[1], bf_lo(p[m].y) + gq8(g[m], 2) * v0[2], bf_hi(p[m].y) + gq8(g[m], 3) * v0[3],
                                        bf_lo(p[m].z) + gq8(g[m], 4) * v1[0], bf_hi(p[m].z) + gq8(g[m], 5) * v1[1], bf_lo(p[m].w) + gq8(g[m], 6) * v1[2], bf_hi(p[m].w) + gq8(g[m], 7) * v1[3]};
                    if (bi != 2) { uint4 o; o.x = pk_bf16(t[0], t[1]); o.y = pk_bf16(t[2], t[3]); o.z = pk_bf16(t[4], t[5]); o.w = pk_bf16(t[6], t[7]); *(uint4*)(yb + k) = o; }
                    else { const int row = u.row0 + ai * 128 + wr * 64 + m * 16 + fr, col = u.col0 + bj * 128 + wc * 32 + 8 * fq;
                        uint4 o; o.x = pk_bf16(t[0], t[1]); o.y = pk_bf16(t[2], t[3]); o.z = pk_bf16(t[4], t[5]); o.w = pk_bf16(t[6], t[7]);
                        *(uint4*)(Y + (size_t)row * D + col) = o; }
                }
            }
    } };
__device__ __forceinline__ void ph_merge(const Params& P, LAS unsigned char* lds, int l) {
    const int G_ = (int)gridDim.x, cx = (G_ % 8 == 0) ? ((int)bid_() % 8) * (G_ / 8) + (int)bid_() / 8 : (int)bid_();
    SchedMerge S{G_, cx, (const char*)(P.ws + WS_BR), (const char*)(P.ws + WS_WBR), l == DEPTH - 1};
    EpiMerge E{(const bf16_t*)(P.ws + WS_GT), (bf16_t*)(P.ws + WS_H), (bf16_t*)(P.ws + WS_Y), (bf16_t*)(P.ws + WS_PG)};
    pg8::gemm_phase(lds, pg8::Gemm{512, BRW, 512}, S, E);
    if (l + 1 < DEPTH && cx >= 96) wconv_range(P, lds, l + 1, 0, 16 * 124, cx - 96, G_ - 96);
    if (l == DEPTH - 1) wconv_range(P, lds, l, CONV_T_DENSE + 16 * 16 * 16, CONV_T_ALL, cx, G_);
    else if (cx >= 96) wconv_range(P, lds, l, CONV_T_DENSE + 16 * 16 * 16, CONV_T_ALL, cx - 96, G_ - 96);
}
struct EpiDelta { bf16_t* DX; const float* mods; int l;
    __device__ __forceinline__ void operator()(const f32x4 (&acc)[2][2][4][2], const pg8::Unit& u, int wr, int wc, int fr, int fq) const {
        const float* gate = mods + ((size_t)l * 9 + row_modrow(u.row0)) * 6144 + 2 * 1024 + u.col0 + wc * 32 + 8 * fq;
        f32x4 gv[2][2];
#pragma unroll
        for (int bj = 0; bj < 2; ++bj)
#pragma unroll
            for (int n = 0; n < 2; ++n) gv[bj][n] = *(const f32x4*)(gate + bj * 128 + n * 4);
#pragma unroll
        for (int ai = 0; ai < 2; ++ai)
#pragma unroll
            for (int m = 0; m < 4; ++m)
#pragma unroll
                for (int bj = 0; bj < 2; ++bj) { const int row = u.row0 + ai * 128 + wr * 64 + m * 16 + fr, col = u.col0 + bj * 128 + wc * 32 + 8 * fq;
                    const f32x4 v0 = acc[ai][bj][m][0] * gv[bj][0], v1 = acc[ai][bj][m][1] * gv[bj][1];
                    uint4 o; o.x = pk_bf16(v0[0], v0[1]); o.y = pk_bf16(v0[2], v0[3]); o.z = pk_bf16(v1[0], v1[1]); o.w = pk_bf16(v1[2], v1[3]);
                    *(uint4*)(DX + (size_t)row * D + col) = o; }
    } };
struct SchedWout { int G, c; const char* A; const char* B; bool last;
    __device__ __forceinline__ bool next(int i, pg8::Unit& u) const {
        int tile;
        if (last) { tile = c + i * G; if (tile >= 256) return false; }
        else if (G != 256) { const int nc = (c < 32) ? 1 : 0; if (i < nc) tile = 256 + c; else { tile = c + (i - nc) * G; if (tile >= 256) return false; } }
        else { const int nc = (c < 32) ? 1 : 0; if (i < nc) tile = 256 + c; else { tile = c + (i - nc) * G; if (tile >= 256) return false; } }
        const int pm = tile >> 2, pn = tile & 3;
        u.row0 = pm * 256; u.col0 = pn * 256; u.aux = 0; u.A = A + (size_t)pm * 256 * D * 2; u.B = B + (size_t)pn * 256 * D * 2; return true; } };
__device__ __forceinline__ void ph_wout(const Params& P, LAS unsigned char* lds, int l, bool dry = false) {
    const bool last = (l == DEPTH - 1);
    const int c = ((int)gridDim.x % 8 == 0) ? ((int)bid_() % 8) * ((int)gridDim.x / 8) + (int)bid_() / 8 : (int)bid_();
    if (!last && c < 32) {
        const int tid = tid_(), wid = tid >> 6, lane = tid & 63, wr = wid >> 2, wc = wid & 3, fr = lane & 15, fq = lane >> 4;
        const bf16_t* PG = (const bf16_t*)(P.ws + WS_PG); bf16_t* Y = (bf16_t*)(P.ws + WS_Y);
        const int pp = c >> 2;
        for (int pn = 0; pn < 4; ++pn)
#pragma unroll
            for (int kk = 0; kk < 16; ++kk) {
                const size_t off = ((size_t)pp * 4 + pn) * 65536 + kk * 4096 + tid * 8;
                const uint4 a = *(const uint4*)(PG + off), b = *(const uint4*)(PG + (size_t)32 * 65536 + off), d = *(const uint4*)(PG + (size_t)64 * 65536 + off);
                const int ai = kk >> 3, bj = (kk >> 2) & 1, m = kk & 3;
                const int row = (64 + pp) * 256 + ai * 128 + wr * 64 + m * 16 + fr, col = pn * 256 + bj * 128 + wc * 32 + 8 * fq;
                uint4 o;
                o.x = pk_bf16(bf_lo(a.x) + bf_lo(b.x) + bf_lo(d.x), bf_hi(a.x) + bf_hi(b.x) + bf_hi(d.x)); o.y = pk_bf16(bf_lo(a.y) + bf_lo(b.y) + bf_lo(d.y), bf_hi(a.y) + bf_hi(b.y) + bf_hi(d.y));
                o.z = pk_bf16(bf_lo(a.z) + bf_lo(b.z) + bf_lo(d.z), bf_hi(a.z) + bf_hi(b.z) + bf_hi(d.z)); o.w = pk_bf16(bf_lo(a.w) + bf_lo(b.w) + bf_lo(d.w), bf_hi(a.w) + bf_hi(b.w) + bf_hi(d.w));
                *(uint4*)(Y + (size_t)row * D + col) = o;
            }
        asm volatile("s_waitcnt vmcnt(0)" ::: "memory");
        __syncthreads();
    }
    SchedWout S{(int)gridDim.x, c, (const char*)(P.ws + WS_Y), (const char*)(P.ws + WS_WOUT), last};
    EpiDelta E{(bf16_t*)(P.ws + (dry ? WS_END : WS_BR)), (const float*)(P.ws + WS_MODS), l};
    pg8::gemm_phase(lds, pg8::Gemm{D, D, D}, S, E);
    if (!dry) { const int G_ = (int)gridDim.x;
        constexpr int GU_END = CONV_T_DENSE + 16 * 16 * 16;
        if (last) wconv_range(P, lds, l, CONV_T_DENSE, GU_END, c, G_);
        else if (c >= 32) wconv_range(P, lds, l, CONV_T_DENSE, GU_END, c - 32, G_ - 32); }
}
__device__ __forceinline__ void ph_norm2_route(const Params& P, LAS unsigned char* lds, int l, bool dry = false) {
    const int tid = tid_(), lane = tid & 63, wid = tid >> 6;
    LAS float* Wt = (LAS float*)lds;
    LAS int* lcnt = (LAS int*)(lds + 81920); LAS int* lbase = lcnt + 16; LAS int* rinfo = lbase + 16;
    LAS float* rw = (LAS float*)(rinfo + 128 * 4); LAS float* rlog = rw + 256;
    { const f32x4* rt4 = (const f32x4*)((const float*)(P.ws + WS_RT) + (size_t)l * 20480);
      for (int i = tid; i < 5 * 1024; i += NTHR) *(LAS f32x4*)(Wt + i * 4) = rt4[i]; }
    if (tid < 16) lcnt[tid] = 0;
    __syncthreads();
    const float* xres = (const float*)(P.ws + WS_X);
    const bf16_t* dx = (const bf16_t*)(P.ws + WS_BR);
    bf16_t* f = (bf16_t*)(P.ws + (dry ? WS_END : WS_H));
    const float* g = P.in[I_GFFN] + l * 1024;
    int* cnt = (int*)(P.ws + (dry ? 32768 : WS_CNT)) + l * 16;
    int* inv = (int*)(P.ws + WS_INV);
    int* sel_e = (int*)(P.ws + (dry ? WS_END + 40000000 : WS_SELE)); float* sel_w = (float*)(P.ws + (dry ? WS_END + 41000000 : WS_SELW)); int* sel_p = (int*)(P.ws + (dry ? WS_END + 42000000 : WS_SELP));
    const int NR = (l == DEPTH - 1) ? NLAT : NTOK;
    const int RPW = (NR + 8 * (int)gridDim.x - 1) / (8 * (int)gridDim.x);
    const int widu = __builtin_amdgcn_readfirstlane(wid);
    const int r0 = bid_() * 8 * RPW;
    const float* modl = (const float*)(P.ws + WS_MODS) + (size_t)l * 9 * 6144;
    int cm = -1;
    f32x4 gsc[4], shv[4];
    for (int k = 0; k < RPW; k += 3) {
        const int slotA = widu * RPW + k, rA = r0 + slotA;
        if (rA >= NR) break;
        int nv = RPW - k; if (nv > 3) nv = 3; if (nv > NR - rA) nv = NR - rA;
        f32x4 x[3][4];
#pragma unroll
        for (int q = 0; q < 3; ++q) {
            const int r = rA + (q < nv ? q : 0);
#pragma unroll
            for (int i = 0; i < 4; ++i) { f32x4 v = *(const f32x4*)(xrow(P, l, r) + lane * 4 + 256 * i);
                const uint2 dv = *(const uint2*)(dx + (size_t)r * D + lane * 4 + 256 * i);
                v[0] += bf_lo(dv.x); v[1] += bf_hi(dv.x); v[2] += bf_lo(dv.y); v[3] += bf_hi(dv.y); x[q][i] = v; }
        }
#pragma unroll
        for (int q = 0; q < 3; ++q) {
            const int r = rA + (q < nv ? q : 0);
            float ss = 0.f;
#pragma unroll
            for (int i = 0; i < 4; ++i) ss += x[q][i][0] * x[q][i][0] + x[q][i][1] * x[q][i][1] + x[q][i][2] * x[q][i][2] + x[q][i][3] * x[q][i][3];
            ss = wave_sum(ss);
            const float rstd = __builtin_amdgcn_rsqf(ss * (1.0f / 1024.0f) + 1e-6f);
            const int mr = row_modrow(r);
            if (mr != cm) {
                cm = mr;
                const float* mod = modl + (size_t)mr * 6144;
#pragma unroll
                for (int i = 0; i < 4; ++i) { const int c = lane * 4 + 256 * i;
                    const f32x4 gv = *(const f32x4*)(g + c), sc = *(const f32x4*)(mod + 4 * 1024 + c);
                    gsc[i] = gv * (1.0f + sc); shv[i] = *(const f32x4*)(mod + 3 * 1024 + c); }
            }
#pragma unroll
            for (int i = 0; i < 4; ++i) x[q][i] = x[q][i] * rstd * gsc[i] + shv[i];
            if (q < nv) {
#pragma unroll
                for (int i = 0; i < 4; ++i) { uint2 u; u.x = pk_bf16(x[q][i][0], x[q][i][1]); u.y = pk_bf16(x[q][i][2], x[q][i][3]); *(uint2*)(f + (size_t)r * D + lane * 4 + 256 * i) = u; }
            }
        }
#pragma unroll
        for (int jb = 0; jb < 5; ++jb) {
            pkf32x2_t s[3][4];
#pragma unroll
            for (int jj = 0; jj < 4; ++jj) {
                f32x4 w[4];
#pragma unroll
                for (int i = 0; i < 4; ++i) w[i] = *(const LAS f32x4*)(Wt + (jb * 4 + jj) * 1024 + lane * 4 + 256 * i);
#pragma unroll
                for (int q = 0; q < 3; ++q) { pkf32x2_t a = {0.f, 0.f};
#pragma unroll
                    for (int i = 0; i < 4; ++i) { a += x[q][i].lo * w[i].lo; a += x[q][i].hi * w[i].hi; }
                    s[q][jj] = a; }
            }
#pragma unroll
            for (int q = 0; q < 3; ++q) {
                const float a0 = s[q][0][0] + s[q][0][1], a1 = s[q][1][0] + s[q][1][1], a2 = s[q][2][0] + s[q][2][1], a3 = s[q][3][0] + s[q][3][1];
                auto r1 = __builtin_amdgcn_permlane32_swap(__float_as_uint(a0), __float_as_uint(a1), false, false);
                auto r2 = __builtin_amdgcn_permlane32_swap(__float_as_uint(a2), __float_as_uint(a3), false, false);
                const float c1 = __uint_as_float(r1[0]) + __uint_as_float(r1[1]), c2 = __uint_as_float(r2[0]) + __uint_as_float(r2[1]);
                auto r3 = __builtin_amdgcn_permlane16_swap(__float_as_uint(c1), __float_as_uint(c2), false, false);
                float e = __uint_as_float(r3[0]) + __uint_as_float(r3[1]);
                e += dpp_f(e, 0); e += dpp_f(e, 1); e += dpp_f(e, 2); e += dpp_f(e, 3);
                if ((lane & 15) == 0 && q < nv) { const int gq = lane >> 4; rlog[(slotA + q) * 20 + jb * 4 + ((gq & 1) << 1 | (gq >> 1))] = e; }
            }
        }
    }
    __syncthreads();
    for (int slot = tid; slot < 128; slot += NTHR) {
        const int r = r0 + slot;
        if (slot < 8 * RPW && r < NR) {
            float lg[20];
#pragma unroll
            for (int j = 0; j < 20; ++j) lg[j] = rlog[slot * 20 + j];
            float gl[4]; int gi = 0;
#pragma unroll
            for (int j = 0; j < 4; ++j) gl[j] = lg[j] + P.in[I_BGR][l * 4 + j];
            float gm = gl[0];
#pragma unroll
            for (int j = 1; j < 4; ++j) if (gl[j] > gm) { gm = gl[j]; gi = j; }
            float se = 0.f;
#pragma unroll
            for (int j = 0; j < 4; ++j) se += __expf(gl[j] - gm);
            const float pg = __builtin_amdgcn_rcpf(se);
            float el[4];
#pragma unroll
            for (int j = 0; j < 4; ++j) {
                float v = 0.f;
#pragma unroll
                for (int q = 0; q < 4; ++q) v = (gi == q) ? lg[4 + q * 4 + j] : v;
                el[j] = v + P.in[I_BER][l * 16 + gi * 4 + j];
            }
            int i0 = 0; float v0 = el[0];
#pragma unroll
            for (int j = 1; j < 4; ++j) if (el[j] > v0) { v0 = el[j]; i0 = j; }
            int i1 = -1; float v1 = -INFINITY;
#pragma unroll
            for (int j = 0; j < 4; ++j) if (j != i0 && el[j] > v1) { v1 = el[j]; i1 = j; }
            const float w0 = __builtin_amdgcn_rcpf(1.0f + __expf(v1 - v0)), w1 = 1.0f - w0;
            const int e0 = gi * 4 + i0, e1 = gi * 4 + i1;
            rinfo[slot * 4 + 0] = e0 | (e1 << 8);
            rinfo[slot * 4 + 1] = __hip_atomic_fetch_add(&lcnt[e0], 1, __ATOMIC_RELAXED, __HIP_MEMORY_SCOPE_WORKGROUP);
            rinfo[slot * 4 + 2] = __hip_atomic_fetch_add(&lcnt[e1], 1, __ATOMIC_RELAXED, __HIP_MEMORY_SCOPE_WORKGROUP);
            rw[slot * 2] = w0 * pg; rw[slot * 2 + 1] = w1 * pg;
        }
    }
    __syncthreads();
    if (tid < 16) lbase[tid] = atomicAdd(&cnt[tid], lcnt[tid]);
    __syncthreads();
    for (int slot = tid; slot < 128; slot += NTHR) {
        const int r = r0 + slot;
        if (slot < 8 * RPW && r < NR) { const int ee = rinfo[slot * 4], e0 = ee & 255, e1 = ee >> 8;
            sel_e[r * 2] = e0; sel_e[r * 2 + 1] = e1;
            sel_w[r * 2] = rw[slot * 2]; sel_w[r * 2 + 1] = rw[slot * 2 + 1];
            const int p0_ = lbase[e0] + rinfo[slot * 4 + 1], p1_ = lbase[e1] + rinfo[slot * 4 + 2];
            sel_p[r * 2] = p0_; sel_p[r * 2 + 1] = p1_;
            if (!dry) { inv[(size_t)e0 * NTOK + p0_] = r; inv[(size_t)e1 * NTOK + p1_] = r; } }
    }
    __syncthreads();
}
__device__ __forceinline__ void moe_offsets(const int* cnt, int (&off)[17]) {
    int a = 0;
#pragma unroll
    for (int e = 0; e < 16; ++e) { off[e] = a; a += (cnt[e] + 255) & ~255; }
    off[16] = a;
}
__device__ __forceinline__ void ph_scatter(const Params& P, int l) {
    const int tid = tid_(), lane = tid & 63, wid = tid >> 6;
    const int* cnt = (const int*)(P.ws + WS_CNT) + l * 16;
    int off[17]; moe_offsets(cnt, off);
    const bf16_t* f = (const bf16_t*)(P.ws + WS_H); bf16_t* Fs = (bf16_t*)(P.ws + WS_FS);
    const int* sel_e = (const int*)(P.ws + WS_SELE); const int* sel_p = (const int*)(P.ws + WS_SELP); int* srow = (int*)(P.ws + WS_SROW);
    for (int r = bid_() * 8 + wid; r < ((l == DEPTH - 1) ? NLAT : NTOK); r += gridDim.x * 8) {
        const uint4 a = *(const uint4*)(f + (size_t)r * D + lane * 8), b = *(const uint4*)(f + (size_t)r * D + 512 + lane * 8);
#pragma unroll
        for (int k = 0; k < 2; ++k) {
            const int e = sel_e[r * 2 + k];
            int o = 0;
#pragma unroll
            for (int q = 0; q < 16; ++q) o = (e == q) ? off[q] : o;
            const int d = o + sel_p[r * 2 + k];
            *(uint4*)(Fs + (size_t)d * D + lane * 8) = a; *(uint4*)(Fs + (size_t)d * D + 512 + lane * 8) = b;
            if (lane == 0) srow[r * 2 + k] = d;
        }
    }
}
struct SchedMoe { int NM, G, c; int tfirst[16]; const char* A; const char* W; size_t tA, eW, tW;
    __device__ __forceinline__ bool next(int i, pg8::Unit& u) const {
        const int L = i * G + c; if (L >= NM * 4) return false;
        const int pm = L >> 2, pn = L & 3;
        int e = 0;
#pragma unroll
        for (int q = 1; q < 16; ++q) e += (pm >= tfirst[q]) ? 1 : 0;
        u.row0 = pm * 256; u.col0 = pn * 256; u.aux = e; u.A = A + (size_t)pm * tA; u.B = W + (size_t)e * eW + (size_t)pn * tW; return true; } };
struct FSwiglu { bf16_t* H;
    __device__ __forceinline__ void operator()(const pg8::Unit&, int row, int col, const f32x4& v0, const f32x4& v1) const {
        const int hc = ((col & ~31) >> 1) + (col & 15);
        uint2 a; a.x = pk_bf16(siluf_(v0[0]) * v1[0], siluf_(v0[1]) * v1[1]); a.y = pk_bf16(siluf_(v0[2]) * v1[2], siluf_(v0[3]) * v1[3]);
        *(uint2*)(H + (size_t)row * EH + hc) = a; } };
__device__ __forceinline__ void moe_sched(const Params& P, int l, SchedMoe& S) {
    const int* cnt = (const int*)(P.ws + WS_CNT) + l * 16;
    int a = 0;
#pragma unroll
    for (int e = 0; e < 16; ++e) { S.tfirst[e] = a; a += (cnt[e] + 255) >> 8; }
    S.NM = a; S.G = (int)gridDim.x; S.c = (S.G % 8 == 0) ? ((int)bid_() % 8) * (S.G / 8) + (int)bid_() / 8 : (int)bid_();
}
struct SchedMoeG { int NM, G, c; int tfirst[16]; int cnt[16]; const int* inv; const char* A; const char* W; int R[2], C[2];
    __device__ __forceinline__ bool next(int i, pg8::Unit& u) const {
        const int L = i * G + c; if (L >= NM * 4) return false;
        const int pm = L >> 2, pn = L & 3;
        int e = 0;
#pragma unroll
        for (int q = 1; q < 16; ++q) e += (pm >= tfirst[q]) ? 1 : 0;
        int tf = 0, ne = 0;
#pragma unroll
        for (int q = 0; q < 16; ++q) { tf = (e == q) ? tfirst[q] : tf; ne = (e == q) ? cnt[q] : ne; }
        u.row0 = pm * 256; u.col0 = pn * 256; u.aux = e | (tf << 8) | (ne << 16); u.A = A; u.B = W + (size_t)e * (1024 * 1024 * 2) + (size_t)pn * (256 * 1024 * 2);
        return true; }
    __device__ __forceinline__ void gather(const pg8::Unit& u, unsigned (&gv)[2][2]) const {
        const int e = u.aux & 255, tf = (u.aux >> 8) & 255, ne = (int)((unsigned)u.aux >> 16), p0 = ((u.row0 >> 8) - tf) * 256;
#pragma unroll
        for (int h = 0; h < 2; ++h)
#pragma unroll
            for (int k = 0; k < 2; ++k) { const int idx = p0 + h * 128 + R[k];
                const int tok = (idx < ne) ? inv[(size_t)e * NTOK + idx] : 0;
                gv[h][k] = (unsigned)(tok * D + C[k]) * 2u; } } };
__device__ __forceinline__ void ph_moe1(const Params& P, LAS unsigned char* lds, int l) {
    SchedMoeG S;
    { const int* cnt = (const int*)(P.ws + WS_CNT) + l * 16; int a = 0;
#pragma unroll
      for (int e = 0; e < 16; ++e) { S.tfirst[e] = a; S.cnt[e] = cnt[e]; a += (cnt[e] + 255) >> 8; }
      S.NM = a; }
    S.G = (int)gridDim.x; S.c = (S.G % 8 == 0) ? ((int)bid_() % 8) * (S.G / 8) + (int)bid_() / 8 : (int)bid_(); S.inv = (const int*)(P.ws + WS_INV); S.A = (const char*)(P.ws + WS_H); S.W = (const char*)(P.ws + WS_WGU);
    { const int tid = tid_();
#pragma unroll
      for (int k = 0; k < 2; ++k) { int R_, C_; pg8::stage_rc(tid * 16 + k * 8192, R_, C_); S.R[k] = R_; S.C[k] = C_; } }
    pg8::EpiPair<FSwiglu> E{{(bf16_t*)(P.ws + WS_HS)}};
    pg8::gemm_phase<pg8::EpiPair<FSwiglu>, SchedMoeG, true>(lds, pg8::Gemm{1024, 1024, 1024}, S, E);
}
__device__ __forceinline__ void ph_moe2(const Params& P, LAS unsigned char* lds, int l) {
    SchedMoe S; moe_sched(P, l, S);
    S.A = (const char*)(P.ws + WS_HS); S.W = (const char*)(P.ws + WS_WDN); S.tA = (size_t)256 * EH * 2; S.eW = (size_t)1024 * 512 * 2; S.tW = (size_t)256 * 512 * 2;
    EpiStore16 E{(bf16_t*)(P.ws + WS_YS), D};
    pg8::gemm_phase(lds, pg8::Gemm{512, 512, 512}, S, E);
    if (l + 1 < DEPTH) { const int T = S.NM * 4, rem = T % S.G; int nidle = (rem == 0) ? S.G : S.G - rem, idx = (rem == 0) ? S.c : S.c - rem;
        if (nidle < 64) { nidle = S.G; idx = S.c; }
        if (idx >= 0) wconv_range(P, lds, l + 1, 16 * 124, CONV_T_DENSE, idx, nidle); }
}
__device__ __forceinline__ int srow_of(const int (&moff)[17], int e, int p) { int o = 0;
#pragma unroll
    for (int q = 0; q < 16; ++q) o = (e == q) ? moff[q] : o;
    return o + p; }
__device__ __forceinline__ void ph_combine(const Params& P, int l, bool dry = false) {
    const int tid = tid_(), lane = tid & 63, wid = tid >> 6;
    float* xres = (float*)(P.ws + WS_X);
    const bf16_t* Ys = (const bf16_t*)(P.ws + WS_YS);
    const float* sel_w = (const float*)(P.ws + WS_SELW); const int* sel_e = (const int*)(P.ws + WS_SELE); const int* sel_p = (const int*)(P.ws + WS_SELP);
    int moff[17]; moe_offsets((const int*)(P.ws + WS_CNT) + l * 16, moff);
#define SROW_(i_) srow_of(moff, sel_e[i_], sel_p[i_])
    bf16_t* h = (bf16_t*)(P.ws + (dry ? WS_END : WS_H));
    const bf16_t* dxb = (const bf16_t*)(P.ws + WS_BR);
    const int NR_ = (l == DEPTH - 1) ? NLAT : NTOK, rs_ = gridDim.x * 8;
    int rq = bid_() * 8 + wid;
    float nw0 = 0.f, nw1 = 0.f; int ns0 = 0, ns1 = 0;
    if (rq < NR_) { nw0 = sel_w[rq * 2]; nw1 = sel_w[rq * 2 + 1]; ns0 = SROW_(rq * 2); ns1 = SROW_(rq * 2 + 1); }
    float4 xn[4]; uint2 dn[4], an[4], bn[4]; float cw0 = 0.f, cw1 = 0.f;
    if (rq < NR_) {
        cw0 = nw0; cw1 = nw1;
#pragma unroll
        for (int i = 0; i < 4; ++i) { const int c = lane * 4 + 256 * i; xn[i] = *(const float4*)(xrow(P, l, rq) + c); dn[i] = *(const uint2*)(dxb + (size_t)rq * D + c);
            an[i] = *(const uint2*)(Ys + (size_t)ns0 * D + c); bn[i] = *(const uint2*)(Ys + (size_t)ns1 * D + c); }
        if (rq + rs_ < NR_) { nw0 = sel_w[(rq + rs_) * 2]; nw1 = sel_w[(rq + rs_) * 2 + 1]; ns0 = SROW_((rq + rs_) * 2); ns1 = SROW_((rq + rs_) * 2 + 1); }
    }
    for (int r = rq; r < NR_; r += rs_) {
        const float* gate = (const float*)(P.ws + WS_MODS) + ((size_t)l * 9 + row_modrow(r)) * 6144 + 5 * 1024;
        const float w0 = cw0, w1 = cw1;
        float4 x[4]; uint2 dv_[4], a_[4], b_[4];
#pragma unroll
        for (int i = 0; i < 4; ++i) { x[i] = xn[i]; dv_[i] = dn[i]; a_[i] = an[i]; b_[i] = bn[i]; }
        if (r + rs_ < NR_) {
            cw0 = nw0; cw1 = nw1;
#pragma unroll
            for (int i = 0; i < 4; ++i) { const int c = lane * 4 + 256 * i; xn[i] = *(const float4*)(xrow(P, l, r + rs_) + c); dn[i] = *(const uint2*)(dxb + (size_t)(r + rs_) * D + c);
                an[i] = *(const uint2*)(Ys + (size_t)ns0 * D + c); bn[i] = *(const uint2*)(Ys + (size_t)ns1 * D + c); }
            if (r + 2 * rs_ < NR_) { nw0 = sel_w[(r + 2 * rs_) * 2]; nw1 = sel_w[(r + 2 * rs_) * 2 + 1]; ns0 = SROW_((r + 2 * rs_) * 2); ns1 = SROW_((r + 2 * rs_) * 2 + 1); }
        }
#pragma unroll
        for (int i = 0; i < 4; ++i) {
            const int c = lane * 4 + 256 * i;
            x[i].x += bf_lo(dv_[i].x); x[i].y += bf_hi(dv_[i].x); x[i].z += bf_lo(dv_[i].y); x[i].w += bf_hi(dv_[i].y);
            const uint2 a = a_[i], b = b_[i];
            const float4 gv = *(const float4*)(gate + c);
            x[i].x += gv.x * (w0 * bf_lo(a.x) + w1 * bf_lo(b.x)); x[i].y += gv.y * (w0 * bf_hi(a.x) + w1 * bf_hi(b.x));
            x[i].z += gv.z * (w0 * bf_lo(a.y) + w1 * bf_lo(b.y)); x[i].w += gv.w * (w0 * bf_hi(a.y) + w1 * bf_hi(b.y));
        }
        if (l < DEPTH - 1) {
#pragma unroll
            for (int i = 0; i < 4; ++i) *(float4*)((dry ? (float*)(P.ws + WS_END) + (size_t)NTOK * 512 : xres) + (size_t)r * D + lane * 4 + 256 * i) = x[i];
            const float* mod = (const float*)(P.ws + WS_MODS) + ((size_t)(l + 1) * 9 + row_modrow(r)) * 6144;
            float4 o[4];
            norm_row(x, P.in[I_GMIX] + (l + 1) * 1024, mod, mod + 1024, lane, o);
#pragma unroll
            for (int i = 0; i < 4; ++i) { uint2 u; u.x = pk_bf16(o[i].x, o[i].y); u.y = pk_bf16(o[i].z, o[i].w); *(uint2*)(h + (size_t)r * D + lane * 4 + 256 * i) = u; }
        } else if (r < NLAT) {
            float ss = 0.f;
#pragma unroll
            for (int i = 0; i < 4; ++i) ss += x[i].x * x[i].x + x[i].y * x[i].y + x[i].z * x[i].z + x[i].w * x[i].w;
            ss = wave_sum(ss);
            const float rstd = __builtin_amdgcn_rsqf(ss * (1.0f / 1024.0f) + 1e-6f);
#pragma unroll
            for (int i = 0; i < 4; ++i) {
                const int c = lane * 4 + 256 * i;
                const float4 gv = *(const float4*)(P.in[I_GFIN] + c);
                float4 o; o.x = x[i].x * rstd * gv.x; o.y = x[i].y * rstd * gv.y; o.z = x[i].z * rstd * gv.z; o.w = x[i].w * rstd * gv.w;
                *(float4*)((dry ? (float*)(P.ws + WS_END) : P.out) + (size_t)r * D + c) = o;
            }
        }
    }
}

constexpr int NPH_LAYER = 12, NPH = 1 + DEPTH * NPH_LAYER;
#define CAS __attribute__((address_space(4)))
__device__ __forceinline__ const Params& kparams() { const CAS Params* k = (const CAS Params*)__builtin_amdgcn_kernarg_segment_ptr(); asm volatile("" : "+s"(k)); return *(const Params*)k; }
__global__ void __launch_bounds__(NTHR, 2) fwd(Params P_) {
    extern __shared__ __attribute__((aligned(16))) unsigned char lds_raw[];
    LAS unsigned char* lds = (LAS unsigned char*)lds_raw;
    volatile LAS unsigned* xbw = (volatile LAS unsigned*)(lds + LDS_BYTES - 16);
    if (threadIdx.x == 0) { xbw[0] = 0u; xbw[1] = 0u; xbw[2] = 0u; xbw[3] = 0u; }
    __syncthreads();
    const int lo = P_.ph_lo, hi = P_.ph_hi;
    asm volatile(".rept 15\n\ts_nop 0\n\t.endr");
    XcdBarrier bar; bar.bar = (unsigned*)(P_.ws + WS_BAR); bar.x = 0; bar.st = xbw;
    if (hi - lo > 1) bar = xcd_barrier_post((unsigned*)(P_.ws + WS_BAR), xbw);
#ifndef PHMASK
#define PHMASK 0xFFFF
#endif
#define EN(j) ((PHMASK >> (j)) & 1)
#define IN(k) (lo <= (k) && (k) < hi)
#define SEAM(k) do { if (IN(k) && IN((k) + 1)) xcd_barrier(bar); } while (0)
    if (EN(12) && IN(0)) for (int rep = 0; rep < NREP(12); ++rep) { ph_prologue(kparams(), lds); }
    SEAM(0);
    for (int l = 0; l < DEPTH; ++l) {
        const int p0 = 1 + l * NPH_LAYER;
        if (l == 0) { if (EN(0) && IN(p0 + 0)) for (int rep = 0; rep < NREP(0); ++rep) { ph_wconv(kparams(), lds, l); ph_norm1(kparams(), l); }
        SEAM(p0 + 0); }
        if (EN(1) && IN(p0 + 1)) for (int rep = 0; rep < NREP(1); ++rep) ph_g1(kparams(), lds);
        SEAM(p0 + 1);
        if (EN(2) && IN(p0 + 2)) for (int rep = 0; rep < NREP(2); ++rep) { ph_prepnavt(kparams(), lds, l); }
        SEAM(p0 + 2);
        if (EN(3) && IN(p0 + 3)) { ph_mix(kparams(), lds, (char*)lds_raw, l);
            if (REPEAT_MASK & 0x8) { xcd_barrier(bar); ph_mix(kparams(), lds, (char*)lds_raw, l, 1, 0); }
            if (REPEAT_MASK & 0x2000) { xcd_barrier(bar); ph_mix(kparams(), lds, (char*)lds_raw, l, 1, 1); }
            if (REPEAT_MASK & 0x4000) { xcd_barrier(bar); ph_mix(kparams(), lds, (char*)lds_raw, l, 1, 2); }
            if (REPEAT_MASK & 0x8000) { xcd_barrier(bar); ph_mix(kparams(), lds, (char*)lds_raw, l, 1, 3); } }
        SEAM(p0 + 3);
        if (EN(4) && IN(p0 + 4)) for (int rep = 0; rep < NREP(4); ++rep) {
#if defined(DIAG) && DIAG == 5
            { const Params& Pq = kparams(); const int G_ = gridDim.x, c_ = bid_(), vcu_ = (c_ % 8) * (G_ / 8) + c_ / 8; for (int u = vcu_; u < 320; u += G_) na_unit(Pq, lds, l, u, (bf16_t*)(Pq.ws + WS_BR), BRW); __syncthreads(); }
#endif
            ph_readout(kparams(), l);
#if defined(DIAG) && (DIAG == 1 || DIAG == 4)
            ph_diag_cmp(kparams());
#endif
#if defined(DIAG) && DIAG == 3
            { const Params& Pq = kparams(); const uint4* d1 = (const uint4*)(Pq.ws + WS_END); bf16_t* brq = (bf16_t*)(Pq.ws + WS_BR);
              for (size_t i = (size_t)bid_() * NTHR + tid_(); i < (size_t)NTOK * 64; i += (size_t)gridDim.x * NTHR) { const size_t r = i >> 6; const int c8 = (int)(i & 63) * 8; *(uint4*)(brq + r * BRW + c8) = d1[i]; } }
#endif
        }
        SEAM(p0 + 4);
        if (EN(5) && IN(p0 + 5)) for (int rep = 0; rep < NREP(5); ++rep) ph_merge(kparams(), lds, l);
        SEAM(p0 + 5);
        if (EN(6) && IN(p0 + 6)) for (int rep = 0; rep < NREP(6); ++rep) ph_wout(kparams(), lds, l, rep > 0);
        SEAM(p0 + 6);
        if (EN(7) && IN(p0 + 7)) for (int rep = 0; rep < NREP(7); ++rep) ph_norm2_route(kparams(), lds, l, rep > 0);
        SEAM(p0 + 7);
        if (EN(9) && IN(p0 + 9)) for (int rep = 0; rep < NREP(9); ++rep) ph_moe1(kparams(), lds, l);
        SEAM(p0 + 9);
        if (EN(10) && IN(p0 + 10)) for (int rep = 0; rep < NREP(10); ++rep) ph_moe2(kparams(), lds, l);
        SEAM(p0 + 10);
        if (EN(11) && IN(p0 + 11)) for (int rep = 0; rep < NREP(11); ++rep) { ph_combine(kparams(), l, rep > 0); }
        if (l + 1 < DEPTH) { if (IN(p0 + 11) && IN(p0 + 13)) xcd_barrier(bar); }
    }
#if defined(DIAG) && (DIAG == 1 || DIAG == 4)
    xcd_barrier(bar); ph_diag_out(kparams());
#endif
#undef IN
#undef SEAM
}

#ifndef MK_PER_PHASE
#define MK_PER_PHASE 0
#endif
extern "C" void kernel_launch(void* const* d_in, const int* in_sizes, int n_in, void* d_out, int out_size, void* d_ws, size_t ws_size, hipStream_t stream) {
    static int grid = 0;
    if (grid == 0) {
        if (n_in != 24 || out_size != NLAT * D || ws_size < WS_END + (size_t)NTOK * 4096 + 4096) { fprintf(stderr, "kernel_launch: unexpected shapes (n_in %d out %d ws %zu need %zu)\n", n_in, out_size, ws_size, (size_t)WS_END); grid = -1; return; }
        int dev = 0, cus = 0, per_cu = 0;
        if (hipGetDevice(&dev) != hipSuccess || hipDeviceGetAttribute(&cus, hipDeviceAttributeMultiprocessorCount, dev) != hipSuccess) { grid = -1; return; }
        if (hipFuncSetAttribute((const void*)fwd, hipFuncAttributeMaxDynamicSharedMemorySize, LDS_BYTES) != hipSuccess) { fprintf(stderr, "kernel_launch: hipFuncSetAttribute failed\n"); grid = -1; return; }
        if (hipOccupancyMaxActiveBlocksPerMultiprocessor(&per_cu, (const void*)fwd, NTHR, LDS_BYTES) != hipSuccess || per_cu < 1) { fprintf(stderr, "kernel_launch: occupancy query says %d\n", per_cu); }
        (void)hipGetLastError();
        grid = cus;
    }
    if (grid < 0) return;
    (void)hipMemsetAsync(d_ws, 0, WS_ZERO_BYTES, stream);
    Params p{};
    for (int i = 0; i < 24; ++i) p.in[i] = (const float*)d_in[i];
    p.out = (float*)d_out; p.ws = (unsigned char*)d_ws;
#if MK_PER_PHASE
    for (int ph = 0; ph < NPH; ++ph) { p.ph_lo = ph; p.ph_hi = ph + 1; hipLaunchKernelGGL(fwd, dim3(grid), dim3(NTHR), LDS_BYTES, stream, p); }
#else
    p.ph_lo = 0; p.ph_hi = NPH; hipLaunchKernelGGL(fwd, dim3(grid), dim3(NTHR), LDS_BYTES, stream, p);
#endif
}
```
